# Optimizing an MI355X kernel written in HIP

```python
import math
import jax
import jax.numpy as jnp
from jax import lax
import numpy as np


D_MODEL = 1024
BATCH = 32
SEQ = 2048
DEPTH = 4

A_HEADS = 4
A_QK_DIM = 64
A_V_DIM = 128
A_WIDTH = A_HEADS * A_V_DIM
B_WIDTH = 512
B_CONV = 3
C_HEADDIM = 64
C_WIDTH = 512
C_HEADS = C_WIDTH // C_HEADDIM
C_GROUPS = 2
C_HPG = C_HEADS // C_GROUPS
C_STATE = 128
C_CONV = 4
C_CONV_CH = C_WIDTH + 2 * C_GROUPS * C_STATE
DT_MIN = 1e-3
DT_MAX = 1e-1
D_HEADS = 4
D_HEAD_DIM = 128
D_WIDTH = D_HEADS * D_HEAD_DIM
Q_BLOCK = 128
N_BRANCH = 4
BRANCH_WIDTH = 512
CHUNK = 64
D_FF = 2816
FFN_CONV = 3
EPS = 1e-6
NEG = -1e30

SPLITS = (A_HEADS * A_QK_DIM, A_HEADS * A_QK_DIM, A_WIDTH, A_WIDTH, A_HEADS, A_HEADS,
          B_WIDTH, B_WIDTH, B_WIDTH,
          C_WIDTH, C_CONV_CH, C_HEADS,
          D_WIDTH, D_WIDTH, D_WIDTH,
          N_BRANCH * D_MODEL)
P_IN = sum(SPLITS)
SPLIT_POINTS = tuple(int(v) for v in np.cumsum(SPLITS)[:-1])

kernel_name = 'hybrid_gated_mlstm_shortconv_ssd_stickbreak'


def rmsnorm(x, g):
    xf = x.astype(jnp.float32)
    y = xf * lax.rsqrt(jnp.mean(xf * xf, axis=-1, keepdims=True) + EPS)
    return (y * g.astype(jnp.float32)).astype(x.dtype)


def causal_dwconv(x, w):
    K = w.shape[0]
    S = x.shape[1]
    xp = jnp.pad(x, ((0, 0), (K - 1, 0), (0, 0)))
    out = xp[:, 0:S] * w[0]
    for j in range(1, K):
        out = out + xp[:, j:j + S] * w[j]
    return out


def to_chunks(t):
    Bn, S = t.shape[0], t.shape[1]
    return jnp.moveaxis(t.reshape(Bn, S // CHUNK, CHUNK, *t.shape[2:]), 1, 0)


def from_chunks(t):
    nc, Bn, L = t.shape[0], t.shape[1], t.shape[2]
    return jnp.moveaxis(t, 0, 1).reshape(Bn, nc * L, *t.shape[3:])


def mlstm(q, k, v, o, ig, fg, norm_g):
    f32 = jnp.float32
    Bn, S = q.shape[0], q.shape[1]
    q = q.reshape(Bn, S, A_HEADS, A_QK_DIM).astype(f32) * (A_QK_DIM ** -0.5)
    k = k.reshape(Bn, S, A_HEADS, A_QK_DIM).astype(f32)
    v = v.reshape(Bn, S, A_HEADS, A_V_DIM).astype(f32)
    ig = ig.astype(f32)
    lf = jax.nn.log_sigmoid(fg.astype(f32))
    qc = jnp.swapaxes(to_chunks(q), 2, 3)
    kc = jnp.swapaxes(to_chunks(k), 2, 3)
    vc = jnp.swapaxes(to_chunks(v), 2, 3)
    igc = jnp.swapaxes(to_chunks(ig), 2, 3)
    lfc = jnp.swapaxes(to_chunks(lf), 2, 3)
    tri = jnp.tril(jnp.ones((CHUNK, CHUNK), dtype=bool))

    def step(carry, xs):
        C, n, m = carry
        qx, kx, vx, ix, fx = xs
        b = jnp.cumsum(fx, axis=-1)
        logD = jnp.where(tri, b[..., :, None] - b[..., None, :] + ix[..., None, :], NEG)
        inter = b + m[..., None]
        m_t = jnp.maximum(inter, jnp.max(logD, axis=-1))
        Dm = jnp.exp(logD - m_t[..., None])
        inter_s = jnp.exp(inter - m_t)
        Sm = jnp.einsum('bhtk,bhsk->bhts', qx, kx) * Dm
        num = jnp.einsum('bhts,bhsv->bhtv', Sm, vx) + inter_s[..., None] * jnp.einsum('bhtk,bhkv->bhtv', qx, C)
        den = jnp.sum(Sm, axis=-1) + inter_s * jnp.einsum('bhtk,bhk->bht', qx, n)
        h = num / jnp.maximum(jnp.abs(den), jnp.exp(-m_t))[..., None]
        bL = b[..., -1]
        logw = bL[..., None] - b + ix
        m_new = jnp.maximum(bL + m, jnp.max(logw, axis=-1))
        w = jnp.exp(logw - m_new[..., None])
        sc = jnp.exp(bL + m - m_new)
        C = sc[..., None, None] * C + jnp.einsum('bhs,bhsk,bhsv->bhkv', w, kx, vx)
        n = sc[..., None] * n + jnp.einsum('bhs,bhsk->bhk', w, kx)
        return (C, n, m_new), h

    init = (jnp.zeros((Bn, A_HEADS, A_QK_DIM, A_V_DIM), f32),
            jnp.zeros((Bn, A_HEADS, A_QK_DIM), f32),
            jnp.zeros((Bn, A_HEADS), f32))
    _, h = lax.scan(step, init, (qc, kc, vc, igc, lfc))
    h = from_chunks(jnp.swapaxes(h, 2, 3))
    h = h * lax.rsqrt(jnp.mean(h * h, axis=-1, keepdims=True) + EPS)
    h = h.reshape(Bn, S, A_WIDTH) * norm_g.astype(f32)
    return (jax.nn.sigmoid(o.astype(f32)) * h).astype(o.dtype)


def short_conv_mixer(bg, cg, xb, conv_w):
    return bg * causal_dwconv(cg * xb, conv_w)


def ssd_scan(x, dt, A, Bm, Cm):
    f32 = jnp.float32
    Bn = x.shape[0]
    tri = jnp.tril(jnp.ones((CHUNK, CHUNK), dtype=bool))

    def step(h, xs):
        xx, dd, bb, cc = xs
        a = jnp.cumsum(dd * A, axis=1)
        seg = a[:, :, None] - a[:, None, :]
        Ldec = jnp.exp(jnp.where(tri[:, :, None, None], seg, NEG))
        CB = jnp.einsum('btgn,bsgn->btsg', cc, bb)
        y_diag = jnp.einsum('btsg,btsgh,bsgh,bsghp->btghp', CB, Ldec, dd, xx)
        y_off = jnp.einsum('btgn,bghpn->btghp', cc, h) * jnp.exp(a)[..., None]
        a_last = a[:, -1]
        wdec = jnp.exp(a_last[:, None] - a) * dd
        h = h * jnp.exp(a_last)[..., None, None] + jnp.einsum('bsgn,bsgh,bsghp->bghpn', bb, wdec, xx)
        return h, y_diag + y_off

    h0 = jnp.zeros((Bn, C_GROUPS, C_HPG, C_HEADDIM, C_STATE), f32)
    _, y = lax.scan(step, h0, (to_chunks(x), to_chunks(dt), to_chunks(Bm), to_chunks(Cm)))
    return from_chunks(y)


def mamba2_mixer(z, xbc, dt_raw, conv_w, conv_b, dt_bias, a_log, d_skip, norm_g):
    f32 = jnp.float32
    Bn, S = z.shape[0], z.shape[1]
    xbc = jax.nn.silu(causal_dwconv(xbc, conv_w) + conv_b).astype(f32)
    xs = xbc[..., :C_WIDTH].reshape(Bn, S, C_GROUPS, C_HPG, C_HEADDIM)
    Bm = xbc[..., C_WIDTH:C_WIDTH + C_GROUPS * C_STATE].reshape(Bn, S, C_GROUPS, C_STATE)
    Cm = xbc[..., C_WIDTH + C_GROUPS * C_STATE:].reshape(Bn, S, C_GROUPS, C_STATE)
    dt = jax.nn.softplus(dt_raw.astype(f32) + dt_bias.astype(f32)).reshape(Bn, S, C_GROUPS, C_HPG)
    A = -jnp.exp(a_log.astype(f32)).reshape(C_GROUPS, C_HPG)
    y = ssd_scan(xs, dt, A, Bm, Cm)
    y = y + d_skip.astype(f32).reshape(C_GROUPS, C_HPG)[..., None] * xs
    y = y.reshape(Bn, S, C_WIDTH) * jax.nn.silu(z.astype(f32))
    return rmsnorm(y, norm_g).astype(z.dtype)


def stick_breaking_attention(q, k, v):
    f32 = jnp.float32
    Bn, S = q.shape[0], q.shape[1]
    def heads(t):
        return t.reshape(Bn, S, D_HEADS, D_HEAD_DIM).transpose(0, 2, 1, 3).astype(f32)
    qh = heads(q) * (D_HEAD_DIM ** -0.5)
    kh = heads(k)
    vh = heads(v)
    nb = S // Q_BLOCK
    qb = qh.reshape(Bn, D_HEADS, nb, Q_BLOCK, D_HEAD_DIM).transpose(2, 0, 1, 3, 4)
    key_pos = jnp.arange(S)

    def block(args):
        qblk, start = args
        z = jnp.einsum('bhtd,bhsd->bhts', qblk, kh)
        t_pos = start + jnp.arange(Q_BLOCK)
        mask = key_pos[None, :] < t_pos[:, None]
        log_rest = jnp.where(mask, jax.nn.log_sigmoid(-z), 0.0)
        shifted = jnp.concatenate([log_rest[..., 1:], jnp.zeros_like(log_rest[..., :1])], axis=-1)
        R = lax.cumsum(shifted, axis=3, reverse=True)
        A = jnp.where(mask, jnp.exp(jax.nn.log_sigmoid(z) + R), 0.0)
        return jnp.einsum('bhts,bhsd->bhtd', A, vh)

    starts = jnp.arange(nb) * Q_BLOCK
    out = lax.map(block, (qb, starts))
    out = out.transpose(1, 0, 3, 2, 4).reshape(Bn, S, D_WIDTH)
    return out.astype(q.dtype)


def conv_glu_mlp(x, w_up, conv_w, conv_b, w_down):
    h = causal_dwconv(x @ w_up, conv_w) + conv_b
    g, u = jnp.split(h, 2, axis=-1)
    return (jax.nn.silu(g) * u) @ w_down


def setup_inputs(seed: int = 0) -> dict:
    key = jax.random.key(seed)
    ks = jax.random.split(key, 22)
    f32 = jnp.float32

    def nrm(k, shape, scale):
        return jax.random.normal(k, shape, f32) * scale

    def gain(k, shape):
        return 1.0 + 0.1 * jax.random.normal(k, shape, f32)

    dt0 = jnp.exp(jax.random.uniform(ks[9], (DEPTH, C_HEADS), f32, math.log(DT_MIN), math.log(DT_MAX)))
    return {
        'x': nrm(ks[0], (BATCH, SEQ, D_MODEL), 1.0),
        'mix_norm_g': gain(ks[1], (DEPTH, D_MODEL)),
        'w_in': nrm(ks[2], (DEPTH, D_MODEL, P_IN), D_MODEL ** -0.5),
        'a_igate_b': nrm(ks[3], (DEPTH, A_HEADS), 0.1),
        'a_fgate_b': jnp.linspace(3.0, 6.0, A_HEADS, dtype=f32)[None, :] + nrm(ks[4], (DEPTH, A_HEADS), 0.1),
        'a_norm_g': gain(ks[5], (DEPTH, A_WIDTH)),
        'b_conv_w': nrm(ks[6], (DEPTH, B_CONV, B_WIDTH), B_CONV ** -0.5),
        'c_conv_w': nrm(ks[7], (DEPTH, C_CONV, C_CONV_CH), C_CONV ** -0.5),
        'c_conv_b': nrm(ks[8], (DEPTH, C_CONV_CH), 0.02),
        'c_dt_bias': jnp.log(jnp.expm1(dt0)),
        'c_a_log': jnp.log(jax.random.uniform(ks[10], (DEPTH, C_HEADS), f32, 1.0, 16.0)),
        'c_d_skip': gain(ks[11], (DEPTH, C_HEADS)),
        'c_norm_g': gain(ks[12], (DEPTH, C_WIDTH)),
        'w_lift': nrm(ks[13], (DEPTH, N_BRANCH, BRANCH_WIDTH, D_MODEL), BRANCH_WIDTH ** -0.5),
        'w_out': nrm(ks[14], (DEPTH, D_MODEL, D_MODEL), D_MODEL ** -0.5),
        'ffn_norm_g': gain(ks[15], (DEPTH, D_MODEL)),
        'w_up': nrm(ks[16], (DEPTH, D_MODEL, 2 * D_FF), D_MODEL ** -0.5),
        'ffn_conv_w': nrm(ks[17], (DEPTH, FFN_CONV, 2 * D_FF), FFN_CONV ** -0.5),
        'ffn_conv_b': nrm(ks[18], (DEPTH, 2 * D_FF), 0.02),
        'w_down': nrm(ks[19], (DEPTH, D_FF, D_MODEL), D_FF ** -0.5),
        'final_norm_g': gain(ks[20], (D_MODEL,)),
    }


def reference(x, mix_norm_g, w_in, a_igate_b, a_fgate_b, a_norm_g, b_conv_w, c_conv_w, c_conv_b,
              c_dt_bias, c_a_log, c_d_skip, c_norm_g, w_lift, w_out, ffn_norm_g, w_up,
              ffn_conv_w, ffn_conv_b, w_down, final_norm_g):
    Bn, S = x.shape[0], x.shape[1]
    for l in range(DEPTH):
        xn = rmsnorm(x, mix_norm_g[l])
        p = xn @ w_in[l]
        (aq, ak, av, ao, ai, af, bb, bc, bx, cz, cxbc, cdt,
         sq, sk, sv, gates) = jnp.split(p, SPLIT_POINTS, axis=-1)
        ya = mlstm(aq, ak, av, ao, ai + a_igate_b[l], af + a_fgate_b[l], a_norm_g[l])
        yb = short_conv_mixer(bb, bc, bx, b_conv_w[l])
        yc = mamba2_mixer(cz, cxbc, cdt, c_conv_w[l], c_conv_b[l], c_dt_bias[l], c_a_log[l],
                          c_d_skip[l], c_norm_g[l])
        yd = stick_breaking_attention(sq, sk, sv)
        ycat = jnp.stack([ya, yb, yc, yd], axis=2)
        lifted = jnp.einsum('bsie,ied->bsid', ycat, w_lift[l])
        g = jax.nn.sigmoid(gates.reshape(Bn, S, N_BRANCH, D_MODEL))
        merged = jnp.einsum('bsid,bsid->bsd', g, lifted)
        x = x + merged @ w_out[l]
        x = x + conv_glu_mlp(rmsnorm(x, ffn_norm_g[l]), w_up[l], ffn_conv_w[l], ffn_conv_b[l], w_down[l])
    return rmsnorm(x, final_norm_g)
```

```cpp
#include <hip/hip_runtime.h>
#include <cstdio>
#include <cstdint>

#define LAS __attribute__((address_space(3)))
#define GAS __attribute__((address_space(1)))
typedef unsigned short bf16;
typedef short bf16x8 __attribute__((ext_vector_type(8)));
typedef short s16x4 __attribute__((ext_vector_type(4)));
typedef float f32x4 __attribute__((ext_vector_type(4)));
typedef float f32x2 __attribute__((ext_vector_type(2)));
typedef unsigned u32x4 __attribute__((ext_vector_type(4)));
typedef unsigned u32x2 __attribute__((ext_vector_type(2)));

constexpr int DM = 1024, BATCH = 32, SEQ = 2048, DEPTH = 4;
constexpr int PIN = 10256, PW = 10240, DFF = 2816, DFF2 = 5632;
constexpr int GB = 8;
constexpr int NG = BATCH / GB;
constexpr int T = GB * SEQ;
constexpr int NCH = SEQ / 64;
constexpr float EPS = 1e-6f;
constexpr int P_AQ = 0, P_AK = 256, P_AV = 512, P_AO = 1024, P_BB = 1536, P_BC = 2048, P_BX = 2560, P_CZ = 3072, P_CX = 3584, P_SQ = 4608, P_SK = 5120, P_SV = 5632, P_G = 6144;
constexpr int YW = 2048;

constexpr size_t MiB = 1u << 20;
constexpr size_t WS_CTL = 0, CTL_BYTES = 1 * MiB;
constexpr size_t WS_WIN = 1 * MiB;
constexpr size_t WS_WLIFT = WS_WIN + (size_t)PW * DM * 2;
constexpr size_t WS_WOUT = WS_WLIFT + (size_t)4 * DM * 512 * 2;
constexpr size_t WS_WUP = WS_WOUT + (size_t)DM * DM * 2;
constexpr size_t WS_WDOWN = WS_WUP + (size_t)DFF2 * DM * 2;
constexpr size_t WS_W16 = WS_WDOWN + (size_t)DM * DFF * 2;
constexpr size_t WS_XN = WS_W16 + 65536;
constexpr size_t WS_P = WS_XN + (size_t)T * DM * 2;
constexpr size_t WS_U = WS_P, WS_ACT = WS_P + (size_t)T * DFF2 * 2;
constexpr size_t WS_YCAT = WS_P + (size_t)T * PW * 2;
constexpr size_t WS_MG = WS_YCAT + (size_t)T * YW * 2;
constexpr size_t WS_MB = WS_MG + (size_t)T * DM * 4;
constexpr size_t WS_SP = WS_MB + (size_t)T * DM * 2;
constexpr size_t WS_GB = WS_SP + (size_t)T * 16 * 4;
constexpr size_t WS_GG = WS_GB + (size_t)T * 16;
constexpr size_t WS_GMT = WS_GG + (size_t)T * 16;
constexpr size_t WS_MCAR = WS_GMT + (size_t)T * 16;
constexpr size_t WS_MNEW = WS_MCAR + 4096;
constexpr size_t WS_MSC = WS_MNEW + 4096;
constexpr size_t WS_DT = WS_MSC + 4096;
constexpr size_t WS_AC = WS_DT + (size_t)T * 32;
constexpr size_t WS_XBC = WS_AC + (size_t)T * 32;
constexpr size_t WS_DC = WS_XBC + (size_t)T * DM * 2;
constexpr size_t WS_CS = WS_DC + (size_t)GB * 4 * NCH * 9216 * 4;
constexpr size_t WS_DH = WS_CS + (size_t)GB * 4 * NCH * 9216 * 2;
constexpr size_t WS_HS = WS_DH + (size_t)GB * NCH * 8 * 8192 * 4;
constexpr size_t WS_END = WS_HS + (size_t)GB * NCH * 8 * 8192 * 2;

constexpr int NWAVES = 8, NTHR = 512;
constexpr int LDS_BYTES = 155648;
constexpr int MISC_OFF = 153600;

__device__ __forceinline__ float bf2f(unsigned b) { return __uint_as_float(b << 16); }
__device__ __forceinline__ unsigned f2bf(float f) { unsigned u = __float_as_uint(f); return (u + 0x7fffu + ((u >> 16) & 1u)) >> 16; }
__device__ __forceinline__ unsigned pk2(float lo, float hi) { return f2bf(lo) | (f2bf(hi) << 16); }
__device__ __forceinline__ float sigmoidf_(float x) { return 1.f / (1.f + __expf(-x)); }
__device__ __forceinline__ float siluf_(float x) { return x / (1.f + __expf(-x)); }
__device__ __forceinline__ float logsigf_(float x) { return fminf(x, 0.f) - log1pf(expf(-fabsf(x))); }
__device__ __forceinline__ float softplusf_(float x) { return fmaxf(x, 0.f) + log1pf(expf(-fabsf(x))); }
__device__ __forceinline__ float wave_sum(float v) {
#pragma unroll
    for (int o = 1; o < 64; o <<= 1) v += __shfl_xor(v, o);
    return v;
}
#define LDS_WAIT() asm volatile("s_waitcnt lgkmcnt(0)" ::: "memory")

namespace pg8 {
constexpr int BM = 256, BK = 64, HALF = 128, HTB = HALF * BK * 2, STAGE_BYTES = 8 * HTB, NXCD = 8, WGM = 8;
__host__ __device__ __forceinline__ int lds_byte(int r, int c) { const int st = (r >> 4) * 2 + (c >> 5), rr = r & 15, cc = c & 31, ob = rr * 64 + cc * 2; return st * 1024 + (ob ^ (((ob >> 9) & 1) << 5)); }
__host__ __device__ __forceinline__ void stage_rc(int b, int& R, int& C) { const int st = b / 1024, sb = b % 1024, swz = sb ^ (((sb >> 9) & 1) << 5); R = (st >> 1) * 16 + swz / 64; C = (st & 1) * 32 + (swz % 64) / 2; }
__host__ __device__ __forceinline__ int perm32(int rho) { const int n = rho >> 4, i = rho & 15; return 8 * (i >> 2) + 4 * n + (i & 3); }

struct Unit { int pm, pn, z; };
struct Gemm { const bf16* A; const bf16* Bt; int K, lda, ldb; size_t zA, zB; };

struct Order {
    int nM, nN, nwg, G, c, Z;
    __device__ void init(int M, int N, int G_, int c_, int Z_) { nM = M / BM; nN = N / BM; nwg = nM * nN; G = G_; c = c_; Z = Z_; }
    __device__ bool next(int i, Unit& u) const {
        const int ti = i / Z; u.z = i - ti * Z;
        const long L = (long)ti * G + c; if (L >= nwg) return false;
        int wgid = (int)L; { const int q = nwg / NXCD, r = nwg % NXCD, xcd = wgid % NXCD, off = wgid / NXCD; wgid = (xcd < r ? xcd * (q + 1) : r * (q + 1) + (xcd - r) * q) + off; }
        const int nig = WGM * nN, gid = wgid / nig, fm = gid * WGM, gsz = (nM - fm) < WGM ? (nM - fm) : WGM;
        u.pm = fm + ((wgid % nig) % gsz); u.pn = (wgid % nig) / gsz; return true;
    }
};
__device__ __forceinline__ unsigned cvt_pk_bf16(float lo, float hi) { unsigned r; asm volatile("v_cvt_pk_bf16_f32 %0, %1, %2" : "=v"(r) : "v"(lo), "v"(hi)); return r; }

struct EpiBf16 {
    static constexpr bool PERM = true;
    bf16* O; int ldc;
    __device__ __forceinline__ void operator()(const f32x4 (&acc)[2][2][4][2], const Unit& u, int wr, int wc, int fr, int fq) const {
        const int row0 = u.pm * BM + wr * 64 + fr, col0 = u.pn * BM + wc * 32 + 8 * fq;
#pragma unroll
        for (int ai = 0; ai < 2; ++ai)
#pragma unroll
            for (int m = 0; m < 4; ++m) { bf16* rowp = O + (size_t)(row0 + ai * HALF + m * 16) * ldc + col0;
#pragma unroll
                for (int bj = 0; bj < 2; ++bj) { const f32x4 v0 = acc[ai][bj][m][0], v1 = acc[ai][bj][m][1];
                    u32x4 w; w.x = cvt_pk_bf16(v0[0], v0[1]); w.y = cvt_pk_bf16(v0[2], v0[3]); w.z = cvt_pk_bf16(v1[0], v1[1]); w.w = cvt_pk_bf16(v1[2], v1[3]);
                    *(u32x4*)(rowp + bj * HALF) = w; } }
    }
};
struct EpiResid {
    static constexpr bool PERM = false;
    const float* base; float* out; int ldc;
    __device__ __forceinline__ void operator()(const f32x4 (&acc)[2][2][4][2], const Unit& u, int wr, int wc, int fr, int fq) const {
        const int row0 = u.pm * BM + wr * 64 + fr, col0 = u.pn * BM + wc * 32 + 4 * fq;
#pragma unroll
        for (int ai = 0; ai < 2; ++ai)
#pragma unroll
            for (int m = 0; m < 4; ++m) { const size_t off = (size_t)(row0 + ai * HALF + m * 16) * ldc + col0;
#pragma unroll
                for (int bj = 0; bj < 2; ++bj)
#pragma unroll
                    for (int n = 0; n < 2; ++n) { const f32x4 b = *(const f32x4*)(base + off + bj * HALF + n * 16); *(f32x4*)(out + off + bj * HALF + n * 16) = b + acc[ai][bj][m][n]; } }
    }
};
struct EpiLift {
    static constexpr bool PERM = true;
    const bf16* gate; int ldg; float* mg; bf16* mb; int ldc;
    __device__ __forceinline__ void operator()(const f32x4 (&acc)[2][2][4][2], const Unit& u, int wr, int wc, int fr, int fq) const {
        const int row0 = u.pm * BM + wr * 64 + fr, col0 = u.pn * BM + wc * 32 + 8 * fq;
#pragma unroll
        for (int ai = 0; ai < 2; ++ai)
#pragma unroll
            for (int m = 0; m < 4; ++m) { const int row = row0 + ai * HALF + m * 16;
#pragma unroll
                for (int bj = 0; bj < 2; ++bj) { const int col = col0 + bj * HALF;
                    const u32x4 gw = *(const u32x4*)(gate + (size_t)row * ldg + u.z * 1024 + col);
                    f32x4 v0 = acc[ai][bj][m][0], v1 = acc[ai][bj][m][1];
                    v0[0] *= sigmoidf_(bf2f(gw.x & 0xffffu)); v0[1] *= sigmoidf_(bf2f(gw.x >> 16)); v0[2] *= sigmoidf_(bf2f(gw.y & 0xffffu)); v0[3] *= sigmoidf_(bf2f(gw.y >> 16));
                    v1[0] *= sigmoidf_(bf2f(gw.z & 0xffffu)); v1[1] *= sigmoidf_(bf2f(gw.z >> 16)); v1[2] *= sigmoidf_(bf2f(gw.w & 0xffffu)); v1[3] *= sigmoidf_(bf2f(gw.w >> 16));
                    float* mp = mg + (size_t)row * ldc + col;
                    if (u.z > 0) { v0 += *(const f32x4*)mp; v1 += *(const f32x4*)(mp + 4); }
                    if (u.z < 3) { *(f32x4*)mp = v0; *(f32x4*)(mp + 4) = v1; }
                    else { u32x4 w; w.x = cvt_pk_bf16(v0[0], v0[1]); w.y = cvt_pk_bf16(v0[2], v0[3]); w.z = cvt_pk_bf16(v1[0], v1[1]); w.w = cvt_pk_bf16(v1[2], v1[3]);
                        *(u32x4*)(mb + (size_t)row * ldc + col) = w; } } }
    }
};

template <class Epi>
__device__ __forceinline__ void gemm_phase(LAS unsigned char* lds, const Gemm g, const Order& S, const Epi& E) {
    int tid = threadIdx.x; asm volatile("" : "+v"(tid));
    const int wid = __builtin_amdgcn_readfirstlane(tid >> 6), lane = tid & 63, wr = wid >> 2, wc = wid & 3, fr = lane & 15, fq = lane >> 4;
    const int K = g.K, nt = K / BK;
    unsigned voffA[2], voffB[2];
#pragma unroll
    for (int i = 0; i < 2; ++i) { int R, C; stage_rc(tid * 16 + i * 8192, R, C); const int Rb = Epi::PERM ? ((R & ~31) + perm32(R & 31)) : R;
        voffA[i] = (unsigned)(R * g.lda + C) * 2u; voffB[i] = (unsigned)(Rb * g.ldb + C) * 2u; }
    const size_t kstep = (size_t)(BK * 2);
    const size_t hstepA = (size_t)HALF * g.lda * 2, hstepB = (size_t)HALF * g.ldb * 2;
    const size_t tstepA = 2 * hstepA, tstepB = 2 * hstepB;
    const unsigned ldsw = (unsigned)wid * 1024u;
    const int aoff = lds_byte(wr * 64 + fr, fq * 8), boff = lds_byte(wc * 32 + fr, fq * 8);
#define PG8_SA(b, h) (((b) * 2 + (h)) * HTB)
#define PG8_SB(b, h) ((4 + (b) * 2 + (h)) * HTB)
#define PG8_STAGE(bufoff, gbase, voff) do { _Pragma("unroll") for (int _i = 0; _i < 2; ++_i) \
        __builtin_amdgcn_global_load_lds((const unsigned*)((const char*)(gbase) + (voff)[_i]), (LAS unsigned*)(lds + (bufoff) + ldsw + _i * 8192), 16, 0, 0); } while (0)
#define PG8_LDA(dst, b, h) do { _Pragma("unroll") for (int m = 0; m < 4; ++m) _Pragma("unroll") for (int k = 0; k < 2; ++k) dst[m][k] = *(const LAS bf16x8*)(lds + PG8_SA(b, h) + aoff + m * 2048 + k * 1024); } while (0)
#define PG8_LDB(dst, b, h) do { _Pragma("unroll") for (int n = 0; n < 2; ++n) _Pragma("unroll") for (int k = 0; k < 2; ++k) dst[n][k] = *(const LAS bf16x8*)(lds + PG8_SB(b, h) + boff + n * 2048 + k * 1024); } while (0)
#define PG8_MMA(ai, bj, At, Bt) do { __builtin_amdgcn_s_setprio(1); _Pragma("unroll") for (int m = 0; m < 4; ++m) _Pragma("unroll") for (int n = 0; n < 2; ++n) _Pragma("unroll") for (int k = 0; k < 2; ++k) \
        acc[ai][bj][m][n] = __builtin_amdgcn_mfma_f32_16x16x32_bf16(Bt[n][k], At[m][k], acc[ai][bj][m][n], 0, 0, 0); __builtin_amdgcn_s_setprio(0); } while (0)
#define PG8_WAIT_V(n) asm volatile("s_waitcnt vmcnt(" #n ")" ::: "memory")
#define PG8_WAIT_L(n) asm volatile("s_waitcnt lgkmcnt(" #n ")" ::: "memory")
#define PG8_BAR __builtin_amdgcn_s_barrier()
#define PG8_SCHED __builtin_amdgcn_sched_barrier(0)
    Unit cur, nxt; int ui = 0;
    if (!S.next(0, cur)) return;
    f32x4 acc[2][2][4][2];
#pragma unroll
    for (int a = 0; a < 2; ++a)
#pragma unroll
        for (int b = 0; b < 2; ++b)
#pragma unroll
            for (int m = 0; m < 4; ++m)
#pragma unroll
                for (int n = 0; n < 2; ++n) acc[a][b][m][n] = (f32x4){0.f, 0.f, 0.f, 0.f};
    bf16x8 At[4][2], B0[2][2], B1[2][2];
    const char* cA = (const char*)g.A + (size_t)cur.pm * tstepA + (size_t)cur.z * g.zA; const char* cB = (const char*)g.Bt + (size_t)cur.pn * tstepB + (size_t)cur.z * g.zB;
    PG8_STAGE(PG8_SB(0, 0), cB, voffB); PG8_STAGE(PG8_SB(0, 1), cB + hstepB, voffB); PG8_STAGE(PG8_SA(0, 0), cA, voffA); PG8_STAGE(PG8_SA(0, 1), cA + hstepA, voffA);
    if (wr == 1) PG8_BAR;
    PG8_WAIT_V(2); PG8_BAR;
    PG8_STAGE(PG8_SB(1, 0), cB + kstep, voffB); PG8_STAGE(PG8_SA(1, 0), cA + kstep, voffA); PG8_STAGE(PG8_SB(1, 1), cB + hstepB + kstep, voffB);
    PG8_WAIT_V(6); PG8_BAR;
    for (;;) {
        const bool has_next = S.next(ui + 1, nxt);
        const char* nA = has_next ? (const char*)g.A + (size_t)nxt.pm * tstepA + (size_t)nxt.z * g.zA : cA; const char* nB = has_next ? (const char*)g.Bt + (size_t)nxt.pn * tstepB + (size_t)nxt.z * g.zB : cB;
        for (int t = 0; t < nt; t += 2) {
            const bool last = (t == nt - 2);
            const char* a1 = cA + (size_t)(t + 1) * kstep;
            const char* a2 = last ? nA : cA + (size_t)(t + 2) * kstep; const char* b2 = last ? nB : cB + (size_t)(t + 2) * kstep;
            const char* a3 = a2 + kstep; const char* b3 = b2 + kstep;
            PG8_LDB(B0, 0, 0); PG8_LDB(B1, 0, 1); PG8_SCHED; PG8_LDA(At, 0, 0); PG8_STAGE(PG8_SA(1, 1), a1 + hstepA, voffA);
            PG8_WAIT_V(8); PG8_WAIT_L(0); PG8_BAR; PG8_MMA(0, 0, At, B0); PG8_MMA(0, 1, At, B1); PG8_BAR; PG8_SCHED;
            PG8_LDA(At, 0, 1); PG8_STAGE(PG8_SB(0, 0), b2, voffB); PG8_STAGE(PG8_SB(0, 1), b2 + hstepB, voffB); PG8_STAGE(PG8_SA(0, 0), a2, voffA);
            PG8_WAIT_V(8); PG8_WAIT_L(0); PG8_BAR; PG8_MMA(1, 0, At, B0); PG8_MMA(1, 1, At, B1); PG8_BAR; PG8_SCHED;
            PG8_LDB(B0, 1, 0); PG8_LDB(B1, 1, 1); PG8_SCHED; PG8_LDA(At, 1, 0); PG8_STAGE(PG8_SA(0, 1), a2 + hstepA, voffA);
            PG8_WAIT_V(8); PG8_WAIT_L(0); PG8_BAR; PG8_MMA(0, 0, At, B0); PG8_MMA(0, 1, At, B1); PG8_BAR; PG8_SCHED;
            PG8_LDA(At, 1, 1); PG8_STAGE(PG8_SB(1, 0), b3, voffB); PG8_STAGE(PG8_SB(1, 1), b3 + hstepB, voffB); PG8_STAGE(PG8_SA(1, 0), a3, voffA);
            PG8_WAIT_V(8); PG8_WAIT_L(0); PG8_BAR; PG8_MMA(1, 0, At, B0); PG8_MMA(1, 1, At, B1); PG8_BAR; PG8_SCHED;
        }
        if (wr == 0) PG8_BAR;
        E(acc, cur, wr, wc, fr, fq);
        if (!has_next) break;
#pragma unroll
        for (int a = 0; a < 2; ++a)
#pragma unroll
            for (int b = 0; b < 2; ++b)
#pragma unroll
                for (int m = 0; m < 4; ++m)
#pragma unroll
                    for (int n = 0; n < 2; ++n) acc[a][b][m][n] = (f32x4){0.f, 0.f, 0.f, 0.f};
        cur = nxt; cA = nA; cB = nB; ++ui;
        if (wr == 1) PG8_BAR;
    }
    PG8_WAIT_V(0);
    PG8_BAR;
#undef PG8_SA
#undef PG8_SB
#undef PG8_STAGE
#undef PG8_LDA
#undef PG8_LDB
#undef PG8_MMA
#undef PG8_WAIT_V
#undef PG8_WAIT_L
#undef PG8_BAR
#undef PG8_SCHED
}
}

#define XB_TMO      128
#define XB_XCNT(j)  (256  + 64 * (j))
#define XB_XSUB(j)  (1280 + 64 * (j))
#define XB_XGEN(j)  (2304 + 64 * (j))
#define XB_TOP      3328
#define XB_TOPGEN   3392
#define XCD_BAR_WORDS 3456
#define XB_SPIN_CAP (1u << 18)
__device__ __forceinline__ unsigned xb_ld(unsigned* p)              { return __hip_atomic_load(p, __ATOMIC_RELAXED, __HIP_MEMORY_SCOPE_AGENT); }
__device__ __forceinline__ unsigned xb_add(unsigned* p, unsigned v) { return __hip_atomic_fetch_add(p, v, __ATOMIC_RELAXED, __HIP_MEMORY_SCOPE_AGENT); }
__device__ __forceinline__ unsigned xb_xcc_id() { return (unsigned)__builtin_amdgcn_s_getreg((3 << 11) | 20) & 0xFu; }
#define XB_SPIN(cond, bar) do { unsigned _sp = 0; while (cond) { __builtin_amdgcn_s_sleep(1); \
    if ((++_sp & 255u) == 0u) { if (xb_ld(&(bar)[XB_TMO])) break; if (_sp > XB_SPIN_CAP) { atomicAdd(&(bar)[XB_TMO], 1u); break; } } } } while (0)
struct XcdBarrier { unsigned* bar; unsigned x; volatile LAS unsigned* st; };
__device__ __forceinline__ XcdBarrier xcd_barrier_post(unsigned* bar, volatile LAS unsigned* st) {
    XcdBarrier b; b.bar = bar; b.x = xb_xcc_id(); b.st = st;
    if (threadIdx.x == 0) (void)xb_add(&bar[XB_XCNT(b.x)], 1u);
    return b;
}
__device__ __forceinline__ void xcd_barrier_complete(unsigned* bar, unsigned x, unsigned& nloc, unsigned& nx) {
    const unsigned G = gridDim.x * gridDim.y * gridDim.z;
    unsigned sum, cnt, mine, sp = 0u;
    for (;;) {
        sum = 0u; cnt = 0u; mine = 0u;
#pragma unroll
        for (unsigned j = 0; j < 16; ++j) { const unsigned c = xb_ld(&bar[XB_XCNT(j)]); sum += c; cnt += (c > 0u) ? 1u : 0u; mine = (j == x) ? c : mine; }
        if (sum == G) break;
        __builtin_amdgcn_s_sleep(1);
        if ((++sp & 255u) == 0u) { if (xb_ld(&bar[XB_TMO])) break; if (sp > XB_SPIN_CAP) { atomicAdd(&bar[XB_TMO], 1u); break; } }
    }
    nloc = mine > 0u ? mine : 1u; nx = cnt > 0u ? cnt : 1u;
}
__device__ __forceinline__ void xcd_barrier(const XcdBarrier& b) {
    asm volatile("s_waitcnt vmcnt(0)" ::: "memory");
    __syncthreads();
    if (threadIdx.x == 0) {
        unsigned* bar = b.bar;
        __builtin_amdgcn_s_waitcnt(0);
        unsigned nloc = b.st[0], nx = b.st[1];
        if (nloc == 0u) { xcd_barrier_complete(bar, b.x, nloc, nx); b.st[0] = nloc; b.st[1] = nx; }
        const unsigned old = xb_add(&bar[XB_XSUB(b.x)], 1u);
        const unsigned gen = old / nloc;
        if (old + 1u == (gen + 1u) * nloc) {
            __builtin_amdgcn_fence(__ATOMIC_RELEASE, "agent");
            asm volatile("s_waitcnt vmcnt(0)" ::: "memory");
            const unsigned og = xb_add(&bar[XB_TOP], 1u);
            const unsigned tg = og / nx;
            if (og + 1u == (tg + 1u) * nx) xb_add(&bar[XB_TOPGEN], 1u);
            else XB_SPIN(xb_ld(&bar[XB_TOPGEN]) == tg, bar);
            __builtin_amdgcn_fence(__ATOMIC_ACQUIRE, "agent");
            xb_add(&bar[XB_XGEN(b.x)], 1u);
            asm volatile("s_waitcnt vmcnt(0)" ::: "memory");
        } else {
            XB_SPIN(xb_ld(&bar[XB_XGEN(b.x)]) == gen, bar);
            __builtin_amdgcn_fence(__ATOMIC_ACQUIRE, "agent");
            asm volatile("s_waitcnt vmcnt(0)" ::: "memory");
        }
    }
    __syncthreads();
}

__device__ __forceinline__ bf16x8 frag_kc(const LAS bf16* X, int ld, int mn0, int k0, int lane) { return *(const LAS bf16x8*)(X + (mn0 + (lane & 15)) * ld + k0 + 8 * (lane >> 4)); }
__device__ __forceinline__ bf16x8 gfrag_kc(const bf16* X, int ld, int mn0, int k0, int lane) { return *(const bf16x8*)(X + (size_t)(mn0 + (lane & 15)) * ld + k0 + 8 * (lane >> 4)); }
__device__ __forceinline__ s16x4 trr(const LAS bf16* p) { return __builtin_bit_cast(s16x4, __builtin_amdgcn_ds_read_tr16_b64_v4i16((LAS s16x4*)p)); }
__device__ __forceinline__ bf16x8 frag_ks(const LAS bf16* X, int ld, int mn0, int k0, int lane) {
    const int r = lane & 15, g = lane >> 4;
    const LAS bf16* p = X + (k0 + 8 * g + (r >> 2)) * ld + mn0 + 4 * (r & 3);
    const s16x4 lo = trr(p), hi = trr(p + 4 * ld);
    return (bf16x8){lo[0], lo[1], lo[2], lo[3], hi[0], hi[1], hi[2], hi[3]};
}
#define MFMA16(a, b, c) __builtin_amdgcn_mfma_f32_16x16x32_bf16((a), (b), (c), 0, 0, 0)
__device__ __forceinline__ u32x4 scale8(u32x4 w, float s) {
    u32x4 o;
    o.x = pk2(bf2f(w.x & 0xffffu) * s, bf2f(w.x >> 16) * s); o.y = pk2(bf2f(w.y & 0xffffu) * s, bf2f(w.y >> 16) * s);
    o.z = pk2(bf2f(w.z & 0xffffu) * s, bf2f(w.z >> 16) * s); o.w = pk2(bf2f(w.w & 0xffffu) * s, bf2f(w.w >> 16) * s);
    return o;
}
__device__ __forceinline__ float wscan_add(float v, int lane) {
#pragma unroll
    for (int o = 1; o < 64; o <<= 1) { const float t = __shfl_up(v, o); if (lane >= o) v += t; }
    return v;
}
__device__ __forceinline__ float wscan_max(float v, int lane) {
#pragma unroll
    for (int o = 1; o < 64; o <<= 1) { const float t = __shfl_up(v, o); if (lane >= o) v = fmaxf(v, t); }
    return v;
}

enum { PH_W = 0, PH_N1, PH_INPROJ, PH_M0, PH_M1, PH_M2, PH_M3, PH_ATT, PH_LIFT, PH_OUT, PH_N2, PH_UP, PH_CONVACT, PH_DOWN, PH_FINAL, PH_COUNT };
enum { I_X = 0, I_MIXG, I_WIN, I_AIB, I_AFB, I_ANG, I_BCW, I_CCW, I_CCB, I_CDTB, I_CALOG, I_CDSKIP, I_CNG, I_WLIFT, I_WOUT, I_FFNG, I_WUP, I_FCW, I_FCB, I_WDOWN, I_FING, N_IN };
struct Args { const float* in[N_IN]; float* out; unsigned char* ws; int l_lo, l_hi, g_lo, g_hi, ph_lo, ph_hi, use_bar, pad; };

__device__ __forceinline__ void transpose_item(const float* W, int ldw, int nsrc0, int k0, bf16* WT, int ldt, int ndst0, LAS float* scr, int lane) {
#pragma unroll 8
    for (int i = 0; i < 32; ++i) { const int kk = 2 * i + (lane >> 5); scr[kk * 33 + (lane & 31)] = W[(size_t)(k0 + kk) * ldw + nsrc0 + (lane & 31)]; }
    LDS_WAIT(); asm volatile("" ::: "memory");
    const int c = lane & 7;
#pragma unroll
    for (int j = 0; j < 4; ++j) { const int n = (lane >> 3) + 8 * j; const LAS float* s = scr + (8 * c) * 33 + n;
        u32x4 o; o.x = pk2(s[0 * 33], s[1 * 33]); o.y = pk2(s[2 * 33], s[3 * 33]); o.z = pk2(s[4 * 33], s[5 * 33]); o.w = pk2(s[6 * 33], s[7 * 33]);
        *(u32x4*)(WT + (size_t)(ndst0 + n) * ldt + k0 + 8 * c) = o; }
    LDS_WAIT(); asm volatile("" ::: "memory");
}

__global__ void __launch_bounds__(NTHR, 2) fwd(Args args) {
    extern __shared__ __attribute__((aligned(16))) unsigned char lds_raw[];
    LAS unsigned char* lds = (LAS unsigned char*)lds_raw;
    const int NBLK = gridDim.x, blk = blockIdx.x;
    {
        volatile LAS unsigned* MISC0 = (volatile LAS unsigned*)(lds + MISC_OFF);
        if (threadIdx.x < 16) MISC0[threadIdx.x] = 0u;
        __syncthreads();
    }
    XcdBarrier bar; bar.bar = (unsigned*)(args.ws + WS_CTL) + 4096; bar.x = 0; bar.st = nullptr;
    if (args.use_bar) bar = xcd_barrier_post((unsigned*)(args.ws + WS_CTL) + 4096, (volatile LAS unsigned*)(lds + MISC_OFF) + 8);
#define GRID_BAR() do { if (args.use_bar) xcd_barrier(bar); } while (0)
#define IN(k) (args.ph_lo <= (k) && (k) < args.ph_hi)
#define PHASE_BEGIN() int tid = threadIdx.x; asm volatile("" : "+v"(tid)); const int lane = tid & 63, wave = __builtin_amdgcn_readfirstlane(tid >> 6); \
    unsigned char* ws = args.ws; asm volatile("" : "+s"(ws)); \
    const int gw = blk * NWAVES + wave, NGW = NBLK * NWAVES, gt = blk * NTHR + tid, NGT = NBLK * NTHR; (void)lane; (void)gw; (void)NGW; (void)gt; (void)NGT; \
    bf16* const WinT = (bf16*)(ws + WS_WIN); bf16* const WliftT = (bf16*)(ws + WS_WLIFT); bf16* const WoutT = (bf16*)(ws + WS_WOUT); \
    bf16* const WupT = (bf16*)(ws + WS_WUP); bf16* const WdownT = (bf16*)(ws + WS_WDOWN); float* const W16T = (float*)(ws + WS_W16); \
    bf16* const XN = (bf16*)(ws + WS_XN); bf16* const P = (bf16*)(ws + WS_P); bf16* const U = (bf16*)(ws + WS_U); bf16* const ACT = (bf16*)(ws + WS_ACT); \
    bf16* const YCAT = (bf16*)(ws + WS_YCAT); float* const MG = (float*)(ws + WS_MG); bf16* const MB = (bf16*)(ws + WS_MB); float* const SP = (float*)(ws + WS_SP); \
    float* const GBc = (float*)(ws + WS_GB); float* const GGc = (float*)(ws + WS_GG); float* const GMT = (float*)(ws + WS_GMT); \
    float* const MCAR = (float*)(ws + WS_MCAR); float* const MNEW = (float*)(ws + WS_MNEW); float* const MSC = (float*)(ws + WS_MSC); \
    float* const DTB = (float*)(ws + WS_DT); float* const ACB = (float*)(ws + WS_AC); bf16* const XBC = (bf16*)(ws + WS_XBC); \
    float* const DC = (float*)(ws + WS_DC); bf16* const CS = (bf16*)(ws + WS_CS); float* const DH = (float*)(ws + WS_DH); bf16* const HS = (bf16*)(ws + WS_HS); \
    (void)WinT; (void)WliftT; (void)WoutT; (void)WupT; (void)WdownT; (void)W16T; (void)XN; (void)P; (void)U; (void)ACT; (void)YCAT; (void)MG; (void)MB; (void)SP; (void)GBc; (void)GGc; (void)GMT; \
    (void)MCAR; (void)MNEW; (void)MSC; (void)DTB; (void)ACB; (void)XBC; (void)DC; (void)CS; (void)DH; (void)HS

    for (int l = args.l_lo; l < args.l_hi; ++l)
    for (int grp = args.g_lo; grp < args.g_hi; ++grp) {
        const size_t grow0 = (size_t)grp * T;
        const float* xsrc = (l == 0) ? args.in[I_X] : args.out;

        if (IN(PH_W) && grp == 0) {
            PHASE_BEGIN();
            LAS float* scr = (LAS float*)(lds + wave * 16384);
            constexpr int I_IN = 16 * 320, I_LF = 4 * 8 * 32, I_OUT = 16 * 32, I_UP = 16 * 176, I_DN = 44 * 32, NIT = I_IN + I_LF + I_OUT + I_UP + I_DN;
            for (int it = gw; it < NIT; it += NGW) {
                int r = it;
                if (r < I_IN) { const int kb = r / 320, nb = r % 320, n0 = 32 * nb, ns = n0 + (n0 >= P_SQ ? 16 : (n0 >= P_BB ? 8 : 0));
                    transpose_item(args.in[I_WIN] + (size_t)l * DM * PIN, PIN, ns, 64 * kb, WinT, DM, n0, scr, lane); continue; } r -= I_IN;
                if (r < I_LF) { const int br = r / 256, q = r % 256, kb = q / 32, nb = q % 32;
                    transpose_item(args.in[I_WLIFT] + (size_t)(l * 4 + br) * 512 * DM, DM, 32 * nb, 64 * kb, WliftT + (size_t)br * DM * 512, 512, 32 * nb, scr, lane); continue; } r -= I_LF;
                if (r < I_OUT) { const int kb = r / 32, nb = r % 32;
                    transpose_item(args.in[I_WOUT] + (size_t)l * DM * DM, DM, 32 * nb, 64 * kb, WoutT, DM, 32 * nb, scr, lane); continue; } r -= I_OUT;
                if (r < I_UP) { const int kb = r / 176, nb = r % 176;
                    transpose_item(args.in[I_WUP] + (size_t)l * DM * DFF2, DFF2, 32 * nb, 64 * kb, WupT, DM, 32 * nb, scr, lane); continue; } r -= I_UP;
                { const int kb = r / 32, nb = r % 32;
                    transpose_item(args.in[I_WDOWN] + (size_t)l * DFF * DM, DM, 32 * nb, 64 * kb, WdownT, DFF, 32 * nb, scr, lane); }
            }
            for (int i = gt; i < 16 * DM; i += NGT) { const int c = i >> 10, k = i & 1023; const int oc = (c < 8) ? (1536 + c) : (4616 + (c - 8));
                W16T[i] = args.in[I_WIN][(size_t)l * DM * PIN + (size_t)k * PIN + oc]; }
            GRID_BAR();
        }

        if (IN(PH_N1)) {
            PHASE_BEGIN();
            LAS float* W16s = (LAS float*)lds;
            for (int i = tid; i < 16 * DM / 4; i += NTHR) ((LAS f32x4*)W16s)[i] = ((const f32x4*)W16T)[i];
            __syncthreads();
            const float* gain = args.in[I_MIXG] + (size_t)l * DM;
            f32x4 gv[4];
#pragma unroll
            for (int j = 0; j < 4; ++j) gv[j] = ((const f32x4*)gain)[lane + 64 * j];
            for (int m = gw; m < T; m += NGW) {
                const f32x4* xr = (const f32x4*)(xsrc + (grow0 + m) * DM) + lane;
                f32x4 v[4]; float s = 0.f;
#pragma unroll
                for (int j = 0; j < 4; ++j) { v[j] = xr[64 * j]; s += (v[j].x * v[j].x + v[j].y * v[j].y) + (v[j].z * v[j].z + v[j].w * v[j].w); }
                const float rstd = rsqrtf(wave_sum(s) * (1.f / DM) + EPS);
#pragma unroll
                for (int j = 0; j < 4; ++j) v[j] = v[j] * rstd * gv[j];
                u32x2* o8 = (u32x2*)(XN + (size_t)m * DM) + lane;
#pragma unroll
                for (int j = 0; j < 4; ++j) o8[64 * j] = (u32x2){pk2(v[j].x, v[j].y), pk2(v[j].z, v[j].w)};
                float mine = 0.f;
#pragma unroll 1
                for (int c = 0; c < 16; ++c) { float p = 0.f;
#pragma unroll
                    for (int j = 0; j < 4; ++j) { const f32x4 w = ((const LAS f32x4*)(W16s + c * DM))[lane + 64 * j]; p += (v[j].x * w.x + v[j].y * w.y) + (v[j].z * w.z + v[j].w * w.w); }
                    p = wave_sum(p); if (lane == c) mine = p; }
                if (lane < 16) SP[(size_t)m * 16 + lane] = mine;
            }
            GRID_BAR();
        }

        if (IN(PH_INPROJ)) {
            PHASE_BEGIN();
            pg8::Gemm g{XN, WinT, DM, DM, DM, 0, 0}; pg8::Order S; S.init(T, PW, NBLK, blk, 1);
            pg8::EpiBf16 E{P, PW};
            pg8::gemm_phase<pg8::EpiBf16>(lds, g, S, E);
            GRID_BAR();
        }

        if (IN(PH_M0)) {
            PHASE_BEGIN();
            for (int task = gw; task < GB * 4; task += NGW) {
                const int bl = task >> 2, h = task & 3; float mcar = 0.f;
                const float igb = args.in[I_AIB][l * 4 + h], fgb = args.in[I_AFB][l * 4 + h];
                for (int c = 0; c < NCH; ++c) {
                    const size_t m = (size_t)bl * SEQ + c * 64 + lane;
                    const float ig = SP[m * 16 + h] + igb, fg = SP[m * 16 + 4 + h] + fgb;
                    const float b = wscan_add(logsigf_(fg), lane);
                    const float gg = ig - b;
                    const float pm = wscan_max(gg, lane);
                    GBc[m * 4 + h] = b; GGc[m * 4 + h] = gg; GMT[m * 4 + h] = b + fmaxf(mcar, pm);
                    const float bL = __shfl(b, 63), gmax = __shfl(pm, 63);
                    const float mnew = bL + fmaxf(mcar, gmax);
                    if (lane == 0) { MCAR[task * NCH + c] = mcar; MNEW[task * NCH + c] = mnew; MSC[task * NCH + c] = __expf(bL + mcar - mnew); }
                    mcar = mnew;
                }
            }
            for (int task = gw; task < GB * NCH; task += NGW) {
                const size_t m = (size_t)task * 64 + lane;
#pragma unroll
                for (int hd = 0; hd < 8; ++hd) {
                    const float dt = softplusf_(SP[m * 16 + 8 + hd] + args.in[I_CDTB][l * 8 + hd]);
                    const float a = wscan_add(-dt * __expf(args.in[I_CALOG][l * 8 + hd]), lane);
                    DTB[m * 8 + hd] = dt; ACB[m * 8 + hd] = a;
                }
            }
            {
                const float* cw = args.in[I_CCW] + (size_t)l * 4 * 1024; const float* cb = args.in[I_CCB] + (size_t)l * 1024;
                for (int i = gt; i < T * 128; i += NGT) {
                    const int m = i >> 7, c8 = (i & 127) * 8, t = m & (SEQ - 1);
                    float acc[8];
#pragma unroll
                    for (int e = 0; e < 8; ++e) acc[e] = cb[c8 + e];
#pragma unroll
                    for (int j = 0; j < 4; ++j) { if (t - 3 + j >= 0) { const u32x4 w = *(const u32x4*)(P + (size_t)(m - 3 + j) * PW + P_CX + c8); const float* cwj = cw + j * 1024 + c8;
                        acc[0] += cwj[0] * bf2f(w.x & 0xffffu); acc[1] += cwj[1] * bf2f(w.x >> 16); acc[2] += cwj[2] * bf2f(w.y & 0xffffu); acc[3] += cwj[3] * bf2f(w.y >> 16);
                        acc[4] += cwj[4] * bf2f(w.z & 0xffffu); acc[5] += cwj[5] * bf2f(w.z >> 16); acc[6] += cwj[6] * bf2f(w.w & 0xffffu); acc[7] += cwj[7] * bf2f(w.w >> 16); } }
                    u32x4 o; o.x = pk2(siluf_(acc[0]), siluf_(acc[1])); o.y = pk2(siluf_(acc[2]), siluf_(acc[3])); o.z = pk2(siluf_(acc[4]), siluf_(acc[5])); o.w = pk2(siluf_(acc[6]), siluf_(acc[7]));
                    *(u32x4*)(XBC + (size_t)m * 1024 + c8) = o;
                }
            }
            {
                const float* bw = args.in[I_BCW] + (size_t)l * 3 * 512;
                for (int i = gt; i < T * 64; i += NGT) {
                    const int m = i >> 6, c8 = (i & 63) * 8, t = m & (SEQ - 1);
                    float acc[8];
#pragma unroll
                    for (int e = 0; e < 8; ++e) acc[e] = 0.f;
#pragma unroll
                    for (int j = 0; j < 3; ++j) { if (t - 2 + j >= 0) { const bf16* pr = P + (size_t)(m - 2 + j) * PW; const u32x4 a = *(const u32x4*)(pr + P_BC + c8), b = *(const u32x4*)(pr + P_BX + c8); const float* wj = bw + j * 512 + c8;
                        acc[0] += wj[0] * bf2f(a.x & 0xffffu) * bf2f(b.x & 0xffffu); acc[1] += wj[1] * bf2f(a.x >> 16) * bf2f(b.x >> 16);
                        acc[2] += wj[2] * bf2f(a.y & 0xffffu) * bf2f(b.y & 0xffffu); acc[3] += wj[3] * bf2f(a.y >> 16) * bf2f(b.y >> 16);
                        acc[4] += wj[4] * bf2f(a.z & 0xffffu) * bf2f(b.z & 0xffffu); acc[5] += wj[5] * bf2f(a.z >> 16) * bf2f(b.z >> 16);
                        acc[6] += wj[6] * bf2f(a.w & 0xffffu) * bf2f(b.w & 0xffffu); acc[7] += wj[7] * bf2f(a.w >> 16) * bf2f(b.w >> 16); } }
                    const u32x4 g = *(const u32x4*)(P + (size_t)m * PW + P_BB + c8);
                    u32x4 o; o.x = pk2(acc[0] * bf2f(g.x & 0xffffu), acc[1] * bf2f(g.x >> 16)); o.y = pk2(acc[2] * bf2f(g.y & 0xffffu), acc[3] * bf2f(g.y >> 16));
                    o.z = pk2(acc[4] * bf2f(g.z & 0xffffu), acc[5] * bf2f(g.z >> 16)); o.w = pk2(acc[6] * bf2f(g.w & 0xffffu), acc[7] * bf2f(g.w >> 16));
                    *(u32x4*)(YCAT + (size_t)m * YW + 512 + c8) = o;
                }
            }
            GRID_BAR();
        }

        if (IN(PH_M1)) {
            PHASE_BEGIN();
            constexpr int NUA = GB * 4 * NCH, NUC = GB * NCH;
            for (int u = blk; u < NUA + NUC; u += NBLK) {
                if (u < NUA) {
                    const int ua = u, bh = ua >> 5, c = ua & 31, bl = bh >> 2, h = bh & 3; const size_t m0 = (size_t)bl * SEQ + c * 64;
                    LAS bf16* VP = (LAS bf16*)lds; LAS bf16* WK = (LAS bf16*)(lds + 64 * 152 * 2);
                    const float bL = GBc[(m0 + 63) * 4 + h], mnew = MNEW[ua];
                    for (int i = tid; i < 1024; i += NTHR) { const int s = i >> 4, c8 = i & 15; *(LAS u32x4*)(VP + s * 152 + c8 * 8) = *(const u32x4*)(P + (m0 + s) * PW + P_AV + h * 128 + c8 * 8); }
                    if (tid < 64) { *(LAS u32x4*)(VP + tid * 152 + 128) = (u32x4){0x3F80u, 0u, 0u, 0u}; *(LAS u32x4*)(VP + tid * 152 + 136) = (u32x4){0u, 0u, 0u, 0u}; }
                    { const int s = tid >> 3, c8 = tid & 7; const float w = __expf(bL + GGc[(m0 + s) * 4 + h] - mnew);
                      *(LAS u32x4*)(WK + s * 72 + c8 * 8) = scale8(*(const u32x4*)(P + (m0 + s) * PW + P_AK + h * 64 + c8 * 8), w); }
                    __syncthreads();
                    for (int ti = wave; ti < 36; ti += NWAVES) { const int mt = ti >> 2, nt = ti & 3; f32x4 acc = {0.f, 0.f, 0.f, 0.f};
#pragma unroll
                        for (int ks = 0; ks < 2; ++ks) acc = MFMA16(frag_ks(VP, 152, 16 * mt, 32 * ks, lane), frag_ks(WK, 72, 16 * nt, 32 * ks, lane), acc);
                        float* d = DC + (size_t)ua * 9216 + (16 * mt + 4 * (lane >> 4)) * 64 + 16 * nt + (lane & 15);
#pragma unroll
                        for (int i = 0; i < 4; ++i) d[i * 64] = acc[i]; }
                    __syncthreads();
                } else {
                    const int uc = u - NUA, bl = uc >> 5, c = uc & 31, hd = wave, gi = hd >> 2; const size_t m0 = (size_t)bl * SEQ + c * 64;
                    LAS bf16* XW = (LAS bf16*)(lds + hd * (64 * 72 * 2)); LAS bf16* BMs = (LAS bf16*)(lds + 8 * 64 * 72 * 2);
                    const float alast = ACB[(m0 + 63) * 8 + hd];
#pragma unroll
                    for (int k = 0; k < 8; ++k) { const int i = lane + 64 * k, s = i >> 3, c8 = i & 7; const float wd = __expf(alast - ACB[(m0 + s) * 8 + hd]) * DTB[(m0 + s) * 8 + hd];
                        *(LAS u32x4*)(XW + s * 72 + c8 * 8) = scale8(*(const u32x4*)(XBC + (m0 + s) * 1024 + hd * 64 + c8 * 8), wd); }
                    for (int i = tid; i < 2048; i += NTHR) { const int g2 = i >> 10, rem = i & 1023, s = rem >> 4, c8 = rem & 15;
                        *(LAS u32x4*)(BMs + g2 * (64 * 136) + s * 136 + c8 * 8) = *(const u32x4*)(XBC + (m0 + s) * 1024 + 512 + g2 * 128 + c8 * 8); }
                    __syncthreads();
                    const LAS bf16* BMg = BMs + gi * (64 * 136);
                    for (int pt = 0; pt < 4; ++pt) { f32x4 acc[8];
#pragma unroll
                        for (int n = 0; n < 8; ++n) acc[n] = (f32x4){0.f, 0.f, 0.f, 0.f};
#pragma unroll
                        for (int ks = 0; ks < 2; ++ks) { const bf16x8 a = frag_ks(XW, 72, 16 * pt, 32 * ks, lane);
#pragma unroll
                            for (int n = 0; n < 8; ++n) acc[n] = MFMA16(a, frag_ks(BMg, 136, 16 * n, 32 * ks, lane), acc[n]); }
                        float* d = DH + ((size_t)(uc * 8 + hd) * 64 + 16 * pt + 4 * (lane >> 4)) * 128 + (lane & 15);
#pragma unroll
                        for (int n = 0; n < 8; ++n)
#pragma unroll
                            for (int i = 0; i < 4; ++i) d[i * 128 + 16 * n] = acc[n][i]; }
                    __syncthreads();
                }
            }
            GRID_BAR();
        }

        if (IN(PH_M2)) {
            PHASE_BEGIN();
            constexpr int NA = GB * 4 * 2304, NC = GB * 8 * 2048;
            for (int i = gt; i < NA + NC; i += NGT) {
                f32x4 st = {0.f, 0.f, 0.f, 0.f};
                if (i < NA) { const int bh = i / 2304, e = (i - bh * 2304) * 4;
                    for (int c = 0; c < NCH; ++c) { const size_t ua = (size_t)bh * NCH + c;
                        *(u32x2*)(CS + ua * 9216 + e) = (u32x2){pk2(st.x, st.y), pk2(st.z, st.w)};
                        st = st * MSC[ua] + *(const f32x4*)(DC + ua * 9216 + e); }
                } else { const int j = i - NA, bhd = j >> 11, e = (j & 2047) * 4, bl = bhd >> 3, hd = bhd & 7;
                    for (int c = 0; c < NCH; ++c) { const size_t uh = (size_t)(bl * NCH + c) * 8 + hd;
                        *(u32x2*)(HS + uh * 8192 + e) = (u32x2){pk2(st.x, st.y), pk2(st.z, st.w)};
                        st = st * __expf(ACB[((size_t)bl * SEQ + c * 64 + 63) * 8 + hd]) + *(const f32x4*)(DH + uh * 8192 + e); }
                }
            }
            GRID_BAR();
        }

        if (IN(PH_M3)) {
            PHASE_BEGIN();
            constexpr int NUA = GB * 4 * NCH, NUC = GB * NCH;
            for (int u = blk; u < NUA + NUC; u += NBLK) {
                const int r = lane & 15, g4 = lane >> 4;
                if (u < NUA) {
                    const int ua = u, bh = ua >> 5, c = ua & 31, bl = bh >> 2, h = bh & 3; const size_t m0 = (size_t)bl * SEQ + c * 64;
                    LAS bf16* Qs = (LAS bf16*)lds; LAS bf16* Ks = Qs + 64 * 72; LAS bf16* VP = Ks + 64 * 72; LAS bf16* CST = VP + 64 * 152; LAS bf16* SMT = CST + 144 * 72;
                    LAS float* SSQ = (LAS float*)(SMT + 64 * 72);
                    { const int s = tid >> 3, c8 = tid & 7; const bf16* pr = P + (m0 + s) * PW + h * 64 + c8 * 8;
                      *(LAS u32x4*)(Qs + s * 72 + c8 * 8) = *(const u32x4*)(pr + P_AQ); *(LAS u32x4*)(Ks + s * 72 + c8 * 8) = *(const u32x4*)(pr + P_AK); }
                    for (int i = tid; i < 1024; i += NTHR) { const int s = i >> 4, c8 = i & 15; *(LAS u32x4*)(VP + s * 152 + c8 * 8) = *(const u32x4*)(P + (m0 + s) * PW + P_AV + h * 128 + c8 * 8); }
                    if (tid < 64) { *(LAS u32x4*)(VP + tid * 152 + 128) = (u32x4){0x3F80u, 0u, 0u, 0u}; *(LAS u32x4*)(VP + tid * 152 + 136) = (u32x4){0u, 0u, 0u, 0u}; }
                    for (int i = tid; i < 1152; i += NTHR) { const int dv = i >> 3, c8 = i & 7; *(LAS u32x4*)(CST + dv * 72 + c8 * 8) = *(const u32x4*)(CS + (size_t)ua * 9216 + dv * 64 + c8 * 8); }
                    __syncthreads();
#pragma unroll
                    for (int q2 = 0; q2 < 2; ++q2) { const int ti = 2 * wave + q2, tt = ti >> 2, st = ti & 3;
                        f32x4 acc = {0.f, 0.f, 0.f, 0.f};
                        if (st <= tt) {
#pragma unroll
                            for (int ks = 0; ks < 2; ++ks) acc = MFMA16(frag_kc(Qs, 72, 16 * tt, 32 * ks, lane), frag_kc(Ks, 72, 16 * st, 32 * ks, lane), acc);
                            const int s = 16 * st + r; const float gs = GGc[(m0 + s) * 4 + h];
#pragma unroll
                            for (int i = 0; i < 4; ++i) { const int t = 16 * tt + 4 * g4 + i; const float e = GBc[(m0 + t) * 4 + h] - GMT[(m0 + t) * 4 + h] + gs;
                                acc[i] = (s <= t) ? acc[i] * 0.125f * __expf(e) : 0.f; }
                        }
                        *(LAS u32x2*)(SMT + (16 * st + r) * 72 + 16 * tt + 4 * g4) = (u32x2){pk2(acc[0], acc[1]), pk2(acc[2], acc[3])}; }
                    __syncthreads();
                    const int tt = wave & 3, half = wave >> 2;
                    f32x4 a1[5], a2[5];
#pragma unroll
                    for (int j = 0; j < 5; ++j) { a1[j] = (f32x4){0.f, 0.f, 0.f, 0.f}; a2[j] = (f32x4){0.f, 0.f, 0.f, 0.f}; }
#pragma unroll
                    for (int ks = 0; ks < 2; ++ks) { const bf16x8 fa1 = frag_ks(SMT, 72, 16 * tt, 32 * ks, lane), fa2 = frag_kc(Qs, 72, 16 * tt, 32 * ks, lane);
#pragma unroll
                        for (int j = 0; j < 5; ++j) { const int dvt = (j < 4) ? half * 4 + j : 8;
                            a1[j] = MFMA16(fa1, frag_ks(VP, 152, 16 * dvt, 32 * ks, lane), a1[j]);
                            a2[j] = MFMA16(fa2, frag_kc(CST, 72, 16 * dvt, 32 * ks, lane), a2[j]); } }
                    float hv[4][4], ssq[4]; const float mcar = MCAR[ua];
#pragma unroll
                    for (int i = 0; i < 4; ++i) { const int t = 16 * tt + 4 * g4 + i; const float b = GBc[(m0 + t) * 4 + h], mt = GMT[(m0 + t) * 4 + h];
                        const float is = 0.125f * __expf(b + mcar - mt);
                        float den = a1[4][i] + is * a2[4][i]; den = __shfl(den, lane & 48);
                        const float dn = fmaxf(fabsf(den), __expf(-mt)); float q = 0.f;
#pragma unroll
                        for (int j = 0; j < 4; ++j) { const float v = (a1[j][i] + is * a2[j][i]) / dn; hv[j][i] = v; q += v * v; }
                        q += __shfl_xor(q, 1); q += __shfl_xor(q, 2); q += __shfl_xor(q, 4); q += __shfl_xor(q, 8); ssq[i] = q; }
                    if (r == 0) {
#pragma unroll
                        for (int i = 0; i < 4; ++i) SSQ[half * 64 + 16 * tt + 4 * g4 + i] = ssq[i]; }
                    __syncthreads();
                    const float* ng = args.in[I_ANG] + (size_t)l * 512 + h * 128;
#pragma unroll
                    for (int i = 0; i < 4; ++i) { const int t = 16 * tt + 4 * g4 + i; const float rstd = rsqrtf((SSQ[t] + SSQ[64 + t]) * (1.f / 128.f) + EPS);
#pragma unroll
                        for (int j = 0; j < 4; ++j) { const int dv = 16 * (half * 4 + j) + r; const float o = bf2f(P[(m0 + t) * PW + P_AO + h * 128 + dv]);
                            YCAT[(m0 + t) * YW + h * 128 + dv] = (bf16)f2bf(sigmoidf_(o) * hv[j][i] * rstd * ng[dv]); } }
                    __syncthreads();
                } else {
                    const int uc = u - NUA, bl = uc >> 5, c = uc & 31, hd = wave, gi = hd >> 2; const size_t m0 = (size_t)bl * SEQ + c * 64;
                    LAS bf16* XH = (LAS bf16*)(lds + hd * (64 * 72 * 2)); LAS bf16* MT = (LAS bf16*)(lds + (8 + hd) * (64 * 72 * 2));
                    LAS float* SSQ = (LAS float*)(lds + 16 * (64 * 72 * 2));
#pragma unroll
                    for (int k = 0; k < 8; ++k) { const int i = lane + 64 * k, s = i >> 3, c8 = i & 7; *(LAS u32x4*)(XH + s * 72 + c8 * 8) = *(const u32x4*)(XBC + (m0 + s) * 1024 + hd * 64 + c8 * 8); }
                    const bf16* Cm = XBC + m0 * 1024 + 768 + gi * 128; const bf16* Bm = XBC + m0 * 1024 + 512 + gi * 128;
                    const bf16* Hst = HS + (size_t)(uc * 8 + hd) * 8192;
                    for (int tt = 0; tt < 4; ++tt) { bf16x8 fc[4];
#pragma unroll
                        for (int ks = 0; ks < 4; ++ks) fc[ks] = gfrag_kc(Cm, 1024, 16 * tt, 32 * ks, lane);
                        float at[4];
#pragma unroll
                        for (int i = 0; i < 4; ++i) at[i] = ACB[(m0 + 16 * tt + 4 * g4 + i) * 8 + hd];
                        for (int st = 0; st < 4; ++st) { f32x4 acc = {0.f, 0.f, 0.f, 0.f};
                            if (st <= tt) {
#pragma unroll
                                for (int ks = 0; ks < 4; ++ks) acc = MFMA16(fc[ks], gfrag_kc(Bm, 1024, 16 * st, 32 * ks, lane), acc);
                                const int s = 16 * st + r; const float as = ACB[(m0 + s) * 8 + hd], dts = DTB[(m0 + s) * 8 + hd];
#pragma unroll
                                for (int i = 0; i < 4; ++i) { const int t = 16 * tt + 4 * g4 + i; acc[i] = (s <= t) ? acc[i] * __expf(at[i] - as) * dts : 0.f; }
                            }
                            *(LAS u32x2*)(MT + (16 * st + r) * 72 + 16 * tt + 4 * g4) = (u32x2){pk2(acc[0], acc[1]), pk2(acc[2], acc[3])}; } }
                    __syncthreads();
                    const float dsk = args.in[I_CDSKIP][l * 8 + hd];
                    for (int tt = 0; tt < 4; ++tt) { f32x4 ad[4], ao[4];
#pragma unroll
                        for (int p = 0; p < 4; ++p) { ad[p] = (f32x4){0.f, 0.f, 0.f, 0.f}; ao[p] = (f32x4){0.f, 0.f, 0.f, 0.f}; }
#pragma unroll
                        for (int ks = 0; ks < 2; ++ks) { const bf16x8 fa = frag_ks(MT, 72, 16 * tt, 32 * ks, lane);
#pragma unroll
                            for (int p = 0; p < 4; ++p) ad[p] = MFMA16(fa, frag_ks(XH, 72, 16 * p, 32 * ks, lane), ad[p]); }
#pragma unroll
                        for (int ks = 0; ks < 4; ++ks) { const bf16x8 fa = gfrag_kc(Cm, 1024, 16 * tt, 32 * ks, lane);
#pragma unroll
                            for (int p = 0; p < 4; ++p) ao[p] = MFMA16(fa, gfrag_kc(Hst, 128, 16 * p, 32 * ks, lane), ao[p]); }
                        float ssq[4];
#pragma unroll
                        for (int i = 0; i < 4; ++i) { const int t = 16 * tt + 4 * g4 + i; const float ea = __expf(ACB[(m0 + t) * 8 + hd]); float q = 0.f;
#pragma unroll
                            for (int p = 0; p < 4; ++p) { const int pc = 16 * p + r; const float xv = bf2f(XH[t * 72 + pc]); const float z = bf2f(P[(m0 + t) * PW + P_CZ + hd * 64 + pc]);
                                const float y = (ad[p][i] + ea * ao[p][i] + dsk * xv) * siluf_(z); q += y * y;
                                YCAT[(m0 + t) * YW + 1024 + hd * 64 + pc] = (bf16)f2bf(y); }
                            q += __shfl_xor(q, 1); q += __shfl_xor(q, 2); q += __shfl_xor(q, 4); q += __shfl_xor(q, 8); ssq[i] = q; }
                        if (r == 0) {
#pragma unroll
                            for (int i = 0; i < 4; ++i) SSQ[hd * 64 + 16 * tt + 4 * g4 + i] = ssq[i]; } }
                    __syncthreads();
                    const float* ng = args.in[I_CNG] + (size_t)l * 512 + hd * 64;
                    for (int tt = 0; tt < 4; ++tt)
#pragma unroll
                        for (int i = 0; i < 4; ++i) { const int t = 16 * tt + 4 * g4 + i; float q = 0.f;
#pragma unroll
                            for (int w8 = 0; w8 < 8; ++w8) q += SSQ[w8 * 64 + t];
                            const float rstd = rsqrtf(q * (1.f / 512.f) + EPS);
#pragma unroll
                            for (int p = 0; p < 4; ++p) { const int pc = 16 * p + r; bf16* yp = YCAT + (m0 + t) * YW + 1024 + hd * 64 + pc; *yp = (bf16)f2bf(bf2f(*yp) * rstd * ng[pc]); } }
                    __syncthreads();
                }
            }
            GRID_BAR();
        }

        if (IN(PH_ATT)) {
            PHASE_BEGIN();
            LAS bf16* Qs = (LAS bf16*)lds; LAS bf16* Ks = Qs + 128 * 136; LAS bf16* Vs = Ks + 64 * 136; LAS bf16* Aw = Vs + 64 * 136 + wave * (16 * 72);
            const int r = lane & 15, g4 = lane >> 4;
            for (int u = blk; u < GB * 4 * 16; u += NBLK) {
                const int bl = u >> 6, h = (u >> 4) & 3, qt = u & 15; const size_t mb = (size_t)bl * SEQ; const int q0 = qt * 128;
                __syncthreads();
                for (int i = tid; i < 2048; i += NTHR) { const int s = i >> 4, c8 = i & 15; *(LAS u32x4*)(Qs + s * 136 + c8 * 8) = *(const u32x4*)(P + (mb + q0 + s) * PW + P_SQ + h * 128 + c8 * 8); }
                f32x4 O[8];
#pragma unroll
                for (int d = 0; d < 8; ++d) O[d] = (f32x4){0.f, 0.f, 0.f, 0.f};
                float racc = 0.f; const int tq = q0 + 16 * wave + r;
                for (int kt = 2 * qt + 1; kt >= 0; --kt) {
                    const int s0 = kt * 64;
                    __syncthreads();
                    for (int i = tid; i < 1024; i += NTHR) { const int s = i >> 4, c8 = i & 15; const bf16* pr = P + (mb + s0 + s) * PW + h * 128 + c8 * 8;
                        *(LAS u32x4*)(Ks + s * 136 + c8 * 8) = *(const u32x4*)(pr + P_SK); *(LAS u32x4*)(Vs + s * 136 + c8 * 8) = *(const u32x4*)(pr + P_SV); }
                    __syncthreads();
                    if (s0 < q0 + 16 * wave + 15) {
                        f32x4 z[4];
#pragma unroll
                        for (int j = 0; j < 4; ++j) z[j] = (f32x4){0.f, 0.f, 0.f, 0.f};
#pragma unroll
                        for (int ks = 0; ks < 4; ++ks) { const bf16x8 fq = frag_kc(Qs, 136, 16 * wave, 32 * ks, lane);
#pragma unroll
                            for (int j = 0; j < 4; ++j) z[j] = MFMA16(frag_kc(Ks, 136, 16 * j, 32 * ks, lane), fq, z[j]); }
                        float ls[4][4], x[4][4], tsum[4];
#pragma unroll
                        for (int j = 0; j < 4; ++j) { float tj = 0.f;
#pragma unroll
                            for (int i = 0; i < 4; ++i) { const int s = s0 + 16 * j + 4 * g4 + i; const float zz = z[j][i] * 0.08838834764831845f;
                                const float l1 = fminf(zz, 0.f) - __logf(1.f + __expf(-fabsf(zz)));
                                ls[j][i] = l1; x[j][i] = (s < tq) ? (l1 - zz) : 0.f; tj += x[j][i]; }
                            tsum[j] = tj; }
                        float above[4], tot[4];
#pragma unroll
                        for (int j = 0; j < 4; ++j) { const float y1 = __shfl_xor(tsum[j], 16), y2 = __shfl_xor(tsum[j], 32), y3 = __shfl_xor(tsum[j], 48);
                            tot[j] = tsum[j] + y1 + y2 + y3;
                            above[j] = (g4 == 0) ? (y1 + y2 + y3) : (g4 == 1) ? (y2 + y3) : (g4 == 2) ? y1 : 0.f; }
                        float hi = racc;
#pragma unroll
                        for (int j = 3; j >= 0; --j) { float run = hi + above[j]; float av[4];
#pragma unroll
                            for (int i = 3; i >= 0; --i) { const int s = s0 + 16 * j + 4 * g4 + i; av[i] = (s < tq) ? __expf(ls[j][i] + run) : 0.f; run += x[j][i]; }
                            *(LAS u32x2*)(Aw + r * 72 + 16 * j + 4 * g4) = (u32x2){pk2(av[0], av[1]), pk2(av[2], av[3])};
                            hi += tot[j]; }
                        racc = hi;
                        LDS_WAIT(); asm volatile("" ::: "memory");
#pragma unroll
                        for (int ks = 0; ks < 2; ++ks) { const bf16x8 fa = frag_kc(Aw, 72, 0, 32 * ks, lane);
#pragma unroll
                            for (int d = 0; d < 8; ++d) O[d] = MFMA16(fa, frag_ks(Vs, 136, 16 * d, 32 * ks, lane), O[d]); }
                    }
                }
#pragma unroll
                for (int d = 0; d < 8; ++d)
#pragma unroll
                    for (int i = 0; i < 4; ++i) YCAT[(mb + q0 + 16 * wave + 4 * g4 + i) * YW + 1536 + h * 128 + 16 * d + r] = (bf16)f2bf(O[d][i]);
            }
            GRID_BAR();
        }

        if (IN(PH_LIFT)) {
            PHASE_BEGIN();
            pg8::Gemm g{YCAT, WliftT, 512, YW, 512, (size_t)512 * 2, (size_t)DM * 512 * 2}; pg8::Order S; S.init(T, DM, NBLK, blk, 4);
            pg8::EpiLift E{P + P_G, PW, MG, MB, DM};
            pg8::gemm_phase<pg8::EpiLift>(lds, g, S, E);
            GRID_BAR();
        }
        if (IN(PH_OUT)) {
            PHASE_BEGIN();
            pg8::Gemm g{MB, WoutT, DM, DM, DM, 0, 0}; pg8::Order S; S.init(T, DM, NBLK, blk, 1);
            pg8::EpiResid E{xsrc + grow0 * DM, args.out + grow0 * DM, DM};
            pg8::gemm_phase<pg8::EpiResid>(lds, g, S, E);
            GRID_BAR();
        }
        if (IN(PH_N2)) {
            PHASE_BEGIN();
            const float* gain = args.in[I_FFNG] + (size_t)l * DM;
            f32x4 gv[4];
#pragma unroll
            for (int j = 0; j < 4; ++j) gv[j] = ((const f32x4*)gain)[lane + 64 * j];
            for (int m = gw; m < T; m += NGW) {
                const f32x4* xr = (const f32x4*)(args.out + (grow0 + m) * DM) + lane;
                f32x4 v[4]; float s = 0.f;
#pragma unroll
                for (int j = 0; j < 4; ++j) { v[j] = xr[64 * j]; s += (v[j].x * v[j].x + v[j].y * v[j].y) + (v[j].z * v[j].z + v[j].w * v[j].w); }
                const float rstd = rsqrtf(wave_sum(s) * (1.f / DM) + EPS);
                u32x2* o8 = (u32x2*)(XN + (size_t)m * DM) + lane;
#pragma unroll
                for (int j = 0; j < 4; ++j) { const f32x4 y = v[j] * rstd * gv[j]; o8[64 * j] = (u32x2){pk2(y.x, y.y), pk2(y.z, y.w)}; }
            }
            GRID_BAR();
        }
        if (IN(PH_UP)) {
            PHASE_BEGIN();
            pg8::Gemm g{XN, WupT, DM, DM, DM, 0, 0}; pg8::Order S; S.init(T, DFF2, NBLK, blk, 1);
            pg8::EpiBf16 E{U, DFF2};
            pg8::gemm_phase<pg8::EpiBf16>(lds, g, S, E);
            GRID_BAR();
        }
        if (IN(PH_CONVACT)) {
            PHASE_BEGIN();
            const float* fw = args.in[I_FCW] + (size_t)l * 3 * DFF2; const float* fb = args.in[I_FCB] + (size_t)l * DFF2;
            for (int i = gt; i < T * (DFF / 8); i += NGT) {
                const int m = i / (DFF / 8), c8 = (i - m * (DFF / 8)) * 8, t = m & (SEQ - 1);
                float ag[8], au[8];
#pragma unroll
                for (int e = 0; e < 8; ++e) { ag[e] = fb[c8 + e]; au[e] = fb[DFF + c8 + e]; }
#pragma unroll
                for (int j = 0; j < 3; ++j) { if (t - 2 + j >= 0) { const bf16* ur = U + (size_t)(m - 2 + j) * DFF2 + c8; const u32x4 a = *(const u32x4*)ur, b = *(const u32x4*)(ur + DFF);
                    const float* wg = fw + j * DFF2 + c8; const float* wu = wg + DFF;
                    ag[0] += wg[0] * bf2f(a.x & 0xffffu); ag[1] += wg[1] * bf2f(a.x >> 16); ag[2] += wg[2] * bf2f(a.y & 0xffffu); ag[3] += wg[3] * bf2f(a.y >> 16);
                    ag[4] += wg[4] * bf2f(a.z & 0xffffu); ag[5] += wg[5] * bf2f(a.z >> 16); ag[6] += wg[6] * bf2f(a.w & 0xffffu); ag[7] += wg[7] * bf2f(a.w >> 16);
                    au[0] += wu[0] * bf2f(b.x & 0xffffu); au[1] += wu[1] * bf2f(b.x >> 16); au[2] += wu[2] * bf2f(b.y & 0xffffu); au[3] += wu[3] * bf2f(b.y >> 16);
                    au[4] += wu[4] * bf2f(b.z & 0xffffu); au[5] += wu[5] * bf2f(b.z >> 16); au[6] += wu[6] * bf2f(b.w & 0xffffu); au[7] += wu[7] * bf2f(b.w >> 16); } }
                u32x4 o; o.x = pk2(siluf_(ag[0]) * au[0], siluf_(ag[1]) * au[1]); o.y = pk2(siluf_(ag[2]) * au[2], siluf_(ag[3]) * au[3]);
                o.z = pk2(siluf_(ag[4]) * au[4], siluf_(ag[5]) * au[5]); o.w = pk2(siluf_(ag[6]) * au[6], siluf_(ag[7]) * au[7]);
                *(u32x4*)(ACT + (size_t)m * DFF + c8) = o;
            }
            GRID_BAR();
        }
        if (IN(PH_DOWN)) {
            PHASE_BEGIN();
            pg8::Gemm g{ACT, WdownT, DFF, DFF, DFF, 0, 0}; pg8::Order S; S.init(T, DM, NBLK, blk, 1);
            pg8::EpiResid E{args.out + grow0 * DM, args.out + grow0 * DM, DM};
            pg8::gemm_phase<pg8::EpiResid>(lds, g, S, E);
            GRID_BAR();
        }
        if (IN(PH_FINAL) && l == DEPTH - 1) {
            PHASE_BEGIN();
            const float* gain = args.in[I_FING];
            f32x4 gv[4];
#pragma unroll
            for (int j = 0; j < 4; ++j) gv[j] = ((const f32x4*)gain)[lane + 64 * j];
            for (int m = gw; m < T; m += NGW) {
                f32x4* xr = (f32x4*)(args.out + (grow0 + m) * DM) + lane;
                f32x4 v[4]; float s = 0.f;
#pragma unroll
                for (int j = 0; j < 4; ++j) { v[j] = xr[64 * j]; s += (v[j].x * v[j].x + v[j].y * v[j].y) + (v[j].z * v[j].z + v[j].w * v[j].w); }
                const float rstd = rsqrtf(wave_sum(s) * (1.f / DM) + EPS);
#pragma unroll
                for (int j = 0; j < 4; ++j) xr[64 * j] = v[j] * rstd * gv[j];
            }
            GRID_BAR();
        }
    }
#undef IN
#undef GRID_BAR
#undef PHASE_BEGIN
}

#ifndef ONE_LAUNCH
#define ONE_LAUNCH 1
#endif
extern "C" void kernel_launch(void* const* d_in, const int* in_sizes, int n_in, void* d_out, int out_size, void* d_ws, size_t ws_size, hipStream_t stream) {
    static int grid = 0;
    if (grid == 0) {
        if (n_in != N_IN || in_sizes[0] != BATCH * SEQ * DM || out_size != BATCH * SEQ * DM || ws_size < WS_END) {
            fprintf(stderr, "kernel_launch: unexpected shapes / workspace (n_in %d, ws %zu, need %zu); nothing launched\n", n_in, ws_size, (size_t)WS_END); grid = -1; return; }
        int dev = 0, cus = 0, per_cu = 0;
        if (hipGetDevice(&dev) != hipSuccess || hipDeviceGetAttribute(&cus, hipDeviceAttributeMultiprocessorCount, dev) != hipSuccess) { grid = -1; return; }
        if (hipFuncSetAttribute((const void*)fwd, hipFuncAttributeMaxDynamicSharedMemorySize, LDS_BYTES) != hipSuccess) { fprintf(stderr, "kernel_launch: hipFuncSetAttribute failed\n"); grid = -1; return; }
        if (hipOccupancyMaxActiveBlocksPerMultiprocessor(&per_cu, (const void*)fwd, NTHR, LDS_BYTES) != hipSuccess || per_cu < 1) { fprintf(stderr, "kernel_launch: occupancy query says %d\n", per_cu); (void)hipGetLastError(); }
        grid = cus;
    }
    if (grid < 0) return;
    (void)hipMemsetAsync((char*)d_ws + WS_CTL, 0, CTL_BYTES, stream);
    Args a{};
    for (int i = 0; i < N_IN; ++i) a.in[i] = (const float*)d_in[i];
    a.out = (float*)d_out; a.ws = (unsigned char*)d_ws; a.pad = 0;
#if ONE_LAUNCH
    a.l_lo = 0; a.l_hi = DEPTH; a.g_lo = 0; a.g_hi = NG; a.ph_lo = 0; a.ph_hi = PH_COUNT; a.use_bar = 1;
    hipLaunchKernelGGL(fwd, dim3(grid), dim3(NTHR), LDS_BYTES, stream, a);
#else
    a.use_bar = 0;
    for (int l = 0; l < DEPTH; ++l)
        for (int g = 0; g < NG; ++g)
            for (int ph = 0; ph < PH_COUNT; ++ph) {
                if (ph == PH_W && g != 0) continue;
                if (ph == PH_FINAL && l != DEPTH - 1) continue;
                a.l_lo = l; a.l_hi = l + 1; a.g_lo = g; a.g_hi = g + 1; a.ph_lo = ph; a.ph_hi = ph + 1;
                hipLaunchKernelGGL(fwd, dim3(grid), dim3(NTHR), LDS_BYTES, stream, a);
            }
#endif
}
```

```cpp
#include <hip/hip_runtime.h>
#include <cstdio>
#include <cstdint>

#define LAS __attribute__((address_space(3)))
#define GAS __attribute__((address_space(1)))
typedef unsigned short bf16;
typedef short bf16x8 __attribute__((ext_vector_type(8)));
typedef short s16x4 __attribute__((ext_vector_type(4)));
typedef float f32x4 __attribute__((ext_vector_type(4)));
typedef float f32x2 __attribute__((ext_vector_type(2)));
typedef unsigned u32x4 __attribute__((ext_vector_type(4)));
typedef unsigned u32x2 __attribute__((ext_vector_type(2)));

constexpr int DM = 1024, BATCH = 32, SEQ = 2048, DEPTH = 4;
constexpr int PIN = 10256, PW = 10240, DFF = 2816, DFF2 = 5632;
constexpr int GB = 8;
constexpr int NG = BATCH / GB;
constexpr int T = GB * SEQ;
constexpr int NCH = SEQ / 64;
constexpr float EPS = 1e-6f;
constexpr int P_AQ = 0, P_AK = 256, P_AV = 512, P_AO = 1024, P_BB = 1536, P_BC = 2048, P_BX = 2560, P_CZ = 3072, P_CX = 3584, P_SQ = 4608, P_SK = 5120, P_SV = 5632, P_G = 6144;
constexpr int YW = 2048;

constexpr size_t MiB = 1u << 20;
constexpr size_t WS_CTL = 0, CTL_BYTES = 1 * MiB;
constexpr size_t WS_WIN = 1 * MiB;
constexpr size_t WS_WLIFT = WS_WIN + (size_t)PW * DM * 2;
constexpr size_t WS_WOUT = WS_WLIFT + (size_t)4 * DM * 512 * 2;
constexpr size_t WS_WUP = WS_WOUT + (size_t)DM * DM * 2;
constexpr size_t WS_WDOWN = WS_WUP + (size_t)DFF2 * DM * 2;
constexpr size_t WS_W16 = WS_WDOWN + (size_t)DM * DFF * 2;
constexpr size_t WS_XN = WS_W16 + 65536;
constexpr size_t WS_P = WS_XN + (size_t)T * DM * 2;
constexpr size_t WS_U = WS_P, WS_ACT = WS_P + (size_t)T * DFF2 * 2;
constexpr size_t WS_YCAT = WS_P + (size_t)T * PW * 2;
constexpr size_t WS_MG = WS_YCAT + (size_t)T * YW * 2;
constexpr size_t WS_MB = WS_MG + (size_t)T * DM * 4;
constexpr size_t WS_SP = WS_MB + (size_t)T * DM * 2;
constexpr size_t WS_GB = WS_SP + (size_t)T * 16 * 4;
constexpr size_t WS_GG = WS_GB + (size_t)T * 16;
constexpr size_t WS_GMT = WS_GG + (size_t)T * 16;
constexpr size_t WS_MCAR = WS_GMT + (size_t)T * 16;
constexpr size_t WS_MNEW = WS_MCAR + 4096;
constexpr size_t WS_MSC = WS_MNEW + 4096;
constexpr size_t WS_DT = WS_MSC + 4096;
constexpr size_t WS_AC = WS_DT + (size_t)T * 32;
constexpr size_t WS_XBC = WS_AC + (size_t)T * 32;
constexpr size_t WS_DC = WS_XBC + (size_t)T * DM * 2;
constexpr size_t WS_CS = WS_DC + (size_t)GB * 4 * NCH * 9216 * 4;
constexpr size_t WS_DH = WS_CS + (size_t)GB * 4 * NCH * 9216 * 2;
constexpr size_t WS_HS = WS_DH + (size_t)GB * NCH * 8 * 8192 * 4;
constexpr size_t WS_END = WS_HS + (size_t)GB * NCH * 8 * 8192 * 2;

constexpr int NWAVES = 8, NTHR = 512;
constexpr int LDS_BYTES = 155648;
constexpr int MISC_OFF = 153600;

__device__ __forceinline__ float bf2f(unsigned b) { return __uint_as_float(b << 16); }
__device__ __forceinline__ unsigned f2bf(float f) { unsigned u = __float_as_uint(f); return (u + 0x7fffu + ((u >> 16) & 1u)) >> 16; }
__device__ __forceinline__ unsigned pk2(float lo, float hi) { return f2bf(lo) | (f2bf(hi) << 16); }
__device__ __forceinline__ float sigmoidf_(float x) { return 1.f / (1.f + __expf(-x)); }
__device__ __forceinline__ float siluf_(float x) { return x / (1.f + __expf(-x)); }
__device__ __forceinline__ float logsigf_(float x) { return fminf(x, 0.f) - log1pf(expf(-fabsf(x))); }
__device__ __forceinline__ float softplusf_(float x) { return fmaxf(x, 0.f) + log1pf(expf(-fabsf(x))); }
__device__ __forceinline__ float wave_sum(float v) {
#pragma unroll
    for (int o = 1; o < 64; o <<= 1) v += __shfl_xor(v, o);
    return v;
}
#define LDS_WAIT() asm volatile("s_waitcnt lgkmcnt(0)" ::: "memory")

namespace pg8 {
constexpr int BM = 256, BK = 64, HALF = 128, HTB = HALF * BK * 2, STAGE_BYTES = 8 * HTB, NXCD = 8, WGM = 8;
__host__ __device__ __forceinline__ int lds_byte(int r, int c) { const int st = (r >> 4) * 2 + (c >> 5), rr = r & 15, cc = c & 31, ob = rr * 64 + cc * 2; return st * 1024 + (ob ^ (((ob >> 9) & 1) << 5)); }
__host__ __device__ __forceinline__ void stage_rc(int b, int& R, int& C) { const int st = b / 1024, sb = b % 1024, swz = sb ^ (((sb >> 9) & 1) << 5); R = (st >> 1) * 16 + swz / 64; C = (st & 1) * 32 + (swz % 64) / 2; }
__host__ __device__ __forceinline__ int perm32(int rho) { const int n = rho >> 4, i = rho & 15; return 8 * (i >> 2) + 4 * n + (i & 3); }

struct Unit { int pm, pn, z; };
struct Gemm { const bf16* A; const bf16* Bt; int K, lda, ldb; size_t zA, zB; };

struct Order {
    int nM, nN, nwg, G, c, Z;
    __device__ void init(int M, int N, int G_, int c_, int Z_) { nM = M / BM; nN = N / BM; nwg = nM * nN; G = G_; c = c_; Z = Z_; }
    __device__ bool next(int i, Unit& u) const {
        const int ti = i / Z; u.z = i - ti * Z;
        const long L = (long)ti * G + c; if (L >= nwg) return false;
        int wgid = (int)L; { const int q = nwg / NXCD, r = nwg % NXCD, xcd = wgid % NXCD, off = wgid / NXCD; wgid = (xcd < r ? xcd * (q + 1) : r * (q + 1) + (xcd - r) * q) + off; }
        const int nig = WGM * nN, gid = wgid / nig, fm = gid * WGM, gsz = (nM - fm) < WGM ? (nM - fm) : WGM;
        u.pm = fm + ((wgid % nig) % gsz); u.pn = (wgid % nig) / gsz; return true;
    }
};
__device__ __forceinline__ unsigned cvt_pk_bf16(float lo, float hi) { unsigned r; asm volatile("v_cvt_pk_bf16_f32 %0, %1, %2" : "=v"(r) : "v"(lo), "v"(hi)); return r; }

struct EpiBf16 {
    static constexpr bool PERM = true, KEEP = false;
    bf16* O; int ldc;
    __device__ __forceinline__ void operator()(f32x4 (&acc)[2][2][4][2], const Unit& u, int wr, int wc, int fr, int fq) const {
        const int row0 = u.pm * BM + wr * 64 + fr, col0 = u.pn * BM + wc * 32 + 8 * fq;
#pragma unroll
        for (int ai = 0; ai < 2; ++ai)
#pragma unroll
            for (int m = 0; m < 4; ++m) { bf16* rowp = O + (size_t)(row0 + ai * HALF + m * 16) * ldc + col0;
#pragma unroll
                for (int bj = 0; bj < 2; ++bj) { const f32x4 v0 = acc[ai][bj][m][0], v1 = acc[ai][bj][m][1];
                    u32x4 w; w.x = cvt_pk_bf16(v0[0], v0[1]); w.y = cvt_pk_bf16(v0[2], v0[3]); w.z = cvt_pk_bf16(v1[0], v1[1]); w.w = cvt_pk_bf16(v1[2], v1[3]);
                    *(u32x4*)(rowp + bj * HALF) = w; } }
    }
};
struct EpiResid {
    static constexpr bool PERM = false, KEEP = false;
    const float* base; float* out; int ldc;
    __device__ __forceinline__ void operator()(f32x4 (&acc)[2][2][4][2], const Unit& u, int wr, int wc, int fr, int fq) const {
        const int row0 = u.pm * BM + wr * 64 + fr, col0 = u.pn * BM + wc * 32 + 4 * fq;
#pragma unroll
        for (int ai = 0; ai < 2; ++ai)
#pragma unroll
            for (int m = 0; m < 4; ++m) { const size_t off = (size_t)(row0 + ai * HALF + m * 16) * ldc + col0;
#pragma unroll
                for (int bj = 0; bj < 2; ++bj)
#pragma unroll
                    for (int n = 0; n < 2; ++n) { const f32x4 b = *(const f32x4*)(base + off + bj * HALF + n * 16); *(f32x4*)(out + off + bj * HALF + n * 16) = b + acc[ai][bj][m][n]; } }
    }
};
struct EpiLift {
    static constexpr bool PERM = true, KEEP = true;
    const bf16* gate; int ldg; bf16* mb; int ldc;
    static __device__ __forceinline__ float em(unsigned b) { return __expf(-fminf(fmaxf(bf2f(b), -30.f), 30.f)); }
    __device__ __forceinline__ void operator()(f32x4 (&acc)[2][2][4][2], const Unit& u, int wr, int wc, int fr, int fq) const {
        const int row0 = u.pm * BM + wr * 64 + fr, col0 = u.pn * BM + wc * 32 + 8 * fq;
#pragma unroll
        for (int ai = 0; ai < 2; ++ai)
#pragma unroll
            for (int m = 0; m < 4; ++m) { const int row = row0 + ai * HALF + m * 16;
#pragma unroll
                for (int bj = 0; bj < 2; ++bj) { const int col = col0 + bj * HALF;
                    const bf16* gp = gate + (size_t)row * ldg + u.z * 1024 + col;
                    const u32x4 g0 = *(const u32x4*)gp;
                    f32x4& v0 = acc[ai][bj][m][0]; f32x4& v1 = acc[ai][bj][m][1];
                    if (u.z < 3) { const u32x4 g1 = *(const u32x4*)(gp + 1024);
                        v0[0] *= (1.f + em(g1.x & 0xffffu)) / (1.f + em(g0.x & 0xffffu)); v0[1] *= (1.f + em(g1.x >> 16)) / (1.f + em(g0.x >> 16));
                        v0[2] *= (1.f + em(g1.y & 0xffffu)) / (1.f + em(g0.y & 0xffffu)); v0[3] *= (1.f + em(g1.y >> 16)) / (1.f + em(g0.y >> 16));
                        v1[0] *= (1.f + em(g1.z & 0xffffu)) / (1.f + em(g0.z & 0xffffu)); v1[1] *= (1.f + em(g1.z >> 16)) / (1.f + em(g0.z >> 16));
                        v1[2] *= (1.f + em(g1.w & 0xffffu)) / (1.f + em(g0.w & 0xffffu)); v1[3] *= (1.f + em(g1.w >> 16)) / (1.f + em(g0.w >> 16));
                    } else {
                        u32x4 w;
                        w.x = cvt_pk_bf16(v0[0] / (1.f + em(g0.x & 0xffffu)), v0[1] / (1.f + em(g0.x >> 16))); w.y = cvt_pk_bf16(v0[2] / (1.f + em(g0.y & 0xffffu)), v0[3] / (1.f + em(g0.y >> 16)));
                        w.z = cvt_pk_bf16(v1[0] / (1.f + em(g0.z & 0xffffu)), v1[1] / (1.f + em(g0.z >> 16))); w.w = cvt_pk_bf16(v1[2] / (1.f + em(g0.w & 0xffffu)), v1[3] / (1.f + em(g0.w >> 16)));
                        *(u32x4*)(mb + (size_t)row * ldc + col) = w; } } }
    }
};

template <class Epi>
__device__ __forceinline__ void gemm_phase(LAS unsigned char* lds, const Gemm g, const Order& S, const Epi& E) {
    int tid = threadIdx.x; asm volatile("" : "+v"(tid));
    const int wid = __builtin_amdgcn_readfirstlane(tid >> 6), lane = tid & 63, wr = wid >> 2, wc = wid & 3, fr = lane & 15, fq = lane >> 4;
    const int K = g.K, nt = K / BK;
    unsigned voffA[2], voffB[2];
#pragma unroll
    for (int i = 0; i < 2; ++i) { int R, C; stage_rc(tid * 16 + i * 8192, R, C); const int Rb = Epi::PERM ? ((R & ~31) + perm32(R & 31)) : R;
        voffA[i] = (unsigned)(R * g.lda + C) * 2u; voffB[i] = (unsigned)(Rb * g.ldb + C) * 2u; }
    const size_t kstep = (size_t)(BK * 2);
    const size_t hstepA = (size_t)HALF * g.lda * 2, hstepB = (size_t)HALF * g.ldb * 2;
    const size_t tstepA = 2 * hstepA, tstepB = 2 * hstepB;
    const unsigned ldsw = (unsigned)wid * 1024u;
    const int aoff = lds_byte(wr * 64 + fr, fq * 8), boff = lds_byte(wc * 32 + fr, fq * 8);
#define PG8_SA(b, h) (((b) * 2 + (h)) * HTB)
#define PG8_SB(b, h) ((4 + (b) * 2 + (h)) * HTB)
#define PG8_STAGE(bufoff, gbase, voff) do { _Pragma("unroll") for (int _i = 0; _i < 2; ++_i) \
        __builtin_amdgcn_global_load_lds((const unsigned*)((const char*)(gbase) + (voff)[_i]), (LAS unsigned*)(lds + (bufoff) + ldsw + _i * 8192), 16, 0, 0); } while (0)
#define PG8_LDA(dst, b, h) do { _Pragma("unroll") for (int m = 0; m < 4; ++m) _Pragma("unroll") for (int k = 0; k < 2; ++k) dst[m][k] = *(const LAS bf16x8*)(lds + PG8_SA(b, h) + aoff + m * 2048 + k * 1024); } while (0)
#define PG8_LDB(dst, b, h) do { _Pragma("unroll") for (int n = 0; n < 2; ++n) _Pragma("unroll") for (int k = 0; k < 2; ++k) dst[n][k] = *(const LAS bf16x8*)(lds + PG8_SB(b, h) + boff + n * 2048 + k * 1024); } while (0)
#define PG8_MMA(ai, bj, At, Bt) do { __builtin_amdgcn_s_setprio(1); _Pragma("unroll") for (int m = 0; m < 4; ++m) _Pragma("unroll") for (int n = 0; n < 2; ++n) _Pragma("unroll") for (int k = 0; k < 2; ++k) \
        acc[ai][bj][m][n] = __builtin_amdgcn_mfma_f32_16x16x32_bf16(Bt[n][k], At[m][k], acc[ai][bj][m][n], 0, 0, 0); __builtin_amdgcn_s_setprio(0); } while (0)
#define PG8_WAIT_V(n) asm volatile("s_waitcnt vmcnt(" #n ")" ::: "memory")
#define PG8_WAIT_L(n) asm volatile("s_waitcnt lgkmcnt(" #n ")" ::: "memory")
#define PG8_BAR __builtin_amdgcn_s_barrier()
#define PG8_SCHED __builtin_amdgcn_sched_barrier(0)
    Unit cur, nxt; int ui = 0;
    if (!S.next(0, cur)) return;
    f32x4 acc[2][2][4][2];
#pragma unroll
    for (int a = 0; a < 2; ++a)
#pragma unroll
        for (int b = 0; b < 2; ++b)
#pragma unroll
            for (int m = 0; m < 4; ++m)
#pragma unroll
                for (int n = 0; n < 2; ++n) acc[a][b][m][n] = (f32x4){0.f, 0.f, 0.f, 0.f};
    bf16x8 At[4][2], B0[2][2], B1[2][2];
    const char* cA = (const char*)g.A + (size_t)cur.pm * tstepA + (size_t)cur.z * g.zA; const char* cB = (const char*)g.Bt + (size_t)cur.pn * tstepB + (size_t)cur.z * g.zB;
    PG8_STAGE(PG8_SB(0, 0), cB, voffB); PG8_STAGE(PG8_SB(0, 1), cB + hstepB, voffB); PG8_STAGE(PG8_SA(0, 0), cA, voffA); PG8_STAGE(PG8_SA(0, 1), cA + hstepA, voffA);
    if (wr == 1) PG8_BAR;
    PG8_WAIT_V(2); PG8_BAR;
    PG8_STAGE(PG8_SB(1, 0), cB + kstep, voffB); PG8_STAGE(PG8_SA(1, 0), cA + kstep, voffA); PG8_STAGE(PG8_SB(1, 1), cB + hstepB + kstep, voffB);
    PG8_WAIT_V(6); PG8_BAR;
    for (;;) {
        const bool has_next = S.next(ui + 1, nxt);
        const char* nA = has_next ? (const char*)g.A + (size_t)nxt.pm * tstepA + (size_t)nxt.z * g.zA : cA; const char* nB = has_next ? (const char*)g.Bt + (size_t)nxt.pn * tstepB + (size_t)nxt.z * g.zB : cB;
        for (int t = 0; t < nt; t += 2) {
            const bool last = (t == nt - 2);
            const char* a1 = cA + (size_t)(t + 1) * kstep;
            const char* a2 = last ? nA : cA + (size_t)(t + 2) * kstep; const char* b2 = last ? nB : cB + (size_t)(t + 2) * kstep;
            const char* a3 = a2 + kstep; const char* b3 = b2 + kstep;
            PG8_LDB(B0, 0, 0); PG8_LDB(B1, 0, 1); PG8_SCHED; PG8_LDA(At, 0, 0); PG8_STAGE(PG8_SA(1, 1), a1 + hstepA, voffA);
            PG8_WAIT_V(8); PG8_WAIT_L(0); PG8_BAR; PG8_MMA(0, 0, At, B0); PG8_MMA(0, 1, At, B1); PG8_BAR; PG8_SCHED;
            PG8_LDA(At, 0, 1); PG8_STAGE(PG8_SB(0, 0), b2, voffB); PG8_STAGE(PG8_SB(0, 1), b2 + hstepB, voffB); PG8_STAGE(PG8_SA(0, 0), a2, voffA);
            PG8_WAIT_V(8); PG8_WAIT_L(0); PG8_BAR; PG8_MMA(1, 0, At, B0); PG8_MMA(1, 1, At, B1); PG8_BAR; PG8_SCHED;
            PG8_LDB(B0, 1, 0); PG8_LDB(B1, 1, 1); PG8_SCHED; PG8_LDA(At, 1, 0); PG8_STAGE(PG8_SA(0, 1), a2 + hstepA, voffA);
            PG8_WAIT_V(8); PG8_WAIT_L(0); PG8_BAR; PG8_MMA(0, 0, At, B0); PG8_MMA(0, 1, At, B1); PG8_BAR; PG8_SCHED;
            PG8_LDA(At, 1, 1); PG8_STAGE(PG8_SB(1, 0), b3, voffB); PG8_STAGE(PG8_SB(1, 1), b3 + hstepB, voffB); PG8_STAGE(PG8_SA(1, 0), a3, voffA);
            PG8_WAIT_V(8); PG8_WAIT_L(0); PG8_BAR; PG8_MMA(1, 0, At, B0); PG8_MMA(1, 1, At, B1); PG8_BAR; PG8_SCHED;
        }
        if (wr == 0) PG8_BAR;
        E(acc, cur, wr, wc, fr, fq);
        if (!has_next) break;
        if (!(Epi::KEEP && nxt.z != 0))
#pragma unroll
        for (int a = 0; a < 2; ++a)
#pragma unroll
            for (int b = 0; b < 2; ++b)
#pragma unroll
                for (int m = 0; m < 4; ++m)
#pragma unroll
                    for (int n = 0; n < 2; ++n) acc[a][b][m][n] = (f32x4){0.f, 0.f, 0.f, 0.f};
        cur = nxt; cA = nA; cB = nB; ++ui;
        if (wr == 1) PG8_BAR;
    }
    PG8_WAIT_V(0);
    PG8_BAR;
#undef PG8_SA
#undef PG8_SB
#undef PG8_STAGE
#undef PG8_LDA
#undef PG8_LDB
#undef PG8_MMA
#undef PG8_WAIT_V
#undef PG8_WAIT_L
#undef PG8_BAR
#undef PG8_SCHED
}
}

#define XB_TMO      128
#define XB_XCNT(j)  (256  + 64 * (j))
#define XB_XSUB(j)  (1280 + 64 * (j))
#define XB_XGEN(j)  (2304 + 64 * (j))
#define XB_TOP      3328
#define XB_TOPGEN   3392
#define XCD_BAR_WORDS 3456
#define XB_SPIN_CAP (1u << 18)
__device__ __forceinline__ unsigned xb_ld(unsigned* p)              { return __hip_atomic_load(p, __ATOMIC_RELAXED, __HIP_MEMORY_SCOPE_AGENT); }
__device__ __forceinline__ unsigned xb_add(unsigned* p, unsigned v) { return __hip_atomic_fetch_add(p, v, __ATOMIC_RELAXED, __HIP_MEMORY_SCOPE_AGENT); }
__device__ __forceinline__ unsigned xb_xcc_id() { return (unsigned)__builtin_amdgcn_s_getreg((3 << 11) | 20) & 0xFu; }
#define XB_SPIN(cond, bar) do { unsigned _sp = 0; while (cond) { __builtin_amdgcn_s_sleep(1); \
    if ((++_sp & 255u) == 0u) { if (xb_ld(&(bar)[XB_TMO])) break; if (_sp > XB_SPIN_CAP) { atomicAdd(&(bar)[XB_TMO], 1u); break; } } } } while (0)
struct XcdBarrier { unsigned* bar; unsigned x; volatile LAS unsigned* st; };
__device__ __forceinline__ XcdBarrier xcd_barrier_post(unsigned* bar, volatile LAS unsigned* st) {
    XcdBarrier b; b.bar = bar; b.x = xb_xcc_id(); b.st = st;
    if (threadIdx.x == 0) (void)xb_add(&bar[XB_XCNT(b.x)], 1u);
    return b;
}
__device__ __forceinline__ void xcd_barrier_complete(unsigned* bar, unsigned x, unsigned& nloc, unsigned& nx) {
    const unsigned G = gridDim.x * gridDim.y * gridDim.z;
    unsigned sum, cnt, mine, sp = 0u;
    for (;;) {
        sum = 0u; cnt = 0u; mine = 0u;
#pragma unroll
        for (unsigned j = 0; j < 16; ++j) { const unsigned c = xb_ld(&bar[XB_XCNT(j)]); sum += c; cnt += (c > 0u) ? 1u : 0u; mine = (j == x) ? c : mine; }
        if (sum == G) break;
        __builtin_amdgcn_s_sleep(1);
        if ((++sp & 255u) == 0u) { if (xb_ld(&bar[XB_TMO])) break; if (sp > XB_SPIN_CAP) { atomicAdd(&bar[XB_TMO], 1u); break; } }
    }
    nloc = mine > 0u ? mine : 1u; nx = cnt > 0u ? cnt : 1u;
}
__device__ __forceinline__ void xcd_barrier(const XcdBarrier& b) {
    asm volatile("s_waitcnt vmcnt(0)" ::: "memory");
    __syncthreads();
    if (threadIdx.x == 0) {
        unsigned* bar = b.bar;
        __builtin_amdgcn_s_waitcnt(0);
        unsigned nloc = b.st[0], nx = b.st[1];
        if (nloc == 0u) { xcd_barrier_complete(bar, b.x, nloc, nx); b.st[0] = nloc; b.st[1] = nx; }
        const unsigned old = xb_add(&bar[XB_XSUB(b.x)], 1u);
        const unsigned gen = old / nloc;
        if (old + 1u == (gen + 1u) * nloc) {
            __builtin_amdgcn_fence(__ATOMIC_RELEASE, "agent");
            asm volatile("s_waitcnt vmcnt(0)" ::: "memory");
            const unsigned og = xb_add(&bar[XB_TOP], 1u);
            const unsigned tg = og / nx;
            if (og + 1u == (tg + 1u) * nx) xb_add(&bar[XB_TOPGEN], 1u);
            else XB_SPIN(xb_ld(&bar[XB_TOPGEN]) == tg, bar);
            __builtin_amdgcn_fence(__ATOMIC_ACQUIRE, "agent");
            xb_add(&bar[XB_XGEN(b.x)], 1u);
            asm volatile("s_waitcnt vmcnt(0)" ::: "memory");
        } else {
            XB_SPIN(xb_ld(&bar[XB_XGEN(b.x)]) == gen, bar);
            __builtin_amdgcn_fence(__ATOMIC_ACQUIRE, "agent");
            asm volatile("s_waitcnt vmcnt(0)" ::: "memory");
        }
    }
    __syncthreads();
}

__device__ __forceinline__ bf16x8 frag_kc(const LAS bf16* X, int ld, int mn0, int k0, int lane) { return *(const LAS bf16x8*)(X + (mn0 + (lane & 15)) * ld + k0 + 8 * (lane >> 4)); }
__device__ __forceinline__ bf16x8 gfrag_kc(const bf16* X, int ld, int mn0, int k0, int lane) { return *(const bf16x8*)(X + (size_t)(mn0 + (lane & 15)) * ld + k0 + 8 * (lane >> 4)); }
__device__ __forceinline__ s16x4 trr(const LAS bf16* p) { return __builtin_bit_cast(s16x4, __builtin_amdgcn_ds_read_tr16_b64_v4i16((LAS s16x4*)p)); }
__device__ __forceinline__ bf16x8 frag_ks(const LAS bf16* X, int ld, int mn0, int k0, int lane) {
    const int r = lane & 15, g = lane >> 4;
    const LAS bf16* p = X + (k0 + 8 * g + (r >> 2)) * ld + mn0 + 4 * (r & 3);
    const s16x4 lo = trr(p), hi = trr(p + 4 * ld);
    return (bf16x8){lo[0], lo[1], lo[2], lo[3], hi[0], hi[1], hi[2], hi[3]};
}
#define MFMA16(a, b, c) __builtin_amdgcn_mfma_f32_16x16x32_bf16((a), (b), (c), 0, 0, 0)
__device__ __forceinline__ u32x4 scale8(u32x4 w, float s) {
    u32x4 o;
    o.x = pk2(bf2f(w.x & 0xffffu) * s, bf2f(w.x >> 16) * s); o.y = pk2(bf2f(w.y & 0xffffu) * s, bf2f(w.y >> 16) * s);
    o.z = pk2(bf2f(w.z & 0xffffu) * s, bf2f(w.z >> 16) * s); o.w = pk2(bf2f(w.w & 0xffffu) * s, bf2f(w.w >> 16) * s);
    return o;
}
__device__ __forceinline__ float wscan_add(float v, int lane) {
#pragma unroll
    for (int o = 1; o < 64; o <<= 1) { const float t = __shfl_up(v, o); if (lane >= o) v += t; }
    return v;
}
__device__ __forceinline__ float wscan_max(float v, int lane) {
#pragma unroll
    for (int o = 1; o < 64; o <<= 1) { const float t = __shfl_up(v, o); if (lane >= o) v = fmaxf(v, t); }
    return v;
}

enum { PH_W = 0, PH_N1, PH_INPROJ, PH_M0, PH_M1, PH_M2, PH_M3, PH_ATT, PH_LIFT, PH_OUT, PH_N2, PH_UP, PH_CONVACT, PH_DOWN, PH_FINAL, PH_COUNT };
enum { I_X = 0, I_MIXG, I_WIN, I_AIB, I_AFB, I_ANG, I_BCW, I_CCW, I_CCB, I_CDTB, I_CALOG, I_CDSKIP, I_CNG, I_WLIFT, I_WOUT, I_FFNG, I_WUP, I_FCW, I_FCB, I_WDOWN, I_FING, N_IN };
struct Args { const float* in[N_IN]; float* out; unsigned char* ws; int l_lo, l_hi, g_lo, g_hi, ph_lo, ph_hi, use_bar, pad; };

__device__ __forceinline__ void transpose_item(const float* W, int ldw, int nsrc0, int k0, bf16* WT, int ldt, int ndst0, LAS float* scr, int lane) {
#pragma unroll 8
    for (int i = 0; i < 32; ++i) { const int kk = 2 * i + (lane >> 5); scr[kk * 33 + (lane & 31)] = W[(size_t)(k0 + kk) * ldw + nsrc0 + (lane & 31)]; }
    LDS_WAIT(); asm volatile("" ::: "memory");
    const int c = lane & 7;
#pragma unroll
    for (int j = 0; j < 4; ++j) { const int n = (lane >> 3) + 8 * j; const LAS float* s = scr + (8 * c) * 33 + n;
        u32x4 o; o.x = pk2(s[0 * 33], s[1 * 33]); o.y = pk2(s[2 * 33], s[3 * 33]); o.z = pk2(s[4 * 33], s[5 * 33]); o.w = pk2(s[6 * 33], s[7 * 33]);
        *(u32x4*)(WT + (size_t)(ndst0 + n) * ldt + k0 + 8 * c) = o; }
    LDS_WAIT(); asm volatile("" ::: "memory");
}

__global__ void __launch_bounds__(NTHR, 2) fwd(Args args) {
    extern __shared__ __attribute__((aligned(16))) unsigned char lds_raw[];
    LAS unsigned char* lds = (LAS unsigned char*)lds_raw;
    const int NBLK = gridDim.x, blk = blockIdx.x;
    {
        volatile LAS unsigned* MISC0 = (volatile LAS unsigned*)(lds + MISC_OFF);
        if (threadIdx.x < 16) MISC0[threadIdx.x] = 0u;
        __syncthreads();
    }
    XcdBarrier bar; bar.bar = (unsigned*)(args.ws + WS_CTL) + 4096; bar.x = 0; bar.st = nullptr;
    if (args.use_bar) bar = xcd_barrier_post((unsigned*)(args.ws + WS_CTL) + 4096, (volatile LAS unsigned*)(lds + MISC_OFF) + 8);
#define GRID_BAR() do { if (args.use_bar) xcd_barrier(bar); } while (0)
#ifndef REPMASK
#define REPMASK 0
#endif
#define IN(k) (args.ph_lo <= (k) && (k) < args.ph_hi)
#define REPS(k) for (int rep_ = 0; rep_ < 1 + ((REPMASK >> (k)) & 1); ++rep_)
#define PHASE_BEGIN() int tid = threadIdx.x; asm volatile("" : "+v"(tid)); const int lane = tid & 63, wave = __builtin_amdgcn_readfirstlane(tid >> 6); \
    unsigned char* ws = args.ws; asm volatile("" : "+s"(ws)); \
    const int gw = blk * NWAVES + wave, NGW = NBLK * NWAVES, gt = blk * NTHR + tid, NGT = NBLK * NTHR; (void)lane; (void)gw; (void)NGW; (void)gt; (void)NGT; \
    bf16* const WinT = (bf16*)(ws + WS_WIN); bf16* const WliftT = (bf16*)(ws + WS_WLIFT); bf16* const WoutT = (bf16*)(ws + WS_WOUT); \
    bf16* const WupT = (bf16*)(ws + WS_WUP); bf16* const WdownT = (bf16*)(ws + WS_WDOWN); float* const W16T = (float*)(ws + WS_W16); \
    bf16* const XN = (bf16*)(ws + WS_XN); bf16* const P = (bf16*)(ws + WS_P); bf16* const U = (bf16*)(ws + WS_U); bf16* const ACT = (bf16*)(ws + WS_ACT); \
    bf16* const YCAT = (bf16*)(ws + WS_YCAT); float* const MG = (float*)(ws + WS_MG); bf16* const MB = (bf16*)(ws + WS_MB); float* const SP = (float*)(ws + WS_SP); \
    float* const GBc = (float*)(ws + WS_GB); float* const GGc = (float*)(ws + WS_GG); float* const GMT = (float*)(ws + WS_GMT); \
    float* const MCAR = (float*)(ws + WS_MCAR); float* const MNEW = (float*)(ws + WS_MNEW); float* const MSC = (float*)(ws + WS_MSC); \
    float* const DTB = (float*)(ws + WS_DT); float* const ACB = (float*)(ws + WS_AC); bf16* const XBC = (bf16*)(ws + WS_XBC); \
    float* const DC = (float*)(ws + WS_DC); bf16* const CS = (bf16*)(ws + WS_CS); float* const DH = (float*)(ws + WS_DH); bf16* const HS = (bf16*)(ws + WS_HS); \
    (void)WinT; (void)WliftT; (void)WoutT; (void)WupT; (void)WdownT; (void)W16T; (void)XN; (void)P; (void)U; (void)ACT; (void)YCAT; (void)MG; (void)MB; (void)SP; (void)GBc; (void)GGc; (void)GMT; \
    (void)MCAR; (void)MNEW; (void)MSC; (void)DTB; (void)ACB; (void)XBC; (void)DC; (void)CS; (void)DH; (void)HS

    for (int l = args.l_lo; l < args.l_hi; ++l)
    for (int grp = args.g_lo; grp < args.g_hi; ++grp) {
        const size_t grow0 = (size_t)grp * T;
        const float* xsrc = (l == 0) ? args.in[I_X] : args.out;

        REPS(PH_W) if (IN(PH_W) && grp == 0) {
            PHASE_BEGIN();
            LAS float* scr = (LAS float*)(lds + wave * 16384);
            constexpr int I_IN = 16 * 320, I_LF = 4 * 8 * 32, I_OUT = 16 * 32, I_UP = 16 * 176, I_DN = 44 * 32, NIT = I_IN + I_LF + I_OUT + I_UP + I_DN;
            for (int it = gw; it < NIT; it += NGW) {
                int r = it;
                if (r < I_IN) { const int kb = r / 320, nb = r % 320, n0 = 32 * nb, ns = n0 + (n0 >= P_SQ ? 16 : (n0 >= P_BB ? 8 : 0));
                    transpose_item(args.in[I_WIN] + (size_t)l * DM * PIN, PIN, ns, 64 * kb, WinT, DM, n0, scr, lane); continue; } r -= I_IN;
                if (r < I_LF) { const int br = r / 256, q = r % 256, kb = q / 32, nb = q % 32;
                    transpose_item(args.in[I_WLIFT] + (size_t)(l * 4 + br) * 512 * DM, DM, 32 * nb, 64 * kb, WliftT + (size_t)br * DM * 512, 512, 32 * nb, scr, lane); continue; } r -= I_LF;
                if (r < I_OUT) { const int kb = r / 32, nb = r % 32;
                    transpose_item(args.in[I_WOUT] + (size_t)l * DM * DM, DM, 32 * nb, 64 * kb, WoutT, DM, 32 * nb, scr, lane); continue; } r -= I_OUT;
                if (r < I_UP) { const int kb = r / 176, nb = r % 176;
                    transpose_item(args.in[I_WUP] + (size_t)l * DM * DFF2, DFF2, 32 * nb, 64 * kb, WupT, DM, 32 * nb, scr, lane); continue; } r -= I_UP;
                { const int kb = r / 32, nb = r % 32;
                    transpose_item(args.in[I_WDOWN] + (size_t)l * DFF * DM, DM, 32 * nb, 64 * kb, WdownT, DFF, 32 * nb, scr, lane); }
            }
            for (int i = gt; i < 16 * DM; i += NGT) { const int c = i >> 10, k = i & 1023; const int oc = (c < 8) ? (1536 + c) : (4616 + (c - 8));
                W16T[i] = args.in[I_WIN][(size_t)l * DM * PIN + (size_t)k * PIN + oc]; }
            GRID_BAR();
        }

        REPS(PH_N1) if (IN(PH_N1)) {
            PHASE_BEGIN();
            LAS float* W16s = (LAS float*)lds;
            for (int i = tid; i < 16 * DM / 4; i += NTHR) ((LAS f32x4*)W16s)[i] = ((const f32x4*)W16T)[i];
            __syncthreads();
            const float* gain = args.in[I_MIXG] + (size_t)l * DM;
            f32x4 gv[4];
#pragma unroll
            for (int j = 0; j < 4; ++j) gv[j] = ((const f32x4*)gain)[lane + 64 * j];
            for (int m = gw; m < T; m += NGW) {
                const f32x4* xr = (const f32x4*)(xsrc + (grow0 + m) * DM) + lane;
                f32x4 v[4]; float s = 0.f;
#pragma unroll
                for (int j = 0; j < 4; ++j) { v[j] = xr[64 * j]; s += (v[j].x * v[j].x + v[j].y * v[j].y) + (v[j].z * v[j].z + v[j].w * v[j].w); }
                const float rstd = rsqrtf(wave_sum(s) * (1.f / DM) + EPS);
#pragma unroll
                for (int j = 0; j < 4; ++j) v[j] = v[j] * rstd * gv[j];
                u32x2* o8 = (u32x2*)(XN + (size_t)m * DM) + lane;
#pragma unroll
                for (int j = 0; j < 4; ++j) o8[64 * j] = (u32x2){pk2(v[j].x, v[j].y), pk2(v[j].z, v[j].w)};
                float mine = 0.f;
#pragma unroll 1
                for (int c = 0; c < 16; ++c) { float p = 0.f;
#pragma unroll
                    for (int j = 0; j < 4; ++j) { const f32x4 w = ((const LAS f32x4*)(W16s + c * DM))[lane + 64 * j]; p += (v[j].x * w.x + v[j].y * w.y) + (v[j].z * w.z + v[j].w * w.w); }
                    p = wave_sum(p); if (lane == c) mine = p; }
                if (lane < 16) SP[(size_t)m * 16 + lane] = mine;
            }
            GRID_BAR();
        }

        REPS(PH_INPROJ) if (IN(PH_INPROJ)) {
            PHASE_BEGIN();
            pg8::Gemm g{XN, WinT, DM, DM, DM, 0, 0}; pg8::Order S; S.init(T, PW, NBLK, blk, 1);
            pg8::EpiBf16 E{P, PW};
            pg8::gemm_phase<pg8::EpiBf16>(lds, g, S, E);
            GRID_BAR();
        }

        REPS(PH_M0) if (IN(PH_M0)) {
            PHASE_BEGIN();
            for (int task = gw; task < GB * 4; task += NGW) {
                const int bl = task >> 2, h = task & 3; float mcar = 0.f;
                const float igb = args.in[I_AIB][l * 4 + h], fgb = args.in[I_AFB][l * 4 + h];
                for (int c = 0; c < NCH; ++c) {
                    const size_t m = (size_t)bl * SEQ + c * 64 + lane;
                    const float ig = SP[m * 16 + h] + igb, fg = SP[m * 16 + 4 + h] + fgb;
                    const float b = wscan_add(logsigf_(fg), lane);
                    const float gg = ig - b;
                    const float pm = wscan_max(gg, lane);
                    GBc[m * 4 + h] = b; GGc[m * 4 + h] = gg; GMT[m * 4 + h] = b + fmaxf(mcar, pm);
                    const float bL = __shfl(b, 63), gmax = __shfl(pm, 63);
                    const float mnew = bL + fmaxf(mcar, gmax);
                    if (lane == 0) { MCAR[task * NCH + c] = mcar; MNEW[task * NCH + c] = mnew; MSC[task * NCH + c] = __expf(bL + mcar - mnew); }
                    mcar = mnew;
                }
            }
            for (int task = gw; task < GB * NCH; task += NGW) {
                const size_t m = (size_t)task * 64 + lane;
#pragma unroll
                for (int hd = 0; hd < 8; ++hd) {
                    const float dt = softplusf_(SP[m * 16 + 8 + hd] + args.in[I_CDTB][l * 8 + hd]);
                    const float a = wscan_add(-dt * __expf(args.in[I_CALOG][l * 8 + hd]), lane);
                    DTB[m * 8 + hd] = dt; ACB[m * 8 + hd] = a;
                }
            }
            {
                const float* cw = args.in[I_CCW] + (size_t)l * 4 * 1024; const float* cb = args.in[I_CCB] + (size_t)l * 1024;
                for (int i = gt; i < T * 128; i += NGT) {
                    const int m = i >> 7, c8 = (i & 127) * 8, t = m & (SEQ - 1);
                    float acc[8];
#pragma unroll
                    for (int e = 0; e < 8; ++e) acc[e] = cb[c8 + e];
#pragma unroll
                    for (int j = 0; j < 4; ++j) { if (t - 3 + j >= 0) { const u32x4 w = *(const u32x4*)(P + (size_t)(m - 3 + j) * PW + P_CX + c8); const float* cwj = cw + j * 1024 + c8;
                        acc[0] += cwj[0] * bf2f(w.x & 0xffffu); acc[1] += cwj[1] * bf2f(w.x >> 16); acc[2] += cwj[2] * bf2f(w.y & 0xffffu); acc[3] += cwj[3] * bf2f(w.y >> 16);
                        acc[4] += cwj[4] * bf2f(w.z & 0xffffu); acc[5] += cwj[5] * bf2f(w.z >> 16); acc[6] += cwj[6] * bf2f(w.w & 0xffffu); acc[7] += cwj[7] * bf2f(w.w >> 16); } }
                    u32x4 o; o.x = pk2(siluf_(acc[0]), siluf_(acc[1])); o.y = pk2(siluf_(acc[2]), siluf_(acc[3])); o.z = pk2(siluf_(acc[4]), siluf_(acc[5])); o.w = pk2(siluf_(acc[6]), siluf_(acc[7]));
                    *(u32x4*)(XBC + (size_t)m * 1024 + c8) = o;
                }
            }
            {
                const float* bw = args.in[I_BCW] + (size_t)l * 3 * 512;
                for (int i = gt; i < T * 64; i += NGT) {
                    const int m = i >> 6, c8 = (i & 63) * 8, t = m & (SEQ - 1);
                    float acc[8];
#pragma unroll
                    for (int e = 0; e < 8; ++e) acc[e] = 0.f;
#pragma unroll
                    for (int j = 0; j < 3; ++j) { if (t - 2 + j >= 0) { const bf16* pr = P + (size_t)(m - 2 + j) * PW; const u32x4 a = *(const u32x4*)(pr + P_BC + c8), b = *(const u32x4*)(pr + P_BX + c8); const float* wj = bw + j * 512 + c8;
                        acc[0] += wj[0] * bf2f(a.x & 0xffffu) * bf2f(b.x & 0xffffu); acc[1] += wj[1] * bf2f(a.x >> 16) * bf2f(b.x >> 16);
                        acc[2] += wj[2] * bf2f(a.y & 0xffffu) * bf2f(b.y & 0xffffu); acc[3] += wj[3] * bf2f(a.y >> 16) * bf2f(b.y >> 16);
                        acc[4] += wj[4] * bf2f(a.z & 0xffffu) * bf2f(b.z & 0xffffu); acc[5] += wj[5] * bf2f(a.z >> 16) * bf2f(b.z >> 16);
                        acc[6] += wj[6] * bf2f(a.w & 0xffffu) * bf2f(b.w & 0xffffu); acc[7] += wj[7] * bf2f(a.w >> 16) * bf2f(b.w >> 16); } }
                    const u32x4 g = *(const u32x4*)(P + (size_t)m * PW + P_BB + c8);
                    u32x4 o; o.x = pk2(acc[0] * bf2f(g.x & 0xffffu), acc[1] * bf2f(g.x >> 16)); o.y = pk2(acc[2] * bf2f(g.y & 0xffffu), acc[3] * bf2f(g.y >> 16));
                    o.z = pk2(acc[4] * bf2f(g.z & 0xffffu), acc[5] * bf2f(g.z >> 16)); o.w = pk2(acc[6] * bf2f(g.w & 0xffffu), acc[7] * bf2f(g.w >> 16));
                    *(u32x4*)(YCAT + (size_t)m * YW + 512 + c8) = o;
                }
            }
            GRID_BAR();
        }

        REPS(PH_M1) if (IN(PH_M1)) {
            PHASE_BEGIN();
            constexpr int NUA = GB * 4 * NCH, NUC = GB * NCH;
            for (int u = blk; u < NUA + NUC; u += NBLK) {
                if (u < NUA) {
                    const int ua = u, bh = ua >> 5, c = ua & 31, bl = bh >> 2, h = bh & 3; const size_t m0 = (size_t)bl * SEQ + c * 64;
                    LAS bf16* VP = (LAS bf16*)lds; LAS bf16* WK = (LAS bf16*)(lds + 64 * 152 * 2);
                    const float bL = GBc[(m0 + 63) * 4 + h], mnew = MNEW[ua];
                    for (int i = tid; i < 1024; i += NTHR) { const int s = i >> 4, c8 = i & 15; *(LAS u32x4*)(VP + s * 152 + c8 * 8) = *(const u32x4*)(P + (m0 + s) * PW + P_AV + h * 128 + c8 * 8); }
                    if (tid < 64) { *(LAS u32x4*)(VP + tid * 152 + 128) = (u32x4){0x3F80u, 0u, 0u, 0u}; *(LAS u32x4*)(VP + tid * 152 + 136) = (u32x4){0u, 0u, 0u, 0u}; }
                    { const int s = tid >> 3, c8 = tid & 7; const float w = __expf(bL + GGc[(m0 + s) * 4 + h] - mnew);
                      *(LAS u32x4*)(WK + s * 72 + c8 * 8) = scale8(*(const u32x4*)(P + (m0 + s) * PW + P_AK + h * 64 + c8 * 8), w); }
                    __syncthreads();
                    for (int ti = wave; ti < 36; ti += NWAVES) { const int mt = ti >> 2, nt = ti & 3; f32x4 acc = {0.f, 0.f, 0.f, 0.f};
#pragma unroll
                        for (int ks = 0; ks < 2; ++ks) acc = MFMA16(frag_ks(VP, 152, 16 * mt, 32 * ks, lane), frag_ks(WK, 72, 16 * nt, 32 * ks, lane), acc);
                        float* d = DC + (size_t)ua * 9216 + (16 * mt + 4 * (lane >> 4)) * 64 + 16 * nt + (lane & 15);
#pragma unroll
                        for (int i = 0; i < 4; ++i) d[i * 64] = acc[i]; }
                    __syncthreads();
                } else {
                    const int uc = u - NUA, bl = uc >> 5, c = uc & 31, hd = wave, gi = hd >> 2; const size_t m0 = (size_t)bl * SEQ + c * 64;
                    LAS bf16* XW = (LAS bf16*)(lds + hd * (64 * 72 * 2)); LAS bf16* BMs = (LAS bf16*)(lds + 8 * 64 * 72 * 2);
                    const float alast = ACB[(m0 + 63) * 8 + hd];
#pragma unroll
                    for (int k = 0; k < 8; ++k) { const int i = lane + 64 * k, s = i >> 3, c8 = i & 7; const float wd = __expf(alast - ACB[(m0 + s) * 8 + hd]) * DTB[(m0 + s) * 8 + hd];
                        *(LAS u32x4*)(XW + s * 72 + c8 * 8) = scale8(*(const u32x4*)(XBC + (m0 + s) * 1024 + hd * 64 + c8 * 8), wd); }
                    for (int i = tid; i < 2048; i += NTHR) { const int g2 = i >> 10, rem = i & 1023, s = rem >> 4, c8 = rem & 15;
                        *(LAS u32x4*)(BMs + g2 * (64 * 136) + s * 136 + c8 * 8) = *(const u32x4*)(XBC + (m0 + s) * 1024 + 512 + g2 * 128 + c8 * 8); }
                    __syncthreads();
                    const LAS bf16* BMg = BMs + gi * (64 * 136);
                    for (int pt = 0; pt < 4; ++pt) { f32x4 acc[8];
#pragma unroll
                        for (int n = 0; n < 8; ++n) acc[n] = (f32x4){0.f, 0.f, 0.f, 0.f};
#pragma unroll
                        for (int ks = 0; ks < 2; ++ks) { const bf16x8 a = frag_ks(XW, 72, 16 * pt, 32 * ks, lane);
#pragma unroll
                            for (int n = 0; n < 8; ++n) acc[n] = MFMA16(a, frag_ks(BMg, 136, 16 * n, 32 * ks, lane), acc[n]); }
                        float* d = DH + ((size_t)(uc * 8 + hd) * 64 + 16 * pt + 4 * (lane >> 4)) * 128 + (lane & 15);
#pragma unroll
                        for (int n = 0; n < 8; ++n)
#pragma unroll
                            for (int i = 0; i < 4; ++i) d[i * 128 + 16 * n] = acc[n][i]; }
                    __syncthreads();
                }
            }
            GRID_BAR();
        }

        REPS(PH_M2) if (IN(PH_M2)) {
            PHASE_BEGIN();
            constexpr int NA = GB * 4 * 2304, NC = GB * 8 * 2048;
            for (int i = gt; i < NA + NC; i += NGT) {
                f32x4 st = {0.f, 0.f, 0.f, 0.f};
                if (i < NA) { const int bh = i / 2304, e = (i - bh * 2304) * 4;
                    for (int c = 0; c < NCH; ++c) { const size_t ua = (size_t)bh * NCH + c;
                        *(u32x2*)(CS + ua * 9216 + e) = (u32x2){pk2(st.x, st.y), pk2(st.z, st.w)};
                        st = st * MSC[ua] + *(const f32x4*)(DC + ua * 9216 + e); }
                } else { const int j = i - NA, bhd = j >> 11, e = (j & 2047) * 4, bl = bhd >> 3, hd = bhd & 7;
                    for (int c = 0; c < NCH; ++c) { const size_t uh = (size_t)(bl * NCH + c) * 8 + hd;
                        *(u32x2*)(HS + uh * 8192 + e) = (u32x2){pk2(st.x, st.y), pk2(st.z, st.w)};
                        st = st * __expf(ACB[((size_t)bl * SEQ + c * 64 + 63) * 8 + hd]) + *(const f32x4*)(DH + uh * 8192 + e); }
                }
            }
            GRID_BAR();
        }

        REPS(PH_M3) if (IN(PH_M3)) {
            PHASE_BEGIN();
            constexpr int NUA = GB * 4 * NCH, NUC = GB * NCH;
            for (int u = blk; u < NUA + NUC; u += NBLK) {
                const int r = lane & 15, g4 = lane >> 4;
                if (u < NUA) {
                    const int ua = u, bh = ua >> 5, c = ua & 31, bl = bh >> 2, h = bh & 3; const size_t m0 = (size_t)bl * SEQ + c * 64;
                    LAS bf16* Qs = (LAS bf16*)lds; LAS bf16* Ks = Qs + 64 * 72; LAS bf16* VP = Ks + 64 * 72; LAS bf16* CST = VP + 64 * 152; LAS bf16* SMT = CST + 144 * 72;
                    LAS float* SSQ = (LAS float*)(SMT + 64 * 72);
                    { const int s = tid >> 3, c8 = tid & 7; const bf16* pr = P + (m0 + s) * PW + h * 64 + c8 * 8;
                      *(LAS u32x4*)(Qs + s * 72 + c8 * 8) = *(const u32x4*)(pr + P_AQ); *(LAS u32x4*)(Ks + s * 72 + c8 * 8) = *(const u32x4*)(pr + P_AK); }
                    for (int i = tid; i < 1024; i += NTHR) { const int s = i >> 4, c8 = i & 15; *(LAS u32x4*)(VP + s * 152 + c8 * 8) = *(const u32x4*)(P + (m0 + s) * PW + P_AV + h * 128 + c8 * 8); }
                    if (tid < 64) { *(LAS u32x4*)(VP + tid * 152 + 128) = (u32x4){0x3F80u, 0u, 0u, 0u}; *(LAS u32x4*)(VP + tid * 152 + 136) = (u32x4){0u, 0u, 0u, 0u}; }
                    for (int i = tid; i < 1152; i += NTHR) { const int dv = i >> 3, c8 = i & 7; *(LAS u32x4*)(CST + dv * 72 + c8 * 8) = *(const u32x4*)(CS + (size_t)ua * 9216 + dv * 64 + c8 * 8); }
                    __syncthreads();
#pragma unroll
                    for (int q2 = 0; q2 < 2; ++q2) { const int ti = 2 * wave + q2, tt = ti >> 2, st = ti & 3;
                        f32x4 acc = {0.f, 0.f, 0.f, 0.f};
                        if (st <= tt) {
#pragma unroll
                            for (int ks = 0; ks < 2; ++ks) acc = MFMA16(frag_kc(Qs, 72, 16 * tt, 32 * ks, lane), frag_kc(Ks, 72, 16 * st, 32 * ks, lane), acc);
                            const int s = 16 * st + r; const float gs = GGc[(m0 + s) * 4 + h];
#pragma unroll
                            for (int i = 0; i < 4; ++i) { const int t = 16 * tt + 4 * g4 + i; const float e = GBc[(m0 + t) * 4 + h] - GMT[(m0 + t) * 4 + h] + gs;
                                acc[i] = (s <= t) ? acc[i] * 0.125f * __expf(e) : 0.f; }
                        }
                        *(LAS u32x2*)(SMT + (16 * st + r) * 72 + 16 * tt + 4 * g4) = (u32x2){pk2(acc[0], acc[1]), pk2(acc[2], acc[3])}; }
                    __syncthreads();
                    const int tt = wave & 3, half = wave >> 2;
                    f32x4 a1[5], a2[5];
#pragma unroll
                    for (int j = 0; j < 5; ++j) { a1[j] = (f32x4){0.f, 0.f, 0.f, 0.f}; a2[j] = (f32x4){0.f, 0.f, 0.f, 0.f}; }
#pragma unroll
                    for (int ks = 0; ks < 2; ++ks) { const bf16x8 fa1 = frag_ks(SMT, 72, 16 * tt, 32 * ks, lane), fa2 = frag_kc(Qs, 72, 16 * tt, 32 * ks, lane);
#pragma unroll
                        for (int j = 0; j < 5; ++j) { const int dvt = (j < 4) ? half * 4 + j : 8;
                            a1[j] = MFMA16(fa1, frag_ks(VP, 152, 16 * dvt, 32 * ks, lane), a1[j]);
                            a2[j] = MFMA16(fa2, frag_kc(CST, 72, 16 * dvt, 32 * ks, lane), a2[j]); } }
                    float hv[4][4], ssq[4]; const float mcar = MCAR[ua];
#pragma unroll
                    for (int i = 0; i < 4; ++i) { const int t = 16 * tt + 4 * g4 + i; const float b = GBc[(m0 + t) * 4 + h], mt = GMT[(m0 + t) * 4 + h];
                        const float is = 0.125f * __expf(b + mcar - mt);
                        float den = a1[4][i] + is * a2[4][i]; den = __shfl(den, lane & 48);
                        const float dn = fmaxf(fabsf(den), __expf(-mt)); float q = 0.f;
#pragma unroll
                        for (int j = 0; j < 4; ++j) { const float v = (a1[j][i] + is * a2[j][i]) / dn; hv[j][i] = v; q += v * v; }
                        q += __shfl_xor(q, 1); q += __shfl_xor(q, 2); q += __shfl_xor(q, 4); q += __shfl_xor(q, 8); ssq[i] = q; }
                    if (r == 0) {
#pragma unroll
                        for (int i = 0; i < 4; ++i) SSQ[half * 64 + 16 * tt + 4 * g4 + i] = ssq[i]; }
                    __syncthreads();
                    const float* ng = args.in[I_ANG] + (size_t)l * 512 + h * 128;
#pragma unroll
                    for (int i = 0; i < 4; ++i) { const int t = 16 * tt + 4 * g4 + i; const float rstd = rsqrtf((SSQ[t] + SSQ[64 + t]) * (1.f / 128.f) + EPS);
#pragma unroll
                        for (int j = 0; j < 4; ++j) { const int dv = 16 * (half * 4 + j) + r; const float o = bf2f(P[(m0 + t) * PW + P_AO + h * 128 + dv]);
                            YCAT[(m0 + t) * YW + h * 128 + dv] = (bf16)f2bf(sigmoidf_(o) * hv[j][i] * rstd * ng[dv]); } }
                    __syncthreads();
                } else {
                    const int uc = u - NUA, bl = uc >> 5, c = uc & 31, hd = wave, gi = hd >> 2; const size_t m0 = (size_t)bl * SEQ + c * 64;
                    LAS bf16* XH = (LAS bf16*)(lds + hd * (64 * 72 * 2)); LAS bf16* MT = (LAS bf16*)(lds + (8 + hd) * (64 * 72 * 2));
                    LAS float* SSQ = (LAS float*)(lds + 16 * (64 * 72 * 2));
#pragma unroll
                    for (int k = 0; k < 8; ++k) { const int i = lane + 64 * k, s = i >> 3, c8 = i & 7; *(LAS u32x4*)(XH + s * 72 + c8 * 8) = *(const u32x4*)(XBC + (m0 + s) * 1024 + hd * 64 + c8 * 8); }
                    const bf16* Cm = XBC + m0 * 1024 + 768 + gi * 128; const bf16* Bm = XBC + m0 * 1024 + 512 + gi * 128;
                    const bf16* Hst = HS + (size_t)(uc * 8 + hd) * 8192;
                    for (int tt = 0; tt < 4; ++tt) { bf16x8 fc[4];
#pragma unroll
                        for (int ks = 0; ks < 4; ++ks) fc[ks] = gfrag_kc(Cm, 1024, 16 * tt, 32 * ks, lane);
                        float at[4];
#pragma unroll
                        for (int i = 0; i < 4; ++i) at[i] = ACB[(m0 + 16 * tt + 4 * g4 + i) * 8 + hd];
                        for (int st = 0; st < 4; ++st) { f32x4 acc = {0.f, 0.f, 0.f, 0.f};
                            if (st <= tt) {
#pragma unroll
                                for (int ks = 0; ks < 4; ++ks) acc = MFMA16(fc[ks], gfrag_kc(Bm, 1024, 16 * st, 32 * ks, lane), acc);
                                const int s = 16 * st + r; const float as = ACB[(m0 + s) * 8 + hd], dts = DTB[(m0 + s) * 8 + hd];
#pragma unroll
                                for (int i = 0; i < 4; ++i) { const int t = 16 * tt + 4 * g4 + i; acc[i] = (s <= t) ? acc[i] * __expf(at[i] - as) * dts : 0.f; }
                            }
                            *(LAS u32x2*)(MT + (16 * st + r) * 72 + 16 * tt + 4 * g4) = (u32x2){pk2(acc[0], acc[1]), pk2(acc[2], acc[3])}; } }
                    __syncthreads();
                    const float dsk = args.in[I_CDSKIP][l * 8 + hd];
                    for (int tt = 0; tt < 4; ++tt) { f32x4 ad[4], ao[4];
#pragma unroll
                        for (int p = 0; p < 4; ++p) { ad[p] = (f32x4){0.f, 0.f, 0.f, 0.f}; ao[p] = (f32x4){0.f, 0.f, 0.f, 0.f}; }
#pragma unroll
                        for (int ks = 0; ks < 2; ++ks) { const bf16x8 fa = frag_ks(MT, 72, 16 * tt, 32 * ks, lane);
#pragma unroll
                            for (int p = 0; p < 4; ++p) ad[p] = MFMA16(fa, frag_ks(XH, 72, 16 * p, 32 * ks, lane), ad[p]); }
#pragma unroll
                        for (int ks = 0; ks < 4; ++ks) { const bf16x8 fa = gfrag_kc(Cm, 1024, 16 * tt, 32 * ks, lane);
#pragma unroll
                            for (int p = 0; p < 4; ++p) ao[p] = MFMA16(fa, gfrag_kc(Hst, 128, 16 * p, 32 * ks, lane), ao[p]); }
                        float ssq[4];
#pragma unroll
                        for (int i = 0; i < 4; ++i) { const int t = 16 * tt + 4 * g4 + i; const float ea = __expf(ACB[(m0 + t) * 8 + hd]); float q = 0.f;
#pragma unroll
                            for (int p = 0; p < 4; ++p) { const int pc = 16 * p + r; const float xv = bf2f(XH[t * 72 + pc]); const float z = bf2f(P[(m0 + t) * PW + P_CZ + hd * 64 + pc]);
                                const float y = (ad[p][i] + ea * ao[p][i] + dsk * xv) * siluf_(z); q += y * y;
                                YCAT[(m0 + t) * YW + 1024 + hd * 64 + pc] = (bf16)f2bf(y); }
                            q += __shfl_xor(q, 1); q += __shfl_xor(q, 2); q += __shfl_xor(q, 4); q += __shfl_xor(q, 8); ssq[i] = q; }
                        if (r == 0) {
#pragma unroll
                            for (int i = 0; i < 4; ++i) SSQ[hd * 64 + 16 * tt + 4 * g4 + i] = ssq[i]; } }
                    __syncthreads();
                    const float* ng = args.in[I_CNG] + (size_t)l * 512 + hd * 64;
                    for (int tt = 0; tt < 4; ++tt)
#pragma unroll
                        for (int i = 0; i < 4; ++i) { const int t = 16 * tt + 4 * g4 + i; float q = 0.f;
#pragma unroll
                            for (int w8 = 0; w8 < 8; ++w8) q += SSQ[w8 * 64 + t];
                            const float rstd = rsqrtf(q * (1.f / 512.f) + EPS);
#pragma unroll
                            for (int p = 0; p < 4; ++p) { const int pc = 16 * p + r; bf16* yp = YCAT + (m0 + t) * YW + 1024 + hd * 64 + pc; *yp = (bf16)f2bf(bf2f(*yp) * rstd * ng[pc]); } }
                    __syncthreads();
                }
            }
            GRID_BAR();
        }

        REPS(PH_ATT) if (IN(PH_ATT)) {
            PHASE_BEGIN();
            LAS bf16* Qs = (LAS bf16*)lds; LAS bf16* Ks = Qs + 128 * 136; LAS bf16* Vs = Ks + 64 * 136; LAS bf16* Aw = Vs + 64 * 136 + wave * (16 * 72);
            const int r = lane & 15, g4 = lane >> 4;
            for (int u = blk; u < GB * 4 * 16; u += NBLK) {
                const int bl = u >> 6, h = (u >> 4) & 3, qt = u & 15; const size_t mb = (size_t)bl * SEQ; const int q0 = qt * 128;
                __syncthreads();
                for (int i = tid; i < 2048; i += NTHR) { const int s = i >> 4, c8 = i & 15; *(LAS u32x4*)(Qs + s * 136 + c8 * 8) = *(const u32x4*)(P + (mb + q0 + s) * PW + P_SQ + h * 128 + c8 * 8); }
                f32x4 O[8];
#pragma unroll
                for (int d = 0; d < 8; ++d) O[d] = (f32x4){0.f, 0.f, 0.f, 0.f};
                float racc = 0.f; const int tq = q0 + 16 * wave + r;
                for (int kt = 2 * qt + 1; kt >= 0; --kt) {
                    const int s0 = kt * 64;
                    if (__syncthreads_and(racc < -104.f)) break;
                    for (int i = tid; i < 1024; i += NTHR) { const int s = i >> 4, c8 = i & 15; const bf16* pr = P + (mb + s0 + s) * PW + h * 128 + c8 * 8;
                        *(LAS u32x4*)(Ks + s * 136 + c8 * 8) = *(const u32x4*)(pr + P_SK); *(LAS u32x4*)(Vs + s * 136 + c8 * 8) = *(const u32x4*)(pr + P_SV); }
                    __syncthreads();
                    if (s0 < q0 + 16 * wave + 15) {
                        f32x4 z[4];
#pragma unroll
                        for (int j = 0; j < 4; ++j) z[j] = (f32x4){0.f, 0.f, 0.f, 0.f};
#pragma unroll
                        for (int ks = 0; ks < 4; ++ks) { const bf16x8 fq = frag_kc(Qs, 136, 16 * wave, 32 * ks, lane);
#pragma unroll
                            for (int j = 0; j < 4; ++j) z[j] = MFMA16(frag_kc(Ks, 136, 16 * j, 32 * ks, lane), fq, z[j]); }
                        float ls[4][4], x[4][4], tsum[4];
#pragma unroll
                        for (int j = 0; j < 4; ++j) { float tj = 0.f;
#pragma unroll
                            for (int i = 0; i < 4; ++i) { const int s = s0 + 16 * j + 4 * g4 + i; const float zz = z[j][i] * 0.08838834764831845f;
                                const float l1 = fminf(zz, 0.f) - __logf(1.f + __expf(-fabsf(zz)));
                                ls[j][i] = l1; x[j][i] = (s < tq) ? (l1 - zz) : 0.f; tj += x[j][i]; }
                            tsum[j] = tj; }
                        float above[4], tot[4];
#pragma unroll
                        for (int j = 0; j < 4; ++j) { const float y1 = __shfl_xor(tsum[j], 16), y2 = __shfl_xor(tsum[j], 32), y3 = __shfl_xor(tsum[j], 48);
                            tot[j] = tsum[j] + y1 + y2 + y3;
                            above[j] = (g4 == 0) ? (y1 + y2 + y3) : (g4 == 1) ? (y2 + y3) : (g4 == 2) ? y1 : 0.f; }
                        float hi = racc;
#pragma unroll
                        for (int j = 3; j >= 0; --j) { float run = hi + above[j]; float av[4];
#pragma unroll
                            for (int i = 3; i >= 0; --i) { const int s = s0 + 16 * j + 4 * g4 + i; av[i] = (s < tq) ? __expf(ls[j][i] + run) : 0.f; run += x[j][i]; }
                            *(LAS u32x2*)(Aw + r * 72 + 16 * j + 4 * g4) = (u32x2){pk2(av[0], av[1]), pk2(av[2], av[3])};
                            hi += tot[j]; }
                        racc = hi;
                        LDS_WAIT(); asm volatile("" ::: "memory");
#pragma unroll
                        for (int ks = 0; ks < 2; ++ks) { const bf16x8 fa = frag_kc(Aw, 72, 0, 32 * ks, lane);
#pragma unroll
                            for (int d = 0; d < 8; ++d) O[d] = MFMA16(fa, frag_ks(Vs, 136, 16 * d, 32 * ks, lane), O[d]); }
                    }
                }
#pragma unroll
                for (int d = 0; d < 8; ++d)
#pragma unroll
                    for (int i = 0; i < 4; ++i) YCAT[(mb + q0 + 16 * wave + 4 * g4 + i) * YW + 1536 + h * 128 + 16 * d + r] = (bf16)f2bf(O[d][i]);
            }
            GRID_BAR();
        }

        REPS(PH_LIFT) if (IN(PH_LIFT)) {
            PHASE_BEGIN();
            pg8::Gemm g{YCAT, WliftT, 512, YW, 512, (size_t)512 * 2, (size_t)DM * 512 * 2}; pg8::Order S; S.init(T, DM, NBLK, blk, 4);
            pg8::EpiLift E{P + P_G, PW, MB, DM};
            pg8::gemm_phase<pg8::EpiLift>(lds, g, S, E);
            GRID_BAR();
        }
        REPS(PH_OUT) if (IN(PH_OUT)) {
            PHASE_BEGIN();
            pg8::Gemm g{MB, WoutT, DM, DM, DM, 0, 0}; pg8::Order S; S.init(T, DM, NBLK, blk, 1);
            pg8::EpiResid E{xsrc + grow0 * DM, args.out + grow0 * DM, DM};
            pg8::gemm_phase<pg8::EpiResid>(lds, g, S, E);
            GRID_BAR();
        }
        REPS(PH_N2) if (IN(PH_N2)) {
            PHASE_BEGIN();
            const float* gain = args.in[I_FFNG] + (size_t)l * DM;
            f32x4 gv[4];
#pragma unroll
            for (int j = 0; j < 4; ++j) gv[j] = ((const f32x4*)gain)[lane + 64 * j];
            for (int m = gw; m < T; m += NGW) {
                const f32x4* xr = (const f32x4*)(args.out + (grow0 + m) * DM) + lane;
                f32x4 v[4]; float s = 0.f;
#pragma unroll
                for (int j = 0; j < 4; ++j) { v[j] = xr[64 * j]; s += (v[j].x * v[j].x + v[j].y * v[j].y) + (v[j].z * v[j].z + v[j].w * v[j].w); }
                const float rstd = rsqrtf(wave_sum(s) * (1.f / DM) + EPS);
                u32x2* o8 = (u32x2*)(XN + (size_t)m * DM) + lane;
#pragma unroll
                for (int j = 0; j < 4; ++j) { const f32x4 y = v[j] * rstd * gv[j]; o8[64 * j] = (u32x2){pk2(y.x, y.y), pk2(y.z, y.w)}; }
            }
            GRID_BAR();
        }
        REPS(PH_UP) if (IN(PH_UP)) {
            PHASE_BEGIN();
            pg8::Gemm g{XN, WupT, DM, DM, DM, 0, 0}; pg8::Order S; S.init(T, DFF2, NBLK, blk, 1);
            pg8::EpiBf16 E{U, DFF2};
            pg8::gemm_phase<pg8::EpiBf16>(lds, g, S, E);
            GRID_BAR();
        }
        REPS(PH_CONVACT) if (IN(PH_CONVACT)) {
            PHASE_BEGIN();
            const float* fw = args.in[I_FCW] + (size_t)l * 3 * DFF2; const float* fb = args.in[I_FCB] + (size_t)l * DFF2;
            constexpr int RUN = 16, NCC = DFF / 8;
            for (int i = gt; i < (T / RUN) * NCC; i += NGT) {
                const int rb = i / NCC, c8 = (i - rb * NCC) * 8, m0 = rb * RUN, t0 = m0 & (SEQ - 1);
                float wg[3][8], wu[3][8], bg[8], bu[8];
#pragma unroll
                for (int e = 0; e < 8; ++e) { bg[e] = fb[c8 + e]; bu[e] = fb[DFF + c8 + e];
#pragma unroll
                    for (int j = 0; j < 3; ++j) { wg[j][e] = fw[j * DFF2 + c8 + e]; wu[j][e] = fw[j * DFF2 + DFF + c8 + e]; } }
                u32x4 ga[3], ua[3];
                const u32x4 zz = {0u, 0u, 0u, 0u};
                ga[0] = zz; ua[0] = zz; ga[1] = zz; ua[1] = zz;
                if (t0 >= 2) { const bf16* ur = U + (size_t)(m0 - 2) * DFF2 + c8; ga[0] = *(const u32x4*)ur; ua[0] = *(const u32x4*)(ur + DFF); ga[1] = *(const u32x4*)(ur + DFF2); ua[1] = *(const u32x4*)(ur + DFF2 + DFF); }
#pragma unroll 4
                for (int rr = 0; rr < RUN; ++rr) {
                    const bf16* ur = U + (size_t)(m0 + rr) * DFF2 + c8; ga[2] = *(const u32x4*)ur; ua[2] = *(const u32x4*)(ur + DFF);
                    float ag[8], au[8];
#pragma unroll
                    for (int e = 0; e < 8; ++e) { ag[e] = bg[e]; au[e] = bu[e]; }
#pragma unroll
                    for (int j = 0; j < 3; ++j) {
                        ag[0] += wg[j][0] * bf2f(ga[j].x & 0xffffu); ag[1] += wg[j][1] * bf2f(ga[j].x >> 16); ag[2] += wg[j][2] * bf2f(ga[j].y & 0xffffu); ag[3] += wg[j][3] * bf2f(ga[j].y >> 16);
                        ag[4] += wg[j][4] * bf2f(ga[j].z & 0xffffu); ag[5] += wg[j][5] * bf2f(ga[j].z >> 16); ag[6] += wg[j][6] * bf2f(ga[j].w & 0xffffu); ag[7] += wg[j][7] * bf2f(ga[j].w >> 16);
                        au[0] += wu[j][0] * bf2f(ua[j].x & 0xffffu); au[1] += wu[j][1] * bf2f(ua[j].x >> 16); au[2] += wu[j][2] * bf2f(ua[j].y & 0xffffu); au[3] += wu[j][3] * bf2f(ua[j].y >> 16);
                        au[4] += wu[j][4] * bf2f(ua[j].z & 0xffffu); au[5] += wu[j][5] * bf2f(ua[j].z >> 16); au[6] += wu[j][6] * bf2f(ua[j].w & 0xffffu); au[7] += wu[j][7] * bf2f(ua[j].w >> 16); }
                    u32x4 o; o.x = pk2(siluf_(ag[0]) * au[0], siluf_(ag[1]) * au[1]); o.y = pk2(siluf_(ag[2]) * au[2], siluf_(ag[3]) * au[3]);
                    o.z = pk2(siluf_(ag[4]) * au[4], siluf_(ag[5]) * au[5]); o.w = pk2(siluf_(ag[6]) * au[6], siluf_(ag[7]) * au[7]);
                    *(u32x4*)(ACT + (size_t)(m0 + rr) * DFF + c8) = o;
                    ga[0] = ga[1]; ga[1] = ga[2]; ua[0] = ua[1]; ua[1] = ua[2];
                }
            }
            GRID_BAR();
        }
        REPS(PH_DOWN) if (IN(PH_DOWN)) {
            PHASE_BEGIN();
            pg8::Gemm g{ACT, WdownT, DFF, DFF, DFF, 0, 0}; pg8::Order S; S.init(T, DM, NBLK, blk, 1);
            pg8::EpiResid E{args.out + grow0 * DM, args.out + grow0 * DM, DM};
            pg8::gemm_phase<pg8::EpiResid>(lds, g, S, E);
            GRID_BAR();
        }
        REPS(PH_FINAL) if (IN(PH_FINAL) && l == DEPTH - 1) {
            PHASE_BEGIN();
            const float* gain = args.in[I_FING];
            f32x4 gv[4];
#pragma unroll
            for (int j = 0; j < 4; ++j) gv[j] = ((const f32x4*)gain)[lane + 64 * j];
            for (int m = gw; m < T; m += NGW) {
                f32x4* xr = (f32x4*)(args.out + (grow0 + m) * DM) + lane;
                f32x4 v[4]; float s = 0.f;
#pragma unroll
                for (int j = 0; j < 4; ++j) { v[j] = xr[64 * j]; s += (v[j].x * v[j].x + v[j].y * v[j].y) + (v[j].z * v[j].z + v[j].w * v[j].w); }
                const float rstd = rsqrtf(wave_sum(s) * (1.f / DM) + EPS);
#pragma unroll
                for (int j = 0; j < 4; ++j) xr[64 * j] = v[j] * rstd * gv[j];
            }
            GRID_BAR();
        }
    }
#undef IN
#undef GRID_BAR
#undef PHASE_BEGIN
}

#ifndef ONE_LAUNCH
#define ONE_LAUNCH 1
#endif
extern "C" void kernel_launch(void* const* d_in, const int* in_sizes, int n_in, void* d_out, int out_size, void* d_ws, size_t ws_size, hipStream_t stream) {
    static int grid = 0;
    if (grid == 0) {
        if (n_in != N_IN || in_sizes[0] != BATCH * SEQ * DM || out_size != BATCH * SEQ * DM || ws_size < WS_END) {
            fprintf(stderr, "kernel_launch: unexpected shapes / workspace (n_in %d, ws %zu, need %zu); nothing launched\n", n_in, ws_size, (size_t)WS_END); grid = -1; return; }
        int dev = 0, cus = 0, per_cu = 0;
        if (hipGetDevice(&dev) != hipSuccess || hipDeviceGetAttribute(&cus, hipDeviceAttributeMultiprocessorCount, dev) != hipSuccess) { grid = -1; return; }
        if (hipFuncSetAttribute((const void*)fwd, hipFuncAttributeMaxDynamicSharedMemorySize, LDS_BYTES) != hipSuccess) { fprintf(stderr, "kernel_launch: hipFuncSetAttribute failed\n"); grid = -1; return; }
        if (hipOccupancyMaxActiveBlocksPerMultiprocessor(&per_cu, (const void*)fwd, NTHR, LDS_BYTES) != hipSuccess || per_cu < 1) { fprintf(stderr, "kernel_launch: occupancy query says %d\n", per_cu); (void)hipGetLastError(); }
        grid = cus;
    }
    if (grid < 0) return;
    (void)hipMemsetAsync((char*)d_ws + WS_CTL, 0, CTL_BYTES, stream);
    Args a{};
    for (int i = 0; i < N_IN; ++i) a.in[i] = (const float*)d_in[i];
    a.out = (float*)d_out; a.ws = (unsigned char*)d_ws; a.pad = 0;
#if ONE_LAUNCH
    a.l_lo = 0; a.l_hi = DEPTH; a.g_lo = 0; a.g_hi = NG; a.ph_lo = 0; a.ph_hi = PH_COUNT; a.use_bar = 1;
    hipLaunchKernelGGL(fwd, dim3(grid), dim3(NTHR), LDS_BYTES, stream, a);
#else
    a.use_bar = 0;
    for (int l = 0; l < DEPTH; ++l)
        for (int g = 0; g < NG; ++g)
            for (int ph = 0; ph < PH_COUNT; ++ph) {
                if (ph == PH_W && g != 0) continue;
                if (ph == PH_FINAL && l != DEPTH - 1) continue;
                a.l_lo = l; a.l_hi = l + 1; a.g_lo = g; a.g_hi = g + 1; a.ph_lo = ph; a.ph_hi = ph + 1;
                hipLaunchKernelGGL(fwd, dim3(grid), dim3(NTHR), LDS_BYTES, stream, a);
            }
#endif
}
```

```cpp
#include <hip/hip_runtime.h>
#include <cstdio>
#include <cstdint>

#define LAS __attribute__((address_space(3)))
#define GAS __attribute__((address_space(1)))
typedef unsigned short bf16;
typedef short bf16x8 __attribute__((ext_vector_type(8)));
typedef short s16x4 __attribute__((ext_vector_type(4)));
typedef float f32x4 __attribute__((ext_vector_type(4)));
typedef float f32x2 __attribute__((ext_vector_type(2)));
typedef unsigned u32x4 __attribute__((ext_vector_type(4)));
typedef unsigned u32x2 __attribute__((ext_vector_type(2)));

constexpr int DM = 1024, BATCH = 32, SEQ = 2048, DEPTH = 4;
constexpr int PIN = 10256, PW = 10240, DFF = 2816, DFF2 = 5632;
constexpr int GB = 8;
constexpr int NG = BATCH / GB;
constexpr int T = GB * SEQ;
constexpr int NCH = SEQ / 64;
constexpr float EPS = 1e-6f;
constexpr int P_AQ = 0, P_AK = 256, P_AV = 512, P_AO = 1024, P_BB = 1536, P_BC = 2048, P_BX = 2560, P_CZ = 3072, P_CX = 3584, P_SQ = 4608, P_SK = 5120, P_SV = 5632, P_G = 6144;
constexpr int YW = 2048;

constexpr size_t MiB = 1u << 20;
constexpr size_t WS_CTL = 0, CTL_BYTES = 1 * MiB;
constexpr size_t WS_WIN = 1 * MiB;
constexpr size_t WS_WLIFT = WS_WIN + (size_t)PW * DM * 2;
constexpr size_t WS_WOUT = WS_WLIFT + (size_t)4 * DM * 512 * 2;
constexpr size_t WS_WUP = WS_WOUT + (size_t)DM * DM * 2;
constexpr size_t WS_WDOWN = WS_WUP + (size_t)DFF2 * DM * 2;
constexpr size_t WS_W16 = WS_WDOWN + (size_t)DM * DFF * 2;
constexpr size_t WS_XN = WS_W16 + 65536;
constexpr size_t WS_P = WS_XN + (size_t)T * DM * 2;
constexpr size_t WS_U = WS_P, WS_ACT = WS_P + (size_t)T * DFF2 * 2;
constexpr size_t WS_YCAT = WS_P + (size_t)T * PW * 2;
constexpr size_t WS_XG = WS_YCAT + (size_t)T * YW * 2;
constexpr size_t WS_MB = WS_XG + (size_t)BATCH * SEQ * DM * 2;
constexpr size_t WS_SP = WS_MB + (size_t)T * DM * 2;
constexpr size_t WS_GB = WS_SP + (size_t)T * 16 * 4;
constexpr size_t WS_GG = WS_GB + (size_t)T * 16;
constexpr size_t WS_GMT = WS_GG + (size_t)T * 16;
constexpr size_t WS_MCAR = WS_GMT + (size_t)T * 16;
constexpr size_t WS_MNEW = WS_MCAR + 4096;
constexpr size_t WS_MSC = WS_MNEW + 4096;
constexpr size_t WS_DT = WS_MSC + 4096;
constexpr size_t WS_AC = WS_DT + (size_t)T * 32;
constexpr size_t WS_XBC = WS_AC + (size_t)T * 32;
constexpr size_t WS_DC = WS_XBC + (size_t)T * DM * 2;
constexpr size_t WS_CS = WS_DC + (size_t)GB * 4 * NCH * 9216 * 4;
constexpr size_t WS_DH = WS_CS + (size_t)GB * 4 * NCH * 9216 * 2;
constexpr size_t WS_HS = WS_DH + (size_t)GB * NCH * 8 * 8192 * 4;
constexpr size_t WS_SSQ1 = WS_HS + (size_t)GB * NCH * 8 * 8192 * 2;
constexpr size_t WS_SSQ2 = WS_SSQ1 + (size_t)BATCH * SEQ * 64;
constexpr size_t WS_END = WS_SSQ2 + (size_t)T * 64;

constexpr int NWAVES = 8, NTHR = 512;
constexpr int LDS_BYTES = 155648;
constexpr int MISC_OFF = 153600;

__device__ __forceinline__ float bf2f(unsigned b) { return __uint_as_float(b << 16); }
__device__ __forceinline__ unsigned f2bf(float f) { unsigned u = __float_as_uint(f); return (u + 0x7fffu + ((u >> 16) & 1u)) >> 16; }
__device__ __forceinline__ unsigned pk2(float lo, float hi) { return f2bf(lo) | (f2bf(hi) << 16); }
__device__ __forceinline__ float sigmoidf_(float x) { return __builtin_amdgcn_rcpf(1.f + __builtin_amdgcn_exp2f(-1.4426950408889634f * x)); }
__device__ __forceinline__ float siluf_(float x) { return x * __builtin_amdgcn_rcpf(1.f + __builtin_amdgcn_exp2f(-1.4426950408889634f * x)); }
__device__ __forceinline__ float logsigf_(float x) { return fminf(x, 0.f) - log1pf(expf(-fabsf(x))); }
__device__ __forceinline__ float softplusf_(float x) { return fmaxf(x, 0.f) + log1pf(expf(-fabsf(x))); }
__device__ __forceinline__ float wave_sum(float v) {
#pragma unroll
    for (int o = 1; o < 64; o <<= 1) v += __shfl_xor(v, o);
    return v;
}
#define LDS_WAIT() asm volatile("s_waitcnt lgkmcnt(0)" ::: "memory")
__device__ __forceinline__ float row_rstd(const float* ssq16) {
    const f32x4* p = (const f32x4*)ssq16; const f32x4 a = (p[0] + p[1]) + (p[2] + p[3]);
    return rsqrtf(((a.x + a.y) + (a.z + a.w)) * (1.f / 1024.f) + 1e-6f);
}

namespace pg8 {
constexpr int BM = 256, BK = 64, HALF = 128, HTB = HALF * BK * 2, STAGE_BYTES = 8 * HTB, NXCD = 8, WGM = 8;
__host__ __device__ __forceinline__ int lds_byte(int r, int c) { const int st = (r >> 4) * 2 + (c >> 5), rr = r & 15, cc = c & 31, ob = rr * 64 + cc * 2; return st * 1024 + (ob ^ (((ob >> 9) & 1) << 5)); }
__host__ __device__ __forceinline__ void stage_rc(int b, int& R, int& C) { const int st = b / 1024, sb = b % 1024, swz = sb ^ (((sb >> 9) & 1) << 5); R = (st >> 1) * 16 + swz / 64; C = (st & 1) * 32 + (swz % 64) / 2; }
__host__ __device__ __forceinline__ int perm32(int rho) { const int n = rho >> 4, i = rho & 15; return 8 * (i >> 2) + 4 * n + (i & 3); }

struct Unit { int pm, pn, z; };
struct Gemm { const bf16* A; const bf16* Bt; int K, lda, ldb; size_t zA, zB; };

struct Order {
    int nM, nN, nwg, G, c, Z;
    __device__ void init(int M, int N, int G_, int c_, int Z_) { nM = M / BM; nN = N / BM; nwg = nM * nN; G = G_; c = c_; Z = Z_; }
    __device__ bool next(int i, Unit& u) const {
        const int ti = i / Z; u.z = i - ti * Z;
        const long L = (long)ti * G + c; if (L >= nwg) return false;
        int wgid = (int)L; { const int q = nwg / NXCD, r = nwg % NXCD, xcd = wgid % NXCD, off = wgid / NXCD; wgid = (xcd < r ? xcd * (q + 1) : r * (q + 1) + (xcd - r) * q) + off; }
        const int nig = WGM * nN, gid = wgid / nig, fm = gid * WGM, gsz = (nM - fm) < WGM ? (nM - fm) : WGM;
        u.pm = fm + ((wgid % nig) % gsz); u.pn = (wgid % nig) / gsz; return true;
    }
};
__device__ __forceinline__ unsigned cvt_pk_bf16(float lo, float hi) { unsigned r; asm volatile("v_cvt_pk_bf16_f32 %0, %1, %2" : "=v"(r) : "v"(lo), "v"(hi)); return r; }

struct EpiBf16 {
    static constexpr bool PERM = true, KEEP = false;
    bf16* O; int ldc; const float* ssq;
    __device__ __forceinline__ void operator()(f32x4 (&acc)[2][2][4][2], const Unit& u, int wr, int wc, int fr, int fq) const {
        const int row0 = u.pm * BM + wr * 64 + fr, col0 = u.pn * BM + wc * 32 + 8 * fq;
#pragma unroll
        for (int ai = 0; ai < 2; ++ai)
#pragma unroll
            for (int m = 0; m < 4; ++m) { const int row = row0 + ai * HALF + m * 16; bf16* rowp = O + (size_t)row * ldc + col0;
                float sq; { const f32x4 p = *(const f32x4*)(ssq + (size_t)row * 16 + 4 * fq); sq = (p.x + p.y) + (p.z + p.w); }
                sq += __shfl_xor(sq, 16); sq += __shfl_xor(sq, 32);
                const float rs = rsqrtf(sq * (1.f / 1024.f) + 1e-6f);
#pragma unroll
                for (int bj = 0; bj < 2; ++bj) { const f32x4 v0 = acc[ai][bj][m][0] * rs, v1 = acc[ai][bj][m][1] * rs;
                    u32x4 w; w.x = cvt_pk_bf16(v0[0], v0[1]); w.y = cvt_pk_bf16(v0[2], v0[3]); w.z = cvt_pk_bf16(v1[0], v1[1]); w.w = cvt_pk_bf16(v1[2], v1[3]);
                    *(u32x4*)(rowp + bj * HALF) = w; } }
    }
};
struct EpiResid {
    static constexpr bool PERM = true, KEEP = false;
    const float* base; float* out; int ldc; const float* gain; bf16* xg; float* ssq;
    __device__ __forceinline__ void operator()(f32x4 (&acc)[2][2][4][2], const Unit& u, int wr, int wc, int fr, int fq) const {
        const int row0 = u.pm * BM + wr * 64 + fr, col0 = u.pn * BM + wc * 32 + 8 * fq;
#pragma unroll
        for (int ai = 0; ai < 2; ++ai)
#pragma unroll
            for (int m = 0; m < 4; ++m) { const int row = row0 + ai * HALF + m * 16; const size_t off = (size_t)row * ldc + col0; float q = 0.f;
#pragma unroll
                for (int bj = 0; bj < 2; ++bj) {
                    const f32x4 x0 = *(const f32x4*)(base + off + bj * HALF) + acc[ai][bj][m][0], x1 = *(const f32x4*)(base + off + bj * HALF + 4) + acc[ai][bj][m][1];
                    *(f32x4*)(out + off + bj * HALF) = x0; *(f32x4*)(out + off + bj * HALF + 4) = x1;
                    if (gain) { q += (x0[0] * x0[0] + x0[1] * x0[1]) + (x0[2] * x0[2] + x0[3] * x0[3]) + (x1[0] * x1[0] + x1[1] * x1[1]) + (x1[2] * x1[2] + x1[3] * x1[3]);
                        const f32x4 y0 = x0 * *(const f32x4*)(gain + col0 + bj * HALF), y1 = x1 * *(const f32x4*)(gain + col0 + bj * HALF + 4);
                        u32x4 w; w.x = cvt_pk_bf16(y0[0], y0[1]); w.y = cvt_pk_bf16(y0[2], y0[3]); w.z = cvt_pk_bf16(y1[0], y1[1]); w.w = cvt_pk_bf16(y1[2], y1[3]);
                        *(u32x4*)(xg + off + bj * HALF) = w; } }
                if (gain) { q += __shfl_xor(q, 16); q += __shfl_xor(q, 32); if (fq == 0) ssq[(size_t)row * 16 + u.pn * 4 + wc] = q; }
            }
    }
};
struct EpiLift {
    static constexpr bool PERM = true, KEEP = true;
    const bf16* gate; int ldg; bf16* mb; int ldc;
    static __device__ __forceinline__ float em(unsigned b) { return 1.f + __builtin_amdgcn_exp2f(-1.4426950408889634f * __builtin_amdgcn_fmed3f(bf2f(b), -30.f, 30.f)); }
    __device__ __forceinline__ void operator()(f32x4 (&acc)[2][2][4][2], const Unit& u, int wr, int wc, int fr, int fq) const {
        const int row0 = u.pm * BM + wr * 64 + fr, col0 = u.pn * BM + wc * 32 + 8 * fq;
#pragma unroll
        for (int ai = 0; ai < 2; ++ai)
#pragma unroll
            for (int m = 0; m < 4; ++m) { const int row = row0 + ai * HALF + m * 16;
#pragma unroll
                for (int bj = 0; bj < 2; ++bj) { const int col = col0 + bj * HALF;
                    const bf16* gp = gate + (size_t)row * ldg + u.z * 1024 + col;
                    const u32x4 g0 = *(const u32x4*)gp;
                    f32x4& v0 = acc[ai][bj][m][0]; f32x4& v1 = acc[ai][bj][m][1];
                    if (u.z < 3) { const u32x4 g1 = *(const u32x4*)(gp + 1024);
                        v0[0] *= em(g1.x & 0xffffu) * __builtin_amdgcn_rcpf(em(g0.x & 0xffffu)); v0[1] *= em(g1.x >> 16) * __builtin_amdgcn_rcpf(em(g0.x >> 16));
                        v0[2] *= em(g1.y & 0xffffu) * __builtin_amdgcn_rcpf(em(g0.y & 0xffffu)); v0[3] *= em(g1.y >> 16) * __builtin_amdgcn_rcpf(em(g0.y >> 16));
                        v1[0] *= em(g1.z & 0xffffu) * __builtin_amdgcn_rcpf(em(g0.z & 0xffffu)); v1[1] *= em(g1.z >> 16) * __builtin_amdgcn_rcpf(em(g0.z >> 16));
                        v1[2] *= em(g1.w & 0xffffu) * __builtin_amdgcn_rcpf(em(g0.w & 0xffffu)); v1[3] *= em(g1.w >> 16) * __builtin_amdgcn_rcpf(em(g0.w >> 16));
                    } else {
                        u32x4 w;
                        w.x = cvt_pk_bf16(v0[0] * __builtin_amdgcn_rcpf(em(g0.x & 0xffffu)), v0[1] * __builtin_amdgcn_rcpf(em(g0.x >> 16))); w.y = cvt_pk_bf16(v0[2] * __builtin_amdgcn_rcpf(em(g0.y & 0xffffu)), v0[3] * __builtin_amdgcn_rcpf(em(g0.y >> 16)));
                        w.z = cvt_pk_bf16(v1[0] * __builtin_amdgcn_rcpf(em(g0.z & 0xffffu)), v1[1] * __builtin_amdgcn_rcpf(em(g0.z >> 16))); w.w = cvt_pk_bf16(v1[2] * __builtin_amdgcn_rcpf(em(g0.w & 0xffffu)), v1[3] * __builtin_amdgcn_rcpf(em(g0.w >> 16)));
                        *(u32x4*)(mb + (size_t)row * ldc + col) = w; } } }
    }
};

template <class Epi>
__device__ __forceinline__ void gemm_phase(LAS unsigned char* lds, const Gemm g, const Order& S, const Epi& E) {
    int tid = threadIdx.x; asm volatile("" : "+v"(tid));
    const int wid = __builtin_amdgcn_readfirstlane(tid >> 6), lane = tid & 63, wr = wid >> 2, wc = wid & 3, fr = lane & 15, fq = lane >> 4;
    const int K = g.K, nt = K / BK;
    unsigned voffA[2], voffB[2];
#pragma unroll
    for (int i = 0; i < 2; ++i) { int R, C; stage_rc(tid * 16 + i * 8192, R, C); const int Rb = Epi::PERM ? ((R & ~31) + perm32(R & 31)) : R;
        voffA[i] = (unsigned)(R * g.lda + C) * 2u; voffB[i] = (unsigned)(Rb * g.ldb + C) * 2u; }
    const size_t kstep = (size_t)(BK * 2);
    const size_t hstepA = (size_t)HALF * g.lda * 2, hstepB = (size_t)HALF * g.ldb * 2;
    const size_t tstepA = 2 * hstepA, tstepB = 2 * hstepB;
    const unsigned ldsw = (unsigned)wid * 1024u;
    const int aoff = lds_byte(wr * 64 + fr, fq * 8), boff = lds_byte(wc * 32 + fr, fq * 8);
#define PG8_SA(b, h) (((b) * 2 + (h)) * HTB)
#define PG8_SB(b, h) ((4 + (b) * 2 + (h)) * HTB)
#define PG8_STAGE(bufoff, gbase, voff) do { _Pragma("unroll") for (int _i = 0; _i < 2; ++_i) \
        __builtin_amdgcn_global_load_lds((const unsigned*)((const char*)(gbase) + (voff)[_i]), (LAS unsigned*)(lds + (bufoff) + ldsw + _i * 8192), 16, 0, 0); } while (0)
#define PG8_LDA(dst, b, h) do { _Pragma("unroll") for (int m = 0; m < 4; ++m) _Pragma("unroll") for (int k = 0; k < 2; ++k) dst[m][k] = *(const LAS bf16x8*)(lds + PG8_SA(b, h) + aoff + m * 2048 + k * 1024); } while (0)
#define PG8_LDB(dst, b, h) do { _Pragma("unroll") for (int n = 0; n < 2; ++n) _Pragma("unroll") for (int k = 0; k < 2; ++k) dst[n][k] = *(const LAS bf16x8*)(lds + PG8_SB(b, h) + boff + n * 2048 + k * 1024); } while (0)
#define PG8_MMA(ai, bj, At, Bt) do { __builtin_amdgcn_s_setprio(1); _Pragma("unroll") for (int m = 0; m < 4; ++m) _Pragma("unroll") for (int n = 0; n < 2; ++n) _Pragma("unroll") for (int k = 0; k < 2; ++k) \
        acc[ai][bj][m][n] = __builtin_amdgcn_mfma_f32_16x16x32_bf16(Bt[n][k], At[m][k], acc[ai][bj][m][n], 0, 0, 0); __builtin_amdgcn_s_setprio(0); } while (0)
#define PG8_WAIT_V(n) asm volatile("s_waitcnt vmcnt(" #n ")" ::: "memory")
#define PG8_WAIT_L(n) asm volatile("s_waitcnt lgkmcnt(" #n ")" ::: "memory")
#define PG8_BAR __builtin_amdgcn_s_barrier()
#define PG8_SCHED __builtin_amdgcn_sched_barrier(0)
    Unit cur, nxt; int ui = 0;
    if (!S.next(0, cur)) return;
    f32x4 acc[2][2][4][2];
#pragma unroll
    for (int a = 0; a < 2; ++a)
#pragma unroll
        for (int b = 0; b < 2; ++b)
#pragma unroll
            for (int m = 0; m < 4; ++m)
#pragma unroll
                for (int n = 0; n < 2; ++n) acc[a][b][m][n] = (f32x4){0.f, 0.f, 0.f, 0.f};
    bf16x8 At[4][2], B0[2][2], B1[2][2];
    const char* cA = (const char*)g.A + (size_t)cur.pm * tstepA + (size_t)cur.z * g.zA; const char* cB = (const char*)g.Bt + (size_t)cur.pn * tstepB + (size_t)cur.z * g.zB;
    PG8_STAGE(PG8_SB(0, 0), cB, voffB); PG8_STAGE(PG8_SB(0, 1), cB + hstepB, voffB); PG8_STAGE(PG8_SA(0, 0), cA, voffA); PG8_STAGE(PG8_SA(0, 1), cA + hstepA, voffA);
    if (wr == 1) PG8_BAR;
    PG8_WAIT_V(2); PG8_BAR;
    PG8_STAGE(PG8_SB(1, 0), cB + kstep, voffB); PG8_STAGE(PG8_SA(1, 0), cA + kstep, voffA); PG8_STAGE(PG8_SB(1, 1), cB + hstepB + kstep, voffB);
    PG8_WAIT_V(6); PG8_BAR;
    for (;;) {
        const bool has_next = S.next(ui + 1, nxt);
        const char* nA = has_next ? (const char*)g.A + (size_t)nxt.pm * tstepA + (size_t)nxt.z * g.zA : cA; const char* nB = has_next ? (const char*)g.Bt + (size_t)nxt.pn * tstepB + (size_t)nxt.z * g.zB : cB;
        for (int t = 0; t < nt; t += 2) {
            const bool last = (t == nt - 2);
            const char* a1 = cA + (size_t)(t + 1) * kstep;
            const char* a2 = last ? nA : cA + (size_t)(t + 2) * kstep; const char* b2 = last ? nB : cB + (size_t)(t + 2) * kstep;
            const char* a3 = a2 + kstep; const char* b3 = b2 + kstep;
            PG8_LDB(B0, 0, 0); PG8_LDB(B1, 0, 1); PG8_SCHED; PG8_LDA(At, 0, 0); PG8_STAGE(PG8_SA(1, 1), a1 + hstepA, voffA);
            PG8_WAIT_V(8); PG8_WAIT_L(0); PG8_BAR; PG8_MMA(0, 0, At, B0); PG8_MMA(0, 1, At, B1); PG8_BAR; PG8_SCHED;
            PG8_LDA(At, 0, 1); PG8_STAGE(PG8_SB(0, 0), b2, voffB); PG8_STAGE(PG8_SB(0, 1), b2 + hstepB, voffB); PG8_STAGE(PG8_SA(0, 0), a2, voffA);
            PG8_WAIT_V(8); PG8_WAIT_L(0); PG8_BAR; PG8_MMA(1, 0, At, B0); PG8_MMA(1, 1, At, B1); PG8_BAR; PG8_SCHED;
            PG8_LDB(B0, 1, 0); PG8_LDB(B1, 1, 1); PG8_SCHED; PG8_LDA(At, 1, 0); PG8_STAGE(PG8_SA(0, 1), a2 + hstepA, voffA);
            PG8_WAIT_V(8); PG8_WAIT_L(0); PG8_BAR; PG8_MMA(0, 0, At, B0); PG8_MMA(0, 1, At, B1); PG8_BAR; PG8_SCHED;
            PG8_LDA(At, 1, 1); PG8_STAGE(PG8_SB(1, 0), b3, voffB); PG8_STAGE(PG8_SB(1, 1), b3 + hstepB, voffB); PG8_STAGE(PG8_SA(1, 0), a3, voffA);
            PG8_WAIT_V(8); PG8_WAIT_L(0); PG8_BAR; PG8_MMA(1, 0, At, B0); PG8_MMA(1, 1, At, B1); PG8_BAR; PG8_SCHED;
        }
        if (wr == 0) PG8_BAR;
        E(acc, cur, wr, wc, fr, fq);
        if (!has_next) break;
        if (!(Epi::KEEP && nxt.z != 0))
#pragma unroll
        for (int a = 0; a < 2; ++a)
#pragma unroll
            for (int b = 0; b < 2; ++b)
#pragma unroll
                for (int m = 0; m < 4; ++m)
#pragma unroll
                    for (int n = 0; n < 2; ++n) acc[a][b][m][n] = (f32x4){0.f, 0.f, 0.f, 0.f};
        cur = nxt; cA = nA; cB = nB; ++ui;
        if (wr == 1) PG8_BAR;
    }
    PG8_WAIT_V(0);
    PG8_BAR;
#undef PG8_SA
#undef PG8_SB
#undef PG8_STAGE
#undef PG8_LDA
#undef PG8_LDB
#undef PG8_MMA
#undef PG8_WAIT_V
#undef PG8_WAIT_L
#undef PG8_BAR
#undef PG8_SCHED
}
}

#define XB_TMO      128
#define XB_XCNT(j)  (256  + 64 * (j))
#define XB_XSUB(j)  (1280 + 64 * (j))
#define XB_XGEN(j)  (2304 + 64 * (j))
#define XB_TOP      3328
#define XB_TOPGEN   3392
#define XCD_BAR_WORDS 3456
#define XB_SPIN_CAP (1u << 18)
__device__ __forceinline__ unsigned xb_ld(unsigned* p)              { return __hip_atomic_load(p, __ATOMIC_RELAXED, __HIP_MEMORY_SCOPE_AGENT); }
__device__ __forceinline__ unsigned xb_add(unsigned* p, unsigned v) { return __hip_atomic_fetch_add(p, v, __ATOMIC_RELAXED, __HIP_MEMORY_SCOPE_AGENT); }
__device__ __forceinline__ unsigned xb_xcc_id() { return (unsigned)__builtin_amdgcn_s_getreg((3 << 11) | 20) & 0xFu; }
#define XB_SPIN(cond, bar) do { unsigned _sp = 0; while (cond) { __builtin_amdgcn_s_sleep(1); \
    if ((++_sp & 255u) == 0u) { if (xb_ld(&(bar)[XB_TMO])) break; if (_sp > XB_SPIN_CAP) { atomicAdd(&(bar)[XB_TMO], 1u); break; } } } } while (0)
struct XcdBarrier { unsigned* bar; unsigned x; volatile LAS unsigned* st; };
__device__ __forceinline__ XcdBarrier xcd_barrier_post(unsigned* bar, volatile LAS unsigned* st) {
    XcdBarrier b; b.bar = bar; b.x = xb_xcc_id(); b.st = st;
    if (threadIdx.x == 0) (void)xb_add(&bar[XB_XCNT(b.x)], 1u);
    return b;
}
__device__ __forceinline__ void xcd_barrier_complete(unsigned* bar, unsigned x, unsigned& nloc, unsigned& nx) {
    const unsigned G = gridDim.x * gridDim.y * gridDim.z;
    unsigned sum, cnt, mine, sp = 0u;
    for (;;) {
        sum = 0u; cnt = 0u; mine = 0u;
#pragma unroll
        for (unsigned j = 0; j < 16; ++j) { const unsigned c = xb_ld(&bar[XB_XCNT(j)]); sum += c; cnt += (c > 0u) ? 1u : 0u; mine = (j == x) ? c : mine; }
        if (sum == G) break;
        __builtin_amdgcn_s_sleep(1);
        if ((++sp & 255u) == 0u) { if (xb_ld(&bar[XB_TMO])) break; if (sp > XB_SPIN_CAP) { atomicAdd(&bar[XB_TMO], 1u); break; } }
    }
    nloc = mine > 0u ? mine : 1u; nx = cnt > 0u ? cnt : 1u;
}
__device__ __forceinline__ void xcd_barrier(const XcdBarrier& b) {
    asm volatile("s_waitcnt vmcnt(0)" ::: "memory");
    __syncthreads();
    if (threadIdx.x == 0) {
        unsigned* bar = b.bar;
        __builtin_amdgcn_s_waitcnt(0);
        unsigned nloc = b.st[0], nx = b.st[1];
        if (nloc == 0u) { xcd_barrier_complete(bar, b.x, nloc, nx); b.st[0] = nloc; b.st[1] = nx; }
        const unsigned old = xb_add(&bar[XB_XSUB(b.x)], 1u);
        const unsigned gen = old / nloc;
        if (old + 1u == (gen + 1u) * nloc) {
            __builtin_amdgcn_fence(__ATOMIC_RELEASE, "agent");
            asm volatile("s_waitcnt vmcnt(0)" ::: "memory");
            const unsigned og = xb_add(&bar[XB_TOP], 1u);
            const unsigned tg = og / nx;
            if (og + 1u == (tg + 1u) * nx) xb_add(&bar[XB_TOPGEN], 1u);
            else XB_SPIN(xb_ld(&bar[XB_TOPGEN]) == tg, bar);
            __builtin_amdgcn_fence(__ATOMIC_ACQUIRE, "agent");
            xb_add(&bar[XB_XGEN(b.x)], 1u);
            asm volatile("s_waitcnt vmcnt(0)" ::: "memory");
        } else {
            XB_SPIN(xb_ld(&bar[XB_XGEN(b.x)]) == gen, bar);
            __builtin_amdgcn_fence(__ATOMIC_ACQUIRE, "agent");
            asm volatile("s_waitcnt vmcnt(0)" ::: "memory");
        }
    }
    __syncthreads();
}

__device__ __forceinline__ bf16x8 frag_kc(const LAS bf16* X, int ld, int mn0, int k0, int lane) { return *(const LAS bf16x8*)(X + (mn0 + (lane & 15)) * ld + k0 + 8 * (lane >> 4)); }
__device__ __forceinline__ bf16x8 gfrag_kc(const bf16* X, int ld, int mn0, int k0, int lane) { return *(const bf16x8*)(X + (size_t)(mn0 + (lane & 15)) * ld + k0 + 8 * (lane >> 4)); }
__device__ __forceinline__ s16x4 trr(const LAS bf16* p) { return __builtin_bit_cast(s16x4, __builtin_amdgcn_ds_read_tr16_b64_v4i16((LAS s16x4*)p)); }
__device__ __forceinline__ bf16x8 frag_ks(const LAS bf16* X, int ld, int mn0, int k0, int lane) {
    const int r = lane & 15, g = lane >> 4;
    const LAS bf16* p = X + (k0 + 8 * g + (r >> 2)) * ld + mn0 + 4 * (r & 3);
    const s16x4 lo = trr(p), hi = trr(p + 4 * ld);
    return (bf16x8){lo[0], lo[1], lo[2], lo[3], hi[0], hi[1], hi[2], hi[3]};
}
__device__ __forceinline__ f32x4 zero4() { f32x4 z = {0.f, 0.f, 0.f, 0.f}; asm volatile("" : "+v"(z)); return z; }
__device__ __forceinline__ u32x4 uzero4() { u32x4 z = {0u, 0u, 0u, 0u}; asm volatile("" : "+v"(z)); return z; }
#define MFMA16(a, b, c) __builtin_amdgcn_mfma_f32_16x16x32_bf16((a), (b), (c), 0, 0, 0)
__device__ __forceinline__ u32x4 scale8(u32x4 w, float s) {
    u32x4 o;
    o.x = pk2(bf2f(w.x & 0xffffu) * s, bf2f(w.x >> 16) * s); o.y = pk2(bf2f(w.y & 0xffffu) * s, bf2f(w.y >> 16) * s);
    o.z = pk2(bf2f(w.z & 0xffffu) * s, bf2f(w.z >> 16) * s); o.w = pk2(bf2f(w.w & 0xffffu) * s, bf2f(w.w >> 16) * s);
    return o;
}
__device__ __forceinline__ float wscan_add(float v, int lane) {
#pragma unroll
    for (int o = 1; o < 64; o <<= 1) { const float t = __shfl_up(v, o); if (lane >= o) v += t; }
    return v;
}
__device__ __forceinline__ float wscan_max(float v, int lane) {
#pragma unroll
    for (int o = 1; o < 64; o <<= 1) { const float t = __shfl_up(v, o); if (lane >= o) v = fmaxf(v, t); }
    return v;
}

enum { PH_W = 0, PH_INPROJ, PH_M0, PH_M1, PH_M2, PH_M3, PH_ATT, PH_LIFT, PH_OUT, PH_UP, PH_CONVACT, PH_DOWN, PH_FINAL, PH_COUNT };
enum { I_X = 0, I_MIXG, I_WIN, I_AIB, I_AFB, I_ANG, I_BCW, I_CCW, I_CCB, I_CDTB, I_CALOG, I_CDSKIP, I_CNG, I_WLIFT, I_WOUT, I_FFNG, I_WUP, I_FCW, I_FCB, I_WDOWN, I_FING, N_IN };
struct Args { const float* in[N_IN]; float* out; unsigned char* ws; int l_lo, l_hi, g_lo, g_hi, ph_lo, ph_hi, use_bar, pad; };

__device__ __forceinline__ void transpose_item(const float* W, int ldw, int nsrc0, int k0, bf16* WT, int ldt, int ndst0, LAS float* scr, int lane) {
#pragma unroll 8
    for (int i = 0; i < 32; ++i) { const int kk = 2 * i + (lane >> 5); scr[kk * 33 + (lane & 31)] = W[(size_t)(k0 + kk) * ldw + nsrc0 + (lane & 31)]; }
    LDS_WAIT(); asm volatile("" ::: "memory");
    const int c = lane & 7;
#pragma unroll
    for (int j = 0; j < 4; ++j) { const int n = (lane >> 3) + 8 * j; const LAS float* s = scr + (8 * c) * 33 + n;
        u32x4 o; o.x = pk2(s[0 * 33], s[1 * 33]); o.y = pk2(s[2 * 33], s[3 * 33]); o.z = pk2(s[4 * 33], s[5 * 33]); o.w = pk2(s[6 * 33], s[7 * 33]);
        *(u32x4*)(WT + (size_t)(ndst0 + n) * ldt + k0 + 8 * c) = o; }
    LDS_WAIT(); asm volatile("" ::: "memory");
}

__global__ void __launch_bounds__(NTHR, 2) fwd(Args args) {
    extern __shared__ __attribute__((aligned(16))) unsigned char lds_raw[];
    LAS unsigned char* lds = (LAS unsigned char*)lds_raw;
    const int NBLK = gridDim.x, blk = blockIdx.x;
    {
        volatile LAS unsigned* MISC0 = (volatile LAS unsigned*)(lds + MISC_OFF);
        if (threadIdx.x < 16) MISC0[threadIdx.x] = 0u;
        __syncthreads();
    }
    XcdBarrier bar; bar.bar = (unsigned*)(args.ws + WS_CTL) + 4096; bar.x = 0; bar.st = nullptr;
    if (args.use_bar) bar = xcd_barrier_post((unsigned*)(args.ws + WS_CTL) + 4096, (volatile LAS unsigned*)(lds + MISC_OFF) + 8);
#define GRID_BAR() do { if (args.use_bar) xcd_barrier(bar); } while (0)
#ifndef REPMASK
#define REPMASK 0
#endif
#define IN(k) (args.ph_lo <= (k) && (k) < args.ph_hi)
#define REPS(k) for (int rep_ = 0; rep_ < 1 + ((REPMASK >> (k)) & 1); ++rep_)
#define PHASE_BEGIN() int tid = threadIdx.x; asm volatile("" : "+v"(tid)); const int lane = tid & 63, wave = __builtin_amdgcn_readfirstlane(tid >> 6); \
    const __attribute__((address_space(4))) Args* ka = (const __attribute__((address_space(4))) Args*)__builtin_amdgcn_kernarg_segment_ptr(); asm volatile("" : "+s"(ka)); \
    unsigned char* ws = ka->ws; \
    const size_t grow0 = (size_t)grp * T; const float* xsrc = (l == 0) ? ka->in[I_X] : ka->out; (void)grow0; (void)xsrc; \
    const int gw = blk * NWAVES + wave, NGW = NBLK * NWAVES, gt = blk * NTHR + tid, NGT = NBLK * NTHR; (void)lane; (void)gw; (void)NGW; (void)gt; (void)NGT; \
    bf16* const WinT = (bf16*)(ws + WS_WIN); bf16* const WliftT = (bf16*)(ws + WS_WLIFT); bf16* const WoutT = (bf16*)(ws + WS_WOUT); \
    bf16* const WupT = (bf16*)(ws + WS_WUP); bf16* const WdownT = (bf16*)(ws + WS_WDOWN); bf16* const W16B = (bf16*)(ws + WS_W16); \
    bf16* const XN = (bf16*)(ws + WS_XN); bf16* const P = (bf16*)(ws + WS_P); bf16* const U = (bf16*)(ws + WS_U); bf16* const ACT = (bf16*)(ws + WS_ACT); \
    bf16* const YCAT = (bf16*)(ws + WS_YCAT); bf16* const XG = (bf16*)(ws + WS_XG); bf16* const MB = (bf16*)(ws + WS_MB); float* const SP = (float*)(ws + WS_SP); \
    float* const SSQ1 = (float*)(ws + WS_SSQ1); float* const SSQ2 = (float*)(ws + WS_SSQ2); (void)SSQ1; (void)SSQ2; \
    float* const GBc = (float*)(ws + WS_GB); float* const GGc = (float*)(ws + WS_GG); float* const GMT = (float*)(ws + WS_GMT); \
    float* const MCAR = (float*)(ws + WS_MCAR); float* const MNEW = (float*)(ws + WS_MNEW); float* const MSC = (float*)(ws + WS_MSC); \
    float* const DTB = (float*)(ws + WS_DT); float* const ACB = (float*)(ws + WS_AC); bf16* const XBC = (bf16*)(ws + WS_XBC); \
    float* const DC = (float*)(ws + WS_DC); bf16* const CS = (bf16*)(ws + WS_CS); float* const DH = (float*)(ws + WS_DH); bf16* const HS = (bf16*)(ws + WS_HS); \
    (void)WinT; (void)WliftT; (void)WoutT; (void)WupT; (void)WdownT; (void)W16B; (void)XN; (void)P; (void)U; (void)ACT; (void)YCAT; (void)XG; (void)MB; (void)SP; (void)GBc; (void)GGc; (void)GMT; \
    (void)MCAR; (void)MNEW; (void)MSC; (void)DTB; (void)ACB; (void)XBC; (void)DC; (void)CS; (void)DH; (void)HS

    for (int l = args.l_lo; l < args.l_hi; ++l)
    for (int grp = args.g_lo; grp < args.g_hi; ++grp) {

        REPS(PH_W) if (IN(PH_W) && grp == 0) {
            PHASE_BEGIN();
            LAS float* scr = (LAS float*)(lds + wave * 16384);
            constexpr int I_IN = 16 * 320, I_LF = 4 * 8 * 32, I_OUT = 16 * 32, I_UP = 16 * 176, I_DN = 44 * 32, NIT = I_IN + I_LF + I_OUT + I_UP + I_DN;
            for (int it = gw; it < NIT; it += NGW) {
                int r = it;
                if (r < I_IN) { const int kb = r / 320, nb = r % 320, n0 = 32 * nb, ns = n0 + (n0 >= P_SQ ? 16 : (n0 >= P_BB ? 8 : 0));
                    transpose_item(ka->in[I_WIN] + (size_t)l * DM * PIN, PIN, ns, 64 * kb, WinT, DM, n0, scr, lane); continue; } r -= I_IN;
                if (r < I_LF) { const int br = r / 256, q = r % 256, kb = q / 32, nb = q % 32;
                    transpose_item(ka->in[I_WLIFT] + (size_t)(l * 4 + br) * 512 * DM, DM, 32 * nb, 64 * kb, WliftT + (size_t)br * DM * 512, 512, 32 * nb, scr, lane); continue; } r -= I_LF;
                if (r < I_OUT) { const int kb = r / 32, nb = r % 32;
                    transpose_item(ka->in[I_WOUT] + (size_t)l * DM * DM, DM, 32 * nb, 64 * kb, WoutT, DM, 32 * nb, scr, lane); continue; } r -= I_OUT;
                if (r < I_UP) { const int kb = r / 176, nb = r % 176;
                    transpose_item(ka->in[I_WUP] + (size_t)l * DM * DFF2, DFF2, 32 * nb, 64 * kb, WupT, DM, 32 * nb, scr, lane); continue; } r -= I_UP;
                { const int kb = r / 32, nb = r % 32;
                    transpose_item(ka->in[I_WDOWN] + (size_t)l * DFF * DM, DM, 32 * nb, 64 * kb, WdownT, DFF, 32 * nb, scr, lane); }
            }
            for (int i = gt; i < 16 * DM; i += NGT) { const int c = i >> 10, k = i & 1023; const int oc = (c < 8) ? (1536 + c) : (4616 + (c - 8));
                const float w = ka->in[I_WIN][(size_t)l * DM * PIN + (size_t)k * PIN + oc]; const unsigned hi = f2bf(w);
                W16B[i] = (bf16)hi; W16B[16 * DM + i] = (bf16)f2bf(w - bf2f(hi)); }
            if (l == 0) {
                const float* gain = ka->in[I_MIXG];
                f32x4 gv[4];
#pragma unroll
                for (int j = 0; j < 4; ++j) gv[j] = ((const f32x4*)gain)[lane + 64 * j];
                for (int m = gw; m < BATCH * SEQ; m += NGW) {
                    const f32x4* xr = (const f32x4*)(ka->in[I_X] + (size_t)m * DM) + lane;
                    f32x4 v[4]; float sq = 0.f;
#pragma unroll
                    for (int j = 0; j < 4; ++j) { v[j] = xr[64 * j]; sq += (v[j].x * v[j].x + v[j].y * v[j].y) + (v[j].z * v[j].z + v[j].w * v[j].w); }
                    sq = wave_sum(sq); if (lane < 16) SSQ1[(size_t)m * 16 + lane] = (lane == 0) ? sq : 0.f;
                    u32x2* o8 = (u32x2*)(XG + (size_t)m * DM) + lane;
#pragma unroll
                    for (int j = 0; j < 4; ++j) { const f32x4 y = v[j] * gv[j]; o8[64 * j] = (u32x2){pk2(y.x, y.y), pk2(y.z, y.w)}; }
                }
            }
            GRID_BAR();
        }

        REPS(PH_INPROJ) if (IN(PH_INPROJ)) {
            PHASE_BEGIN();
            const bf16* XGg = XG + grow0 * DM; const float* ssq = SSQ1 + grow0 * 16;
            for (int rb = blk; rb < T / 64; rb += NBLK) {
                const int r0 = rb * 64 + 16 * (wave & 3), kh = (wave >> 2) * 512; f32x4 acc = zero4(), acc2 = zero4();
#pragma unroll 8
                for (int ks = 0; ks < 16; ++ks) { const bf16x8 a = gfrag_kc(XGg, DM, r0, kh + 32 * ks, lane);
                    acc = MFMA16(a, gfrag_kc(W16B, DM, 0, kh + 32 * ks, lane), acc); acc2 = MFMA16(a, gfrag_kc(W16B + 16 * DM, DM, 0, kh + 32 * ks, lane), acc2); }
                acc += acc2;
                LAS f32x4* xch = (LAS f32x4*)lds;
                if (wave >= 4) xch[(wave - 4) * 64 + lane] = acc;
                __syncthreads();
                if (wave < 4) { acc += xch[wave * 64 + lane];
#pragma unroll
                    for (int i = 0; i < 4; ++i) { const int row = r0 + 4 * (lane >> 4) + i; SP[(size_t)row * 16 + (lane & 15)] = acc[i] * row_rstd(ssq + (size_t)row * 16); } }
                __syncthreads();
            }
            pg8::Gemm g{XGg, WinT, DM, DM, DM, 0, 0}; pg8::Order S; S.init(T, PW, NBLK, blk, 1);
            pg8::EpiBf16 E{P, PW, ssq};
            pg8::gemm_phase<pg8::EpiBf16>(lds, g, S, E);
            GRID_BAR();
        }

        REPS(PH_M0) if (IN(PH_M0)) {
            PHASE_BEGIN();
            for (int task = gw; task < GB * 4; task += NGW) {
                const int bl = task >> 2, h = task & 3; float mcar = 0.f;
                const float igb = ka->in[I_AIB][l * 4 + h], fgb = ka->in[I_AFB][l * 4 + h];
                float igv[NCH], fgv[NCH];
#pragma unroll
                for (int c = 0; c < NCH; ++c) { const size_t m = (size_t)bl * SEQ + c * 64 + lane; igv[c] = SP[m * 16 + h]; fgv[c] = SP[m * 16 + 4 + h]; }
#pragma unroll
                for (int c = 0; c < NCH; ++c) {
                    const size_t m = (size_t)bl * SEQ + c * 64 + lane;
                    const float ig = igv[c] + igb, fg = fgv[c] + fgb;
                    const float b = wscan_add(logsigf_(fg), lane);
                    const float gg = ig - b;
                    const float pm = wscan_max(gg, lane);
                    GBc[m * 4 + h] = b; GGc[m * 4 + h] = gg; GMT[m * 4 + h] = b + fmaxf(mcar, pm);
                    const float bL = __shfl(b, 63), gmax = __shfl(pm, 63);
                    const float mnew = bL + fmaxf(mcar, gmax);
                    if (lane == 0) { MCAR[task * NCH + c] = mcar; MNEW[task * NCH + c] = mnew; MSC[task * NCH + c] = __expf(bL + mcar - mnew); }
                    mcar = mnew;
                }
            }
            for (int task = gw; task < GB * NCH; task += NGW) {
                const size_t m = (size_t)task * 64 + lane;
#pragma unroll
                for (int hd = 0; hd < 8; ++hd) {
                    const float dt = softplusf_(SP[m * 16 + 8 + hd] + ka->in[I_CDTB][l * 8 + hd]);
                    const float a = wscan_add(-dt * __expf(ka->in[I_CALOG][l * 8 + hd]), lane);
                    DTB[m * 8 + hd] = dt; ACB[m * 8 + hd] = a;
                }
            }
            {
                const float* cw = ka->in[I_CCW] + (size_t)l * 4 * 1024; const float* cb = ka->in[I_CCB] + (size_t)l * 1024;
                constexpr int RUN = 16;
                for (int i = gt; i < (T / RUN) * 128; i += NGT) {
                    const int rb = i >> 7, c8 = (i & 127) * 8, m0 = rb * RUN, t0 = m0 & (SEQ - 1);
                    float w[4][8], bb[8];
#pragma unroll
                    for (int e = 0; e < 8; ++e) { bb[e] = cb[c8 + e];
#pragma unroll
                        for (int j = 0; j < 4; ++j) w[j][e] = cw[j * 1024 + c8 + e]; }
                    const u32x4 zz = uzero4(); u32x4 win[4]; win[0] = zz; win[1] = zz; win[2] = zz;
                    if (t0 >= 3) { const bf16* pr = P + (size_t)(m0 - 3) * PW + P_CX + c8; win[0] = *(const u32x4*)pr; win[1] = *(const u32x4*)(pr + PW); win[2] = *(const u32x4*)(pr + 2 * PW); }
#pragma unroll 4
                    for (int rr = 0; rr < RUN; ++rr) {
                        win[3] = *(const u32x4*)(P + (size_t)(m0 + rr) * PW + P_CX + c8);
                        float acc[8];
#pragma unroll
                        for (int e = 0; e < 8; ++e) acc[e] = bb[e];
#pragma unroll
                        for (int j = 0; j < 4; ++j) {
                            acc[0] += w[j][0] * bf2f(win[j].x & 0xffffu); acc[1] += w[j][1] * bf2f(win[j].x >> 16); acc[2] += w[j][2] * bf2f(win[j].y & 0xffffu); acc[3] += w[j][3] * bf2f(win[j].y >> 16);
                            acc[4] += w[j][4] * bf2f(win[j].z & 0xffffu); acc[5] += w[j][5] * bf2f(win[j].z >> 16); acc[6] += w[j][6] * bf2f(win[j].w & 0xffffu); acc[7] += w[j][7] * bf2f(win[j].w >> 16); }
                        u32x4 o; o.x = pk2(siluf_(acc[0]), siluf_(acc[1])); o.y = pk2(siluf_(acc[2]), siluf_(acc[3])); o.z = pk2(siluf_(acc[4]), siluf_(acc[5])); o.w = pk2(siluf_(acc[6]), siluf_(acc[7]));
                        *(u32x4*)(XBC + (size_t)(m0 + rr) * 1024 + c8) = o;
                        win[0] = win[1]; win[1] = win[2]; win[2] = win[3];
                    }
                }
            }
            {
                const float* bw = ka->in[I_BCW] + (size_t)l * 3 * 512;
                constexpr int RUN = 16;
                for (int i = gt; i < (T / RUN) * 64; i += NGT) {
                    const int rb = i >> 6, c8 = (i & 63) * 8, m0 = rb * RUN, t0 = m0 & (SEQ - 1);
                    float w[3][8];
#pragma unroll
                    for (int e = 0; e < 8; ++e)
#pragma unroll
                        for (int j = 0; j < 3; ++j) w[j][e] = bw[j * 512 + c8 + e];
                    float pw[3][8];
#pragma unroll
                    for (int e = 0; e < 8; ++e) { pw[0][e] = 0.f; pw[1][e] = 0.f; }
                    if (t0 >= 2) {
#pragma unroll
                        for (int j = 0; j < 2; ++j) { const bf16* pr = P + (size_t)(m0 - 2 + j) * PW; const u32x4 a = *(const u32x4*)(pr + P_BC + c8), b = *(const u32x4*)(pr + P_BX + c8);
                            pw[j][0] = bf2f(a.x & 0xffffu) * bf2f(b.x & 0xffffu); pw[j][1] = bf2f(a.x >> 16) * bf2f(b.x >> 16); pw[j][2] = bf2f(a.y & 0xffffu) * bf2f(b.y & 0xffffu); pw[j][3] = bf2f(a.y >> 16) * bf2f(b.y >> 16);
                            pw[j][4] = bf2f(a.z & 0xffffu) * bf2f(b.z & 0xffffu); pw[j][5] = bf2f(a.z >> 16) * bf2f(b.z >> 16); pw[j][6] = bf2f(a.w & 0xffffu) * bf2f(b.w & 0xffffu); pw[j][7] = bf2f(a.w >> 16) * bf2f(b.w >> 16); } }
#pragma unroll 4
                    for (int rr = 0; rr < RUN; ++rr) {
                        const bf16* pr = P + (size_t)(m0 + rr) * PW; const u32x4 a = *(const u32x4*)(pr + P_BC + c8), b = *(const u32x4*)(pr + P_BX + c8), g = *(const u32x4*)(pr + P_BB + c8);
                        pw[2][0] = bf2f(a.x & 0xffffu) * bf2f(b.x & 0xffffu); pw[2][1] = bf2f(a.x >> 16) * bf2f(b.x >> 16); pw[2][2] = bf2f(a.y & 0xffffu) * bf2f(b.y & 0xffffu); pw[2][3] = bf2f(a.y >> 16) * bf2f(b.y >> 16);
                        pw[2][4] = bf2f(a.z & 0xffffu) * bf2f(b.z & 0xffffu); pw[2][5] = bf2f(a.z >> 16) * bf2f(b.z >> 16); pw[2][6] = bf2f(a.w & 0xffffu) * bf2f(b.w & 0xffffu); pw[2][7] = bf2f(a.w >> 16) * bf2f(b.w >> 16);
                        float acc[8];
#pragma unroll
                        for (int e = 0; e < 8; ++e) acc[e] = w[0][e] * pw[0][e] + w[1][e] * pw[1][e] + w[2][e] * pw[2][e];
                        u32x4 o; o.x = pk2(acc[0] * bf2f(g.x & 0xffffu), acc[1] * bf2f(g.x >> 16)); o.y = pk2(acc[2] * bf2f(g.y & 0xffffu), acc[3] * bf2f(g.y >> 16));
                        o.z = pk2(acc[4] * bf2f(g.z & 0xffffu), acc[5] * bf2f(g.z >> 16)); o.w = pk2(acc[6] * bf2f(g.w & 0xffffu), acc[7] * bf2f(g.w >> 16));
                        *(u32x4*)(YCAT + (size_t)(m0 + rr) * YW + 512 + c8) = o;
#pragma unroll
                        for (int e = 0; e < 8; ++e) { pw[0][e] = pw[1][e]; pw[1][e] = pw[2][e]; }
                    }
                }
            }
            GRID_BAR();
        }

        REPS(PH_M1) if (IN(PH_M1)) {
            PHASE_BEGIN();
            constexpr int NUA = GB * 4 * NCH, NUC = GB * NCH;
            for (int u = blk; u < NUA + NUC; u += NBLK) {
                if (u < NUA) {
                    const int ua = u, bh = ua >> 5, c = ua & 31, bl = bh >> 2, h = bh & 3; const size_t m0 = (size_t)bl * SEQ + c * 64;
                    LAS bf16* VP = (LAS bf16*)lds; LAS bf16* WK = (LAS bf16*)(lds + 64 * 152 * 2);
                    const float bL = GBc[(m0 + 63) * 4 + h], mnew = MNEW[ua];
                    for (int i = tid; i < 1024; i += NTHR) { const int s = i >> 4, c8 = i & 15; *(LAS u32x4*)(VP + s * 152 + c8 * 8) = *(const u32x4*)(P + (m0 + s) * PW + P_AV + h * 128 + c8 * 8); }
                    if (tid < 64) { *(LAS u32x4*)(VP + tid * 152 + 128) = (u32x4){0x3F80u, 0u, 0u, 0u}; *(LAS u32x4*)(VP + tid * 152 + 136) = uzero4(); }
                    { const int s = tid >> 3, c8 = tid & 7; const float w = __expf(bL + GGc[(m0 + s) * 4 + h] - mnew);
                      *(LAS u32x4*)(WK + s * 72 + c8 * 8) = scale8(*(const u32x4*)(P + (m0 + s) * PW + P_AK + h * 64 + c8 * 8), w); }
                    __syncthreads();
                    for (int ti = wave; ti < 36; ti += NWAVES) { const int mt = ti >> 2, nt = ti & 3; f32x4 acc = zero4();
#pragma unroll
                        for (int ks = 0; ks < 2; ++ks) acc = MFMA16(frag_ks(VP, 152, 16 * mt, 32 * ks, lane), frag_ks(WK, 72, 16 * nt, 32 * ks, lane), acc);
                        float* d = DC + (size_t)ua * 9216 + (16 * mt + 4 * (lane >> 4)) * 64 + 16 * nt + (lane & 15);
#pragma unroll
                        for (int i = 0; i < 4; ++i) d[i * 64] = acc[i]; }
                    __syncthreads();
                } else {
                    const int uc = u - NUA, bl = uc >> 5, c = uc & 31, hd = wave, gi = hd >> 2; const size_t m0 = (size_t)bl * SEQ + c * 64;
                    LAS bf16* XW = (LAS bf16*)(lds + hd * (64 * 72 * 2)); LAS bf16* BMs = (LAS bf16*)(lds + 8 * 64 * 72 * 2);
                    const float alast = ACB[(m0 + 63) * 8 + hd];
#pragma unroll
                    for (int k = 0; k < 8; ++k) { const int i = lane + 64 * k, s = i >> 3, c8 = i & 7; const float wd = __expf(alast - ACB[(m0 + s) * 8 + hd]) * DTB[(m0 + s) * 8 + hd];
                        *(LAS u32x4*)(XW + s * 72 + c8 * 8) = scale8(*(const u32x4*)(XBC + (m0 + s) * 1024 + hd * 64 + c8 * 8), wd); }
                    for (int i = tid; i < 2048; i += NTHR) { const int g2 = i >> 10, rem = i & 1023, s = rem >> 4, c8 = rem & 15;
                        *(LAS u32x4*)(BMs + g2 * (64 * 136) + s * 136 + c8 * 8) = *(const u32x4*)(XBC + (m0 + s) * 1024 + 512 + g2 * 128 + c8 * 8); }
                    __syncthreads();
                    const LAS bf16* BMg = BMs + gi * (64 * 136);
                    for (int pt = 0; pt < 4; ++pt) { f32x4 acc[8];
#pragma unroll
                        for (int n = 0; n < 8; ++n) acc[n] = zero4();
#pragma unroll
                        for (int ks = 0; ks < 2; ++ks) { const bf16x8 a = frag_ks(XW, 72, 16 * pt, 32 * ks, lane);
#pragma unroll
                            for (int n = 0; n < 8; ++n) acc[n] = MFMA16(a, frag_ks(BMg, 136, 16 * n, 32 * ks, lane), acc[n]); }
                        float* d = DH + ((size_t)(uc * 8 + hd) * 64 + 16 * pt + 4 * (lane >> 4)) * 128 + (lane & 15);
#pragma unroll
                        for (int n = 0; n < 8; ++n)
#pragma unroll
                            for (int i = 0; i < 4; ++i) d[i * 128 + 16 * n] = acc[n][i]; }
                    __syncthreads();
                }
            }
            GRID_BAR();
        }

        REPS(PH_M2) if (IN(PH_M2)) {
            PHASE_BEGIN();
            constexpr int NA = GB * 4 * 2304, NC = GB * 8 * 2048;
            for (int i = gt; i < NA + NC; i += NGT) {
                f32x4 st = zero4();
                if (i < NA) { const int bh = i / 2304, e = (i - bh * 2304) * 4;
                    for (int c = 0; c < NCH; ++c) { const size_t ua = (size_t)bh * NCH + c;
                        *(u32x2*)(CS + ua * 9216 + e) = (u32x2){pk2(st.x, st.y), pk2(st.z, st.w)};
                        st = st * MSC[ua] + *(const f32x4*)(DC + ua * 9216 + e); }
                } else { const int j = i - NA, bhd = j >> 11, e = (j & 2047) * 4, bl = bhd >> 3, hd = bhd & 7;
                    for (int c = 0; c < NCH; ++c) { const size_t uh = (size_t)(bl * NCH + c) * 8 + hd;
                        *(u32x2*)(HS + uh * 8192 + e) = (u32x2){pk2(st.x, st.y), pk2(st.z, st.w)};
                        st = st * __expf(ACB[((size_t)bl * SEQ + c * 64 + 63) * 8 + hd]) + *(const f32x4*)(DH + uh * 8192 + e); }
                }
            }
            GRID_BAR();
        }

        REPS(PH_M3) if (IN(PH_M3)) {
            PHASE_BEGIN();
            constexpr int NUA = GB * 4 * NCH, NUC = GB * NCH;
            for (int u = blk; u < NUA + NUC; u += NBLK) {
                const int r = lane & 15, g4 = lane >> 4;
                if (u < NUA) {
                    const int ua = u, bh = ua >> 5, c = ua & 31, bl = bh >> 2, h = bh & 3; const size_t m0 = (size_t)bl * SEQ + c * 64;
                    LAS bf16* Qs = (LAS bf16*)lds; LAS bf16* Ks = Qs + 64 * 72; LAS bf16* VP = Ks + 64 * 72; LAS bf16* CST = VP + 64 * 152; LAS bf16* SMT = CST + 144 * 72;
                    LAS float* SSQ = (LAS float*)(SMT + 64 * 72);
                    { const int s = tid >> 3, c8 = tid & 7; const bf16* pr = P + (m0 + s) * PW + h * 64 + c8 * 8;
                      *(LAS u32x4*)(Qs + s * 72 + c8 * 8) = *(const u32x4*)(pr + P_AQ); *(LAS u32x4*)(Ks + s * 72 + c8 * 8) = *(const u32x4*)(pr + P_AK); }
                    for (int i = tid; i < 1024; i += NTHR) { const int s = i >> 4, c8 = i & 15; *(LAS u32x4*)(VP + s * 152 + c8 * 8) = *(const u32x4*)(P + (m0 + s) * PW + P_AV + h * 128 + c8 * 8); }
                    if (tid < 64) { *(LAS u32x4*)(VP + tid * 152 + 128) = (u32x4){0x3F80u, 0u, 0u, 0u}; *(LAS u32x4*)(VP + tid * 152 + 136) = uzero4(); }
                    for (int i = tid; i < 1152; i += NTHR) { const int dv = i >> 3, c8 = i & 7; *(LAS u32x4*)(CST + dv * 72 + c8 * 8) = *(const u32x4*)(CS + (size_t)ua * 9216 + dv * 64 + c8 * 8); }
                    __syncthreads();
#pragma unroll
                    for (int q2 = 0; q2 < 2; ++q2) { const int ti = 2 * wave + q2, tt = ti >> 2, st = ti & 3;
                        f32x4 acc = zero4();
                        if (st <= tt) {
#pragma unroll
                            for (int ks = 0; ks < 2; ++ks) acc = MFMA16(frag_kc(Qs, 72, 16 * tt, 32 * ks, lane), frag_kc(Ks, 72, 16 * st, 32 * ks, lane), acc);
                            const int s = 16 * st + r; const float gs = GGc[(m0 + s) * 4 + h];
#pragma unroll
                            for (int i = 0; i < 4; ++i) { const int t = 16 * tt + 4 * g4 + i; const float e = GBc[(m0 + t) * 4 + h] - GMT[(m0 + t) * 4 + h] + gs;
                                acc[i] = (s <= t) ? acc[i] * 0.125f * __expf(e) : 0.f; }
                        }
                        *(LAS u32x2*)(SMT + (16 * st + r) * 72 + 16 * tt + 4 * g4) = (u32x2){pk2(acc[0], acc[1]), pk2(acc[2], acc[3])}; }
                    __syncthreads();
                    const int tt = wave & 3, half = wave >> 2;
                    f32x4 a1[5], a2[5];
#pragma unroll
                    for (int j = 0; j < 5; ++j) { a1[j] = zero4(); a2[j] = zero4(); }
#pragma unroll
                    for (int ks = 0; ks < 2; ++ks) { const bf16x8 fa1 = frag_ks(SMT, 72, 16 * tt, 32 * ks, lane), fa2 = frag_kc(Qs, 72, 16 * tt, 32 * ks, lane);
#pragma unroll
                        for (int j = 0; j < 5; ++j) { const int dvt = (j < 4) ? half * 4 + j : 8;
                            a1[j] = MFMA16(fa1, frag_ks(VP, 152, 16 * dvt, 32 * ks, lane), a1[j]);
                            a2[j] = MFMA16(fa2, frag_kc(CST, 72, 16 * dvt, 32 * ks, lane), a2[j]); } }
                    float hv[4][4], ssq[4]; const float mcar = MCAR[ua];
#pragma unroll
                    for (int i = 0; i < 4; ++i) { const int t = 16 * tt + 4 * g4 + i; const float b = GBc[(m0 + t) * 4 + h], mt = GMT[(m0 + t) * 4 + h];
                        const float is = 0.125f * __expf(b + mcar - mt);
                        float den = a1[4][i] + is * a2[4][i]; den = __shfl(den, lane & 48);
                        const float dn = __builtin_amdgcn_rcpf(fmaxf(fabsf(den), __expf(-mt))); float q = 0.f;
#pragma unroll
                        for (int j = 0; j < 4; ++j) { const float v = (a1[j][i] + is * a2[j][i]) * dn; hv[j][i] = v; q += v * v; }
                        q += __shfl_xor(q, 1); q += __shfl_xor(q, 2); q += __shfl_xor(q, 4); q += __shfl_xor(q, 8); ssq[i] = q; }
                    if (r == 0) {
#pragma unroll
                        for (int i = 0; i < 4; ++i) SSQ[half * 64 + 16 * tt + 4 * g4 + i] = ssq[i]; }
                    __syncthreads();
                    const float* ng = ka->in[I_ANG] + (size_t)l * 512 + h * 128;
#pragma unroll
                    for (int i = 0; i < 4; ++i) { const int t = 16 * tt + 4 * g4 + i; const float rstd = rsqrtf((SSQ[t] + SSQ[64 + t]) * (1.f / 128.f) + EPS);
#pragma unroll
                        for (int j = 0; j < 4; ++j) { const int dv = 16 * (half * 4 + j) + r; const float o = bf2f(P[(m0 + t) * PW + P_AO + h * 128 + dv]);
                            YCAT[(m0 + t) * YW + h * 128 + dv] = (bf16)f2bf(sigmoidf_(o) * hv[j][i] * rstd * ng[dv]); } }
                    __syncthreads();
                } else {
                    const int uc = u - NUA, bl = uc >> 5, c = uc & 31, hd = wave, gi = hd >> 2; const size_t m0 = (size_t)bl * SEQ + c * 64;
                    LAS bf16* XH = (LAS bf16*)(lds + hd * (64 * 72 * 2)); LAS bf16* MT = (LAS bf16*)(lds + (8 + hd) * (64 * 72 * 2));
                    LAS float* SSQ = (LAS float*)(lds + 16 * (64 * 72 * 2));
#pragma unroll
                    for (int k = 0; k < 8; ++k) { const int i = lane + 64 * k, s = i >> 3, c8 = i & 7; *(LAS u32x4*)(XH + s * 72 + c8 * 8) = *(const u32x4*)(XBC + (m0 + s) * 1024 + hd * 64 + c8 * 8); }
                    const bf16* Cm = XBC + m0 * 1024 + 768 + gi * 128; const bf16* Bm = XBC + m0 * 1024 + 512 + gi * 128;
                    const bf16* Hst = HS + (size_t)(uc * 8 + hd) * 8192;
                    for (int tt = 0; tt < 4; ++tt) { bf16x8 fc[4];
#pragma unroll
                        for (int ks = 0; ks < 4; ++ks) fc[ks] = gfrag_kc(Cm, 1024, 16 * tt, 32 * ks, lane);
                        float at[4];
#pragma unroll
                        for (int i = 0; i < 4; ++i) at[i] = ACB[(m0 + 16 * tt + 4 * g4 + i) * 8 + hd];
                        for (int st = 0; st < 4; ++st) { f32x4 acc = zero4();
                            if (st <= tt) {
#pragma unroll
                                for (int ks = 0; ks < 4; ++ks) acc = MFMA16(fc[ks], gfrag_kc(Bm, 1024, 16 * st, 32 * ks, lane), acc);
                                const int s = 16 * st + r; const float as = ACB[(m0 + s) * 8 + hd], dts = DTB[(m0 + s) * 8 + hd];
#pragma unroll
                                for (int i = 0; i < 4; ++i) { const int t = 16 * tt + 4 * g4 + i; acc[i] = (s <= t) ? acc[i] * __expf(at[i] - as) * dts : 0.f; }
                            }
                            *(LAS u32x2*)(MT + (16 * st + r) * 72 + 16 * tt + 4 * g4) = (u32x2){pk2(acc[0], acc[1]), pk2(acc[2], acc[3])}; } }
                    __syncthreads();
                    const float dsk = ka->in[I_CDSKIP][l * 8 + hd];
                    for (int tt = 0; tt < 4; ++tt) { f32x4 ad[4], ao[4];
#pragma unroll
                        for (int p = 0; p < 4; ++p) { ad[p] = zero4(); ao[p] = zero4(); }
#pragma unroll
                        for (int ks = 0; ks < 2; ++ks) { const bf16x8 fa = frag_ks(MT, 72, 16 * tt, 32 * ks, lane);
#pragma unroll
                            for (int p = 0; p < 4; ++p) ad[p] = MFMA16(fa, frag_ks(XH, 72, 16 * p, 32 * ks, lane), ad[p]); }
#pragma unroll
                        for (int ks = 0; ks < 4; ++ks) { const bf16x8 fa = gfrag_kc(Cm, 1024, 16 * tt, 32 * ks, lane);
#pragma unroll
                            for (int p = 0; p < 4; ++p) ao[p] = MFMA16(fa, gfrag_kc(Hst, 128, 16 * p, 32 * ks, lane), ao[p]); }
                        float ssq[4];
#pragma unroll
                        for (int i = 0; i < 4; ++i) { const int t = 16 * tt + 4 * g4 + i; const float ea = __expf(ACB[(m0 + t) * 8 + hd]); float q = 0.f;
#pragma unroll
                            for (int p = 0; p < 4; ++p) { const int pc = 16 * p + r; const float xv = bf2f(XH[t * 72 + pc]); const float z = bf2f(P[(m0 + t) * PW + P_CZ + hd * 64 + pc]);
                                const float y = (ad[p][i] + ea * ao[p][i] + dsk * xv) * siluf_(z); q += y * y;
                                YCAT[(m0 + t) * YW + 1024 + hd * 64 + pc] = (bf16)f2bf(y); }
                            q += __shfl_xor(q, 1); q += __shfl_xor(q, 2); q += __shfl_xor(q, 4); q += __shfl_xor(q, 8); ssq[i] = q; }
                        if (r == 0) {
#pragma unroll
                            for (int i = 0; i < 4; ++i) SSQ[hd * 64 + 16 * tt + 4 * g4 + i] = ssq[i]; } }
                    __syncthreads();
                    const float* ng = ka->in[I_CNG] + (size_t)l * 512 + hd * 64;
                    for (int tt = 0; tt < 4; ++tt)
#pragma unroll
                        for (int i = 0; i < 4; ++i) { const int t = 16 * tt + 4 * g4 + i; float q = 0.f;
#pragma unroll
                            for (int w8 = 0; w8 < 8; ++w8) q += SSQ[w8 * 64 + t];
                            const float rstd = rsqrtf(q * (1.f / 512.f) + EPS);
#pragma unroll
                            for (int p = 0; p < 4; ++p) { const int pc = 16 * p + r; bf16* yp = YCAT + (m0 + t) * YW + 1024 + hd * 64 + pc; *yp = (bf16)f2bf(bf2f(*yp) * rstd * ng[pc]); } }
                    __syncthreads();
                }
            }
            GRID_BAR();
        }

        REPS(PH_ATT) if (IN(PH_ATT)) {
            PHASE_BEGIN();
            LAS bf16* Qs = (LAS bf16*)lds; LAS bf16* Ks = Qs + 128 * 136; LAS bf16* Vs = Ks + 64 * 136; LAS bf16* Aw = Vs + 64 * 136 + wave * (16 * 72);
            const int r = lane & 15, g4 = lane >> 4;
            for (int u = blk; u < GB * 4 * 16; u += NBLK) {
                const int bl = u >> 6, h = (u >> 4) & 3, qt = u & 15; const size_t mb = (size_t)bl * SEQ; const int q0 = qt * 128;
                __syncthreads();
                for (int i = tid; i < 2048; i += NTHR) { const int s = i >> 4, c8 = i & 15; *(LAS u32x4*)(Qs + s * 136 + c8 * 8) = *(const u32x4*)(P + (mb + q0 + s) * PW + P_SQ + h * 128 + c8 * 8); }
                f32x4 O[8];
#pragma unroll
                for (int d = 0; d < 8; ++d) O[d] = zero4();
                float racc = 0.f; const int tq = q0 + 16 * wave + r;
                for (int kt = 2 * qt + 1; kt >= 0; --kt) {
                    const int s0 = kt * 64;
                    if (__syncthreads_and(racc < -104.f)) break;
                    for (int i = tid; i < 1024; i += NTHR) { const int s = i >> 4, c8 = i & 15; const bf16* pr = P + (mb + s0 + s) * PW + h * 128 + c8 * 8;
                        *(LAS u32x4*)(Ks + s * 136 + c8 * 8) = *(const u32x4*)(pr + P_SK); *(LAS u32x4*)(Vs + s * 136 + c8 * 8) = *(const u32x4*)(pr + P_SV); }
                    __syncthreads();
                    if (s0 < q0 + 16 * wave + 15) {
                        f32x4 z[4];
#pragma unroll
                        for (int j = 0; j < 4; ++j) z[j] = zero4();
#pragma unroll
                        for (int ks = 0; ks < 4; ++ks) { const bf16x8 fq = frag_kc(Qs, 136, 16 * wave, 32 * ks, lane);
#pragma unroll
                            for (int j = 0; j < 4; ++j) z[j] = MFMA16(frag_kc(Ks, 136, 16 * j, 32 * ks, lane), fq, z[j]); }
                        float ls[4][4], x[4][4], tsum[4];
#pragma unroll
                        for (int j = 0; j < 4; ++j) { float tj = 0.f;
#pragma unroll
                            for (int i = 0; i < 4; ++i) { const int s = s0 + 16 * j + 4 * g4 + i; const float zz = z[j][i] * 0.08838834764831845f;
                                const float l1 = fminf(zz, 0.f) - __logf(1.f + __expf(-fabsf(zz)));
                                ls[j][i] = l1; x[j][i] = (s < tq) ? (l1 - zz) : 0.f; tj += x[j][i]; }
                            tsum[j] = tj; }
                        float above[4], tot[4];
#pragma unroll
                        for (int j = 0; j < 4; ++j) { const float y1 = __shfl_xor(tsum[j], 16), y2 = __shfl_xor(tsum[j], 32), y3 = __shfl_xor(tsum[j], 48);
                            tot[j] = tsum[j] + y1 + y2 + y3;
                            above[j] = (g4 == 0) ? (y1 + y2 + y3) : (g4 == 1) ? (y2 + y3) : (g4 == 2) ? y1 : 0.f; }
                        float hi = racc;
#pragma unroll
                        for (int j = 3; j >= 0; --j) { float run = hi + above[j]; float av[4];
#pragma unroll
                            for (int i = 3; i >= 0; --i) { const int s = s0 + 16 * j + 4 * g4 + i; av[i] = (s < tq) ? __expf(ls[j][i] + run) : 0.f; run += x[j][i]; }
                            *(LAS u32x2*)(Aw + r * 72 + 16 * j + 4 * g4) = (u32x2){pk2(av[0], av[1]), pk2(av[2], av[3])};
                            hi += tot[j]; }
                        racc = hi;
                        LDS_WAIT(); asm volatile("" ::: "memory");
#pragma unroll
                        for (int ks = 0; ks < 2; ++ks) { const bf16x8 fa = frag_kc(Aw, 72, 0, 32 * ks, lane);
#pragma unroll
                            for (int d = 0; d < 8; ++d) O[d] = MFMA16(fa, frag_ks(Vs, 136, 16 * d, 32 * ks, lane), O[d]); }
                    }
                }
#pragma unroll
                for (int d = 0; d < 8; ++d)
#pragma unroll
                    for (int i = 0; i < 4; ++i) YCAT[(mb + q0 + 16 * wave + 4 * g4 + i) * YW + 1536 + h * 128 + 16 * d + r] = (bf16)f2bf(O[d][i]);
            }
            GRID_BAR();
        }

        REPS(PH_LIFT) if (IN(PH_LIFT)) {
            PHASE_BEGIN();
            pg8::Gemm g{YCAT, WliftT, 512, YW, 512, (size_t)512 * 2, (size_t)DM * 512 * 2}; pg8::Order S; S.init(T, DM, NBLK, blk, 4);
            pg8::EpiLift E{P + P_G, PW, MB, DM};
            pg8::gemm_phase<pg8::EpiLift>(lds, g, S, E);
            GRID_BAR();
        }
        REPS(PH_OUT) if (IN(PH_OUT)) {
            PHASE_BEGIN();
            pg8::Gemm g{MB, WoutT, DM, DM, DM, 0, 0}; pg8::Order S; S.init(T, DM, NBLK, blk, 1);
            pg8::EpiResid E{xsrc + grow0 * DM, ka->out + grow0 * DM, DM, ka->in[I_FFNG] + (size_t)l * DM, XN, SSQ2};
            pg8::gemm_phase<pg8::EpiResid>(lds, g, S, E);
            GRID_BAR();
        }
        REPS(PH_UP) if (IN(PH_UP)) {
            PHASE_BEGIN();
            pg8::Gemm g{XN, WupT, DM, DM, DM, 0, 0}; pg8::Order S; S.init(T, DFF2, NBLK, blk, 1);
            pg8::EpiBf16 E{U, DFF2, SSQ2};
            pg8::gemm_phase<pg8::EpiBf16>(lds, g, S, E);
            GRID_BAR();
        }
        REPS(PH_CONVACT) if (IN(PH_CONVACT)) {
            PHASE_BEGIN();
            const float* fw = ka->in[I_FCW] + (size_t)l * 3 * DFF2; const float* fb = ka->in[I_FCB] + (size_t)l * DFF2;
            constexpr int RUN = 16, NCC = DFF / 8;
            for (int i = gt; i < (T / RUN) * NCC; i += NGT) {
                const int rb = i / NCC, c8 = (i - rb * NCC) * 8, m0 = rb * RUN, t0 = m0 & (SEQ - 1);
                float wg[3][8], wu[3][8], bg[8], bu[8];
#pragma unroll
                for (int e = 0; e < 8; ++e) { bg[e] = fb[c8 + e]; bu[e] = fb[DFF + c8 + e];
#pragma unroll
                    for (int j = 0; j < 3; ++j) { wg[j][e] = fw[j * DFF2 + c8 + e]; wu[j][e] = fw[j * DFF2 + DFF + c8 + e]; } }
                u32x4 ga[3], ua[3];
                const u32x4 zz = uzero4();
                ga[0] = zz; ua[0] = zz; ga[1] = zz; ua[1] = zz;
                if (t0 >= 2) { const bf16* ur = U + (size_t)(m0 - 2) * DFF2 + c8; ga[0] = *(const u32x4*)ur; ua[0] = *(const u32x4*)(ur + DFF); ga[1] = *(const u32x4*)(ur + DFF2); ua[1] = *(const u32x4*)(ur + DFF2 + DFF); }
#pragma unroll 4
                for (int rr = 0; rr < RUN; ++rr) {
                    const bf16* ur = U + (size_t)(m0 + rr) * DFF2 + c8; ga[2] = *(const u32x4*)ur; ua[2] = *(const u32x4*)(ur + DFF);
                    float ag[8], au[8];
#pragma unroll
                    for (int e = 0; e < 8; ++e) { ag[e] = bg[e]; au[e] = bu[e]; }
#pragma unroll
                    for (int j = 0; j < 3; ++j) {
                        ag[0] += wg[j][0] * bf2f(ga[j].x & 0xffffu); ag[1] += wg[j][1] * bf2f(ga[j].x >> 16); ag[2] += wg[j][2] * bf2f(ga[j].y & 0xffffu); ag[3] += wg[j][3] * bf2f(ga[j].y >> 16);
                        ag[4] += wg[j][4] * bf2f(ga[j].z & 0xffffu); ag[5] += wg[j][5] * bf2f(ga[j].z >> 16); ag[6] += wg[j][6] * bf2f(ga[j].w & 0xffffu); ag[7] += wg[j][7] * bf2f(ga[j].w >> 16);
                        au[0] += wu[j][0] * bf2f(ua[j].x & 0xffffu); au[1] += wu[j][1] * bf2f(ua[j].x >> 16); au[2] += wu[j][2] * bf2f(ua[j].y & 0xffffu); au[3] += wu[j][3] * bf2f(ua[j].y >> 16);
                        au[4] += wu[j][4] * bf2f(ua[j].z & 0xffffu); au[5] += wu[j][5] * bf2f(ua[j].z >> 16); au[6] += wu[j][6] * bf2f(ua[j].w & 0xffffu); au[7] += wu[j][7] * bf2f(ua[j].w >> 16); }
                    u32x4 o; o.x = pk2(siluf_(ag[0]) * au[0], siluf_(ag[1]) * au[1]); o.y = pk2(siluf_(ag[2]) * au[2], siluf_(ag[3]) * au[3]);
                    o.z = pk2(siluf_(ag[4]) * au[4], siluf_(ag[5]) * au[5]); o.w = pk2(siluf_(ag[6]) * au[6], siluf_(ag[7]) * au[7]);
                    *(u32x4*)(ACT + (size_t)(m0 + rr) * DFF + c8) = o;
                    ga[0] = ga[1]; ga[1] = ga[2]; ua[0] = ua[1]; ua[1] = ua[2];
                }
            }
            GRID_BAR();
        }
        REPS(PH_DOWN) if (IN(PH_DOWN)) {
            PHASE_BEGIN();
            pg8::Gemm g{ACT, WdownT, DFF, DFF, DFF, 0, 0}; pg8::Order S; S.init(T, DM, NBLK, blk, 1);
            const bool more = (l + 1 < DEPTH);
            pg8::EpiResid E{ka->out + grow0 * DM, ka->out + grow0 * DM, DM, more ? ka->in[I_MIXG] + (size_t)(l + 1) * DM : nullptr, XG + grow0 * DM, SSQ1 + grow0 * 16};
            pg8::gemm_phase<pg8::EpiResid>(lds, g, S, E);
            GRID_BAR();
        }
        REPS(PH_FINAL) if (IN(PH_FINAL) && l == DEPTH - 1) {
            PHASE_BEGIN();
            const float* gain = ka->in[I_FING];
            f32x4 gv[4];
#pragma unroll
            for (int j = 0; j < 4; ++j) gv[j] = ((const f32x4*)gain)[lane + 64 * j];
            for (int m = gw; m < T; m += NGW) {
                f32x4* xr = (f32x4*)(ka->out + (grow0 + m) * DM) + lane;
                f32x4 v[4]; float s = 0.f;
#pragma unroll
                for (int j = 0; j < 4; ++j) { v[j] = xr[64 * j]; s += (v[j].x * v[j].x + v[j].y * v[j].y) + (v[j].z * v[j].z + v[j].w * v[j].w); }
                const float rstd = rsqrtf(wave_sum(s) * (1.f / DM) + EPS);
#pragma unroll
                for (int j = 0; j < 4; ++j) xr[64 * j] = v[j] * rstd * gv[j];
            }
            GRID_BAR();
        }
    }
#undef IN
#undef GRID_BAR
#undef PHASE_BEGIN
}

#ifndef ONE_LAUNCH
#define ONE_LAUNCH 1
#endif
extern "C" void kernel_launch(void* const* d_in, const int* in_sizes, int n_in, void* d_out, int out_size, void* d_ws, size_t ws_size, hipStream_t stream) {
    static int grid = 0;
    if (grid == 0) {
        if (n_in != N_IN || in_sizes[0] != BATCH * SEQ * DM || out_size != BATCH * SEQ * DM || ws_size < WS_END) {
            fprintf(stderr, "kernel_launch: unexpected shapes / workspace (n_in %d, ws %zu, need %zu); nothing launched\n", n_in, ws_size, (size_t)WS_END); grid = -1; return; }
        int dev = 0, cus = 0, per_cu = 0;
        if (hipGetDevice(&dev) != hipSuccess || hipDeviceGetAttribute(&cus, hipDeviceAttributeMultiprocessorCount, dev) != hipSuccess) { grid = -1; return; }
        if (hipFuncSetAttribute((const void*)fwd, hipFuncAttributeMaxDynamicSharedMemorySize, LDS_BYTES) != hipSuccess) { fprintf(stderr, "kernel_launch: hipFuncSetAttribute failed\n"); grid = -1; return; }
        if (hipOccupancyMaxActiveBlocksPerMultiprocessor(&per_cu, (const void*)fwd, NTHR, LDS_BYTES) != hipSuccess || per_cu < 1) { fprintf(stderr, "kernel_launch: occupancy query says %d\n", per_cu); (void)hipGetLastError(); }
        grid = cus;
    }
    if (grid < 0) return;
    (void)hipMemsetAsync((char*)d_ws + WS_CTL, 0, CTL_BYTES, stream);
    Args a{};
    for (int i = 0; i < N_IN; ++i) a.in[i] = (const float*)d_in[i];
    a.out = (float*)d_out; a.ws = (unsigned char*)d_ws; a.pad = 0;
#if ONE_LAUNCH
    a.l_lo = 0; a.l_hi = DEPTH; a.g_lo = 0; a.g_hi = NG; a.ph_lo = 0; a.ph_hi = PH_COUNT; a.use_bar = 1;
    hipLaunchKernelGGL(fwd, dim3(grid), dim3(NTHR), LDS_BYTES, stream, a);
#else
    a.use_bar = 0;
    for (int l = 0; l < DEPTH; ++l)
        for (int g = 0; g < NG; ++g)
            for (int ph = 0; ph < PH_COUNT; ++ph) {
                if (ph == PH_W && g != 0) continue;
                if (ph == PH_FINAL && l != DEPTH - 1) continue;
                a.l_lo = l; a.l_hi = l + 1; a.g_lo = g; a.g_hi = g + 1; a.ph_lo = ph; a.ph_hi = ph + 1;
                hipLaunchKernelGGL(fwd, dim3(grid), dim3(NTHR), LDS_BYTES, stream, a);
            }
#endif
}
```

```cpp
#include <hip/hip_runtime.h>
#include <cstdio>
#include <cstdint>

#define LAS __attribute__((address_space(3)))
#define GAS __attribute__((address_space(1)))
typedef unsigned short bf16;
typedef short bf16x8 __attribute__((ext_vector_type(8)));
typedef short s16x4 __attribute__((ext_vector_type(4)));
typedef float f32x4 __attribute__((ext_vector_type(4)));
typedef float f32x2 __attribute__((ext_vector_type(2)));
typedef unsigned u32x4 __attribute__((ext_vector_type(4)));
typedef unsigned u32x2 __attribute__((ext_vector_type(2)));

constexpr int DM = 1024, BATCH = 32, SEQ = 2048, DEPTH = 4;
constexpr int PIN = 10256, PW = 10240, DFF = 2816, DFF2 = 5632;
constexpr int GB = 8;
constexpr int NG = BATCH / GB;
constexpr int T = GB * SEQ;
constexpr int NCH = SEQ / 64;
constexpr float EPS = 1e-6f;
constexpr int P_AQ = 0, P_AK = 256, P_AV = 512, P_AO = 1024, P_BB = 1536, P_BC = 2048, P_BX = 2560, P_CZ = 3072, P_CX = 3584, P_SQ = 4608, P_SK = 5120, P_SV = 5632, P_G = 6144;
constexpr int YW = 2048;

constexpr size_t MiB = 1u << 20;
constexpr size_t WS_CTL = 0, CTL_BYTES = 1 * MiB;
constexpr size_t WS_WIN = 1 * MiB;
constexpr size_t WS_WLIFT = WS_WIN + (size_t)PW * DM * 2;
constexpr size_t WS_WOUT = WS_WLIFT + (size_t)4 * DM * 512 * 2;
constexpr size_t WS_WUP = WS_WOUT + (size_t)DM * DM * 2;
constexpr size_t WS_WDOWN = WS_WUP + (size_t)DFF2 * DM * 2;
constexpr size_t WS_W16 = WS_WDOWN + (size_t)DM * DFF * 2;
constexpr size_t WS_XN = WS_W16 + 65536;
constexpr size_t WS_P = WS_XN + (size_t)T * DM * 2;
constexpr size_t WS_U = WS_P, WS_ACT = WS_P + (size_t)T * DFF2 * 2;
constexpr size_t WS_YCAT = WS_P + (size_t)T * PW * 2;
constexpr size_t WS_XG = WS_YCAT + (size_t)T * YW * 2;
constexpr size_t WS_MB = WS_XG + (size_t)BATCH * SEQ * DM * 2;
constexpr size_t WS_SP = WS_MB + (size_t)T * DM * 2;
constexpr size_t WS_GB = WS_SP + (size_t)T * 16 * 4;
constexpr size_t WS_GG = WS_GB + (size_t)T * 16;
constexpr size_t WS_GMT = WS_GG + (size_t)T * 16;
constexpr size_t WS_MCAR = WS_GMT + (size_t)T * 16;
constexpr size_t WS_MNEW = WS_MCAR + 4096;
constexpr size_t WS_MSC = WS_MNEW + 4096;
constexpr size_t WS_DT = WS_MSC + 4096;
constexpr size_t WS_AC = WS_DT + (size_t)T * 32;
constexpr size_t WS_XBC = WS_AC + (size_t)T * 32;
constexpr size_t WS_DC = WS_XBC + (size_t)T * DM * 2;
constexpr size_t WS_CS = WS_DC + (size_t)GB * 4 * NCH * 9216 * 4;
constexpr size_t WS_DH = WS_CS + (size_t)GB * 4 * NCH * 9216 * 2;
constexpr size_t WS_HS = WS_DH + (size_t)GB * NCH * 8 * 8192 * 4;
constexpr size_t WS_SSQ1 = WS_HS + (size_t)GB * NCH * 8 * 8192 * 2;
constexpr size_t WS_SSQ2 = WS_SSQ1 + (size_t)BATCH * SEQ * 64;
constexpr size_t WS_SSQC = WS_SSQ2 + (size_t)T * 64;
constexpr size_t WS_RAWH = WS_SSQC + (size_t)T * 32;
constexpr size_t WS_END = WS_RAWH + (size_t)(T / 256) * 22 * 4 * 256 * 4;

constexpr int NWAVES = 8, NTHR = 512;
constexpr int LDS_BYTES = 155648;
constexpr int MISC_OFF = 153600;

__device__ __forceinline__ float bf2f(unsigned b) { return __uint_as_float(b << 16); }
__device__ __forceinline__ unsigned f2bf(float f) { unsigned u = __float_as_uint(f); return (u + 0x7fffu + ((u >> 16) & 1u)) >> 16; }
__device__ __forceinline__ unsigned pk2(float lo, float hi) { return f2bf(lo) | (f2bf(hi) << 16); }
__device__ __forceinline__ float sigmoidf_(float x) { return __builtin_amdgcn_rcpf(1.f + __builtin_amdgcn_exp2f(-1.4426950408889634f * x)); }
__device__ __forceinline__ float siluf_(float x) { return x * __builtin_amdgcn_rcpf(1.f + __builtin_amdgcn_exp2f(-1.4426950408889634f * x)); }
__device__ __forceinline__ float logsigf_(float x) { return fminf(x, 0.f) - log1pf(expf(-fabsf(x))); }
__device__ __forceinline__ float softplusf_(float x) { return fmaxf(x, 0.f) + log1pf(expf(-fabsf(x))); }
__device__ __forceinline__ float wave_sum(float v) {
#pragma unroll
    for (int o = 1; o < 64; o <<= 1) v += __shfl_xor(v, o);
    return v;
}
#define LDS_WAIT() asm volatile("s_waitcnt lgkmcnt(0)" ::: "memory")
__device__ __forceinline__ float row_rstd(const float* ssq16) {
    const f32x4* p = (const f32x4*)ssq16; const f32x4 a = (p[0] + p[1]) + (p[2] + p[3]);
    return rsqrtf(((a.x + a.y) + (a.z + a.w)) * (1.f / 1024.f) + 1e-6f);
}

namespace pg8 {
constexpr int BM = 256, BK = 64, HALF = 128, HTB = HALF * BK * 2, STAGE_BYTES = 8 * HTB, NXCD = 8, WGM = 8;
__host__ __device__ __forceinline__ int lds_byte(int r, int c) { const int st = (r >> 4) * 2 + (c >> 5), rr = r & 15, cc = c & 31, ob = rr * 64 + cc * 2; return st * 1024 + (ob ^ (((ob >> 9) & 1) << 5)); }
__host__ __device__ __forceinline__ void stage_rc(int b, int& R, int& C) { const int st = b / 1024, sb = b % 1024, swz = sb ^ (((sb >> 9) & 1) << 5); R = (st >> 1) * 16 + swz / 64; C = (st & 1) * 32 + (swz % 64) / 2; }
__host__ __device__ __forceinline__ int perm32(int rho) { const int n = rho >> 4, i = rho & 15; return 8 * (i >> 2) + 4 * n + (i & 3); }

struct Unit { int pm, pn, z; };
struct Gemm { const bf16* A; const bf16* Bt; int K, lda, ldb; size_t zA, zB; };

struct Order {
    int nM, nN, nwg, G, c, Z;
    __device__ __forceinline__ void init(int M, int N, int G_, int c_, int Z_) { nM = M / BM; nN = N / BM; nwg = nM * nN; G = G_; c = c_; Z = Z_; }
    __device__ __forceinline__ bool next(int i, Unit& u) const {
        const int ti = i / Z; u.z = i - ti * Z;
        const long L = (long)ti * G + c; if (L >= nwg) return false;
        int wgid = (int)L; { const int q = nwg / NXCD, r = nwg % NXCD, xcd = wgid % NXCD, off = wgid / NXCD; wgid = (xcd < r ? xcd * (q + 1) : r * (q + 1) + (xcd - r) * q) + off; }
        const int nig = WGM * nN, gid = wgid / nig, fm = gid * WGM, gsz = (nM - fm) < WGM ? (nM - fm) : WGM;
        u.pm = fm + ((wgid % nig) % gsz); u.pn = (wgid % nig) / gsz; return true;
    }
};
__device__ __forceinline__ unsigned cvt_pk_bf16(float lo, float hi) { unsigned r; asm volatile("v_cvt_pk_bf16_f32 %0, %1, %2" : "=v"(r) : "v"(lo), "v"(hi)); return r; }

struct EpiBf16 {
    static constexpr bool PERM = true, KEEP = false;
    bf16* O; int ldc; const float* ssq;
    __device__ __forceinline__ void operator()(f32x4 (&acc)[2][2][4][2], const Unit& u, int wr, int wc, int fr, int fq) const {
        const int row0 = u.pm * BM + wr * 64 + fr, col0 = u.pn * BM + wc * 32 + 8 * fq;
#pragma unroll
        for (int ai = 0; ai < 2; ++ai)
#pragma unroll
            for (int m = 0; m < 4; ++m) { const int row = row0 + ai * HALF + m * 16; bf16* rowp = O + (size_t)row * ldc + col0;
                float sq; { const f32x4 p = *(const f32x4*)(ssq + (size_t)row * 16 + 4 * fq); sq = (p.x + p.y) + (p.z + p.w); }
                sq += __shfl_xor(sq, 16); sq += __shfl_xor(sq, 32);
                const float rs = rsqrtf(sq * (1.f / 1024.f) + 1e-6f);
#pragma unroll
                for (int bj = 0; bj < 2; ++bj) { const f32x4 v0 = acc[ai][bj][m][0] * rs, v1 = acc[ai][bj][m][1] * rs;
                    u32x4 w; w.x = cvt_pk_bf16(v0[0], v0[1]); w.y = cvt_pk_bf16(v0[2], v0[3]); w.z = cvt_pk_bf16(v1[0], v1[1]); w.w = cvt_pk_bf16(v1[2], v1[3]);
                    *(u32x4*)(rowp + bj * HALF) = w; } }
    }
};
struct EpiResid {
    static constexpr bool PERM = true, KEEP = false;
    const float* base; float* out; int ldc; const float* gain; bf16* xg; float* ssq;
    __device__ __forceinline__ void operator()(f32x4 (&acc)[2][2][4][2], const Unit& u, int wr, int wc, int fr, int fq) const {
        const int row0 = u.pm * BM + wr * 64 + fr, col0 = u.pn * BM + wc * 32 + 8 * fq;
#pragma unroll
        for (int ai = 0; ai < 2; ++ai)
#pragma unroll
            for (int m = 0; m < 4; ++m) { const int row = row0 + ai * HALF + m * 16; const size_t off = (size_t)row * ldc + col0; float q = 0.f;
#pragma unroll
                for (int bj = 0; bj < 2; ++bj) {
                    const f32x4 x0 = *(const f32x4*)(base + off + bj * HALF) + acc[ai][bj][m][0], x1 = *(const f32x4*)(base + off + bj * HALF + 4) + acc[ai][bj][m][1];
                    *(f32x4*)(out + off + bj * HALF) = x0; *(f32x4*)(out + off + bj * HALF + 4) = x1;
                    if (gain) { q += (x0[0] * x0[0] + x0[1] * x0[1]) + (x0[2] * x0[2] + x0[3] * x0[3]) + (x1[0] * x1[0] + x1[1] * x1[1]) + (x1[2] * x1[2] + x1[3] * x1[3]);
                        const f32x4 y0 = x0 * *(const f32x4*)(gain + col0 + bj * HALF), y1 = x1 * *(const f32x4*)(gain + col0 + bj * HALF + 4);
                        u32x4 w; w.x = cvt_pk_bf16(y0[0], y0[1]); w.y = cvt_pk_bf16(y0[2], y0[3]); w.z = cvt_pk_bf16(y1[0], y1[1]); w.w = cvt_pk_bf16(y1[2], y1[3]);
                        *(u32x4*)(xg + off + bj * HALF) = w; } }
                if (gain) { q += __shfl_xor(q, 16); q += __shfl_xor(q, 32); if (fq == 0) ssq[(size_t)row * 16 + u.pn * 4 + wc] = q; }
            }
    }
};
struct EpiLift {
    static constexpr bool PERM = true, KEEP = true;
    const bf16* gate; int ldg; bf16* mb; int ldc; const float* ssqc;
    static __device__ __forceinline__ float em(unsigned b) { return 1.f + __builtin_amdgcn_exp2f(-1.4426950408889634f * __builtin_amdgcn_fmed3f(bf2f(b), -30.f, 30.f)); }
    __device__ __forceinline__ void operator()(f32x4 (&acc)[2][2][4][2], const Unit& u, int wr, int wc, int fr, int fq) const {
        const int row0 = u.pm * BM + wr * 64 + fr, col0 = u.pn * BM + wc * 32 + 8 * fq;
#pragma unroll
        for (int ai = 0; ai < 2; ++ai)
#pragma unroll
            for (int m = 0; m < 4; ++m) { const int row = row0 + ai * HALF + m * 16;
                float rsc = 1.f;
                if (u.z == 1 || u.z == 2) { const f32x2 p = *(const f32x2*)(ssqc + (size_t)row * 8 + 2 * fq); float sq = p.x + p.y; sq += __shfl_xor(sq, 16); sq += __shfl_xor(sq, 32);
                    const float v = sq * (1.f / 512.f) + 1e-6f; rsc = (u.z == 1) ? sqrtf(v) : rsqrtf(v); }
#pragma unroll
                for (int bj = 0; bj < 2; ++bj) { const int col = col0 + bj * HALF;
                    const bf16* gp = gate + (size_t)row * ldg + u.z * 1024 + col;
                    const u32x4 g0 = *(const u32x4*)gp;
                    f32x4& v0 = acc[ai][bj][m][0]; f32x4& v1 = acc[ai][bj][m][1];
                    if (u.z < 3) { const u32x4 g1 = *(const u32x4*)(gp + 1024);
                        v0[0] *= rsc * em(g1.x & 0xffffu) * __builtin_amdgcn_rcpf(em(g0.x & 0xffffu)); v0[1] *= rsc * em(g1.x >> 16) * __builtin_amdgcn_rcpf(em(g0.x >> 16));
                        v0[2] *= rsc * em(g1.y & 0xffffu) * __builtin_amdgcn_rcpf(em(g0.y & 0xffffu)); v0[3] *= rsc * em(g1.y >> 16) * __builtin_amdgcn_rcpf(em(g0.y >> 16));
                        v1[0] *= rsc * em(g1.z & 0xffffu) * __builtin_amdgcn_rcpf(em(g0.z & 0xffffu)); v1[1] *= rsc * em(g1.z >> 16) * __builtin_amdgcn_rcpf(em(g0.z >> 16));
                        v1[2] *= rsc * em(g1.w & 0xffffu) * __builtin_amdgcn_rcpf(em(g0.w & 0xffffu)); v1[3] *= rsc * em(g1.w >> 16) * __builtin_amdgcn_rcpf(em(g0.w >> 16));
                    } else {
                        u32x4 w;
                        w.x = cvt_pk_bf16(v0[0] * __builtin_amdgcn_rcpf(em(g0.x & 0xffffu)), v0[1] * __builtin_amdgcn_rcpf(em(g0.x >> 16))); w.y = cvt_pk_bf16(v0[2] * __builtin_amdgcn_rcpf(em(g0.y & 0xffffu)), v0[3] * __builtin_amdgcn_rcpf(em(g0.y >> 16)));
                        w.z = cvt_pk_bf16(v1[0] * __builtin_amdgcn_rcpf(em(g0.z & 0xffffu)), v1[1] * __builtin_amdgcn_rcpf(em(g0.z >> 16))); w.w = cvt_pk_bf16(v1[2] * __builtin_amdgcn_rcpf(em(g0.w & 0xffffu)), v1[3] * __builtin_amdgcn_rcpf(em(g0.w >> 16)));
                        *(u32x4*)(mb + (size_t)row * ldc + col) = w; } } }
    }
};

__device__ __forceinline__ float dpp_ror1(float x) { return __int_as_float(__builtin_amdgcn_update_dpp(0, __float_as_int(x), 0x121, 0xf, 0xf, false)); }
__device__ __forceinline__ float dpp_ror2(float x) { return __int_as_float(__builtin_amdgcn_update_dpp(0, __float_as_int(x), 0x122, 0xf, 0xf, false)); }
struct EpiConvAct {
    static constexpr bool PERM = true, KEEP = false;
    bf16* act; const float* ssq; const float* cw; const float* cb; float* rawh; LAS unsigned char* halo; int ntn;
    __device__ __forceinline__ void operator()(f32x4 (&acc)[2][2][4][2], const Unit& u, int wr, int wc, int fr, int fq) const {
        asm volatile("" : "+v"(fr), "+v"(fq));
        const int row0 = u.pm * BM + wr * 64 + fr, ch0 = u.pn * 128 + wc * 32 + 8 * fq;
#pragma unroll
        for (int ai = 0; ai < 2; ++ai)
#pragma unroll
            for (int m = 0; m < 4; ++m) { const int row = row0 + ai * HALF + m * 16;
                float sq; { const f32x4 p = *(const f32x4*)(ssq + (size_t)row * 16 + 4 * fq); sq = (p.x + p.y) + (p.z + p.w); }
                sq += __shfl_xor(sq, 16); sq += __shfl_xor(sq, 32);
                const float rs = rsqrtf(sq * (1.f / 1024.f) + 1e-6f);
#pragma unroll
                for (int bj = 0; bj < 2; ++bj) { acc[ai][bj][m][0] = acc[ai][bj][m][0] * rs; acc[ai][bj][m][1] = acc[ai][bj][m][1] * rs; } }
        LAS f32x4* H = (LAS f32x4*)halo;
        if (fr >= 14) {
#pragma unroll
            for (int ai = 0; ai < 2; ++ai) { const int b = 2 * ai + wr;
#pragma unroll
                for (int bj = 0; bj < 2; ++bj)
#pragma unroll
                    for (int n = 0; n < 2; ++n) H[((((b * 4 + wc) * 4 + fq) * 2 + (fr - 14)) * 2 + bj) * 2 + n] = acc[ai][bj][3][n]; } }
        { float* rw = rawh + (size_t)(u.pm * ntn + u.pn) * 1024;
          if (wr == 1 && fr >= 14) {
#pragma unroll
            for (int bj = 0; bj < 2; ++bj)
#pragma unroll
                for (int n = 0; n < 2; ++n) *(f32x4*)(rw + (2 + fr - 14) * 256 + bj * HALF + wc * 32 + 8 * fq + 4 * n) = acc[1][bj][3][n]; }
          if (wr == 0 && fr < 2) {
#pragma unroll
            for (int bj = 0; bj < 2; ++bj)
#pragma unroll
                for (int n = 0; n < 2; ++n) *(f32x4*)(rw + fr * 256 + bj * HALF + wc * 32 + 8 * fq + 4 * n) = acc[0][bj][0][n]; } }
        asm volatile("s_waitcnt lgkmcnt(0)" ::: "memory"); __builtin_amdgcn_s_barrier(); asm volatile("" ::: "memory");
        bf16* actb = act + (size_t)(u.pm * BM + wr * 64) * 2816 + u.pn * 128 + wc * 32;
        const unsigned alane = (unsigned)(fr * 2816 + 8 * fq);
#pragma unroll
        for (int n = 0; n < 2; ++n) {
            unsigned half0[2][4];
#pragma unroll
            for (int eh = 0; eh < 2; ++eh) {
                const int ch = ch0 + 4 * n + 2 * eh;
                f32x2 wg[3], wu[3], bg, bu;
#pragma unroll
                for (int j = 0; j < 3; ++j) { wg[j] = *(const f32x2*)(cw + j * 5632 + ch); wu[j] = *(const f32x2*)(cw + j * 5632 + 2816 + ch); }
                bg = *(const f32x2*)(cb + ch); bu = *(const f32x2*)(cb + 2816 + ch);
#pragma unroll
                for (int ai = 0; ai < 2; ++ai) { const int b = 2 * ai + wr;
#pragma unroll
                    for (int m = 3; m >= 0; --m) {
                        float r2[2];
#pragma unroll
                        for (int e2 = 0; e2 < 2; ++e2) { const int e = 2 * eh + e2;
                            const float gc = acc[ai][0][m][n][e], uc = acc[ai][1][m][n][e];
                            float gp = 0.f, up = 0.f; asm volatile("" : "+v"(gp), "+v"(up));
                            if (m > 0) { gp = acc[ai][0][m - 1][n][e]; up = acc[ai][1][m - 1][n][e]; }
                            else if (b >= 1) { const int fk = fr >= 14 ? fr - 14 : 0; const LAS float* hp = (const LAS float*)(H + ((((b - 1) * 4 + wc) * 4 + fq) * 2 + fk) * 4 + n); gp = hp[e]; up = hp[8 + e]; }
                            const float gc1 = dpp_ror1(gc), gp1 = dpp_ror1(gp), gc2 = dpp_ror2(gc), gp2 = dpp_ror2(gp), uc1 = dpp_ror1(uc), up1 = dpp_ror1(up), uc2 = dpp_ror2(uc), up2 = dpp_ror2(up);
                            const float g1 = (fr >= 1) ? gc1 : gp1, g2 = (fr >= 2) ? gc2 : gp2, u1 = (fr >= 1) ? uc1 : up1, u2 = (fr >= 2) ? uc2 : up2;
                            const float vg = bg[e2] + wg[0][e2] * g2 + wg[1][e2] * g1 + wg[2][e2] * gc;
                            const float vu = bu[e2] + wu[0][e2] * u2 + wu[1][e2] * u1 + wu[2][e2] * uc;
                            r2[e2] = siluf_(vg) * vu; }
                        const unsigned pk = cvt_pk_bf16(r2[0], r2[1]);
                        if (eh == 0) half0[ai][m] = pk;
                        else *(u32x2*)(actb + (size_t)(ai * HALF + m * 16) * 2816 + 4 * n + alane) = (u32x2){half0[ai][m], pk};
                    }
                }
            }
        }
    }
};

template <class Epi, bool ALIGN_EPI = true>
__device__ __forceinline__ void gemm_phase(LAS unsigned char* lds, const Gemm g, const Order& S, const Epi& E) {
    int tid = threadIdx.x; asm volatile("" : "+v"(tid));
    const int wid = __builtin_amdgcn_readfirstlane(tid >> 6), lane = tid & 63, wr = wid >> 2, wc = wid & 3, fr = lane & 15, fq = lane >> 4;
    const int K = g.K, nt = K / BK;
    unsigned voffA[2], voffB[2];
#pragma unroll
    for (int i = 0; i < 2; ++i) { int R, C; stage_rc(tid * 16 + i * 8192, R, C); const int Rb = Epi::PERM ? ((R & ~31) + perm32(R & 31)) : R;
        voffA[i] = (unsigned)(R * g.lda + C) * 2u; voffB[i] = (unsigned)(Rb * g.ldb + C) * 2u; }
    const size_t kstep = (size_t)(BK * 2);
    const size_t hstepA = (size_t)HALF * g.lda * 2, hstepB = (size_t)HALF * g.ldb * 2;
    const size_t tstepA = 2 * hstepA, tstepB = 2 * hstepB;
    const unsigned ldsw = (unsigned)wid * 1024u;
    const int aoff = lds_byte(wr * 64 + fr, fq * 8), boff = lds_byte(wc * 32 + fr, fq * 8);
#define PG8_SA(b, h) (((b) * 2 + (h)) * HTB)
#define PG8_SB(b, h) ((4 + (b) * 2 + (h)) * HTB)
#define PG8_STAGE(bufoff, gbase, voff) do { _Pragma("unroll") for (int _i = 0; _i < 2; ++_i) \
        __builtin_amdgcn_global_load_lds((const unsigned*)((const char*)(gbase) + (voff)[_i]), (LAS unsigned*)(lds + (bufoff) + ldsw + _i * 8192), 16, 0, 0); } while (0)
#define PG8_LDA(dst, b, h) do { _Pragma("unroll") for (int m = 0; m < 4; ++m) _Pragma("unroll") for (int k = 0; k < 2; ++k) dst[m][k] = *(const LAS bf16x8*)(lds + PG8_SA(b, h) + aoff + m * 2048 + k * 1024); } while (0)
#define PG8_LDB(dst, b, h) do { _Pragma("unroll") for (int n = 0; n < 2; ++n) _Pragma("unroll") for (int k = 0; k < 2; ++k) dst[n][k] = *(const LAS bf16x8*)(lds + PG8_SB(b, h) + boff + n * 2048 + k * 1024); } while (0)
#define PG8_MMA(ai, bj, At, Bt) do { __builtin_amdgcn_s_setprio(1); _Pragma("unroll") for (int m = 0; m < 4; ++m) _Pragma("unroll") for (int n = 0; n < 2; ++n) _Pragma("unroll") for (int k = 0; k < 2; ++k) \
        acc[ai][bj][m][n] = __builtin_amdgcn_mfma_f32_16x16x32_bf16(Bt[n][k], At[m][k], acc[ai][bj][m][n], 0, 0, 0); __builtin_amdgcn_s_setprio(0); } while (0)
#define PG8_WAIT_V(n) asm volatile("s_waitcnt vmcnt(" #n ")" ::: "memory")
#define PG8_WAIT_L(n) asm volatile("s_waitcnt lgkmcnt(" #n ")" ::: "memory")
#define PG8_BAR __builtin_amdgcn_s_barrier()
#define PG8_SCHED __builtin_amdgcn_sched_barrier(0)
    Unit cur, nxt; int ui = 0;
    if (!S.next(0, cur)) return;
    f32x4 acc[2][2][4][2];
#pragma unroll
    for (int a = 0; a < 2; ++a)
#pragma unroll
        for (int b = 0; b < 2; ++b)
#pragma unroll
            for (int m = 0; m < 4; ++m)
#pragma unroll
                for (int n = 0; n < 2; ++n) acc[a][b][m][n] = (f32x4){0.f, 0.f, 0.f, 0.f};
    bf16x8 At[4][2], B0[2][2], B1[2][2];
    const char* cA = (const char*)g.A + (size_t)cur.pm * tstepA + (size_t)cur.z * g.zA; const char* cB = (const char*)g.Bt + (size_t)cur.pn * tstepB + (size_t)cur.z * g.zB;
    PG8_STAGE(PG8_SB(0, 0), cB, voffB); PG8_STAGE(PG8_SB(0, 1), cB + hstepB, voffB); PG8_STAGE(PG8_SA(0, 0), cA, voffA); PG8_STAGE(PG8_SA(0, 1), cA + hstepA, voffA);
    if (wr == 1) PG8_BAR;
    PG8_WAIT_V(2); PG8_BAR;
    PG8_STAGE(PG8_SB(1, 0), cB + kstep, voffB); PG8_STAGE(PG8_SA(1, 0), cA + kstep, voffA); PG8_STAGE(PG8_SB(1, 1), cB + hstepB + kstep, voffB);
    PG8_WAIT_V(6); PG8_BAR;
    for (;;) {
        const bool has_next = S.next(ui + 1, nxt);
        const char* nA = has_next ? (const char*)g.A + (size_t)nxt.pm * tstepA + (size_t)nxt.z * g.zA : cA; const char* nB = has_next ? (const char*)g.Bt + (size_t)nxt.pn * tstepB + (size_t)nxt.z * g.zB : cB;
        for (int t = 0; t < nt; t += 2) {
            const bool last = (t == nt - 2);
            const char* a1 = cA + (size_t)(t + 1) * kstep;
            const char* a2 = last ? nA : cA + (size_t)(t + 2) * kstep; const char* b2 = last ? nB : cB + (size_t)(t + 2) * kstep;
            const char* a3 = a2 + kstep; const char* b3 = b2 + kstep;
            PG8_LDB(B0, 0, 0); PG8_LDB(B1, 0, 1); PG8_SCHED; PG8_LDA(At, 0, 0); PG8_STAGE(PG8_SA(1, 1), a1 + hstepA, voffA);
            PG8_WAIT_V(8); PG8_WAIT_L(0); PG8_BAR; PG8_MMA(0, 0, At, B0); PG8_MMA(0, 1, At, B1); PG8_BAR; PG8_SCHED;
            PG8_LDA(At, 0, 1); PG8_STAGE(PG8_SB(0, 0), b2, voffB); PG8_STAGE(PG8_SB(0, 1), b2 + hstepB, voffB); PG8_STAGE(PG8_SA(0, 0), a2, voffA);
            PG8_WAIT_V(8); PG8_WAIT_L(0); PG8_BAR; PG8_MMA(1, 0, At, B0); PG8_MMA(1, 1, At, B1); PG8_BAR; PG8_SCHED;
            PG8_LDB(B0, 1, 0); PG8_LDB(B1, 1, 1); PG8_SCHED; PG8_LDA(At, 1, 0); PG8_STAGE(PG8_SA(0, 1), a2 + hstepA, voffA);
            PG8_WAIT_V(8); PG8_WAIT_L(0); PG8_BAR; PG8_MMA(0, 0, At, B0); PG8_MMA(0, 1, At, B1); PG8_BAR; PG8_SCHED;
            PG8_LDA(At, 1, 1); PG8_STAGE(PG8_SB(1, 0), b3, voffB); PG8_STAGE(PG8_SB(1, 1), b3 + hstepB, voffB); PG8_STAGE(PG8_SA(1, 0), a3, voffA);
            PG8_WAIT_V(8); PG8_WAIT_L(0); PG8_BAR; PG8_MMA(1, 0, At, B0); PG8_MMA(1, 1, At, B1); PG8_BAR; PG8_SCHED;
        }
        if constexpr (ALIGN_EPI) { if (wr == 0) PG8_BAR; }
        E(acc, cur, wr, wc, fr, fq);
        if (!has_next) break;
        if (!(Epi::KEEP && nxt.z != 0))
#pragma unroll
        for (int a = 0; a < 2; ++a)
#pragma unroll
            for (int b = 0; b < 2; ++b)
#pragma unroll
                for (int m = 0; m < 4; ++m)
#pragma unroll
                    for (int n = 0; n < 2; ++n) acc[a][b][m][n] = (f32x4){0.f, 0.f, 0.f, 0.f};
        cur = nxt; cA = nA; cB = nB; ++ui;
        if constexpr (ALIGN_EPI) { if (wr == 1) PG8_BAR; }
    }
    PG8_WAIT_V(0);
    if constexpr (!ALIGN_EPI) { if (wr == 0) PG8_BAR; }
    PG8_BAR;
#undef PG8_SA
#undef PG8_SB
#undef PG8_STAGE
#undef PG8_LDA
#undef PG8_LDB
#undef PG8_MMA
#undef PG8_WAIT_V
#undef PG8_WAIT_L
#undef PG8_BAR
#undef PG8_SCHED
}
}

#define XB_TMO      128
#define XB_XCNT(j)  (256  + 64 * (j))
#define XB_XSUB(j)  (1280 + 64 * (j))
#define XB_XGEN(j)  (2304 + 64 * (j))
#define XB_TOP      3328
#define XB_TOPGEN   3392
#define XCD_BAR_WORDS 3456
#define XB_SPIN_CAP (1u << 18)
__device__ __forceinline__ unsigned xb_ld(unsigned* p)              { return __hip_atomic_load(p, __ATOMIC_RELAXED, __HIP_MEMORY_SCOPE_AGENT); }
__device__ __forceinline__ unsigned xb_add(unsigned* p, unsigned v) { return __hip_atomic_fetch_add(p, v, __ATOMIC_RELAXED, __HIP_MEMORY_SCOPE_AGENT); }
__device__ __forceinline__ unsigned xb_xcc_id() { return (unsigned)__builtin_amdgcn_s_getreg((3 << 11) | 20) & 0xFu; }
#define XB_SPIN(cond, bar) do { unsigned _sp = 0; while (cond) { __builtin_amdgcn_s_sleep(1); \
    if ((++_sp & 255u) == 0u) { if (xb_ld(&(bar)[XB_TMO])) break; if (_sp > XB_SPIN_CAP) { atomicAdd(&(bar)[XB_TMO], 1u); break; } } } } while (0)
struct XcdBarrier { unsigned* bar; unsigned x; volatile LAS unsigned* st; };
__device__ __forceinline__ XcdBarrier xcd_barrier_post(unsigned* bar, volatile LAS unsigned* st) {
    XcdBarrier b; b.bar = bar; b.x = xb_xcc_id(); b.st = st;
    if (threadIdx.x == 0) (void)xb_add(&bar[XB_XCNT(b.x)], 1u);
    return b;
}
__device__ __forceinline__ void xcd_barrier_complete(unsigned* bar, unsigned x, unsigned& nloc, unsigned& nx) {
    const unsigned G = gridDim.x * gridDim.y * gridDim.z;
    unsigned sum, cnt, mine, sp = 0u;
    for (;;) {
        sum = 0u; cnt = 0u; mine = 0u;
#pragma unroll
        for (unsigned j = 0; j < 16; ++j) { const unsigned c = xb_ld(&bar[XB_XCNT(j)]); sum += c; cnt += (c > 0u) ? 1u : 0u; mine = (j == x) ? c : mine; }
        if (sum == G) break;
        __builtin_amdgcn_s_sleep(1);
        if ((++sp & 255u) == 0u) { if (xb_ld(&bar[XB_TMO])) break; if (sp > XB_SPIN_CAP) { atomicAdd(&bar[XB_TMO], 1u); break; } }
    }
    nloc = mine > 0u ? mine : 1u; nx = cnt > 0u ? cnt : 1u;
}
__device__ __forceinline__ void xcd_barrier(const XcdBarrier& b) {
    asm volatile("s_waitcnt vmcnt(0)" ::: "memory");
    __syncthreads();
    if (threadIdx.x == 0) {
        unsigned* bar = b.bar;
        __builtin_amdgcn_s_waitcnt(0);
        unsigned nloc = b.st[0], nx = b.st[1];
        if (nloc == 0u) { xcd_barrier_complete(bar, b.x, nloc, nx); b.st[0] = nloc; b.st[1] = nx; }
        const unsigned old = xb_add(&bar[XB_XSUB(b.x)], 1u);
        const unsigned gen = old / nloc;
        if (old + 1u == (gen + 1u) * nloc) {
            __builtin_amdgcn_fence(__ATOMIC_RELEASE, "agent");
            asm volatile("s_waitcnt vmcnt(0)" ::: "memory");
            const unsigned og = xb_add(&bar[XB_TOP], 1u);
            const unsigned tg = og / nx;
            if (og + 1u == (tg + 1u) * nx) xb_add(&bar[XB_TOPGEN], 1u);
            else XB_SPIN(xb_ld(&bar[XB_TOPGEN]) == tg, bar);
            __builtin_amdgcn_fence(__ATOMIC_ACQUIRE, "agent");
            xb_add(&bar[XB_XGEN(b.x)], 1u);
            asm volatile("s_waitcnt vmcnt(0)" ::: "memory");
        } else {
            XB_SPIN(xb_ld(&bar[XB_XGEN(b.x)]) == gen, bar);
            __builtin_amdgcn_fence(__ATOMIC_ACQUIRE, "agent");
            asm volatile("s_waitcnt vmcnt(0)" ::: "memory");
        }
    }
    __syncthreads();
}

__device__ __forceinline__ bf16x8 frag_kc(const LAS bf16* X, int ld, int mn0, int k0, int lane) { return *(const LAS bf16x8*)(X + (mn0 + (lane & 15)) * ld + k0 + 8 * (lane >> 4)); }
__device__ __forceinline__ bf16x8 gfrag_kc(const bf16* X, int ld, int mn0, int k0, int lane) { const bf16* b = X + (size_t)mn0 * ld + k0; const unsigned lo = (unsigned)((lane & 15) * ld + 8 * (lane >> 4)); return *(const bf16x8*)(b + lo); }
__device__ __forceinline__ s16x4 trr(const LAS bf16* p) { return __builtin_bit_cast(s16x4, __builtin_amdgcn_ds_read_tr16_b64_v4i16((LAS s16x4*)p)); }
__device__ __forceinline__ bf16x8 frag_ks(const LAS bf16* X, int ld, int mn0, int k0, int lane) {
    const int r = lane & 15, g = lane >> 4;
    const LAS bf16* p = X + (k0 + 8 * g + (r >> 2)) * ld + mn0 + 4 * (r & 3);
    const s16x4 lo = trr(p), hi = trr(p + 4 * ld);
    return (bf16x8){lo[0], lo[1], lo[2], lo[3], hi[0], hi[1], hi[2], hi[3]};
}
__device__ __forceinline__ f32x4 zero4() { f32x4 z = {0.f, 0.f, 0.f, 0.f}; asm volatile("" : "+v"(z)); return z; }
__device__ __forceinline__ u32x4 uone4() { u32x4 z = {0x3F80u, 0u, 0u, 0u}; asm volatile("" : "+v"(z)); return z; }
__device__ __forceinline__ u32x4 uzero4() { u32x4 z = {0u, 0u, 0u, 0u}; asm volatile("" : "+v"(z)); return z; }
#define MFMA16(a, b, c) __builtin_amdgcn_mfma_f32_16x16x32_bf16((a), (b), (c), 0, 0, 0)
__device__ __forceinline__ u32x4 scale8(u32x4 w, float s) {
    u32x4 o;
    o.x = pk2(bf2f(w.x & 0xffffu) * s, bf2f(w.x >> 16) * s); o.y = pk2(bf2f(w.y & 0xffffu) * s, bf2f(w.y >> 16) * s);
    o.z = pk2(bf2f(w.z & 0xffffu) * s, bf2f(w.z >> 16) * s); o.w = pk2(bf2f(w.w & 0xffffu) * s, bf2f(w.w >> 16) * s);
    return o;
}
__device__ __forceinline__ float wscan_add(float v, int lane) {
#pragma unroll
    for (int o = 1; o < 64; o <<= 1) { const float t = __shfl_up(v, o); if (lane >= o) v += t; }
    return v;
}
__device__ __forceinline__ float wscan_max(float v, int lane) {
#pragma unroll
    for (int o = 1; o < 64; o <<= 1) { const float t = __shfl_up(v, o); if (lane >= o) v = fmaxf(v, t); }
    return v;
}

#ifndef GEMM_ALIGN
#define GEMM_ALIGN true
#endif
enum { PH_W = 0, PH_INPROJ, PH_M0, PH_M1, PH_M2, PH_M3, PH_ATT, PH_LIFT, PH_OUT, PH_UP, PH_DOWN, PH_FINAL, PH_COUNT };
enum { I_X = 0, I_MIXG, I_WIN, I_AIB, I_AFB, I_ANG, I_BCW, I_CCW, I_CCB, I_CDTB, I_CALOG, I_CDSKIP, I_CNG, I_WLIFT, I_WOUT, I_FFNG, I_WUP, I_FCW, I_FCB, I_WDOWN, I_FING, N_IN };
struct Args { const float* in[N_IN]; float* out; unsigned char* ws; int l_lo, l_hi, g_lo, g_hi, ph_lo, ph_hi, use_bar, pad; };

__device__ __forceinline__ void transpose_item(const float* W, int ldw, int nsrc0, int k0, bf16* WT, int ldt, int ndst0, LAS float* scr, int lane, const float* kscale = nullptr) {
#pragma unroll 8
    for (int i = 0; i < 32; ++i) { const int kk = 2 * i + (lane >> 5); scr[kk * 33 + (lane & 31)] = W[(size_t)(k0 + kk) * ldw + nsrc0 + (lane & 31)] * (kscale ? kscale[k0 + kk] : 1.f); }
    LDS_WAIT(); asm volatile("" ::: "memory");
    const int c = lane & 7;
#pragma unroll
    for (int j = 0; j < 4; ++j) { const int n = (lane >> 3) + 8 * j; const LAS float* s = scr + (8 * c) * 33 + n;
        u32x4 o; o.x = pk2(s[0 * 33], s[1 * 33]); o.y = pk2(s[2 * 33], s[3 * 33]); o.z = pk2(s[4 * 33], s[5 * 33]); o.w = pk2(s[6 * 33], s[7 * 33]);
        *(u32x4*)(WT + (size_t)(ndst0 + n) * ldt + k0 + 8 * c) = o; }
    LDS_WAIT(); asm volatile("" ::: "memory");
}

__global__ void __launch_bounds__(NTHR, 2) fwd(Args args) {
    extern __shared__ __attribute__((aligned(16))) unsigned char lds_raw[];
    LAS unsigned char* lds = (LAS unsigned char*)lds_raw;
    const int NBLK = gridDim.x, blk = blockIdx.x;
    {
        volatile LAS unsigned* MISC0 = (volatile LAS unsigned*)(lds + MISC_OFF);
        if (threadIdx.x < 16) MISC0[threadIdx.x] = 0u;
        __syncthreads();
    }
    XcdBarrier bar; bar.bar = (unsigned*)(args.ws + WS_CTL) + 4096; bar.x = 0; bar.st = nullptr;
    if (args.use_bar) bar = xcd_barrier_post((unsigned*)(args.ws + WS_CTL) + 4096, (volatile LAS unsigned*)(lds + MISC_OFF) + 8);
#define GRID_BAR() do { if (args.use_bar) xcd_barrier(bar); } while (0)
#ifndef REPMASK
#define REPMASK 0
#endif
#define IN(k) (args.ph_lo <= (k) && (k) < args.ph_hi)
#define REPS(k) for (int rep_ = 0; rep_ < 1 + ((REPMASK >> (k)) & 1); ++rep_)
#define PHASE_BEGIN() int tid = threadIdx.x; asm volatile("" : "+v"(tid)); const int lane = tid & 63, wave = __builtin_amdgcn_readfirstlane(tid >> 6); \
    const __attribute__((address_space(4))) Args* ka = (const __attribute__((address_space(4))) Args*)__builtin_amdgcn_kernarg_segment_ptr(); asm volatile("" : "+s"(ka)); \
    unsigned char* ws = ka->ws; \
    const size_t grow0 = (size_t)grp * T; const float* xsrc = (l == 0) ? ka->in[I_X] : ka->out; (void)grow0; (void)xsrc; \
    const int gw = blk * NWAVES + wave, NGW = NBLK * NWAVES, gt = blk * NTHR + tid, NGT = NBLK * NTHR; (void)lane; (void)gw; (void)NGW; (void)gt; (void)NGT; \
    bf16* const WinT = (bf16*)(ws + WS_WIN); bf16* const WliftT = (bf16*)(ws + WS_WLIFT); bf16* const WoutT = (bf16*)(ws + WS_WOUT); \
    bf16* const WupT = (bf16*)(ws + WS_WUP); bf16* const WdownT = (bf16*)(ws + WS_WDOWN); bf16* const W16B = (bf16*)(ws + WS_W16); \
    bf16* const XN = (bf16*)(ws + WS_XN); bf16* const P = (bf16*)(ws + WS_P); bf16* const U = (bf16*)(ws + WS_U); bf16* const ACT = (bf16*)(ws + WS_ACT); \
    bf16* const YCAT = (bf16*)(ws + WS_YCAT); bf16* const XG = (bf16*)(ws + WS_XG); bf16* const MB = (bf16*)(ws + WS_MB); float* const SP = (float*)(ws + WS_SP); \
    float* const SSQ1 = (float*)(ws + WS_SSQ1); float* const SSQ2 = (float*)(ws + WS_SSQ2); float* const SSQC = (float*)(ws + WS_SSQC); float* const RAWH = (float*)(ws + WS_RAWH); (void)SSQ1; (void)SSQ2; (void)SSQC; (void)RAWH; \
    float* const GBc = (float*)(ws + WS_GB); float* const GGc = (float*)(ws + WS_GG); float* const GMT = (float*)(ws + WS_GMT); \
    float* const MCAR = (float*)(ws + WS_MCAR); float* const MNEW = (float*)(ws + WS_MNEW); float* const MSC = (float*)(ws + WS_MSC); \
    float* const DTB = (float*)(ws + WS_DT); float* const ACB = (float*)(ws + WS_AC); bf16* const XBC = (bf16*)(ws + WS_XBC); \
    float* const DC = (float*)(ws + WS_DC); bf16* const CS = (bf16*)(ws + WS_CS); float* const DH = (float*)(ws + WS_DH); bf16* const HS = (bf16*)(ws + WS_HS); \
    (void)WinT; (void)WliftT; (void)WoutT; (void)WupT; (void)WdownT; (void)W16B; (void)XN; (void)P; (void)U; (void)ACT; (void)YCAT; (void)XG; (void)MB; (void)SP; (void)GBc; (void)GGc; (void)GMT; \
    (void)MCAR; (void)MNEW; (void)MSC; (void)DTB; (void)ACB; (void)XBC; (void)DC; (void)CS; (void)DH; (void)HS

    for (int l = args.l_lo; l < args.l_hi; ++l)
    for (int grp = args.g_lo; grp < args.g_hi; ++grp) {

        REPS(PH_W) if (IN(PH_W) && grp == 0) {
            PHASE_BEGIN();
            LAS float* scr = (LAS float*)(lds + wave * 16384);
            constexpr int I_IN = 16 * 320, I_LF = 4 * 8 * 32, I_OUT = 16 * 32, I_UP = 16 * 176, I_DN = 44 * 32, NIT = I_IN + I_LF + I_OUT + I_UP + I_DN;
            for (int it = gw; it < NIT; it += NGW) {
                int r = it;
                if (r < I_IN) { const int kb = r / 320, nb = r % 320, n0 = 32 * nb, ns = n0 + (n0 >= P_SQ ? 16 : (n0 >= P_BB ? 8 : 0));
                    transpose_item(ka->in[I_WIN] + (size_t)l * DM * PIN, PIN, ns, 64 * kb, WinT, DM, n0, scr, lane); continue; } r -= I_IN;
                if (r < I_LF) { const int br = r / 256, q = r % 256, kb = q / 32, nb = q % 32;
                    transpose_item(ka->in[I_WLIFT] + (size_t)(l * 4 + br) * 512 * DM, DM, 32 * nb, 64 * kb, WliftT + (size_t)br * DM * 512, 512, 32 * nb, scr, lane, br == 2 ? ka->in[I_CNG] + (size_t)l * 512 : nullptr); continue; } r -= I_LF;
                if (r < I_OUT) { const int kb = r / 32, nb = r % 32;
                    transpose_item(ka->in[I_WOUT] + (size_t)l * DM * DM, DM, 32 * nb, 64 * kb, WoutT, DM, 32 * nb, scr, lane); continue; } r -= I_OUT;
                if (r < I_UP) { const int kb = r / 176, nb = r % 176, n0 = 32 * nb, tp = n0 >> 8, j = n0 & 255, ns = (j < 128) ? 128 * tp + j : 2816 + 128 * tp + (j - 128);
                    transpose_item(ka->in[I_WUP] + (size_t)l * DM * DFF2, DFF2, ns, 64 * kb, WupT, DM, n0, scr, lane); continue; } r -= I_UP;
                { const int kb = r / 32, nb = r % 32;
                    transpose_item(ka->in[I_WDOWN] + (size_t)l * DFF * DM, DM, 32 * nb, 64 * kb, WdownT, DFF, 32 * nb, scr, lane); }
            }
            for (int i = gt; i < 16 * DM; i += NGT) { const int c = i >> 10, k = i & 1023; const int oc = (c < 8) ? (1536 + c) : (4616 + (c - 8));
                const float w = ka->in[I_WIN][(size_t)l * DM * PIN + (size_t)k * PIN + oc]; const unsigned hi = f2bf(w);
                W16B[i] = (bf16)hi; W16B[16 * DM + i] = (bf16)f2bf(w - bf2f(hi)); }
            if (l == 0) {
                const float* gain = ka->in[I_MIXG];
                f32x4 gv[4];
#pragma unroll
                for (int j = 0; j < 4; ++j) gv[j] = ((const f32x4*)gain)[lane + 64 * j];
                for (int m = gw; m < BATCH * SEQ; m += NGW) {
                    const f32x4* xr = (const f32x4*)(ka->in[I_X] + (size_t)m * DM) + lane;
                    f32x4 v[4]; float sq = 0.f;
#pragma unroll
                    for (int j = 0; j < 4; ++j) { v[j] = xr[64 * j]; sq += (v[j].x * v[j].x + v[j].y * v[j].y) + (v[j].z * v[j].z + v[j].w * v[j].w); }
                    sq = wave_sum(sq); if (lane < 16) SSQ1[(size_t)m * 16 + lane] = (lane == 0) ? sq : 0.f;
                    u32x2* o8 = (u32x2*)(XG + (size_t)m * DM) + lane;
#pragma unroll
                    for (int j = 0; j < 4; ++j) { const f32x4 y = v[j] * gv[j]; o8[64 * j] = (u32x2){pk2(y.x, y.y), pk2(y.z, y.w)}; }
                }
            }
            GRID_BAR();
        }

        REPS(PH_INPROJ) if (IN(PH_INPROJ)) {
            PHASE_BEGIN();
            const bf16* XGg = XG + grow0 * DM; const float* ssq = SSQ1 + grow0 * 16;
            for (int rb = blk; rb < T / 64; rb += NBLK) {
                const int r0 = rb * 64 + 16 * (wave & 3), kh = (wave >> 2) * 512; f32x4 acc = zero4(), acc2 = zero4();
#pragma unroll 8
                for (int ks = 0; ks < 16; ++ks) { const bf16x8 a = gfrag_kc(XGg, DM, r0, kh + 32 * ks, lane);
                    acc = MFMA16(a, gfrag_kc(W16B, DM, 0, kh + 32 * ks, lane), acc); acc2 = MFMA16(a, gfrag_kc(W16B + 16 * DM, DM, 0, kh + 32 * ks, lane), acc2); }
                acc += acc2;
                LAS f32x4* xch = (LAS f32x4*)lds;
                if (wave >= 4) xch[(wave - 4) * 64 + lane] = acc;
                __syncthreads();
                if (wave < 4) { acc += xch[wave * 64 + lane];
#pragma unroll
                    for (int i = 0; i < 4; ++i) { const int row = r0 + 4 * (lane >> 4) + i; SP[(size_t)row * 16 + (lane & 15)] = acc[i] * row_rstd(ssq + (size_t)row * 16); } }
                __syncthreads();
            }
            pg8::Gemm g{XGg, WinT, DM, DM, DM, 0, 0}; pg8::Order S; S.init(T, PW, NBLK, blk, 1);
            pg8::EpiBf16 E{P, PW, ssq};
            pg8::gemm_phase<pg8::EpiBf16, GEMM_ALIGN>(lds, g, S, E);
            GRID_BAR();
        }

        REPS(PH_M0) if (IN(PH_M0)) {
            PHASE_BEGIN();
            for (int task = gw; task < GB * 4; task += NGW) {
                const int bl = task >> 2, h = task & 3; float mcar = 0.f;
                const float igb = ka->in[I_AIB][l * 4 + h], fgb = ka->in[I_AFB][l * 4 + h];
                float igv[NCH], fgv[NCH];
#pragma unroll
                for (int c = 0; c < NCH; ++c) { const size_t m = (size_t)bl * SEQ + c * 64 + lane; igv[c] = SP[m * 16 + h]; fgv[c] = SP[m * 16 + 4 + h]; }
#pragma unroll
                for (int c = 0; c < NCH; ++c) {
                    const size_t m = (size_t)bl * SEQ + c * 64 + lane;
                    const float ig = igv[c] + igb, fg = fgv[c] + fgb;
                    const float b = wscan_add(logsigf_(fg), lane);
                    const float gg = ig - b;
                    const float pm = wscan_max(gg, lane);
                    GBc[m * 4 + h] = b; GGc[m * 4 + h] = gg; GMT[m * 4 + h] = b + fmaxf(mcar, pm);
                    const float bL = __shfl(b, 63), gmax = __shfl(pm, 63);
                    const float mnew = bL + fmaxf(mcar, gmax);
                    if (lane == 0) { MCAR[task * NCH + c] = mcar; MNEW[task * NCH + c] = mnew; MSC[task * NCH + c] = __expf(bL + mcar - mnew); }
                    mcar = mnew;
                }
            }
            for (int task = gw; task < GB * NCH; task += NGW) {
                const size_t m = (size_t)task * 64 + lane;
#pragma unroll
                for (int hd = 0; hd < 8; ++hd) {
                    const float dt = softplusf_(SP[m * 16 + 8 + hd] + ka->in[I_CDTB][l * 8 + hd]);
                    const float a = wscan_add(-dt * __expf(ka->in[I_CALOG][l * 8 + hd]), lane);
                    DTB[m * 8 + hd] = dt; ACB[m * 8 + hd] = a;
                }
            }
            {
                const float* cw = ka->in[I_CCW] + (size_t)l * 4 * 1024; const float* cb = ka->in[I_CCB] + (size_t)l * 1024;
                constexpr int RUN = 16;
                for (int i = gt; i < (T / RUN) * 128; i += NGT) {
                    const int rb = i >> 7, c8 = (i & 127) * 8, m0 = rb * RUN, t0 = m0 & (SEQ - 1);
                    float w[4][8], bb[8];
#pragma unroll
                    for (int e = 0; e < 8; ++e) { bb[e] = cb[c8 + e];
#pragma unroll
                        for (int j = 0; j < 4; ++j) w[j][e] = cw[j * 1024 + c8 + e]; }
                    const u32x4 zz = uzero4(); u32x4 win[4]; win[0] = zz; win[1] = zz; win[2] = zz;
                    if (t0 >= 3) { const bf16* pr = P + (size_t)(m0 - 3) * PW + P_CX + c8; win[0] = *(const u32x4*)pr; win[1] = *(const u32x4*)(pr + PW); win[2] = *(const u32x4*)(pr + 2 * PW); }
#pragma unroll 4
                    for (int rr = 0; rr < RUN; ++rr) {
                        win[3] = *(const u32x4*)(P + (size_t)(m0 + rr) * PW + P_CX + c8);
                        float acc[8];
#pragma unroll
                        for (int e = 0; e < 8; ++e) acc[e] = bb[e];
#pragma unroll
                        for (int j = 0; j < 4; ++j) {
                            acc[0] += w[j][0] * bf2f(win[j].x & 0xffffu); acc[1] += w[j][1] * bf2f(win[j].x >> 16); acc[2] += w[j][2] * bf2f(win[j].y & 0xffffu); acc[3] += w[j][3] * bf2f(win[j].y >> 16);
                            acc[4] += w[j][4] * bf2f(win[j].z & 0xffffu); acc[5] += w[j][5] * bf2f(win[j].z >> 16); acc[6] += w[j][6] * bf2f(win[j].w & 0xffffu); acc[7] += w[j][7] * bf2f(win[j].w >> 16); }
                        u32x4 o; o.x = pk2(siluf_(acc[0]), siluf_(acc[1])); o.y = pk2(siluf_(acc[2]), siluf_(acc[3])); o.z = pk2(siluf_(acc[4]), siluf_(acc[5])); o.w = pk2(siluf_(acc[6]), siluf_(acc[7]));
                        *(u32x4*)(XBC + (size_t)(m0 + rr) * 1024 + c8) = o;
                        win[0] = win[1]; win[1] = win[2]; win[2] = win[3];
                    }
                }
            }
            {
                const float* bw = ka->in[I_BCW] + (size_t)l * 3 * 512;
                constexpr int RUN = 16;
                for (int i = gt; i < (T / RUN) * 64; i += NGT) {
                    const int rb = i >> 6, c8 = (i & 63) * 8, m0 = rb * RUN, t0 = m0 & (SEQ - 1);
                    float w[3][8];
#pragma unroll
                    for (int e = 0; e < 8; ++e)
#pragma unroll
                        for (int j = 0; j < 3; ++j) w[j][e] = bw[j * 512 + c8 + e];
                    float pw[3][8];
#pragma unroll
                    for (int e = 0; e < 8; ++e) { pw[0][e] = 0.f; pw[1][e] = 0.f; }
                    if (t0 >= 2) {
#pragma unroll
                        for (int j = 0; j < 2; ++j) { const bf16* pr = P + (size_t)(m0 - 2 + j) * PW; const u32x4 a = *(const u32x4*)(pr + P_BC + c8), b = *(const u32x4*)(pr + P_BX + c8);
                            pw[j][0] = bf2f(a.x & 0xffffu) * bf2f(b.x & 0xffffu); pw[j][1] = bf2f(a.x >> 16) * bf2f(b.x >> 16); pw[j][2] = bf2f(a.y & 0xffffu) * bf2f(b.y & 0xffffu); pw[j][3] = bf2f(a.y >> 16) * bf2f(b.y >> 16);
                            pw[j][4] = bf2f(a.z & 0xffffu) * bf2f(b.z & 0xffffu); pw[j][5] = bf2f(a.z >> 16) * bf2f(b.z >> 16); pw[j][6] = bf2f(a.w & 0xffffu) * bf2f(b.w & 0xffffu); pw[j][7] = bf2f(a.w >> 16) * bf2f(b.w >> 16); } }
#pragma unroll 4
                    for (int rr = 0; rr < RUN; ++rr) {
                        const bf16* pr = P + (size_t)(m0 + rr) * PW; const u32x4 a = *(const u32x4*)(pr + P_BC + c8), b = *(const u32x4*)(pr + P_BX + c8), g = *(const u32x4*)(pr + P_BB + c8);
                        pw[2][0] = bf2f(a.x & 0xffffu) * bf2f(b.x & 0xffffu); pw[2][1] = bf2f(a.x >> 16) * bf2f(b.x >> 16); pw[2][2] = bf2f(a.y & 0xffffu) * bf2f(b.y & 0xffffu); pw[2][3] = bf2f(a.y >> 16) * bf2f(b.y >> 16);
                        pw[2][4] = bf2f(a.z & 0xffffu) * bf2f(b.z & 0xffffu); pw[2][5] = bf2f(a.z >> 16) * bf2f(b.z >> 16); pw[2][6] = bf2f(a.w & 0xffffu) * bf2f(b.w & 0xffffu); pw[2][7] = bf2f(a.w >> 16) * bf2f(b.w >> 16);
                        float acc[8];
#pragma unroll
                        for (int e = 0; e < 8; ++e) acc[e] = w[0][e] * pw[0][e] + w[1][e] * pw[1][e] + w[2][e] * pw[2][e];
                        u32x4 o; o.x = pk2(acc[0] * bf2f(g.x & 0xffffu), acc[1] * bf2f(g.x >> 16)); o.y = pk2(acc[2] * bf2f(g.y & 0xffffu), acc[3] * bf2f(g.y >> 16));
                        o.z = pk2(acc[4] * bf2f(g.z & 0xffffu), acc[5] * bf2f(g.z >> 16)); o.w = pk2(acc[6] * bf2f(g.w & 0xffffu), acc[7] * bf2f(g.w >> 16));
                        *(u32x4*)(YCAT + (size_t)(m0 + rr) * YW + 512 + c8) = o;
#pragma unroll
                        for (int e = 0; e < 8; ++e) { pw[0][e] = pw[1][e]; pw[1][e] = pw[2][e]; }
                    }
                }
            }
            GRID_BAR();
        }

        REPS(PH_M1) if (IN(PH_M1)) {
            PHASE_BEGIN();
            constexpr int NUA = GB * 4 * NCH, NUC = GB * NCH;
            for (int u = blk; u < NUA + NUC; u += NBLK) {
                if (u < NUA) {
                    const int ua = u, bh = ua >> 5, c = ua & 31, bl = bh >> 2, h = bh & 3; const size_t m0 = (size_t)bl * SEQ + c * 64;
                    LAS bf16* VP = (LAS bf16*)lds; LAS bf16* WK = (LAS bf16*)(lds + 64 * 152 * 2);
                    const float bL = GBc[(m0 + 63) * 4 + h], mnew = MNEW[ua];
                    for (int i = tid; i < 1024; i += NTHR) { const int s = i >> 4, c8 = i & 15; *(LAS u32x4*)(VP + s * 152 + c8 * 8) = *(const u32x4*)(P + (m0 + s) * PW + P_AV + h * 128 + c8 * 8); }
                    if (tid < 64) { *(LAS u32x4*)(VP + tid * 152 + 128) = uone4(); *(LAS u32x4*)(VP + tid * 152 + 136) = uzero4(); }
                    { const int s = tid >> 3, c8 = tid & 7; const float w = __expf(bL + GGc[(m0 + s) * 4 + h] - mnew);
                      *(LAS u32x4*)(WK + s * 72 + c8 * 8) = scale8(*(const u32x4*)(P + (m0 + s) * PW + P_AK + h * 64 + c8 * 8), w); }
                    __syncthreads();
                    for (int ti = wave; ti < 36; ti += NWAVES) { const int mt = ti >> 2, nt = ti & 3; f32x4 acc = zero4();
#pragma unroll
                        for (int ks = 0; ks < 2; ++ks) acc = MFMA16(frag_ks(VP, 152, 16 * mt, 32 * ks, lane), frag_ks(WK, 72, 16 * nt, 32 * ks, lane), acc);
                        float* d = DC + (size_t)ua * 9216 + (16 * mt + 4 * (lane >> 4)) * 64 + 16 * nt + (lane & 15);
#pragma unroll
                        for (int i = 0; i < 4; ++i) d[i * 64] = acc[i]; }
                    __syncthreads();
                } else {
                    const int uc = u - NUA, bl = uc >> 5, c = uc & 31, hd = wave, gi = hd >> 2; const size_t m0 = (size_t)bl * SEQ + c * 64;
                    LAS bf16* XW = (LAS bf16*)(lds + hd * (64 * 72 * 2)); LAS bf16* BMs = (LAS bf16*)(lds + 8 * 64 * 72 * 2);
                    const float alast = ACB[(m0 + 63) * 8 + hd];
#pragma unroll
                    for (int k = 0; k < 8; ++k) { const int i = lane + 64 * k, s = i >> 3, c8 = i & 7; const float wd = __expf(alast - ACB[(m0 + s) * 8 + hd]) * DTB[(m0 + s) * 8 + hd];
                        *(LAS u32x4*)(XW + s * 72 + c8 * 8) = scale8(*(const u32x4*)(XBC + (m0 + s) * 1024 + hd * 64 + c8 * 8), wd); }
                    for (int i = tid; i < 2048; i += NTHR) { const int g2 = i >> 10, rem = i & 1023, s = rem >> 4, c8 = rem & 15;
                        *(LAS u32x4*)(BMs + g2 * (64 * 136) + s * 136 + c8 * 8) = *(const u32x4*)(XBC + (m0 + s) * 1024 + 512 + g2 * 128 + c8 * 8); }
                    __syncthreads();
                    const LAS bf16* BMg = BMs + gi * (64 * 136);
                    for (int pt = 0; pt < 4; ++pt) { f32x4 acc[8];
#pragma unroll
                        for (int n = 0; n < 8; ++n) acc[n] = zero4();
#pragma unroll
                        for (int ks = 0; ks < 2; ++ks) { const bf16x8 a = frag_ks(XW, 72, 16 * pt, 32 * ks, lane);
#pragma unroll
                            for (int n = 0; n < 8; ++n) acc[n] = MFMA16(a, frag_ks(BMg, 136, 16 * n, 32 * ks, lane), acc[n]); }
                        float* d = DH + ((size_t)(uc * 8 + hd) * 64 + 16 * pt + 4 * (lane >> 4)) * 128 + (lane & 15);
#pragma unroll
                        for (int n = 0; n < 8; ++n)
#pragma unroll
                            for (int i = 0; i < 4; ++i) d[i * 128 + 16 * n] = acc[n][i]; }
                    __syncthreads();
                }
            }
            GRID_BAR();
        }

        REPS(PH_M2) if (IN(PH_M2)) {
            PHASE_BEGIN();
            constexpr int NA = GB * 4 * 2304, NC = GB * 8 * 2048;
            for (int i = gt; i < NA + NC; i += NGT) {
                f32x4 st = zero4();
                if (i < NA) { const int bh = i / 2304, e = (i - bh * 2304) * 4;
                    for (int c = 0; c < NCH; ++c) { const size_t ua = (size_t)bh * NCH + c;
                        *(u32x2*)(CS + ua * 9216 + e) = (u32x2){pk2(st.x, st.y), pk2(st.z, st.w)};
                        st = st * MSC[ua] + *(const f32x4*)(DC + ua * 9216 + e); }
                } else { const int j = i - NA, bhd = j >> 11, e = (j & 2047) * 4, bl = bhd >> 3, hd = bhd & 7;
                    for (int c = 0; c < NCH; ++c) { const size_t uh = (size_t)(bl * NCH + c) * 8 + hd;
                        *(u32x2*)(HS + uh * 8192 + e) = (u32x2){pk2(st.x, st.y), pk2(st.z, st.w)};
                        st = st * __expf(ACB[((size_t)bl * SEQ + c * 64 + 63) * 8 + hd]) + *(const f32x4*)(DH + uh * 8192 + e); }
                }
            }
            GRID_BAR();
        }

        REPS(PH_M3) if (IN(PH_M3)) {
            PHASE_BEGIN();
            constexpr int NUA = GB * 4 * NCH, NUC = 2 * GB * NCH;
            for (int u = blk; u < NUA + NUC; u += NBLK) {
                const int r = lane & 15, g4 = lane >> 4;
                if (u < NUA) {
                    const int ua = u, bh = ua >> 5, c = ua & 31, bl = bh >> 2, h = bh & 3; const size_t m0 = (size_t)bl * SEQ + c * 64;
                    LAS bf16* Qs = (LAS bf16*)lds; LAS bf16* Ks = Qs + 64 * 72; LAS bf16* VP = Ks + 64 * 72; LAS bf16* CST = VP + 64 * 152; LAS bf16* SMT = CST + 144 * 72; LAS bf16* AOT = SMT + 64 * 72;
                    LAS float* GS = (LAS float*)(AOT + 64 * 136);
                    LAS float* SSQ = GS + 256;
                    const float mcar = MCAR[ua];
                    { const int s = tid >> 3, c8 = tid & 7; const bf16* pr = P + (m0 + s) * PW + h * 64 + c8 * 8;
                      *(LAS u32x4*)(Qs + s * 72 + c8 * 8) = *(const u32x4*)(pr + P_AQ); *(LAS u32x4*)(Ks + s * 72 + c8 * 8) = *(const u32x4*)(pr + P_AK); }
                    for (int i = tid; i < 1024; i += NTHR) { const int s = i >> 4, c8 = i & 15; const bf16* pr = P + (m0 + s) * PW + h * 128 + c8 * 8;
                        *(LAS u32x4*)(VP + s * 152 + c8 * 8) = *(const u32x4*)(pr + P_AV); *(LAS u32x4*)(AOT + s * 136 + c8 * 8) = *(const u32x4*)(pr + P_AO); }
                    if (tid < 64) { *(LAS u32x4*)(VP + tid * 152 + 128) = uone4(); *(LAS u32x4*)(VP + tid * 152 + 136) = uzero4(); }
                    for (int i = tid; i < 1152; i += NTHR) { const int dv = i >> 3, c8 = i & 7; *(LAS u32x4*)(CST + dv * 72 + c8 * 8) = *(const u32x4*)(CS + (size_t)ua * 9216 + dv * 64 + c8 * 8); }
                    if (tid < 192) { const int arr = tid >> 6, s = tid & 63; const float* src = (arr == 0) ? GBc : (arr == 1) ? GGc : GMT; GS[arr * 64 + s] = src[(m0 + s) * 4 + h]; }
                    __syncthreads();
#pragma unroll
                    for (int q2 = 0; q2 < 2; ++q2) { const int ti = 2 * wave + q2, tt = ti >> 2, st = ti & 3;
                        f32x4 acc = zero4();
                        if (st <= tt) {
#pragma unroll
                            for (int ks = 0; ks < 2; ++ks) acc = MFMA16(frag_kc(Qs, 72, 16 * tt, 32 * ks, lane), frag_kc(Ks, 72, 16 * st, 32 * ks, lane), acc);
                            const int s = 16 * st + r; const float gs = GS[64 + s];
#pragma unroll
                            for (int i = 0; i < 4; ++i) { const int t = 16 * tt + 4 * g4 + i; const float e = GS[t] - GS[128 + t] + gs;
                                acc[i] = (s <= t) ? acc[i] * 0.125f * __expf(e) : 0.f; }
                        }
                        *(LAS u32x2*)(SMT + (16 * st + r) * 72 + 16 * tt + 4 * g4) = (u32x2){pk2(acc[0], acc[1]), pk2(acc[2], acc[3])}; }
                    __syncthreads();
                    const int tt = wave & 3, half = wave >> 2;
                    f32x4 a1[5], a2[5];
#pragma unroll
                    for (int j = 0; j < 5; ++j) { a1[j] = zero4(); a2[j] = zero4(); }
#pragma unroll
                    for (int ks = 0; ks < 2; ++ks) { const bf16x8 fa1 = frag_ks(SMT, 72, 16 * tt, 32 * ks, lane), fa2 = frag_kc(Qs, 72, 16 * tt, 32 * ks, lane);
#pragma unroll
                        for (int j = 0; j < 5; ++j) { const int dvt = (j < 4) ? half * 4 + j : 8;
                            a1[j] = MFMA16(fa1, frag_ks(VP, 152, 16 * dvt, 32 * ks, lane), a1[j]);
                            a2[j] = MFMA16(fa2, frag_kc(CST, 72, 16 * dvt, 32 * ks, lane), a2[j]); } }
                    float hv[4][4], ssq[4];
#pragma unroll
                    for (int i = 0; i < 4; ++i) { const int t = 16 * tt + 4 * g4 + i; const float b = GS[t], mt = GS[128 + t];
                        const float is = 0.125f * __expf(b + mcar - mt);
                        float den = a1[4][i] + is * a2[4][i]; den = __shfl(den, lane & 48);
                        const float dn = __builtin_amdgcn_rcpf(fmaxf(fabsf(den), __expf(-mt))); float q = 0.f;
#pragma unroll
                        for (int j = 0; j < 4; ++j) { const float v = (a1[j][i] + is * a2[j][i]) * dn; hv[j][i] = v; q += v * v; }
                        q += __shfl_xor(q, 1); q += __shfl_xor(q, 2); q += __shfl_xor(q, 4); q += __shfl_xor(q, 8); ssq[i] = q; }
                    if (r == 0) {
#pragma unroll
                        for (int i = 0; i < 4; ++i) SSQ[half * 64 + 16 * tt + 4 * g4 + i] = ssq[i]; }
                    __syncthreads();
                    const float* ng = ka->in[I_ANG] + (size_t)l * 512 + h * 128;
#pragma unroll
                    for (int i = 0; i < 4; ++i) { const int t = 16 * tt + 4 * g4 + i; const float rstd = rsqrtf((SSQ[t] + SSQ[64 + t]) * (1.f / 128.f) + EPS);
#pragma unroll
                        for (int j = 0; j < 4; ++j) { const int dv = 16 * (half * 4 + j) + r; LAS bf16* op = AOT + t * 136 + dv;
                            *op = (bf16)f2bf(sigmoidf_(bf2f(*op)) * hv[j][i] * rstd * ng[dv]); } }
                    __syncthreads();
                    for (int i = tid; i < 1024; i += NTHR) { const int s = i >> 4, c8 = i & 15; *(u32x4*)(YCAT + (m0 + s) * YW + h * 128 + c8 * 8) = *(const LAS u32x4*)(AOT + s * 136 + c8 * 8); }
                    __syncthreads();
                } else {
                    const int uc2 = u - NUA, bl = uc2 >> 6, c = (uc2 >> 1) & 31, gi = uc2 & 1, hl = wave & 3, th = wave >> 2, hd = gi * 4 + hl; const size_t m0 = (size_t)bl * SEQ + c * 64;
                    LAS bf16* XHs = (LAS bf16*)lds;
                    LAS bf16* HTs = (LAS bf16*)(lds + 36864);
                    LAS bf16* BMg = (LAS bf16*)(lds + 36864 + 69632);
                    LAS bf16* MTt = (LAS bf16*)(lds + 36864 + 69632 + 17408 + wave * 3072);
                    LAS float* ADs = (LAS float*)(lds + 36864 + 69632 + 17408 + 24576);
                    const bf16* Xb = XBC + m0 * 1024;
                    for (int i = tid; i < 2048; i += NTHR) { const int h4 = i >> 9, rem = i & 511, s = rem >> 3, c8 = rem & 7;
                        *(LAS u32x4*)(XHs + h4 * (64 * 72) + s * 72 + c8 * 8) = *(const u32x4*)((Xb + gi * 256) + (unsigned)(s * 1024 + h4 * 64 + c8 * 8)); }
                    { const bf16* Hb = HS + (size_t)((bl * NCH + c) * 8 + gi * 4) * 8192;
                      for (int i = tid; i < 4096; i += NTHR) { const int h4 = i >> 10, rem = i & 1023, p = rem >> 4, c8 = rem & 15;
                        *(LAS u32x4*)(HTs + h4 * (64 * 136) + p * 136 + c8 * 8) = *(const u32x4*)(Hb + (unsigned)(h4 * 8192 + p * 128 + c8 * 8)); } }
                    for (int i = tid; i < 1024; i += NTHR) { const int s = i >> 4, c8 = i & 15; *(LAS u32x4*)(BMg + s * 136 + c8 * 8) = *(const u32x4*)((Xb + 512 + gi * 128) + (unsigned)(s * 1024 + c8 * 8)); }
                    { const int h4 = tid >> 7, arr = (tid >> 6) & 1, s = tid & 63; const float* src = arr ? DTB : ACB; ADs[tid] = (src + m0 * 8 + gi * 4)[(unsigned)(s * 8 + h4)]; }
                    const LAS bf16* XH = XHs + hl * (64 * 72); const LAS bf16* HT = HTs + hl * (64 * 136); const LAS float* AD = ADs + hl * 128;
                    const bf16* Cm = Xb + 768 + gi * 128; const bf16* Zp = P + m0 * PW + P_CZ + hd * 64; const unsigned zlane = (unsigned)(4 * g4 * PW + r), ylane = (unsigned)(4 * g4 * YW + r);
                    bf16* Yp = YCAT + m0 * YW + 1024 + hd * 64; float* Sp = SSQC + m0 * 8 + hd;
                    bf16x8 fcn[4];
#pragma unroll
                    for (int ks = 0; ks < 4; ++ks) fcn[ks] = gfrag_kc(Cm, 1024, 16 * th, 32 * ks, lane);
                    const float dsk = ka->in[I_CDSKIP][l * 8 + hd];
                    __syncthreads();
#pragma unroll 1
                    for (int k2 = 0; k2 < 2; ++k2) { const int tt = k2 ? 3 - th : th;
                        bf16x8 fcm[4]; unsigned short zc[4][4];
#pragma unroll
                        for (int ks = 0; ks < 4; ++ks) fcm[ks] = fcn[ks];
#pragma unroll
                        for (int p = 0; p < 4; ++p)
#pragma unroll
                            for (int i = 0; i < 4; ++i) zc[p][i] = (Zp + (size_t)(16 * tt + i) * PW + 16 * p)[zlane];
#pragma unroll
                        for (int ks = 0; ks < 4; ++ks) fcn[ks] = gfrag_kc(Cm, 1024, 16 * (3 - th), 32 * ks, lane);
                        float at[4];
#pragma unroll
                        for (int i = 0; i < 4; ++i) at[i] = AD[16 * tt + 4 * g4 + i];
#pragma unroll 1
                        for (int st = 0; st <= tt; ++st) { f32x4 acc = zero4();
#pragma unroll
                            for (int ks = 0; ks < 4; ++ks) acc = MFMA16(fcm[ks], frag_kc(BMg, 136, 16 * st, 32 * ks, lane), acc);
                            const int s = 16 * st + r; const float as = AD[s], dts = AD[64 + s];
#pragma unroll
                            for (int i = 0; i < 4; ++i) { const int t = 16 * tt + 4 * g4 + i; acc[i] = (s <= t) ? acc[i] * __expf(at[i] - as) * dts : 0.f; if (s == t) acc[i] += dsk; }
                            *(LAS u32x2*)(MTt + (16 * st + r) * 24 + 4 * g4) = (u32x2){pk2(acc[0], acc[1]), pk2(acc[2], acc[3])}; }
                        if ((tt & 1) == 0) *(LAS u32x2*)(MTt + (16 * (tt + 1) + r) * 24 + 4 * g4) = (u32x2){uzero4().x, uzero4().y};
                        LDS_WAIT(); asm volatile("" ::: "memory");
                        f32x4 ad[4], ao[4];
#pragma unroll
                        for (int p = 0; p < 4; ++p) { ad[p] = zero4(); ao[p] = zero4(); }
#pragma unroll 1
                        for (int ks = 0; ks <= (tt >> 1); ++ks) { const bf16x8 fa = frag_ks(MTt, 24, 0, 32 * ks, lane);
#pragma unroll
                            for (int p = 0; p < 4; ++p) ad[p] = MFMA16(fa, frag_ks(XH, 72, 16 * p, 32 * ks, lane), ad[p]); }
#pragma unroll
                        for (int ks = 0; ks < 4; ++ks)
#pragma unroll
                            for (int p = 0; p < 4; ++p) ao[p] = MFMA16(fcm[ks], frag_kc(HT, 136, 16 * p, 32 * ks, lane), ao[p]);
#pragma unroll
                        for (int i = 0; i < 4; ++i) { const float ea = __expf(at[i]); float q = 0.f;
#pragma unroll
                            for (int p = 0; p < 4; ++p) { const float y = (ad[p][i] + ea * ao[p][i]) * siluf_(bf2f(zc[p][i])); q += y * y;
                                (Yp + (size_t)(16 * tt + i) * YW + 16 * p)[ylane] = (bf16)f2bf(y); }
                            q += __shfl_xor(q, 1); q += __shfl_xor(q, 2); q += __shfl_xor(q, 4); q += __shfl_xor(q, 8);
                            if (r == 0) (Sp + (16 * tt + i) * 8)[(unsigned)(32 * g4)] = q; }
                        LDS_WAIT(); asm volatile("" ::: "memory");
                    }
                    __syncthreads();
                }
            }
            GRID_BAR();
        }

        REPS(PH_ATT) if (IN(PH_ATT)) {
            PHASE_BEGIN();
            LAS bf16* Qs = (LAS bf16*)lds; LAS bf16* Ks = Qs + 128 * 136; LAS bf16* Vs = Ks + 64 * 136; LAS bf16* Aw = Vs + 64 * 136 + wave * (16 * 72);
            const int r = lane & 15, g4 = lane >> 4;
            for (int u = blk; u < GB * 4 * 16; u += NBLK) {
                const int bl = u >> 6, h = (u >> 4) & 3, qt = u & 15; const size_t mb = (size_t)bl * SEQ; const int q0 = qt * 128;
                volatile LAS unsigned* FLG = (volatile LAS unsigned*)(lds + MISC_OFF + 128);
                int par = 0;
                __syncthreads();
                if (lane == 0) { FLG[wave] = 0u; FLG[8 + wave] = 0u; }
                for (int i = tid; i < 2048; i += NTHR) { const int s = i >> 4, c8 = i & 15; *(LAS u32x4*)(Qs + s * 136 + c8 * 8) = *(const u32x4*)(P + (mb + q0 + s) * PW + P_SQ + h * 128 + c8 * 8); }
                f32x4 O[8];
#pragma unroll
                for (int d = 0; d < 8; ++d) O[d] = zero4();
                float racc = 0.f; const int tq = q0 + 16 * wave + r;
                for (int kt = 2 * qt + 1; kt >= 0; --kt) {
                    const int s0 = kt * 64;
                    __syncthreads();
                    { unsigned alldone = 1u;
#pragma unroll
                      for (int w8 = 0; w8 < 8; ++w8) alldone &= FLG[par * 8 + w8];
                      if (__builtin_amdgcn_readfirstlane((int)alldone)) break; }
                    for (int i = tid; i < 1024; i += NTHR) { const int s = i >> 4, c8 = i & 15; const bf16* pr = P + (mb + s0 + s) * PW + h * 128 + c8 * 8;
                        *(LAS u32x4*)(Ks + s * 136 + c8 * 8) = *(const u32x4*)(pr + P_SK); *(LAS u32x4*)(Vs + s * 136 + c8 * 8) = *(const u32x4*)(pr + P_SV); }
                    __syncthreads();
                    if (s0 < q0 + 16 * wave + 15) {
                        f32x4 z[4];
#pragma unroll
                        for (int j = 0; j < 4; ++j) z[j] = zero4();
#pragma unroll
                        for (int ks = 0; ks < 4; ++ks) { const bf16x8 fq = frag_kc(Qs, 136, 16 * wave, 32 * ks, lane);
#pragma unroll
                            for (int j = 0; j < 4; ++j) z[j] = MFMA16(frag_kc(Ks, 136, 16 * j, 32 * ks, lane), fq, z[j]); }
                        float ls[4][4], x[4][4], tsum[4];
#pragma unroll
                        for (int j = 0; j < 4; ++j) { float tj = 0.f;
#pragma unroll
                            for (int i = 0; i < 4; ++i) { const int s = s0 + 16 * j + 4 * g4 + i; const float zz = z[j][i] * 0.08838834764831845f;
                                const float l1 = fminf(zz, 0.f) - __logf(1.f + __expf(-fabsf(zz)));
                                ls[j][i] = l1; x[j][i] = (s < tq) ? (l1 - zz) : 0.f; tj += x[j][i]; }
                            tsum[j] = tj; }
                        float above[4], tot[4];
#pragma unroll
                        for (int j = 0; j < 4; ++j) { const float y1 = __shfl_xor(tsum[j], 16), y2 = __shfl_xor(tsum[j], 32), y3 = __shfl_xor(tsum[j], 48);
                            tot[j] = tsum[j] + y1 + y2 + y3;
                            above[j] = (g4 == 0) ? (y1 + y2 + y3) : (g4 == 1) ? (y2 + y3) : (g4 == 2) ? y1 : 0.f; }
                        float hi = racc;
#pragma unroll
                        for (int j = 3; j >= 0; --j) { float run = hi + above[j]; float av[4];
#pragma unroll
                            for (int i = 3; i >= 0; --i) { const int s = s0 + 16 * j + 4 * g4 + i; av[i] = (s < tq) ? __expf(ls[j][i] + run) : 0.f; run += x[j][i]; }
                            *(LAS u32x2*)(Aw + r * 72 + 16 * j + 4 * g4) = (u32x2){pk2(av[0], av[1]), pk2(av[2], av[3])};
                            hi += tot[j]; }
                        racc = hi;
                        LDS_WAIT(); asm volatile("" ::: "memory");
#pragma unroll
                        for (int ks = 0; ks < 2; ++ks) { const bf16x8 fa = frag_kc(Aw, 72, 0, 32 * ks, lane);
#pragma unroll
                            for (int d = 0; d < 8; ++d) O[d] = MFMA16(fa, frag_ks(Vs, 136, 16 * d, 32 * ks, lane), O[d]); }
                    }
                    par ^= 1;
                    { const bool wd = __all(racc < -104.f); if (lane == 0) FLG[par * 8 + wave] = wd ? 1u : 0u; }
                }
#pragma unroll
                for (int d = 0; d < 8; ++d)
#pragma unroll
                    for (int i = 0; i < 4; ++i) YCAT[(mb + q0 + 16 * wave + 4 * g4 + i) * YW + 1536 + h * 128 + 16 * d + r] = (bf16)f2bf(O[d][i]);
            }
            GRID_BAR();
        }

        REPS(PH_LIFT) if (IN(PH_LIFT)) {
            PHASE_BEGIN();
            pg8::Gemm g{YCAT, WliftT, 512, YW, 512, (size_t)512 * 2, (size_t)DM * 512 * 2}; pg8::Order S; S.init(T, DM, NBLK, blk, 4);
            pg8::EpiLift E{P + P_G, PW, MB, DM, SSQC};
            pg8::gemm_phase<pg8::EpiLift, GEMM_ALIGN>(lds, g, S, E);
            GRID_BAR();
        }
        REPS(PH_OUT) if (IN(PH_OUT)) {
            PHASE_BEGIN();
            pg8::Gemm g{MB, WoutT, DM, DM, DM, 0, 0}; pg8::Order S; S.init(T, DM, NBLK, blk, 1);
            pg8::EpiResid E{xsrc + grow0 * DM, ka->out + grow0 * DM, DM, ka->in[I_FFNG] + (size_t)l * DM, XN, SSQ2};
            pg8::gemm_phase<pg8::EpiResid, GEMM_ALIGN>(lds, g, S, E);
            GRID_BAR();
        }
        REPS(PH_UP) if (IN(PH_UP)) {
            PHASE_BEGIN();
            pg8::Gemm g{XN, WupT, DM, DM, DM, 0, 0}; pg8::Order S; S.init(T, DFF2, NBLK, blk, 1);
            pg8::EpiConvAct E{ACT, SSQ2, ka->in[I_FCW] + (size_t)l * 3 * DFF2, ka->in[I_FCB] + (size_t)l * DFF2, RAWH, lds + 131072, DFF2 / 256};
            pg8::gemm_phase<pg8::EpiConvAct, GEMM_ALIGN>(lds, g, S, E);
            GRID_BAR();
        }
        REPS(PH_DOWN) if (IN(PH_DOWN)) {
            PHASE_BEGIN();
            pg8::Gemm g{ACT, WdownT, DFF, DFF, DFF, 0, 0}; pg8::Order S; S.init(T, DM, NBLK, blk, 1);
            {
                const float* fw = ka->in[I_FCW] + (size_t)l * 3 * DFF2; const float* fb = ka->in[I_FCB] + (size_t)l * DFF2;
                pg8::Unit uu;
                for (int i = 0; S.next(i, uu); ++i) { const int pm = uu.pm; if ((pm & 7) == 0) continue;
                    for (int ch = tid; ch < DFF; ch += NTHR) { const int tp = ch >> 7, j = ch & 127;
                        const float* own = RAWH + (size_t)(pm * 22 + tp) * 1024; const float* prv = RAWH + (size_t)((pm - 1) * 22 + tp) * 1024;
                        const float g254 = prv[2 * 256 + j], g255 = prv[3 * 256 + j], g0 = own[j], g1 = own[256 + j];
                        const float u254 = prv[2 * 256 + 128 + j], u255 = prv[3 * 256 + 128 + j], u0 = own[128 + j], u1 = own[256 + 128 + j];
                        const float wg0 = fw[ch], wg1 = fw[DFF2 + ch], wg2 = fw[2 * DFF2 + ch], wu0 = fw[DFF + ch], wu1 = fw[DFF2 + DFF + ch], wu2 = fw[2 * DFF2 + DFF + ch], bg = fb[ch], bu = fb[DFF + ch];
                        ACT[(size_t)(pm * 256) * DFF + ch] = (bf16)f2bf(siluf_(bg + wg0 * g254 + wg1 * g255 + wg2 * g0) * (bu + wu0 * u254 + wu1 * u255 + wu2 * u0));
                        ACT[(size_t)(pm * 256 + 1) * DFF + ch] = (bf16)f2bf(siluf_(bg + wg0 * g255 + wg1 * g0 + wg2 * g1) * (bu + wu0 * u255 + wu1 * u0 + wu2 * u1)); } }
                asm volatile("s_waitcnt vmcnt(0)" ::: "memory"); __syncthreads();
            }
            const bool more = (l + 1 < DEPTH);
            pg8::EpiResid E{ka->out + grow0 * DM, ka->out + grow0 * DM, DM, more ? ka->in[I_MIXG] + (size_t)(l + 1) * DM : nullptr, XG + grow0 * DM, SSQ1 + grow0 * 16};
            pg8::gemm_phase<pg8::EpiResid, GEMM_ALIGN>(lds, g, S, E);
            GRID_BAR();
        }
        REPS(PH_FINAL) if (IN(PH_FINAL) && l == DEPTH - 1) {
            PHASE_BEGIN();
            const float* gain = ka->in[I_FING];
            f32x4 gv[4];
#pragma unroll
            for (int j = 0; j < 4; ++j) gv[j] = ((const f32x4*)gain)[lane + 64 * j];
            for (int m = gw; m < T; m += NGW) {
                f32x4* xr = (f32x4*)(ka->out + (grow0 + m) * DM) + lane;
                f32x4 v[4]; float s = 0.f;
#pragma unroll
                for (int j = 0; j < 4; ++j) { v[j] = xr[64 * j]; s += (v[j].x * v[j].x + v[j].y * v[j].y) + (v[j].z * v[j].z + v[j].w * v[j].w); }
                const float rstd = rsqrtf(wave_sum(s) * (1.f / DM) + EPS);
#pragma unroll
                for (int j = 0; j < 4; ++j) xr[64 * j] = v[j] * rstd * gv[j];
            }
            GRID_BAR();
        }
    }
#undef IN
#undef GRID_BAR
#undef PHASE_BEGIN
}

#ifndef ONE_LAUNCH
#define ONE_LAUNCH 1
#endif
extern "C" void kernel_launch(void* const* d_in, const int* in_sizes, int n_in, void* d_out, int out_size, void* d_ws, size_t ws_size, hipStream_t stream) {
    static int grid = 0;
    if (grid == 0) {
        if (n_in != N_IN || in_sizes[0] != BATCH * SEQ * DM || out_size != BATCH * SEQ * DM || ws_size < WS_END) {
            fprintf(stderr, "kernel_launch: unexpected shapes / workspace (n_in %d, ws %zu, need %zu); nothing launched\n", n_in, ws_size, (size_t)WS_END); grid = -1; return; }
        int dev = 0, cus = 0, per_cu = 0;
        if (hipGetDevice(&dev) != hipSuccess || hipDeviceGetAttribute(&cus, hipDeviceAttributeMultiprocessorCount, dev) != hipSuccess) { grid = -1; return; }
        if (hipFuncSetAttribute((const void*)fwd, hipFuncAttributeMaxDynamicSharedMemorySize, LDS_BYTES) != hipSuccess) { fprintf(stderr, "kernel_launch: hipFuncSetAttribute failed\n"); grid = -1; return; }
        if (hipOccupancyMaxActiveBlocksPerMultiprocessor(&per_cu, (const void*)fwd, NTHR, LDS_BYTES) != hipSuccess || per_cu < 1) { fprintf(stderr, "kernel_launch: occupancy query says %d\n", per_cu); (void)hipGetLastError(); }
        grid = cus;
    }
    if (grid < 0) return;
    (void)hipMemsetAsync((char*)d_ws + WS_CTL, 0, CTL_BYTES, stream);
    Args a{};
    for (int i = 0; i < N_IN; ++i) a.in[i] = (const float*)d_in[i];
    a.out = (float*)d_out; a.ws = (unsigned char*)d_ws; a.pad = 0;
#if ONE_LAUNCH
    a.l_lo = 0; a.l_hi = DEPTH; a.g_lo = 0; a.g_hi = NG; a.ph_lo = 0; a.ph_hi = PH_COUNT; a.use_bar = 1;
    hipLaunchKernelGGL(fwd, dim3(grid), dim3(NTHR), LDS_BYTES, stream, a);
#else
    a.use_bar = 0;
    for (int l = 0; l < DEPTH; ++l)
        for (int g = 0; g < NG; ++g)
            for (int ph = 0; ph < PH_COUNT; ++ph) {
                if (ph == PH_W && g != 0) continue;
                if (ph == PH_FINAL && l != DEPTH - 1) continue;
                a.l_lo = l; a.l_hi = l + 1; a.g_lo = g; a.g_hi = g + 1; a.ph_lo = ph; a.ph_hi = ph + 1;
                hipLaunchKernelGGL(fwd, dim3(grid), dim3(NTHR), LDS_BYTES, stream, a);
            }
#endif
}
```

```cpp
#include <hip/hip_runtime.h>
#include <cstdio>
#include <cstdint>

#define LAS __attribute__((address_space(3)))
#define GAS __attribute__((address_space(1)))
typedef unsigned short bf16;
typedef short bf16x8 __attribute__((ext_vector_type(8)));
typedef short s16x4 __attribute__((ext_vector_type(4)));
typedef float f32x4 __attribute__((ext_vector_type(4)));
typedef float f32x2 __attribute__((ext_vector_type(2)));
typedef unsigned u32x4 __attribute__((ext_vector_type(4)));
typedef unsigned u32x2 __attribute__((ext_vector_type(2)));

constexpr int DM = 1024, BATCH = 32, SEQ = 2048, DEPTH = 4;
constexpr int PIN = 10256, PW = 10240, DFF = 2816, DFF2 = 5632;
constexpr int GB = 8;
constexpr int NG = BATCH / GB;
constexpr int T = GB * SEQ;
constexpr int NCH = SEQ / 64;
constexpr float EPS = 1e-6f;
constexpr int P_AQ = 0, P_AK = 256, P_AV = 512, P_AO = 1024, P_BB = 1536, P_BC = 2048, P_BX = 2560, P_CZ = 3072, P_CX = 3584, P_SQ = 4608, P_SK = 5120, P_SV = 5632, P_G = 6144;
constexpr int YW = 2048;

constexpr size_t MiB = 1u << 20;
constexpr size_t WS_CTL = 0, CTL_BYTES = 1 * MiB;
constexpr size_t WS_WIN = 1 * MiB;
constexpr size_t WS_WLIFT = WS_WIN + (size_t)PW * DM * 2;
constexpr size_t WS_WOUT = WS_WLIFT + (size_t)4 * DM * 512 * 2;
constexpr size_t WS_WUP = WS_WOUT + (size_t)DM * DM * 2;
constexpr size_t WS_WDOWN = WS_WUP + (size_t)DFF2 * DM * 2;
constexpr size_t WS_W16 = WS_WDOWN + (size_t)DM * DFF * 2;
constexpr size_t WS_XN = WS_W16 + 65536;
constexpr size_t WS_P = WS_XN + (size_t)T * DM * 2;
constexpr size_t WS_U = WS_P, WS_ACT = WS_P + (size_t)T * DFF2 * 2;
constexpr size_t WS_YCAT = WS_P + (size_t)T * PW * 2;
constexpr size_t WS_XG = WS_YCAT + (size_t)T * YW * 2;
constexpr size_t WS_MB = WS_XG + (size_t)BATCH * SEQ * DM * 2;
constexpr size_t WS_SP = WS_MB + (size_t)T * DM * 2;
constexpr size_t WS_GB = WS_SP + (size_t)T * 16 * 4;
constexpr size_t WS_GG = WS_GB + (size_t)T * 16;
constexpr size_t WS_GMT = WS_GG + (size_t)T * 16;
constexpr size_t WS_MCAR = WS_GMT + (size_t)T * 16;
constexpr size_t WS_MNEW = WS_MCAR + 4096;
constexpr size_t WS_MSC = WS_MNEW + 4096;
constexpr size_t WS_DT = WS_MSC + 4096;
constexpr size_t WS_AC = WS_DT + (size_t)T * 32;
constexpr size_t WS_XBC = WS_AC + (size_t)T * 32;
constexpr size_t WS_DC = WS_XBC + (size_t)T * DM * 2;
constexpr size_t WS_CS = WS_DC + (size_t)GB * 4 * NCH * 9216 * 4;
constexpr size_t WS_DH = WS_CS + (size_t)GB * 4 * NCH * 9216 * 2;
constexpr size_t WS_HS = WS_DH + (size_t)GB * NCH * 8 * 8192 * 4;
constexpr size_t WS_SSQ1 = WS_HS + (size_t)GB * NCH * 8 * 8192 * 2;
constexpr size_t WS_SSQ2 = WS_SSQ1 + (size_t)BATCH * SEQ * 64;
constexpr size_t WS_SSQC = WS_SSQ2 + (size_t)T * 64;
constexpr size_t WS_RAWH = WS_SSQC + (size_t)T * 32;
constexpr size_t WS_END = WS_RAWH + (size_t)(T / 256) * 22 * 4 * 256 * 4;

constexpr int NWAVES = 8, NTHR = 512;
constexpr int LDS_BYTES = 155648;
constexpr int MISC_OFF = 153600;

__device__ __forceinline__ float bf2f(unsigned b) { return __uint_as_float(b << 16); }
__device__ __forceinline__ unsigned f2bf(float f) { unsigned u = __float_as_uint(f); return (u + 0x7fffu + ((u >> 16) & 1u)) >> 16; }
__device__ __forceinline__ unsigned pk2(float lo, float hi) { return f2bf(lo) | (f2bf(hi) << 16); }
__device__ __forceinline__ float sigmoidf_(float x) { return __builtin_amdgcn_rcpf(1.f + __builtin_amdgcn_exp2f(-1.4426950408889634f * x)); }
__device__ __forceinline__ float siluf_(float x) { return x * __builtin_amdgcn_rcpf(1.f + __builtin_amdgcn_exp2f(-1.4426950408889634f * x)); }
__device__ __forceinline__ float logsigf_(float x) { return fminf(x, 0.f) - log1pf(expf(-fabsf(x))); }
__device__ __forceinline__ float softplusf_(float x) { return fmaxf(x, 0.f) + log1pf(expf(-fabsf(x))); }
__device__ __forceinline__ float wave_sum(float v) {
#pragma unroll
    for (int o = 1; o < 64; o <<= 1) v += __shfl_xor(v, o);
    return v;
}
#define LDS_WAIT() asm volatile("s_waitcnt lgkmcnt(0)" ::: "memory")
__device__ __forceinline__ float row_rstd(const float* ssq16) {
    const f32x4* p = (const f32x4*)ssq16; const f32x4 a = (p[0] + p[1]) + (p[2] + p[3]);
    return rsqrtf(((a.x + a.y) + (a.z + a.w)) * (1.f / 1024.f) + 1e-6f);
}

namespace pg8 {
constexpr int BM = 256, BK = 64, HALF = 128, HTB = HALF * BK * 2, STAGE_BYTES = 8 * HTB, NXCD = 8, WGM = 8;
__host__ __device__ __forceinline__ int lds_byte(int r, int c) { const int st = (r >> 4) * 2 + (c >> 5), rr = r & 15, cc = c & 31, ob = rr * 64 + cc * 2; return st * 1024 + (ob ^ (((ob >> 9) & 1) << 5)); }
__host__ __device__ __forceinline__ void stage_rc(int b, int& R, int& C) { const int st = b / 1024, sb = b % 1024, swz = sb ^ (((sb >> 9) & 1) << 5); R = (st >> 1) * 16 + swz / 64; C = (st & 1) * 32 + (swz % 64) / 2; }
__host__ __device__ __forceinline__ int perm32(int rho) { const int n = rho >> 4, i = rho & 15; return 8 * (i >> 2) + 4 * n + (i & 3); }

struct Unit { int pm, pn, z; };
struct Gemm { const bf16* A; const bf16* Bt; int K, lda, ldb; size_t zA, zB; };

struct Order {
    int nM, nN, nwg, G, c, Z;
    __device__ __forceinline__ void init(int M, int N, int G_, int c_, int Z_) { nM = M / BM; nN = N / BM; nwg = nM * nN; G = G_; c = c_; Z = Z_; }
    __device__ __forceinline__ bool next(int i, Unit& u) const {
        const int ti = i / Z; u.z = i - ti * Z;
        const long L = (long)ti * G + c; if (L >= nwg) return false;
        int wgid = (int)L; { const int q = nwg / NXCD, r = nwg % NXCD, xcd = wgid % NXCD, off = wgid / NXCD; wgid = (xcd < r ? xcd * (q + 1) : r * (q + 1) + (xcd - r) * q) + off; }
        const int nig = WGM * nN, gid = wgid / nig, fm = gid * WGM, gsz = (nM - fm) < WGM ? (nM - fm) : WGM;
        u.pm = fm + ((wgid % nig) % gsz); u.pn = (wgid % nig) / gsz; return true;
    }
};
__device__ __forceinline__ unsigned cvt_pk_bf16(float lo, float hi) { unsigned r; asm volatile("v_cvt_pk_bf16_f32 %0, %1, %2" : "=v"(r) : "v"(lo), "v"(hi)); return r; }

struct EpiBf16 {
    static constexpr bool PERM = true, KEEP = false, CONTIG = true;
    bf16* O; int ldc; const float* ssq; int gate_pn0;
    static __device__ __forceinline__ float s1(float x) { return 1.f + __builtin_amdgcn_exp2f(-1.4426950408889634f * __builtin_amdgcn_fmed3f(x, -30.f, 30.f)); }
    __device__ __forceinline__ void operator()(f32x4 (&acc)[2][2][4][2], const Unit& u, int wr, int wc, int fr, int fq) const {
        if (u.pn >= gate_pn0) {
            const int row0g = u.pm * BM + wr * 64 + fr, d0 = 64 * (u.pn - gate_pn0) + 16 * wc + 4 * fq;
#pragma unroll
            for (int ai = 0; ai < 2; ++ai)
#pragma unroll
                for (int m = 0; m < 4; ++m) { const int row = row0g + ai * HALF + m * 16; bf16* rowp = O + (size_t)row * ldc + gate_pn0 * BM + d0;
                    float sq; { const f32x4 p = *(const f32x4*)(ssq + (size_t)row * 16 + 4 * fq); sq = (p.x + p.y) + (p.z + p.w); }
                    sq += __shfl_xor(sq, 16); sq += __shfl_xor(sq, 32);
                    const float rs = rsqrtf(sq * (1.f / 1024.f) + 1e-6f);
                    float one = 1.f; asm volatile("" : "+v"(one));
                    float f0[4], f1[4], f2[4], f3[4];
#pragma unroll
                    for (int e = 0; e < 4; ++e) { const float a0 = s1(acc[ai][0][m][0][e] * rs), a1 = s1(acc[ai][0][m][1][e] * rs), a2 = s1(acc[ai][1][m][0][e] * rs), a3 = s1(acc[ai][1][m][1][e] * rs);
                        f0[e] = a1 * __builtin_amdgcn_rcpf(a0); f1[e] = a2 * __builtin_amdgcn_rcpf(a1); f2[e] = a3 * __builtin_amdgcn_rcpf(a2); f3[e] = one * __builtin_amdgcn_rcpf(a3); }
                    *(u32x2*)(rowp) = (u32x2){cvt_pk_bf16(f0[0], f0[1]), cvt_pk_bf16(f0[2], f0[3])};
                    *(u32x2*)(rowp + 1024) = (u32x2){cvt_pk_bf16(f1[0], f1[1]), cvt_pk_bf16(f1[2], f1[3])};
                    *(u32x2*)(rowp + 2048) = (u32x2){cvt_pk_bf16(f2[0], f2[1]), cvt_pk_bf16(f2[2], f2[3])};
                    *(u32x2*)(rowp + 3072) = (u32x2){cvt_pk_bf16(f3[0], f3[1]), cvt_pk_bf16(f3[2], f3[3])}; }
            return; }
        const int row0 = u.pm * BM + wr * 64 + fr, col0 = u.pn * BM + wc * 64 + 8 * fq;
#pragma unroll
        for (int ai = 0; ai < 2; ++ai)
#pragma unroll
            for (int m = 0; m < 4; ++m) { const int row = row0 + ai * HALF + m * 16; bf16* rowp = O + (size_t)row * ldc + col0;
                float sq; { const f32x4 p = *(const f32x4*)(ssq + (size_t)row * 16 + 4 * fq); sq = (p.x + p.y) + (p.z + p.w); }
                sq += __shfl_xor(sq, 16); sq += __shfl_xor(sq, 32);
                const float rs = rsqrtf(sq * (1.f / 1024.f) + 1e-6f);
#pragma unroll
                for (int bj = 0; bj < 2; ++bj) { const f32x4 v0 = acc[ai][bj][m][0] * rs, v1 = acc[ai][bj][m][1] * rs;
                    u32x4 w; w.x = cvt_pk_bf16(v0[0], v0[1]); w.y = cvt_pk_bf16(v0[2], v0[3]); w.z = cvt_pk_bf16(v1[0], v1[1]); w.w = cvt_pk_bf16(v1[2], v1[3]);
                    *(u32x4*)(rowp + bj * 32) = w; } }
    }
};
struct EpiResid {
    static constexpr bool PERM = true, KEEP = false, CONTIG = true;
    const float* base; float* out; int ldc; const float* gain; bf16* xg; float* ssq;
    __device__ __forceinline__ void operator()(f32x4 (&acc)[2][2][4][2], const Unit& u, int wr, int wc, int fr, int fq) const {
        const int row0 = u.pm * BM + wr * 64 + fr, col0 = u.pn * BM + wc * 64 + 8 * fq;
#pragma unroll
        for (int ai = 0; ai < 2; ++ai)
#pragma unroll
            for (int m = 0; m < 4; ++m) { const int row = row0 + ai * HALF + m * 16; const size_t off = (size_t)row * ldc + col0; float q = 0.f;
#pragma unroll
                for (int bj = 0; bj < 2; ++bj) {
                    const f32x4 x0 = *(const f32x4*)(base + off + bj * 32) + acc[ai][bj][m][0], x1 = *(const f32x4*)(base + off + bj * 32 + 4) + acc[ai][bj][m][1];
                    *(f32x4*)(out + off + bj * 32) = x0; *(f32x4*)(out + off + bj * 32 + 4) = x1;
                    if (gain) { q += (x0[0] * x0[0] + x0[1] * x0[1]) + (x0[2] * x0[2] + x0[3] * x0[3]) + (x1[0] * x1[0] + x1[1] * x1[1]) + (x1[2] * x1[2] + x1[3] * x1[3]);
                        const f32x4 y0 = x0 * *(const f32x4*)(gain + col0 + bj * 32), y1 = x1 * *(const f32x4*)(gain + col0 + bj * 32 + 4);
                        u32x4 w; w.x = cvt_pk_bf16(y0[0], y0[1]); w.y = cvt_pk_bf16(y0[2], y0[3]); w.z = cvt_pk_bf16(y1[0], y1[1]); w.w = cvt_pk_bf16(y1[2], y1[3]);
                        *(u32x4*)(xg + off + bj * 32) = w; } }
                if (gain) { q += __shfl_xor(q, 16); q += __shfl_xor(q, 32); if (fq == 0) ssq[(size_t)row * 16 + u.pn * 4 + wc] = q; }
            }
    }
};
struct EpiLift {
    static constexpr bool PERM = true, KEEP = true, CONTIG = false;
    const bf16* fac; int ldg; bf16* mb; int ldc; const float* ssqc;
    __device__ __forceinline__ void operator()(f32x4 (&acc)[2][2][4][2], const Unit& u, int wr, int wc, int fr, int fq) const {
        const int row0 = u.pm * BM + wr * 64 + fr, col0 = u.pn * BM + wc * 32 + 8 * fq;
#pragma unroll
        for (int ai = 0; ai < 2; ++ai)
#pragma unroll
            for (int m = 0; m < 4; ++m) { const int row = row0 + ai * HALF + m * 16;
                float rsc = 1.f;
                if (u.z == 1 || u.z == 2) { const f32x2 p = *(const f32x2*)(ssqc + (size_t)row * 8 + 2 * fq); float sq = p.x + p.y; sq += __shfl_xor(sq, 16); sq += __shfl_xor(sq, 32);
                    const float v = sq * (1.f / 512.f) + 1e-6f; rsc = (u.z == 1) ? sqrtf(v) : rsqrtf(v); }
#pragma unroll
                for (int bj = 0; bj < 2; ++bj) { const int col = col0 + bj * HALF;
                    const u32x4 g0 = *(const u32x4*)(fac + (size_t)row * ldg + u.z * 1024 + col);
                    f32x4& v0 = acc[ai][bj][m][0]; f32x4& v1 = acc[ai][bj][m][1];
                    v0[0] *= rsc * bf2f(g0.x & 0xffffu); v0[1] *= rsc * bf2f(g0.x >> 16); v0[2] *= rsc * bf2f(g0.y & 0xffffu); v0[3] *= rsc * bf2f(g0.y >> 16);
                    v1[0] *= rsc * bf2f(g0.z & 0xffffu); v1[1] *= rsc * bf2f(g0.z >> 16); v1[2] *= rsc * bf2f(g0.w & 0xffffu); v1[3] *= rsc * bf2f(g0.w >> 16);
                    if (u.z == 3) { u32x4 w; w.x = cvt_pk_bf16(v0[0], v0[1]); w.y = cvt_pk_bf16(v0[2], v0[3]); w.z = cvt_pk_bf16(v1[0], v1[1]); w.w = cvt_pk_bf16(v1[2], v1[3]);
                        *(u32x4*)(mb + (size_t)row * ldc + col) = w; } } }
    }
};

__device__ __forceinline__ float dpp_ror1(float x) { return __int_as_float(__builtin_amdgcn_update_dpp(0, __float_as_int(x), 0x121, 0xf, 0xf, false)); }
__device__ __forceinline__ float dpp_ror2(float x) { return __int_as_float(__builtin_amdgcn_update_dpp(0, __float_as_int(x), 0x122, 0xf, 0xf, false)); }
__device__ __forceinline__ float dpp_prev1(float cur, float prev) { return __int_as_float(__builtin_amdgcn_update_dpp(__builtin_amdgcn_update_dpp(0, __float_as_int(prev), 0x121, 0xf, 0xf, false), __float_as_int(cur), 0x111, 0xf, 0xf, false)); }
__device__ __forceinline__ float dpp_prev2(float cur, float prev) { return __int_as_float(__builtin_amdgcn_update_dpp(__builtin_amdgcn_update_dpp(0, __float_as_int(prev), 0x122, 0xf, 0xf, false), __float_as_int(cur), 0x112, 0xf, 0xf, false)); }
struct EpiConvAct {
    static constexpr bool PERM = true, KEEP = false, CONTIG = false;
    bf16* act; const float* ssq; const float* cw; const float* cb; float* rawh; LAS unsigned char* halo; int ntn;
    __device__ __forceinline__ void operator()(f32x4 (&acc)[2][2][4][2], const Unit& u, int wr, int wc, int fr, int fq) const {
        asm volatile("" : "+v"(fr), "+v"(fq));
        const int row0 = u.pm * BM + wr * 64 + fr, ch0 = u.pn * 128 + wc * 32 + 8 * fq;
#pragma unroll
        for (int ai = 0; ai < 2; ++ai)
#pragma unroll
            for (int m = 0; m < 4; ++m) { const int row = row0 + ai * HALF + m * 16;
                float sq; { const f32x4 p = *(const f32x4*)(ssq + (size_t)row * 16 + 4 * fq); sq = (p.x + p.y) + (p.z + p.w); }
                sq += __shfl_xor(sq, 16); sq += __shfl_xor(sq, 32);
                const float rs = rsqrtf(sq * (1.f / 1024.f) + 1e-6f);
#pragma unroll
                for (int bj = 0; bj < 2; ++bj) { acc[ai][bj][m][0] = acc[ai][bj][m][0] * rs; acc[ai][bj][m][1] = acc[ai][bj][m][1] * rs; } }
        LAS f32x4* H = (LAS f32x4*)halo;
        if (fr >= 14) {
#pragma unroll
            for (int ai = 0; ai < 2; ++ai) { const int b = 2 * ai + wr;
#pragma unroll
                for (int bj = 0; bj < 2; ++bj)
#pragma unroll
                    for (int n = 0; n < 2; ++n) H[((((b * 4 + wc) * 4 + fq) * 2 + (fr - 14)) * 2 + bj) * 2 + n] = acc[ai][bj][3][n]; } }
        { float* rw = rawh + (size_t)(u.pm * ntn + u.pn) * 1024;
          if (wr == 1 && fr >= 14) {
#pragma unroll
            for (int bj = 0; bj < 2; ++bj)
#pragma unroll
                for (int n = 0; n < 2; ++n) *(f32x4*)(rw + (2 + fr - 14) * 256 + bj * HALF + wc * 32 + 8 * fq + 4 * n) = acc[1][bj][3][n]; }
          if (wr == 0 && fr < 2) {
#pragma unroll
            for (int bj = 0; bj < 2; ++bj)
#pragma unroll
                for (int n = 0; n < 2; ++n) *(f32x4*)(rw + fr * 256 + bj * HALF + wc * 32 + 8 * fq + 4 * n) = acc[0][bj][0][n]; } }
        LAS float* WL = (LAS float*)(halo + 8192);
        { const int tidl = (wr * 4 + wc) * 64 + fq * 16 + fr, i2 = tidl * 2, kind = i2 >> 7, c = i2 & 127, k4 = kind & 3;
          const float* src = (k4 < 3 ? cw + k4 * 5632 : cb) + (kind >= 4 ? 2816 : 0) + u.pn * 128 + c;
          *(LAS f32x2*)(WL + i2) = *(const f32x2*)src; }
        asm volatile("s_waitcnt vmcnt(0) lgkmcnt(0)" ::: "memory"); __builtin_amdgcn_s_barrier(); asm volatile("" ::: "memory");
        bf16* actb = act + (size_t)(u.pm * BM + wr * 64) * 2816 + u.pn * 128 + wc * 32;
        const unsigned alane = (unsigned)(fr * 2816 + 8 * fq);
#pragma unroll
        for (int n = 0; n < 2; ++n) {
            unsigned half0[2][4];
#pragma unroll
            for (int eh = 0; eh < 2; ++eh) {
                const int cl = wc * 32 + 8 * fq + 4 * n + 2 * eh;
                f32x2 wg[3], wu[3], bg, bu;
#pragma unroll
                for (int j = 0; j < 3; ++j) { wg[j] = *(const LAS f32x2*)(WL + j * 128 + cl); wu[j] = *(const LAS f32x2*)(WL + (4 + j) * 128 + cl); }
                bg = *(const LAS f32x2*)(WL + 3 * 128 + cl); bu = *(const LAS f32x2*)(WL + 7 * 128 + cl);
#pragma unroll
                for (int ai = 0; ai < 2; ++ai) { const int b = 2 * ai + wr;
#pragma unroll
                    for (int m = 3; m >= 0; --m) {
                        float r2[2];
#pragma unroll
                        for (int e2 = 0; e2 < 2; ++e2) { const int e = 2 * eh + e2;
                            const float gc = acc[ai][0][m][n][e], uc = acc[ai][1][m][n][e];
                            float gp = 0.f, up = 0.f; asm volatile("" : "+v"(gp), "+v"(up));
                            if (m > 0) { gp = acc[ai][0][m - 1][n][e]; up = acc[ai][1][m - 1][n][e]; }
                            else if (b >= 1) { const int fk = fr >= 14 ? fr - 14 : 0; const LAS float* hp = (const LAS float*)(H + ((((b - 1) * 4 + wc) * 4 + fq) * 2 + fk) * 4 + n); gp = hp[e]; up = hp[8 + e]; }
                            const float g1 = dpp_prev1(gc, gp), g2 = dpp_prev2(gc, gp), u1 = dpp_prev1(uc, up), u2 = dpp_prev2(uc, up);
                            const float vg = bg[e2] + wg[0][e2] * g2 + wg[1][e2] * g1 + wg[2][e2] * gc;
                            const float vu = bu[e2] + wu[0][e2] * u2 + wu[1][e2] * u1 + wu[2][e2] * uc;
                            r2[e2] = siluf_(vg) * vu; }
                        const unsigned pk = cvt_pk_bf16(r2[0], r2[1]);
                        if (eh == 0) half0[ai][m] = pk;
                        else *(u32x2*)(actb + (size_t)(ai * HALF + m * 16) * 2816 + 4 * n + alane) = (u32x2){half0[ai][m], pk};
                    }
                }
            }
        }
    }
};

template <class Epi, bool ALIGN_EPI = true>
__device__ __forceinline__ void gemm_phase(LAS unsigned char* lds, const Gemm g, const Order& S, const Epi& E) {
    int tid = threadIdx.x; asm volatile("" : "+v"(tid));
    const int wid = __builtin_amdgcn_readfirstlane(tid >> 6), lane = tid & 63, wr = wid >> 2, wc = wid & 3, fr = lane & 15, fq = lane >> 4;
    const int K = g.K, nt = K / BK;
    unsigned voffA[2], voffB[2];
#pragma unroll
    for (int i = 0; i < 2; ++i) { int R, C; stage_rc(tid * 16 + i * 8192, R, C);
        const int Rb = Epi::CONTIG ? (64 * (R >> 5) + perm32(R & 31)) : (Epi::PERM ? ((R & ~31) + perm32(R & 31)) : R);
        voffA[i] = (unsigned)(R * g.lda + C) * 2u; voffB[i] = (unsigned)(Rb * g.ldb + C) * 2u; }
    const size_t kstep = (size_t)(BK * 2);
    const size_t hstepA = (size_t)HALF * g.lda * 2, hstepB = (size_t)(Epi::CONTIG ? 32 : HALF) * g.ldb * 2;
    const size_t tstepA = 2 * hstepA, tstepB = (size_t)BM * g.ldb * 2;
    const unsigned ldsw = (unsigned)wid * 1024u;
    const int aoff = lds_byte(wr * 64 + fr, fq * 8), boff = lds_byte(wc * 32 + fr, fq * 8);
#define PG8_SA(b, h) (((b) * 2 + (h)) * HTB)
#define PG8_SB(b, h) ((4 + (b) * 2 + (h)) * HTB)
#define PG8_STAGE(bufoff, gbase, voff) do { _Pragma("unroll") for (int _i = 0; _i < 2; ++_i) \
        __builtin_amdgcn_global_load_lds((const unsigned*)((const char*)(gbase) + (voff)[_i]), (LAS unsigned*)(lds + (bufoff) + ldsw + _i * 8192), 16, 0, 0); } while (0)
#define PG8_LDA(dst, b, h) do { _Pragma("unroll") for (int m = 0; m < 4; ++m) _Pragma("unroll") for (int k = 0; k < 2; ++k) dst[m][k] = *(const LAS bf16x8*)(lds + PG8_SA(b, h) + aoff + m * 2048 + k * 1024); } while (0)
#define PG8_LDB(dst, b, h) do { _Pragma("unroll") for (int n = 0; n < 2; ++n) _Pragma("unroll") for (int k = 0; k < 2; ++k) dst[n][k] = *(const LAS bf16x8*)(lds + PG8_SB(b, h) + boff + n * 2048 + k * 1024); } while (0)
#define PG8_MMA(ai, bj, At, Bt) do { __builtin_amdgcn_s_setprio(1); _Pragma("unroll") for (int m = 0; m < 4; ++m) _Pragma("unroll") for (int n = 0; n < 2; ++n) _Pragma("unroll") for (int k = 0; k < 2; ++k) \
        acc[ai][bj][m][n] = __builtin_amdgcn_mfma_f32_16x16x32_bf16(Bt[n][k], At[m][k], acc[ai][bj][m][n], 0, 0, 0); __builtin_amdgcn_s_setprio(0); } while (0)
#define PG8_WAIT_V(n) asm volatile("s_waitcnt vmcnt(" #n ")" ::: "memory")
#define PG8_WAIT_L(n) asm volatile("s_waitcnt lgkmcnt(" #n ")" ::: "memory")
#define PG8_BAR __builtin_amdgcn_s_barrier()
#define PG8_SCHED __builtin_amdgcn_sched_barrier(0)
    Unit cur, nxt; int ui = 0;
    if (!S.next(0, cur)) return;
    f32x4 acc[2][2][4][2];
#pragma unroll
    for (int a = 0; a < 2; ++a)
#pragma unroll
        for (int b = 0; b < 2; ++b)
#pragma unroll
            for (int m = 0; m < 4; ++m)
#pragma unroll
                for (int n = 0; n < 2; ++n) acc[a][b][m][n] = (f32x4){0.f, 0.f, 0.f, 0.f};
    bf16x8 At[4][2], B0[2][2], B1[2][2];
    const char* cA = (const char*)g.A + (size_t)cur.pm * tstepA + (size_t)cur.z * g.zA; const char* cB = (const char*)g.Bt + (size_t)cur.pn * tstepB + (size_t)cur.z * g.zB;
    PG8_STAGE(PG8_SB(0, 0), cB, voffB); PG8_STAGE(PG8_SB(0, 1), cB + hstepB, voffB); PG8_STAGE(PG8_SA(0, 0), cA, voffA); PG8_STAGE(PG8_SA(0, 1), cA + hstepA, voffA);
    if (wr == 1) PG8_BAR;
    PG8_WAIT_V(2); PG8_BAR;
    PG8_STAGE(PG8_SB(1, 0), cB + kstep, voffB); PG8_STAGE(PG8_SA(1, 0), cA + kstep, voffA); PG8_STAGE(PG8_SB(1, 1), cB + hstepB + kstep, voffB);
    PG8_WAIT_V(6); PG8_BAR;
    for (;;) {
        const bool has_next = S.next(ui + 1, nxt);
        const char* nA = has_next ? (const char*)g.A + (size_t)nxt.pm * tstepA + (size_t)nxt.z * g.zA : cA; const char* nB = has_next ? (const char*)g.Bt + (size_t)nxt.pn * tstepB + (size_t)nxt.z * g.zB : cB;
        for (int t = 0; t < nt; t += 2) {
            const bool last = (t == nt - 2);
            const char* a1 = cA + (size_t)(t + 1) * kstep;
            const char* a2 = last ? nA : cA + (size_t)(t + 2) * kstep; const char* b2 = last ? nB : cB + (size_t)(t + 2) * kstep;
            const char* a3 = a2 + kstep; const char* b3 = b2 + kstep;
            PG8_LDB(B0, 0, 0); PG8_LDB(B1, 0, 1); PG8_SCHED; PG8_LDA(At, 0, 0); PG8_STAGE(PG8_SA(1, 1), a1 + hstepA, voffA);
            PG8_WAIT_V(8); PG8_WAIT_L(0); PG8_BAR; PG8_MMA(0, 0, At, B0); PG8_MMA(0, 1, At, B1); PG8_BAR; PG8_SCHED;
            PG8_LDA(At, 0, 1); PG8_STAGE(PG8_SB(0, 0), b2, voffB); PG8_STAGE(PG8_SB(0, 1), b2 + hstepB, voffB); PG8_STAGE(PG8_SA(0, 0), a2, voffA);
            PG8_WAIT_V(8); PG8_WAIT_L(0); PG8_BAR; PG8_MMA(1, 0, At, B0); PG8_MMA(1, 1, At, B1); PG8_BAR; PG8_SCHED;
            PG8_LDB(B0, 1, 0); PG8_LDB(B1, 1, 1); PG8_SCHED; PG8_LDA(At, 1, 0); PG8_STAGE(PG8_SA(0, 1), a2 + hstepA, voffA);
            PG8_WAIT_V(8); PG8_WAIT_L(0); PG8_BAR; PG8_MMA(0, 0, At, B0); PG8_MMA(0, 1, At, B1); PG8_BAR; PG8_SCHED;
            PG8_LDA(At, 1, 1); PG8_STAGE(PG8_SB(1, 0), b3, voffB); PG8_STAGE(PG8_SB(1, 1), b3 + hstepB, voffB); PG8_STAGE(PG8_SA(1, 0), a3, voffA);
            PG8_WAIT_V(8); PG8_WAIT_L(0); PG8_BAR; PG8_MMA(1, 0, At, B0); PG8_MMA(1, 1, At, B1); PG8_BAR; PG8_SCHED;
        }
        if constexpr (ALIGN_EPI) { if (wr == 0) PG8_BAR; }
        E(acc, cur, wr, wc, fr, fq);
        if (!has_next) break;
        if (!(Epi::KEEP && nxt.z != 0))
#pragma unroll
        for (int a = 0; a < 2; ++a)
#pragma unroll
            for (int b = 0; b < 2; ++b)
#pragma unroll
                for (int m = 0; m < 4; ++m)
#pragma unroll
                    for (int n = 0; n < 2; ++n) acc[a][b][m][n] = (f32x4){0.f, 0.f, 0.f, 0.f};
        cur = nxt; cA = nA; cB = nB; ++ui;
        if constexpr (ALIGN_EPI) { if (wr == 1) PG8_BAR; }
    }
    PG8_WAIT_V(0);
    if constexpr (!ALIGN_EPI) { if (wr == 0) PG8_BAR; }
    PG8_BAR;
#undef PG8_SA
#undef PG8_SB
#undef PG8_STAGE
#undef PG8_LDA
#undef PG8_LDB
#undef PG8_MMA
#undef PG8_WAIT_V
#undef PG8_WAIT_L
#undef PG8_BAR
#undef PG8_SCHED
}
}

#define XB_TMO      128
#define XB_XCNT(j)  (256  + 64 * (j))
#define XB_XSUB(j)  (1280 + 64 * (j))
#define XB_XGEN(j)  (2304 + 64 * (j))
#define XB_TOP      3328
#define XB_TOPGEN   3392
#define XCD_BAR_WORDS 3456
#define XB_SPIN_CAP (1u << 18)
__device__ __forceinline__ unsigned xb_ld(unsigned* p)              { return __hip_atomic_load(p, __ATOMIC_RELAXED, __HIP_MEMORY_SCOPE_AGENT); }
__device__ __forceinline__ unsigned xb_add(unsigned* p, unsigned v) { return __hip_atomic_fetch_add(p, v, __ATOMIC_RELAXED, __HIP_MEMORY_SCOPE_AGENT); }
__device__ __forceinline__ unsigned xb_xcc_id() { return (unsigned)__builtin_amdgcn_s_getreg((3 << 11) | 20) & 0xFu; }
#define XB_SPIN(cond, bar) do { unsigned _sp = 0; while (cond) { __builtin_amdgcn_s_sleep(1); \
    if ((++_sp & 255u) == 0u) { if (xb_ld(&(bar)[XB_TMO])) break; if (_sp > XB_SPIN_CAP) { atomicAdd(&(bar)[XB_TMO], 1u); break; } } } } while (0)
struct XcdBarrier { unsigned* bar; unsigned x; volatile LAS unsigned* st; };
__device__ __forceinline__ XcdBarrier xcd_barrier_post(unsigned* bar, volatile LAS unsigned* st) {
    XcdBarrier b; b.bar = bar; b.x = xb_xcc_id(); b.st = st;
    if (threadIdx.x == 0) (void)xb_add(&bar[XB_XCNT(b.x)], 1u);
    return b;
}
__device__ __forceinline__ void xcd_barrier_complete(unsigned* bar, unsigned x, unsigned& nloc, unsigned& nx) {
    const unsigned G = gridDim.x * gridDim.y * gridDim.z;
    unsigned sum, cnt, mine, sp = 0u;
    for (;;) {
        sum = 0u; cnt = 0u; mine = 0u;
#pragma unroll
        for (unsigned j = 0; j < 16; ++j) { const unsigned c = xb_ld(&bar[XB_XCNT(j)]); sum += c; cnt += (c > 0u) ? 1u : 0u; mine = (j == x) ? c : mine; }
        if (sum == G) break;
        __builtin_amdgcn_s_sleep(1);
        if ((++sp & 255u) == 0u) { if (xb_ld(&bar[XB_TMO])) break; if (sp > XB_SPIN_CAP) { atomicAdd(&bar[XB_TMO], 1u); break; } }
    }
    nloc = mine > 0u ? mine : 1u; nx = cnt > 0u ? cnt : 1u;
}
__device__ __forceinline__ void xcd_barrier(const XcdBarrier& b) {
    asm volatile("s_waitcnt vmcnt(0)" ::: "memory");
    __syncthreads();
    if (threadIdx.x == 0) {
        unsigned* bar = b.bar;
        __builtin_amdgcn_s_waitcnt(0);
        unsigned nloc = b.st[0], nx = b.st[1];
        if (nloc == 0u) { xcd_barrier_complete(bar, b.x, nloc, nx); b.st[0] = nloc; b.st[1] = nx; }
        const unsigned old = xb_add(&bar[XB_XSUB(b.x)], 1u);
        const unsigned gen = old / nloc;
        if (old + 1u == (gen + 1u) * nloc) {
            __builtin_amdgcn_fence(__ATOMIC_RELEASE, "agent");
            asm volatile("s_waitcnt vmcnt(0)" ::: "memory");
            const unsigned og = xb_add(&bar[XB_TOP], 1u);
            const unsigned tg = og / nx;
            if (og + 1u == (tg + 1u) * nx) xb_add(&bar[XB_TOPGEN], 1u);
            else XB_SPIN(xb_ld(&bar[XB_TOPGEN]) == tg, bar);
            __builtin_amdgcn_fence(__ATOMIC_ACQUIRE, "agent");
            xb_add(&bar[XB_XGEN(b.x)], 1u);
            asm volatile("s_waitcnt vmcnt(0)" ::: "memory");
        } else {
            XB_SPIN(xb_ld(&bar[XB_XGEN(b.x)]) == gen, bar);
            __builtin_amdgcn_fence(__ATOMIC_ACQUIRE, "agent");
            asm volatile("s_waitcnt vmcnt(0)" ::: "memory");
        }
    }
    __syncthreads();
}

__device__ __forceinline__ bf16x8 frag_kc(const LAS bf16* X, int ld, int mn0, int k0, int lane) { return *(const LAS bf16x8*)(X + (mn0 + (lane & 15)) * ld + k0 + 8 * (lane >> 4)); }
__device__ __forceinline__ bf16x8 gfrag_kc(const bf16* X, int ld, int mn0, int k0, int lane) { const bf16* b = X + (size_t)mn0 * ld + k0; const unsigned lo = (unsigned)((lane & 15) * ld + 8 * (lane >> 4)); return *(const bf16x8*)(b + lo); }
__device__ __forceinline__ s16x4 trr(const LAS bf16* p) { return __builtin_bit_cast(s16x4, __builtin_amdgcn_ds_read_tr16_b64_v4i16((LAS s16x4*)p)); }
__device__ __forceinline__ bf16x8 frag_ks(const LAS bf16* X, int ld, int mn0, int k0, int lane) {
    const int r = lane & 15, g = lane >> 4;
    const LAS bf16* p = X + (k0 + 8 * g + (r >> 2)) * ld + mn0 + 4 * (r & 3);
    const s16x4 lo = trr(p), hi = trr(p + 4 * ld);
    return (bf16x8){lo[0], lo[1], lo[2], lo[3], hi[0], hi[1], hi[2], hi[3]};
}
__device__ __forceinline__ f32x4 zero4() { f32x4 z = {0.f, 0.f, 0.f, 0.f}; asm volatile("" : "+v"(z)); return z; }
__device__ __forceinline__ u32x4 uone4() { u32x4 z = {0x3F80u, 0u, 0u, 0u}; asm volatile("" : "+v"(z)); return z; }
__device__ __forceinline__ u32x4 uzero4() { u32x4 z = {0u, 0u, 0u, 0u}; asm volatile("" : "+v"(z)); return z; }
#define MFMA16(a, b, c) __builtin_amdgcn_mfma_f32_16x16x32_bf16((a), (b), (c), 0, 0, 0)
__device__ __forceinline__ u32x4 scale8(u32x4 w, float s) {
    u32x4 o;
    o.x = pk2(bf2f(w.x & 0xffffu) * s, bf2f(w.x >> 16) * s); o.y = pk2(bf2f(w.y & 0xffffu) * s, bf2f(w.y >> 16) * s);
    o.z = pk2(bf2f(w.z & 0xffffu) * s, bf2f(w.z >> 16) * s); o.w = pk2(bf2f(w.w & 0xffffu) * s, bf2f(w.w >> 16) * s);
    return o;
}
__device__ __forceinline__ float wscan_add(float v, int lane) {
#pragma unroll
    for (int o = 1; o < 64; o <<= 1) { const float t = __shfl_up(v, o); if (lane >= o) v += t; }
    return v;
}
__device__ __forceinline__ float wscan_max(float v, int lane) {
#pragma unroll
    for (int o = 1; o < 64; o <<= 1) { const float t = __shfl_up(v, o); if (lane >= o) v = fmaxf(v, t); }
    return v;
}

#ifndef GEMM_ALIGN
#define GEMM_ALIGN true
#endif
enum { PH_W = 0, PH_INPROJ, PH_M0, PH_M1, PH_M2, PH_M3, PH_ATT, PH_LIFT, PH_OUT, PH_UP, PH_DOWN, PH_FINAL, PH_COUNT };
enum { I_X = 0, I_MIXG, I_WIN, I_AIB, I_AFB, I_ANG, I_BCW, I_CCW, I_CCB, I_CDTB, I_CALOG, I_CDSKIP, I_CNG, I_WLIFT, I_WOUT, I_FFNG, I_WUP, I_FCW, I_FCB, I_WDOWN, I_FING, N_IN };
struct Args { const float* in[N_IN]; float* out; unsigned char* ws; int l_lo, l_hi, g_lo, g_hi, ph_lo, ph_hi, use_bar, pad; };

__device__ __forceinline__ void transpose_item(const float* W, int ldw, int nsrc0, int k0, bf16* WT, int ldt, int ndst0, LAS float* scr, int lane, const float* kscale = nullptr, int gate_tile = -1) {
    int scol = nsrc0 + (lane & 31);
    if (gate_tile >= 0) {
        const int c = (ndst0 & 255) + (lane & 31), wc = c >> 6, bj = (c >> 5) & 1, fq = (c >> 3) & 3, n = (c >> 2) & 1, e = c & 3;
        scol = 6160 + (2 * bj + n) * 1024 + 64 * gate_tile + 16 * wc + 4 * fq + e; }
#pragma unroll 8
    for (int i = 0; i < 32; ++i) { const int kk = 2 * i + (lane >> 5); scr[kk * 33 + (lane & 31)] = W[(size_t)(k0 + kk) * ldw + scol] * (kscale ? kscale[k0 + kk] : 1.f); }
    LDS_WAIT(); asm volatile("" ::: "memory");
    const int c = lane & 7;
#pragma unroll
    for (int j = 0; j < 4; ++j) { const int n = (lane >> 3) + 8 * j; const LAS float* s = scr + (8 * c) * 33 + n;
        u32x4 o; o.x = pk2(s[0 * 33], s[1 * 33]); o.y = pk2(s[2 * 33], s[3 * 33]); o.z = pk2(s[4 * 33], s[5 * 33]); o.w = pk2(s[6 * 33], s[7 * 33]);
        *(u32x4*)(WT + (size_t)(ndst0 + n) * ldt + k0 + 8 * c) = o; }
    LDS_WAIT(); asm volatile("" ::: "memory");
}

__global__ void __launch_bounds__(NTHR, 2) fwd(Args args) {
    extern __shared__ __attribute__((aligned(16))) unsigned char lds_raw[];
    LAS unsigned char* lds = (LAS unsigned char*)lds_raw;
    const int NBLK = gridDim.x, blk = blockIdx.x;
    {
        volatile LAS unsigned* MISC0 = (volatile LAS unsigned*)(lds + MISC_OFF);
        if (threadIdx.x < 16) MISC0[threadIdx.x] = 0u;
        __syncthreads();
    }
    XcdBarrier bar; bar.bar = (unsigned*)(args.ws + WS_CTL) + 4096; bar.x = 0; bar.st = nullptr;
    if (args.use_bar) bar = xcd_barrier_post((unsigned*)(args.ws + WS_CTL) + 4096, (volatile LAS unsigned*)(lds + MISC_OFF) + 8);
#define GRID_BAR() do { if (args.use_bar) xcd_barrier(bar); } while (0)
#ifndef REPMASK
#define REPMASK 0
#endif
#define IN(k) (args.ph_lo <= (k) && (k) < args.ph_hi)
#define REPS(k) for (int rep_ = 0; rep_ < 1 + ((REPMASK >> (k)) & 1); ++rep_)
#define PHASE_BEGIN() int tid = threadIdx.x; asm volatile("" : "+v"(tid)); const int lane = tid & 63, wave = __builtin_amdgcn_readfirstlane(tid >> 6); \
    const __attribute__((address_space(4))) Args* ka = (const __attribute__((address_space(4))) Args*)__builtin_amdgcn_kernarg_segment_ptr(); asm volatile("" : "+s"(ka)); \
    unsigned char* ws = ka->ws; \
    const size_t grow0 = (size_t)grp * T; const float* xsrc = (l == 0) ? ka->in[I_X] : ka->out; (void)grow0; (void)xsrc; \
    const int gw = blk * NWAVES + wave, NGW = NBLK * NWAVES, gt = blk * NTHR + tid, NGT = NBLK * NTHR; (void)lane; (void)gw; (void)NGW; (void)gt; (void)NGT; \
    bf16* const WinT = (bf16*)(ws + WS_WIN); bf16* const WliftT = (bf16*)(ws + WS_WLIFT); bf16* const WoutT = (bf16*)(ws + WS_WOUT); \
    bf16* const WupT = (bf16*)(ws + WS_WUP); bf16* const WdownT = (bf16*)(ws + WS_WDOWN); bf16* const W16B = (bf16*)(ws + WS_W16); \
    bf16* const XN = (bf16*)(ws + WS_XN); bf16* const P = (bf16*)(ws + WS_P); bf16* const U = (bf16*)(ws + WS_U); bf16* const ACT = (bf16*)(ws + WS_ACT); \
    bf16* const YCAT = (bf16*)(ws + WS_YCAT); bf16* const XG = (bf16*)(ws + WS_XG); bf16* const MB = (bf16*)(ws + WS_MB); float* const SP = (float*)(ws + WS_SP); \
    float* const SSQ1 = (float*)(ws + WS_SSQ1); float* const SSQ2 = (float*)(ws + WS_SSQ2); float* const SSQC = (float*)(ws + WS_SSQC); float* const RAWH = (float*)(ws + WS_RAWH); (void)SSQ1; (void)SSQ2; (void)SSQC; (void)RAWH; \
    float* const GBc = (float*)(ws + WS_GB); float* const GGc = (float*)(ws + WS_GG); float* const GMT = (float*)(ws + WS_GMT); \
    float* const MCAR = (float*)(ws + WS_MCAR); float* const MNEW = (float*)(ws + WS_MNEW); float* const MSC = (float*)(ws + WS_MSC); \
    float* const DTB = (float*)(ws + WS_DT); float* const ACB = (float*)(ws + WS_AC); bf16* const XBC = (bf16*)(ws + WS_XBC); \
    float* const DC = (float*)(ws + WS_DC); bf16* const CS = (bf16*)(ws + WS_CS); float* const DH = (float*)(ws + WS_DH); bf16* const HS = (bf16*)(ws + WS_HS); \
    (void)WinT; (void)WliftT; (void)WoutT; (void)WupT; (void)WdownT; (void)W16B; (void)XN; (void)P; (void)U; (void)ACT; (void)YCAT; (void)XG; (void)MB; (void)SP; (void)GBc; (void)GGc; (void)GMT; \
    (void)MCAR; (void)MNEW; (void)MSC; (void)DTB; (void)ACB; (void)XBC; (void)DC; (void)CS; (void)DH; (void)HS

    for (int l = args.l_lo; l < args.l_hi; ++l)
    for (int grp = args.g_lo; grp < args.g_hi; ++grp) {

        REPS(PH_W) if (IN(PH_W) && grp == 0) {
            PHASE_BEGIN();
            LAS float* scr = (LAS float*)(lds + wave * 16384);
            constexpr int I_IN = 16 * 320, I_LF = 4 * 8 * 32, I_OUT = 16 * 32, I_UP = 16 * 176, I_DN = 44 * 32, NIT = I_IN + I_LF + I_OUT + I_UP + I_DN;
            for (int it = gw; it < NIT; it += NGW) {
                int r = it;
                if (r < I_IN) { const int kb = r / 320, nb = r % 320, n0 = 32 * nb, ns = n0 + (n0 >= P_SQ ? 16 : (n0 >= P_BB ? 8 : 0));
                    transpose_item(ka->in[I_WIN] + (size_t)l * DM * PIN, PIN, ns, 64 * kb, WinT, DM, n0, scr, lane, nullptr, n0 >= P_G ? (n0 - P_G) >> 8 : -1); continue; } r -= I_IN;
                if (r < I_LF) { const int br = r / 256, q = r % 256, kb = q / 32, nb = q % 32;
                    transpose_item(ka->in[I_WLIFT] + (size_t)(l * 4 + br) * 512 * DM, DM, 32 * nb, 64 * kb, WliftT + (size_t)br * DM * 512, 512, 32 * nb, scr, lane, br == 2 ? ka->in[I_CNG] + (size_t)l * 512 : nullptr); continue; } r -= I_LF;
                if (r < I_OUT) { const int kb = r / 32, nb = r % 32;
                    transpose_item(ka->in[I_WOUT] + (size_t)l * DM * DM, DM, 32 * nb, 64 * kb, WoutT, DM, 32 * nb, scr, lane); continue; } r -= I_OUT;
                if (r < I_UP) { const int kb = r / 176, nb = r % 176, n0 = 32 * nb, tp = n0 >> 8, j = n0 & 255, ns = (j < 128) ? 128 * tp + j : 2816 + 128 * tp + (j - 128);
                    transpose_item(ka->in[I_WUP] + (size_t)l * DM * DFF2, DFF2, ns, 64 * kb, WupT, DM, n0, scr, lane); continue; } r -= I_UP;
                { const int kb = r / 32, nb = r % 32;
                    transpose_item(ka->in[I_WDOWN] + (size_t)l * DFF * DM, DM, 32 * nb, 64 * kb, WdownT, DFF, 32 * nb, scr, lane); }
            }
            for (int i = gt; i < 16 * DM; i += NGT) { const int c = i >> 10, k = i & 1023; const int oc = (c < 8) ? (1536 + c) : (4616 + (c - 8));
                const float w = ka->in[I_WIN][(size_t)l * DM * PIN + (size_t)k * PIN + oc]; const unsigned hi = f2bf(w);
                W16B[i] = (bf16)hi; W16B[16 * DM + i] = (bf16)f2bf(w - bf2f(hi)); }
            if (l == 0) {
                const float* gain = ka->in[I_MIXG];
                f32x4 gv[4];
#pragma unroll
                for (int j = 0; j < 4; ++j) gv[j] = ((const f32x4*)gain)[lane + 64 * j];
                for (int m = gw; m < BATCH * SEQ; m += NGW) {
                    const f32x4* xr = (const f32x4*)(ka->in[I_X] + (size_t)m * DM) + lane;
                    f32x4 v[4]; float sq = 0.f;
#pragma unroll
                    for (int j = 0; j < 4; ++j) { v[j] = xr[64 * j]; sq += (v[j].x * v[j].x + v[j].y * v[j].y) + (v[j].z * v[j].z + v[j].w * v[j].w); }
                    sq = wave_sum(sq); if (lane < 16) SSQ1[(size_t)m * 16 + lane] = (lane == 0) ? sq : 0.f;
                    u32x2* o8 = (u32x2*)(XG + (size_t)m * DM) + lane;
#pragma unroll
                    for (int j = 0; j < 4; ++j) { const f32x4 y = v[j] * gv[j]; o8[64 * j] = (u32x2){pk2(y.x, y.y), pk2(y.z, y.w)}; }
                }
            }
            GRID_BAR();
        }

        REPS(PH_INPROJ) if (IN(PH_INPROJ)) {
            PHASE_BEGIN();
            const bf16* XGg = XG + grow0 * DM; const float* ssq = SSQ1 + grow0 * 16;
            for (int rb = blk; rb < T / 64; rb += NBLK) {
                const int r0 = rb * 64 + 16 * (wave & 3), kh = (wave >> 2) * 512; f32x4 acc = zero4(), acc2 = zero4();
#pragma unroll 8
                for (int ks = 0; ks < 16; ++ks) { const bf16x8 a = gfrag_kc(XGg, DM, r0, kh + 32 * ks, lane);
                    acc = MFMA16(a, gfrag_kc(W16B, DM, 0, kh + 32 * ks, lane), acc); acc2 = MFMA16(a, gfrag_kc(W16B + 16 * DM, DM, 0, kh + 32 * ks, lane), acc2); }
                acc += acc2;
                LAS f32x4* xch = (LAS f32x4*)lds;
                if (wave >= 4) xch[(wave - 4) * 64 + lane] = acc;
                __syncthreads();
                if (wave < 4) { acc += xch[wave * 64 + lane];
#pragma unroll
                    for (int i = 0; i < 4; ++i) { const int row = r0 + 4 * (lane >> 4) + i; SP[(size_t)row * 16 + (lane & 15)] = acc[i] * row_rstd(ssq + (size_t)row * 16); } }
                __syncthreads();
            }
            pg8::Gemm g{XGg, WinT, DM, DM, DM, 0, 0}; pg8::Order S; S.init(T, PW, NBLK, blk, 1);
            pg8::EpiBf16 E{P, PW, ssq, P_G / 256};
            pg8::gemm_phase<pg8::EpiBf16, GEMM_ALIGN>(lds, g, S, E);
            GRID_BAR();
        }

        REPS(PH_M0) if (IN(PH_M0)) {
            PHASE_BEGIN();
            for (int task = gw; task < GB * 4; task += NGW) {
                const int bl = task >> 2, h = task & 3; float mcar = 0.f;
                const float igb = ka->in[I_AIB][l * 4 + h], fgb = ka->in[I_AFB][l * 4 + h];
                float igv[NCH], fgv[NCH];
#pragma unroll
                for (int c = 0; c < NCH; ++c) { const size_t m = (size_t)bl * SEQ + c * 64 + lane; igv[c] = SP[m * 16 + h]; fgv[c] = SP[m * 16 + 4 + h]; }
#pragma unroll
                for (int c = 0; c < NCH; ++c) {
                    const size_t m = (size_t)bl * SEQ + c * 64 + lane;
                    const float ig = igv[c] + igb, fg = fgv[c] + fgb;
                    const float b = wscan_add(logsigf_(fg), lane);
                    const float gg = ig - b;
                    const float pm = wscan_max(gg, lane);
                    GBc[m * 4 + h] = b; GGc[m * 4 + h] = gg; GMT[m * 4 + h] = b + fmaxf(mcar, pm);
                    const float bL = __shfl(b, 63), gmax = __shfl(pm, 63);
                    const float mnew = bL + fmaxf(mcar, gmax);
                    if (lane == 0) { MCAR[task * NCH + c] = mcar; MNEW[task * NCH + c] = mnew; MSC[task * NCH + c] = __expf(bL + mcar - mnew); }
                    mcar = mnew;
                }
            }
            for (int task = gw; task < GB * NCH; task += NGW) {
                const size_t m = (size_t)task * 64 + lane;
#pragma unroll
                for (int hd = 0; hd < 8; ++hd) {
                    const float dt = softplusf_(SP[m * 16 + 8 + hd] + ka->in[I_CDTB][l * 8 + hd]);
                    const float a = wscan_add(-dt * __expf(ka->in[I_CALOG][l * 8 + hd]), lane);
                    DTB[m * 8 + hd] = dt; ACB[m * 8 + hd] = a;
                }
            }
            {
                const float* cw = ka->in[I_CCW] + (size_t)l * 4 * 1024; const float* cb = ka->in[I_CCB] + (size_t)l * 1024;
                constexpr int RUN = 16;
                for (int i = gt; i < (T / RUN) * 128; i += NGT) {
                    const int rb = i >> 7, c8 = (i & 127) * 8, m0 = rb * RUN, t0 = m0 & (SEQ - 1);
                    float w[4][8], bb[8];
#pragma unroll
                    for (int e = 0; e < 8; ++e) { bb[e] = cb[c8 + e];
#pragma unroll
                        for (int j = 0; j < 4; ++j) w[j][e] = cw[j * 1024 + c8 + e]; }
                    const u32x4 zz = uzero4(); u32x4 win[4]; win[0] = zz; win[1] = zz; win[2] = zz;
                    if (t0 >= 3) { const bf16* pr = P + (size_t)(m0 - 3) * PW + P_CX + c8; win[0] = *(const u32x4*)pr; win[1] = *(const u32x4*)(pr + PW); win[2] = *(const u32x4*)(pr + 2 * PW); }
#pragma unroll 4
                    for (int rr = 0; rr < RUN; ++rr) {
                        win[3] = *(const u32x4*)(P + (size_t)(m0 + rr) * PW + P_CX + c8);
                        float acc[8];
#pragma unroll
                        for (int e = 0; e < 8; ++e) acc[e] = bb[e];
#pragma unroll
                        for (int j = 0; j < 4; ++j) {
                            acc[0] += w[j][0] * bf2f(win[j].x & 0xffffu); acc[1] += w[j][1] * bf2f(win[j].x >> 16); acc[2] += w[j][2] * bf2f(win[j].y & 0xffffu); acc[3] += w[j][3] * bf2f(win[j].y >> 16);
                            acc[4] += w[j][4] * bf2f(win[j].z & 0xffffu); acc[5] += w[j][5] * bf2f(win[j].z >> 16); acc[6] += w[j][6] * bf2f(win[j].w & 0xffffu); acc[7] += w[j][7] * bf2f(win[j].w >> 16); }
                        u32x4 o; o.x = pk2(siluf_(acc[0]), siluf_(acc[1])); o.y = pk2(siluf_(acc[2]), siluf_(acc[3])); o.z = pk2(siluf_(acc[4]), siluf_(acc[5])); o.w = pk2(siluf_(acc[6]), siluf_(acc[7]));
                        *(u32x4*)(XBC + (size_t)(m0 + rr) * 1024 + c8) = o;
                        win[0] = win[1]; win[1] = win[2]; win[2] = win[3];
                    }
                }
            }
            {
                const float* bw = ka->in[I_BCW] + (size_t)l * 3 * 512;
                constexpr int RUN = 16;
                for (int i = gt; i < (T / RUN) * 64; i += NGT) {
                    const int rb = i >> 6, c8 = (i & 63) * 8, m0 = rb * RUN, t0 = m0 & (SEQ - 1);
                    float w[3][8];
#pragma unroll
                    for (int e = 0; e < 8; ++e)
#pragma unroll
                        for (int j = 0; j < 3; ++j) w[j][e] = bw[j * 512 + c8 + e];
                    float pw[3][8];
#pragma unroll
                    for (int e = 0; e < 8; ++e) { pw[0][e] = 0.f; pw[1][e] = 0.f; }
                    if (t0 >= 2) {
#pragma unroll
                        for (int j = 0; j < 2; ++j) { const bf16* pr = P + (size_t)(m0 - 2 + j) * PW; const u32x4 a = *(const u32x4*)(pr + P_BC + c8), b = *(const u32x4*)(pr + P_BX + c8);
                            pw[j][0] = bf2f(a.x & 0xffffu) * bf2f(b.x & 0xffffu); pw[j][1] = bf2f(a.x >> 16) * bf2f(b.x >> 16); pw[j][2] = bf2f(a.y & 0xffffu) * bf2f(b.y & 0xffffu); pw[j][3] = bf2f(a.y >> 16) * bf2f(b.y >> 16);
                            pw[j][4] = bf2f(a.z & 0xffffu) * bf2f(b.z & 0xffffu); pw[j][5] = bf2f(a.z >> 16) * bf2f(b.z >> 16); pw[j][6] = bf2f(a.w & 0xffffu) * bf2f(b.w & 0xffffu); pw[j][7] = bf2f(a.w >> 16) * bf2f(b.w >> 16); } }
#pragma unroll 4
                    for (int rr = 0; rr < RUN; ++rr) {
                        const bf16* pr = P + (size_t)(m0 + rr) * PW; const u32x4 a = *(const u32x4*)(pr + P_BC + c8), b = *(const u32x4*)(pr + P_BX + c8), g = *(const u32x4*)(pr + P_BB + c8);
                        pw[2][0] = bf2f(a.x & 0xffffu) * bf2f(b.x & 0xffffu); pw[2][1] = bf2f(a.x >> 16) * bf2f(b.x >> 16); pw[2][2] = bf2f(a.y & 0xffffu) * bf2f(b.y & 0xffffu); pw[2][3] = bf2f(a.y >> 16) * bf2f(b.y >> 16);
                        pw[2][4] = bf2f(a.z & 0xffffu) * bf2f(b.z & 0xffffu); pw[2][5] = bf2f(a.z >> 16) * bf2f(b.z >> 16); pw[2][6] = bf2f(a.w & 0xffffu) * bf2f(b.w & 0xffffu); pw[2][7] = bf2f(a.w >> 16) * bf2f(b.w >> 16);
                        float acc[8];
#pragma unroll
                        for (int e = 0; e < 8; ++e) acc[e] = w[0][e] * pw[0][e] + w[1][e] * pw[1][e] + w[2][e] * pw[2][e];
                        u32x4 o; o.x = pk2(acc[0] * bf2f(g.x & 0xffffu), acc[1] * bf2f(g.x >> 16)); o.y = pk2(acc[2] * bf2f(g.y & 0xffffu), acc[3] * bf2f(g.y >> 16));
                        o.z = pk2(acc[4] * bf2f(g.z & 0xffffu), acc[5] * bf2f(g.z >> 16)); o.w = pk2(acc[6] * bf2f(g.w & 0xffffu), acc[7] * bf2f(g.w >> 16));
                        *(u32x4*)(YCAT + (size_t)(m0 + rr) * YW + 512 + c8) = o;
#pragma unroll
                        for (int e = 0; e < 8; ++e) { pw[0][e] = pw[1][e]; pw[1][e] = pw[2][e]; }
                    }
                }
            }
            GRID_BAR();
        }

        REPS(PH_M1) if (IN(PH_M1)) {
            PHASE_BEGIN();
            constexpr int NUA = GB * 4 * NCH, NUC = GB * NCH;
            for (int u = blk; u < NUA + NUC; u += NBLK) {
                if (u < NUA) {
                    const int ua = u, bh = ua >> 5, c = ua & 31, bl = bh >> 2, h = bh & 3; const size_t m0 = (size_t)bl * SEQ + c * 64;
                    LAS bf16* VP = (LAS bf16*)lds; LAS bf16* WK = (LAS bf16*)(lds + 64 * 152 * 2);
                    const float bL = GBc[(m0 + 63) * 4 + h], mnew = MNEW[ua];
                    for (int i = tid; i < 1024; i += NTHR) { const int s = i >> 4, c8 = i & 15; *(LAS u32x4*)(VP + s * 152 + c8 * 8) = *(const u32x4*)(P + (m0 + s) * PW + P_AV + h * 128 + c8 * 8); }
                    if (tid < 64) { *(LAS u32x4*)(VP + tid * 152 + 128) = uone4(); *(LAS u32x4*)(VP + tid * 152 + 136) = uzero4(); }
                    { const int s = tid >> 3, c8 = tid & 7; const float w = __expf(bL + GGc[(m0 + s) * 4 + h] - mnew);
                      *(LAS u32x4*)(WK + s * 72 + c8 * 8) = scale8(*(const u32x4*)(P + (m0 + s) * PW + P_AK + h * 64 + c8 * 8), w); }
                    __syncthreads();
                    for (int ti = wave; ti < 36; ti += NWAVES) { const int mt = ti >> 2, nt = ti & 3; f32x4 acc = zero4();
#pragma unroll
                        for (int ks = 0; ks < 2; ++ks) acc = MFMA16(frag_ks(VP, 152, 16 * mt, 32 * ks, lane), frag_ks(WK, 72, 16 * nt, 32 * ks, lane), acc);
                        float* d = DC + (size_t)ua * 9216 + (16 * mt + 4 * (lane >> 4)) * 64 + 16 * nt + (lane & 15);
#pragma unroll
                        for (int i = 0; i < 4; ++i) d[i * 64] = acc[i]; }
                    __syncthreads();
                } else {
                    const int uc = u - NUA, bl = uc >> 5, c = uc & 31, hd = wave, gi = hd >> 2; const size_t m0 = (size_t)bl * SEQ + c * 64;
                    LAS bf16* XW = (LAS bf16*)(lds + hd * (64 * 72 * 2)); LAS bf16* BMs = (LAS bf16*)(lds + 8 * 64 * 72 * 2);
                    const float alast = ACB[(m0 + 63) * 8 + hd];
#pragma unroll
                    for (int k = 0; k < 8; ++k) { const int i = lane + 64 * k, s = i >> 3, c8 = i & 7; const float wd = __expf(alast - ACB[(m0 + s) * 8 + hd]) * DTB[(m0 + s) * 8 + hd];
                        *(LAS u32x4*)(XW + s * 72 + c8 * 8) = scale8(*(const u32x4*)(XBC + (m0 + s) * 1024 + hd * 64 + c8 * 8), wd); }
                    for (int i = tid; i < 2048; i += NTHR) { const int g2 = i >> 10, rem = i & 1023, s = rem >> 4, c8 = rem & 15;
                        *(LAS u32x4*)(BMs + g2 * (64 * 136) + s * 136 + c8 * 8) = *(const u32x4*)(XBC + (m0 + s) * 1024 + 512 + g2 * 128 + c8 * 8); }
                    __syncthreads();
                    const LAS bf16* BMg = BMs + gi * (64 * 136);
                    for (int pt = 0; pt < 4; ++pt) { f32x4 acc[8];
#pragma unroll
                        for (int n = 0; n < 8; ++n) acc[n] = zero4();
#pragma unroll
                        for (int ks = 0; ks < 2; ++ks) { const bf16x8 a = frag_ks(XW, 72, 16 * pt, 32 * ks, lane);
#pragma unroll
                            for (int n = 0; n < 8; ++n) acc[n] = MFMA16(a, frag_ks(BMg, 136, 16 * n, 32 * ks, lane), acc[n]); }
                        float* d = DH + ((size_t)(uc * 8 + hd) * 64 + 16 * pt + 4 * (lane >> 4)) * 128 + (lane & 15);
#pragma unroll
                        for (int n = 0; n < 8; ++n)
#pragma unroll
                            for (int i = 0; i < 4; ++i) d[i * 128 + 16 * n] = acc[n][i]; }
                    __syncthreads();
                }
            }
            GRID_BAR();
        }

        REPS(PH_M2) if (IN(PH_M2)) {
            PHASE_BEGIN();
            constexpr int NA = GB * 4 * 2304, NC = GB * 8 * 2048;
            for (int i = gt; i < NA + NC; i += NGT) {
                f32x4 st = zero4();
                if (i < NA) { const int bh = i / 2304, e = (i - bh * 2304) * 4;
                    for (int c = 0; c < NCH; ++c) { const size_t ua = (size_t)bh * NCH + c;
                        *(u32x2*)(CS + ua * 9216 + e) = (u32x2){pk2(st.x, st.y), pk2(st.z, st.w)};
                        st = st * MSC[ua] + *(const f32x4*)(DC + ua * 9216 + e); }
                } else { const int j = i - NA, bhd = j >> 11, e = (j & 2047) * 4, bl = bhd >> 3, hd = bhd & 7;
                    for (int c = 0; c < NCH; ++c) { const size_t uh = (size_t)(bl * NCH + c) * 8 + hd;
                        *(u32x2*)(HS + uh * 8192 + e) = (u32x2){pk2(st.x, st.y), pk2(st.z, st.w)};
                        st = st * __expf(ACB[((size_t)bl * SEQ + c * 64 + 63) * 8 + hd]) + *(const f32x4*)(DH + uh * 8192 + e); }
                }
            }
            GRID_BAR();
        }

        REPS(PH_M3) if (IN(PH_M3)) {
            PHASE_BEGIN();
            constexpr int NUA = GB * 4 * NCH, NUC = 2 * GB * NCH;
            for (int u = blk; u < NUA + NUC; u += NBLK) {
                const int r = lane & 15, g4 = lane >> 4;
                if (u < NUA) {
                    const int ua = u, bh = ua >> 5, c = ua & 31, bl = bh >> 2, h = bh & 3; const size_t m0 = (size_t)bl * SEQ + c * 64;
                    LAS bf16* Qs = (LAS bf16*)lds; LAS bf16* Ks = Qs + 64 * 72; LAS bf16* VP = Ks + 64 * 72; LAS bf16* CST = VP + 64 * 152; LAS bf16* SMT = CST + 144 * 72; LAS bf16* AOT = SMT + 64 * 72;
                    LAS float* GS = (LAS float*)(AOT + 64 * 136);
                    LAS float* SSQ = GS + 256;
                    const float mcar = MCAR[ua];
                    { const int s = tid >> 3, c8 = tid & 7; const bf16* pr = P + (m0 + s) * PW + h * 64 + c8 * 8;
                      *(LAS u32x4*)(Qs + s * 72 + c8 * 8) = *(const u32x4*)(pr + P_AQ); *(LAS u32x4*)(Ks + s * 72 + c8 * 8) = *(const u32x4*)(pr + P_AK); }
                    for (int i = tid; i < 1024; i += NTHR) { const int s = i >> 4, c8 = i & 15; const bf16* pr = P + (m0 + s) * PW + h * 128 + c8 * 8;
                        *(LAS u32x4*)(VP + s * 152 + c8 * 8) = *(const u32x4*)(pr + P_AV); *(LAS u32x4*)(AOT + s * 136 + c8 * 8) = *(const u32x4*)(pr + P_AO); }
                    if (tid < 64) { *(LAS u32x4*)(VP + tid * 152 + 128) = uone4(); *(LAS u32x4*)(VP + tid * 152 + 136) = uzero4(); }
                    for (int i = tid; i < 1152; i += NTHR) { const int dv = i >> 3, c8 = i & 7; *(LAS u32x4*)(CST + dv * 72 + c8 * 8) = *(const u32x4*)(CS + (size_t)ua * 9216 + dv * 64 + c8 * 8); }
                    if (tid < 192) { const int arr = tid >> 6, s = tid & 63; const float* src = (arr == 0) ? GBc : (arr == 1) ? GGc : GMT; GS[arr * 64 + s] = src[(m0 + s) * 4 + h]; }
                    __syncthreads();
#pragma unroll
                    for (int q2 = 0; q2 < 2; ++q2) { const int ti = 2 * wave + q2, tt = ti >> 2, st = ti & 3;
                        f32x4 acc = zero4();
                        if (st <= tt) {
#pragma unroll
                            for (int ks = 0; ks < 2; ++ks) acc = MFMA16(frag_kc(Qs, 72, 16 * tt, 32 * ks, lane), frag_kc(Ks, 72, 16 * st, 32 * ks, lane), acc);
                            const int s = 16 * st + r; const float gs = GS[64 + s];
#pragma unroll
                            for (int i = 0; i < 4; ++i) { const int t = 16 * tt + 4 * g4 + i; const float e = GS[t] - GS[128 + t] + gs;
                                acc[i] = (s <= t) ? acc[i] * 0.125f * __expf(e) : 0.f; }
                        }
                        *(LAS u32x2*)(SMT + (16 * st + r) * 72 + 16 * tt + 4 * g4) = (u32x2){pk2(acc[0], acc[1]), pk2(acc[2], acc[3])}; }
                    __syncthreads();
                    const int tt = wave & 3, half = wave >> 2;
                    f32x4 a1[5], a2[5];
#pragma unroll
                    for (int j = 0; j < 5; ++j) { a1[j] = zero4(); a2[j] = zero4(); }
#pragma unroll
                    for (int ks = 0; ks < 2; ++ks) { const bf16x8 fa1 = frag_ks(SMT, 72, 16 * tt, 32 * ks, lane), fa2 = frag_kc(Qs, 72, 16 * tt, 32 * ks, lane);
#pragma unroll
                        for (int j = 0; j < 5; ++j) { const int dvt = (j < 4) ? half * 4 + j : 8;
                            a1[j] = MFMA16(fa1, frag_ks(VP, 152, 16 * dvt, 32 * ks, lane), a1[j]);
                            a2[j] = MFMA16(fa2, frag_kc(CST, 72, 16 * dvt, 32 * ks, lane), a2[j]); } }
                    float hv[4][4], ssq[4];
#pragma unroll
                    for (int i = 0; i < 4; ++i) { const int t = 16 * tt + 4 * g4 + i; const float b = GS[t], mt = GS[128 + t];
                        const float is = 0.125f * __expf(b + mcar - mt);
                        float den = a1[4][i] + is * a2[4][i]; den = __shfl(den, lane & 48);
                        const float dn = __builtin_amdgcn_rcpf(fmaxf(fabsf(den), __expf(-mt))); float q = 0.f;
#pragma unroll
                        for (int j = 0; j < 4; ++j) { const float v = (a1[j][i] + is * a2[j][i]) * dn; hv[j][i] = v; q += v * v; }
                        q += __shfl_xor(q, 1); q += __shfl_xor(q, 2); q += __shfl_xor(q, 4); q += __shfl_xor(q, 8); ssq[i] = q; }
                    if (r == 0) {
#pragma unroll
                        for (int i = 0; i < 4; ++i) SSQ[half * 64 + 16 * tt + 4 * g4 + i] = ssq[i]; }
                    __syncthreads();
                    const float* ng = ka->in[I_ANG] + (size_t)l * 512 + h * 128;
#pragma unroll
                    for (int i = 0; i < 4; ++i) { const int t = 16 * tt + 4 * g4 + i; const float rstd = rsqrtf((SSQ[t] + SSQ[64 + t]) * (1.f / 128.f) + EPS);
#pragma unroll
                        for (int j = 0; j < 4; ++j) { const int dv = 16 * (half * 4 + j) + r; LAS bf16* op = AOT + t * 136 + dv;
                            *op = (bf16)f2bf(sigmoidf_(bf2f(*op)) * hv[j][i] * rstd * ng[dv]); } }
                    __syncthreads();
                    for (int i = tid; i < 1024; i += NTHR) { const int s = i >> 4, c8 = i & 15; *(u32x4*)(YCAT + (m0 + s) * YW + h * 128 + c8 * 8) = *(const LAS u32x4*)(AOT + s * 136 + c8 * 8); }
                    __syncthreads();
                } else {
                    const int uc2 = u - NUA, bl = uc2 >> 6, c = (uc2 >> 1) & 31, gi = uc2 & 1, hl = wave & 3, th = wave >> 2, hd = gi * 4 + hl; const size_t m0 = (size_t)bl * SEQ + c * 64;
                    LAS bf16* XHs = (LAS bf16*)lds;
                    LAS bf16* HTs = (LAS bf16*)(lds + 36864);
                    LAS bf16* BMg = (LAS bf16*)(lds + 36864 + 69632);
                    LAS bf16* MTt = (LAS bf16*)(lds + 36864 + 69632 + 17408 + wave * 3072);
                    LAS float* ADs = (LAS float*)(lds + 36864 + 69632 + 17408 + 24576);
                    const bf16* Xb = XBC + m0 * 1024;
                    for (int i = tid; i < 2048; i += NTHR) { const int h4 = i >> 9, rem = i & 511, s = rem >> 3, c8 = rem & 7;
                        *(LAS u32x4*)(XHs + h4 * (64 * 72) + s * 72 + c8 * 8) = *(const u32x4*)((Xb + gi * 256) + (unsigned)(s * 1024 + h4 * 64 + c8 * 8)); }
                    { const bf16* Hb = HS + (size_t)((bl * NCH + c) * 8 + gi * 4) * 8192;
                      for (int i = tid; i < 4096; i += NTHR) { const int h4 = i >> 10, rem = i & 1023, p = rem >> 4, c8 = rem & 15;
                        *(LAS u32x4*)(HTs + h4 * (64 * 136) + p * 136 + c8 * 8) = *(const u32x4*)(Hb + (unsigned)(h4 * 8192 + p * 128 + c8 * 8)); } }
                    for (int i = tid; i < 1024; i += NTHR) { const int s = i >> 4, c8 = i & 15; *(LAS u32x4*)(BMg + s * 136 + c8 * 8) = *(const u32x4*)((Xb + 512 + gi * 128) + (unsigned)(s * 1024 + c8 * 8)); }
                    { const int h4 = tid >> 7, arr = (tid >> 6) & 1, s = tid & 63; const float* src = arr ? DTB : ACB; ADs[tid] = (src + m0 * 8 + gi * 4)[(unsigned)(s * 8 + h4)]; }
                    const LAS bf16* XH = XHs + hl * (64 * 72); const LAS bf16* HT = HTs + hl * (64 * 136); const LAS float* AD = ADs + hl * 128;
                    const bf16* Cm = Xb + 768 + gi * 128; const bf16* Zp = P + m0 * PW + P_CZ + hd * 64; const unsigned zlane = (unsigned)(4 * g4 * PW + r), ylane = (unsigned)(4 * g4 * YW + r);
                    bf16* Yp = YCAT + m0 * YW + 1024 + hd * 64; float* Sp = SSQC + m0 * 8 + hd;
                    bf16x8 fcn[4];
#pragma unroll
                    for (int ks = 0; ks < 4; ++ks) fcn[ks] = gfrag_kc(Cm, 1024, 16 * th, 32 * ks, lane);
                    const float dsk = ka->in[I_CDSKIP][l * 8 + hd];
                    __syncthreads();
#pragma unroll 1
                    for (int k2 = 0; k2 < 2; ++k2) { const int tt = k2 ? 3 - th : th;
                        bf16x8 fcm[4]; unsigned short zc[4][4];
#pragma unroll
                        for (int ks = 0; ks < 4; ++ks) fcm[ks] = fcn[ks];
#pragma unroll
                        for (int p = 0; p < 4; ++p)
#pragma unroll
                            for (int i = 0; i < 4; ++i) zc[p][i] = (Zp + (size_t)(16 * tt + i) * PW + 16 * p)[zlane];
#pragma unroll
                        for (int ks = 0; ks < 4; ++ks) fcn[ks] = gfrag_kc(Cm, 1024, 16 * (3 - th), 32 * ks, lane);
                        float at[4];
#pragma unroll
                        for (int i = 0; i < 4; ++i) at[i] = AD[16 * tt + 4 * g4 + i];
#pragma unroll 1
                        for (int st = 0; st <= tt; ++st) { f32x4 acc = zero4();
#pragma unroll
                            for (int ks = 0; ks < 4; ++ks) acc = MFMA16(fcm[ks], frag_kc(BMg, 136, 16 * st, 32 * ks, lane), acc);
                            const int s = 16 * st + r; const float as = AD[s], dts = AD[64 + s];
#pragma unroll
                            for (int i = 0; i < 4; ++i) { const int t = 16 * tt + 4 * g4 + i; acc[i] = (s <= t) ? acc[i] * __expf(at[i] - as) * dts : 0.f; if (s == t) acc[i] += dsk; }
                            *(LAS u32x2*)(MTt + (16 * st + r) * 24 + 4 * g4) = (u32x2){pk2(acc[0], acc[1]), pk2(acc[2], acc[3])}; }
                        if ((tt & 1) == 0) *(LAS u32x2*)(MTt + (16 * (tt + 1) + r) * 24 + 4 * g4) = (u32x2){uzero4().x, uzero4().y};
                        LDS_WAIT(); asm volatile("" ::: "memory");
                        f32x4 ad[4], ao[4];
#pragma unroll
                        for (int p = 0; p < 4; ++p) { ad[p] = zero4(); ao[p] = zero4(); }
#pragma unroll 1
                        for (int ks = 0; ks <= (tt >> 1); ++ks) { const bf16x8 fa = frag_ks(MTt, 24, 0, 32 * ks, lane);
#pragma unroll
                            for (int p = 0; p < 4; ++p) ad[p] = MFMA16(fa, frag_ks(XH, 72, 16 * p, 32 * ks, lane), ad[p]); }
#pragma unroll
                        for (int ks = 0; ks < 4; ++ks)
#pragma unroll
                            for (int p = 0; p < 4; ++p) ao[p] = MFMA16(fcm[ks], frag_kc(HT, 136, 16 * p, 32 * ks, lane), ao[p]);
#pragma unroll
                        for (int i = 0; i < 4; ++i) { const float ea = __expf(at[i]); float q = 0.f;
#pragma unroll
                            for (int p = 0; p < 4; ++p) { const float y = (ad[p][i] + ea * ao[p][i]) * siluf_(bf2f(zc[p][i])); q += y * y;
                                (Yp + (size_t)(16 * tt + i) * YW + 16 * p)[ylane] = (bf16)f2bf(y); }
                            q += __shfl_xor(q, 1); q += __shfl_xor(q, 2); q += __shfl_xor(q, 4); q += __shfl_xor(q, 8);
                            if (r == 0) (Sp + (16 * tt + i) * 8)[(unsigned)(32 * g4)] = q; }
                        LDS_WAIT(); asm volatile("" ::: "memory");
                    }
                    __syncthreads();
                }
            }
            GRID_BAR();
        }

        REPS(PH_ATT) if (IN(PH_ATT)) {
            PHASE_BEGIN();
            LAS bf16* Qs = (LAS bf16*)lds; LAS bf16* Ks = Qs + 128 * 136; LAS bf16* Vs = Ks + 64 * 136; LAS bf16* Aw = Vs + 64 * 136 + wave * (16 * 72);
            const int r = lane & 15, g4 = lane >> 4;
            for (int u = blk; u < GB * 4 * 16; u += NBLK) {
                const int bl = u >> 6, h = (u >> 4) & 3, qt = u & 15; const size_t mb = (size_t)bl * SEQ; const int q0 = qt * 128;
                volatile LAS unsigned* FLG = (volatile LAS unsigned*)(lds + MISC_OFF + 128);
                int par = 0;
                __syncthreads();
                if (lane == 0) { FLG[wave] = 0u; FLG[8 + wave] = 0u; }
                for (int i = tid; i < 2048; i += NTHR) { const int s = i >> 4, c8 = i & 15; *(LAS u32x4*)(Qs + s * 136 + c8 * 8) = *(const u32x4*)(P + (mb + q0 + s) * PW + P_SQ + h * 128 + c8 * 8); }
                f32x4 O[8];
#pragma unroll
                for (int d = 0; d < 8; ++d) O[d] = zero4();
                float racc = 0.f; const int tq = q0 + 16 * wave + r;
                for (int kt = 2 * qt + 1; kt >= 0; --kt) {
                    const int s0 = kt * 64;
                    __syncthreads();
                    { unsigned alldone = 1u;
#pragma unroll
                      for (int w8 = 0; w8 < 8; ++w8) alldone &= FLG[par * 8 + w8];
                      if (__builtin_amdgcn_readfirstlane((int)alldone)) break; }
                    for (int i = tid; i < 1024; i += NTHR) { const int s = i >> 4, c8 = i & 15; const bf16* pr = P + (mb + s0 + s) * PW + h * 128 + c8 * 8;
                        *(LAS u32x4*)(Ks + s * 136 + c8 * 8) = *(const u32x4*)(pr + P_SK); *(LAS u32x4*)(Vs + s * 136 + c8 * 8) = *(const u32x4*)(pr + P_SV); }
                    __syncthreads();
                    if (s0 < q0 + 16 * wave + 15) {
                        f32x4 z[4];
#pragma unroll
                        for (int j = 0; j < 4; ++j) z[j] = zero4();
#pragma unroll
                        for (int ks = 0; ks < 4; ++ks) { const bf16x8 fq = frag_kc(Qs, 136, 16 * wave, 32 * ks, lane);
#pragma unroll
                            for (int j = 0; j < 4; ++j) z[j] = MFMA16(frag_kc(Ks, 136, 16 * j, 32 * ks, lane), fq, z[j]); }
                        float ls[4][4], x[4][4], tsum[4];
#pragma unroll
                        for (int j = 0; j < 4; ++j) { float tj = 0.f;
#pragma unroll
                            for (int i = 0; i < 4; ++i) { const int s = s0 + 16 * j + 4 * g4 + i; const float zz = z[j][i] * 0.08838834764831845f;
                                const float l1 = fminf(zz, 0.f) - __logf(1.f + __expf(-fabsf(zz)));
                                ls[j][i] = l1; x[j][i] = (s < tq) ? (l1 - zz) : 0.f; tj += x[j][i]; }
                            tsum[j] = tj; }
                        float above[4], tot[4];
#pragma unroll
                        for (int j = 0; j < 4; ++j) { const float y1 = __shfl_xor(tsum[j], 16), y2 = __shfl_xor(tsum[j], 32), y3 = __shfl_xor(tsum[j], 48);
                            tot[j] = tsum[j] + y1 + y2 + y3;
                            above[j] = (g4 == 0) ? (y1 + y2 + y3) : (g4 == 1) ? (y2 + y3) : (g4 == 2) ? y1 : 0.f; }
                        float hi = racc;
#pragma unroll
                        for (int j = 3; j >= 0; --j) { float run = hi + above[j]; float av[4];
#pragma unroll
                            for (int i = 3; i >= 0; --i) { const int s = s0 + 16 * j + 4 * g4 + i; av[i] = (s < tq) ? __expf(ls[j][i] + run) : 0.f; run += x[j][i]; }
                            *(LAS u32x2*)(Aw + r * 72 + 16 * j + 4 * g4) = (u32x2){pk2(av[0], av[1]), pk2(av[2], av[3])};
                            hi += tot[j]; }
                        racc = hi;
                        LDS_WAIT(); asm volatile("" ::: "memory");
#pragma unroll
                        for (int ks = 0; ks < 2; ++ks) { const bf16x8 fa = frag_kc(Aw, 72, 0, 32 * ks, lane);
#pragma unroll
                            for (int d = 0; d < 8; ++d) O[d] = MFMA16(fa, frag_ks(Vs, 136, 16 * d, 32 * ks, lane), O[d]); }
                    }
                    par ^= 1;
                    { const bool wd = __all(racc < -104.f); if (lane == 0) FLG[par * 8 + wave] = wd ? 1u : 0u; }
                }
#pragma unroll
                for (int d = 0; d < 8; ++d)
#pragma unroll
                    for (int i = 0; i < 4; ++i) YCAT[(mb + q0 + 16 * wave + 4 * g4 + i) * YW + 1536 + h * 128 + 16 * d + r] = (bf16)f2bf(O[d][i]);
            }
            GRID_BAR();
        }

        REPS(PH_LIFT) if (IN(PH_LIFT)) {
            PHASE_BEGIN();
            pg8::Gemm g{YCAT, WliftT, 512, YW, 512, (size_t)512 * 2, (size_t)DM * 512 * 2}; pg8::Order S; S.init(T, DM, NBLK, blk, 4);
            pg8::EpiLift E{P + P_G, PW, MB, DM, SSQC};
            pg8::gemm_phase<pg8::EpiLift, GEMM_ALIGN>(lds, g, S, E);
            GRID_BAR();
        }
        REPS(PH_OUT) if (IN(PH_OUT)) {
            PHASE_BEGIN();
            pg8::Gemm g{MB, WoutT, DM, DM, DM, 0, 0}; pg8::Order S; S.init(T, DM, NBLK, blk, 1);
            pg8::EpiResid E{xsrc + grow0 * DM, ka->out + grow0 * DM, DM, ka->in[I_FFNG] + (size_t)l * DM, XN, SSQ2};
            pg8::gemm_phase<pg8::EpiResid, GEMM_ALIGN>(lds, g, S, E);
            GRID_BAR();
        }
        REPS(PH_UP) if (IN(PH_UP)) {
            PHASE_BEGIN();
            pg8::Gemm g{XN, WupT, DM, DM, DM, 0, 0}; pg8::Order S; S.init(T, DFF2, NBLK, blk, 1);
            pg8::EpiConvAct E{ACT, SSQ2, ka->in[I_FCW] + (size_t)l * 3 * DFF2, ka->in[I_FCB] + (size_t)l * DFF2, RAWH, lds + 131072, DFF2 / 256};
            pg8::gemm_phase<pg8::EpiConvAct, GEMM_ALIGN>(lds, g, S, E);
            GRID_BAR();
        }
        REPS(PH_DOWN) if (IN(PH_DOWN)) {
            PHASE_BEGIN();
            pg8::Gemm g{ACT, WdownT, DFF, DFF, DFF, 0, 0}; pg8::Order S; S.init(T, DM, NBLK, blk, 1);
            {
                const float* fw = ka->in[I_FCW] + (size_t)l * 3 * DFF2; const float* fb = ka->in[I_FCB] + (size_t)l * DFF2;
                pg8::Unit uu;
                for (int i = 0; S.next(i, uu); ++i) { const int pm = uu.pm; if ((pm & 7) == 0) continue;
                    for (int ch = tid; ch < DFF; ch += NTHR) { const int tp = ch >> 7, j = ch & 127;
                        const float* own = RAWH + (size_t)(pm * 22 + tp) * 1024; const float* prv = RAWH + (size_t)((pm - 1) * 22 + tp) * 1024;
                        const float g254 = prv[2 * 256 + j], g255 = prv[3 * 256 + j], g0 = own[j], g1 = own[256 + j];
                        const float u254 = prv[2 * 256 + 128 + j], u255 = prv[3 * 256 + 128 + j], u0 = own[128 + j], u1 = own[256 + 128 + j];
                        const float wg0 = fw[ch], wg1 = fw[DFF2 + ch], wg2 = fw[2 * DFF2 + ch], wu0 = fw[DFF + ch], wu1 = fw[DFF2 + DFF + ch], wu2 = fw[2 * DFF2 + DFF + ch], bg = fb[ch], bu = fb[DFF + ch];
                        ACT[(size_t)(pm * 256) * DFF + ch] = (bf16)f2bf(siluf_(bg + wg0 * g254 + wg1 * g255 + wg2 * g0) * (bu + wu0 * u254 + wu1 * u255 + wu2 * u0));
                        ACT[(size_t)(pm * 256 + 1) * DFF + ch] = (bf16)f2bf(siluf_(bg + wg0 * g255 + wg1 * g0 + wg2 * g1) * (bu + wu0 * u255 + wu1 * u0 + wu2 * u1)); } }
                asm volatile("s_waitcnt vmcnt(0)" ::: "memory"); __syncthreads();
            }
            const bool more = (l + 1 < DEPTH);
            pg8::EpiResid E{ka->out + grow0 * DM, ka->out + grow0 * DM, DM, more ? ka->in[I_MIXG] + (size_t)(l + 1) * DM : nullptr, XG + grow0 * DM, SSQ1 + grow0 * 16};
            pg8::gemm_phase<pg8::EpiResid, GEMM_ALIGN>(lds, g, S, E);
            GRID_BAR();
        }
        REPS(PH_FINAL) if (IN(PH_FINAL) && l == DEPTH - 1) {
            PHASE_BEGIN();
            const float* gain = ka->in[I_FING];
            f32x4 gv[4];
#pragma unroll
            for (int j = 0; j < 4; ++j) gv[j] = ((const f32x4*)gain)[lane + 64 * j];
            for (int m = gw; m < T; m += NGW) {
                f32x4* xr = (f32x4*)(ka->out + (grow0 + m) * DM) + lane;
                f32x4 v[4]; float s = 0.f;
#pragma unroll
                for (int j = 0; j < 4; ++j) { v[j] = xr[64 * j]; s += (v[j].x * v[j].x + v[j].y * v[j].y) + (v[j].z * v[j].z + v[j].w * v[j].w); }
                const float rstd = rsqrtf(wave_sum(s) * (1.f / DM) + EPS);
#pragma unroll
                for (int j = 0; j < 4; ++j) xr[64 * j] = v[j] * rstd * gv[j];
            }
            GRID_BAR();
        }
    }
#undef IN
#undef GRID_BAR
#undef PHASE_BEGIN
}

#ifndef ONE_LAUNCH
#define ONE_LAUNCH 1
#endif
extern "C" void kernel_launch(void* const* d_in, const int* in_sizes, int n_in, void* d_out, int out_size, void* d_ws, size_t ws_size, hipStream_t stream) {
    static int grid = 0;
    if (grid == 0) {
        if (n_in != N_IN || in_sizes[0] != BATCH * SEQ * DM || out_size != BATCH * SEQ * DM || ws_size < WS_END) {
            fprintf(stderr, "kernel_launch: unexpected shapes / workspace (n_in %d, ws %zu, need %zu); nothing launched\n", n_in, ws_size, (size_t)WS_END); grid = -1; return; }
        int dev = 0, cus = 0, per_cu = 0;
        if (hipGetDevice(&dev) != hipSuccess || hipDeviceGetAttribute(&cus, hipDeviceAttributeMultiprocessorCount, dev) != hipSuccess) { grid = -1; return; }
        if (hipFuncSetAttribute((const void*)fwd, hipFuncAttributeMaxDynamicSharedMemorySize, LDS_BYTES) != hipSuccess) { fprintf(stderr, "kernel_launch: hipFuncSetAttribute failed\n"); grid = -1; return; }
        if (hipOccupancyMaxActiveBlocksPerMultiprocessor(&per_cu, (const void*)fwd, NTHR, LDS_BYTES) != hipSuccess || per_cu < 1) { fprintf(stderr, "kernel_launch: occupancy query says %d\n", per_cu); (void)hipGetLastError(); }
        grid = cus;
    }
    if (grid < 0) return;
    (void)hipMemsetAsync((char*)d_ws + WS_CTL, 0, CTL_BYTES, stream);
    Args a{};
    for (int i = 0; i < N_IN; ++i) a.in[i] = (const float*)d_in[i];
    a.out = (float*)d_out; a.ws = (unsigned char*)d_ws; a.pad = 0;
#if ONE_LAUNCH
    a.l_lo = 0; a.l_hi = DEPTH; a.g_lo = 0; a.g_hi = NG; a.ph_lo = 0; a.ph_hi = PH_COUNT; a.use_bar = 1;
    hipLaunchKernelGGL(fwd, dim3(grid), dim3(NTHR), LDS_BYTES, stream, a);
#else
    a.use_bar = 0;
    for (int l = 0; l < DEPTH; ++l)
        for (int g = 0; g < NG; ++g)
            for (int ph = 0; ph < PH_COUNT; ++ph) {
                if (ph == PH_W && g != 0) continue;
                if (ph == PH_FINAL && l != DEPTH - 1) continue;
                a.l_lo = l; a.l_hi = l + 1; a.g_lo = g; a.g_hi = g + 1; a.ph_lo = ph; a.ph_hi = ph + 1;
                hipLaunchKernelGGL(fwd, dim3(grid), dim3(NTHR), LDS_BYTES, stream, a);
            }
#endif
}
```

```cpp
#include <hip/hip_runtime.h>
#include <cstdio>
#include <cstdint>

#define LAS __attribute__((address_space(3)))
#define GAS __attribute__((address_space(1)))
typedef unsigned short bf16;
typedef short bf16x8 __attribute__((ext_vector_type(8)));
typedef short s16x4 __attribute__((ext_vector_type(4)));
typedef float f32x4 __attribute__((ext_vector_type(4)));
typedef float f32x2 __attribute__((ext_vector_type(2)));
typedef unsigned u32x4 __attribute__((ext_vector_type(4)));
typedef unsigned u32x2 __attribute__((ext_vector_type(2)));

constexpr int DM = 1024, BATCH = 32, SEQ = 2048, DEPTH = 4;
constexpr int PIN = 10256, PW = 10240, DFF = 2816, DFF2 = 5632;
constexpr int GB = 8;
constexpr int NG = BATCH / GB;
constexpr int T = GB * SEQ;
constexpr int NCH = SEQ / 64;
constexpr float EPS = 1e-6f;
constexpr int P_AQ = 0, P_AK = 256, P_AV = 512, P_AO = 1024, P_BB = 1536, P_BC = 2048, P_BX = 2560, P_CZ = 3072, P_CX = 3584, P_SQ = 4608, P_SK = 5120, P_SV = 5632, P_G = 6144;
constexpr int YW = 2048;

constexpr size_t MiB = 1u << 20;
constexpr size_t WS_CTL = 0, CTL_BYTES = 1 * MiB;
constexpr size_t WS_WIN = 1 * MiB;
constexpr size_t WS_WLIFT = WS_WIN + (size_t)PW * DM * 2;
constexpr size_t WS_WOUT = WS_WLIFT + (size_t)4 * DM * 512 * 2;
constexpr size_t WS_WUP = WS_WOUT + (size_t)DM * DM * 2;
constexpr size_t WS_WDOWN = WS_WUP + (size_t)DFF2 * DM * 2;
constexpr size_t WS_W16 = WS_WDOWN + (size_t)DM * DFF * 2;
constexpr size_t WS_XN = WS_W16 + 65536;
constexpr size_t WS_P = WS_XN + (size_t)T * DM * 2;
constexpr size_t WS_U = WS_P, WS_ACT = WS_P + (size_t)T * DFF2 * 2;
constexpr size_t WS_YCAT = WS_P + (size_t)T * PW * 2;
constexpr size_t WS_XG = WS_YCAT + (size_t)T * YW * 2;
constexpr size_t WS_MB = WS_XG + (size_t)BATCH * SEQ * DM * 2;
constexpr size_t WS_SP = WS_MB + (size_t)T * DM * 2;
constexpr size_t WS_GB = WS_SP + (size_t)T * 16 * 4;
constexpr size_t WS_GG = WS_GB + (size_t)T * 16;
constexpr size_t WS_GMT = WS_GG + (size_t)T * 16;
constexpr size_t WS_MCAR = WS_GMT + (size_t)T * 16;
constexpr size_t WS_MNEW = WS_MCAR + 4096;
constexpr size_t WS_MSC = WS_MNEW + 4096;
constexpr size_t WS_DT = WS_MSC + 4096;
constexpr size_t WS_AC = WS_DT + (size_t)T * 32;
constexpr size_t WS_XBC = WS_AC + (size_t)T * 32;
constexpr size_t WS_DC = WS_XBC + (size_t)T * DM * 2;
constexpr size_t WS_CS = WS_DC + (size_t)GB * 4 * NCH * 9216 * 4;
constexpr size_t WS_DH = WS_CS + (size_t)GB * 4 * NCH * 9216 * 2;
constexpr size_t WS_HS = WS_DH + (size_t)GB * NCH * 8 * 8192 * 4;
constexpr size_t WS_SSQ1 = WS_HS + (size_t)GB * NCH * 8 * 8192 * 2;
constexpr size_t WS_SSQ2 = WS_SSQ1 + (size_t)BATCH * SEQ * 64;
constexpr size_t WS_SSQC = WS_SSQ2 + (size_t)T * 64;
constexpr size_t WS_RAWH = WS_SSQC + (size_t)T * 32;
constexpr size_t WS_END = WS_RAWH + (size_t)(T / 256) * 22 * 4 * 256 * 4;

constexpr int NWAVES = 8, NTHR = 512;
constexpr int LDS_BYTES = 155648;
constexpr int MISC_OFF = 153600;

__device__ __forceinline__ float bf2f(unsigned b) { return __uint_as_float(b << 16); }
__device__ __forceinline__ unsigned f2bf(float f) { unsigned u = __float_as_uint(f); return (u + 0x7fffu + ((u >> 16) & 1u)) >> 16; }
__device__ __forceinline__ unsigned pk2(float lo, float hi) { return f2bf(lo) | (f2bf(hi) << 16); }
__device__ __forceinline__ float sigmoidf_(float x) { return __builtin_amdgcn_rcpf(1.f + __builtin_amdgcn_exp2f(-1.4426950408889634f * x)); }
__device__ __forceinline__ float siluf_(float x) { return x * __builtin_amdgcn_rcpf(1.f + __builtin_amdgcn_exp2f(-1.4426950408889634f * x)); }
__device__ __forceinline__ float logsigf_(float x) { return fminf(x, 0.f) - log1pf(expf(-fabsf(x))); }
__device__ __forceinline__ float softplusf_(float x) { return fmaxf(x, 0.f) + log1pf(expf(-fabsf(x))); }
__device__ __forceinline__ float wave_sum(float v) {
#pragma unroll
    for (int o = 1; o < 64; o <<= 1) v += __shfl_xor(v, o);
    return v;
}
#define LDS_WAIT() asm volatile("s_waitcnt lgkmcnt(0)" ::: "memory")
__device__ __forceinline__ float row_rstd(const float* ssq16) {
    const f32x4* p = (const f32x4*)ssq16; const f32x4 a = (p[0] + p[1]) + (p[2] + p[3]);
    return rsqrtf(((a.x + a.y) + (a.z + a.w)) * (1.f / 1024.f) + 1e-6f);
}

namespace pg8 {
constexpr int BM = 256, BK = 64, HALF = 128, HTB = HALF * BK * 2, STAGE_BYTES = 8 * HTB, NXCD = 8, WGM = 8;
__host__ __device__ __forceinline__ int lds_byte(int r, int c) { const int st = (r >> 4) * 2 + (c >> 5), rr = r & 15, cc = c & 31, ob = rr * 64 + cc * 2; return st * 1024 + (ob ^ (((ob >> 9) & 1) << 5)); }
__host__ __device__ __forceinline__ void stage_rc(int b, int& R, int& C) { const int st = b / 1024, sb = b % 1024, swz = sb ^ (((sb >> 9) & 1) << 5); R = (st >> 1) * 16 + swz / 64; C = (st & 1) * 32 + (swz % 64) / 2; }
__host__ __device__ __forceinline__ int perm32(int rho) { const int n = rho >> 4, i = rho & 15; return 8 * (i >> 2) + 4 * n + (i & 3); }

struct Unit { int pm, pn, z; };
struct Gemm { const bf16* A; const bf16* Bt; int K, lda, ldb; size_t zA, zB; };

struct Order {
    int nM, nN, nwg, G, c, Z;
    __device__ __forceinline__ void init(int M, int N, int G_, int c_, int Z_) { nM = M / BM; nN = N / BM; nwg = nM * nN; G = G_; c = c_; Z = Z_; }
    __device__ __forceinline__ bool next(int i, Unit& u) const {
        const int ti = i / Z; u.z = i - ti * Z;
        const long L = (long)ti * G + c; if (L >= nwg) return false;
        int wgid = (int)L; { const int q = nwg / NXCD, r = nwg % NXCD, xcd = wgid % NXCD, off = wgid / NXCD; wgid = (xcd < r ? xcd * (q + 1) : r * (q + 1) + (xcd - r) * q) + off; }
        const int nig = WGM * nN, gid = wgid / nig, fm = gid * WGM, gsz = (nM - fm) < WGM ? (nM - fm) : WGM;
        u.pm = fm + ((wgid % nig) % gsz); u.pn = (wgid % nig) / gsz; return true;
    }
};
__device__ __forceinline__ unsigned cvt_pk_bf16(float lo, float hi) { unsigned r; asm volatile("v_cvt_pk_bf16_f32 %0, %1, %2" : "=v"(r) : "v"(lo), "v"(hi)); return r; }

struct EpiBf16 {
    static constexpr bool PERM = true, KEEP = false, CONTIG = true;
    bf16* O; int ldc; const float* ssq; int gate_pn0;
    static __device__ __forceinline__ float s1(float x) { return 1.f + __builtin_amdgcn_exp2f(-1.4426950408889634f * __builtin_amdgcn_fmed3f(x, -30.f, 30.f)); }
    __device__ __forceinline__ void operator()(f32x4 (&acc)[2][2][4][2], const Unit& u, int wr, int wc, int fr, int fq) const {
        if (u.pn >= gate_pn0) {
            const int row0g = u.pm * BM + wr * 64 + fr, d0 = 64 * (u.pn - gate_pn0) + 16 * wc + 4 * fq;
#pragma unroll
            for (int ai = 0; ai < 2; ++ai)
#pragma unroll
                for (int m = 0; m < 4; ++m) { const int row = row0g + ai * HALF + m * 16; bf16* rowp = O + (size_t)row * ldc + gate_pn0 * BM + d0;
                    float sq; { const f32x4 p = *(const f32x4*)(ssq + (size_t)row * 16 + 4 * fq); sq = (p.x + p.y) + (p.z + p.w); }
                    sq += __shfl_xor(sq, 16); sq += __shfl_xor(sq, 32);
                    const float rs = rsqrtf(sq * (1.f / 1024.f) + 1e-6f);
                    float one = 1.f; asm volatile("" : "+v"(one));
                    float f0[4], f1[4], f2[4], f3[4];
#pragma unroll
                    for (int e = 0; e < 4; ++e) { const float a0 = s1(acc[ai][0][m][0][e] * rs), a1 = s1(acc[ai][0][m][1][e] * rs), a2 = s1(acc[ai][1][m][0][e] * rs), a3 = s1(acc[ai][1][m][1][e] * rs);
                        f0[e] = a1 * __builtin_amdgcn_rcpf(a0); f1[e] = a2 * __builtin_amdgcn_rcpf(a1); f2[e] = a3 * __builtin_amdgcn_rcpf(a2); f3[e] = one * __builtin_amdgcn_rcpf(a3); }
                    *(u32x2*)(rowp) = (u32x2){cvt_pk_bf16(f0[0], f0[1]), cvt_pk_bf16(f0[2], f0[3])};
                    *(u32x2*)(rowp + 1024) = (u32x2){cvt_pk_bf16(f1[0], f1[1]), cvt_pk_bf16(f1[2], f1[3])};
                    *(u32x2*)(rowp + 2048) = (u32x2){cvt_pk_bf16(f2[0], f2[1]), cvt_pk_bf16(f2[2], f2[3])};
                    *(u32x2*)(rowp + 3072) = (u32x2){cvt_pk_bf16(f3[0], f3[1]), cvt_pk_bf16(f3[2], f3[3])}; }
            return; }
        const int row0 = u.pm * BM + wr * 64 + fr, col0 = u.pn * BM + wc * 64 + 8 * fq;
#pragma unroll
        for (int ai = 0; ai < 2; ++ai)
#pragma unroll
            for (int m = 0; m < 4; ++m) { const int row = row0 + ai * HALF + m * 16; bf16* rowp = O + (size_t)row * ldc + col0;
                float sq; { const f32x4 p = *(const f32x4*)(ssq + (size_t)row * 16 + 4 * fq); sq = (p.x + p.y) + (p.z + p.w); }
                sq += __shfl_xor(sq, 16); sq += __shfl_xor(sq, 32);
                const float rs = rsqrtf(sq * (1.f / 1024.f) + 1e-6f);
#pragma unroll
                for (int bj = 0; bj < 2; ++bj) { const f32x4 v0 = acc[ai][bj][m][0] * rs, v1 = acc[ai][bj][m][1] * rs;
                    u32x4 w; w.x = cvt_pk_bf16(v0[0], v0[1]); w.y = cvt_pk_bf16(v0[2], v0[3]); w.z = cvt_pk_bf16(v1[0], v1[1]); w.w = cvt_pk_bf16(v1[2], v1[3]);
                    *(u32x4*)(rowp + bj * 32) = w; } }
    }
};
struct EpiResid {
    static constexpr bool PERM = true, KEEP = false, CONTIG = true;
    bf16* xb; int ldc; float* ssq;
    __device__ __forceinline__ void operator()(f32x4 (&acc)[2][2][4][2], const Unit& u, int wr, int wc, int fr, int fq) const {
        const int row0 = u.pm * BM + wr * 64 + fr, col0 = u.pn * BM + wc * 64 + 8 * fq;
#pragma unroll
        for (int ai = 0; ai < 2; ++ai)
#pragma unroll
            for (int m = 0; m < 4; ++m) { const int row = row0 + ai * HALF + m * 16; const size_t off = (size_t)row * ldc + col0; float q = 0.f;
#pragma unroll
                for (int bj = 0; bj < 2; ++bj) {
                    const u32x4 o = *(const u32x4*)(xb + off + bj * 32);
                    const f32x4 x0 = (f32x4){bf2f(o.x & 0xffffu), bf2f(o.x >> 16), bf2f(o.y & 0xffffu), bf2f(o.y >> 16)} + acc[ai][bj][m][0];
                    const f32x4 x1 = (f32x4){bf2f(o.z & 0xffffu), bf2f(o.z >> 16), bf2f(o.w & 0xffffu), bf2f(o.w >> 16)} + acc[ai][bj][m][1];
                    q += (x0[0] * x0[0] + x0[1] * x0[1]) + (x0[2] * x0[2] + x0[3] * x0[3]) + (x1[0] * x1[0] + x1[1] * x1[1]) + (x1[2] * x1[2] + x1[3] * x1[3]);
                    u32x4 w; w.x = cvt_pk_bf16(x0[0], x0[1]); w.y = cvt_pk_bf16(x0[2], x0[3]); w.z = cvt_pk_bf16(x1[0], x1[1]); w.w = cvt_pk_bf16(x1[2], x1[3]);
                    *(u32x4*)(xb + off + bj * 32) = w; }
                q += __shfl_xor(q, 16); q += __shfl_xor(q, 32); if (fq == 0) ssq[(size_t)row * 16 + u.pn * 4 + wc] = q;
            }
    }
};
struct EpiLift {
    static constexpr bool PERM = true, KEEP = true, CONTIG = false;
    const bf16* fac; int ldg; bf16* mb; int ldc; const float* ssqc;
    __device__ __forceinline__ void operator()(f32x4 (&acc)[2][2][4][2], const Unit& u, int wr, int wc, int fr, int fq) const {
        const int row0 = u.pm * BM + wr * 64 + fr, col0 = u.pn * BM + wc * 32 + 8 * fq;
#pragma unroll
        for (int ai = 0; ai < 2; ++ai)
#pragma unroll
            for (int m = 0; m < 4; ++m) { const int row = row0 + ai * HALF + m * 16;
                float rsc = 1.f;
                if (u.z == 1 || u.z == 2) { const f32x2 p = *(const f32x2*)(ssqc + (size_t)row * 8 + 2 * fq); float sq = p.x + p.y; sq += __shfl_xor(sq, 16); sq += __shfl_xor(sq, 32);
                    const float v = sq * (1.f / 512.f) + 1e-6f; rsc = (u.z == 1) ? sqrtf(v) : rsqrtf(v); }
#pragma unroll
                for (int bj = 0; bj < 2; ++bj) { const int col = col0 + bj * HALF;
                    const u32x4 g0 = *(const u32x4*)(fac + (size_t)row * ldg + u.z * 1024 + col);
                    f32x4& v0 = acc[ai][bj][m][0]; f32x4& v1 = acc[ai][bj][m][1];
                    v0[0] *= rsc * bf2f(g0.x & 0xffffu); v0[1] *= rsc * bf2f(g0.x >> 16); v0[2] *= rsc * bf2f(g0.y & 0xffffu); v0[3] *= rsc * bf2f(g0.y >> 16);
                    v1[0] *= rsc * bf2f(g0.z & 0xffffu); v1[1] *= rsc * bf2f(g0.z >> 16); v1[2] *= rsc * bf2f(g0.w & 0xffffu); v1[3] *= rsc * bf2f(g0.w >> 16);
                    if (u.z == 3) { u32x4 w; w.x = cvt_pk_bf16(v0[0], v0[1]); w.y = cvt_pk_bf16(v0[2], v0[3]); w.z = cvt_pk_bf16(v1[0], v1[1]); w.w = cvt_pk_bf16(v1[2], v1[3]);
                        *(u32x4*)(mb + (size_t)row * ldc + col) = w; } } }
    }
};

__device__ __forceinline__ float dpp_ror1(float x) { return __int_as_float(__builtin_amdgcn_update_dpp(0, __float_as_int(x), 0x121, 0xf, 0xf, false)); }
__device__ __forceinline__ float dpp_ror2(float x) { return __int_as_float(__builtin_amdgcn_update_dpp(0, __float_as_int(x), 0x122, 0xf, 0xf, false)); }
__device__ __forceinline__ float dpp_prev1(float cur, float prev) { return __int_as_float(__builtin_amdgcn_update_dpp(__builtin_amdgcn_update_dpp(0, __float_as_int(prev), 0x121, 0xf, 0xf, false), __float_as_int(cur), 0x111, 0xf, 0xf, false)); }
__device__ __forceinline__ float dpp_prev2(float cur, float prev) { return __int_as_float(__builtin_amdgcn_update_dpp(__builtin_amdgcn_update_dpp(0, __float_as_int(prev), 0x122, 0xf, 0xf, false), __float_as_int(cur), 0x112, 0xf, 0xf, false)); }
struct EpiConvAct {
    static constexpr bool PERM = true, KEEP = false, CONTIG = false;
    bf16* act; const float* ssq; const float* cw; const float* cb; float* rawh; LAS unsigned char* halo; int ntn;
    __device__ __forceinline__ void operator()(f32x4 (&acc)[2][2][4][2], const Unit& u, int wr, int wc, int fr, int fq) const {
        asm volatile("" : "+v"(fr), "+v"(fq));
        const int row0 = u.pm * BM + wr * 64 + fr, ch0 = u.pn * 128 + wc * 32 + 8 * fq;
#pragma unroll
        for (int ai = 0; ai < 2; ++ai)
#pragma unroll
            for (int m = 0; m < 4; ++m) { const int row = row0 + ai * HALF + m * 16;
                float sq; { const f32x4 p = *(const f32x4*)(ssq + (size_t)row * 16 + 4 * fq); sq = (p.x + p.y) + (p.z + p.w); }
                sq += __shfl_xor(sq, 16); sq += __shfl_xor(sq, 32);
                const float rs = rsqrtf(sq * (1.f / 1024.f) + 1e-6f);
#pragma unroll
                for (int bj = 0; bj < 2; ++bj) { acc[ai][bj][m][0] = acc[ai][bj][m][0] * rs; acc[ai][bj][m][1] = acc[ai][bj][m][1] * rs; } }
        LAS f32x4* H = (LAS f32x4*)halo;
        if (fr >= 14) {
#pragma unroll
            for (int ai = 0; ai < 2; ++ai) { const int b = 2 * ai + wr;
#pragma unroll
                for (int bj = 0; bj < 2; ++bj)
#pragma unroll
                    for (int n = 0; n < 2; ++n) H[((((b * 4 + wc) * 4 + fq) * 2 + (fr - 14)) * 2 + bj) * 2 + n] = acc[ai][bj][3][n]; } }
        { float* rw = rawh + (size_t)(u.pm * ntn + u.pn) * 1024;
          if (wr == 1 && fr >= 14) {
#pragma unroll
            for (int bj = 0; bj < 2; ++bj)
#pragma unroll
                for (int n = 0; n < 2; ++n) *(f32x4*)(rw + (2 + fr - 14) * 256 + bj * HALF + wc * 32 + 8 * fq + 4 * n) = acc[1][bj][3][n]; }
          if (wr == 0 && fr < 2) {
#pragma unroll
            for (int bj = 0; bj < 2; ++bj)
#pragma unroll
                for (int n = 0; n < 2; ++n) *(f32x4*)(rw + fr * 256 + bj * HALF + wc * 32 + 8 * fq + 4 * n) = acc[0][bj][0][n]; } }
        LAS float* WL = (LAS float*)(halo + 8192);
        { const int tidl = (wr * 4 + wc) * 64 + fq * 16 + fr, i2 = tidl * 2, kind = i2 >> 7, c = i2 & 127, k4 = kind & 3;
          const float* src = (k4 < 3 ? cw + k4 * 5632 : cb) + (kind >= 4 ? 2816 : 0) + u.pn * 128 + c;
          *(LAS f32x2*)(WL + i2) = *(const f32x2*)src; }
        asm volatile("s_waitcnt vmcnt(0) lgkmcnt(0)" ::: "memory"); __builtin_amdgcn_s_barrier(); asm volatile("" ::: "memory");
        bf16* actb = act + (size_t)(u.pm * BM + wr * 64) * 2816 + u.pn * 128 + wc * 32;
        const unsigned alane = (unsigned)(fr * 2816 + 8 * fq);
#pragma unroll
        for (int n = 0; n < 2; ++n) {
            unsigned half0[2][4];
#pragma unroll
            for (int eh = 0; eh < 2; ++eh) {
                const int cl = wc * 32 + 8 * fq + 4 * n + 2 * eh;
                f32x2 wg[3], wu[3], bg, bu;
#pragma unroll
                for (int j = 0; j < 3; ++j) { wg[j] = *(const LAS f32x2*)(WL + j * 128 + cl); wu[j] = *(const LAS f32x2*)(WL + (4 + j) * 128 + cl); }
                bg = *(const LAS f32x2*)(WL + 3 * 128 + cl); bu = *(const LAS f32x2*)(WL + 7 * 128 + cl);
#pragma unroll
                for (int ai = 0; ai < 2; ++ai) { const int b = 2 * ai + wr;
#pragma unroll
                    for (int m = 3; m >= 0; --m) {
                        float r2[2];
#pragma unroll
                        for (int e2 = 0; e2 < 2; ++e2) { const int e = 2 * eh + e2;
                            const float gc = acc[ai][0][m][n][e], uc = acc[ai][1][m][n][e];
                            float gp = 0.f, up = 0.f; asm volatile("" : "+v"(gp), "+v"(up));
                            if (m > 0) { gp = acc[ai][0][m - 1][n][e]; up = acc[ai][1][m - 1][n][e]; }
                            else if (b >= 1) { const int fk = fr >= 14 ? fr - 14 : 0; const LAS float* hp = (const LAS float*)(H + ((((b - 1) * 4 + wc) * 4 + fq) * 2 + fk) * 4 + n); gp = hp[e]; up = hp[8 + e]; }
                            const float g1 = dpp_prev1(gc, gp), g2 = dpp_prev2(gc, gp), u1 = dpp_prev1(uc, up), u2 = dpp_prev2(uc, up);
                            const float vg = bg[e2] + wg[0][e2] * g2 + wg[1][e2] * g1 + wg[2][e2] * gc;
                            const float vu = bu[e2] + wu[0][e2] * u2 + wu[1][e2] * u1 + wu[2][e2] * uc;
                            r2[e2] = siluf_(vg) * vu; }
                        const unsigned pk = cvt_pk_bf16(r2[0], r2[1]);
                        if (eh == 0) half0[ai][m] = pk;
                        else *(u32x2*)(actb + (size_t)(ai * HALF + m * 16) * 2816 + 4 * n + alane) = (u32x2){half0[ai][m], pk};
                    }
                }
            }
        }
    }
};

template <class Epi, bool ALIGN_EPI = true>
__device__ __forceinline__ void gemm_phase(LAS unsigned char* lds, const Gemm g, const Order& S, const Epi& E) {
    int tid = threadIdx.x; asm volatile("" : "+v"(tid));
    const int wid = __builtin_amdgcn_readfirstlane(tid >> 6), lane = tid & 63, wr = wid >> 2, wc = wid & 3, fr = lane & 15, fq = lane >> 4;
    const int K = g.K, nt = K / BK;
    unsigned voffA[2], voffB[2];
#pragma unroll
    for (int i = 0; i < 2; ++i) { int R, C; stage_rc(tid * 16 + i * 8192, R, C);
        const int Rb = Epi::CONTIG ? (64 * (R >> 5) + perm32(R & 31)) : (Epi::PERM ? ((R & ~31) + perm32(R & 31)) : R);
        voffA[i] = (unsigned)(R * g.lda + C) * 2u; voffB[i] = (unsigned)(Rb * g.ldb + C) * 2u; }
    const size_t kstep = (size_t)(BK * 2);
    const size_t hstepA = (size_t)HALF * g.lda * 2, hstepB = (size_t)(Epi::CONTIG ? 32 : HALF) * g.ldb * 2;
    const size_t tstepA = 2 * hstepA, tstepB = (size_t)BM * g.ldb * 2;
    const unsigned ldsw = (unsigned)wid * 1024u;
    const int aoff = lds_byte(wr * 64 + fr, fq * 8), boff = lds_byte(wc * 32 + fr, fq * 8);
#define PG8_SA(b, h) (((b) * 2 + (h)) * HTB)
#define PG8_SB(b, h) ((4 + (b) * 2 + (h)) * HTB)
#define PG8_STAGE(bufoff, gbase, voff) do { _Pragma("unroll") for (int _i = 0; _i < 2; ++_i) \
        __builtin_amdgcn_global_load_lds((const unsigned*)((const char*)(gbase) + (voff)[_i]), (LAS unsigned*)(lds + (bufoff) + ldsw + _i * 8192), 16, 0, 0); } while (0)
#define PG8_LDA(dst, b, h) do { _Pragma("unroll") for (int m = 0; m < 4; ++m) _Pragma("unroll") for (int k = 0; k < 2; ++k) dst[m][k] = *(const LAS bf16x8*)(lds + PG8_SA(b, h) + aoff + m * 2048 + k * 1024); } while (0)
#define PG8_LDB(dst, b, h) do { _Pragma("unroll") for (int n = 0; n < 2; ++n) _Pragma("unroll") for (int k = 0; k < 2; ++k) dst[n][k] = *(const LAS bf16x8*)(lds + PG8_SB(b, h) + boff + n * 2048 + k * 1024); } while (0)
#define PG8_MMA(ai, bj, At, Bt) do { __builtin_amdgcn_s_setprio(1); _Pragma("unroll") for (int m = 0; m < 4; ++m) _Pragma("unroll") for (int n = 0; n < 2; ++n) _Pragma("unroll") for (int k = 0; k < 2; ++k) \
        acc[ai][bj][m][n] = __builtin_amdgcn_mfma_f32_16x16x32_bf16(Bt[n][k], At[m][k], acc[ai][bj][m][n], 0, 0, 0); __builtin_amdgcn_s_setprio(0); } while (0)
#define PG8_WAIT_V(n) asm volatile("s_waitcnt vmcnt(" #n ")" ::: "memory")
#define PG8_WAIT_L(n) asm volatile("s_waitcnt lgkmcnt(" #n ")" ::: "memory")
#define PG8_BAR __builtin_amdgcn_s_barrier()
#define PG8_SCHED __builtin_amdgcn_sched_barrier(0)
    Unit cur, nxt; int ui = 0;
    if (!S.next(0, cur)) return;
    f32x4 acc[2][2][4][2];
#pragma unroll
    for (int a = 0; a < 2; ++a)
#pragma unroll
        for (int b = 0; b < 2; ++b)
#pragma unroll
            for (int m = 0; m < 4; ++m)
#pragma unroll
                for (int n = 0; n < 2; ++n) acc[a][b][m][n] = (f32x4){0.f, 0.f, 0.f, 0.f};
    bf16x8 At[4][2], B0[2][2], B1[2][2];
    const char* cA = (const char*)g.A + (size_t)cur.pm * tstepA + (size_t)cur.z * g.zA; const char* cB = (const char*)g.Bt + (size_t)cur.pn * tstepB + (size_t)cur.z * g.zB;
    PG8_STAGE(PG8_SB(0, 0), cB, voffB); PG8_STAGE(PG8_SB(0, 1), cB + hstepB, voffB); PG8_STAGE(PG8_SA(0, 0), cA, voffA); PG8_STAGE(PG8_SA(0, 1), cA + hstepA, voffA);
    if (wr == 1) PG8_BAR;
    PG8_WAIT_V(2); PG8_BAR;
    PG8_STAGE(PG8_SB(1, 0), cB + kstep, voffB); PG8_STAGE(PG8_SA(1, 0), cA + kstep, voffA); PG8_STAGE(PG8_SB(1, 1), cB + hstepB + kstep, voffB);
    PG8_WAIT_V(6); PG8_BAR;
    for (;;) {
        const bool has_next = S.next(ui + 1, nxt);
        const char* nA = has_next ? (const char*)g.A + (size_t)nxt.pm * tstepA + (size_t)nxt.z * g.zA : cA; const char* nB = has_next ? (const char*)g.Bt + (size_t)nxt.pn * tstepB + (size_t)nxt.z * g.zB : cB;
        for (int t = 0; t < nt; t += 2) {
            const bool last = (t == nt - 2);
            const char* a1 = cA + (size_t)(t + 1) * kstep;
            const char* a2 = last ? nA : cA + (size_t)(t + 2) * kstep; const char* b2 = last ? nB : cB + (size_t)(t + 2) * kstep;
            const char* a3 = a2 + kstep; const char* b3 = b2 + kstep;
            PG8_LDB(B0, 0, 0); PG8_LDB(B1, 0, 1); PG8_SCHED; PG8_LDA(At, 0, 0); PG8_STAGE(PG8_SA(1, 1), a1 + hstepA, voffA);
            PG8_WAIT_V(8); PG8_WAIT_L(0); PG8_BAR; PG8_MMA(0, 0, At, B0); PG8_MMA(0, 1, At, B1); PG8_BAR; PG8_SCHED;
            PG8_LDA(At, 0, 1); PG8_STAGE(PG8_SB(0, 0), b2, voffB); PG8_STAGE(PG8_SB(0, 1), b2 + hstepB, voffB); PG8_STAGE(PG8_SA(0, 0), a2, voffA);
            PG8_WAIT_V(8); PG8_WAIT_L(0); PG8_BAR; PG8_MMA(1, 0, At, B0); PG8_MMA(1, 1, At, B1); PG8_BAR; PG8_SCHED;
            PG8_LDB(B0, 1, 0); PG8_LDB(B1, 1, 1); PG8_SCHED; PG8_LDA(At, 1, 0); PG8_STAGE(PG8_SA(0, 1), a2 + hstepA, voffA);
            PG8_WAIT_V(8); PG8_WAIT_L(0); PG8_BAR; PG8_MMA(0, 0, At, B0); PG8_MMA(0, 1, At, B1); PG8_BAR; PG8_SCHED;
            PG8_LDA(At, 1, 1); PG8_STAGE(PG8_SB(1, 0), b3, voffB); PG8_STAGE(PG8_SB(1, 1), b3 + hstepB, voffB); PG8_STAGE(PG8_SA(1, 0), a3, voffA);
            PG8_WAIT_V(8); PG8_WAIT_L(0); PG8_BAR; PG8_MMA(1, 0, At, B0); PG8_MMA(1, 1, At, B1); PG8_BAR; PG8_SCHED;
        }
        if constexpr (ALIGN_EPI) { if (wr == 0) PG8_BAR; }
        E(acc, cur, wr, wc, fr, fq);
        if (!has_next) break;
        if (!(Epi::KEEP && nxt.z != 0))
#pragma unroll
        for (int a = 0; a < 2; ++a)
#pragma unroll
            for (int b = 0; b < 2; ++b)
#pragma unroll
                for (int m = 0; m < 4; ++m)
#pragma unroll
                    for (int n = 0; n < 2; ++n) acc[a][b][m][n] = (f32x4){0.f, 0.f, 0.f, 0.f};
        cur = nxt; cA = nA; cB = nB; ++ui;
        if constexpr (ALIGN_EPI) { if (wr == 1) PG8_BAR; }
    }
    PG8_WAIT_V(0);
    if constexpr (!ALIGN_EPI) { if (wr == 0) PG8_BAR; }
    PG8_BAR;
#undef PG8_SA
#undef PG8_SB
#undef PG8_STAGE
#undef PG8_LDA
#undef PG8_LDB
#undef PG8_MMA
#undef PG8_WAIT_V
#undef PG8_WAIT_L
#undef PG8_BAR
#undef PG8_SCHED
}
}

#define XB_TMO      128
#define XB_XCNT(j)  (256  + 64 * (j))
#define XB_XSUB(j)  (1280 + 64 * (j))
#define XB_XGEN(j)  (2304 + 64 * (j))
#define XB_TOP      3328
#define XB_TOPGEN   3392
#define XCD_BAR_WORDS 3456
#define XB_SPIN_CAP (1u << 18)
__device__ __forceinline__ unsigned xb_ld(unsigned* p)              { return __hip_atomic_load(p, __ATOMIC_RELAXED, __HIP_MEMORY_SCOPE_AGENT); }
__device__ __forceinline__ unsigned xb_add(unsigned* p, unsigned v) { return __hip_atomic_fetch_add(p, v, __ATOMIC_RELAXED, __HIP_MEMORY_SCOPE_AGENT); }
__device__ __forceinline__ unsigned xb_xcc_id() { return (unsigned)__builtin_amdgcn_s_getreg((3 << 11) | 20) & 0xFu; }
#define XB_SPIN(cond, bar) do { unsigned _sp = 0; while (cond) { __builtin_amdgcn_s_sleep(1); \
    if ((++_sp & 255u) == 0u) { if (xb_ld(&(bar)[XB_TMO])) break; if (_sp > XB_SPIN_CAP) { atomicAdd(&(bar)[XB_TMO], 1u); break; } } } } while (0)
struct XcdBarrier { unsigned* bar; unsigned x; volatile LAS unsigned* st; };
__device__ __forceinline__ XcdBarrier xcd_barrier_post(unsigned* bar, volatile LAS unsigned* st) {
    XcdBarrier b; b.bar = bar; b.x = xb_xcc_id(); b.st = st;
    if (threadIdx.x == 0) (void)xb_add(&bar[XB_XCNT(b.x)], 1u);
    return b;
}
__device__ __forceinline__ void xcd_barrier_complete(unsigned* bar, unsigned x, unsigned& nloc, unsigned& nx) {
    const unsigned G = gridDim.x * gridDim.y * gridDim.z;
    unsigned sum, cnt, mine, sp = 0u;
    for (;;) {
        sum = 0u; cnt = 0u; mine = 0u;
#pragma unroll
        for (unsigned j = 0; j < 16; ++j) { const unsigned c = xb_ld(&bar[XB_XCNT(j)]); sum += c; cnt += (c > 0u) ? 1u : 0u; mine = (j == x) ? c : mine; }
        if (sum == G) break;
        __builtin_amdgcn_s_sleep(1);
        if ((++sp & 255u) == 0u) { if (xb_ld(&bar[XB_TMO])) break; if (sp > XB_SPIN_CAP) { atomicAdd(&bar[XB_TMO], 1u); break; } }
    }
    nloc = mine > 0u ? mine : 1u; nx = cnt > 0u ? cnt : 1u;
}
__device__ __forceinline__ void xcd_barrier(const XcdBarrier& b) {
    asm volatile("s_waitcnt vmcnt(0)" ::: "memory");
    __syncthreads();
    if (threadIdx.x == 0) {
        unsigned* bar = b.bar;
        __builtin_amdgcn_s_waitcnt(0);
        unsigned nloc = b.st[0], nx = b.st[1];
        if (nloc == 0u) { xcd_barrier_complete(bar, b.x, nloc, nx); b.st[0] = nloc; b.st[1] = nx; }
        const unsigned old = xb_add(&bar[XB_XSUB(b.x)], 1u);
        const unsigned gen = old / nloc;
        if (old + 1u == (gen + 1u) * nloc) {
            __builtin_amdgcn_fence(__ATOMIC_RELEASE, "agent");
            asm volatile("s_waitcnt vmcnt(0)" ::: "memory");
            const unsigned og = xb_add(&bar[XB_TOP], 1u);
            const unsigned tg = og / nx;
            if (og + 1u == (tg + 1u) * nx) xb_add(&bar[XB_TOPGEN], 1u);
            else XB_SPIN(xb_ld(&bar[XB_TOPGEN]) == tg, bar);
            __builtin_amdgcn_fence(__ATOMIC_ACQUIRE, "agent");
            xb_add(&bar[XB_XGEN(b.x)], 1u);
            asm volatile("s_waitcnt vmcnt(0)" ::: "memory");
        } else {
            XB_SPIN(xb_ld(&bar[XB_XGEN(b.x)]) == gen, bar);
            __builtin_amdgcn_fence(__ATOMIC_ACQUIRE, "agent");
            asm volatile("s_waitcnt vmcnt(0)" ::: "memory");
        }
    }
    __syncthreads();
}

__device__ __forceinline__ bf16x8 frag_kc(const LAS bf16* X, int ld, int mn0, int k0, int lane) { return *(const LAS bf16x8*)(X + (mn0 + (lane & 15)) * ld + k0 + 8 * (lane >> 4)); }
__device__ __forceinline__ bf16x8 gfrag_kc(const bf16* X, int ld, int mn0, int k0, int lane) { const bf16* b = X + (size_t)mn0 * ld + k0; const unsigned lo = (unsigned)((lane & 15) * ld + 8 * (lane >> 4)); return *(const bf16x8*)(b + lo); }
__device__ __forceinline__ s16x4 trr(const LAS bf16* p) { return __builtin_bit_cast(s16x4, __builtin_amdgcn_ds_read_tr16_b64_v4i16((LAS s16x4*)p)); }
__device__ __forceinline__ bf16x8 frag_ks(const LAS bf16* X, int ld, int mn0, int k0, int lane) {
    const int r = lane & 15, g = lane >> 4;
    const LAS bf16* p = X + (k0 + 8 * g + (r >> 2)) * ld + mn0 + 4 * (r & 3);
    const s16x4 lo = trr(p), hi = trr(p + 4 * ld);
    return (bf16x8){lo[0], lo[1], lo[2], lo[3], hi[0], hi[1], hi[2], hi[3]};
}
__device__ __forceinline__ f32x4 zero4() { f32x4 z = {0.f, 0.f, 0.f, 0.f}; asm volatile("" : "+v"(z)); return z; }
__device__ __forceinline__ u32x4 uone4() { u32x4 z = {0x3F80u, 0u, 0u, 0u}; asm volatile("" : "+v"(z)); return z; }
__device__ __forceinline__ u32x4 uzero4() { u32x4 z = {0u, 0u, 0u, 0u}; asm volatile("" : "+v"(z)); return z; }
#define MFMA16(a, b, c) __builtin_amdgcn_mfma_f32_16x16x32_bf16((a), (b), (c), 0, 0, 0)
__device__ __forceinline__ u32x4 scale8(u32x4 w, float s) {
    u32x4 o;
    o.x = pk2(bf2f(w.x & 0xffffu) * s, bf2f(w.x >> 16) * s); o.y = pk2(bf2f(w.y & 0xffffu) * s, bf2f(w.y >> 16) * s);
    o.z = pk2(bf2f(w.z & 0xffffu) * s, bf2f(w.z >> 16) * s); o.w = pk2(bf2f(w.w & 0xffffu) * s, bf2f(w.w >> 16) * s);
    return o;
}
__device__ __forceinline__ float wscan_add(float v, int lane) {
#pragma unroll
    for (int o = 1; o < 64; o <<= 1) { const float t = __shfl_up(v, o); if (lane >= o) v += t; }
    return v;
}
__device__ __forceinline__ float wscan_max(float v, int lane) {
#pragma unroll
    for (int o = 1; o < 64; o <<= 1) { const float t = __shfl_up(v, o); if (lane >= o) v = fmaxf(v, t); }
    return v;
}

#ifndef GEMM_ALIGN
#define GEMM_ALIGN true
#endif
enum { PH_W = 0, PH_INPROJ, PH_M0, PH_M1, PH_M2, PH_M3, PH_ATT, PH_LIFT, PH_OUT, PH_UP, PH_DOWN, PH_FINAL, PH_COUNT };
enum { I_X = 0, I_MIXG, I_WIN, I_AIB, I_AFB, I_ANG, I_BCW, I_CCW, I_CCB, I_CDTB, I_CALOG, I_CDSKIP, I_CNG, I_WLIFT, I_WOUT, I_FFNG, I_WUP, I_FCW, I_FCB, I_WDOWN, I_FING, N_IN };
struct Args { const float* in[N_IN]; float* out; unsigned char* ws; int l_lo, l_hi, g_lo, g_hi, ph_lo, ph_hi, use_bar, pad; };

__device__ __forceinline__ void transpose_item(const float* W, int ldw, int nsrc0, int k0, bf16* WT, int ldt, int ndst0, LAS float* scr, int lane, const float* kscale = nullptr, int gate_tile = -1) {
    int scol = nsrc0 + (lane & 31);
    if (gate_tile >= 0) {
        const int c = (ndst0 & 255) + (lane & 31), wc = c >> 6, bj = (c >> 5) & 1, fq = (c >> 3) & 3, n = (c >> 2) & 1, e = c & 3;
        scol = 6160 + (2 * bj + n) * 1024 + 64 * gate_tile + 16 * wc + 4 * fq + e; }
#pragma unroll 8
    for (int i = 0; i < 32; ++i) { const int kk = 2 * i + (lane >> 5); scr[kk * 33 + (lane & 31)] = W[(size_t)(k0 + kk) * ldw + scol] * (kscale ? kscale[k0 + kk] : 1.f); }
    LDS_WAIT(); asm volatile("" ::: "memory");
    const int c = lane & 7;
#pragma unroll
    for (int j = 0; j < 4; ++j) { const int n = (lane >> 3) + 8 * j; const LAS float* s = scr + (8 * c) * 33 + n;
        u32x4 o; o.x = pk2(s[0 * 33], s[1 * 33]); o.y = pk2(s[2 * 33], s[3 * 33]); o.z = pk2(s[4 * 33], s[5 * 33]); o.w = pk2(s[6 * 33], s[7 * 33]);
        *(u32x4*)(WT + (size_t)(ndst0 + n) * ldt + k0 + 8 * c) = o; }
    LDS_WAIT(); asm volatile("" ::: "memory");
}

__global__ void __launch_bounds__(NTHR, 2) fwd(Args args) {
    extern __shared__ __attribute__((aligned(16))) unsigned char lds_raw[];
    LAS unsigned char* lds = (LAS unsigned char*)lds_raw;
    const int NBLK = gridDim.x, blk = blockIdx.x;
    {
        volatile LAS unsigned* MISC0 = (volatile LAS unsigned*)(lds + MISC_OFF);
        if (threadIdx.x < 16) MISC0[threadIdx.x] = 0u;
        __syncthreads();
    }
    XcdBarrier bar; bar.bar = (unsigned*)(args.ws + WS_CTL) + 4096; bar.x = 0; bar.st = nullptr;
    if (args.use_bar) bar = xcd_barrier_post((unsigned*)(args.ws + WS_CTL) + 4096, (volatile LAS unsigned*)(lds + MISC_OFF) + 8);
#define GRID_BAR() do { if (args.use_bar) xcd_barrier(bar); } while (0)
#ifndef REPMASK
#define REPMASK 0
#endif
#define IN(k) (args.ph_lo <= (k) && (k) < args.ph_hi)
#define REPS(k) for (int rep_ = 0; rep_ < 1 + ((REPMASK >> (k)) & 1); ++rep_)
#define PHASE_BEGIN() int tid = threadIdx.x; asm volatile("" : "+v"(tid)); const int lane = tid & 63, wave = __builtin_amdgcn_readfirstlane(tid >> 6); \
    const __attribute__((address_space(4))) Args* ka = (const __attribute__((address_space(4))) Args*)__builtin_amdgcn_kernarg_segment_ptr(); asm volatile("" : "+s"(ka)); \
    unsigned char* ws = ka->ws; \
    const size_t grow0 = (size_t)grp * T; const float* xsrc = (l == 0) ? ka->in[I_X] : ka->out; (void)grow0; (void)xsrc; \
    const int gw = blk * NWAVES + wave, NGW = NBLK * NWAVES, gt = blk * NTHR + tid, NGT = NBLK * NTHR; (void)lane; (void)gw; (void)NGW; (void)gt; (void)NGT; \
    bf16* const WinT = (bf16*)(ws + WS_WIN); bf16* const WliftT = (bf16*)(ws + WS_WLIFT); bf16* const WoutT = (bf16*)(ws + WS_WOUT); \
    bf16* const WupT = (bf16*)(ws + WS_WUP); bf16* const WdownT = (bf16*)(ws + WS_WDOWN); bf16* const W16B = (bf16*)(ws + WS_W16); \
    bf16* const XN = (bf16*)(ws + WS_XN); bf16* const P = (bf16*)(ws + WS_P); bf16* const U = (bf16*)(ws + WS_U); bf16* const ACT = (bf16*)(ws + WS_ACT); \
    bf16* const YCAT = (bf16*)(ws + WS_YCAT); bf16* const XG = (bf16*)(ws + WS_XG); bf16* const MB = (bf16*)(ws + WS_MB); float* const SP = (float*)(ws + WS_SP); \
    float* const SSQ1 = (float*)(ws + WS_SSQ1); float* const SSQ2 = (float*)(ws + WS_SSQ2); float* const SSQC = (float*)(ws + WS_SSQC); float* const RAWH = (float*)(ws + WS_RAWH); (void)SSQ1; (void)SSQ2; (void)SSQC; (void)RAWH; \
    float* const GBc = (float*)(ws + WS_GB); float* const GGc = (float*)(ws + WS_GG); float* const GMT = (float*)(ws + WS_GMT); \
    float* const MCAR = (float*)(ws + WS_MCAR); float* const MNEW = (float*)(ws + WS_MNEW); float* const MSC = (float*)(ws + WS_MSC); \
    float* const DTB = (float*)(ws + WS_DT); float* const ACB = (float*)(ws + WS_AC); bf16* const XBC = (bf16*)(ws + WS_XBC); \
    bf16* const DC = (bf16*)(ws + WS_DC); bf16* const CS = (bf16*)(ws + WS_CS); bf16* const DH = (bf16*)(ws + WS_DH); bf16* const HS = (bf16*)(ws + WS_HS); \
    (void)WinT; (void)WliftT; (void)WoutT; (void)WupT; (void)WdownT; (void)W16B; (void)XN; (void)P; (void)U; (void)ACT; (void)YCAT; (void)XG; (void)MB; (void)SP; (void)GBc; (void)GGc; (void)GMT; \
    (void)MCAR; (void)MNEW; (void)MSC; (void)DTB; (void)ACB; (void)XBC; (void)DC; (void)CS; (void)DH; (void)HS

    for (int l = args.l_lo; l < args.l_hi; ++l)
    for (int grp = args.g_lo; grp < args.g_hi; ++grp) {

        REPS(PH_W) if (IN(PH_W) && grp == 0) {
            PHASE_BEGIN();
            LAS float* scr = (LAS float*)(lds + wave * 16384);
            constexpr int I_IN = 16 * 320, I_LF = 4 * 8 * 32, I_OUT = 16 * 32, I_UP = 16 * 176, I_DN = 44 * 32, NIT = I_IN + I_LF + I_OUT + I_UP + I_DN;
            for (int it = gw; it < NIT; it += NGW) {
                int r = it;
                if (r < I_IN) { const int kb = r / 320, nb = r % 320, n0 = 32 * nb, ns = n0 + (n0 >= P_SQ ? 16 : (n0 >= P_BB ? 8 : 0));
                    transpose_item(ka->in[I_WIN] + (size_t)l * DM * PIN, PIN, ns, 64 * kb, WinT, DM, n0, scr, lane, ka->in[I_MIXG] + (size_t)l * DM, n0 >= P_G ? (n0 - P_G) >> 8 : -1); continue; } r -= I_IN;
                if (r < I_LF) { const int br = r / 256, q = r % 256, kb = q / 32, nb = q % 32;
                    transpose_item(ka->in[I_WLIFT] + (size_t)(l * 4 + br) * 512 * DM, DM, 32 * nb, 64 * kb, WliftT + (size_t)br * DM * 512, 512, 32 * nb, scr, lane, br == 2 ? ka->in[I_CNG] + (size_t)l * 512 : nullptr); continue; } r -= I_LF;
                if (r < I_OUT) { const int kb = r / 32, nb = r % 32;
                    transpose_item(ka->in[I_WOUT] + (size_t)l * DM * DM, DM, 32 * nb, 64 * kb, WoutT, DM, 32 * nb, scr, lane); continue; } r -= I_OUT;
                if (r < I_UP) { const int kb = r / 176, nb = r % 176, n0 = 32 * nb, tp = n0 >> 8, j = n0 & 255, ns = (j < 128) ? 128 * tp + j : 2816 + 128 * tp + (j - 128);
                    transpose_item(ka->in[I_WUP] + (size_t)l * DM * DFF2, DFF2, ns, 64 * kb, WupT, DM, n0, scr, lane, ka->in[I_FFNG] + (size_t)l * DM); continue; } r -= I_UP;
                { const int kb = r / 32, nb = r % 32;
                    transpose_item(ka->in[I_WDOWN] + (size_t)l * DFF * DM, DM, 32 * nb, 64 * kb, WdownT, DFF, 32 * nb, scr, lane); }
            }
            for (int i = gt; i < 16 * DM; i += NGT) { const int c = i >> 10, k = i & 1023; const int oc = (c < 8) ? (1536 + c) : (4616 + (c - 8));
                const float w = ka->in[I_WIN][(size_t)l * DM * PIN + (size_t)k * PIN + oc] * ka->in[I_MIXG][(size_t)l * DM + k]; const unsigned hi = f2bf(w);
                W16B[i] = (bf16)hi; W16B[16 * DM + i] = (bf16)f2bf(w - bf2f(hi)); }
            if (l == 0) {
                for (int m = gw; m < BATCH * SEQ; m += NGW) {
                    const f32x4* xr = (const f32x4*)(ka->in[I_X] + (size_t)m * DM) + lane;
                    f32x4 v[4]; float sq = 0.f;
#pragma unroll
                    for (int j = 0; j < 4; ++j) { v[j] = xr[64 * j]; sq += (v[j].x * v[j].x + v[j].y * v[j].y) + (v[j].z * v[j].z + v[j].w * v[j].w); }
                    sq = wave_sum(sq); if (lane < 16) SSQ1[(size_t)m * 16 + lane] = (lane == 0) ? sq : 0.f;
                    u32x2* o8 = (u32x2*)(XG + (size_t)m * DM) + lane;
#pragma unroll
                    for (int j = 0; j < 4; ++j) o8[64 * j] = (u32x2){pk2(v[j].x, v[j].y), pk2(v[j].z, v[j].w)};
                }
            }
            GRID_BAR();
        }

        REPS(PH_INPROJ) if (IN(PH_INPROJ)) {
            PHASE_BEGIN();
            const bf16* XGg = XG + grow0 * DM; const float* ssq = SSQ1 + grow0 * 16;
            for (int rb = blk; rb < T / 64; rb += NBLK) {
                const int r0 = rb * 64 + 16 * (wave & 3), kh = (wave >> 2) * 512; f32x4 acc = zero4(), acc2 = zero4();
#pragma unroll 8
                for (int ks = 0; ks < 16; ++ks) { const bf16x8 a = gfrag_kc(XGg, DM, r0, kh + 32 * ks, lane);
                    acc = MFMA16(a, gfrag_kc(W16B, DM, 0, kh + 32 * ks, lane), acc); acc2 = MFMA16(a, gfrag_kc(W16B + 16 * DM, DM, 0, kh + 32 * ks, lane), acc2); }
                acc += acc2;
                LAS f32x4* xch = (LAS f32x4*)lds;
                if (wave >= 4) xch[(wave - 4) * 64 + lane] = acc;
                __syncthreads();
                if (wave < 4) { acc += xch[wave * 64 + lane];
#pragma unroll
                    for (int i = 0; i < 4; ++i) { const int row = r0 + 4 * (lane >> 4) + i; SP[(size_t)row * 16 + (lane & 15)] = acc[i] * row_rstd(ssq + (size_t)row * 16); } }
                __syncthreads();
            }
            pg8::Gemm g{XGg, WinT, DM, DM, DM, 0, 0}; pg8::Order S; S.init(T, PW, NBLK, blk, 1);
            pg8::EpiBf16 E{P, PW, ssq, P_G / 256};
            pg8::gemm_phase<pg8::EpiBf16, GEMM_ALIGN>(lds, g, S, E);
            GRID_BAR();
        }

        REPS(PH_M0) if (IN(PH_M0)) {
            PHASE_BEGIN();
            for (int task = gw; task < GB * 4; task += NGW) {
                const int bl = task >> 2, h = task & 3; float mcar = 0.f;
                const float igb = ka->in[I_AIB][l * 4 + h], fgb = ka->in[I_AFB][l * 4 + h];
                float igv[NCH], fgv[NCH];
#pragma unroll
                for (int c = 0; c < NCH; ++c) { const size_t m = (size_t)bl * SEQ + c * 64 + lane; igv[c] = SP[m * 16 + h]; fgv[c] = SP[m * 16 + 4 + h]; }
#pragma unroll
                for (int c = 0; c < NCH; ++c) {
                    const size_t m = (size_t)bl * SEQ + c * 64 + lane;
                    const float ig = igv[c] + igb, fg = fgv[c] + fgb;
                    const float b = wscan_add(logsigf_(fg), lane);
                    const float gg = ig - b;
                    const float pm = wscan_max(gg, lane);
                    GBc[m * 4 + h] = b; GGc[m * 4 + h] = gg; GMT[m * 4 + h] = b + fmaxf(mcar, pm);
                    const float bL = __shfl(b, 63), gmax = __shfl(pm, 63);
                    const float mnew = bL + fmaxf(mcar, gmax);
                    if (lane == 0) { MCAR[task * NCH + c] = mcar; MNEW[task * NCH + c] = mnew; MSC[task * NCH + c] = __expf(bL + mcar - mnew); }
                    mcar = mnew;
                }
            }
            for (int task = gw; task < GB * NCH; task += NGW) {
                const size_t m = (size_t)task * 64 + lane;
#pragma unroll
                for (int hd = 0; hd < 8; ++hd) {
                    const float dt = softplusf_(SP[m * 16 + 8 + hd] + ka->in[I_CDTB][l * 8 + hd]);
                    const float a = wscan_add(-dt * __expf(ka->in[I_CALOG][l * 8 + hd]), lane);
                    DTB[m * 8 + hd] = dt; ACB[m * 8 + hd] = a;
                }
            }
            {
                const float* cw = ka->in[I_CCW] + (size_t)l * 4 * 1024; const float* cb = ka->in[I_CCB] + (size_t)l * 1024;
                constexpr int RUN = 16;
                for (int i = gt; i < (T / RUN) * 128; i += NGT) {
                    const int rb = i >> 7, c8 = (i & 127) * 8, m0 = rb * RUN, t0 = m0 & (SEQ - 1);
                    float w[4][8], bb[8];
#pragma unroll
                    for (int e = 0; e < 8; ++e) { bb[e] = cb[c8 + e];
#pragma unroll
                        for (int j = 0; j < 4; ++j) w[j][e] = cw[j * 1024 + c8 + e]; }
                    const u32x4 zz = uzero4(); u32x4 win[4]; win[0] = zz; win[1] = zz; win[2] = zz;
                    if (t0 >= 3) { const bf16* pr = P + (size_t)(m0 - 3) * PW + P_CX + c8; win[0] = *(const u32x4*)pr; win[1] = *(const u32x4*)(pr + PW); win[2] = *(const u32x4*)(pr + 2 * PW); }
#pragma unroll 4
                    for (int rr = 0; rr < RUN; ++rr) {
                        win[3] = *(const u32x4*)(P + (size_t)(m0 + rr) * PW + P_CX + c8);
                        float acc[8];
#pragma unroll
                        for (int e = 0; e < 8; ++e) acc[e] = bb[e];
#pragma unroll
                        for (int j = 0; j < 4; ++j) {
                            acc[0] += w[j][0] * bf2f(win[j].x & 0xffffu); acc[1] += w[j][1] * bf2f(win[j].x >> 16); acc[2] += w[j][2] * bf2f(win[j].y & 0xffffu); acc[3] += w[j][3] * bf2f(win[j].y >> 16);
                            acc[4] += w[j][4] * bf2f(win[j].z & 0xffffu); acc[5] += w[j][5] * bf2f(win[j].z >> 16); acc[6] += w[j][6] * bf2f(win[j].w & 0xffffu); acc[7] += w[j][7] * bf2f(win[j].w >> 16); }
                        u32x4 o; o.x = pk2(siluf_(acc[0]), siluf_(acc[1])); o.y = pk2(siluf_(acc[2]), siluf_(acc[3])); o.z = pk2(siluf_(acc[4]), siluf_(acc[5])); o.w = pk2(siluf_(acc[6]), siluf_(acc[7]));
                        *(u32x4*)(XBC + (size_t)(m0 + rr) * 1024 + c8) = o;
                        win[0] = win[1]; win[1] = win[2]; win[2] = win[3];
                    }
                }
            }
            {
                const float* bw = ka->in[I_BCW] + (size_t)l * 3 * 512;
                constexpr int RUN = 16;
                for (int i = gt; i < (T / RUN) * 64; i += NGT) {
                    const int rb = i >> 6, c8 = (i & 63) * 8, m0 = rb * RUN, t0 = m0 & (SEQ - 1);
                    float w[3][8];
#pragma unroll
                    for (int e = 0; e < 8; ++e)
#pragma unroll
                        for (int j = 0; j < 3; ++j) w[j][e] = bw[j * 512 + c8 + e];
                    float pw[3][8];
#pragma unroll
                    for (int e = 0; e < 8; ++e) { pw[0][e] = 0.f; pw[1][e] = 0.f; }
                    if (t0 >= 2) {
#pragma unroll
                        for (int j = 0; j < 2; ++j) { const bf16* pr = P + (size_t)(m0 - 2 + j) * PW; const u32x4 a = *(const u32x4*)(pr + P_BC + c8), b = *(const u32x4*)(pr + P_BX + c8);
                            pw[j][0] = bf2f(a.x & 0xffffu) * bf2f(b.x & 0xffffu); pw[j][1] = bf2f(a.x >> 16) * bf2f(b.x >> 16); pw[j][2] = bf2f(a.y & 0xffffu) * bf2f(b.y & 0xffffu); pw[j][3] = bf2f(a.y >> 16) * bf2f(b.y >> 16);
                            pw[j][4] = bf2f(a.z & 0xffffu) * bf2f(b.z & 0xffffu); pw[j][5] = bf2f(a.z >> 16) * bf2f(b.z >> 16); pw[j][6] = bf2f(a.w & 0xffffu) * bf2f(b.w & 0xffffu); pw[j][7] = bf2f(a.w >> 16) * bf2f(b.w >> 16); } }
#pragma unroll 4
                    for (int rr = 0; rr < RUN; ++rr) {
                        const bf16* pr = P + (size_t)(m0 + rr) * PW; const u32x4 a = *(const u32x4*)(pr + P_BC + c8), b = *(const u32x4*)(pr + P_BX + c8), g = *(const u32x4*)(pr + P_BB + c8);
                        pw[2][0] = bf2f(a.x & 0xffffu) * bf2f(b.x & 0xffffu); pw[2][1] = bf2f(a.x >> 16) * bf2f(b.x >> 16); pw[2][2] = bf2f(a.y & 0xffffu) * bf2f(b.y & 0xffffu); pw[2][3] = bf2f(a.y >> 16) * bf2f(b.y >> 16);
                        pw[2][4] = bf2f(a.z & 0xffffu) * bf2f(b.z & 0xffffu); pw[2][5] = bf2f(a.z >> 16) * bf2f(b.z >> 16); pw[2][6] = bf2f(a.w & 0xffffu) * bf2f(b.w & 0xffffu); pw[2][7] = bf2f(a.w >> 16) * bf2f(b.w >> 16);
                        float acc[8];
#pragma unroll
                        for (int e = 0; e < 8; ++e) acc[e] = w[0][e] * pw[0][e] + w[1][e] * pw[1][e] + w[2][e] * pw[2][e];
                        u32x4 o; o.x = pk2(acc[0] * bf2f(g.x & 0xffffu), acc[1] * bf2f(g.x >> 16)); o.y = pk2(acc[2] * bf2f(g.y & 0xffffu), acc[3] * bf2f(g.y >> 16));
                        o.z = pk2(acc[4] * bf2f(g.z & 0xffffu), acc[5] * bf2f(g.z >> 16)); o.w = pk2(acc[6] * bf2f(g.w & 0xffffu), acc[7] * bf2f(g.w >> 16));
                        *(u32x4*)(YCAT + (size_t)(m0 + rr) * YW + 512 + c8) = o;
#pragma unroll
                        for (int e = 0; e < 8; ++e) { pw[0][e] = pw[1][e]; pw[1][e] = pw[2][e]; }
                    }
                }
            }
            GRID_BAR();
        }

        REPS(PH_M1) if (IN(PH_M1)) {
            PHASE_BEGIN();
            constexpr int NUA = GB * 4 * NCH, NUC = GB * NCH;
            for (int u = blk; u < NUA + NUC; u += NBLK) {
                if (u < NUA) {
                    const int ua = u, bh = ua >> 5, c = ua & 31, bl = bh >> 2, h = bh & 3; const size_t m0 = (size_t)bl * SEQ + c * 64;
                    LAS bf16* VP = (LAS bf16*)lds; LAS bf16* WK = (LAS bf16*)(lds + 64 * 152 * 2);
                    const float bL = GBc[(m0 + 63) * 4 + h], mnew = MNEW[ua];
                    for (int i = tid; i < 1024; i += NTHR) { const int s = i >> 4, c8 = i & 15; *(LAS u32x4*)(VP + s * 152 + c8 * 8) = *(const u32x4*)(P + (m0 + s) * PW + P_AV + h * 128 + c8 * 8); }
                    if (tid < 64) { *(LAS u32x4*)(VP + tid * 152 + 128) = uone4(); *(LAS u32x4*)(VP + tid * 152 + 136) = uzero4(); }
                    { const int s = tid >> 3, c8 = tid & 7; const float w = __expf(bL + GGc[(m0 + s) * 4 + h] - mnew);
                      *(LAS u32x4*)(WK + s * 72 + c8 * 8) = scale8(*(const u32x4*)(P + (m0 + s) * PW + P_AK + h * 64 + c8 * 8), w); }
                    __syncthreads();
                    for (int ti = wave; ti < 36; ti += NWAVES) { const int mt = ti >> 2, nt = ti & 3; f32x4 acc = zero4();
#pragma unroll
                        for (int ks = 0; ks < 2; ++ks) acc = MFMA16(frag_ks(VP, 152, 16 * mt, 32 * ks, lane), frag_ks(WK, 72, 16 * nt, 32 * ks, lane), acc);
                        bf16* d = DC + (size_t)ua * 9216 + (16 * mt + 4 * (lane >> 4)) * 64 + 16 * nt + (lane & 15);
#pragma unroll
                        for (int i = 0; i < 4; ++i) d[i * 64] = (bf16)f2bf(acc[i]); }
                    __syncthreads();
                } else {
                    const int uc = u - NUA, bl = uc >> 5, c = uc & 31, hd = wave, gi = hd >> 2; const size_t m0 = (size_t)bl * SEQ + c * 64;
                    LAS bf16* XW = (LAS bf16*)(lds + hd * (64 * 72 * 2)); LAS bf16* BMs = (LAS bf16*)(lds + 8 * 64 * 72 * 2);
                    const float alast = ACB[(m0 + 63) * 8 + hd];
#pragma unroll
                    for (int k = 0; k < 8; ++k) { const int i = lane + 64 * k, s = i >> 3, c8 = i & 7; const float wd = __expf(alast - ACB[(m0 + s) * 8 + hd]) * DTB[(m0 + s) * 8 + hd];
                        *(LAS u32x4*)(XW + s * 72 + c8 * 8) = scale8(*(const u32x4*)(XBC + (m0 + s) * 1024 + hd * 64 + c8 * 8), wd); }
                    for (int i = tid; i < 2048; i += NTHR) { const int g2 = i >> 10, rem = i & 1023, s = rem >> 4, c8 = rem & 15;
                        *(LAS u32x4*)(BMs + g2 * (64 * 136) + s * 136 + c8 * 8) = *(const u32x4*)(XBC + (m0 + s) * 1024 + 512 + g2 * 128 + c8 * 8); }
                    __syncthreads();
                    const LAS bf16* BMg = BMs + gi * (64 * 136);
                    for (int pt = 0; pt < 4; ++pt) { f32x4 acc[8];
#pragma unroll
                        for (int n = 0; n < 8; ++n) acc[n] = zero4();
#pragma unroll
                        for (int ks = 0; ks < 2; ++ks) { const bf16x8 a = frag_ks(XW, 72, 16 * pt, 32 * ks, lane);
#pragma unroll
                            for (int n = 0; n < 8; ++n) acc[n] = MFMA16(a, frag_ks(BMg, 136, 16 * n, 32 * ks, lane), acc[n]); }
                        bf16* d = DH + ((size_t)(uc * 8 + hd) * 64 + 16 * pt + 4 * (lane >> 4)) * 128 + (lane & 15);
#pragma unroll
                        for (int n = 0; n < 8; ++n)
#pragma unroll
                            for (int i = 0; i < 4; ++i) d[i * 128 + 16 * n] = (bf16)f2bf(acc[n][i]); }
                    __syncthreads();
                }
            }
            GRID_BAR();
        }

        REPS(PH_M2) if (IN(PH_M2)) {
            PHASE_BEGIN();
            constexpr int NA = GB * 4 * 2304, NC = GB * 8 * 2048;
            for (int i = gt; i < NA + NC; i += NGT) {
                f32x4 st = zero4();
                if (i < NA) { const int bh = i / 2304, e = (i - bh * 2304) * 4;
                    for (int c = 0; c < NCH; ++c) { const size_t ua = (size_t)bh * NCH + c;
                        *(u32x2*)(CS + ua * 9216 + e) = (u32x2){pk2(st.x, st.y), pk2(st.z, st.w)};
                        { const u32x2 dw = *(const u32x2*)(DC + ua * 9216 + e); st = st * MSC[ua] + (f32x4){bf2f(dw.x & 0xffffu), bf2f(dw.x >> 16), bf2f(dw.y & 0xffffu), bf2f(dw.y >> 16)}; } }
                } else { const int j = i - NA, bhd = j >> 11, e = (j & 2047) * 4, bl = bhd >> 3, hd = bhd & 7;
                    for (int c = 0; c < NCH; ++c) { const size_t uh = (size_t)(bl * NCH + c) * 8 + hd;
                        *(u32x2*)(HS + uh * 8192 + e) = (u32x2){pk2(st.x, st.y), pk2(st.z, st.w)};
                        { const u32x2 dw = *(const u32x2*)(DH + uh * 8192 + e); st = st * __expf(ACB[((size_t)bl * SEQ + c * 64 + 63) * 8 + hd]) + (f32x4){bf2f(dw.x & 0xffffu), bf2f(dw.x >> 16), bf2f(dw.y & 0xffffu), bf2f(dw.y >> 16)}; } }
                }
            }
            GRID_BAR();
        }

        REPS(PH_M3) if (IN(PH_M3)) {
            PHASE_BEGIN();
            constexpr int NUA = GB * 4 * NCH, NUC = 2 * GB * NCH;
            for (int u = blk; u < NUA + NUC; u += NBLK) {
                const int r = lane & 15, g4 = lane >> 4;
                if (u < NUA) {
                    const int ua = u, bh = ua >> 5, c = ua & 31, bl = bh >> 2, h = bh & 3; const size_t m0 = (size_t)bl * SEQ + c * 64;
                    LAS bf16* Qs = (LAS bf16*)lds; LAS bf16* Ks = Qs + 64 * 72; LAS bf16* VP = Ks + 64 * 72; LAS bf16* CST = VP + 64 * 152; LAS bf16* SMT = CST + 144 * 72; LAS bf16* AOT = SMT + 64 * 72;
                    LAS float* GS = (LAS float*)(AOT + 64 * 136);
                    LAS float* SSQ = GS + 256;
                    const float mcar = MCAR[ua];
                    { const int s = tid >> 3, c8 = tid & 7; const bf16* pr = P + (m0 + s) * PW + h * 64 + c8 * 8;
                      *(LAS u32x4*)(Qs + s * 72 + c8 * 8) = *(const u32x4*)(pr + P_AQ); *(LAS u32x4*)(Ks + s * 72 + c8 * 8) = *(const u32x4*)(pr + P_AK); }
                    for (int i = tid; i < 1024; i += NTHR) { const int s = i >> 4, c8 = i & 15; const bf16* pr = P + (m0 + s) * PW + h * 128 + c8 * 8;
                        *(LAS u32x4*)(VP + s * 152 + c8 * 8) = *(const u32x4*)(pr + P_AV); *(LAS u32x4*)(AOT + s * 136 + c8 * 8) = *(const u32x4*)(pr + P_AO); }
                    if (tid < 64) { *(LAS u32x4*)(VP + tid * 152 + 128) = uone4(); *(LAS u32x4*)(VP + tid * 152 + 136) = uzero4(); }
                    for (int i = tid; i < 1152; i += NTHR) { const int dv = i >> 3, c8 = i & 7; *(LAS u32x4*)(CST + dv * 72 + c8 * 8) = *(const u32x4*)(CS + (size_t)ua * 9216 + dv * 64 + c8 * 8); }
                    if (tid < 192) { const int arr = tid >> 6, s = tid & 63; const float* src = (arr == 0) ? GBc : (arr == 1) ? GGc : GMT; GS[arr * 64 + s] = src[(m0 + s) * 4 + h]; }
                    __syncthreads();
#pragma unroll
                    for (int q2 = 0; q2 < 2; ++q2) { const int ti = 2 * wave + q2, tt = ti >> 2, st = ti & 3;
                        f32x4 acc = zero4();
                        if (st <= tt) {
#pragma unroll
                            for (int ks = 0; ks < 2; ++ks) acc = MFMA16(frag_kc(Qs, 72, 16 * tt, 32 * ks, lane), frag_kc(Ks, 72, 16 * st, 32 * ks, lane), acc);
                            const int s = 16 * st + r; const float gs = GS[64 + s];
#pragma unroll
                            for (int i = 0; i < 4; ++i) { const int t = 16 * tt + 4 * g4 + i; const float e = GS[t] - GS[128 + t] + gs;
                                acc[i] = (s <= t) ? acc[i] * 0.125f * __expf(e) : 0.f; }
                        }
                        *(LAS u32x2*)(SMT + (16 * st + r) * 72 + 16 * tt + 4 * g4) = (u32x2){pk2(acc[0], acc[1]), pk2(acc[2], acc[3])}; }
                    __syncthreads();
                    const int tt = wave & 3, half = wave >> 2;
                    f32x4 a1[5], a2[5];
#pragma unroll
                    for (int j = 0; j < 5; ++j) { a1[j] = zero4(); a2[j] = zero4(); }
#pragma unroll
                    for (int ks = 0; ks < 2; ++ks) { const bf16x8 fa1 = frag_ks(SMT, 72, 16 * tt, 32 * ks, lane), fa2 = frag_kc(Qs, 72, 16 * tt, 32 * ks, lane);
#pragma unroll
                        for (int j = 0; j < 5; ++j) { const int dvt = (j < 4) ? half * 4 + j : 8;
                            a1[j] = MFMA16(fa1, frag_ks(VP, 152, 16 * dvt, 32 * ks, lane), a1[j]);
                            a2[j] = MFMA16(fa2, frag_kc(CST, 72, 16 * dvt, 32 * ks, lane), a2[j]); } }
                    float hv[4][4], ssq[4];
#pragma unroll
                    for (int i = 0; i < 4; ++i) { const int t = 16 * tt + 4 * g4 + i; const float b = GS[t], mt = GS[128 + t];
                        const float is = 0.125f * __expf(b + mcar - mt);
                        float den = a1[4][i] + is * a2[4][i]; den = __shfl(den, lane & 48);
                        const float dn = __builtin_amdgcn_rcpf(fmaxf(fabsf(den), __expf(-mt))); float q = 0.f;
#pragma unroll
                        for (int j = 0; j < 4; ++j) { const float v = (a1[j][i] + is * a2[j][i]) * dn; hv[j][i] = v; q += v * v; }
                        q += __shfl_xor(q, 1); q += __shfl_xor(q, 2); q += __shfl_xor(q, 4); q += __shfl_xor(q, 8); ssq[i] = q; }
                    if (r == 0) {
#pragma unroll
                        for (int i = 0; i < 4; ++i) SSQ[half * 64 + 16 * tt + 4 * g4 + i] = ssq[i]; }
                    __syncthreads();
                    const float* ng = ka->in[I_ANG] + (size_t)l * 512 + h * 128;
#pragma unroll
                    for (int i = 0; i < 4; ++i) { const int t = 16 * tt + 4 * g4 + i; const float rstd = rsqrtf((SSQ[t] + SSQ[64 + t]) * (1.f / 128.f) + EPS);
#pragma unroll
                        for (int j = 0; j < 4; ++j) { const int dv = 16 * (half * 4 + j) + r; LAS bf16* op = AOT + t * 136 + dv;
                            *op = (bf16)f2bf(sigmoidf_(bf2f(*op)) * hv[j][i] * rstd * ng[dv]); } }
                    __syncthreads();
                    for (int i = tid; i < 1024; i += NTHR) { const int s = i >> 4, c8 = i & 15; *(u32x4*)(YCAT + (m0 + s) * YW + h * 128 + c8 * 8) = *(const LAS u32x4*)(AOT + s * 136 + c8 * 8); }
                    __syncthreads();
                } else {
                    const int uc2 = u - NUA, bl = uc2 >> 6, c = (uc2 >> 1) & 31, gi = uc2 & 1, hl = wave & 3, th = wave >> 2, hd = gi * 4 + hl; const size_t m0 = (size_t)bl * SEQ + c * 64;
                    LAS bf16* XHs = (LAS bf16*)lds;
                    LAS bf16* HTs = (LAS bf16*)(lds + 36864);
                    LAS bf16* BMg = (LAS bf16*)(lds + 36864 + 69632);
                    LAS bf16* MTt = (LAS bf16*)(lds + 36864 + 69632 + 17408 + wave * 3072);
                    LAS float* ADs = (LAS float*)(lds + 36864 + 69632 + 17408 + 24576);
                    const bf16* Xb = XBC + m0 * 1024;
                    for (int i = tid; i < 2048; i += NTHR) { const int h4 = i >> 9, rem = i & 511, s = rem >> 3, c8 = rem & 7;
                        *(LAS u32x4*)(XHs + h4 * (64 * 72) + s * 72 + c8 * 8) = *(const u32x4*)((Xb + gi * 256) + (unsigned)(s * 1024 + h4 * 64 + c8 * 8)); }
                    { const bf16* Hb = HS + (size_t)((bl * NCH + c) * 8 + gi * 4) * 8192;
                      for (int i = tid; i < 4096; i += NTHR) { const int h4 = i >> 10, rem = i & 1023, p = rem >> 4, c8 = rem & 15;
                        *(LAS u32x4*)(HTs + h4 * (64 * 136) + p * 136 + c8 * 8) = *(const u32x4*)(Hb + (unsigned)(h4 * 8192 + p * 128 + c8 * 8)); } }
                    for (int i = tid; i < 1024; i += NTHR) { const int s = i >> 4, c8 = i & 15; *(LAS u32x4*)(BMg + s * 136 + c8 * 8) = *(const u32x4*)((Xb + 512 + gi * 128) + (unsigned)(s * 1024 + c8 * 8)); }
                    { const int h4 = tid >> 7, arr = (tid >> 6) & 1, s = tid & 63; const float* src = arr ? DTB : ACB; ADs[tid] = (src + m0 * 8 + gi * 4)[(unsigned)(s * 8 + h4)]; }
                    const LAS bf16* XH = XHs + hl * (64 * 72); const LAS bf16* HT = HTs + hl * (64 * 136); const LAS float* AD = ADs + hl * 128;
                    const bf16* Cm = Xb + 768 + gi * 128; const bf16* Zp = P + m0 * PW + P_CZ + hd * 64; const unsigned zlane = (unsigned)(4 * g4 * PW + r), ylane = (unsigned)(4 * g4 * YW + r);
                    bf16* Yp = YCAT + m0 * YW + 1024 + hd * 64; float* Sp = SSQC + m0 * 8 + hd;
                    bf16x8 fcn[4];
#pragma unroll
                    for (int ks = 0; ks < 4; ++ks) fcn[ks] = gfrag_kc(Cm, 1024, 16 * th, 32 * ks, lane);
                    const float dsk = ka->in[I_CDSKIP][l * 8 + hd];
                    __syncthreads();
#pragma unroll 1
                    for (int k2 = 0; k2 < 2; ++k2) { const int tt = k2 ? 3 - th : th;
                        bf16x8 fcm[4]; unsigned short zc[4][4];
#pragma unroll
                        for (int ks = 0; ks < 4; ++ks) fcm[ks] = fcn[ks];
#pragma unroll
                        for (int p = 0; p < 4; ++p)
#pragma unroll
                            for (int i = 0; i < 4; ++i) zc[p][i] = (Zp + (size_t)(16 * tt + i) * PW + 16 * p)[zlane];
#pragma unroll
                        for (int ks = 0; ks < 4; ++ks) fcn[ks] = gfrag_kc(Cm, 1024, 16 * (3 - th), 32 * ks, lane);
                        float at[4];
#pragma unroll
                        for (int i = 0; i < 4; ++i) at[i] = AD[16 * tt + 4 * g4 + i];
#pragma unroll 1
                        for (int st = 0; st <= tt; ++st) { f32x4 acc = zero4();
#pragma unroll
                            for (int ks = 0; ks < 4; ++ks) acc = MFMA16(fcm[ks], frag_kc(BMg, 136, 16 * st, 32 * ks, lane), acc);
                            const int s = 16 * st + r; const float as = AD[s], dts = AD[64 + s];
#pragma unroll
                            for (int i = 0; i < 4; ++i) { const int t = 16 * tt + 4 * g4 + i; acc[i] = (s <= t) ? acc[i] * __expf(at[i] - as) * dts : 0.f; if (s == t) acc[i] += dsk; }
                            *(LAS u32x2*)(MTt + (16 * st + r) * 24 + 4 * g4) = (u32x2){pk2(acc[0], acc[1]), pk2(acc[2], acc[3])}; }
                        if ((tt & 1) == 0) *(LAS u32x2*)(MTt + (16 * (tt + 1) + r) * 24 + 4 * g4) = (u32x2){uzero4().x, uzero4().y};
                        LDS_WAIT(); asm volatile("" ::: "memory");
                        f32x4 ad[4], ao[4];
#pragma unroll
                        for (int p = 0; p < 4; ++p) { ad[p] = zero4(); ao[p] = zero4(); }
#pragma unroll 1
                        for (int ks = 0; ks <= (tt >> 1); ++ks) { const bf16x8 fa = frag_ks(MTt, 24, 0, 32 * ks, lane);
#pragma unroll
                            for (int p = 0; p < 4; ++p) ad[p] = MFMA16(fa, frag_ks(XH, 72, 16 * p, 32 * ks, lane), ad[p]); }
#pragma unroll
                        for (int ks = 0; ks < 4; ++ks)
#pragma unroll
                            for (int p = 0; p < 4; ++p) ao[p] = MFMA16(fcm[ks], frag_kc(HT, 136, 16 * p, 32 * ks, lane), ao[p]);
#pragma unroll
                        for (int i = 0; i < 4; ++i) { const float ea = __expf(at[i]); float q = 0.f;
#pragma unroll
                            for (int p = 0; p < 4; ++p) { const float y = (ad[p][i] + ea * ao[p][i]) * siluf_(bf2f(zc[p][i])); q += y * y;
                                (Yp + (size_t)(16 * tt + i) * YW + 16 * p)[ylane] = (bf16)f2bf(y); }
                            q += __shfl_xor(q, 1); q += __shfl_xor(q, 2); q += __shfl_xor(q, 4); q += __shfl_xor(q, 8);
                            if (r == 0) (Sp + (16 * tt + i) * 8)[(unsigned)(32 * g4)] = q; }
                        LDS_WAIT(); asm volatile("" ::: "memory");
                    }
                    __syncthreads();
                }
            }
            GRID_BAR();
        }

        REPS(PH_ATT) if (IN(PH_ATT)) {
            PHASE_BEGIN();
            LAS bf16* Qs = (LAS bf16*)lds; LAS bf16* Ks = Qs + 128 * 136; LAS bf16* Vs = Ks + 64 * 136; LAS bf16* Aw = Vs + 64 * 136 + wave * (16 * 72);
            const int r = lane & 15, g4 = lane >> 4;
            for (int u = blk; u < GB * 4 * 16; u += NBLK) {
                const int bl = u >> 6, h = (u >> 4) & 3, qt = u & 15; const size_t mb = (size_t)bl * SEQ; const int q0 = qt * 128;
                volatile LAS unsigned* FLG = (volatile LAS unsigned*)(lds + MISC_OFF + 128);
                int par = 0;
                __syncthreads();
                if (lane == 0) { FLG[wave] = 0u; FLG[8 + wave] = 0u; }
                for (int i = tid; i < 2048; i += NTHR) { const int s = i >> 4, c8 = i & 15; *(LAS u32x4*)(Qs + s * 136 + c8 * 8) = *(const u32x4*)(P + (mb + q0 + s) * PW + P_SQ + h * 128 + c8 * 8); }
                f32x4 O[8];
#pragma unroll
                for (int d = 0; d < 8; ++d) O[d] = zero4();
                float racc = 0.f; const int tq = q0 + 16 * wave + r;
                for (int kt = 2 * qt + 1; kt >= 0; --kt) {
                    const int s0 = kt * 64;
                    __syncthreads();
                    { unsigned alldone = 1u;
#pragma unroll
                      for (int w8 = 0; w8 < 8; ++w8) alldone &= FLG[par * 8 + w8];
                      if (__builtin_amdgcn_readfirstlane((int)alldone)) break; }
                    for (int i = tid; i < 1024; i += NTHR) { const int s = i >> 4, c8 = i & 15; const bf16* pr = P + (mb + s0 + s) * PW + h * 128 + c8 * 8;
                        *(LAS u32x4*)(Ks + s * 136 + c8 * 8) = *(const u32x4*)(pr + P_SK); *(LAS u32x4*)(Vs + s * 136 + c8 * 8) = *(const u32x4*)(pr + P_SV); }
                    __syncthreads();
                    if (s0 < q0 + 16 * wave + 15) {
                        f32x4 z[4];
#pragma unroll
                        for (int j = 0; j < 4; ++j) z[j] = zero4();
#pragma unroll
                        for (int ks = 0; ks < 4; ++ks) { const bf16x8 fq = frag_kc(Qs, 136, 16 * wave, 32 * ks, lane);
#pragma unroll
                            for (int j = 0; j < 4; ++j) z[j] = MFMA16(frag_kc(Ks, 136, 16 * j, 32 * ks, lane), fq, z[j]); }
                        float ls[4][4], x[4][4], tsum[4];
#pragma unroll
                        for (int j = 0; j < 4; ++j) { float tj = 0.f;
#pragma unroll
                            for (int i = 0; i < 4; ++i) { const int s = s0 + 16 * j + 4 * g4 + i; const float zz = z[j][i] * 0.08838834764831845f;
                                const float l1 = fminf(zz, 0.f) - __logf(1.f + __expf(-fabsf(zz)));
                                ls[j][i] = l1; x[j][i] = (s < tq) ? (l1 - zz) : 0.f; tj += x[j][i]; }
                            tsum[j] = tj; }
                        float above[4], tot[4];
#pragma unroll
                        for (int j = 0; j < 4; ++j) { const float y1 = __shfl_xor(tsum[j], 16), y2 = __shfl_xor(tsum[j], 32), y3 = __shfl_xor(tsum[j], 48);
                            tot[j] = tsum[j] + y1 + y2 + y3;
                            above[j] = (g4 == 0) ? (y1 + y2 + y3) : (g4 == 1) ? (y2 + y3) : (g4 == 2) ? y1 : 0.f; }
                        float hi = racc;
#pragma unroll
                        for (int j = 3; j >= 0; --j) { float run = hi + above[j]; float av[4];
#pragma unroll
                            for (int i = 3; i >= 0; --i) { const int s = s0 + 16 * j + 4 * g4 + i; av[i] = (s < tq) ? __expf(ls[j][i] + run) : 0.f; run += x[j][i]; }
                            *(LAS u32x2*)(Aw + r * 72 + 16 * j + 4 * g4) = (u32x2){pk2(av[0], av[1]), pk2(av[2], av[3])};
                            hi += tot[j]; }
                        racc = hi;
                        LDS_WAIT(); asm volatile("" ::: "memory");
#pragma unroll
                        for (int ks = 0; ks < 2; ++ks) { const bf16x8 fa = frag_kc(Aw, 72, 0, 32 * ks, lane);
#pragma unroll
                            for (int d = 0; d < 8; ++d) O[d] = MFMA16(fa, frag_ks(Vs, 136, 16 * d, 32 * ks, lane), O[d]); }
                    }
                    par ^= 1;
                    { const bool wd = __all(racc < -104.f); if (lane == 0) FLG[par * 8 + wave] = wd ? 1u : 0u; }
                }
#pragma unroll
                for (int d = 0; d < 8; ++d)
#pragma unroll
                    for (int i = 0; i < 4; ++i) YCAT[(mb + q0 + 16 * wave + 4 * g4 + i) * YW + 1536 + h * 128 + 16 * d + r] = (bf16)f2bf(O[d][i]);
            }
            GRID_BAR();
        }

        REPS(PH_LIFT) if (IN(PH_LIFT)) {
            PHASE_BEGIN();
            pg8::Gemm g{YCAT, WliftT, 512, YW, 512, (size_t)512 * 2, (size_t)DM * 512 * 2}; pg8::Order S; S.init(T, DM, NBLK, blk, 4);
            pg8::EpiLift E{P + P_G, PW, MB, DM, SSQC};
            pg8::gemm_phase<pg8::EpiLift, GEMM_ALIGN>(lds, g, S, E);
            GRID_BAR();
        }
        REPS(PH_OUT) if (IN(PH_OUT)) {
            PHASE_BEGIN();
            pg8::Gemm g{MB, WoutT, DM, DM, DM, 0, 0}; pg8::Order S; S.init(T, DM, NBLK, blk, 1);
            pg8::EpiResid E{XG + grow0 * DM, DM, SSQ2};
            pg8::gemm_phase<pg8::EpiResid, GEMM_ALIGN>(lds, g, S, E);
            GRID_BAR();
        }
        REPS(PH_UP) if (IN(PH_UP)) {
            PHASE_BEGIN();
            pg8::Gemm g{XG + grow0 * DM, WupT, DM, DM, DM, 0, 0}; pg8::Order S; S.init(T, DFF2, NBLK, blk, 1);
            pg8::EpiConvAct E{ACT, SSQ2, ka->in[I_FCW] + (size_t)l * 3 * DFF2, ka->in[I_FCB] + (size_t)l * DFF2, RAWH, lds + 131072, DFF2 / 256};
            pg8::gemm_phase<pg8::EpiConvAct, GEMM_ALIGN>(lds, g, S, E);
            GRID_BAR();
        }
        REPS(PH_DOWN) if (IN(PH_DOWN)) {
            PHASE_BEGIN();
            pg8::Gemm g{ACT, WdownT, DFF, DFF, DFF, 0, 0}; pg8::Order S; S.init(T, DM, NBLK, blk, 1);
            {
                const float* fw = ka->in[I_FCW] + (size_t)l * 3 * DFF2; const float* fb = ka->in[I_FCB] + (size_t)l * DFF2;
                pg8::Unit uu;
                for (int i = 0; S.next(i, uu); ++i) { const int pm = uu.pm; if ((pm & 7) == 0) continue;
                    for (int ch = tid; ch < DFF; ch += NTHR) { const int tp = ch >> 7, j = ch & 127;
                        const float* own = RAWH + (size_t)(pm * 22 + tp) * 1024; const float* prv = RAWH + (size_t)((pm - 1) * 22 + tp) * 1024;
                        const float g254 = prv[2 * 256 + j], g255 = prv[3 * 256 + j], g0 = own[j], g1 = own[256 + j];
                        const float u254 = prv[2 * 256 + 128 + j], u255 = prv[3 * 256 + 128 + j], u0 = own[128 + j], u1 = own[256 + 128 + j];
                        const float wg0 = fw[ch], wg1 = fw[DFF2 + ch], wg2 = fw[2 * DFF2 + ch], wu0 = fw[DFF + ch], wu1 = fw[DFF2 + DFF + ch], wu2 = fw[2 * DFF2 + DFF + ch], bg = fb[ch], bu = fb[DFF + ch];
                        ACT[(size_t)(pm * 256) * DFF + ch] = (bf16)f2bf(siluf_(bg + wg0 * g254 + wg1 * g255 + wg2 * g0) * (bu + wu0 * u254 + wu1 * u255 + wu2 * u0));
                        ACT[(size_t)(pm * 256 + 1) * DFF + ch] = (bf16)f2bf(siluf_(bg + wg0 * g255 + wg1 * g0 + wg2 * g1) * (bu + wu0 * u255 + wu1 * u0 + wu2 * u1)); } }
                asm volatile("s_waitcnt vmcnt(0)" ::: "memory"); __syncthreads();
            }
            pg8::EpiResid E{XG + grow0 * DM, DM, SSQ1 + grow0 * 16};
            pg8::gemm_phase<pg8::EpiResid, GEMM_ALIGN>(lds, g, S, E);
            GRID_BAR();
        }
        REPS(PH_FINAL) if (IN(PH_FINAL) && l == DEPTH - 1) {
            PHASE_BEGIN();
            const float* gain = ka->in[I_FING];
            f32x4 gv[4];
#pragma unroll
            for (int j = 0; j < 4; ++j) gv[j] = ((const f32x4*)gain)[lane + 64 * j];
            for (int m = gw; m < T; m += NGW) {
                const u32x2* xr = (const u32x2*)(XG + (grow0 + m) * DM) + lane;
                f32x4 v[4]; float sq = 0.f;
#pragma unroll
                for (int j = 0; j < 4; ++j) { const u32x2 w = xr[64 * j]; v[j] = (f32x4){bf2f(w.x & 0xffffu), bf2f(w.x >> 16), bf2f(w.y & 0xffffu), bf2f(w.y >> 16)};
                    sq += (v[j].x * v[j].x + v[j].y * v[j].y) + (v[j].z * v[j].z + v[j].w * v[j].w); }
                const float rstd = rsqrtf(wave_sum(sq) * (1.f / DM) + EPS);
                f32x4* orow = (f32x4*)(ka->out + (grow0 + m) * DM) + lane;
#pragma unroll
                for (int j = 0; j < 4; ++j) orow[64 * j] = v[j] * rstd * gv[j];
            }
            GRID_BAR();
        }
    }
#undef IN
#undef GRID_BAR
#undef PHASE_BEGIN
}

#ifndef ONE_LAUNCH
#define ONE_LAUNCH 1
#endif
extern "C" void kernel_launch(void* const* d_in, const int* in_sizes, int n_in, void* d_out, int out_size, void* d_ws, size_t ws_size, hipStream_t stream) {
    static int grid = 0;
    if (grid == 0) {
        if (n_in != N_IN || in_sizes[0] != BATCH * SEQ * DM || out_size != BATCH * SEQ * DM || ws_size < WS_END) {
            fprintf(stderr, "kernel_launch: unexpected shapes / workspace (n_in %d, ws %zu, need %zu); nothing launched\n", n_in, ws_size, (size_t)WS_END); grid = -1; return; }
        int dev = 0, cus = 0, per_cu = 0;
        if (hipGetDevice(&dev) != hipSuccess || hipDeviceGetAttribute(&cus, hipDeviceAttributeMultiprocessorCount, dev) != hipSuccess) { grid = -1; return; }
        if (hipFuncSetAttribute((const void*)fwd, hipFuncAttributeMaxDynamicSharedMemorySize, LDS_BYTES) != hipSuccess) { fprintf(stderr, "kernel_launch: hipFuncSetAttribute failed\n"); grid = -1; return; }
        if (hipOccupancyMaxActiveBlocksPerMultiprocessor(&per_cu, (const void*)fwd, NTHR, LDS_BYTES) != hipSuccess || per_cu < 1) { fprintf(stderr, "kernel_launch: occupancy query says %d\n", per_cu); (void)hipGetLastError(); }
        grid = cus;
    }
    if (grid < 0) return;
    (void)hipMemsetAsync((char*)d_ws + WS_CTL, 0, CTL_BYTES, stream);
    Args a{};
    for (int i = 0; i < N_IN; ++i) a.in[i] = (const float*)d_in[i];
    a.out = (float*)d_out; a.ws = (unsigned char*)d_ws; a.pad = 0;
#if ONE_LAUNCH
    a.l_lo = 0; a.l_hi = DEPTH; a.g_lo = 0; a.g_hi = NG; a.ph_lo = 0; a.ph_hi = PH_COUNT; a.use_bar = 1;
    hipLaunchKernelGGL(fwd, dim3(grid), dim3(NTHR), LDS_BYTES, stream, a);
#else
    a.use_bar = 0;
    for (int l = 0; l < DEPTH; ++l)
        for (int g = 0; g < NG; ++g)
            for (int ph = 0; ph < PH_COUNT; ++ph) {
                if (ph == PH_W && g != 0) continue;
                if (ph == PH_FINAL && l != DEPTH - 1) continue;
                a.l_lo = l; a.l_hi = l + 1; a.g_lo = g; a.g_hi = g + 1; a.ph_lo = ph; a.ph_hi = ph + 1;
                hipLaunchKernelGGL(fwd, dim3(grid), dim3(NTHR), LDS_BYTES, stream, a);
            }
#endif
}
```

```cpp
#include <hip/hip_runtime.h>
#include <cstdio>
#include <cstdint>

#define LAS __attribute__((address_space(3)))
#define GAS __attribute__((address_space(1)))
typedef unsigned short bf16;
typedef short bf16x8 __attribute__((ext_vector_type(8)));
typedef short s16x4 __attribute__((ext_vector_type(4)));
typedef float f32x4 __attribute__((ext_vector_type(4)));
typedef float f32x2 __attribute__((ext_vector_type(2)));
typedef unsigned u32x4 __attribute__((ext_vector_type(4)));
typedef unsigned u32x2 __attribute__((ext_vector_type(2)));

constexpr int DM = 1024, BATCH = 32, SEQ = 2048, DEPTH = 4;
constexpr int PIN = 10256, PW = 10240, DFF = 2816, DFF2 = 5632;
constexpr int GB = 8;
constexpr int NG = BATCH / GB;
constexpr int T = GB * SEQ;
constexpr int NCH = SEQ / 64;
constexpr float EPS = 1e-6f;
constexpr int P_AQ = 0, P_AK = 256, P_AV = 512, P_AO = 1024, P_BB = 1536, P_BC = 2048, P_BX = 2560, P_CZ = 3072, P_CX = 3584, P_SQ = 4608, P_SK = 5120, P_SV = 5632, P_G = 6144;
constexpr int YW = 2048;

constexpr size_t MiB = 1u << 20;
constexpr size_t WS_CTL = 0, CTL_BYTES = 1 * MiB;
constexpr size_t WS_WIN = 1 * MiB;
constexpr size_t WS_WLIFT = WS_WIN + (size_t)PW * DM * 2;
constexpr size_t WS_WOUT = WS_WLIFT + (size_t)4 * DM * 512 * 2;
constexpr size_t WS_WUP = WS_WOUT + (size_t)DM * DM * 2;
constexpr size_t WS_WDOWN = WS_WUP + (size_t)DFF2 * DM * 2;
constexpr size_t WS_W16 = WS_WDOWN + (size_t)DM * DFF * 2;
constexpr size_t WS_XN = WS_W16 + 65536;
constexpr size_t WS_P = WS_XN + (size_t)T * DM * 2;
constexpr size_t WS_U = WS_P, WS_ACT = WS_P;
constexpr size_t WS_YCAT = WS_P + (size_t)T * PW * 2;
constexpr size_t WS_XG = WS_YCAT + (size_t)T * YW * 2;
constexpr size_t WS_MB = WS_XG + (size_t)BATCH * SEQ * DM * 2;
constexpr size_t WS_SP = WS_MB + (size_t)2 * T * DM * 2;
constexpr size_t WS_GB = WS_SP + (size_t)T * 16 * 4;
constexpr size_t WS_GG = WS_GB + (size_t)T * 16;
constexpr size_t WS_GMT = WS_GG + (size_t)T * 16;
constexpr size_t WS_MCAR = WS_GMT + (size_t)T * 16;
constexpr size_t WS_MNEW = WS_MCAR + 4096;
constexpr size_t WS_MSC = WS_MNEW + 4096;
constexpr size_t WS_SUMB = WS_MSC + 4096, WS_SUMG = WS_SUMB + 4096;
constexpr size_t WS_DT = WS_SUMG + 4096;
constexpr size_t WS_AC = WS_DT + (size_t)T * 32;
constexpr size_t WS_XBC = WS_AC + (size_t)T * 32;
constexpr size_t WS_DC = WS_XBC + (size_t)T * DM * 2;
constexpr size_t WS_CS = WS_DC + (size_t)GB * 4 * NCH * 9216 * 4;
constexpr size_t WS_DH = WS_CS + (size_t)GB * 4 * NCH * 9216 * 2;
constexpr size_t WS_HS = WS_DH + (size_t)GB * NCH * 8 * 8192 * 4;
constexpr size_t WS_SSQ1 = WS_HS + (size_t)GB * NCH * 8 * 8192 * 2;
constexpr size_t WS_SSQ2 = WS_SSQ1 + (size_t)BATCH * SEQ * 64;
constexpr size_t WS_SSQC = WS_SSQ2 + (size_t)2 * T * 64;
constexpr size_t WS_RAWH = WS_SSQC + (size_t)T * 32;
constexpr size_t WS_END = WS_RAWH + (size_t)(2 * T / 256) * 22 * 4 * 256 * 4;

constexpr int NWAVES = 8, NTHR = 512;
constexpr int LDS_BYTES = 155648;
constexpr int MISC_OFF = 153600;

__device__ __forceinline__ float bf2f(unsigned b) { return __uint_as_float(b << 16); }
__device__ __forceinline__ unsigned f2bf(float f) { unsigned u = __float_as_uint(f); return (u + 0x7fffu + ((u >> 16) & 1u)) >> 16; }
__device__ __forceinline__ unsigned pk2(float lo, float hi) { return f2bf(lo) | (f2bf(hi) << 16); }
__device__ __forceinline__ float sigmoidf_(float x) { return __builtin_amdgcn_rcpf(1.f + __builtin_amdgcn_exp2f(-1.4426950408889634f * x)); }
__device__ __forceinline__ float siluf_(float x) { return x * __builtin_amdgcn_rcpf(1.f + __builtin_amdgcn_exp2f(-1.4426950408889634f * x)); }
__device__ __forceinline__ float logsigf_(float x) { return fminf(x, 0.f) - log1pf(expf(-fabsf(x))); }
__device__ __forceinline__ float softplusf_(float x) { return fmaxf(x, 0.f) + log1pf(expf(-fabsf(x))); }
__device__ __forceinline__ float wave_sum(float v) {
#pragma unroll
    for (int o = 1; o < 64; o <<= 1) v += __shfl_xor(v, o);
    return v;
}
#define LDS_WAIT() asm volatile("s_waitcnt lgkmcnt(0)" ::: "memory")
__device__ __forceinline__ float row_rstd(const float* ssq16) {
    const f32x4* p = (const f32x4*)ssq16; const f32x4 a = (p[0] + p[1]) + (p[2] + p[3]);
    return rsqrtf(((a.x + a.y) + (a.z + a.w)) * (1.f / 1024.f) + 1e-6f);
}

namespace pg8 {
constexpr int BM = 256, BK = 64, HALF = 128, HTB = HALF * BK * 2, STAGE_BYTES = 8 * HTB, NXCD = 8, WGM = 8;
__host__ __device__ __forceinline__ int lds_byte(int r, int c) { const int st = (r >> 4) * 2 + (c >> 5), rr = r & 15, cc = c & 31, ob = rr * 64 + cc * 2; return st * 1024 + (ob ^ (((ob >> 9) & 1) << 5)); }
__host__ __device__ __forceinline__ void stage_rc(int b, int& R, int& C) { const int st = b / 1024, sb = b % 1024, swz = sb ^ (((sb >> 9) & 1) << 5); R = (st >> 1) * 16 + swz / 64; C = (st & 1) * 32 + (swz % 64) / 2; }
__host__ __device__ __forceinline__ int perm32(int rho) { const int n = rho >> 4, i = rho & 15; return 8 * (i >> 2) + 4 * n + (i & 3); }

struct Unit { int pm, pn, z; };
struct Gemm { const bf16* A; const bf16* Bt; int K, lda, ldb; size_t zA, zB; };

struct Order {
    int nM, nN, nwg, G, c, Z;
    __device__ __forceinline__ void init(int M, int N, int G_, int c_, int Z_) { nM = M / BM; nN = N / BM; nwg = nM * nN; G = G_; c = c_; Z = Z_; }
    __device__ __forceinline__ bool next(int i, Unit& u) const {
        const int ti = i / Z; u.z = i - ti * Z;
        const long L = (long)ti * G + c; if (L >= nwg) return false;
        int wgid = (int)L; { const int q = nwg / NXCD, r = nwg % NXCD, xcd = wgid % NXCD, off = wgid / NXCD; wgid = (xcd < r ? xcd * (q + 1) : r * (q + 1) + (xcd - r) * q) + off; }
        const int nig = WGM * nN, gid = wgid / nig, fm = gid * WGM, gsz = (nM - fm) < WGM ? (nM - fm) : WGM;
        u.pm = fm + ((wgid % nig) % gsz); u.pn = (wgid % nig) / gsz; return true;
    }
};
__device__ __forceinline__ unsigned cvt_pk_bf16(float lo, float hi) { unsigned r; asm volatile("s_nop 0\n\tv_cvt_pk_bf16_f32 %0, %1, %2" : "=v"(r) : "v"(lo), "v"(hi)); return r; }

struct EpiBf16 {
    static constexpr bool PERM = true, KEEP = false, CONTIG = true;
    bf16* O; int ldc; const float* ssq; int gate_pn0;
    static __device__ __forceinline__ float s1(float x) { return 1.f + __builtin_amdgcn_exp2f(-1.4426950408889634f * __builtin_amdgcn_fmed3f(x, -30.f, 30.f)); }
    __device__ __forceinline__ void operator()(f32x4 (&acc)[2][2][4][2], const Unit& u, int wr, int wc, int fr, int fq) const {
        if (u.pn >= gate_pn0) {
            const int row0g = u.pm * BM + wr * 64 + fr, d0 = 64 * (u.pn - gate_pn0) + 16 * wc + 4 * fq;
#pragma unroll
            for (int ai = 0; ai < 2; ++ai)
#pragma unroll
                for (int m = 0; m < 4; ++m) { const int row = row0g + ai * HALF + m * 16; bf16* rowp = O + (size_t)row * ldc + gate_pn0 * BM + d0;
                    float sq; { const f32x4 p = *(const f32x4*)(ssq + (size_t)row * 16 + 4 * fq); sq = (p.x + p.y) + (p.z + p.w); }
                    sq += __shfl_xor(sq, 16); sq += __shfl_xor(sq, 32);
                    const float rs = rsqrtf(sq * (1.f / 1024.f) + 1e-6f);
                    float one = 1.f; asm volatile("" : "+v"(one));
                    float f0[4], f1[4], f2[4], f3[4];
#pragma unroll
                    for (int e = 0; e < 4; ++e) { const float a0 = s1(acc[ai][0][m][0][e] * rs), a1 = s1(acc[ai][0][m][1][e] * rs), a2 = s1(acc[ai][1][m][0][e] * rs), a3 = s1(acc[ai][1][m][1][e] * rs);
                        f0[e] = a1 * __builtin_amdgcn_rcpf(a0); f1[e] = a2 * __builtin_amdgcn_rcpf(a1); f2[e] = a3 * __builtin_amdgcn_rcpf(a2); f3[e] = one * __builtin_amdgcn_rcpf(a3); }
                    *(u32x2*)(rowp) = (u32x2){cvt_pk_bf16(f0[0], f0[1]), cvt_pk_bf16(f0[2], f0[3])};
                    *(u32x2*)(rowp + 1024) = (u32x2){cvt_pk_bf16(f1[0], f1[1]), cvt_pk_bf16(f1[2], f1[3])};
                    *(u32x2*)(rowp + 2048) = (u32x2){cvt_pk_bf16(f2[0], f2[1]), cvt_pk_bf16(f2[2], f2[3])};
                    *(u32x2*)(rowp + 3072) = (u32x2){cvt_pk_bf16(f3[0], f3[1]), cvt_pk_bf16(f3[2], f3[3])}; }
            return; }
        const int row0 = u.pm * BM + wr * 64 + fr, col0 = u.pn * BM + wc * 64 + 8 * fq;
#pragma unroll
        for (int ai = 0; ai < 2; ++ai)
#pragma unroll
            for (int m = 0; m < 4; ++m) { const int row = row0 + ai * HALF + m * 16; bf16* rowp = O + (size_t)row * ldc + col0;
                float sq; { const f32x4 p = *(const f32x4*)(ssq + (size_t)row * 16 + 4 * fq); sq = (p.x + p.y) + (p.z + p.w); }
                sq += __shfl_xor(sq, 16); sq += __shfl_xor(sq, 32);
                const float rs = rsqrtf(sq * (1.f / 1024.f) + 1e-6f);
#pragma unroll
                for (int bj = 0; bj < 2; ++bj) { const f32x4 v0 = acc[ai][bj][m][0] * rs, v1 = acc[ai][bj][m][1] * rs;
                    u32x4 w; w.x = cvt_pk_bf16(v0[0], v0[1]); w.y = cvt_pk_bf16(v0[2], v0[3]); w.z = cvt_pk_bf16(v1[0], v1[1]); w.w = cvt_pk_bf16(v1[2], v1[3]);
                    *(u32x4*)(rowp + bj * 32) = w; } }
    }
};
struct EpiResid {
    static constexpr bool PERM = true, KEEP = false, CONTIG = true;
    bf16* xb; int ldc; float* ssq;
    __device__ __forceinline__ void operator()(f32x4 (&acc)[2][2][4][2], const Unit& u, int wr, int wc, int fr, int fq) const {
        const int row0 = u.pm * BM + wr * 64 + fr, col0 = u.pn * BM + wc * 64 + 8 * fq;
#pragma unroll
        for (int ai = 0; ai < 2; ++ai)
#pragma unroll
            for (int m = 0; m < 4; ++m) { const int row = row0 + ai * HALF + m * 16; const size_t off = (size_t)row * ldc + col0; float q = 0.f;
#pragma unroll
                for (int bj = 0; bj < 2; ++bj) {
                    const u32x4 o = *(const u32x4*)(xb + off + bj * 32);
                    const f32x4 x0 = (f32x4){bf2f(o.x & 0xffffu), bf2f(o.x >> 16), bf2f(o.y & 0xffffu), bf2f(o.y >> 16)} + acc[ai][bj][m][0];
                    const f32x4 x1 = (f32x4){bf2f(o.z & 0xffffu), bf2f(o.z >> 16), bf2f(o.w & 0xffffu), bf2f(o.w >> 16)} + acc[ai][bj][m][1];
                    q += (x0[0] * x0[0] + x0[1] * x0[1]) + (x0[2] * x0[2] + x0[3] * x0[3]) + (x1[0] * x1[0] + x1[1] * x1[1]) + (x1[2] * x1[2] + x1[3] * x1[3]);
                    u32x4 w; w.x = cvt_pk_bf16(x0[0], x0[1]); w.y = cvt_pk_bf16(x0[2], x0[3]); w.z = cvt_pk_bf16(x1[0], x1[1]); w.w = cvt_pk_bf16(x1[2], x1[3]);
                    *(u32x4*)(xb + off + bj * 32) = w; }
                q += __shfl_xor(q, 16); q += __shfl_xor(q, 32); if (fq == 0) ssq[(size_t)row * 16 + u.pn * 4 + wc] = q;
            }
    }
};
struct EpiLift {
    static constexpr bool PERM = true, KEEP = true, CONTIG = false;
    const bf16* fac; int ldg; bf16* mb; int ldc; const float* ssqc;
    __device__ __forceinline__ void operator()(f32x4 (&acc)[2][2][4][2], const Unit& u, int wr, int wc, int fr, int fq) const {
        const int row0 = u.pm * BM + wr * 64 + fr, col0 = u.pn * BM + wc * 32 + 8 * fq;
#pragma unroll
        for (int ai = 0; ai < 2; ++ai)
#pragma unroll
            for (int m = 0; m < 4; ++m) { const int row = row0 + ai * HALF + m * 16;
                float rsc = 1.f;
                if (u.z == 1 || u.z == 2) { const f32x2 p = *(const f32x2*)(ssqc + (size_t)row * 8 + 2 * fq); float sq = p.x + p.y; sq += __shfl_xor(sq, 16); sq += __shfl_xor(sq, 32);
                    const float v = sq * (1.f / 512.f) + 1e-6f; rsc = (u.z == 1) ? sqrtf(v) : rsqrtf(v); }
#pragma unroll
                for (int bj = 0; bj < 2; ++bj) { const int col = col0 + bj * HALF;
                    const u32x4 g0 = *(const u32x4*)(fac + (size_t)row * ldg + u.z * 1024 + col);
                    f32x4& v0 = acc[ai][bj][m][0]; f32x4& v1 = acc[ai][bj][m][1];
                    v0[0] *= rsc * bf2f(g0.x & 0xffffu); v0[1] *= rsc * bf2f(g0.x >> 16); v0[2] *= rsc * bf2f(g0.y & 0xffffu); v0[3] *= rsc * bf2f(g0.y >> 16);
                    v1[0] *= rsc * bf2f(g0.z & 0xffffu); v1[1] *= rsc * bf2f(g0.z >> 16); v1[2] *= rsc * bf2f(g0.w & 0xffffu); v1[3] *= rsc * bf2f(g0.w >> 16);
                    if (u.z == 3) { u32x4 w; w.x = cvt_pk_bf16(v0[0], v0[1]); w.y = cvt_pk_bf16(v0[2], v0[3]); w.z = cvt_pk_bf16(v1[0], v1[1]); w.w = cvt_pk_bf16(v1[2], v1[3]);
                        *(u32x4*)(mb + (size_t)row * ldc + col) = w; } } }
    }
};

__device__ __forceinline__ float dpp_ror1(float x) { return __int_as_float(__builtin_amdgcn_update_dpp(0, __float_as_int(x), 0x121, 0xf, 0xf, false)); }
__device__ __forceinline__ float dpp_ror2(float x) { return __int_as_float(__builtin_amdgcn_update_dpp(0, __float_as_int(x), 0x122, 0xf, 0xf, false)); }
__device__ __forceinline__ float dpp_prev1(float cur, float prev) { return __int_as_float(__builtin_amdgcn_update_dpp(__builtin_amdgcn_update_dpp(0, __float_as_int(prev), 0x121, 0xf, 0xf, false), __float_as_int(cur), 0x111, 0xf, 0xf, false)); }
__device__ __forceinline__ float dpp_prev2(float cur, float prev) { return __int_as_float(__builtin_amdgcn_update_dpp(__builtin_amdgcn_update_dpp(0, __float_as_int(prev), 0x122, 0xf, 0xf, false), __float_as_int(cur), 0x112, 0xf, 0xf, false)); }
struct EpiConvAct {
    static constexpr bool PERM = true, KEEP = false, CONTIG = false;
    bf16* act; const float* ssq; const float* cw; const float* cb; float* rawh; LAS unsigned char* halo; int ntn;
    __device__ __forceinline__ void operator()(f32x4 (&acc)[2][2][4][2], const Unit& u, int wr, int wc, int fr, int fq) const {
        asm volatile("" : "+v"(fr), "+v"(fq));
        const int row0 = u.pm * BM + wr * 64 + fr, ch0 = u.pn * 128 + wc * 32 + 8 * fq;
#pragma unroll
        for (int ai = 0; ai < 2; ++ai)
#pragma unroll
            for (int m = 0; m < 4; ++m) { const int row = row0 + ai * HALF + m * 16;
                float sq; { const f32x4 p = *(const f32x4*)(ssq + (size_t)row * 16 + 4 * fq); sq = (p.x + p.y) + (p.z + p.w); }
                sq += __shfl_xor(sq, 16); sq += __shfl_xor(sq, 32);
                const float rs = rsqrtf(sq * (1.f / 1024.f) + 1e-6f);
#pragma unroll
                for (int bj = 0; bj < 2; ++bj) { acc[ai][bj][m][0] = acc[ai][bj][m][0] * rs; acc[ai][bj][m][1] = acc[ai][bj][m][1] * rs; } }
        LAS f32x4* H = (LAS f32x4*)halo;
        if (fr >= 14) {
#pragma unroll
            for (int ai = 0; ai < 2; ++ai) { const int b = 2 * ai + wr;
#pragma unroll
                for (int bj = 0; bj < 2; ++bj)
#pragma unroll
                    for (int n = 0; n < 2; ++n) H[((((b * 4 + wc) * 4 + fq) * 2 + (fr - 14)) * 2 + bj) * 2 + n] = acc[ai][bj][3][n]; } }
        { float* rw = rawh + (size_t)(u.pm * ntn + u.pn) * 1024;
          if (wr == 1 && fr >= 14) {
#pragma unroll
            for (int bj = 0; bj < 2; ++bj)
#pragma unroll
                for (int n = 0; n < 2; ++n) *(f32x4*)(rw + (2 + fr - 14) * 256 + bj * HALF + wc * 32 + 8 * fq + 4 * n) = acc[1][bj][3][n]; }
          if (wr == 0 && fr < 2) {
#pragma unroll
            for (int bj = 0; bj < 2; ++bj)
#pragma unroll
                for (int n = 0; n < 2; ++n) *(f32x4*)(rw + fr * 256 + bj * HALF + wc * 32 + 8 * fq + 4 * n) = acc[0][bj][0][n]; } }
        LAS float* WL = (LAS float*)(halo + 8192);
        { const int tidl = (wr * 4 + wc) * 64 + fq * 16 + fr, i2 = tidl * 2, kind = i2 >> 7, c = i2 & 127, k4 = kind & 3;
          const float* src = (k4 < 3 ? cw + k4 * 5632 : cb) + (kind >= 4 ? 2816 : 0) + u.pn * 128 + c;
          *(LAS f32x2*)(WL + i2) = *(const f32x2*)src; }
        asm volatile("s_waitcnt vmcnt(0) lgkmcnt(0)" ::: "memory"); __builtin_amdgcn_s_barrier(); asm volatile("" ::: "memory");
        bf16* actb = act + (size_t)(u.pm * BM + wr * 64) * 2816 + u.pn * 128 + wc * 32;
        const unsigned alane = (unsigned)(fr * 2816 + 8 * fq);
#pragma unroll
        for (int n = 0; n < 2; ++n) {
            unsigned half0[2][4];
#pragma unroll
            for (int eh = 0; eh < 2; ++eh) {
                const int cl = wc * 32 + 8 * fq + 4 * n + 2 * eh;
                f32x2 wg[3], wu[3], bg, bu;
#pragma unroll
                for (int j = 0; j < 3; ++j) { wg[j] = *(const LAS f32x2*)(WL + j * 128 + cl); wu[j] = *(const LAS f32x2*)(WL + (4 + j) * 128 + cl); }
                bg = *(const LAS f32x2*)(WL + 3 * 128 + cl); bu = *(const LAS f32x2*)(WL + 7 * 128 + cl);
#pragma unroll
                for (int ai = 0; ai < 2; ++ai) { const int b = 2 * ai + wr;
#pragma unroll
                    for (int m = 3; m >= 0; --m) {
                        float r2[2];
#pragma unroll
                        for (int e2 = 0; e2 < 2; ++e2) { const int e = 2 * eh + e2;
                            const float gc = acc[ai][0][m][n][e], uc = acc[ai][1][m][n][e];
                            float gp = 0.f, up = 0.f; asm volatile("" : "+v"(gp), "+v"(up));
                            if (m > 0) { gp = acc[ai][0][m - 1][n][e]; up = acc[ai][1][m - 1][n][e]; }
                            else if (b >= 1) { const int fk = fr >= 14 ? fr - 14 : 0; const LAS float* hp = (const LAS float*)(H + ((((b - 1) * 4 + wc) * 4 + fq) * 2 + fk) * 4 + n); gp = hp[e]; up = hp[8 + e]; }
                            const float g1 = dpp_prev1(gc, gp), g2 = dpp_prev2(gc, gp), u1 = dpp_prev1(uc, up), u2 = dpp_prev2(uc, up);
                            const float vg = bg[e2] + wg[0][e2] * g2 + wg[1][e2] * g1 + wg[2][e2] * gc;
                            const float vu = bu[e2] + wu[0][e2] * u2 + wu[1][e2] * u1 + wu[2][e2] * uc;
                            r2[e2] = siluf_(vg) * vu; }
                        const unsigned pk = cvt_pk_bf16(r2[0], r2[1]);
                        if (eh == 0) half0[ai][m] = pk;
                        else *(u32x2*)(actb + (size_t)(ai * HALF + m * 16) * 2816 + 4 * n + alane) = (u32x2){half0[ai][m], pk};
                    }
                }
            }
        }
    }
};

template <class Epi, bool ALIGN_EPI = true>
__device__ __forceinline__ void gemm_phase(LAS unsigned char* lds, const Gemm g, const Order& S, const Epi& E) {
    int tid = threadIdx.x; asm volatile("" : "+v"(tid));
    const int wid = __builtin_amdgcn_readfirstlane(tid >> 6), lane = tid & 63, wr = wid >> 2, wc = wid & 3, fr = lane & 15, fq = lane >> 4;
    const int K = g.K, nt = K / BK;
    unsigned voffA[2], voffB[2];
#pragma unroll
    for (int i = 0; i < 2; ++i) { int R, C; stage_rc(tid * 16 + i * 8192, R, C);
        const int Rb = Epi::CONTIG ? (64 * (R >> 5) + perm32(R & 31)) : (Epi::PERM ? ((R & ~31) + perm32(R & 31)) : R);
        voffA[i] = (unsigned)(R * g.lda + C) * 2u; voffB[i] = (unsigned)(Rb * g.ldb + C) * 2u; }
    const size_t kstep = (size_t)(BK * 2);
    const size_t hstepA = (size_t)HALF * g.lda * 2, hstepB = (size_t)(Epi::CONTIG ? 32 : HALF) * g.ldb * 2;
    const size_t tstepA = 2 * hstepA, tstepB = (size_t)BM * g.ldb * 2;
    const unsigned ldsw = (unsigned)wid * 1024u;
    const int aoff = lds_byte(wr * 64 + fr, fq * 8), boff = lds_byte(wc * 32 + fr, fq * 8);
#define PG8_SA(b, h) (((b) * 2 + (h)) * HTB)
#define PG8_SB(b, h) ((4 + (b) * 2 + (h)) * HTB)
#define PG8_STAGE(bufoff, gbase, voff) do { _Pragma("unroll") for (int _i = 0; _i < 2; ++_i) \
        __builtin_amdgcn_global_load_lds((const unsigned*)((const char*)(gbase) + (voff)[_i]), (LAS unsigned*)(lds + (bufoff) + ldsw + _i * 8192), 16, 0, 0); } while (0)
#define PG8_LDA(dst, b, h) do { _Pragma("unroll") for (int m = 0; m < 4; ++m) _Pragma("unroll") for (int k = 0; k < 2; ++k) dst[m][k] = *(const LAS bf16x8*)(lds + PG8_SA(b, h) + aoff + m * 2048 + k * 1024); } while (0)
#define PG8_LDB(dst, b, h) do { _Pragma("unroll") for (int n = 0; n < 2; ++n) _Pragma("unroll") for (int k = 0; k < 2; ++k) dst[n][k] = *(const LAS bf16x8*)(lds + PG8_SB(b, h) + boff + n * 2048 + k * 1024); } while (0)
#define PG8_MMA(ai, bj, At, Bt) do { __builtin_amdgcn_s_setprio(1); _Pragma("unroll") for (int m = 0; m < 4; ++m) _Pragma("unroll") for (int n = 0; n < 2; ++n) _Pragma("unroll") for (int k = 0; k < 2; ++k) \
        acc[ai][bj][m][n] = __builtin_amdgcn_mfma_f32_16x16x32_bf16(Bt[n][k], At[m][k], acc[ai][bj][m][n], 0, 0, 0); __builtin_amdgcn_s_setprio(0); } while (0)
#define PG8_WAIT_V(n) asm volatile("s_waitcnt vmcnt(" #n ")" ::: "memory")
#define PG8_WAIT_L(n) asm volatile("s_waitcnt lgkmcnt(" #n ")" ::: "memory")
#define PG8_BAR __builtin_amdgcn_s_barrier()
#define PG8_SCHED __builtin_amdgcn_sched_barrier(0)
    Unit cur, nxt; int ui = 0;
    if (!S.next(0, cur)) return;
    f32x4 acc[2][2][4][2];
#pragma unroll
    for (int a = 0; a < 2; ++a)
#pragma unroll
        for (int b = 0; b < 2; ++b)
#pragma unroll
            for (int m = 0; m < 4; ++m)
#pragma unroll
                for (int n = 0; n < 2; ++n) acc[a][b][m][n] = (f32x4){0.f, 0.f, 0.f, 0.f};
    bf16x8 At[4][2], B0[2][2], B1[2][2];
    const char* cA = (const char*)g.A + (size_t)cur.pm * tstepA + (size_t)cur.z * g.zA; const char* cB = (const char*)g.Bt + (size_t)cur.pn * tstepB + (size_t)cur.z * g.zB;
    PG8_STAGE(PG8_SB(0, 0), cB, voffB); PG8_STAGE(PG8_SB(0, 1), cB + hstepB, voffB); PG8_STAGE(PG8_SA(0, 0), cA, voffA); PG8_STAGE(PG8_SA(0, 1), cA + hstepA, voffA);
    if (wr == 1) PG8_BAR;
    PG8_WAIT_V(2); PG8_BAR;
    PG8_STAGE(PG8_SB(1, 0), cB + kstep, voffB); PG8_STAGE(PG8_SA(1, 0), cA + kstep, voffA); PG8_STAGE(PG8_SB(1, 1), cB + hstepB + kstep, voffB);
    PG8_WAIT_V(6); PG8_BAR;
    for (;;) {
        const bool has_next = S.next(ui + 1, nxt);
        const char* nA = has_next ? (const char*)g.A + (size_t)nxt.pm * tstepA + (size_t)nxt.z * g.zA : cA; const char* nB = has_next ? (const char*)g.Bt + (size_t)nxt.pn * tstepB + (size_t)nxt.z * g.zB : cB;
        for (int t = 0; t < nt; t += 2) {
            const bool last = (t == nt - 2);
            const char* a1 = cA + (size_t)(t + 1) * kstep;
            const char* a2 = last ? nA : cA + (size_t)(t + 2) * kstep; const char* b2 = last ? nB : cB + (size_t)(t + 2) * kstep;
            const char* a3 = a2 + kstep; const char* b3 = b2 + kstep;
            PG8_LDB(B0, 0, 0); PG8_LDB(B1, 0, 1); PG8_SCHED; PG8_LDA(At, 0, 0); PG8_STAGE(PG8_SA(1, 1), a1 + hstepA, voffA);
            PG8_WAIT_V(8); PG8_WAIT_L(0); PG8_BAR; PG8_MMA(0, 0, At, B0); PG8_MMA(0, 1, At, B1); PG8_BAR; PG8_SCHED;
            PG8_LDA(At, 0, 1); PG8_STAGE(PG8_SB(0, 0), b2, voffB); PG8_STAGE(PG8_SB(0, 1), b2 + hstepB, voffB); PG8_STAGE(PG8_SA(0, 0), a2, voffA);
            PG8_WAIT_V(8); PG8_WAIT_L(0); PG8_BAR; PG8_MMA(1, 0, At, B0); PG8_MMA(1, 1, At, B1); PG8_BAR; PG8_SCHED;
            PG8_LDB(B0, 1, 0); PG8_LDB(B1, 1, 1); PG8_SCHED; PG8_LDA(At, 1, 0); PG8_STAGE(PG8_SA(0, 1), a2 + hstepA, voffA);
            PG8_WAIT_V(8); PG8_WAIT_L(0); PG8_BAR; PG8_MMA(0, 0, At, B0); PG8_MMA(0, 1, At, B1); PG8_BAR; PG8_SCHED;
            PG8_LDA(At, 1, 1); PG8_STAGE(PG8_SB(1, 0), b3, voffB); PG8_STAGE(PG8_SB(1, 1), b3 + hstepB, voffB); PG8_STAGE(PG8_SA(1, 0), a3, voffA);
            PG8_WAIT_V(8); PG8_WAIT_L(0); PG8_BAR; PG8_MMA(1, 0, At, B0); PG8_MMA(1, 1, At, B1); PG8_BAR; PG8_SCHED;
        }
        if constexpr (ALIGN_EPI) { if (wr == 0) PG8_BAR; }
        E(acc, cur, wr, wc, fr, fq);
        if (!has_next) break;
        if (!(Epi::KEEP && nxt.z != 0))
#pragma unroll
        for (int a = 0; a < 2; ++a)
#pragma unroll
            for (int b = 0; b < 2; ++b)
#pragma unroll
                for (int m = 0; m < 4; ++m)
#pragma unroll
                    for (int n = 0; n < 2; ++n) acc[a][b][m][n] = (f32x4){0.f, 0.f, 0.f, 0.f};
        cur = nxt; cA = nA; cB = nB; ++ui;
        if constexpr (ALIGN_EPI) { if (wr == 1) PG8_BAR; }
    }
    PG8_WAIT_V(0);
    if constexpr (!ALIGN_EPI) { if (wr == 0) PG8_BAR; }
    PG8_BAR;
#undef PG8_SA
#undef PG8_SB
#undef PG8_STAGE
#undef PG8_LDA
#undef PG8_LDB
#undef PG8_MMA
#undef PG8_WAIT_V
#undef PG8_WAIT_L
#undef PG8_BAR
#undef PG8_SCHED
}
}

#define XB_TMO      128
#define XB_XCNT(j)  (256  + 64 * (j))
#define XB_XSUB(j)  (1280 + 64 * (j))
#define XB_XGEN(j)  (2304 + 64 * (j))
#define XB_TOP      3328
#define XB_TOPGEN   3392
#define XCD_BAR_WORDS 3456
#define XB_SPIN_CAP (1u << 18)
__device__ __forceinline__ unsigned xb_ld(unsigned* p)              { return __hip_atomic_load(p, __ATOMIC_RELAXED, __HIP_MEMORY_SCOPE_AGENT); }
__device__ __forceinline__ unsigned xb_add(unsigned* p, unsigned v) { return __hip_atomic_fetch_add(p, v, __ATOMIC_RELAXED, __HIP_MEMORY_SCOPE_AGENT); }
__device__ __forceinline__ unsigned xb_xcc_id() { return (unsigned)__builtin_amdgcn_s_getreg((3 << 11) | 20) & 0xFu; }
#define XB_SPIN(cond, bar) do { unsigned _sp = 0; while (cond) { __builtin_amdgcn_s_sleep(1); \
    if ((++_sp & 255u) == 0u) { if (xb_ld(&(bar)[XB_TMO])) break; if (_sp > XB_SPIN_CAP) { atomicAdd(&(bar)[XB_TMO], 1u); break; } } } } while (0)
struct XcdBarrier { unsigned* bar; unsigned x; volatile LAS unsigned* st; };
__device__ __forceinline__ XcdBarrier xcd_barrier_post(unsigned* bar, volatile LAS unsigned* st) {
    XcdBarrier b; b.bar = bar; b.x = xb_xcc_id(); b.st = st;
    if (threadIdx.x == 0) (void)xb_add(&bar[XB_XCNT(b.x)], 1u);
    return b;
}
__device__ __forceinline__ void xcd_barrier_complete(unsigned* bar, unsigned x, unsigned& nloc, unsigned& nx) {
    const unsigned G = gridDim.x * gridDim.y * gridDim.z;
    unsigned sum, cnt, mine, sp = 0u;
    for (;;) {
        sum = 0u; cnt = 0u; mine = 0u;
#pragma unroll
        for (unsigned j = 0; j < 16; ++j) { const unsigned c = xb_ld(&bar[XB_XCNT(j)]); sum += c; cnt += (c > 0u) ? 1u : 0u; mine = (j == x) ? c : mine; }
        if (sum == G) break;
        __builtin_amdgcn_s_sleep(1);
        if ((++sp & 255u) == 0u) { if (xb_ld(&bar[XB_TMO])) break; if (sp > XB_SPIN_CAP) { atomicAdd(&bar[XB_TMO], 1u); break; } }
    }
    nloc = mine > 0u ? mine : 1u; nx = cnt > 0u ? cnt : 1u;
}
__device__ __forceinline__ void xcd_barrier(const XcdBarrier& b) {
    asm volatile("s_waitcnt vmcnt(0)" ::: "memory");
    __syncthreads();
    if (threadIdx.x == 0) {
        unsigned* bar = b.bar;
        __builtin_amdgcn_s_waitcnt(0);
        unsigned nloc = b.st[0], nx = b.st[1];
        if (nloc == 0u) { xcd_barrier_complete(bar, b.x, nloc, nx); b.st[0] = nloc; b.st[1] = nx; }
        const unsigned old = xb_add(&bar[XB_XSUB(b.x)], 1u);
        const unsigned gen = old / nloc;
        if (old + 1u == (gen + 1u) * nloc) {
            __builtin_amdgcn_fence(__ATOMIC_RELEASE, "agent");
            asm volatile("s_waitcnt vmcnt(0)" ::: "memory");
            const unsigned og = xb_add(&bar[XB_TOP], 1u);
            const unsigned tg = og / nx;
            if (og + 1u == (tg + 1u) * nx) xb_add(&bar[XB_TOPGEN], 1u);
            else XB_SPIN(xb_ld(&bar[XB_TOPGEN]) == tg, bar);
            __builtin_amdgcn_fence(__ATOMIC_ACQUIRE, "agent");
            xb_add(&bar[XB_XGEN(b.x)], 1u);
            asm volatile("s_waitcnt vmcnt(0)" ::: "memory");
        } else {
            XB_SPIN(xb_ld(&bar[XB_XGEN(b.x)]) == gen, bar);
            __builtin_amdgcn_fence(__ATOMIC_ACQUIRE, "agent");
            asm volatile("s_waitcnt vmcnt(0)" ::: "memory");
        }
    }
    __syncthreads();
}

__device__ __forceinline__ bf16x8 frag_kc(const LAS bf16* X, int ld, int mn0, int k0, int lane) { return *(const LAS bf16x8*)(X + (mn0 + (lane & 15)) * ld + k0 + 8 * (lane >> 4)); }
__device__ __forceinline__ bf16x8 gfrag_kc(const bf16* X, int ld, int mn0, int k0, int lane) { const bf16* b = X + (size_t)mn0 * ld + k0; const unsigned lo = (unsigned)((lane & 15) * ld + 8 * (lane >> 4)); return *(const bf16x8*)(b + lo); }
__device__ __forceinline__ s16x4 trr(const LAS bf16* p) { return __builtin_bit_cast(s16x4, __builtin_amdgcn_ds_read_tr16_b64_v4i16((LAS s16x4*)p)); }
__device__ __forceinline__ bf16x8 frag_ks(const LAS bf16* X, int ld, int mn0, int k0, int lane) {
    const int r = lane & 15, g = lane >> 4;
    const LAS bf16* p = X + (k0 + 8 * g + (r >> 2)) * ld + mn0 + 4 * (r & 3);
    const s16x4 lo = trr(p), hi = trr(p + 4 * ld);
    return (bf16x8){lo[0], lo[1], lo[2], lo[3], hi[0], hi[1], hi[2], hi[3]};
}
__device__ __forceinline__ f32x4 zero4() { f32x4 z = {0.f, 0.f, 0.f, 0.f}; asm volatile("" : "+v"(z)); return z; }
__device__ __forceinline__ u32x4 uone4() { u32x4 z = {0x3F80u, 0u, 0u, 0u}; asm volatile("" : "+v"(z)); return z; }
__device__ __forceinline__ u32x4 uzero4() { u32x4 z = {0u, 0u, 0u, 0u}; asm volatile("" : "+v"(z)); return z; }
#define MFMA16(a, b, c) __builtin_amdgcn_mfma_f32_16x16x32_bf16((a), (b), (c), 0, 0, 0)
__device__ __forceinline__ u32x4 scale8(u32x4 w, float s) {
    u32x4 o;
    o.x = pk2(bf2f(w.x & 0xffffu) * s, bf2f(w.x >> 16) * s); o.y = pk2(bf2f(w.y & 0xffffu) * s, bf2f(w.y >> 16) * s);
    o.z = pk2(bf2f(w.z & 0xffffu) * s, bf2f(w.z >> 16) * s); o.w = pk2(bf2f(w.w & 0xffffu) * s, bf2f(w.w >> 16) * s);
    return o;
}
__device__ __forceinline__ float wscan_add(float v, int lane) {
#pragma unroll
    for (int o = 1; o < 64; o <<= 1) { const float t = __shfl_up(v, o); if (lane >= o) v += t; }
    return v;
}
__device__ __forceinline__ float wscan_max(float v, int lane) {
#pragma unroll
    for (int o = 1; o < 64; o <<= 1) { const float t = __shfl_up(v, o); if (lane >= o) v = fmaxf(v, t); }
    return v;
}

#ifndef GEMM_ALIGN
#define GEMM_ALIGN true
#endif
enum { PH_W = 0, PH_INPROJ, PH_M0, PH_M1, PH_M2, PH_M3, PH_LIFT, PH_OUT, PH_UP, PH_DOWN, PH_FINAL, PH_COUNT };
enum { I_X = 0, I_MIXG, I_WIN, I_AIB, I_AFB, I_ANG, I_BCW, I_CCW, I_CCB, I_CDTB, I_CALOG, I_CDSKIP, I_CNG, I_WLIFT, I_WOUT, I_FFNG, I_WUP, I_FCW, I_FCB, I_WDOWN, I_FING, N_IN };
struct Args { const float* in[N_IN]; float* out; unsigned char* ws; int l_lo, l_hi, g_lo, g_hi, ph_lo, ph_hi, use_bar, pad; };

__device__ __forceinline__ void transpose_item(const float* W, int ldw, int nsrc0, int k0, bf16* WT, int ldt, int ndst0, LAS float* scr, int lane, const float* kscale = nullptr, int gate_tile = -1) {
    int scol = nsrc0 + (lane & 31);
    if (gate_tile >= 0) {
        const int c = (ndst0 & 255) + (lane & 31), wc = c >> 6, bj = (c >> 5) & 1, fq = (c >> 3) & 3, n = (c >> 2) & 1, e = c & 3;
        scol = 6160 + (2 * bj + n) * 1024 + 64 * gate_tile + 16 * wc + 4 * fq + e; }
#pragma unroll 8
    for (int i = 0; i < 32; ++i) { const int kk = 2 * i + (lane >> 5); scr[kk * 33 + (lane & 31)] = W[(size_t)(k0 + kk) * ldw + scol] * (kscale ? kscale[k0 + kk] : 1.f); }
    LDS_WAIT(); asm volatile("" ::: "memory");
    const int c = lane & 7;
#pragma unroll
    for (int j = 0; j < 4; ++j) { const int n = (lane >> 3) + 8 * j; const LAS float* s = scr + (8 * c) * 33 + n;
        u32x4 o; o.x = pk2(s[0 * 33], s[1 * 33]); o.y = pk2(s[2 * 33], s[3 * 33]); o.z = pk2(s[4 * 33], s[5 * 33]); o.w = pk2(s[6 * 33], s[7 * 33]);
        *(u32x4*)(WT + (size_t)(ndst0 + n) * ldt + k0 + 8 * c) = o; }
    LDS_WAIT(); asm volatile("" ::: "memory");
}

__global__ void __launch_bounds__(NTHR, 2) fwd(Args args) {
    extern __shared__ __attribute__((aligned(16))) unsigned char lds_raw[];
    LAS unsigned char* lds = (LAS unsigned char*)lds_raw;
    const int NBLK = gridDim.x, blk = blockIdx.x;
    {
        volatile LAS unsigned* MISC0 = (volatile LAS unsigned*)(lds + MISC_OFF);
        if (threadIdx.x < 16) MISC0[threadIdx.x] = 0u;
        __syncthreads();
    }
    XcdBarrier bar; bar.bar = (unsigned*)(args.ws + WS_CTL) + 4096; bar.x = 0; bar.st = nullptr;
    if (args.use_bar) bar = xcd_barrier_post((unsigned*)(args.ws + WS_CTL) + 4096, (volatile LAS unsigned*)(lds + MISC_OFF) + 8);
#define GRID_BAR() do { if (args.use_bar) xcd_barrier(bar); } while (0)
#ifndef REPMASK
#define REPMASK 0
#endif
#define IN(k) (args.ph_lo <= (k) && (k) < args.ph_hi)
#define REPS(k) for (int rep_ = 0; rep_ < 1 + ((REPMASK >> (k)) & 1); ++rep_)
#define PHASE_BEGIN() int tid = threadIdx.x; asm volatile("" : "+v"(tid)); const int lane = tid & 63, wave = __builtin_amdgcn_readfirstlane(tid >> 6); \
    const __attribute__((address_space(4))) Args* ka = (const __attribute__((address_space(4))) Args*)__builtin_amdgcn_kernarg_segment_ptr(); asm volatile("" : "+s"(ka)); \
    unsigned char* ws = ka->ws; \
    const size_t grow0 = (size_t)grp * T; const float* xsrc = (l == 0) ? ka->in[I_X] : ka->out; (void)grow0; (void)xsrc; \
    const int gw = blk * NWAVES + wave, NGW = NBLK * NWAVES, gt = blk * NTHR + tid, NGT = NBLK * NTHR; (void)lane; (void)gw; (void)NGW; (void)gt; (void)NGT; \
    bf16* const WinT = (bf16*)(ws + WS_WIN); bf16* const WliftT = (bf16*)(ws + WS_WLIFT); bf16* const WoutT = (bf16*)(ws + WS_WOUT); \
    bf16* const WupT = (bf16*)(ws + WS_WUP); bf16* const WdownT = (bf16*)(ws + WS_WDOWN); bf16* const W16B = (bf16*)(ws + WS_W16); \
    bf16* const XN = (bf16*)(ws + WS_XN); bf16* const P = (bf16*)(ws + WS_P); bf16* const U = (bf16*)(ws + WS_U); bf16* const ACT = (bf16*)(ws + WS_ACT); \
    bf16* const YCAT = (bf16*)(ws + WS_YCAT); bf16* const XG = (bf16*)(ws + WS_XG); bf16* const MB = (bf16*)(ws + WS_MB); float* const SP = (float*)(ws + WS_SP); \
    float* const SSQ1 = (float*)(ws + WS_SSQ1); float* const SSQ2 = (float*)(ws + WS_SSQ2); float* const SSQC = (float*)(ws + WS_SSQC); float* const RAWH = (float*)(ws + WS_RAWH); (void)SSQ1; (void)SSQ2; (void)SSQC; (void)RAWH; \
    float* const GBc = (float*)(ws + WS_GB); float* const GGc = (float*)(ws + WS_GG); float* const GMT = (float*)(ws + WS_GMT); \
    float* const MCAR = (float*)(ws + WS_MCAR); float* const MNEW = (float*)(ws + WS_MNEW); float* const MSC = (float*)(ws + WS_MSC); float* const SUMB = (float*)(ws + WS_SUMB); float* const SUMG = (float*)(ws + WS_SUMG); (void)SUMB; (void)SUMG; \
    float* const DTB = (float*)(ws + WS_DT); float* const ACB = (float*)(ws + WS_AC); bf16* const XBC = (bf16*)(ws + WS_XBC); \
    bf16* const DC = (bf16*)(ws + WS_DC); bf16* const CS = (bf16*)(ws + WS_CS); bf16* const DH = (bf16*)(ws + WS_DH); bf16* const HS = (bf16*)(ws + WS_HS); \
    (void)WinT; (void)WliftT; (void)WoutT; (void)WupT; (void)WdownT; (void)W16B; (void)XN; (void)P; (void)U; (void)ACT; (void)YCAT; (void)XG; (void)MB; (void)SP; (void)GBc; (void)GGc; (void)GMT; \
    (void)MCAR; (void)MNEW; (void)MSC; (void)DTB; (void)ACB; (void)XBC; (void)DC; (void)CS; (void)DH; (void)HS

    for (int l = args.l_lo; l < args.l_hi; ++l)
    for (int grp = args.g_lo; grp < args.g_hi; ++grp) {

        REPS(PH_W) if (IN(PH_W) && grp == 0) {
            PHASE_BEGIN();
            LAS float* scr = (LAS float*)(lds + wave * 16384);
            constexpr int I_IN = 16 * 320, I_LF = 4 * 8 * 32, I_OUT = 16 * 32, I_UP = 16 * 176, I_DN = 44 * 32, NIT = I_IN + I_LF + I_OUT + I_UP + I_DN;
            for (int it = gw; it < NIT; it += NGW) {
                int r = it;
                if (r < I_IN) { const int kb = r / 320, nb = r % 320, n0 = 32 * nb, ns = n0 + (n0 >= P_SQ ? 16 : (n0 >= P_BB ? 8 : 0));
                    transpose_item(ka->in[I_WIN] + (size_t)l * DM * PIN, PIN, ns, 64 * kb, WinT, DM, n0, scr, lane, ka->in[I_MIXG] + (size_t)l * DM, n0 >= P_G ? (n0 - P_G) >> 8 : -1); continue; } r -= I_IN;
                if (r < I_LF) { const int br = r / 256, q = r % 256, kb = q / 32, nb = q % 32;
                    transpose_item(ka->in[I_WLIFT] + (size_t)(l * 4 + br) * 512 * DM, DM, 32 * nb, 64 * kb, WliftT + (size_t)br * DM * 512, 512, 32 * nb, scr, lane, br == 2 ? ka->in[I_CNG] + (size_t)l * 512 : nullptr); continue; } r -= I_LF;
                if (r < I_OUT) { const int kb = r / 32, nb = r % 32;
                    transpose_item(ka->in[I_WOUT] + (size_t)l * DM * DM, DM, 32 * nb, 64 * kb, WoutT, DM, 32 * nb, scr, lane); continue; } r -= I_OUT;
                if (r < I_UP) { const int kb = r / 176, nb = r % 176, n0 = 32 * nb, tp = n0 >> 8, j = n0 & 255, ns = (j < 128) ? 128 * tp + j : 2816 + 128 * tp + (j - 128);
                    transpose_item(ka->in[I_WUP] + (size_t)l * DM * DFF2, DFF2, ns, 64 * kb, WupT, DM, n0, scr, lane, ka->in[I_FFNG] + (size_t)l * DM); continue; } r -= I_UP;
                { const int kb = r / 32, nb = r % 32;
                    transpose_item(ka->in[I_WDOWN] + (size_t)l * DFF * DM, DM, 32 * nb, 64 * kb, WdownT, DFF, 32 * nb, scr, lane); }
            }
            for (int i = gt; i < 16 * DM; i += NGT) { const int c = i >> 10, k = i & 1023; const int oc = (c < 8) ? (1536 + c) : (4616 + (c - 8));
                const float w = ka->in[I_WIN][(size_t)l * DM * PIN + (size_t)k * PIN + oc] * ka->in[I_MIXG][(size_t)l * DM + k]; const unsigned hi = f2bf(w);
                W16B[i] = (bf16)hi; W16B[16 * DM + i] = (bf16)f2bf(w - bf2f(hi)); }
            if (l == 0) {
                for (int m = gw; m < BATCH * SEQ; m += NGW) {
                    const f32x4* xr = (const f32x4*)(ka->in[I_X] + (size_t)m * DM) + lane;
                    f32x4 v[4]; float sq = 0.f;
#pragma unroll
                    for (int j = 0; j < 4; ++j) { v[j] = xr[64 * j]; sq += (v[j].x * v[j].x + v[j].y * v[j].y) + (v[j].z * v[j].z + v[j].w * v[j].w); }
                    sq = wave_sum(sq); if (lane < 16) SSQ1[(size_t)m * 16 + lane] = (lane == 0) ? sq : 0.f;
                    u32x2* o8 = (u32x2*)(XG + (size_t)m * DM) + lane;
#pragma unroll
                    for (int j = 0; j < 4; ++j) o8[64 * j] = (u32x2){pk2(v[j].x, v[j].y), pk2(v[j].z, v[j].w)};
                }
            }
            GRID_BAR();
        }

        REPS(PH_INPROJ) if (IN(PH_INPROJ)) {
            PHASE_BEGIN();
            const bf16* XGg = XG + grow0 * DM; const float* ssq = SSQ1 + grow0 * 16;
            for (int rb = blk; rb < T / 64; rb += NBLK) {
                const int r0 = rb * 64 + 16 * (wave & 3), kh = (wave >> 2) * 512; f32x4 acc = zero4(), acc2 = zero4();
#pragma unroll 8
                for (int ks = 0; ks < 16; ++ks) { const bf16x8 a = gfrag_kc(XGg, DM, r0, kh + 32 * ks, lane);
                    acc = MFMA16(a, gfrag_kc(W16B, DM, 0, kh + 32 * ks, lane), acc); acc2 = MFMA16(a, gfrag_kc(W16B + 16 * DM, DM, 0, kh + 32 * ks, lane), acc2); }
                acc += acc2;
                LAS f32x4* xch = (LAS f32x4*)lds;
                if (wave >= 4) xch[(wave - 4) * 64 + lane] = acc;
                __syncthreads();
                if (wave < 4) { acc += xch[wave * 64 + lane];
#pragma unroll
                    for (int i = 0; i < 4; ++i) { const int row = r0 + 4 * (lane >> 4) + i; SP[(size_t)row * 16 + (lane & 15)] = acc[i] * row_rstd(ssq + (size_t)row * 16); } }
                __syncthreads();
            }
            pg8::Gemm g{XGg, WinT, DM, DM, DM, 0, 0}; pg8::Order S; S.init(T, PW, NBLK, blk, 1);
            pg8::EpiBf16 E{P, PW, ssq, P_G / 256};
            pg8::gemm_phase<pg8::EpiBf16, GEMM_ALIGN>(lds, g, S, E);
            GRID_BAR();
        }

        REPS(PH_M0) if (IN(PH_M0)) {
            PHASE_BEGIN();
            for (int task = gw; task < GB * 4 * NCH; task += NGW) {
                const int bh = task >> 5, c = task & 31, bl = bh >> 2, h = bh & 3;
                const size_t m = (size_t)bl * SEQ + c * 64 + lane;
                const float ig = SP[m * 16 + h] + ka->in[I_AIB][l * 4 + h], fg = SP[m * 16 + 4 + h] + ka->in[I_AFB][l * 4 + h];
                const float b = wscan_add(logsigf_(fg), lane);
                const float gg = ig - b;
                const float pm = wscan_max(gg, lane);
                GBc[m * 4 + h] = b; GGc[m * 4 + h] = gg; GMT[m * 4 + h] = pm;
                if (lane == 63) { SUMB[task] = b; SUMG[task] = pm; }
            }
            for (int task = gw; task < GB * NCH * 8; task += NGW) {
                const int hd = task & 7; const size_t m = (size_t)(task >> 3) * 64 + lane;
                const float dt = softplusf_(SP[m * 16 + 8 + hd] + ka->in[I_CDTB][l * 8 + hd]);
                const float a = wscan_add(-dt * __expf(ka->in[I_CALOG][l * 8 + hd]), lane);
                DTB[m * 8 + hd] = dt; ACB[m * 8 + hd] = a;
            }
            {
                const float* cw = ka->in[I_CCW] + (size_t)l * 4 * 1024; const float* cb = ka->in[I_CCB] + (size_t)l * 1024;
                constexpr int RUN = 16;
                for (int i = gt; i < (T / RUN) * 128; i += NGT) {
                    const int rb = i >> 7, c8 = (i & 127) * 8, m0 = rb * RUN, t0 = m0 & (SEQ - 1);
                    float w[4][8], bb[8];
#pragma unroll
                    for (int e = 0; e < 8; ++e) { bb[e] = cb[c8 + e];
#pragma unroll
                        for (int j = 0; j < 4; ++j) w[j][e] = cw[j * 1024 + c8 + e]; }
                    const u32x4 zz = uzero4(); u32x4 win[4]; win[0] = zz; win[1] = zz; win[2] = zz;
                    if (t0 >= 3) { const bf16* pr = P + (size_t)(m0 - 3) * PW + P_CX + c8; win[0] = *(const u32x4*)pr; win[1] = *(const u32x4*)(pr + PW); win[2] = *(const u32x4*)(pr + 2 * PW); }
#pragma unroll 4
                    for (int rr = 0; rr < RUN; ++rr) {
                        win[3] = *(const u32x4*)(P + (size_t)(m0 + rr) * PW + P_CX + c8);
                        float acc[8];
#pragma unroll
                        for (int e = 0; e < 8; ++e) acc[e] = bb[e];
#pragma unroll
                        for (int j = 0; j < 4; ++j) {
                            acc[0] += w[j][0] * bf2f(win[j].x & 0xffffu); acc[1] += w[j][1] * bf2f(win[j].x >> 16); acc[2] += w[j][2] * bf2f(win[j].y & 0xffffu); acc[3] += w[j][3] * bf2f(win[j].y >> 16);
                            acc[4] += w[j][4] * bf2f(win[j].z & 0xffffu); acc[5] += w[j][5] * bf2f(win[j].z >> 16); acc[6] += w[j][6] * bf2f(win[j].w & 0xffffu); acc[7] += w[j][7] * bf2f(win[j].w >> 16); }
                        u32x4 o; o.x = pk2(siluf_(acc[0]), siluf_(acc[1])); o.y = pk2(siluf_(acc[2]), siluf_(acc[3])); o.z = pk2(siluf_(acc[4]), siluf_(acc[5])); o.w = pk2(siluf_(acc[6]), siluf_(acc[7]));
                        *(u32x4*)(XBC + (size_t)(m0 + rr) * 1024 + c8) = o;
                        win[0] = win[1]; win[1] = win[2]; win[2] = win[3];
                    }
                }
            }
            {
                const float* bw = ka->in[I_BCW] + (size_t)l * 3 * 512;
                constexpr int RUN = 16;
                for (int i = gt; i < (T / RUN) * 64; i += NGT) {
                    const int rb = i >> 6, c8 = (i & 63) * 8, m0 = rb * RUN, t0 = m0 & (SEQ - 1);
                    float w[3][8];
#pragma unroll
                    for (int e = 0; e < 8; ++e)
#pragma unroll
                        for (int j = 0; j < 3; ++j) w[j][e] = bw[j * 512 + c8 + e];
                    float pw[3][8];
#pragma unroll
                    for (int e = 0; e < 8; ++e) { pw[0][e] = 0.f; pw[1][e] = 0.f; }
                    if (t0 >= 2) {
#pragma unroll
                        for (int j = 0; j < 2; ++j) { const bf16* pr = P + (size_t)(m0 - 2 + j) * PW; const u32x4 a = *(const u32x4*)(pr + P_BC + c8), b = *(const u32x4*)(pr + P_BX + c8);
                            pw[j][0] = bf2f(a.x & 0xffffu) * bf2f(b.x & 0xffffu); pw[j][1] = bf2f(a.x >> 16) * bf2f(b.x >> 16); pw[j][2] = bf2f(a.y & 0xffffu) * bf2f(b.y & 0xffffu); pw[j][3] = bf2f(a.y >> 16) * bf2f(b.y >> 16);
                            pw[j][4] = bf2f(a.z & 0xffffu) * bf2f(b.z & 0xffffu); pw[j][5] = bf2f(a.z >> 16) * bf2f(b.z >> 16); pw[j][6] = bf2f(a.w & 0xffffu) * bf2f(b.w & 0xffffu); pw[j][7] = bf2f(a.w >> 16) * bf2f(b.w >> 16); } }
#pragma unroll 4
                    for (int rr = 0; rr < RUN; ++rr) {
                        const bf16* pr = P + (size_t)(m0 + rr) * PW; const u32x4 a = *(const u32x4*)(pr + P_BC + c8), b = *(const u32x4*)(pr + P_BX + c8), g = *(const u32x4*)(pr + P_BB + c8);
                        pw[2][0] = bf2f(a.x & 0xffffu) * bf2f(b.x & 0xffffu); pw[2][1] = bf2f(a.x >> 16) * bf2f(b.x >> 16); pw[2][2] = bf2f(a.y & 0xffffu) * bf2f(b.y & 0xffffu); pw[2][3] = bf2f(a.y >> 16) * bf2f(b.y >> 16);
                        pw[2][4] = bf2f(a.z & 0xffffu) * bf2f(b.z & 0xffffu); pw[2][5] = bf2f(a.z >> 16) * bf2f(b.z >> 16); pw[2][6] = bf2f(a.w & 0xffffu) * bf2f(b.w & 0xffffu); pw[2][7] = bf2f(a.w >> 16) * bf2f(b.w >> 16);
                        float acc[8];
#pragma unroll
                        for (int e = 0; e < 8; ++e) acc[e] = w[0][e] * pw[0][e] + w[1][e] * pw[1][e] + w[2][e] * pw[2][e];
                        u32x4 o; o.x = pk2(acc[0] * bf2f(g.x & 0xffffu), acc[1] * bf2f(g.x >> 16)); o.y = pk2(acc[2] * bf2f(g.y & 0xffffu), acc[3] * bf2f(g.y >> 16));
                        o.z = pk2(acc[4] * bf2f(g.z & 0xffffu), acc[5] * bf2f(g.z >> 16)); o.w = pk2(acc[6] * bf2f(g.w & 0xffffu), acc[7] * bf2f(g.w >> 16));
                        *(u32x4*)(YCAT + (size_t)(m0 + rr) * YW + 512 + c8) = o;
#pragma unroll
                        for (int e = 0; e < 8; ++e) { pw[0][e] = pw[1][e]; pw[1][e] = pw[2][e]; }
                    }
                }
            }
            __syncthreads();
            {
            LAS bf16* Qs = (LAS bf16*)lds; LAS bf16* Ks = Qs + 128 * 136; LAS bf16* Vs = Ks + 64 * 136; LAS bf16* Aw = Vs + 64 * 136 + wave * (16 * 72);
            const int r = lane & 15, g4 = lane >> 4;
            for (int u = blk; u < GB * 4 * 16; u += NBLK) {
                const int bl = u >> 6, h = (u >> 4) & 3, qt = u & 15; const size_t mb = (size_t)bl * SEQ; const int q0 = qt * 128;
                volatile LAS unsigned* FLG = (volatile LAS unsigned*)(lds + MISC_OFF + 128);
                int par = 0;
                __syncthreads();
                if (lane == 0) { FLG[wave] = 0u; FLG[8 + wave] = 0u; }
                for (int i = tid; i < 2048; i += NTHR) { const int s = i >> 4, c8 = i & 15; *(LAS u32x4*)(Qs + s * 136 + c8 * 8) = *(const u32x4*)(P + (mb + q0 + s) * PW + P_SQ + h * 128 + c8 * 8); }
                f32x4 O[8];
#pragma unroll
                for (int d = 0; d < 8; ++d) O[d] = zero4();
                float racc = 0.f; const int tq = q0 + 16 * wave + r;
                for (int kt = 2 * qt + 1; kt >= 0; --kt) {
                    const int s0 = kt * 64;
                    __syncthreads();
                    { unsigned alldone = 1u;
#pragma unroll
                      for (int w8 = 0; w8 < 8; ++w8) alldone &= FLG[par * 8 + w8];
                      if (__builtin_amdgcn_readfirstlane((int)alldone)) break; }
                    for (int i = tid; i < 1024; i += NTHR) { const int s = i >> 4, c8 = i & 15; const bf16* pr = P + (mb + s0 + s) * PW + h * 128 + c8 * 8;
                        *(LAS u32x4*)(Ks + s * 136 + c8 * 8) = *(const u32x4*)(pr + P_SK); *(LAS u32x4*)(Vs + s * 136 + c8 * 8) = *(const u32x4*)(pr + P_SV); }
                    __syncthreads();
                    if (s0 < q0 + 16 * wave + 15) {
                        f32x4 z[4];
#pragma unroll
                        for (int j = 0; j < 4; ++j) z[j] = zero4();
#pragma unroll
                        for (int ks = 0; ks < 4; ++ks) { const bf16x8 fq = frag_kc(Qs, 136, 16 * wave, 32 * ks, lane);
#pragma unroll
                            for (int j = 0; j < 4; ++j) z[j] = MFMA16(frag_kc(Ks, 136, 16 * j, 32 * ks, lane), fq, z[j]); }
                        float ls[4][4], x[4][4], tsum[4];
#pragma unroll
                        for (int j = 0; j < 4; ++j) { float tj = 0.f;
#pragma unroll
                            for (int i = 0; i < 4; ++i) { const int s = s0 + 16 * j + 4 * g4 + i; const float zz = z[j][i] * 0.08838834764831845f;
                                const float l1 = fminf(zz, 0.f) - __logf(1.f + __expf(-fabsf(zz)));
                                ls[j][i] = l1; x[j][i] = (s < tq) ? (l1 - zz) : 0.f; tj += x[j][i]; }
                            tsum[j] = tj; }
                        float above[4], tot[4];
#pragma unroll
                        for (int j = 0; j < 4; ++j) { const float y1 = __shfl_xor(tsum[j], 16), y2 = __shfl_xor(tsum[j], 32), y3 = __shfl_xor(tsum[j], 48);
                            tot[j] = tsum[j] + y1 + y2 + y3;
                            above[j] = (g4 == 0) ? (y1 + y2 + y3) : (g4 == 1) ? (y2 + y3) : (g4 == 2) ? y1 : 0.f; }
                        float hi = racc;
#pragma unroll
                        for (int j = 3; j >= 0; --j) { float run = hi + above[j]; float av[4];
#pragma unroll
                            for (int i = 3; i >= 0; --i) { const int s = s0 + 16 * j + 4 * g4 + i; av[i] = (s < tq) ? __expf(ls[j][i] + run) : 0.f; run += x[j][i]; }
                            *(LAS u32x2*)(Aw + r * 72 + 16 * j + 4 * g4) = (u32x2){pk2(av[0], av[1]), pk2(av[2], av[3])};
                            hi += tot[j]; }
                        racc = hi;
                        LDS_WAIT(); asm volatile("" ::: "memory");
#pragma unroll
                        for (int ks = 0; ks < 2; ++ks) { const bf16x8 fa = frag_kc(Aw, 72, 0, 32 * ks, lane);
#pragma unroll
                            for (int d = 0; d < 8; ++d) O[d] = MFMA16(fa, frag_ks(Vs, 136, 16 * d, 32 * ks, lane), O[d]); }
                    }
                    par ^= 1;
                    { const bool wd = __all(racc < -104.f); if (lane == 0) FLG[par * 8 + wave] = wd ? 1u : 0u; }
                }
#pragma unroll
                for (int d = 0; d < 8; ++d)
#pragma unroll
                    for (int i = 0; i < 4; ++i) YCAT[(mb + q0 + 16 * wave + 4 * g4 + i) * YW + 1536 + h * 128 + 16 * d + r] = (bf16)f2bf(O[d][i]);
            }
            }
            GRID_BAR();
        }

        REPS(PH_M1) if (IN(PH_M1)) {
            PHASE_BEGIN();
            constexpr int NUA = GB * 4 * NCH, NUC = GB * NCH;
            for (int u = blk; u < NUA + NUC; u += NBLK) {
                if (u < NUA) {
                    const int ua = u, bh = ua >> 5, c = ua & 31, bl = bh >> 2, h = bh & 3; const size_t m0 = (size_t)bl * SEQ + c * 64;
                    LAS bf16* VP = (LAS bf16*)lds; LAS bf16* WK = (LAS bf16*)(lds + 64 * 152 * 2);
                    float bLj = 0.f, gmj = -1e30f;
                    if (lane < 32) { bLj = SUMB[bh * 32 + lane]; gmj = SUMG[bh * 32 + lane]; }
                    float pa = bLj, pq = gmj + bLj;
#pragma unroll
                    for (int o = 1; o < 32; o <<= 1) { const float ta = __shfl_up(pa, o), tq = __shfl_up(pq, o); if (lane >= o) { pq = fmaxf(tq + pa, pq); pa = ta + pa; } }
                    const float mall = fmaxf(pa, pq);
                    const float mnew = __shfl(mall, c), mprev = (c == 0) ? 0.f : __shfl(mall, (c + 63) & 63);
                    const float bL = GBc[(m0 + 63) * 4 + h];
                    if (tid == 0) { MCAR[ua] = mprev; MNEW[ua] = mnew; MSC[ua] = __expf(bL + mprev - mnew); }
                    for (int i = tid; i < 1024; i += NTHR) { const int s = i >> 4, c8 = i & 15; *(LAS u32x4*)(VP + s * 152 + c8 * 8) = *(const u32x4*)(P + (m0 + s) * PW + P_AV + h * 128 + c8 * 8); }
                    if (tid < 64) { *(LAS u32x4*)(VP + tid * 152 + 128) = uone4(); *(LAS u32x4*)(VP + tid * 152 + 136) = uzero4(); }
                    { const int s = tid >> 3, c8 = tid & 7; const float w = __expf(bL + GGc[(m0 + s) * 4 + h] - mnew);
                      *(LAS u32x4*)(WK + s * 72 + c8 * 8) = scale8(*(const u32x4*)(P + (m0 + s) * PW + P_AK + h * 64 + c8 * 8), w); }
                    __syncthreads();
                    for (int ti = wave; ti < 36; ti += NWAVES) { const int mt = ti >> 2, nt = ti & 3; f32x4 acc = zero4();
#pragma unroll
                        for (int ks = 0; ks < 2; ++ks) acc = MFMA16(frag_ks(VP, 152, 16 * mt, 32 * ks, lane), frag_ks(WK, 72, 16 * nt, 32 * ks, lane), acc);
                        bf16* d = DC + (size_t)ua * 9216 + (16 * mt + 4 * (lane >> 4)) * 64 + 16 * nt + (lane & 15);
#pragma unroll
                        for (int i = 0; i < 4; ++i) d[i * 64] = (bf16)f2bf(acc[i]); }
                    __syncthreads();
                } else {
                    const int uc = u - NUA, bl = uc >> 5, c = uc & 31, hd = wave, gi = hd >> 2; const size_t m0 = (size_t)bl * SEQ + c * 64;
                    LAS bf16* XW = (LAS bf16*)(lds + hd * (64 * 72 * 2)); LAS bf16* BMs = (LAS bf16*)(lds + 8 * 64 * 72 * 2);
                    const float alast = ACB[(m0 + 63) * 8 + hd];
#pragma unroll
                    for (int k = 0; k < 8; ++k) { const int i = lane + 64 * k, s = i >> 3, c8 = i & 7; const float wd = __expf(alast - ACB[(m0 + s) * 8 + hd]) * DTB[(m0 + s) * 8 + hd];
                        *(LAS u32x4*)(XW + s * 72 + c8 * 8) = scale8(*(const u32x4*)(XBC + (m0 + s) * 1024 + hd * 64 + c8 * 8), wd); }
                    for (int i = tid; i < 2048; i += NTHR) { const int g2 = i >> 10, rem = i & 1023, s = rem >> 4, c8 = rem & 15;
                        *(LAS u32x4*)(BMs + g2 * (64 * 136) + s * 136 + c8 * 8) = *(const u32x4*)(XBC + (m0 + s) * 1024 + 512 + g2 * 128 + c8 * 8); }
                    __syncthreads();
                    const LAS bf16* BMg = BMs + gi * (64 * 136);
                    for (int pt = 0; pt < 4; ++pt) { f32x4 acc[8];
#pragma unroll
                        for (int n = 0; n < 8; ++n) acc[n] = zero4();
#pragma unroll
                        for (int ks = 0; ks < 2; ++ks) { const bf16x8 a = frag_ks(XW, 72, 16 * pt, 32 * ks, lane);
#pragma unroll
                            for (int n = 0; n < 8; ++n) acc[n] = MFMA16(a, frag_ks(BMg, 136, 16 * n, 32 * ks, lane), acc[n]); }
                        bf16* d = DH + ((size_t)(uc * 8 + hd) * 64 + 16 * pt + 4 * (lane >> 4)) * 128 + (lane & 15);
#pragma unroll
                        for (int n = 0; n < 8; ++n)
#pragma unroll
                            for (int i = 0; i < 4; ++i) d[i * 128 + 16 * n] = (bf16)f2bf(acc[n][i]); }
                    __syncthreads();
                }
            }
            GRID_BAR();
        }

        REPS(PH_M2) if (IN(PH_M2)) {
            PHASE_BEGIN();
            constexpr int NA = GB * 4 * 2304, NC = GB * 8 * 2048;
            for (int i = gt; i < NA + NC; i += NGT) {
                f32x4 st = zero4();
                if (i < NA) { const int bh = i / 2304, e = (i - bh * 2304) * 4;
                    for (int c = 0; c < NCH; ++c) { const size_t ua = (size_t)bh * NCH + c;
                        *(u32x2*)(CS + ua * 9216 + e) = (u32x2){pk2(st.x, st.y), pk2(st.z, st.w)};
                        { const u32x2 dw = *(const u32x2*)(DC + ua * 9216 + e); st = st * MSC[ua] + (f32x4){bf2f(dw.x & 0xffffu), bf2f(dw.x >> 16), bf2f(dw.y & 0xffffu), bf2f(dw.y >> 16)}; } }
                } else { const int j = i - NA, bhd = j >> 11, e = (j & 2047) * 4, bl = bhd >> 3, hd = bhd & 7;
                    for (int c = 0; c < NCH; ++c) { const size_t uh = (size_t)(bl * NCH + c) * 8 + hd;
                        *(u32x2*)(HS + uh * 8192 + e) = (u32x2){pk2(st.x, st.y), pk2(st.z, st.w)};
                        { const u32x2 dw = *(const u32x2*)(DH + uh * 8192 + e); st = st * __expf(ACB[((size_t)bl * SEQ + c * 64 + 63) * 8 + hd]) + (f32x4){bf2f(dw.x & 0xffffu), bf2f(dw.x >> 16), bf2f(dw.y & 0xffffu), bf2f(dw.y >> 16)}; } }
                }
            }
            GRID_BAR();
        }

        REPS(PH_M3) if (IN(PH_M3)) {
            PHASE_BEGIN();
            constexpr int NUA = GB * 4 * NCH, NUC = 2 * GB * NCH;
            for (int u = blk; u < NUA + NUC; u += NBLK) {
                const int r = lane & 15, g4 = lane >> 4;
                if (u < NUA) {
                    const int ua = u, bh = ua >> 5, c = ua & 31, bl = bh >> 2, h = bh & 3; const size_t m0 = (size_t)bl * SEQ + c * 64;
                    LAS bf16* Qs = (LAS bf16*)lds; LAS bf16* Ks = Qs + 64 * 72; LAS bf16* VP = Ks + 64 * 72; LAS bf16* CST = VP + 64 * 152; LAS bf16* SMT = CST + 144 * 72; LAS bf16* AOT = SMT + 64 * 72;
                    LAS float* GS = (LAS float*)(AOT + 64 * 136);
                    LAS float* SSQ = GS + 256;
                    const float mcar = MCAR[ua];
                    { const int s = tid >> 3, c8 = tid & 7; const bf16* pr = P + (m0 + s) * PW + h * 64 + c8 * 8;
                      *(LAS u32x4*)(Qs + s * 72 + c8 * 8) = *(const u32x4*)(pr + P_AQ); *(LAS u32x4*)(Ks + s * 72 + c8 * 8) = *(const u32x4*)(pr + P_AK); }
                    for (int i = tid; i < 1024; i += NTHR) { const int s = i >> 4, c8 = i & 15; const bf16* pr = P + (m0 + s) * PW + h * 128 + c8 * 8;
                        *(LAS u32x4*)(VP + s * 152 + c8 * 8) = *(const u32x4*)(pr + P_AV); *(LAS u32x4*)(AOT + s * 136 + c8 * 8) = *(const u32x4*)(pr + P_AO); }
                    if (tid < 64) { *(LAS u32x4*)(VP + tid * 152 + 128) = uone4(); *(LAS u32x4*)(VP + tid * 152 + 136) = uzero4(); }
                    for (int i = tid; i < 1152; i += NTHR) { const int dv = i >> 3, c8 = i & 7; *(LAS u32x4*)(CST + dv * 72 + c8 * 8) = *(const u32x4*)(CS + (size_t)ua * 9216 + dv * 64 + c8 * 8); }
                    if (tid < 192) { const int arr = tid >> 6, s = tid & 63; const float* src = (arr == 0) ? GBc : (arr == 1) ? GGc : GMT; float v = src[(m0 + s) * 4 + h];
                        if (arr == 2) v = GBc[(m0 + s) * 4 + h] + fmaxf(mcar, v);
                        GS[arr * 64 + s] = v; }
                    __syncthreads();
#pragma unroll
                    for (int q2 = 0; q2 < 2; ++q2) { const int ti = 2 * wave + q2, tt = ti >> 2, st = ti & 3;
                        f32x4 acc = zero4();
                        if (st <= tt) {
#pragma unroll
                            for (int ks = 0; ks < 2; ++ks) acc = MFMA16(frag_kc(Qs, 72, 16 * tt, 32 * ks, lane), frag_kc(Ks, 72, 16 * st, 32 * ks, lane), acc);
                            const int s = 16 * st + r; const float gs = GS[64 + s];
#pragma unroll
                            for (int i = 0; i < 4; ++i) { const int t = 16 * tt + 4 * g4 + i; const float e = GS[t] - GS[128 + t] + gs;
                                acc[i] = (s <= t) ? acc[i] * 0.125f * __expf(e) : 0.f; }
                        }
                        *(LAS u32x2*)(SMT + (16 * st + r) * 72 + 16 * tt + 4 * g4) = (u32x2){pk2(acc[0], acc[1]), pk2(acc[2], acc[3])}; }
                    __syncthreads();
                    const int tt = wave & 3, half = wave >> 2;
                    f32x4 a1[5], a2[5];
#pragma unroll
                    for (int j = 0; j < 5; ++j) { a1[j] = zero4(); a2[j] = zero4(); }
#pragma unroll
                    for (int ks = 0; ks < 2; ++ks) { const bf16x8 fa1 = frag_ks(SMT, 72, 16 * tt, 32 * ks, lane), fa2 = frag_kc(Qs, 72, 16 * tt, 32 * ks, lane);
#pragma unroll
                        for (int j = 0; j < 5; ++j) { const int dvt = (j < 4) ? half * 4 + j : 8;
                            a1[j] = MFMA16(fa1, frag_ks(VP, 152, 16 * dvt, 32 * ks, lane), a1[j]);
                            a2[j] = MFMA16(fa2, frag_kc(CST, 72, 16 * dvt, 32 * ks, lane), a2[j]); } }
                    float hv[4][4], ssq[4];
#pragma unroll
                    for (int i = 0; i < 4; ++i) { const int t = 16 * tt + 4 * g4 + i; const float b = GS[t], mt = GS[128 + t];
                        const float is = 0.125f * __expf(b + mcar - mt);
                        float den = a1[4][i] + is * a2[4][i]; den = __shfl(den, lane & 48);
                        const float dn = __builtin_amdgcn_rcpf(fmaxf(fabsf(den), __expf(-mt))); float q = 0.f;
#pragma unroll
                        for (int j = 0; j < 4; ++j) { const float v = (a1[j][i] + is * a2[j][i]) * dn; hv[j][i] = v; q += v * v; }
                        q += __shfl_xor(q, 1); q += __shfl_xor(q, 2); q += __shfl_xor(q, 4); q += __shfl_xor(q, 8); ssq[i] = q; }
                    if (r == 0) {
#pragma unroll
                        for (int i = 0; i < 4; ++i) SSQ[half * 64 + 16 * tt + 4 * g4 + i] = ssq[i]; }
                    __syncthreads();
                    const float* ng = ka->in[I_ANG] + (size_t)l * 512 + h * 128;
#pragma unroll
                    for (int i = 0; i < 4; ++i) { const int t = 16 * tt + 4 * g4 + i; const float rstd = rsqrtf((SSQ[t] + SSQ[64 + t]) * (1.f / 128.f) + EPS);
#pragma unroll
                        for (int j = 0; j < 4; ++j) { const int dv = 16 * (half * 4 + j) + r; LAS bf16* op = AOT + t * 136 + dv;
                            *op = (bf16)f2bf(sigmoidf_(bf2f(*op)) * hv[j][i] * rstd * ng[dv]); } }
                    __syncthreads();
                    for (int i = tid; i < 1024; i += NTHR) { const int s = i >> 4, c8 = i & 15; *(u32x4*)(YCAT + (m0 + s) * YW + h * 128 + c8 * 8) = *(const LAS u32x4*)(AOT + s * 136 + c8 * 8); }
                    __syncthreads();
                } else {
                    const int uc2 = u - NUA, bl = uc2 >> 6, c = (uc2 >> 1) & 31, gi = uc2 & 1, hl = wave & 3, th = wave >> 2, hd = gi * 4 + hl; const size_t m0 = (size_t)bl * SEQ + c * 64;
                    LAS bf16* XHs = (LAS bf16*)lds;
                    LAS bf16* HTs = (LAS bf16*)(lds + 36864);
                    LAS bf16* BMg = (LAS bf16*)(lds + 36864 + 69632);
                    LAS bf16* MTt = (LAS bf16*)(lds + 36864 + 69632 + 17408 + wave * 3072);
                    LAS float* ADs = (LAS float*)(lds + 36864 + 69632 + 17408 + 24576);
                    const bf16* Xb = XBC + m0 * 1024;
                    for (int i = tid; i < 2048; i += NTHR) { const int h4 = i >> 9, rem = i & 511, s = rem >> 3, c8 = rem & 7;
                        *(LAS u32x4*)(XHs + h4 * (64 * 72) + s * 72 + c8 * 8) = *(const u32x4*)((Xb + gi * 256) + (unsigned)(s * 1024 + h4 * 64 + c8 * 8)); }
                    { const bf16* Hb = HS + (size_t)((bl * NCH + c) * 8 + gi * 4) * 8192;
                      for (int i = tid; i < 4096; i += NTHR) { const int h4 = i >> 10, rem = i & 1023, p = rem >> 4, c8 = rem & 15;
                        *(LAS u32x4*)(HTs + h4 * (64 * 136) + p * 136 + c8 * 8) = *(const u32x4*)(Hb + (unsigned)(h4 * 8192 + p * 128 + c8 * 8)); } }
                    for (int i = tid; i < 1024; i += NTHR) { const int s = i >> 4, c8 = i & 15; *(LAS u32x4*)(BMg + s * 136 + c8 * 8) = *(const u32x4*)((Xb + 512 + gi * 128) + (unsigned)(s * 1024 + c8 * 8)); }
                    { const int h4 = tid >> 7, arr = (tid >> 6) & 1, s = tid & 63; const float* src = arr ? DTB : ACB; ADs[tid] = (src + m0 * 8 + gi * 4)[(unsigned)(s * 8 + h4)]; }
                    const LAS bf16* XH = XHs + hl * (64 * 72); const LAS bf16* HT = HTs + hl * (64 * 136); const LAS float* AD = ADs + hl * 128;
                    const bf16* Cm = Xb + 768 + gi * 128; const bf16* Zp = P + m0 * PW + P_CZ + hd * 64; const unsigned zlane = (unsigned)(4 * g4 * PW + r), ylane = (unsigned)(4 * g4 * YW + r);
                    bf16* Yp = YCAT + m0 * YW + 1024 + hd * 64; float* Sp = SSQC + m0 * 8 + hd;
                    bf16x8 fcn[4];
#pragma unroll
                    for (int ks = 0; ks < 4; ++ks) fcn[ks] = gfrag_kc(Cm, 1024, 16 * th, 32 * ks, lane);
                    const float dsk = ka->in[I_CDSKIP][l * 8 + hd];
                    __syncthreads();
#pragma unroll 1
                    for (int k2 = 0; k2 < 2; ++k2) { const int tt = k2 ? 3 - th : th;
                        bf16x8 fcm[4]; unsigned short zc[4][4];
#pragma unroll
                        for (int ks = 0; ks < 4; ++ks) fcm[ks] = fcn[ks];
#pragma unroll
                        for (int p = 0; p < 4; ++p)
#pragma unroll
                            for (int i = 0; i < 4; ++i) zc[p][i] = (Zp + (size_t)(16 * tt + i) * PW + 16 * p)[zlane];
#pragma unroll
                        for (int ks = 0; ks < 4; ++ks) fcn[ks] = gfrag_kc(Cm, 1024, 16 * (3 - th), 32 * ks, lane);
                        float at[4];
#pragma unroll
                        for (int i = 0; i < 4; ++i) at[i] = AD[16 * tt + 4 * g4 + i];
#pragma unroll 1
                        for (int st = 0; st <= tt; ++st) { f32x4 acc = zero4();
#pragma unroll
                            for (int ks = 0; ks < 4; ++ks) acc = MFMA16(fcm[ks], frag_kc(BMg, 136, 16 * st, 32 * ks, lane), acc);
                            const int s = 16 * st + r; const float as = AD[s], dts = AD[64 + s];
#pragma unroll
                            for (int i = 0; i < 4; ++i) { const int t = 16 * tt + 4 * g4 + i; acc[i] = (s <= t) ? acc[i] * __expf(at[i] - as) * dts : 0.f; if (s == t) acc[i] += dsk; }
                            *(LAS u32x2*)(MTt + (16 * st + r) * 24 + 4 * g4) = (u32x2){pk2(acc[0], acc[1]), pk2(acc[2], acc[3])}; }
                        if ((tt & 1) == 0) *(LAS u32x2*)(MTt + (16 * (tt + 1) + r) * 24 + 4 * g4) = (u32x2){uzero4().x, uzero4().y};
                        LDS_WAIT(); asm volatile("" ::: "memory");
                        f32x4 ad[4], ao[4];
#pragma unroll
                        for (int p = 0; p < 4; ++p) { ad[p] = zero4(); ao[p] = zero4(); }
#pragma unroll 1
                        for (int ks = 0; ks <= (tt >> 1); ++ks) { const bf16x8 fa = frag_ks(MTt, 24, 0, 32 * ks, lane);
#pragma unroll
                            for (int p = 0; p < 4; ++p) ad[p] = MFMA16(fa, frag_ks(XH, 72, 16 * p, 32 * ks, lane), ad[p]); }
#pragma unroll
                        for (int ks = 0; ks < 4; ++ks)
#pragma unroll
                            for (int p = 0; p < 4; ++p) ao[p] = MFMA16(fcm[ks], frag_kc(HT, 136, 16 * p, 32 * ks, lane), ao[p]);
#pragma unroll
                        for (int i = 0; i < 4; ++i) { const float ea = __expf(at[i]); float q = 0.f;
#pragma unroll
                            for (int p = 0; p < 4; ++p) { const float y = (ad[p][i] + ea * ao[p][i]) * siluf_(bf2f(zc[p][i])); q += y * y;
                                (Yp + (size_t)(16 * tt + i) * YW + 16 * p)[ylane] = (bf16)f2bf(y); }
                            q += __shfl_xor(q, 1); q += __shfl_xor(q, 2); q += __shfl_xor(q, 4); q += __shfl_xor(q, 8);
                            if (r == 0) (Sp + (16 * tt + i) * 8)[(unsigned)(32 * g4)] = q; }
                        LDS_WAIT(); asm volatile("" ::: "memory");
                    }
                    __syncthreads();
                }
            }
            GRID_BAR();
        }

        REPS(PH_LIFT) if (IN(PH_LIFT)) {
            PHASE_BEGIN();
            pg8::Gemm g{YCAT, WliftT, 512, YW, 512, (size_t)512 * 2, (size_t)DM * 512 * 2}; pg8::Order S; S.init(T, DM, NBLK, blk, 4);
            pg8::EpiLift E{P + P_G, PW, MB + (size_t)(grp & 1) * T * DM, DM, SSQC};
            pg8::gemm_phase<pg8::EpiLift, GEMM_ALIGN>(lds, g, S, E);
            GRID_BAR();
        }
        REPS(PH_OUT) if (IN(PH_OUT) && (grp & 1)) {
            PHASE_BEGIN();
            const size_t prow0 = grow0 - T;
            pg8::Gemm g{MB, WoutT, DM, DM, DM, 0, 0}; pg8::Order S; S.init(2 * T, DM, NBLK, blk, 1);
            pg8::EpiResid E{XG + prow0 * DM, DM, SSQ2};
            pg8::gemm_phase<pg8::EpiResid, GEMM_ALIGN>(lds, g, S, E);
            GRID_BAR();
        }
        REPS(PH_UP) if (IN(PH_UP) && (grp & 1)) {
            PHASE_BEGIN();
            const size_t prow0 = grow0 - T;
            pg8::Gemm g{XG + prow0 * DM, WupT, DM, DM, DM, 0, 0}; pg8::Order S; S.init(2 * T, DFF2, NBLK, blk, 1);
            pg8::EpiConvAct E{ACT, SSQ2, ka->in[I_FCW] + (size_t)l * 3 * DFF2, ka->in[I_FCB] + (size_t)l * DFF2, RAWH, lds + 131072, DFF2 / 256};
            pg8::gemm_phase<pg8::EpiConvAct, GEMM_ALIGN>(lds, g, S, E);
            GRID_BAR();
        }
        REPS(PH_DOWN) if (IN(PH_DOWN) && (grp & 1)) {
            PHASE_BEGIN();
            const size_t prow0 = grow0 - T;
            pg8::Gemm g{ACT, WdownT, DFF, DFF, DFF, 0, 0}; pg8::Order S; S.init(2 * T, DM, NBLK, blk, 1);
            {
                const float* fw = ka->in[I_FCW] + (size_t)l * 3 * DFF2; const float* fb = ka->in[I_FCB] + (size_t)l * DFF2;
                pg8::Unit uu;
                for (int i = 0; S.next(i, uu); ++i) { const int pm = uu.pm; if ((pm & 7) == 0) continue;
                    for (int ch = tid; ch < DFF; ch += NTHR) { const int tp = ch >> 7, j = ch & 127;
                        const float* own = RAWH + (size_t)(pm * 22 + tp) * 1024; const float* prv = RAWH + (size_t)((pm - 1) * 22 + tp) * 1024;
                        const float g254 = prv[2 * 256 + j], g255 = prv[3 * 256 + j], g0 = own[j], g1 = own[256 + j];
                        const float u254 = prv[2 * 256 + 128 + j], u255 = prv[3 * 256 + 128 + j], u0 = own[128 + j], u1 = own[256 + 128 + j];
                        const float wg0 = fw[ch], wg1 = fw[DFF2 + ch], wg2 = fw[2 * DFF2 + ch], wu0 = fw[DFF + ch], wu1 = fw[DFF2 + DFF + ch], wu2 = fw[2 * DFF2 + DFF + ch], bg = fb[ch], bu = fb[DFF + ch];
                        ACT[(size_t)(pm * 256) * DFF + ch] = (bf16)f2bf(siluf_(bg + wg0 * g254 + wg1 * g255 + wg2 * g0) * (bu + wu0 * u254 + wu1 * u255 + wu2 * u0));
                        ACT[(size_t)(pm * 256 + 1) * DFF + ch] = (bf16)f2bf(siluf_(bg + wg0 * g255 + wg1 * g0 + wg2 * g1) * (bu + wu0 * u255 + wu1 * u0 + wu2 * u1)); } }
                asm volatile("s_waitcnt vmcnt(0)" ::: "memory"); __syncthreads();
            }
            pg8::EpiResid E{XG + prow0 * DM, DM, SSQ1 + prow0 * 16};
            pg8::gemm_phase<pg8::EpiResid, GEMM_ALIGN>(lds, g, S, E);
            GRID_BAR();
        }
        REPS(PH_FINAL) if (IN(PH_FINAL) && l == DEPTH - 1 && (grp & 1)) {
            PHASE_BEGIN();
            const size_t prow0 = grow0 - T;
            const float* gain = ka->in[I_FING];
            f32x4 gv[4];
#pragma unroll
            for (int j = 0; j < 4; ++j) gv[j] = ((const f32x4*)gain)[lane + 64 * j];
            for (int m = gw; m < 2 * T; m += NGW) {
                const u32x2* xr = (const u32x2*)(XG + (prow0 + m) * DM) + lane;
                f32x4 v[4]; float sq = 0.f;
#pragma unroll
                for (int j = 0; j < 4; ++j) { const u32x2 w = xr[64 * j]; v[j] = (f32x4){bf2f(w.x & 0xffffu), bf2f(w.x >> 16), bf2f(w.y & 0xffffu), bf2f(w.y >> 16)};
                    sq += (v[j].x * v[j].x + v[j].y * v[j].y) + (v[j].z * v[j].z + v[j].w * v[j].w); }
                const float rstd = rsqrtf(wave_sum(sq) * (1.f / DM) + EPS);
                f32x4* orow = (f32x4*)(ka->out + (prow0 + m) * DM) + lane;
#pragma unroll
                for (int j = 0; j < 4; ++j) orow[64 * j] = v[j] * rstd * gv[j];
            }
            GRID_BAR();
        }
    }
#undef IN
#undef GRID_BAR
#undef PHASE_BEGIN
}

#ifndef ONE_LAUNCH
#define ONE_LAUNCH 1
#endif
extern "C" void kernel_launch(void* const* d_in, const int* in_sizes, int n_in, void* d_out, int out_size, void* d_ws, size_t ws_size, hipStream_t stream) {
    static int grid = 0;
    if (grid == 0) {
        if (n_in != N_IN || in_sizes[0] != BATCH * SEQ * DM || out_size != BATCH * SEQ * DM || ws_size < WS_END) {
            fprintf(stderr, "kernel_launch: unexpected shapes / workspace (n_in %d, ws %zu, need %zu); nothing launched\n", n_in, ws_size, (size_t)WS_END); grid = -1; return; }
        int dev = 0, cus = 0, per_cu = 0;
        if (hipGetDevice(&dev) != hipSuccess || hipDeviceGetAttribute(&cus, hipDeviceAttributeMultiprocessorCount, dev) != hipSuccess) { grid = -1; return; }
        if (hipFuncSetAttribute((const void*)fwd, hipFuncAttributeMaxDynamicSharedMemorySize, LDS_BYTES) != hipSuccess) { fprintf(stderr, "kernel_launch: hipFuncSetAttribute failed\n"); grid = -1; return; }
        if (hipOccupancyMaxActiveBlocksPerMultiprocessor(&per_cu, (const void*)fwd, NTHR, LDS_BYTES) != hipSuccess || per_cu < 1) { fprintf(stderr, "kernel_launch: occupancy query says %d\n", per_cu); (void)hipGetLastError(); }
        grid = cus;
    }
    if (grid < 0) return;
    (void)hipMemsetAsync((char*)d_ws + WS_CTL, 0, CTL_BYTES, stream);
    Args a{};
    for (int i = 0; i < N_IN; ++i) a.in[i] = (const float*)d_in[i];
    a.out = (float*)d_out; a.ws = (unsigned char*)d_ws; a.pad = 0;
#if ONE_LAUNCH
    a.l_lo = 0; a.l_hi = DEPTH; a.g_lo = 0; a.g_hi = NG; a.ph_lo = 0; a.ph_hi = PH_COUNT; a.use_bar = 1;
    hipLaunchKernelGGL(fwd, dim3(grid), dim3(NTHR), LDS_BYTES, stream, a);
#else
    a.use_bar = 0;
    for (int l = 0; l < DEPTH; ++l)
        for (int g = 0; g < NG; ++g)
            for (int ph = 0; ph < PH_COUNT; ++ph) {
                if (ph == PH_W && g != 0) continue;
                if (ph == PH_FINAL && l != DEPTH - 1) continue;
                if ((ph == PH_OUT || ph == PH_UP || ph == PH_DOWN || ph == PH_FINAL) && !(g & 1)) continue;
                a.l_lo = l; a.l_hi = l + 1; a.g_lo = g; a.g_hi = g + 1; a.ph_lo = ph; a.ph_hi = ph + 1;
                hipLaunchKernelGGL(fwd, dim3(grid), dim3(NTHR), LDS_BYTES, stream, a);
            }
#endif
}
```

```cpp
#include <hip/hip_runtime.h>
#include <cstdio>
#include <cstdint>

#define LAS __attribute__((address_space(3)))
#define GAS __attribute__((address_space(1)))
typedef unsigned short bf16;
typedef short bf16x8 __attribute__((ext_vector_type(8)));
typedef short s16x4 __attribute__((ext_vector_type(4)));
typedef float f32x4 __attribute__((ext_vector_type(4)));
typedef float f32x2 __attribute__((ext_vector_type(2)));
typedef unsigned u32x4 __attribute__((ext_vector_type(4)));
typedef unsigned u32x2 __attribute__((ext_vector_type(2)));

constexpr int DM = 1024, BATCH = 32, SEQ = 2048, DEPTH = 4;
constexpr int PIN = 10256, PW = 10240, DFF = 2816, DFF2 = 5632;
constexpr int GB = 8;
constexpr int NG = BATCH / GB;
constexpr int T = GB * SEQ;
constexpr int NCH = SEQ / 64;
constexpr float EPS = 1e-6f;
constexpr int P_AQ = 0, P_AK = 256, P_AV = 512, P_AO = 1024, P_BB = 1536, P_BC = 2048, P_BX = 2560, P_CZ = 3072, P_CX = 3584, P_SQ = 4608, P_SK = 5120, P_SV = 5632, P_G = 6144;
constexpr int YW = 2048;

constexpr size_t MiB = 1u << 20;
constexpr size_t WS_CTL = 0, CTL_BYTES = 1 * MiB;
constexpr size_t WS_WIN = 1 * MiB;
constexpr size_t WS_WLIFT = WS_WIN + (size_t)PW * DM * 2;
constexpr size_t WS_WOUT = WS_WLIFT + (size_t)4 * DM * 512 * 2;
constexpr size_t WS_WUP = WS_WOUT + (size_t)DM * DM * 2;
constexpr size_t WS_WDOWN = WS_WUP + (size_t)DFF2 * DM * 2;
constexpr size_t WS_W16 = WS_WDOWN + (size_t)DM * DFF * 2;
constexpr size_t WS_XN = WS_W16 + 65536;
constexpr size_t WS_P = WS_XN + (size_t)T * DM * 2;
constexpr size_t WS_U = WS_P, WS_ACT = WS_P;
constexpr size_t WS_YCAT = WS_P + (size_t)T * PW * 2;
constexpr size_t WS_XG = WS_YCAT + (size_t)T * YW * 2;
constexpr size_t WS_MB = WS_XG + (size_t)BATCH * SEQ * DM * 2;
constexpr size_t WS_SP = WS_MB + (size_t)2 * T * DM * 2;
constexpr size_t WS_GB = WS_SP + (size_t)T * 16 * 4;
constexpr size_t WS_GG = WS_GB + (size_t)T * 16;
constexpr size_t WS_GMT = WS_GG + (size_t)T * 16;
constexpr size_t WS_MCAR = WS_GMT + (size_t)T * 16;
constexpr size_t WS_MNEW = WS_MCAR + 4096;
constexpr size_t WS_MSC = WS_MNEW + 4096;
constexpr size_t WS_SUMB = WS_MSC + 4096, WS_SUMG = WS_SUMB + 4096;
constexpr size_t WS_DT = WS_SUMG + 4096;
constexpr size_t WS_AC = WS_DT + (size_t)T * 32;
constexpr size_t WS_XBC = WS_AC + (size_t)T * 32;
constexpr size_t WS_DC = WS_XBC + (size_t)T * DM * 2;
constexpr size_t WS_CS = WS_DC + (size_t)GB * 4 * NCH * 9216 * 4;
constexpr size_t WS_DH = WS_CS + (size_t)GB * 4 * NCH * 9216 * 2;
constexpr size_t WS_HS = WS_DH + (size_t)GB * NCH * 8 * 8192 * 4;
constexpr size_t WS_SSQ1 = WS_HS + (size_t)GB * NCH * 8 * 8192 * 2;
constexpr size_t WS_SSQ2 = WS_SSQ1 + (size_t)BATCH * SEQ * 64;
constexpr size_t WS_SSQC = WS_SSQ2 + (size_t)2 * T * 64;
constexpr size_t WS_RAWH = WS_SSQC + (size_t)T * 32;
constexpr size_t WS_END = WS_RAWH + (size_t)(2 * T / 256) * 22 * 4 * 256 * 4;

constexpr int NWAVES = 8, NTHR = 512;
constexpr int LDS_BYTES = 155648;
constexpr int MISC_OFF = 153600;

__device__ __forceinline__ float bf2f(unsigned b) { return __uint_as_float(b << 16); }
__device__ __forceinline__ unsigned f2bf(float f) { unsigned u = __float_as_uint(f); return (u + 0x7fffu + ((u >> 16) & 1u)) >> 16; }
__device__ __forceinline__ unsigned pk2(float lo, float hi) { return f2bf(lo) | (f2bf(hi) << 16); }
__device__ __forceinline__ float sigmoidf_(float x) { return __builtin_amdgcn_rcpf(1.f + __builtin_amdgcn_exp2f(-1.4426950408889634f * x)); }
__device__ __forceinline__ float siluf_(float x) { return x * __builtin_amdgcn_rcpf(1.f + __builtin_amdgcn_exp2f(-1.4426950408889634f * x)); }
__device__ __forceinline__ float logsigf_(float x) { return fminf(x, 0.f) - log1pf(expf(-fabsf(x))); }
__device__ __forceinline__ float softplusf_(float x) { return fmaxf(x, 0.f) + log1pf(expf(-fabsf(x))); }
__device__ __forceinline__ float wave_sum(float v) {
#pragma unroll
    for (int o = 1; o < 64; o <<= 1) v += __shfl_xor(v, o);
    return v;
}
#define LDS_WAIT() asm volatile("s_waitcnt lgkmcnt(0)" ::: "memory")
__device__ __forceinline__ float row_rstd(const float* ssq16) {
    const f32x4* p = (const f32x4*)ssq16; const f32x4 a = (p[0] + p[1]) + (p[2] + p[3]);
    return rsqrtf(((a.x + a.y) + (a.z + a.w)) * (1.f / 1024.f) + 1e-6f);
}

namespace pg8 {
constexpr int BM = 256, BK = 64, HALF = 128, HTB = HALF * BK * 2, STAGE_BYTES = 8 * HTB, NXCD = 8, WGM = 8;
__host__ __device__ __forceinline__ int lds_byte(int r, int c) { const int st = (r >> 4) * 2 + (c >> 5), rr = r & 15, cc = c & 31, ob = rr * 64 + cc * 2; return st * 1024 + (ob ^ (((ob >> 9) & 1) << 5)); }
__host__ __device__ __forceinline__ void stage_rc(int b, int& R, int& C) { const int st = b / 1024, sb = b % 1024, swz = sb ^ (((sb >> 9) & 1) << 5); R = (st >> 1) * 16 + swz / 64; C = (st & 1) * 32 + (swz % 64) / 2; }
__host__ __device__ __forceinline__ int perm32(int rho) { const int n = rho >> 4, i = rho & 15; return 8 * (i >> 2) + 4 * n + (i & 3); }

struct Unit { int pm, pn, z; };
struct Gemm { const bf16* A; const bf16* Bt; int K, lda, ldb; size_t zA, zB; };

struct Order {
    int nM, nN, nwg, G, c, Z;
    __device__ __forceinline__ void init(int M, int N, int G_, int c_, int Z_) { nM = M / BM; nN = N / BM; nwg = nM * nN; G = G_; c = c_; Z = Z_; }
    __device__ __forceinline__ bool next(int i, Unit& u) const {
        const int ti = i / Z; u.z = i - ti * Z;
        const long L = (long)ti * G + c; if (L >= nwg) return false;
        int wgid = (int)L; { const int q = nwg / NXCD, r = nwg % NXCD, xcd = wgid % NXCD, off = wgid / NXCD; wgid = (xcd < r ? xcd * (q + 1) : r * (q + 1) + (xcd - r) * q) + off; }
        const int nig = WGM * nN, gid = wgid / nig, fm = gid * WGM, gsz = (nM - fm) < WGM ? (nM - fm) : WGM;
        u.pm = fm + ((wgid % nig) % gsz); u.pn = (wgid % nig) / gsz; return true;
    }
};
__device__ __forceinline__ unsigned cvt_pk_bf16(float lo, float hi) { unsigned r; asm volatile("s_nop 0\n\tv_cvt_pk_bf16_f32 %0, %1, %2" : "=v"(r) : "v"(lo), "v"(hi)); return r; }

struct EpiBf16 {
    static constexpr bool PERM = true, KEEP = false, CONTIG = true;
    bf16* O; int ldc; const float* ssq; int gate_pn0;
    static __device__ __forceinline__ float s1(float x) { return 1.f + __builtin_amdgcn_exp2f(-1.4426950408889634f * __builtin_amdgcn_fmed3f(x, -30.f, 30.f)); }
    __device__ __forceinline__ void operator()(f32x4 (&acc)[2][2][4][2], const Unit& u, int wr, int wc, int fr, int fq) const {
        if (u.pn >= gate_pn0) {
            const int row0g = u.pm * BM + wr * 64 + fr, d0 = 64 * (u.pn - gate_pn0) + 16 * wc + 4 * fq;
#pragma unroll
            for (int ai = 0; ai < 2; ++ai)
#pragma unroll
                for (int m = 0; m < 4; ++m) { const int row = row0g + ai * HALF + m * 16; bf16* rowp = O + (size_t)row * ldc + gate_pn0 * BM + d0;
                    float sq; { const f32x4 p = *(const f32x4*)(ssq + (size_t)row * 16 + 4 * fq); sq = (p.x + p.y) + (p.z + p.w); }
                    sq += __shfl_xor(sq, 16); sq += __shfl_xor(sq, 32);
                    const float rs = rsqrtf(sq * (1.f / 1024.f) + 1e-6f);
                    float one = 1.f; asm volatile("" : "+v"(one));
                    float f0[4], f1[4], f2[4], f3[4];
#pragma unroll
                    for (int e = 0; e < 4; ++e) { const float a0 = s1(acc[ai][0][m][0][e] * rs), a1 = s1(acc[ai][0][m][1][e] * rs), a2 = s1(acc[ai][1][m][0][e] * rs), a3 = s1(acc[ai][1][m][1][e] * rs);
                        f0[e] = a1 * __builtin_amdgcn_rcpf(a0); f1[e] = a2 * __builtin_amdgcn_rcpf(a1); f2[e] = a3 * __builtin_amdgcn_rcpf(a2); f3[e] = one * __builtin_amdgcn_rcpf(a3); }
                    *(u32x2*)(rowp) = (u32x2){cvt_pk_bf16(f0[0], f0[1]), cvt_pk_bf16(f0[2], f0[3])};
                    *(u32x2*)(rowp + 1024) = (u32x2){cvt_pk_bf16(f1[0], f1[1]), cvt_pk_bf16(f1[2], f1[3])};
                    *(u32x2*)(rowp + 2048) = (u32x2){cvt_pk_bf16(f2[0], f2[1]), cvt_pk_bf16(f2[2], f2[3])};
                    *(u32x2*)(rowp + 3072) = (u32x2){cvt_pk_bf16(f3[0], f3[1]), cvt_pk_bf16(f3[2], f3[3])}; }
            return; }
        const int row0 = u.pm * BM + wr * 64 + fr, col0 = u.pn * BM + wc * 64 + 8 * fq;
#pragma unroll
        for (int ai = 0; ai < 2; ++ai)
#pragma unroll
            for (int m = 0; m < 4; ++m) { const int row = row0 + ai * HALF + m * 16; bf16* rowp = O + (size_t)row * ldc + col0;
                float sq; { const f32x4 p = *(const f32x4*)(ssq + (size_t)row * 16 + 4 * fq); sq = (p.x + p.y) + (p.z + p.w); }
                sq += __shfl_xor(sq, 16); sq += __shfl_xor(sq, 32);
                const float rs = rsqrtf(sq * (1.f / 1024.f) + 1e-6f);
#pragma unroll
                for (int bj = 0; bj < 2; ++bj) { const f32x4 v0 = acc[ai][bj][m][0] * rs, v1 = acc[ai][bj][m][1] * rs;
                    u32x4 w; w.x = cvt_pk_bf16(v0[0], v0[1]); w.y = cvt_pk_bf16(v0[2], v0[3]); w.z = cvt_pk_bf16(v1[0], v1[1]); w.w = cvt_pk_bf16(v1[2], v1[3]);
                    *(u32x4*)(rowp + bj * 32) = w; } }
    }
};
struct EpiResid {
    static constexpr bool PERM = true, KEEP = false, CONTIG = true;
    bf16* xb; int ldc; float* ssq;
    __device__ __forceinline__ void operator()(f32x4 (&acc)[2][2][4][2], const Unit& u, int wr, int wc, int fr, int fq) const {
        const int row0 = u.pm * BM + wr * 64 + fr, col0 = u.pn * BM + wc * 64 + 8 * fq;
#pragma unroll
        for (int ai = 0; ai < 2; ++ai)
#pragma unroll
            for (int m = 0; m < 4; ++m) { const int row = row0 + ai * HALF + m * 16; const size_t off = (size_t)row * ldc + col0; float q = 0.f;
#pragma unroll
                for (int bj = 0; bj < 2; ++bj) {
                    const u32x4 o = *(const u32x4*)(xb + off + bj * 32);
                    const f32x4 x0 = (f32x4){bf2f(o.x & 0xffffu), bf2f(o.x >> 16), bf2f(o.y & 0xffffu), bf2f(o.y >> 16)} + acc[ai][bj][m][0];
                    const f32x4 x1 = (f32x4){bf2f(o.z & 0xffffu), bf2f(o.z >> 16), bf2f(o.w & 0xffffu), bf2f(o.w >> 16)} + acc[ai][bj][m][1];
                    q += (x0[0] * x0[0] + x0[1] * x0[1]) + (x0[2] * x0[2] + x0[3] * x0[3]) + (x1[0] * x1[0] + x1[1] * x1[1]) + (x1[2] * x1[2] + x1[3] * x1[3]);
                    u32x4 w; w.x = cvt_pk_bf16(x0[0], x0[1]); w.y = cvt_pk_bf16(x0[2], x0[3]); w.z = cvt_pk_bf16(x1[0], x1[1]); w.w = cvt_pk_bf16(x1[2], x1[3]);
                    *(u32x4*)(xb + off + bj * 32) = w; }
                q += __shfl_xor(q, 16); q += __shfl_xor(q, 32); if (fq == 0) ssq[(size_t)row * 16 + u.pn * 4 + wc] = q;
            }
    }
};
struct EpiLift {
    static constexpr bool PERM = true, KEEP = true, CONTIG = false;
    const bf16* fac; int ldg; bf16* mb; int ldc; const float* ssqc;
    __device__ __forceinline__ void operator()(f32x4 (&acc)[2][2][4][2], const Unit& u, int wr, int wc, int fr, int fq) const {
        const int row0 = u.pm * BM + wr * 64 + fr, col0 = u.pn * BM + wc * 32 + 8 * fq;
#pragma unroll
        for (int ai = 0; ai < 2; ++ai)
#pragma unroll
            for (int m = 0; m < 4; ++m) { const int row = row0 + ai * HALF + m * 16;
                float rsc = 1.f;
                if (u.z == 1 || u.z == 2) { const f32x2 p = *(const f32x2*)(ssqc + (size_t)row * 8 + 2 * fq); float sq = p.x + p.y; sq += __shfl_xor(sq, 16); sq += __shfl_xor(sq, 32);
                    const float v = sq * (1.f / 512.f) + 1e-6f; rsc = (u.z == 1) ? sqrtf(v) : rsqrtf(v); }
#pragma unroll
                for (int bj = 0; bj < 2; ++bj) { const int col = col0 + bj * HALF;
                    const u32x4 g0 = *(const u32x4*)(fac + (size_t)row * ldg + u.z * 1024 + col);
                    f32x4& v0 = acc[ai][bj][m][0]; f32x4& v1 = acc[ai][bj][m][1];
                    v0[0] *= rsc * bf2f(g0.x & 0xffffu); v0[1] *= rsc * bf2f(g0.x >> 16); v0[2] *= rsc * bf2f(g0.y & 0xffffu); v0[3] *= rsc * bf2f(g0.y >> 16);
                    v1[0] *= rsc * bf2f(g0.z & 0xffffu); v1[1] *= rsc * bf2f(g0.z >> 16); v1[2] *= rsc * bf2f(g0.w & 0xffffu); v1[3] *= rsc * bf2f(g0.w >> 16);
                    if (u.z == 3) { u32x4 w; w.x = cvt_pk_bf16(v0[0], v0[1]); w.y = cvt_pk_bf16(v0[2], v0[3]); w.z = cvt_pk_bf16(v1[0], v1[1]); w.w = cvt_pk_bf16(v1[2], v1[3]);
                        *(u32x4*)(mb + (size_t)row * ldc + col) = w; } } }
    }
};

__device__ __forceinline__ float dpp_ror1(float x) { return __int_as_float(__builtin_amdgcn_update_dpp(0, __float_as_int(x), 0x121, 0xf, 0xf, false)); }
__device__ __forceinline__ float dpp_ror2(float x) { return __int_as_float(__builtin_amdgcn_update_dpp(0, __float_as_int(x), 0x122, 0xf, 0xf, false)); }
__device__ __forceinline__ float dpp_prev1(float cur, float prev) { return __int_as_float(__builtin_amdgcn_update_dpp(__builtin_amdgcn_update_dpp(0, __float_as_int(prev), 0x121, 0xf, 0xf, false), __float_as_int(cur), 0x111, 0xf, 0xf, false)); }
__device__ __forceinline__ float dpp_prev2(float cur, float prev) { return __int_as_float(__builtin_amdgcn_update_dpp(__builtin_amdgcn_update_dpp(0, __float_as_int(prev), 0x122, 0xf, 0xf, false), __float_as_int(cur), 0x112, 0xf, 0xf, false)); }
struct EpiConvAct {
    static constexpr bool PERM = true, KEEP = false, CONTIG = false;
    bf16* act; const float* ssq; const float* cw; const float* cb; float* rawh; LAS unsigned char* halo; int ntn;
    __device__ __forceinline__ void operator()(f32x4 (&acc)[2][2][4][2], const Unit& u, int wr, int wc, int fr, int fq) const {
        asm volatile("" : "+v"(fr), "+v"(fq));
        const int row0 = u.pm * BM + wr * 64 + fr, ch0 = u.pn * 128 + wc * 32 + 8 * fq;
#pragma unroll
        for (int ai = 0; ai < 2; ++ai)
#pragma unroll
            for (int m = 0; m < 4; ++m) { const int row = row0 + ai * HALF + m * 16;
                float sq; { const f32x4 p = *(const f32x4*)(ssq + (size_t)row * 16 + 4 * fq); sq = (p.x + p.y) + (p.z + p.w); }
                sq += __shfl_xor(sq, 16); sq += __shfl_xor(sq, 32);
                const float rs = rsqrtf(sq * (1.f / 1024.f) + 1e-6f);
#pragma unroll
                for (int bj = 0; bj < 2; ++bj) { acc[ai][bj][m][0] = acc[ai][bj][m][0] * rs; acc[ai][bj][m][1] = acc[ai][bj][m][1] * rs; } }
        LAS f32x4* H = (LAS f32x4*)halo;
        if (fr >= 14) {
#pragma unroll
            for (int ai = 0; ai < 2; ++ai) { const int b = 2 * ai + wr;
#pragma unroll
                for (int bj = 0; bj < 2; ++bj)
#pragma unroll
                    for (int n = 0; n < 2; ++n) H[((((b * 4 + wc) * 4 + fq) * 2 + (fr - 14)) * 2 + bj) * 2 + n] = acc[ai][bj][3][n]; } }
        { float* rw = rawh + (size_t)(u.pm * ntn + u.pn) * 1024;
          if (wr == 1 && fr >= 14) {
#pragma unroll
            for (int bj = 0; bj < 2; ++bj)
#pragma unroll
                for (int n = 0; n < 2; ++n) *(f32x4*)(rw + (2 + fr - 14) * 256 + bj * HALF + wc * 32 + 8 * fq + 4 * n) = acc[1][bj][3][n]; }
          if (wr == 0 && fr < 2) {
#pragma unroll
            for (int bj = 0; bj < 2; ++bj)
#pragma unroll
                for (int n = 0; n < 2; ++n) *(f32x4*)(rw + fr * 256 + bj * HALF + wc * 32 + 8 * fq + 4 * n) = acc[0][bj][0][n]; } }
        LAS float* WL = (LAS float*)(halo + 8192);
        { const int tidl = (wr * 4 + wc) * 64 + fq * 16 + fr, i2 = tidl * 2, kind = i2 >> 7, c = i2 & 127, k4 = kind & 3;
          const float* src = (k4 < 3 ? cw + k4 * 5632 : cb) + (kind >= 4 ? 2816 : 0) + u.pn * 128 + c;
          *(LAS f32x2*)(WL + i2) = *(const f32x2*)src; }
        asm volatile("s_waitcnt vmcnt(0) lgkmcnt(0)" ::: "memory"); __builtin_amdgcn_s_barrier(); asm volatile("" ::: "memory");
        bf16* actb = act + (size_t)(u.pm * BM + wr * 64) * 2816 + u.pn * 128 + wc * 32;
        const unsigned alane = (unsigned)(fr * 2816 + 8 * fq);
#pragma unroll
        for (int n = 0; n < 2; ++n) {
            unsigned half0[2][4];
#pragma unroll
            for (int eh = 0; eh < 2; ++eh) {
                const int cl = wc * 32 + 8 * fq + 4 * n + 2 * eh;
                f32x2 wg[3], wu[3], bg, bu;
#pragma unroll
                for (int j = 0; j < 3; ++j) { wg[j] = *(const LAS f32x2*)(WL + j * 128 + cl); wu[j] = *(const LAS f32x2*)(WL + (4 + j) * 128 + cl); }
                bg = *(const LAS f32x2*)(WL + 3 * 128 + cl); bu = *(const LAS f32x2*)(WL + 7 * 128 + cl);
#pragma unroll
                for (int ai = 0; ai < 2; ++ai) { const int b = 2 * ai + wr;
#pragma unroll
                    for (int m = 3; m >= 0; --m) {
                        float r2[2];
#pragma unroll
                        for (int e2 = 0; e2 < 2; ++e2) { const int e = 2 * eh + e2;
                            const float gc = acc[ai][0][m][n][e], uc = acc[ai][1][m][n][e];
                            float gp = 0.f, up = 0.f; asm volatile("" : "+v"(gp), "+v"(up));
                            if (m > 0) { gp = acc[ai][0][m - 1][n][e]; up = acc[ai][1][m - 1][n][e]; }
                            else if (b >= 1) { const int fk = fr >= 14 ? fr - 14 : 0; const LAS float* hp = (const LAS float*)(H + ((((b - 1) * 4 + wc) * 4 + fq) * 2 + fk) * 4 + n); gp = hp[e]; up = hp[8 + e]; }
                            const float g1 = dpp_prev1(gc, gp), g2 = dpp_prev2(gc, gp), u1 = dpp_prev1(uc, up), u2 = dpp_prev2(uc, up);
                            const float vg = bg[e2] + wg[0][e2] * g2 + wg[1][e2] * g1 + wg[2][e2] * gc;
                            const float vu = bu[e2] + wu[0][e2] * u2 + wu[1][e2] * u1 + wu[2][e2] * uc;
                            r2[e2] = siluf_(vg) * vu; }
                        const unsigned pk = cvt_pk_bf16(r2[0], r2[1]);
                        if (eh == 0) half0[ai][m] = pk;
                        else *(u32x2*)(actb + (size_t)(ai * HALF + m * 16) * 2816 + 4 * n + alane) = (u32x2){half0[ai][m], pk};
                    }
                }
            }
        }
    }
};

template <class Epi, bool ALIGN_EPI = true>
__device__ __forceinline__ void gemm_phase(LAS unsigned char* lds, const Gemm g, const Order& S, const Epi& E) {
    int tid = threadIdx.x; asm volatile("" : "+v"(tid));
    const int wid = __builtin_amdgcn_readfirstlane(tid >> 6), lane = tid & 63, wr = wid >> 2, wc = wid & 3, fr = lane & 15, fq = lane >> 4;
    const int K = g.K, nt = K / BK;
    unsigned voffA[2], voffB[2];
#pragma unroll
    for (int i = 0; i < 2; ++i) { int R, C; stage_rc(tid * 16 + i * 8192, R, C);
        const int Rb = Epi::CONTIG ? (64 * (R >> 5) + perm32(R & 31)) : (Epi::PERM ? ((R & ~31) + perm32(R & 31)) : R);
        voffA[i] = (unsigned)(R * g.lda + C) * 2u; voffB[i] = (unsigned)(Rb * g.ldb + C) * 2u; }
    const size_t kstep = (size_t)(BK * 2);
    const size_t hstepA = (size_t)HALF * g.lda * 2, hstepB = (size_t)(Epi::CONTIG ? 32 : HALF) * g.ldb * 2;
    const size_t tstepA = 2 * hstepA, tstepB = (size_t)BM * g.ldb * 2;
    const unsigned ldsw = (unsigned)wid * 1024u;
    const int aoff = lds_byte(wr * 64 + fr, fq * 8), boff = lds_byte(wc * 32 + fr, fq * 8);
#define PG8_SA(b, h) (((b) * 2 + (h)) * HTB)
#define PG8_SB(b, h) ((4 + (b) * 2 + (h)) * HTB)
#define PG8_STAGE(bufoff, gbase, voff) do { _Pragma("unroll") for (int _i = 0; _i < 2; ++_i) \
        __builtin_amdgcn_global_load_lds((const unsigned*)((const char*)(gbase) + (voff)[_i]), (LAS unsigned*)(lds + (bufoff) + ldsw + _i * 8192), 16, 0, 0); } while (0)
#define PG8_LDA(dst, b, h) do { _Pragma("unroll") for (int m = 0; m < 4; ++m) _Pragma("unroll") for (int k = 0; k < 2; ++k) dst[m][k] = *(const LAS bf16x8*)(lds + PG8_SA(b, h) + aoff + m * 2048 + k * 1024); } while (0)
#define PG8_LDB(dst, b, h) do { _Pragma("unroll") for (int n = 0; n < 2; ++n) _Pragma("unroll") for (int k = 0; k < 2; ++k) dst[n][k] = *(const LAS bf16x8*)(lds + PG8_SB(b, h) + boff + n * 2048 + k * 1024); } while (0)
#define PG8_MMA(ai, bj, At, Bt) do { __builtin_amdgcn_s_setprio(1); _Pragma("unroll") for (int m = 0; m < 4; ++m) _Pragma("unroll") for (int n = 0; n < 2; ++n) _Pragma("unroll") for (int k = 0; k < 2; ++k) \
        acc[ai][bj][m][n] = __builtin_amdgcn_mfma_f32_16x16x32_bf16(Bt[n][k], At[m][k], acc[ai][bj][m][n], 0, 0, 0); __builtin_amdgcn_s_setprio(0); } while (0)
#define PG8_WAIT_V(n) asm volatile("s_waitcnt vmcnt(" #n ")" ::: "memory")
#define PG8_WAIT_L(n) asm volatile("s_waitcnt lgkmcnt(" #n ")" ::: "memory")
#define PG8_BAR __builtin_amdgcn_s_barrier()
#define PG8_SCHED __builtin_amdgcn_sched_barrier(0)
    Unit cur, nxt; int ui = 0;
    if (!S.next(0, cur)) return;
    f32x4 acc[2][2][4][2];
#pragma unroll
    for (int a = 0; a < 2; ++a)
#pragma unroll
        for (int b = 0; b < 2; ++b)
#pragma unroll
            for (int m = 0; m < 4; ++m)
#pragma unroll
                for (int n = 0; n < 2; ++n) acc[a][b][m][n] = (f32x4){0.f, 0.f, 0.f, 0.f};
    bf16x8 At[4][2], B0[2][2], B1[2][2];
    const char* cA = (const char*)g.A + (size_t)cur.pm * tstepA + (size_t)cur.z * g.zA; const char* cB = (const char*)g.Bt + (size_t)cur.pn * tstepB + (size_t)cur.z * g.zB;
    PG8_STAGE(PG8_SB(0, 0), cB, voffB); PG8_STAGE(PG8_SB(0, 1), cB + hstepB, voffB); PG8_STAGE(PG8_SA(0, 0), cA, voffA); PG8_STAGE(PG8_SA(0, 1), cA + hstepA, voffA);
    if (wr == 1) PG8_BAR;
    PG8_WAIT_V(2); PG8_BAR;
    PG8_STAGE(PG8_SB(1, 0), cB + kstep, voffB); PG8_STAGE(PG8_SA(1, 0), cA + kstep, voffA); PG8_STAGE(PG8_SB(1, 1), cB + hstepB + kstep, voffB);
    PG8_WAIT_V(6); PG8_BAR;
    for (;;) {
        const bool has_next = S.next(ui + 1, nxt);
        const char* nA = has_next ? (const char*)g.A + (size_t)nxt.pm * tstepA + (size_t)nxt.z * g.zA : cA; const char* nB = has_next ? (const char*)g.Bt + (size_t)nxt.pn * tstepB + (size_t)nxt.z * g.zB : cB;
        for (int t = 0; t < nt; t += 2) {
            const bool last = (t == nt - 2);
            const char* a1 = cA + (size_t)(t + 1) * kstep;
            const char* a2 = last ? nA : cA + (size_t)(t + 2) * kstep; const char* b2 = last ? nB : cB + (size_t)(t + 2) * kstep;
            const char* a3 = a2 + kstep; const char* b3 = b2 + kstep;
            PG8_LDB(B0, 0, 0); PG8_LDB(B1, 0, 1); PG8_SCHED; PG8_LDA(At, 0, 0); PG8_STAGE(PG8_SA(1, 1), a1 + hstepA, voffA);
            PG8_WAIT_V(8); PG8_WAIT_L(0); PG8_BAR; PG8_MMA(0, 0, At, B0); PG8_MMA(0, 1, At, B1); PG8_BAR; PG8_SCHED;
            PG8_LDA(At, 0, 1); PG8_STAGE(PG8_SB(0, 0), b2, voffB); PG8_STAGE(PG8_SB(0, 1), b2 + hstepB, voffB); PG8_STAGE(PG8_SA(0, 0), a2, voffA);
            PG8_WAIT_V(8); PG8_WAIT_L(0); PG8_BAR; PG8_MMA(1, 0, At, B0); PG8_MMA(1, 1, At, B1); PG8_BAR; PG8_SCHED;
            PG8_LDB(B0, 1, 0); PG8_LDB(B1, 1, 1); PG8_SCHED; PG8_LDA(At, 1, 0); PG8_STAGE(PG8_SA(0, 1), a2 + hstepA, voffA);
            PG8_WAIT_V(8); PG8_WAIT_L(0); PG8_BAR; PG8_MMA(0, 0, At, B0); PG8_MMA(0, 1, At, B1); PG8_BAR; PG8_SCHED;
            PG8_LDA(At, 1, 1); PG8_STAGE(PG8_SB(1, 0), b3, voffB); PG8_STAGE(PG8_SB(1, 1), b3 + hstepB, voffB); PG8_STAGE(PG8_SA(1, 0), a3, voffA);
            PG8_WAIT_V(8); PG8_WAIT_L(0); PG8_BAR; PG8_MMA(1, 0, At, B0); PG8_MMA(1, 1, At, B1); PG8_BAR; PG8_SCHED;
        }
        if constexpr (ALIGN_EPI) { if (wr == 0) PG8_BAR; }
        E(acc, cur, wr, wc, fr, fq);
        if (!has_next) break;
        if (!(Epi::KEEP && nxt.z != 0))
#pragma unroll
        for (int a = 0; a < 2; ++a)
#pragma unroll
            for (int b = 0; b < 2; ++b)
#pragma unroll
                for (int m = 0; m < 4; ++m)
#pragma unroll
                    for (int n = 0; n < 2; ++n) acc[a][b][m][n] = (f32x4){0.f, 0.f, 0.f, 0.f};
        cur = nxt; cA = nA; cB = nB; ++ui;
        if constexpr (ALIGN_EPI) { if (wr == 1) PG8_BAR; }
    }
    PG8_WAIT_V(0);
    if constexpr (!ALIGN_EPI) { if (wr == 0) PG8_BAR; }
    PG8_BAR;
#undef PG8_SA
#undef PG8_SB
#undef PG8_STAGE
#undef PG8_LDA
#undef PG8_LDB
#undef PG8_MMA
#undef PG8_WAIT_V
#undef PG8_WAIT_L
#undef PG8_BAR
#undef PG8_SCHED
}
}

#define XB_TMO      128
#define XB_XCNT(j)  (256  + 64 * (j))
#define XB_XSUB(j)  (1280 + 64 * (j))
#define XB_XGEN(j)  (2304 + 64 * (j))
#define XB_TOP      3328
#define XB_TOPGEN   3392
#define XCD_BAR_WORDS 3456
#define XB_SPIN_CAP (1u << 18)
__device__ __forceinline__ unsigned xb_ld(unsigned* p)              { return __hip_atomic_load(p, __ATOMIC_RELAXED, __HIP_MEMORY_SCOPE_AGENT); }
__device__ __forceinline__ unsigned xb_add(unsigned* p, unsigned v) { return __hip_atomic_fetch_add(p, v, __ATOMIC_RELAXED, __HIP_MEMORY_SCOPE_AGENT); }
__device__ __forceinline__ unsigned xb_xcc_id() { return (unsigned)__builtin_amdgcn_s_getreg((3 << 11) | 20) & 0xFu; }
#define XB_SPIN(cond, bar) do { unsigned _sp = 0; while (cond) { __builtin_amdgcn_s_sleep(1); \
    if ((++_sp & 255u) == 0u) { if (xb_ld(&(bar)[XB_TMO])) break; if (_sp > XB_SPIN_CAP) { atomicAdd(&(bar)[XB_TMO], 1u); break; } } } } while (0)
struct XcdBarrier { unsigned* bar; unsigned x; volatile LAS unsigned* st; };
__device__ __forceinline__ XcdBarrier xcd_barrier_post(unsigned* bar, volatile LAS unsigned* st) {
    XcdBarrier b; b.bar = bar; b.x = xb_xcc_id(); b.st = st;
    if (threadIdx.x == 0) (void)xb_add(&bar[XB_XCNT(b.x)], 1u);
    return b;
}
__device__ __forceinline__ void xcd_barrier_complete(unsigned* bar, unsigned x, unsigned& nloc, unsigned& nx) {
    const unsigned G = gridDim.x * gridDim.y * gridDim.z;
    unsigned sum, cnt, mine, sp = 0u;
    for (;;) {
        sum = 0u; cnt = 0u; mine = 0u;
#pragma unroll
        for (unsigned j = 0; j < 16; ++j) { const unsigned c = xb_ld(&bar[XB_XCNT(j)]); sum += c; cnt += (c > 0u) ? 1u : 0u; mine = (j == x) ? c : mine; }
        if (sum == G) break;
        __builtin_amdgcn_s_sleep(1);
        if ((++sp & 255u) == 0u) { if (xb_ld(&bar[XB_TMO])) break; if (sp > XB_SPIN_CAP) { atomicAdd(&bar[XB_TMO], 1u); break; } }
    }
    nloc = mine > 0u ? mine : 1u; nx = cnt > 0u ? cnt : 1u;
}
__device__ __forceinline__ void xcd_barrier(const XcdBarrier& b) {
    asm volatile("s_waitcnt vmcnt(0)" ::: "memory");
    __syncthreads();
    if (threadIdx.x == 0) {
        unsigned* bar = b.bar;
        __builtin_amdgcn_s_waitcnt(0);
        unsigned nloc = b.st[0], nx = b.st[1];
        if (nloc == 0u) { xcd_barrier_complete(bar, b.x, nloc, nx); b.st[0] = nloc; b.st[1] = nx; }
        const unsigned old = xb_add(&bar[XB_XSUB(b.x)], 1u);
        const unsigned gen = old / nloc;
        if (old + 1u == (gen + 1u) * nloc) {
            __builtin_amdgcn_fence(__ATOMIC_RELEASE, "agent");
            asm volatile("s_waitcnt vmcnt(0)" ::: "memory");
            const unsigned og = xb_add(&bar[XB_TOP], 1u);
            const unsigned tg = og / nx;
            if (og + 1u == (tg + 1u) * nx) xb_add(&bar[XB_TOPGEN], 1u);
            else XB_SPIN(xb_ld(&bar[XB_TOPGEN]) == tg, bar);
            __builtin_amdgcn_fence(__ATOMIC_ACQUIRE, "agent");
            xb_add(&bar[XB_XGEN(b.x)], 1u);
            asm volatile("s_waitcnt vmcnt(0)" ::: "memory");
        } else {
            XB_SPIN(xb_ld(&bar[XB_XGEN(b.x)]) == gen, bar);
            __builtin_amdgcn_fence(__ATOMIC_ACQUIRE, "agent");
            asm volatile("s_waitcnt vmcnt(0)" ::: "memory");
        }
    }
    __syncthreads();
}

__device__ __forceinline__ bf16x8 frag_kc(const LAS bf16* X, int ld, int mn0, int k0, int lane) { return *(const LAS bf16x8*)(X + (mn0 + (lane & 15)) * ld + k0 + 8 * (lane >> 4)); }
__device__ __forceinline__ bf16x8 gfrag_kc(const bf16* X, int ld, int mn0, int k0, int lane) { const bf16* b = X + (size_t)mn0 * ld + k0; const unsigned lo = (unsigned)((lane & 15) * ld + 8 * (lane >> 4)); return *(const bf16x8*)(b + lo); }
__device__ __forceinline__ s16x4 trr(const LAS bf16* p) { return __builtin_bit_cast(s16x4, __builtin_amdgcn_ds_read_tr16_b64_v4i16((LAS s16x4*)p)); }
__device__ __forceinline__ bf16x8 frag_ks(const LAS bf16* X, int ld, int mn0, int k0, int lane) {
    const int r = lane & 15, g = lane >> 4;
    const LAS bf16* p = X + (k0 + 8 * g + (r >> 2)) * ld + mn0 + 4 * (r & 3);
    const s16x4 lo = trr(p), hi = trr(p + 4 * ld);
    return (bf16x8){lo[0], lo[1], lo[2], lo[3], hi[0], hi[1], hi[2], hi[3]};
}
__device__ __forceinline__ f32x4 zero4() { f32x4 z = {0.f, 0.f, 0.f, 0.f}; asm volatile("" : "+v"(z)); return z; }
__device__ __forceinline__ u32x4 uone4() { u32x4 z = {0x3F80u, 0u, 0u, 0u}; asm volatile("" : "+v"(z)); return z; }
__device__ __forceinline__ u32x4 uzero4() { u32x4 z = {0u, 0u, 0u, 0u}; asm volatile("" : "+v"(z)); return z; }
#define MFMA16(a, b, c) __builtin_amdgcn_mfma_f32_16x16x32_bf16((a), (b), (c), 0, 0, 0)
__device__ __forceinline__ u32x4 scale8(u32x4 w, float s) {
    u32x4 o;
    o.x = pk2(bf2f(w.x & 0xffffu) * s, bf2f(w.x >> 16) * s); o.y = pk2(bf2f(w.y & 0xffffu) * s, bf2f(w.y >> 16) * s);
    o.z = pk2(bf2f(w.z & 0xffffu) * s, bf2f(w.z >> 16) * s); o.w = pk2(bf2f(w.w & 0xffffu) * s, bf2f(w.w >> 16) * s);
    return o;
}
__device__ __forceinline__ float wscan_add(float v, int lane) {
#pragma unroll
    for (int o = 1; o < 64; o <<= 1) { const float t = __shfl_up(v, o); if (lane >= o) v += t; }
    return v;
}
__device__ __forceinline__ float wscan_max(float v, int lane) {
#pragma unroll
    for (int o = 1; o < 64; o <<= 1) { const float t = __shfl_up(v, o); if (lane >= o) v = fmaxf(v, t); }
    return v;
}

#ifndef GEMM_ALIGN
#define GEMM_ALIGN true
#endif
enum { PH_W = 0, PH_INPROJ, PH_M0, PH_M1, PH_M2, PH_M3, PH_LIFT, PH_OUT, PH_UP, PH_DOWN, PH_FINAL, PH_COUNT };
enum { I_X = 0, I_MIXG, I_WIN, I_AIB, I_AFB, I_ANG, I_BCW, I_CCW, I_CCB, I_CDTB, I_CALOG, I_CDSKIP, I_CNG, I_WLIFT, I_WOUT, I_FFNG, I_WUP, I_FCW, I_FCB, I_WDOWN, I_FING, N_IN };
struct Args { const float* in[N_IN]; float* out; unsigned char* ws; int l_lo, l_hi, g_lo, g_hi, ph_lo, ph_hi, use_bar, pad; };

__device__ __forceinline__ void transpose_item(const float* W, int ldw, int nsrc0, int k0, bf16* WT, int ldt, int ndst0, LAS float* scr, int lane, const float* kscale = nullptr, int gate_tile = -1) {
    int scol = nsrc0 + (lane & 31);
    if (gate_tile >= 0) {
        const int c = (ndst0 & 255) + (lane & 31), wc = c >> 6, bj = (c >> 5) & 1, fq = (c >> 3) & 3, n = (c >> 2) & 1, e = c & 3;
        scol = 6160 + (2 * bj + n) * 1024 + 64 * gate_tile + 16 * wc + 4 * fq + e; }
#pragma unroll 8
    for (int i = 0; i < 32; ++i) { const int kk = 2 * i + (lane >> 5); scr[kk * 33 + (lane & 31)] = W[(size_t)(k0 + kk) * ldw + scol] * (kscale ? kscale[k0 + kk] : 1.f); }
    LDS_WAIT(); asm volatile("" ::: "memory");
    const int c = lane & 7;
#pragma unroll
    for (int j = 0; j < 4; ++j) { const int n = (lane >> 3) + 8 * j; const LAS float* s = scr + (8 * c) * 33 + n;
        u32x4 o; o.x = pk2(s[0 * 33], s[1 * 33]); o.y = pk2(s[2 * 33], s[3 * 33]); o.z = pk2(s[4 * 33], s[5 * 33]); o.w = pk2(s[6 * 33], s[7 * 33]);
        *(u32x4*)(WT + (size_t)(ndst0 + n) * ldt + k0 + 8 * c) = o; }
    LDS_WAIT(); asm volatile("" ::: "memory");
}

__global__ void __launch_bounds__(NTHR, 2) fwd(Args args) {
    extern __shared__ __attribute__((aligned(16))) unsigned char lds_raw[];
    LAS unsigned char* lds = (LAS unsigned char*)lds_raw;
    const int NBLK = gridDim.x, blk = blockIdx.x;
    {
        volatile LAS unsigned* MISC0 = (volatile LAS unsigned*)(lds + MISC_OFF);
        if (threadIdx.x < 16) MISC0[threadIdx.x] = 0u;
        __syncthreads();
    }
    XcdBarrier bar; bar.bar = (unsigned*)(args.ws + WS_CTL) + 4096; bar.x = 0; bar.st = nullptr;
    if (args.use_bar) bar = xcd_barrier_post((unsigned*)(args.ws + WS_CTL) + 4096, (volatile LAS unsigned*)(lds + MISC_OFF) + 8);
#define GRID_BAR() do { if (args.use_bar) xcd_barrier(bar); } while (0)
#ifndef REPMASK
#define REPMASK 0
#endif
#define IN(k) (args.ph_lo <= (k) && (k) < args.ph_hi)
#define REPS(k) for (int rep_ = 0; rep_ < 1 + ((REPMASK >> (k)) & 1); ++rep_)
#define PHASE_BEGIN() int tid = threadIdx.x; asm volatile("" : "+v"(tid)); const int lane = tid & 63, wave = __builtin_amdgcn_readfirstlane(tid >> 6); \
    const __attribute__((address_space(4))) Args* ka = (const __attribute__((address_space(4))) Args*)__builtin_amdgcn_kernarg_segment_ptr(); asm volatile("" : "+s"(ka)); \
    unsigned char* ws = ka->ws; \
    const size_t grow0 = (size_t)grp * T; const float* xsrc = (l == 0) ? ka->in[I_X] : ka->out; (void)grow0; (void)xsrc; \
    const int gw = blk * NWAVES + wave, NGW = NBLK * NWAVES, gt = blk * NTHR + tid, NGT = NBLK * NTHR; (void)lane; (void)gw; (void)NGW; (void)gt; (void)NGT; \
    bf16* const WinT = (bf16*)(ws + WS_WIN); bf16* const WliftT = (bf16*)(ws + WS_WLIFT); bf16* const WoutT = (bf16*)(ws + WS_WOUT); \
    bf16* const WupT = (bf16*)(ws + WS_WUP); bf16* const WdownT = (bf16*)(ws + WS_WDOWN); bf16* const W16B = (bf16*)(ws + WS_W16); \
    bf16* const XN = (bf16*)(ws + WS_XN); bf16* const P = (bf16*)(ws + WS_P); bf16* const U = (bf16*)(ws + WS_U); bf16* const ACT = (bf16*)(ws + WS_ACT); \
    bf16* const YCAT = (bf16*)(ws + WS_YCAT); bf16* const XG = (bf16*)(ws + WS_XG); bf16* const MB = (bf16*)(ws + WS_MB); float* const SP = (float*)(ws + WS_SP); \
    float* const SSQ1 = (float*)(ws + WS_SSQ1); float* const SSQ2 = (float*)(ws + WS_SSQ2); float* const SSQC = (float*)(ws + WS_SSQC); float* const RAWH = (float*)(ws + WS_RAWH); (void)SSQ1; (void)SSQ2; (void)SSQC; (void)RAWH; \
    float* const GBc = (float*)(ws + WS_GB); float* const GGc = (float*)(ws + WS_GG); float* const GMT = (float*)(ws + WS_GMT); \
    float* const MCAR = (float*)(ws + WS_MCAR); float* const MNEW = (float*)(ws + WS_MNEW); float* const MSC = (float*)(ws + WS_MSC); float* const SUMB = (float*)(ws + WS_SUMB); float* const SUMG = (float*)(ws + WS_SUMG); (void)SUMB; (void)SUMG; \
    float* const DTB = (float*)(ws + WS_DT); float* const ACB = (float*)(ws + WS_AC); bf16* const XBC = (bf16*)(ws + WS_XBC); \
    bf16* const DC = (bf16*)(ws + WS_DC); bf16* const CS = (bf16*)(ws + WS_CS); bf16* const DH = (bf16*)(ws + WS_DH); bf16* const HS = (bf16*)(ws + WS_HS); \
    (void)WinT; (void)WliftT; (void)WoutT; (void)WupT; (void)WdownT; (void)W16B; (void)XN; (void)P; (void)U; (void)ACT; (void)YCAT; (void)XG; (void)MB; (void)SP; (void)GBc; (void)GGc; (void)GMT; \
    (void)MCAR; (void)MNEW; (void)MSC; (void)DTB; (void)ACB; (void)XBC; (void)DC; (void)CS; (void)DH; (void)HS

    for (int l = args.l_lo; l < args.l_hi; ++l)
    for (int grp = args.g_lo; grp < args.g_hi; ++grp) {

        REPS(PH_W) if (IN(PH_W) && grp == 0) {
            PHASE_BEGIN();
            LAS float* scr = (LAS float*)(lds + wave * 16384);
            constexpr int I_IN = 16 * 320, I_LF = 4 * 8 * 32, I_OUT = 16 * 32, I_UP = 16 * 176, I_DN = 44 * 32, NIT = I_IN + I_LF + I_OUT + I_UP + I_DN;
            for (int it = gw; it < NIT; it += NGW) {
                int r = it;
                if (r < I_IN) { const int kb = r / 320, nb = r % 320, n0 = 32 * nb, ns = n0 + (n0 >= P_SQ ? 16 : (n0 >= P_BB ? 8 : 0));
                    transpose_item(ka->in[I_WIN] + (size_t)l * DM * PIN, PIN, ns, 64 * kb, WinT, DM, n0, scr, lane, ka->in[I_MIXG] + (size_t)l * DM, n0 >= P_G ? (n0 - P_G) >> 8 : -1); continue; } r -= I_IN;
                if (r < I_LF) { const int br = r / 256, q = r % 256, kb = q / 32, nb = q % 32;
                    transpose_item(ka->in[I_WLIFT] + (size_t)(l * 4 + br) * 512 * DM, DM, 32 * nb, 64 * kb, WliftT + (size_t)br * DM * 512, 512, 32 * nb, scr, lane, br == 2 ? ka->in[I_CNG] + (size_t)l * 512 : nullptr); continue; } r -= I_LF;
                if (r < I_OUT) { const int kb = r / 32, nb = r % 32;
                    transpose_item(ka->in[I_WOUT] + (size_t)l * DM * DM, DM, 32 * nb, 64 * kb, WoutT, DM, 32 * nb, scr, lane); continue; } r -= I_OUT;
                if (r < I_UP) { const int kb = r / 176, nb = r % 176, n0 = 32 * nb, tp = n0 >> 8, j = n0 & 255, ns = (j < 128) ? 128 * tp + j : 2816 + 128 * tp + (j - 128);
                    transpose_item(ka->in[I_WUP] + (size_t)l * DM * DFF2, DFF2, ns, 64 * kb, WupT, DM, n0, scr, lane, ka->in[I_FFNG] + (size_t)l * DM); continue; } r -= I_UP;
                { const int kb = r / 32, nb = r % 32;
                    transpose_item(ka->in[I_WDOWN] + (size_t)l * DFF * DM, DM, 32 * nb, 64 * kb, WdownT, DFF, 32 * nb, scr, lane); }
            }
            for (int i = gt; i < 16 * DM; i += NGT) { const int c = i >> 10, k = i & 1023; const int oc = (c < 8) ? (1536 + c) : (4616 + (c - 8));
                const float w = ka->in[I_WIN][(size_t)l * DM * PIN + (size_t)k * PIN + oc] * ka->in[I_MIXG][(size_t)l * DM + k]; const unsigned hi = f2bf(w);
                W16B[i] = (bf16)hi; W16B[16 * DM + i] = (bf16)f2bf(w - bf2f(hi)); }
            if (l == 0) {
                for (int m = gw; m < BATCH * SEQ; m += NGW) {
                    const f32x4* xr = (const f32x4*)(ka->in[I_X] + (size_t)m * DM) + lane;
                    f32x4 v[4]; float sq = 0.f;
#pragma unroll
                    for (int j = 0; j < 4; ++j) { v[j] = xr[64 * j]; sq += (v[j].x * v[j].x + v[j].y * v[j].y) + (v[j].z * v[j].z + v[j].w * v[j].w); }
                    sq = wave_sum(sq); if (lane < 16) SSQ1[(size_t)m * 16 + lane] = (lane == 0) ? sq : 0.f;
                    u32x2* o8 = (u32x2*)(XG + (size_t)m * DM) + lane;
#pragma unroll
                    for (int j = 0; j < 4; ++j) o8[64 * j] = (u32x2){pk2(v[j].x, v[j].y), pk2(v[j].z, v[j].w)};
                }
            }
            GRID_BAR();
        }

        REPS(PH_INPROJ) if (IN(PH_INPROJ)) {
            PHASE_BEGIN();
            const bf16* XGg = XG + grow0 * DM; const float* ssq = SSQ1 + grow0 * 16;
            for (int rb = blk; rb < T / 64; rb += NBLK) {
                const int r0 = rb * 64 + 16 * (wave & 3), kh = (wave >> 2) * 512; f32x4 acc = zero4(), acc2 = zero4();
#pragma unroll 8
                for (int ks = 0; ks < 16; ++ks) { const bf16x8 a = gfrag_kc(XGg, DM, r0, kh + 32 * ks, lane);
                    acc = MFMA16(a, gfrag_kc(W16B, DM, 0, kh + 32 * ks, lane), acc); acc2 = MFMA16(a, gfrag_kc(W16B + 16 * DM, DM, 0, kh + 32 * ks, lane), acc2); }
                acc += acc2;
                LAS f32x4* xch = (LAS f32x4*)lds;
                if (wave >= 4) xch[(wave - 4) * 64 + lane] = acc;
                __syncthreads();
                if (wave < 4) { acc += xch[wave * 64 + lane];
#pragma unroll
                    for (int i = 0; i < 4; ++i) { const int row = r0 + 4 * (lane >> 4) + i; SP[(size_t)row * 16 + (lane & 15)] = acc[i] * row_rstd(ssq + (size_t)row * 16); } }
                __syncthreads();
            }
            pg8::Gemm g{XGg, WinT, DM, DM, DM, 0, 0}; pg8::Order S; S.init(T, PW, NBLK, blk, 1);
            pg8::EpiBf16 E{P, PW, ssq, P_G / 256};
            pg8::gemm_phase<pg8::EpiBf16, GEMM_ALIGN>(lds, g, S, E);
            GRID_BAR();
        }

        REPS(PH_M0) if (IN(PH_M0)) {
            PHASE_BEGIN();
            for (int task = gw; task < GB * 4 * NCH; task += NGW) {
                const int bh = task >> 5, c = task & 31, bl = bh >> 2, h = bh & 3;
                const size_t m = (size_t)bl * SEQ + c * 64 + lane;
                const float ig = SP[m * 16 + h] + ka->in[I_AIB][l * 4 + h], fg = SP[m * 16 + 4 + h] + ka->in[I_AFB][l * 4 + h];
                const float b = wscan_add(logsigf_(fg), lane);
                const float gg = ig - b;
                const float pm = wscan_max(gg, lane);
                GBc[m * 4 + h] = b; GGc[m * 4 + h] = gg; GMT[m * 4 + h] = pm;
                if (lane == 63) { SUMB[task] = b; SUMG[task] = pm; }
            }
            for (int task = gw; task < GB * NCH * 8; task += NGW) {
                const int hd = task & 7; const size_t m = (size_t)(task >> 3) * 64 + lane;
                const float dt = softplusf_(SP[m * 16 + 8 + hd] + ka->in[I_CDTB][l * 8 + hd]);
                const float a = wscan_add(-dt * __expf(ka->in[I_CALOG][l * 8 + hd]), lane);
                DTB[m * 8 + hd] = dt; ACB[m * 8 + hd] = a;
            }
            {
                const float* cw = ka->in[I_CCW] + (size_t)l * 4 * 1024; const float* cb = ka->in[I_CCB] + (size_t)l * 1024;
                constexpr int RUN = 16;
                for (int i = gt; i < (T / RUN) * 128; i += NGT) {
                    const int rb = i >> 7, c8 = (i & 127) * 8, m0 = rb * RUN, t0 = m0 & (SEQ - 1);
                    float w[4][8], bb[8];
#pragma unroll
                    for (int e = 0; e < 8; ++e) { bb[e] = cb[c8 + e];
#pragma unroll
                        for (int j = 0; j < 4; ++j) w[j][e] = cw[j * 1024 + c8 + e]; }
                    const u32x4 zz = uzero4(); u32x4 win[4]; win[0] = zz; win[1] = zz; win[2] = zz;
                    if (t0 >= 3) { const bf16* pr = P + (size_t)(m0 - 3) * PW + P_CX + c8; win[0] = *(const u32x4*)pr; win[1] = *(const u32x4*)(pr + PW); win[2] = *(const u32x4*)(pr + 2 * PW); }
#pragma unroll 4
                    for (int rr = 0; rr < RUN; ++rr) {
                        win[3] = *(const u32x4*)(P + (size_t)(m0 + rr) * PW + P_CX + c8);
                        float acc[8];
#pragma unroll
                        for (int e = 0; e < 8; ++e) acc[e] = bb[e];
#pragma unroll
                        for (int j = 0; j < 4; ++j) {
                            acc[0] += w[j][0] * bf2f(win[j].x & 0xffffu); acc[1] += w[j][1] * bf2f(win[j].x >> 16); acc[2] += w[j][2] * bf2f(win[j].y & 0xffffu); acc[3] += w[j][3] * bf2f(win[j].y >> 16);
                            acc[4] += w[j][4] * bf2f(win[j].z & 0xffffu); acc[5] += w[j][5] * bf2f(win[j].z >> 16); acc[6] += w[j][6] * bf2f(win[j].w & 0xffffu); acc[7] += w[j][7] * bf2f(win[j].w >> 16); }
                        u32x4 o; o.x = pk2(siluf_(acc[0]), siluf_(acc[1])); o.y = pk2(siluf_(acc[2]), siluf_(acc[3])); o.z = pk2(siluf_(acc[4]), siluf_(acc[5])); o.w = pk2(siluf_(acc[6]), siluf_(acc[7]));
                        *(u32x4*)(XBC + (size_t)(m0 + rr) * 1024 + c8) = o;
                        win[0] = win[1]; win[1] = win[2]; win[2] = win[3];
                    }
                }
            }
            {
                const float* bw = ka->in[I_BCW] + (size_t)l * 3 * 512;
                constexpr int RUN = 16;
                for (int i = gt; i < (T / RUN) * 64; i += NGT) {
                    const int rb = i >> 6, c8 = (i & 63) * 8, m0 = rb * RUN, t0 = m0 & (SEQ - 1);
                    float w[3][8];
#pragma unroll
                    for (int e = 0; e < 8; ++e)
#pragma unroll
                        for (int j = 0; j < 3; ++j) w[j][e] = bw[j * 512 + c8 + e];
                    float pw[3][8];
#pragma unroll
                    for (int e = 0; e < 8; ++e) { pw[0][e] = 0.f; pw[1][e] = 0.f; }
                    if (t0 >= 2) {
#pragma unroll
                        for (int j = 0; j < 2; ++j) { const bf16* pr = P + (size_t)(m0 - 2 + j) * PW; const u32x4 a = *(const u32x4*)(pr + P_BC + c8), b = *(const u32x4*)(pr + P_BX + c8);
                            pw[j][0] = bf2f(a.x & 0xffffu) * bf2f(b.x & 0xffffu); pw[j][1] = bf2f(a.x >> 16) * bf2f(b.x >> 16); pw[j][2] = bf2f(a.y & 0xffffu) * bf2f(b.y & 0xffffu); pw[j][3] = bf2f(a.y >> 16) * bf2f(b.y >> 16);
                            pw[j][4] = bf2f(a.z & 0xffffu) * bf2f(b.z & 0xffffu); pw[j][5] = bf2f(a.z >> 16) * bf2f(b.z >> 16); pw[j][6] = bf2f(a.w & 0xffffu) * bf2f(b.w & 0xffffu); pw[j][7] = bf2f(a.w >> 16) * bf2f(b.w >> 16); } }
#pragma unroll 4
                    for (int rr = 0; rr < RUN; ++rr) {
                        const bf16* pr = P + (size_t)(m0 + rr) * PW; const u32x4 a = *(const u32x4*)(pr + P_BC + c8), b = *(const u32x4*)(pr + P_BX + c8), g = *(const u32x4*)(pr + P_BB + c8);
                        pw[2][0] = bf2f(a.x & 0xffffu) * bf2f(b.x & 0xffffu); pw[2][1] = bf2f(a.x >> 16) * bf2f(b.x >> 16); pw[2][2] = bf2f(a.y & 0xffffu) * bf2f(b.y & 0xffffu); pw[2][3] = bf2f(a.y >> 16) * bf2f(b.y >> 16);
                        pw[2][4] = bf2f(a.z & 0xffffu) * bf2f(b.z & 0xffffu); pw[2][5] = bf2f(a.z >> 16) * bf2f(b.z >> 16); pw[2][6] = bf2f(a.w & 0xffffu) * bf2f(b.w & 0xffffu); pw[2][7] = bf2f(a.w >> 16) * bf2f(b.w >> 16);
                        float acc[8];
#pragma unroll
                        for (int e = 0; e < 8; ++e) acc[e] = w[0][e] * pw[0][e] + w[1][e] * pw[1][e] + w[2][e] * pw[2][e];
                        u32x4 o; o.x = pk2(acc[0] * bf2f(g.x & 0xffffu), acc[1] * bf2f(g.x >> 16)); o.y = pk2(acc[2] * bf2f(g.y & 0xffffu), acc[3] * bf2f(g.y >> 16));
                        o.z = pk2(acc[4] * bf2f(g.z & 0xffffu), acc[5] * bf2f(g.z >> 16)); o.w = pk2(acc[6] * bf2f(g.w & 0xffffu), acc[7] * bf2f(g.w >> 16));
                        *(u32x4*)(YCAT + (size_t)(m0 + rr) * YW + 512 + c8) = o;
#pragma unroll
                        for (int e = 0; e < 8; ++e) { pw[0][e] = pw[1][e]; pw[1][e] = pw[2][e]; }
                    }
                }
            }
            __syncthreads();
            {
            LAS bf16* Qs = (LAS bf16*)lds; LAS bf16* Ks = Qs + 128 * 136; LAS bf16* Vs = Ks + 64 * 136; LAS bf16* Aw = Vs + 64 * 136 + wave * (16 * 72);
            const int r = lane & 15, g4 = lane >> 4;
            for (int u = blk; u < GB * 4 * 16; u += NBLK) {
                const int bl = u >> 6, h = (u >> 4) & 3, qt = u & 15; const size_t mb = (size_t)bl * SEQ; const int q0 = qt * 128;
                volatile LAS unsigned* FLG = (volatile LAS unsigned*)(lds + MISC_OFF + 128);
                int par = 0;
                __syncthreads();
                if (lane == 0) { FLG[wave] = 0u; FLG[8 + wave] = 0u; }
                for (int i = tid; i < 2048; i += NTHR) { const int s = i >> 4, c8 = i & 15; *(LAS u32x4*)(Qs + s * 136 + c8 * 8) = *(const u32x4*)(P + (mb + q0 + s) * PW + P_SQ + h * 128 + c8 * 8); }
                f32x4 O[8];
#pragma unroll
                for (int d = 0; d < 8; ++d) O[d] = zero4();
                float racc = 0.f; const int tq = q0 + 16 * wave + r;
                u32x4 kreg[2], vreg[2];
                { const int s0f = (2 * qt + 1) * 64;
#pragma unroll
                  for (int k2 = 0; k2 < 2; ++k2) { const int i = tid + 512 * k2, s = i >> 4, c8 = i & 15; const bf16* pr = P + (mb + s0f + s) * PW + h * 128 + c8 * 8; kreg[k2] = *(const u32x4*)(pr + P_SK); vreg[k2] = *(const u32x4*)(pr + P_SV); } }
                for (int kt = 2 * qt + 1; kt >= 0; --kt) {
                    const int s0 = kt * 64;
                    __syncthreads();
                    { unsigned alldone = 1u;
#pragma unroll
                      for (int w8 = 0; w8 < 8; ++w8) alldone &= FLG[par * 8 + w8];
                      if (__builtin_amdgcn_readfirstlane((int)alldone)) break; }
#pragma unroll
                    for (int k2 = 0; k2 < 2; ++k2) { const int i = tid + 512 * k2, s = i >> 4, c8 = i & 15; *(LAS u32x4*)(Ks + s * 136 + c8 * 8) = kreg[k2]; *(LAS u32x4*)(Vs + s * 136 + c8 * 8) = vreg[k2]; }
                    if (kt > 0) {
#pragma unroll
                        for (int k2 = 0; k2 < 2; ++k2) { const int i = tid + 512 * k2, s = i >> 4, c8 = i & 15; const bf16* pr = P + (mb + s0 - 64 + s) * PW + h * 128 + c8 * 8; kreg[k2] = *(const u32x4*)(pr + P_SK); vreg[k2] = *(const u32x4*)(pr + P_SV); } }
                    __syncthreads();
                    if (s0 < q0 + 16 * wave + 15) {
                        f32x4 z[4];
#pragma unroll
                        for (int j = 0; j < 4; ++j) z[j] = zero4();
#pragma unroll
                        for (int ks = 0; ks < 4; ++ks) { const bf16x8 fq = frag_kc(Qs, 136, 16 * wave, 32 * ks, lane);
#pragma unroll
                            for (int j = 0; j < 4; ++j) z[j] = MFMA16(frag_kc(Ks, 136, 16 * j, 32 * ks, lane), fq, z[j]); }
                        float ls[4][4], x[4][4], tsum[4];
#pragma unroll
                        for (int j = 0; j < 4; ++j) { float tj = 0.f;
#pragma unroll
                            for (int i = 0; i < 4; ++i) { const int s = s0 + 16 * j + 4 * g4 + i; const float zz = z[j][i] * 0.08838834764831845f;
                                const float l1 = fminf(zz, 0.f) - __logf(1.f + __expf(-fabsf(zz)));
                                ls[j][i] = l1; x[j][i] = (s < tq) ? (l1 - zz) : 0.f; tj += x[j][i]; }
                            tsum[j] = tj; }
                        float above[4], tot[4];
#pragma unroll
                        for (int j = 0; j < 4; ++j) { const float y1 = __shfl_xor(tsum[j], 16), y2 = __shfl_xor(tsum[j], 32), y3 = __shfl_xor(tsum[j], 48);
                            tot[j] = tsum[j] + y1 + y2 + y3;
                            above[j] = (g4 == 0) ? (y1 + y2 + y3) : (g4 == 1) ? (y2 + y3) : (g4 == 2) ? y1 : 0.f; }
                        float hi = racc;
#pragma unroll
                        for (int j = 3; j >= 0; --j) { float run = hi + above[j]; float av[4];
#pragma unroll
                            for (int i = 3; i >= 0; --i) { const int s = s0 + 16 * j + 4 * g4 + i; av[i] = (s < tq) ? __expf(ls[j][i] + run) : 0.f; run += x[j][i]; }
                            *(LAS u32x2*)(Aw + r * 72 + 16 * j + 4 * g4) = (u32x2){pk2(av[0], av[1]), pk2(av[2], av[3])};
                            hi += tot[j]; }
                        racc = hi;
                        LDS_WAIT(); asm volatile("" ::: "memory");
#pragma unroll
                        for (int ks = 0; ks < 2; ++ks) { const bf16x8 fa = frag_kc(Aw, 72, 0, 32 * ks, lane);
#pragma unroll
                            for (int d = 0; d < 8; ++d) O[d] = MFMA16(fa, frag_ks(Vs, 136, 16 * d, 32 * ks, lane), O[d]); }
                    }
                    par ^= 1;
                    { const bool wd = __all(racc < -104.f); if (lane == 0) FLG[par * 8 + wave] = wd ? 1u : 0u; }
                }
#pragma unroll
                for (int d = 0; d < 8; ++d)
#pragma unroll
                    for (int i = 0; i < 4; ++i) YCAT[(mb + q0 + 16 * wave + 4 * g4 + i) * YW + 1536 + h * 128 + 16 * d + r] = (bf16)f2bf(O[d][i]);
            }
            }
            GRID_BAR();
        }

        REPS(PH_M1) if (IN(PH_M1)) {
            PHASE_BEGIN();
            constexpr int NUA = GB * 4 * NCH, NUC = GB * NCH;
            for (int u = blk; u < NUA + NUC; u += NBLK) {
                if (u < NUA) {
                    const int ua = u, bh = ua >> 5, c = ua & 31, bl = bh >> 2, h = bh & 3; const size_t m0 = (size_t)bl * SEQ + c * 64;
                    LAS bf16* VP = (LAS bf16*)lds; LAS bf16* WK = (LAS bf16*)(lds + 64 * 152 * 2);
                    float bLj = 0.f, gmj = -1e30f;
                    if (lane < 32) { bLj = SUMB[bh * 32 + lane]; gmj = SUMG[bh * 32 + lane]; }
                    float pa = bLj, pq = gmj + bLj;
#pragma unroll
                    for (int o = 1; o < 32; o <<= 1) { const float ta = __shfl_up(pa, o), tq = __shfl_up(pq, o); if (lane >= o) { pq = fmaxf(tq + pa, pq); pa = ta + pa; } }
                    const float mall = fmaxf(pa, pq);
                    const float mnew = __shfl(mall, c), mprev = (c == 0) ? 0.f : __shfl(mall, (c + 63) & 63);
                    const float bL = GBc[(m0 + 63) * 4 + h];
                    if (tid == 0) { MCAR[ua] = mprev; MNEW[ua] = mnew; MSC[ua] = __expf(bL + mprev - mnew); }
                    for (int i = tid; i < 1024; i += NTHR) { const int s = i >> 4, c8 = i & 15; *(LAS u32x4*)(VP + s * 152 + c8 * 8) = *(const u32x4*)(P + (m0 + s) * PW + P_AV + h * 128 + c8 * 8); }
                    if (tid < 64) { *(LAS u32x4*)(VP + tid * 152 + 128) = uone4(); *(LAS u32x4*)(VP + tid * 152 + 136) = uzero4(); }
                    { const int s = tid >> 3, c8 = tid & 7; const float w = __expf(bL + GGc[(m0 + s) * 4 + h] - mnew);
                      *(LAS u32x4*)(WK + s * 72 + c8 * 8) = scale8(*(const u32x4*)(P + (m0 + s) * PW + P_AK + h * 64 + c8 * 8), w); }
                    __syncthreads();
                    for (int ti = wave; ti < 36; ti += NWAVES) { const int mt = ti >> 2, nt = ti & 3; f32x4 acc = zero4();
#pragma unroll
                        for (int ks = 0; ks < 2; ++ks) acc = MFMA16(frag_ks(VP, 152, 16 * mt, 32 * ks, lane), frag_ks(WK, 72, 16 * nt, 32 * ks, lane), acc);
                        bf16* d = DC + (size_t)ua * 9216 + (16 * mt + 4 * (lane >> 4)) * 64 + 16 * nt + (lane & 15);
#pragma unroll
                        for (int i = 0; i < 4; ++i) d[i * 64] = (bf16)f2bf(acc[i]); }
                    __syncthreads();
                } else {
                    const int uc = u - NUA, bl = uc >> 5, c = uc & 31, hd = wave, gi = hd >> 2; const size_t m0 = (size_t)bl * SEQ + c * 64;
                    LAS bf16* XW = (LAS bf16*)(lds + hd * (64 * 72 * 2)); LAS bf16* BMs = (LAS bf16*)(lds + 8 * 64 * 72 * 2);
                    const float alast = ACB[(m0 + 63) * 8 + hd];
#pragma unroll
                    for (int k = 0; k < 8; ++k) { const int i = lane + 64 * k, s = i >> 3, c8 = i & 7; const float wd = __expf(alast - ACB[(m0 + s) * 8 + hd]) * DTB[(m0 + s) * 8 + hd];
                        *(LAS u32x4*)(XW + s * 72 + c8 * 8) = scale8(*(const u32x4*)(XBC + (m0 + s) * 1024 + hd * 64 + c8 * 8), wd); }
                    for (int i = tid; i < 2048; i += NTHR) { const int g2 = i >> 10, rem = i & 1023, s = rem >> 4, c8 = rem & 15;
                        *(LAS u32x4*)(BMs + g2 * (64 * 136) + s * 136 + c8 * 8) = *(const u32x4*)(XBC + (m0 + s) * 1024 + 512 + g2 * 128 + c8 * 8); }
                    __syncthreads();
                    const LAS bf16* BMg = BMs + gi * (64 * 136);
                    for (int pt = 0; pt < 4; ++pt) { f32x4 acc[8];
#pragma unroll
                        for (int n = 0; n < 8; ++n) acc[n] = zero4();
#pragma unroll
                        for (int ks = 0; ks < 2; ++ks) { const bf16x8 a = frag_ks(XW, 72, 16 * pt, 32 * ks, lane);
#pragma unroll
                            for (int n = 0; n < 8; ++n) acc[n] = MFMA16(a, frag_ks(BMg, 136, 16 * n, 32 * ks, lane), acc[n]); }
                        bf16* d = DH + ((size_t)(uc * 8 + hd) * 64 + 16 * pt + 4 * (lane >> 4)) * 128 + (lane & 15);
#pragma unroll
                        for (int n = 0; n < 8; ++n)
#pragma unroll
                            for (int i = 0; i < 4; ++i) d[i * 128 + 16 * n] = (bf16)f2bf(acc[n][i]); }
                    __syncthreads();
                }
            }
            GRID_BAR();
        }

        REPS(PH_M2) if (IN(PH_M2)) {
            PHASE_BEGIN();
            constexpr int NA = GB * 4 * 2304, NC = GB * 8 * 2048;
            for (int i = gt; i < NA + NC; i += NGT) {
                f32x4 st = zero4();
                if (i < NA) { const int bh = i / 2304, e = (i - bh * 2304) * 4;
                    for (int c = 0; c < NCH; ++c) { const size_t ua = (size_t)bh * NCH + c;
                        *(u32x2*)(CS + ua * 9216 + e) = (u32x2){pk2(st.x, st.y), pk2(st.z, st.w)};
                        { const u32x2 dw = *(const u32x2*)(DC + ua * 9216 + e); st = st * MSC[ua] + (f32x4){bf2f(dw.x & 0xffffu), bf2f(dw.x >> 16), bf2f(dw.y & 0xffffu), bf2f(dw.y >> 16)}; } }
                } else { const int j = i - NA, bhd = j >> 11, e = (j & 2047) * 4, bl = bhd >> 3, hd = bhd & 7;
                    for (int c = 0; c < NCH; ++c) { const size_t uh = (size_t)(bl * NCH + c) * 8 + hd;
                        *(u32x2*)(HS + uh * 8192 + e) = (u32x2){pk2(st.x, st.y), pk2(st.z, st.w)};
                        { const u32x2 dw = *(const u32x2*)(DH + uh * 8192 + e); st = st * __expf(ACB[((size_t)bl * SEQ + c * 64 + 63) * 8 + hd]) + (f32x4){bf2f(dw.x & 0xffffu), bf2f(dw.x >> 16), bf2f(dw.y & 0xffffu), bf2f(dw.y >> 16)}; } }
                }
            }
            GRID_BAR();
        }

        REPS(PH_M3) if (IN(PH_M3)) {
            PHASE_BEGIN();
            constexpr int NUA = GB * 4 * NCH, NUC = 2 * GB * NCH;
            for (int u = blk; u < NUA + NUC; u += NBLK) {
                const int r = lane & 15, g4 = lane >> 4;
                if (u < NUA) {
                    const int ua = u, bh = ua >> 5, c = ua & 31, bl = bh >> 2, h = bh & 3; const size_t m0 = (size_t)bl * SEQ + c * 64;
                    LAS bf16* Qs = (LAS bf16*)lds; LAS bf16* Ks = Qs + 64 * 72; LAS bf16* VP = Ks + 64 * 72; LAS bf16* CST = VP + 64 * 152; LAS bf16* SMT = CST + 144 * 72; LAS bf16* AOT = SMT + 64 * 72;
                    LAS float* GS = (LAS float*)(AOT + 64 * 136);
                    LAS float* SSQ = GS + 256;
                    const float mcar = MCAR[ua];
                    { const int s = tid >> 3, c8 = tid & 7; const bf16* pr = P + (m0 + s) * PW + h * 64 + c8 * 8;
                      *(LAS u32x4*)(Qs + s * 72 + c8 * 8) = *(const u32x4*)(pr + P_AQ); *(LAS u32x4*)(Ks + s * 72 + c8 * 8) = *(const u32x4*)(pr + P_AK); }
                    for (int i = tid; i < 1024; i += NTHR) { const int s = i >> 4, c8 = i & 15; const bf16* pr = P + (m0 + s) * PW + h * 128 + c8 * 8;
                        *(LAS u32x4*)(VP + s * 152 + c8 * 8) = *(const u32x4*)(pr + P_AV); *(LAS u32x4*)(AOT + s * 136 + c8 * 8) = *(const u32x4*)(pr + P_AO); }
                    if (tid < 64) { *(LAS u32x4*)(VP + tid * 152 + 128) = uone4(); *(LAS u32x4*)(VP + tid * 152 + 136) = uzero4(); }
                    for (int i = tid; i < 1152; i += NTHR) { const int dv = i >> 3, c8 = i & 7; *(LAS u32x4*)(CST + dv * 72 + c8 * 8) = *(const u32x4*)(CS + (size_t)ua * 9216 + dv * 64 + c8 * 8); }
                    if (tid < 192) { const int arr = tid >> 6, s = tid & 63; const float* src = (arr == 0) ? GBc : (arr == 1) ? GGc : GMT; float v = src[(m0 + s) * 4 + h];
                        if (arr == 2) v = GBc[(m0 + s) * 4 + h] + fmaxf(mcar, v);
                        GS[arr * 64 + s] = v; }
                    __syncthreads();
#pragma unroll
                    for (int q2 = 0; q2 < 2; ++q2) { const int ti = 2 * wave + q2, tt = ti >> 2, st = ti & 3;
                        f32x4 acc = zero4();
                        if (st <= tt) {
#pragma unroll
                            for (int ks = 0; ks < 2; ++ks) acc = MFMA16(frag_kc(Qs, 72, 16 * tt, 32 * ks, lane), frag_kc(Ks, 72, 16 * st, 32 * ks, lane), acc);
                            const int s = 16 * st + r; const float gs = GS[64 + s];
#pragma unroll
                            for (int i = 0; i < 4; ++i) { const int t = 16 * tt + 4 * g4 + i; const float e = GS[t] - GS[128 + t] + gs;
                                acc[i] = (s <= t) ? acc[i] * 0.125f * __expf(e) : 0.f; }
                        }
                        *(LAS u32x2*)(SMT + (16 * st + r) * 72 + 16 * tt + 4 * g4) = (u32x2){pk2(acc[0], acc[1]), pk2(acc[2], acc[3])}; }
                    __syncthreads();
                    const int tt = wave & 3, half = wave >> 2;
                    f32x4 a1[5], a2[5];
#pragma unroll
                    for (int j = 0; j < 5; ++j) { a1[j] = zero4(); a2[j] = zero4(); }
#pragma unroll
                    for (int ks = 0; ks < 2; ++ks) { const bf16x8 fa1 = frag_ks(SMT, 72, 16 * tt, 32 * ks, lane), fa2 = frag_kc(Qs, 72, 16 * tt, 32 * ks, lane);
#pragma unroll
                        for (int j = 0; j < 5; ++j) { const int dvt = (j < 4) ? half * 4 + j : 8;
                            a1[j] = MFMA16(fa1, frag_ks(VP, 152, 16 * dvt, 32 * ks, lane), a1[j]);
                            a2[j] = MFMA16(fa2, frag_kc(CST, 72, 16 * dvt, 32 * ks, lane), a2[j]); } }
                    float hv[4][4], ssq[4];
#pragma unroll
                    for (int i = 0; i < 4; ++i) { const int t = 16 * tt + 4 * g4 + i; const float b = GS[t], mt = GS[128 + t];
                        const float is = 0.125f * __expf(b + mcar - mt);
                        float den = a1[4][i] + is * a2[4][i]; den = __shfl(den, lane & 48);
                        const float dn = __builtin_amdgcn_rcpf(fmaxf(fabsf(den), __expf(-mt))); float q = 0.f;
#pragma unroll
                        for (int j = 0; j < 4; ++j) { const float v = (a1[j][i] + is * a2[j][i]) * dn; hv[j][i] = v; q += v * v; }
                        q += __shfl_xor(q, 1); q += __shfl_xor(q, 2); q += __shfl_xor(q, 4); q += __shfl_xor(q, 8); ssq[i] = q; }
                    if (r == 0) {
#pragma unroll
                        for (int i = 0; i < 4; ++i) SSQ[half * 64 + 16 * tt + 4 * g4 + i] = ssq[i]; }
                    __syncthreads();
                    const float* ng = ka->in[I_ANG] + (size_t)l * 512 + h * 128;
#pragma unroll
                    for (int i = 0; i < 4; ++i) { const int t = 16 * tt + 4 * g4 + i; const float rstd = rsqrtf((SSQ[t] + SSQ[64 + t]) * (1.f / 128.f) + EPS);
#pragma unroll
                        for (int j = 0; j < 4; ++j) { const int dv = 16 * (half * 4 + j) + r; LAS bf16* op = AOT + t * 136 + dv;
                            *op = (bf16)f2bf(sigmoidf_(bf2f(*op)) * hv[j][i] * rstd * ng[dv]); } }
                    __syncthreads();
                    for (int i = tid; i < 1024; i += NTHR) { const int s = i >> 4, c8 = i & 15; *(u32x4*)(YCAT + (m0 + s) * YW + h * 128 + c8 * 8) = *(const LAS u32x4*)(AOT + s * 136 + c8 * 8); }
                    __syncthreads();
                } else {
                    const int uc2 = u - NUA, bl = uc2 >> 6, c = (uc2 >> 1) & 31, gi = uc2 & 1, hl = wave & 3, th = wave >> 2, hd = gi * 4 + hl; const size_t m0 = (size_t)bl * SEQ + c * 64;
                    LAS bf16* XHs = (LAS bf16*)lds;
                    LAS bf16* HTs = (LAS bf16*)(lds + 36864);
                    LAS bf16* BMg = (LAS bf16*)(lds + 36864 + 69632);
                    LAS bf16* MTt = (LAS bf16*)(lds + 36864 + 69632 + 17408 + wave * 3072);
                    LAS float* ADs = (LAS float*)(lds + 36864 + 69632 + 17408 + 24576);
                    const bf16* Xb = XBC + m0 * 1024;
                    for (int i = tid; i < 2048; i += NTHR) { const int h4 = i >> 9, rem = i & 511, s = rem >> 3, c8 = rem & 7;
                        *(LAS u32x4*)(XHs + h4 * (64 * 72) + s * 72 + c8 * 8) = *(const u32x4*)((Xb + gi * 256) + (unsigned)(s * 1024 + h4 * 64 + c8 * 8)); }
                    { const bf16* Hb = HS + (size_t)((bl * NCH + c) * 8 + gi * 4) * 8192;
                      for (int i = tid; i < 4096; i += NTHR) { const int h4 = i >> 10, rem = i & 1023, p = rem >> 4, c8 = rem & 15;
                        *(LAS u32x4*)(HTs + h4 * (64 * 136) + p * 136 + c8 * 8) = *(const u32x4*)(Hb + (unsigned)(h4 * 8192 + p * 128 + c8 * 8)); } }
                    for (int i = tid; i < 1024; i += NTHR) { const int s = i >> 4, c8 = i & 15; *(LAS u32x4*)(BMg + s * 136 + c8 * 8) = *(const u32x4*)((Xb + 512 + gi * 128) + (unsigned)(s * 1024 + c8 * 8)); }
                    { const int h4 = tid >> 7, arr = (tid >> 6) & 1, s = tid & 63; const float* src = arr ? DTB : ACB; ADs[tid] = (src + m0 * 8 + gi * 4)[(unsigned)(s * 8 + h4)]; }
                    const LAS bf16* XH = XHs + hl * (64 * 72); const LAS bf16* HT = HTs + hl * (64 * 136); const LAS float* AD = ADs + hl * 128;
                    const bf16* Cm = Xb + 768 + gi * 128; const bf16* Zp = P + m0 * PW + P_CZ + hd * 64; const unsigned zlane = (unsigned)(4 * g4 * PW + r), ylane = (unsigned)(4 * g4 * YW + r);
                    bf16* Yp = YCAT + m0 * YW + 1024 + hd * 64; float* Sp = SSQC + m0 * 8 + hd;
                    bf16x8 fcn[4];
#pragma unroll
                    for (int ks = 0; ks < 4; ++ks) fcn[ks] = gfrag_kc(Cm, 1024, 16 * th, 32 * ks, lane);
                    const float dsk = ka->in[I_CDSKIP][l * 8 + hd];
                    __syncthreads();
#pragma unroll 1
                    for (int k2 = 0; k2 < 2; ++k2) { const int tt = k2 ? 3 - th : th;
                        bf16x8 fcm[4]; unsigned short zc[4][4];
#pragma unroll
                        for (int ks = 0; ks < 4; ++ks) fcm[ks] = fcn[ks];
#pragma unroll
                        for (int p = 0; p < 4; ++p)
#pragma unroll
                            for (int i = 0; i < 4; ++i) zc[p][i] = (Zp + (size_t)(16 * tt + i) * PW + 16 * p)[zlane];
#pragma unroll
                        for (int ks = 0; ks < 4; ++ks) fcn[ks] = gfrag_kc(Cm, 1024, 16 * (3 - th), 32 * ks, lane);
                        float at[4];
#pragma unroll
                        for (int i = 0; i < 4; ++i) at[i] = AD[16 * tt + 4 * g4 + i];
#pragma unroll 1
                        for (int st = 0; st <= tt; ++st) { f32x4 acc = zero4();
#pragma unroll
                            for (int ks = 0; ks < 4; ++ks) acc = MFMA16(fcm[ks], frag_kc(BMg, 136, 16 * st, 32 * ks, lane), acc);
                            const int s = 16 * st + r; const float as = AD[s], dts = AD[64 + s];
#pragma unroll
                            for (int i = 0; i < 4; ++i) { const int t = 16 * tt + 4 * g4 + i; acc[i] = (s <= t) ? acc[i] * __expf(at[i] - as) * dts : 0.f; if (s == t) acc[i] += dsk; }
                            *(LAS u32x2*)(MTt + (16 * st + r) * 24 + 4 * g4) = (u32x2){pk2(acc[0], acc[1]), pk2(acc[2], acc[3])}; }
                        if ((tt & 1) == 0) *(LAS u32x2*)(MTt + (16 * (tt + 1) + r) * 24 + 4 * g4) = (u32x2){uzero4().x, uzero4().y};
                        LDS_WAIT(); asm volatile("" ::: "memory");
                        f32x4 ad[4], ao[4];
#pragma unroll
                        for (int p = 0; p < 4; ++p) { ad[p] = zero4(); ao[p] = zero4(); }
#pragma unroll 1
                        for (int ks = 0; ks <= (tt >> 1); ++ks) { const bf16x8 fa = frag_ks(MTt, 24, 0, 32 * ks, lane);
#pragma unroll
                            for (int p = 0; p < 4; ++p) ad[p] = MFMA16(fa, frag_ks(XH, 72, 16 * p, 32 * ks, lane), ad[p]); }
#pragma unroll
                        for (int ks = 0; ks < 4; ++ks)
#pragma unroll
                            for (int p = 0; p < 4; ++p) ao[p] = MFMA16(fcm[ks], frag_kc(HT, 136, 16 * p, 32 * ks, lane), ao[p]);
#pragma unroll
                        for (int i = 0; i < 4; ++i) { const float ea = __expf(at[i]); float q = 0.f;
#pragma unroll
                            for (int p = 0; p < 4; ++p) { const float y = (ad[p][i] + ea * ao[p][i]) * siluf_(bf2f(zc[p][i])); q += y * y;
                                (Yp + (size_t)(16 * tt + i) * YW + 16 * p)[ylane] = (bf16)f2bf(y); }
                            q += __shfl_xor(q, 1); q += __shfl_xor(q, 2); q += __shfl_xor(q, 4); q += __shfl_xor(q, 8);
                            if (r == 0) (Sp + (16 * tt + i) * 8)[(unsigned)(32 * g4)] = q; }
                        LDS_WAIT(); asm volatile("" ::: "memory");
                    }
                    __syncthreads();
                }
            }
            GRID_BAR();
        }

        REPS(PH_LIFT) if (IN(PH_LIFT)) {
            PHASE_BEGIN();
            pg8::Gemm g{YCAT, WliftT, 512, YW, 512, (size_t)512 * 2, (size_t)DM * 512 * 2}; pg8::Order S; S.init(T, DM, NBLK, blk, 4);
            pg8::EpiLift E{P + P_G, PW, MB + (size_t)(grp & 1) * T * DM, DM, SSQC};
            pg8::gemm_phase<pg8::EpiLift, GEMM_ALIGN>(lds, g, S, E);
            GRID_BAR();
        }
        REPS(PH_OUT) if (IN(PH_OUT) && (grp & 1)) {
            PHASE_BEGIN();
            const size_t prow0 = grow0 - T;
            pg8::Gemm g{MB, WoutT, DM, DM, DM, 0, 0}; pg8::Order S; S.init(2 * T, DM, NBLK, blk, 1);
            pg8::EpiResid E{XG + prow0 * DM, DM, SSQ2};
            pg8::gemm_phase<pg8::EpiResid, GEMM_ALIGN>(lds, g, S, E);
            GRID_BAR();
        }
        REPS(PH_UP) if (IN(PH_UP) && (grp & 1)) {
            PHASE_BEGIN();
            const size_t prow0 = grow0 - T;
            pg8::Gemm g{XG + prow0 * DM, WupT, DM, DM, DM, 0, 0}; pg8::Order S; S.init(2 * T, DFF2, NBLK, blk, 1);
            pg8::EpiConvAct E{ACT, SSQ2, ka->in[I_FCW] + (size_t)l * 3 * DFF2, ka->in[I_FCB] + (size_t)l * DFF2, RAWH, lds + 131072, DFF2 / 256};
            pg8::gemm_phase<pg8::EpiConvAct, GEMM_ALIGN>(lds, g, S, E);
            GRID_BAR();
        }
        REPS(PH_DOWN) if (IN(PH_DOWN) && (grp & 1)) {
            PHASE_BEGIN();
            const size_t prow0 = grow0 - T;
            pg8::Gemm g{ACT, WdownT, DFF, DFF, DFF, 0, 0}; pg8::Order S; S.init(2 * T, DM, NBLK, blk, 1);
            {
                const float* fw = ka->in[I_FCW] + (size_t)l * 3 * DFF2; const float* fb = ka->in[I_FCB] + (size_t)l * DFF2;
                pg8::Unit uu;
                for (int i = 0; S.next(i, uu); ++i) { const int pm = uu.pm; if ((pm & 7) == 0) continue;
                    for (int ch = tid; ch < DFF; ch += NTHR) { const int tp = ch >> 7, j = ch & 127;
                        const float* own = RAWH + (size_t)(pm * 22 + tp) * 1024; const float* prv = RAWH + (size_t)((pm - 1) * 22 + tp) * 1024;
                        const float g254 = prv[2 * 256 + j], g255 = prv[3 * 256 + j], g0 = own[j], g1 = own[256 + j];
                        const float u254 = prv[2 * 256 + 128 + j], u255 = prv[3 * 256 + 128 + j], u0 = own[128 + j], u1 = own[256 + 128 + j];
                        const float wg0 = fw[ch], wg1 = fw[DFF2 + ch], wg2 = fw[2 * DFF2 + ch], wu0 = fw[DFF + ch], wu1 = fw[DFF2 + DFF + ch], wu2 = fw[2 * DFF2 + DFF + ch], bg = fb[ch], bu = fb[DFF + ch];
                        ACT[(size_t)(pm * 256) * DFF + ch] = (bf16)f2bf(siluf_(bg + wg0 * g254 + wg1 * g255 + wg2 * g0) * (bu + wu0 * u254 + wu1 * u255 + wu2 * u0));
                        ACT[(size_t)(pm * 256 + 1) * DFF + ch] = (bf16)f2bf(siluf_(bg + wg0 * g255 + wg1 * g0 + wg2 * g1) * (bu + wu0 * u255 + wu1 * u0 + wu2 * u1)); } }
                asm volatile("s_waitcnt vmcnt(0)" ::: "memory"); __syncthreads();
            }
            pg8::EpiResid E{XG + prow0 * DM, DM, SSQ1 + prow0 * 16};
            pg8::gemm_phase<pg8::EpiResid, GEMM_ALIGN>(lds, g, S, E);
            GRID_BAR();
        }
        REPS(PH_FINAL) if (IN(PH_FINAL) && l == DEPTH - 1 && (grp & 1)) {
            PHASE_BEGIN();
            const size_t prow0 = grow0 - T;
            const float* gain = ka->in[I_FING];
            f32x4 gv[4];
#pragma unroll
            for (int j = 0; j < 4; ++j) gv[j] = ((const f32x4*)gain)[lane + 64 * j];
            for (int m = gw; m < 2 * T; m += NGW) {
                const u32x2* xr = (const u32x2*)(XG + (prow0 + m) * DM) + lane;
                f32x4 v[4]; float sq = 0.f;
#pragma unroll
                for (int j = 0; j < 4; ++j) { const u32x2 w = xr[64 * j]; v[j] = (f32x4){bf2f(w.x & 0xffffu), bf2f(w.x >> 16), bf2f(w.y & 0xffffu), bf2f(w.y >> 16)};
                    sq += (v[j].x * v[j].x + v[j].y * v[j].y) + (v[j].z * v[j].z + v[j].w * v[j].w); }
                const float rstd = rsqrtf(wave_sum(sq) * (1.f / DM) + EPS);
                f32x4* orow = (f32x4*)(ka->out + (prow0 + m) * DM) + lane;
#pragma unroll
                for (int j = 0; j < 4; ++j) orow[64 * j] = v[j] * rstd * gv[j];
            }
            GRID_BAR();
        }
    }
#undef IN
#undef GRID_BAR
#undef PHASE_BEGIN
}

#ifndef ONE_LAUNCH
#define ONE_LAUNCH 1
#endif
extern "C" void kernel_launch(void* const* d_in, const int* in_sizes, int n_in, void* d_out, int out_size, void* d_ws, size_t ws_size, hipStream_t stream) {
    static int grid = 0;
    if (grid == 0) {
        if (n_in != N_IN || in_sizes[0] != BATCH * SEQ * DM || out_size != BATCH * SEQ * DM || ws_size < WS_END) {
            fprintf(stderr, "kernel_launch: unexpected shapes / workspace (n_in %d, ws %zu, need %zu); nothing launched\n", n_in, ws_size, (size_t)WS_END); grid = -1; return; }
        int dev = 0, cus = 0, per_cu = 0;
        if (hipGetDevice(&dev) != hipSuccess || hipDeviceGetAttribute(&cus, hipDeviceAttributeMultiprocessorCount, dev) != hipSuccess) { grid = -1; return; }
        if (hipFuncSetAttribute((const void*)fwd, hipFuncAttributeMaxDynamicSharedMemorySize, LDS_BYTES) != hipSuccess) { fprintf(stderr, "kernel_launch: hipFuncSetAttribute failed\n"); grid = -1; return; }
        if (hipOccupancyMaxActiveBlocksPerMultiprocessor(&per_cu, (const void*)fwd, NTHR, LDS_BYTES) != hipSuccess || per_cu < 1) { fprintf(stderr, "kernel_launch: occupancy query says %d\n", per_cu); (void)hipGetLastError(); }
        grid = cus;
    }
    if (grid < 0) return;
    (void)hipMemsetAsync((char*)d_ws + WS_CTL, 0, CTL_BYTES, stream);
    Args a{};
    for (int i = 0; i < N_IN; ++i) a.in[i] = (const float*)d_in[i];
    a.out = (float*)d_out; a.ws = (unsigned char*)d_ws; a.pad = 0;
#if ONE_LAUNCH
    a.l_lo = 0; a.l_hi = DEPTH; a.g_lo = 0; a.g_hi = NG; a.ph_lo = 0; a.ph_hi = PH_COUNT; a.use_bar = 1;
    hipLaunchKernelGGL(fwd, dim3(grid), dim3(NTHR), LDS_BYTES, stream, a);
#else
    a.use_bar = 0;
    for (int l = 0; l < DEPTH; ++l)
        for (int g = 0; g < NG; ++g)
            for (int ph = 0; ph < PH_COUNT; ++ph) {
                if (ph == PH_W && g != 0) continue;
                if (ph == PH_FINAL && l != DEPTH - 1) continue;
                if ((ph == PH_OUT || ph == PH_UP || ph == PH_DOWN || ph == PH_FINAL) && !(g & 1)) continue;
                a.l_lo = l; a.l_hi = l + 1; a.g_lo = g; a.g_hi = g + 1; a.ph_lo = ph; a.ph_hi = ph + 1;
                hipLaunchKernelGGL(fwd, dim3(grid), dim3(NTHR), LDS_BYTES, stream, a);
            }
#endif
}
```

```cpp
#include <hip/hip_runtime.h>
#include <cstdio>
#include <cstdint>

#define LAS __attribute__((address_space(3)))
#define GAS __attribute__((address_space(1)))
typedef unsigned short bf16;
typedef short bf16x8 __attribute__((ext_vector_type(8)));
typedef short s16x4 __attribute__((ext_vector_type(4)));
typedef float f32x4 __attribute__((ext_vector_type(4)));
typedef float f32x2 __attribute__((ext_vector_type(2)));
typedef unsigned u32x4 __attribute__((ext_vector_type(4)));
typedef unsigned u32x2 __attribute__((ext_vector_type(2)));

constexpr int DM = 1024, BATCH = 32, SEQ = 2048, DEPTH = 4;
constexpr int PIN = 10256, PW = 10240, DFF = 2816, DFF2 = 5632;
constexpr int GB = 8;
constexpr int NG = BATCH / GB;
constexpr int T = GB * SEQ;
constexpr int NCH = SEQ / 64;
constexpr float EPS = 1e-6f;
constexpr int P_AQ = 0, P_AK = 256, P_AV = 512, P_AO = 1024, P_BB = 1536, P_BC = 2048, P_BX = 2560, P_CZ = 3072, P_CX = 3584, P_SQ = 4608, P_SK = 5120, P_SV = 5632, P_G = 6144;
constexpr int YW = 2048;

constexpr size_t MiB = 1u << 20;
constexpr size_t WS_CTL = 0, CTL_BYTES = 1 * MiB;
constexpr size_t WS_WIN = 1 * MiB;
constexpr size_t WS_WLIFT = WS_WIN + (size_t)PW * DM * 2;
constexpr size_t WS_WOUT = WS_WLIFT + (size_t)4 * DM * 512 * 2;
constexpr size_t WS_WUP = WS_WOUT + (size_t)DM * DM * 2;
constexpr size_t WS_WDOWN = WS_WUP + (size_t)DFF2 * DM * 2;
constexpr size_t WS_W16 = WS_WDOWN + (size_t)DM * DFF * 2;
constexpr size_t WS_XN = WS_W16 + 65536;
constexpr size_t WS_P = WS_XN + (size_t)T * DM * 2;
constexpr size_t WS_U = WS_P, WS_ACT = WS_P;
constexpr size_t WS_YCAT = WS_P + (size_t)T * PW * 2;
constexpr size_t WS_XG = WS_YCAT + (size_t)T * YW * 2;
constexpr size_t WS_MB = WS_XG + (size_t)BATCH * SEQ * DM * 2;
constexpr size_t WS_SP = WS_MB + (size_t)2 * T * DM * 2;
constexpr size_t WS_GB = WS_SP + (size_t)T * 16 * 4;
constexpr size_t WS_GG = WS_GB + (size_t)T * 16;
constexpr size_t WS_GMT = WS_GG + (size_t)T * 16;
constexpr size_t WS_MCAR = WS_GMT + (size_t)T * 16;
constexpr size_t WS_MNEW = WS_MCAR + 4096;
constexpr size_t WS_MSC = WS_MNEW + 4096;
constexpr size_t WS_SUMB = WS_MSC + 4096, WS_SUMG = WS_SUMB + 4096;
constexpr size_t WS_DT = WS_SUMG + 4096;
constexpr size_t WS_AC = WS_DT + (size_t)T * 32;
constexpr size_t WS_XBC = WS_AC + (size_t)T * 32;
constexpr size_t WS_DC = WS_XBC + (size_t)T * DM * 2;
constexpr size_t WS_CS = WS_DC + (size_t)GB * 4 * NCH * 9216 * 4;
constexpr size_t WS_DH = WS_CS + (size_t)GB * 4 * NCH * 9216 * 2;
constexpr size_t WS_HS = WS_DH + (size_t)GB * NCH * 8 * 8192 * 4;
constexpr size_t WS_SSQ1 = WS_HS + (size_t)GB * NCH * 8 * 8192 * 2;
constexpr size_t WS_SSQ2 = WS_SSQ1 + (size_t)BATCH * SEQ * 64;
constexpr size_t WS_SSQC = WS_SSQ2 + (size_t)2 * T * 64;
constexpr size_t WS_RAWH = WS_SSQC + (size_t)T * 32;
constexpr size_t WS_END = WS_RAWH + (size_t)(2 * T / 256) * 22 * 4 * 256 * 4;

constexpr int NWAVES = 8, NTHR = 512;
constexpr int LDS_BYTES = 155648;
constexpr int MISC_OFF = 153600;

__device__ __forceinline__ float bf2f(unsigned b) { return __uint_as_float(b << 16); }
__device__ __forceinline__ unsigned f2bf(float f) { unsigned u = __float_as_uint(f); return (u + 0x7fffu + ((u >> 16) & 1u)) >> 16; }
__device__ __forceinline__ unsigned pk2(float lo, float hi) { return f2bf(lo) | (f2bf(hi) << 16); }
__device__ __forceinline__ float sigmoidf_(float x) { return __builtin_amdgcn_rcpf(1.f + __builtin_amdgcn_exp2f(-1.4426950408889634f * x)); }
__device__ __forceinline__ float siluf_(float x) { return x * __builtin_amdgcn_rcpf(1.f + __builtin_amdgcn_exp2f(-1.4426950408889634f * x)); }
__device__ __forceinline__ float logsigf_(float x) { return fminf(x, 0.f) - log1pf(expf(-fabsf(x))); }
__device__ __forceinline__ float softplusf_(float x) { return fmaxf(x, 0.f) + log1pf(expf(-fabsf(x))); }
__device__ __forceinline__ float wave_sum(float v) {
#pragma unroll
    for (int o = 1; o < 64; o <<= 1) v += __shfl_xor(v, o);
    return v;
}
#define LDS_WAIT() asm volatile("s_waitcnt lgkmcnt(0)" ::: "memory")
__device__ __forceinline__ float row_rstd(const float* ssq16) {
    const f32x4* p = (const f32x4*)ssq16; const f32x4 a = (p[0] + p[1]) + (p[2] + p[3]);
    return rsqrtf(((a.x + a.y) + (a.z + a.w)) * (1.f / 1024.f) + 1e-6f);
}

namespace pg8 {
constexpr int BM = 256, BK = 64, HALF = 128, HTB = HALF * BK * 2, STAGE_BYTES = 8 * HTB, NXCD = 8, WGM = 4;
__host__ __device__ __forceinline__ int lds_byte(int r, int c) { const int st = (r >> 4) * 2 + (c >> 5), rr = r & 15, cc = c & 31, ob = rr * 64 + cc * 2; return st * 1024 + (ob ^ (((ob >> 9) & 1) << 5)); }
__host__ __device__ __forceinline__ void stage_rc(int b, int& R, int& C) { const int st = b / 1024, sb = b % 1024, swz = sb ^ (((sb >> 9) & 1) << 5); R = (st >> 1) * 16 + swz / 64; C = (st & 1) * 32 + (swz % 64) / 2; }
__host__ __device__ __forceinline__ int perm32(int rho) { const int n = rho >> 4, i = rho & 15; return 8 * (i >> 2) + 4 * n + (i & 3); }

struct Unit { int pm, pn, z; };
struct Gemm { const bf16* A; const bf16* Bt; int K, lda, ldb; size_t zA, zB; };

struct Order {
    int nM, nN, nwg, G, c, Z;
    __device__ __forceinline__ void init(int M, int N, int G_, int c_, int Z_) { nM = M / BM; nN = N / BM; nwg = nM * nN; G = G_; c = c_; Z = Z_; }
    __device__ __forceinline__ bool next(int i, Unit& u) const {
        const int ti = i / Z; u.z = i - ti * Z;
        const long L = (long)ti * G + c; if (L >= nwg) return false;
        int wgid = (int)L; { const int q = nwg / NXCD, r = nwg % NXCD, xcd = wgid % NXCD, off = wgid / NXCD; wgid = (xcd < r ? xcd * (q + 1) : r * (q + 1) + (xcd - r) * q) + off; }
        const int nig = WGM * nN, gid = wgid / nig, fm = gid * WGM, gsz = (nM - fm) < WGM ? (nM - fm) : WGM;
        u.pm = fm + ((wgid % nig) % gsz); u.pn = (wgid % nig) / gsz; return true;
    }
};
__device__ __forceinline__ unsigned cvt_pk_bf16(float lo, float hi) { unsigned r; asm volatile("s_nop 0\n\tv_cvt_pk_bf16_f32 %0, %1, %2" : "=v"(r) : "v"(lo), "v"(hi)); return r; }

__device__ __forceinline__ void panel_rstd(LAS float* rsl, const float* ssq, int pm, int wr, int wc, int fr, int fq) {
    volatile LAS int* tag = (volatile LAS int*)(rsl + 256);
    if (__builtin_amdgcn_readfirstlane(*tag) != pm) {
        const int tidl = (wr * 4 + wc) * 64 + fq * 16 + fr, rr = tidl >> 1, hf = tidl & 1;
        const f32x4* p = (const f32x4*)(ssq + (size_t)(pm * BM + rr) * 16 + hf * 8); const f32x4 a = p[0] + p[1];
        float sq = (a.x + a.y) + (a.z + a.w); sq += __shfl_xor(sq, 1);
        __builtin_amdgcn_s_barrier();
        if (hf == 0) rsl[rr] = rsqrtf(sq * (1.f / 1024.f) + 1e-6f);
        if (tidl == 0) *tag = pm;
        asm volatile("s_waitcnt lgkmcnt(0)" ::: "memory"); __builtin_amdgcn_s_barrier(); asm volatile("" ::: "memory");
    }
}
struct EpiBf16 {
    static constexpr bool PERM = true, KEEP = false, CONTIG = true;
    LAS float* rsl;
    bf16* O; int ldc; const float* ssq; int gate_pn0;
    static __device__ __forceinline__ float s1(float x) { return 1.f + __builtin_amdgcn_exp2f(-1.4426950408889634f * __builtin_amdgcn_fmed3f(x, -30.f, 30.f)); }
    __device__ __forceinline__ void operator()(f32x4 (&acc)[2][2][4][2], const Unit& u, int wr, int wc, int fr, int fq) const {
        panel_rstd(rsl, ssq, u.pm, wr, wc, fr, fq);
        if (u.pn >= gate_pn0) {
            const int row0g = u.pm * BM + wr * 64 + fr, d0 = 64 * (u.pn - gate_pn0) + 16 * wc + 4 * fq;
#pragma unroll
            for (int ai = 0; ai < 2; ++ai)
#pragma unroll
                for (int m = 0; m < 4; ++m) { const int row = row0g + ai * HALF + m * 16; bf16* rowp = O + (size_t)row * ldc + gate_pn0 * BM + d0;
                    const float rs = rsl[wr * 64 + fr + ai * HALF + m * 16];
                    float one = 1.f; asm volatile("" : "+v"(one));
                    float f0[4], f1[4], f2[4], f3[4];
#pragma unroll
                    for (int e = 0; e < 4; ++e) { const float a0 = s1(acc[ai][0][m][0][e] * rs), a1 = s1(acc[ai][0][m][1][e] * rs), a2 = s1(acc[ai][1][m][0][e] * rs), a3 = s1(acc[ai][1][m][1][e] * rs);
                        f0[e] = a1 * __builtin_amdgcn_rcpf(a0); f1[e] = a2 * __builtin_amdgcn_rcpf(a1); f2[e] = a3 * __builtin_amdgcn_rcpf(a2); f3[e] = one * __builtin_amdgcn_rcpf(a3); }
                    *(u32x2*)(rowp) = (u32x2){cvt_pk_bf16(f0[0], f0[1]), cvt_pk_bf16(f0[2], f0[3])};
                    *(u32x2*)(rowp + 1024) = (u32x2){cvt_pk_bf16(f1[0], f1[1]), cvt_pk_bf16(f1[2], f1[3])};
                    *(u32x2*)(rowp + 2048) = (u32x2){cvt_pk_bf16(f2[0], f2[1]), cvt_pk_bf16(f2[2], f2[3])};
                    *(u32x2*)(rowp + 3072) = (u32x2){cvt_pk_bf16(f3[0], f3[1]), cvt_pk_bf16(f3[2], f3[3])}; }
            return; }
        const int row0 = u.pm * BM + wr * 64 + fr, col0 = u.pn * BM + wc * 64 + 8 * fq;
#pragma unroll
        for (int ai = 0; ai < 2; ++ai)
#pragma unroll
            for (int m = 0; m < 4; ++m) { const int row = row0 + ai * HALF + m * 16; bf16* rowp = O + (size_t)row * ldc + col0;
                const float rs = rsl[wr * 64 + fr + ai * HALF + m * 16];
#pragma unroll
                for (int bj = 0; bj < 2; ++bj) { const f32x4 v0 = acc[ai][bj][m][0] * rs, v1 = acc[ai][bj][m][1] * rs;
                    u32x4 w; w.x = cvt_pk_bf16(v0[0], v0[1]); w.y = cvt_pk_bf16(v0[2], v0[3]); w.z = cvt_pk_bf16(v1[0], v1[1]); w.w = cvt_pk_bf16(v1[2], v1[3]);
                    *(u32x4*)(rowp + bj * 32) = w; } }
    }
};
struct EpiResid {
    static constexpr bool PERM = true, KEEP = false, CONTIG = true;
    bf16* xb; int ldc; float* ssq;
    __device__ __forceinline__ void operator()(f32x4 (&acc)[2][2][4][2], const Unit& u, int wr, int wc, int fr, int fq) const {
        const int row0 = u.pm * BM + wr * 64 + fr, col0 = u.pn * BM + wc * 64 + 8 * fq;
#pragma unroll
        for (int ai = 0; ai < 2; ++ai)
#pragma unroll
            for (int m = 0; m < 4; ++m) { const int row = row0 + ai * HALF + m * 16; const size_t off = (size_t)row * ldc + col0; float q = 0.f;
#pragma unroll
                for (int bj = 0; bj < 2; ++bj) {
                    const u32x4 o = *(const u32x4*)(xb + off + bj * 32);
                    const f32x4 x0 = (f32x4){bf2f(o.x & 0xffffu), bf2f(o.x >> 16), bf2f(o.y & 0xffffu), bf2f(o.y >> 16)} + acc[ai][bj][m][0];
                    const f32x4 x1 = (f32x4){bf2f(o.z & 0xffffu), bf2f(o.z >> 16), bf2f(o.w & 0xffffu), bf2f(o.w >> 16)} + acc[ai][bj][m][1];
                    q += (x0[0] * x0[0] + x0[1] * x0[1]) + (x0[2] * x0[2] + x0[3] * x0[3]) + (x1[0] * x1[0] + x1[1] * x1[1]) + (x1[2] * x1[2] + x1[3] * x1[3]);
                    u32x4 w; w.x = cvt_pk_bf16(x0[0], x0[1]); w.y = cvt_pk_bf16(x0[2], x0[3]); w.z = cvt_pk_bf16(x1[0], x1[1]); w.w = cvt_pk_bf16(x1[2], x1[3]);
                    *(u32x4*)(xb + off + bj * 32) = w; }
                q += __shfl_xor(q, 16); q += __shfl_xor(q, 32); if (fq == 0) ssq[(size_t)row * 16 + u.pn * 4 + wc] = q;
            }
    }
};
struct EpiLift {
    static constexpr bool PERM = true, KEEP = true, CONTIG = false;
    const bf16* fac; int ldg; bf16* mb; int ldc; const float* ssqc;
    __device__ __forceinline__ void operator()(f32x4 (&acc)[2][2][4][2], const Unit& u, int wr, int wc, int fr, int fq) const {
        const int row0 = u.pm * BM + wr * 64 + fr, col0 = u.pn * BM + wc * 32 + 8 * fq;
#pragma unroll
        for (int ai = 0; ai < 2; ++ai)
#pragma unroll
            for (int m = 0; m < 4; ++m) { const int row = row0 + ai * HALF + m * 16;
                float rsc = 1.f;
                if (u.z == 1 || u.z == 2) { const f32x2 p = *(const f32x2*)(ssqc + (size_t)row * 8 + 2 * fq); float sq = p.x + p.y; sq += __shfl_xor(sq, 16); sq += __shfl_xor(sq, 32);
                    const float v = sq * (1.f / 512.f) + 1e-6f; rsc = (u.z == 1) ? sqrtf(v) : rsqrtf(v); }
#pragma unroll
                for (int bj = 0; bj < 2; ++bj) { const int col = col0 + bj * HALF;
                    const u32x4 g0 = *(const u32x4*)(fac + (size_t)row * ldg + u.z * 1024 + col);
                    f32x4& v0 = acc[ai][bj][m][0]; f32x4& v1 = acc[ai][bj][m][1];
                    v0[0] *= rsc * bf2f(g0.x & 0xffffu); v0[1] *= rsc * bf2f(g0.x >> 16); v0[2] *= rsc * bf2f(g0.y & 0xffffu); v0[3] *= rsc * bf2f(g0.y >> 16);
                    v1[0] *= rsc * bf2f(g0.z & 0xffffu); v1[1] *= rsc * bf2f(g0.z >> 16); v1[2] *= rsc * bf2f(g0.w & 0xffffu); v1[3] *= rsc * bf2f(g0.w >> 16);
                    if (u.z == 3) { u32x4 w; w.x = cvt_pk_bf16(v0[0], v0[1]); w.y = cvt_pk_bf16(v0[2], v0[3]); w.z = cvt_pk_bf16(v1[0], v1[1]); w.w = cvt_pk_bf16(v1[2], v1[3]);
                        *(u32x4*)(mb + (size_t)row * ldc + col) = w; } } }
    }
};

__device__ __forceinline__ float dpp_ror1(float x) { return __int_as_float(__builtin_amdgcn_update_dpp(0, __float_as_int(x), 0x121, 0xf, 0xf, false)); }
__device__ __forceinline__ float dpp_ror2(float x) { return __int_as_float(__builtin_amdgcn_update_dpp(0, __float_as_int(x), 0x122, 0xf, 0xf, false)); }
__device__ __forceinline__ float dpp_prev1(float cur, float prev) { return __int_as_float(__builtin_amdgcn_update_dpp(__builtin_amdgcn_update_dpp(0, __float_as_int(prev), 0x121, 0xf, 0xf, false), __float_as_int(cur), 0x111, 0xf, 0xf, false)); }
__device__ __forceinline__ float dpp_prev2(float cur, float prev) { return __int_as_float(__builtin_amdgcn_update_dpp(__builtin_amdgcn_update_dpp(0, __float_as_int(prev), 0x122, 0xf, 0xf, false), __float_as_int(cur), 0x112, 0xf, 0xf, false)); }
struct EpiConvAct {
    static constexpr bool PERM = true, KEEP = false, CONTIG = false;
    bf16* act; const float* ssq; const float* cw; const float* cb; float* rawh; LAS unsigned char* halo; int ntn;
    __device__ __forceinline__ void operator()(f32x4 (&acc)[2][2][4][2], const Unit& u, int wr, int wc, int fr, int fq) const {
        asm volatile("" : "+v"(fr), "+v"(fq));
        const int row0 = u.pm * BM + wr * 64 + fr, ch0 = u.pn * 128 + wc * 32 + 8 * fq;
        LAS float* rsl = (LAS float*)(halo + 12288);
        panel_rstd(rsl, ssq, u.pm, wr, wc, fr, fq);
#pragma unroll
        for (int ai = 0; ai < 2; ++ai)
#pragma unroll
            for (int m = 0; m < 4; ++m) { const float rs = rsl[wr * 64 + fr + ai * HALF + m * 16];
#pragma unroll
                for (int bj = 0; bj < 2; ++bj) { acc[ai][bj][m][0] = acc[ai][bj][m][0] * rs; acc[ai][bj][m][1] = acc[ai][bj][m][1] * rs; } }
        LAS f32x4* H = (LAS f32x4*)halo;
        if (fr >= 14) {
#pragma unroll
            for (int ai = 0; ai < 2; ++ai) { const int b = 2 * ai + wr;
#pragma unroll
                for (int bj = 0; bj < 2; ++bj)
#pragma unroll
                    for (int n = 0; n < 2; ++n) H[((((b * 4 + wc) * 4 + fq) * 2 + (fr - 14)) * 2 + bj) * 2 + n] = acc[ai][bj][3][n]; } }
        { float* rw = rawh + (size_t)(u.pm * ntn + u.pn) * 1024;
          if (wr == 1 && fr >= 14) {
#pragma unroll
            for (int bj = 0; bj < 2; ++bj)
#pragma unroll
                for (int n = 0; n < 2; ++n) *(f32x4*)(rw + (2 + fr - 14) * 256 + bj * HALF + wc * 32 + 8 * fq + 4 * n) = acc[1][bj][3][n]; }
          if (wr == 0 && fr < 2) {
#pragma unroll
            for (int bj = 0; bj < 2; ++bj)
#pragma unroll
                for (int n = 0; n < 2; ++n) *(f32x4*)(rw + fr * 256 + bj * HALF + wc * 32 + 8 * fq + 4 * n) = acc[0][bj][0][n]; } }
        LAS float* WL = (LAS float*)(halo + 8192);
        { const int tidl = (wr * 4 + wc) * 64 + fq * 16 + fr, i2 = tidl * 2, kind = i2 >> 7, c = i2 & 127, k4 = kind & 3;
          const float* src = (k4 < 3 ? cw + k4 * 5632 : cb) + (kind >= 4 ? 2816 : 0) + u.pn * 128 + c;
          *(LAS f32x2*)(WL + i2) = *(const f32x2*)src; }
        asm volatile("s_waitcnt vmcnt(0) lgkmcnt(0)" ::: "memory"); __builtin_amdgcn_s_barrier(); asm volatile("" ::: "memory");
        bf16* actb = act + (size_t)(u.pm * BM + wr * 64) * 2816 + u.pn * 128 + wc * 32;
        const unsigned alane = (unsigned)(fr * 2816 + 8 * fq);
        unsigned pkw[2][4][3];
#pragma unroll
        for (int n = 0; n < 2; ++n) {
#pragma unroll
            for (int eh = 0; eh < 2; ++eh) {
                const int cl = wc * 32 + 8 * fq + 4 * n + 2 * eh;
                f32x2 wg[3], wu[3], bg, bu;
#pragma unroll
                for (int j = 0; j < 3; ++j) { wg[j] = *(const LAS f32x2*)(WL + j * 128 + cl); wu[j] = *(const LAS f32x2*)(WL + (4 + j) * 128 + cl); }
                bg = *(const LAS f32x2*)(WL + 3 * 128 + cl); bu = *(const LAS f32x2*)(WL + 7 * 128 + cl);
#pragma unroll
                for (int ai = 0; ai < 2; ++ai) { const int b = 2 * ai + wr;
#pragma unroll
                    for (int m = 3; m >= 0; --m) {
                        float r2[2];
#pragma unroll
                        for (int e2 = 0; e2 < 2; ++e2) { const int e = 2 * eh + e2;
                            const float gc = acc[ai][0][m][n][e], uc = acc[ai][1][m][n][e];
                            float gp = 0.f, up = 0.f; asm volatile("" : "+v"(gp), "+v"(up));
                            if (m > 0) { gp = acc[ai][0][m - 1][n][e]; up = acc[ai][1][m - 1][n][e]; }
                            else if (b >= 1) { const int fk = fr >= 14 ? fr - 14 : 0; const LAS float* hp = (const LAS float*)(H + ((((b - 1) * 4 + wc) * 4 + fq) * 2 + fk) * 4 + n); gp = hp[e]; up = hp[8 + e]; }
                            const float g1 = dpp_prev1(gc, gp), g2 = dpp_prev2(gc, gp), u1 = dpp_prev1(uc, up), u2 = dpp_prev2(uc, up);
                            const float vg = bg[e2] + wg[0][e2] * g2 + wg[1][e2] * g1 + wg[2][e2] * gc;
                            const float vu = bu[e2] + wu[0][e2] * u2 + wu[1][e2] * u1 + wu[2][e2] * uc;
                            r2[e2] = siluf_(vg) * vu; }
                        const unsigned pk = cvt_pk_bf16(r2[0], r2[1]);
                        if (2 * n + eh < 3) pkw[ai][m][2 * n + eh] = pk;
                        else *(u32x4*)(actb + (size_t)(ai * HALF + m * 16) * 2816 + alane) = (u32x4){pkw[ai][m][0], pkw[ai][m][1], pkw[ai][m][2], pk};
                    }
                }
            }
        }
    }
};

template <class Epi, bool ALIGN_EPI = true>
__device__ __forceinline__ void gemm_phase(LAS unsigned char* lds, const Gemm g, const Order& S, const Epi& E) {
    int tid = threadIdx.x; asm volatile("" : "+v"(tid));
    const int wid = __builtin_amdgcn_readfirstlane(tid >> 6), lane = tid & 63, wr = wid >> 2, wc = wid & 3, fr = lane & 15, fq = lane >> 4;
    const int K = g.K, nt = K / BK;
    unsigned voffA[2], voffB[2];
#pragma unroll
    for (int i = 0; i < 2; ++i) { int R, C; stage_rc(tid * 16 + i * 8192, R, C);
        const int Rb = Epi::CONTIG ? (64 * (R >> 5) + perm32(R & 31)) : (Epi::PERM ? ((R & ~31) + perm32(R & 31)) : R);
        voffA[i] = (unsigned)(R * g.lda + C) * 2u; voffB[i] = (unsigned)(Rb * g.ldb + C) * 2u; }
    const size_t kstep = (size_t)(BK * 2);
    const size_t hstepA = (size_t)HALF * g.lda * 2, hstepB = (size_t)(Epi::CONTIG ? 32 : HALF) * g.ldb * 2;
    const size_t tstepA = 2 * hstepA, tstepB = (size_t)BM * g.ldb * 2;
    const unsigned ldsw = (unsigned)wid * 1024u;
    const int aoff = lds_byte(wr * 64 + fr, fq * 8), boff = lds_byte(wc * 32 + fr, fq * 8);
#define PG8_SA(b, h) (((b) * 2 + (h)) * HTB)
#define PG8_SB(b, h) ((4 + (b) * 2 + (h)) * HTB)
#define PG8_STAGE(bufoff, gbase, voff) do { _Pragma("unroll") for (int _i = 0; _i < 2; ++_i) \
        __builtin_amdgcn_global_load_lds((const unsigned*)((const char*)(gbase) + (voff)[_i]), (LAS unsigned*)(lds + (bufoff) + ldsw + _i * 8192), 16, 0, 0); } while (0)
#define PG8_LDA(dst, b, h) do { _Pragma("unroll") for (int m = 0; m < 4; ++m) _Pragma("unroll") for (int k = 0; k < 2; ++k) dst[m][k] = *(const LAS bf16x8*)(lds + PG8_SA(b, h) + aoff + m * 2048 + k * 1024); } while (0)
#define PG8_LDB(dst, b, h) do { _Pragma("unroll") for (int n = 0; n < 2; ++n) _Pragma("unroll") for (int k = 0; k < 2; ++k) dst[n][k] = *(const LAS bf16x8*)(lds + PG8_SB(b, h) + boff + n * 2048 + k * 1024); } while (0)
#define PG8_MMA(ai, bj, At, Bt) do { __builtin_amdgcn_s_setprio(1); _Pragma("unroll") for (int m = 0; m < 4; ++m) _Pragma("unroll") for (int n = 0; n < 2; ++n) _Pragma("unroll") for (int k = 0; k < 2; ++k) \
        acc[ai][bj][m][n] = __builtin_amdgcn_mfma_f32_16x16x32_bf16(Bt[n][k], At[m][k], acc[ai][bj][m][n], 0, 0, 0); __builtin_amdgcn_s_setprio(0); } while (0)
#define PG8_WAIT_V(n) asm volatile("s_waitcnt vmcnt(" #n ")" ::: "memory")
#define PG8_WAIT_L(n) asm volatile("s_waitcnt lgkmcnt(" #n ")" ::: "memory")
#define PG8_BAR __builtin_amdgcn_s_barrier()
#define PG8_SCHED __builtin_amdgcn_sched_barrier(0)
    Unit cur, nxt; int ui = 0;
    if (!S.next(0, cur)) return;
    f32x4 acc[2][2][4][2];
#pragma unroll
    for (int a = 0; a < 2; ++a)
#pragma unroll
        for (int b = 0; b < 2; ++b)
#pragma unroll
            for (int m = 0; m < 4; ++m)
#pragma unroll
                for (int n = 0; n < 2; ++n) acc[a][b][m][n] = (f32x4){0.f, 0.f, 0.f, 0.f};
    bf16x8 At[4][2], B0[2][2], B1[2][2];
    const char* cA = (const char*)g.A + (size_t)cur.pm * tstepA + (size_t)cur.z * g.zA; const char* cB = (const char*)g.Bt + (size_t)cur.pn * tstepB + (size_t)cur.z * g.zB;
    PG8_STAGE(PG8_SB(0, 0), cB, voffB); PG8_STAGE(PG8_SB(0, 1), cB + hstepB, voffB); PG8_STAGE(PG8_SA(0, 0), cA, voffA); PG8_STAGE(PG8_SA(0, 1), cA + hstepA, voffA);
    if (wr == 1) PG8_BAR;
    PG8_WAIT_V(2); PG8_BAR;
    PG8_STAGE(PG8_SB(1, 0), cB + kstep, voffB); PG8_STAGE(PG8_SA(1, 0), cA + kstep, voffA); PG8_STAGE(PG8_SB(1, 1), cB + hstepB + kstep, voffB);
    PG8_WAIT_V(6); PG8_BAR;
    for (;;) {
        const bool has_next = S.next(ui + 1, nxt);
        const char* nA = has_next ? (const char*)g.A + (size_t)nxt.pm * tstepA + (size_t)nxt.z * g.zA : cA; const char* nB = has_next ? (const char*)g.Bt + (size_t)nxt.pn * tstepB + (size_t)nxt.z * g.zB : cB;
        for (int t = 0; t < nt; t += 2) {
            const bool last = (t == nt - 2);
            const char* a1 = cA + (size_t)(t + 1) * kstep;
            const char* a2 = last ? nA : cA + (size_t)(t + 2) * kstep; const char* b2 = last ? nB : cB + (size_t)(t + 2) * kstep;
            const char* a3 = a2 + kstep; const char* b3 = b2 + kstep;
            PG8_LDB(B0, 0, 0); PG8_LDB(B1, 0, 1); PG8_SCHED; PG8_LDA(At, 0, 0); PG8_STAGE(PG8_SA(1, 1), a1 + hstepA, voffA);
            PG8_WAIT_V(8); PG8_WAIT_L(0); PG8_BAR; PG8_MMA(0, 0, At, B0); PG8_MMA(0, 1, At, B1); PG8_BAR; PG8_SCHED;
            PG8_LDA(At, 0, 1); PG8_STAGE(PG8_SB(0, 0), b2, voffB); PG8_STAGE(PG8_SB(0, 1), b2 + hstepB, voffB); PG8_STAGE(PG8_SA(0, 0), a2, voffA);
            PG8_WAIT_V(8); PG8_WAIT_L(0); PG8_BAR; PG8_MMA(1, 0, At, B0); PG8_MMA(1, 1, At, B1); PG8_BAR; PG8_SCHED;
            PG8_LDB(B0, 1, 0); PG8_LDB(B1, 1, 1); PG8_SCHED; PG8_LDA(At, 1, 0); PG8_STAGE(PG8_SA(0, 1), a2 + hstepA, voffA);
            PG8_WAIT_V(8); PG8_WAIT_L(0); PG8_BAR; PG8_MMA(0, 0, At, B0); PG8_MMA(0, 1, At, B1); PG8_BAR; PG8_SCHED;
            PG8_LDA(At, 1, 1); PG8_STAGE(PG8_SB(1, 0), b3, voffB); PG8_STAGE(PG8_SB(1, 1), b3 + hstepB, voffB); PG8_STAGE(PG8_SA(1, 0), a3, voffA);
            PG8_WAIT_V(8); PG8_WAIT_L(0); PG8_BAR; PG8_MMA(1, 0, At, B0); PG8_MMA(1, 1, At, B1); PG8_BAR; PG8_SCHED;
        }
        if constexpr (ALIGN_EPI) { if (wr == 0) PG8_BAR; }
        E(acc, cur, wr, wc, fr, fq);
        if (!has_next) break;
        if (!(Epi::KEEP && nxt.z != 0))
#pragma unroll
        for (int a = 0; a < 2; ++a)
#pragma unroll
            for (int b = 0; b < 2; ++b)
#pragma unroll
                for (int m = 0; m < 4; ++m)
#pragma unroll
                    for (int n = 0; n < 2; ++n) acc[a][b][m][n] = (f32x4){0.f, 0.f, 0.f, 0.f};
        cur = nxt; cA = nA; cB = nB; ++ui;
        if constexpr (ALIGN_EPI) { if (wr == 1) PG8_BAR; }
    }
    PG8_WAIT_V(0);
    if constexpr (!ALIGN_EPI) { if (wr == 0) PG8_BAR; }
    PG8_BAR;
#undef PG8_SA
#undef PG8_SB
#undef PG8_STAGE
#undef PG8_LDA
#undef PG8_LDB
#undef PG8_MMA
#undef PG8_WAIT_V
#undef PG8_WAIT_L
#undef PG8_BAR
#undef PG8_SCHED
}
}

#define XB_TMO      128
#define XB_XCNT(j)  (256  + 64 * (j))
#define XB_XSUB(j)  (1280 + 64 * (j))
#define XB_XGEN(j)  (2304 + 64 * (j))
#define XB_TOP      3328
#define XB_TOPGEN   3392
#define XCD_BAR_WORDS 3456
#define XB_SPIN_CAP (1u << 18)
__device__ __forceinline__ unsigned xb_ld(unsigned* p)              { return __hip_atomic_load(p, __ATOMIC_RELAXED, __HIP_MEMORY_SCOPE_AGENT); }
__device__ __forceinline__ unsigned xb_add(unsigned* p, unsigned v) { return __hip_atomic_fetch_add(p, v, __ATOMIC_RELAXED, __HIP_MEMORY_SCOPE_AGENT); }
__device__ __forceinline__ unsigned xb_xcc_id() { return (unsigned)__builtin_amdgcn_s_getreg((3 << 11) | 20) & 0xFu; }
#define XB_SPIN(cond, bar) do { unsigned _sp = 0; while (cond) { __builtin_amdgcn_s_sleep(1); \
    if ((++_sp & 255u) == 0u) { if (xb_ld(&(bar)[XB_TMO])) break; if (_sp > XB_SPIN_CAP) { atomicAdd(&(bar)[XB_TMO], 1u); break; } } } } while (0)
struct XcdBarrier { unsigned* bar; unsigned x; volatile LAS unsigned* st; };
__device__ __forceinline__ XcdBarrier xcd_barrier_post(unsigned* bar, volatile LAS unsigned* st) {
    XcdBarrier b; b.bar = bar; b.x = xb_xcc_id(); b.st = st;
    if (threadIdx.x == 0) (void)xb_add(&bar[XB_XCNT(b.x)], 1u);
    return b;
}
__device__ __forceinline__ void xcd_barrier_complete(unsigned* bar, unsigned x, unsigned& nloc, unsigned& nx) {
    const unsigned G = gridDim.x * gridDim.y * gridDim.z;
    unsigned sum, cnt, mine, sp = 0u;
    for (;;) {
        sum = 0u; cnt = 0u; mine = 0u;
#pragma unroll
        for (unsigned j = 0; j < 16; ++j) { const unsigned c = xb_ld(&bar[XB_XCNT(j)]); sum += c; cnt += (c > 0u) ? 1u : 0u; mine = (j == x) ? c : mine; }
        if (sum == G) break;
        __builtin_amdgcn_s_sleep(1);
        if ((++sp & 255u) == 0u) { if (xb_ld(&bar[XB_TMO])) break; if (sp > XB_SPIN_CAP) { atomicAdd(&bar[XB_TMO], 1u); break; } }
    }
    nloc = mine > 0u ? mine : 1u; nx = cnt > 0u ? cnt : 1u;
}
__device__ __forceinline__ void xcd_barrier(const XcdBarrier& b) {
    asm volatile("s_waitcnt vmcnt(0)" ::: "memory");
    __syncthreads();
    if (threadIdx.x == 0) {
        unsigned* bar = b.bar;
        __builtin_amdgcn_s_waitcnt(0);
        unsigned nloc = b.st[0], nx = b.st[1];
        if (nloc == 0u) { xcd_barrier_complete(bar, b.x, nloc, nx); b.st[0] = nloc; b.st[1] = nx; }
        const unsigned old = xb_add(&bar[XB_XSUB(b.x)], 1u);
        const unsigned gen = old / nloc;
        if (old + 1u == (gen + 1u) * nloc) {
            __builtin_amdgcn_fence(__ATOMIC_RELEASE, "agent");
            asm volatile("s_waitcnt vmcnt(0)" ::: "memory");
            const unsigned og = xb_add(&bar[XB_TOP], 1u);
            const unsigned tg = og / nx;
            if (og + 1u == (tg + 1u) * nx) xb_add(&bar[XB_TOPGEN], 1u);
            else XB_SPIN(xb_ld(&bar[XB_TOPGEN]) == tg, bar);
            __builtin_amdgcn_fence(__ATOMIC_ACQUIRE, "agent");
            xb_add(&bar[XB_XGEN(b.x)], 1u);
            asm volatile("s_waitcnt vmcnt(0)" ::: "memory");
        } else {
            XB_SPIN(xb_ld(&bar[XB_XGEN(b.x)]) == gen, bar);
            __builtin_amdgcn_fence(__ATOMIC_ACQUIRE, "agent");
            asm volatile("s_waitcnt vmcnt(0)" ::: "memory");
        }
    }
    __syncthreads();
}

__device__ __forceinline__ bf16x8 frag_kc(const LAS bf16* X, int ld, int mn0, int k0, int lane) { return *(const LAS bf16x8*)(X + (mn0 + (lane & 15)) * ld + k0 + 8 * (lane >> 4)); }
__device__ __forceinline__ bf16x8 gfrag_kc(const bf16* X, int ld, int mn0, int k0, int lane) { const bf16* b = X + (size_t)mn0 * ld + k0; const unsigned lo = (unsigned)((lane & 15) * ld + 8 * (lane >> 4)); return *(const bf16x8*)(b + lo); }
__device__ __forceinline__ s16x4 trr(const LAS bf16* p) { return __builtin_bit_cast(s16x4, __builtin_amdgcn_ds_read_tr16_b64_v4i16((LAS s16x4*)p)); }
__device__ __forceinline__ bf16x8 frag_ks(const LAS bf16* X, int ld, int mn0, int k0, int lane) {
    const int r = lane & 15, g = lane >> 4;
    const LAS bf16* p = X + (k0 + 8 * g + (r >> 2)) * ld + mn0 + 4 * (r & 3);
    const s16x4 lo = trr(p), hi = trr(p + 4 * ld);
    return (bf16x8){lo[0], lo[1], lo[2], lo[3], hi[0], hi[1], hi[2], hi[3]};
}
__device__ __forceinline__ f32x4 zero4() { f32x4 z = {0.f, 0.f, 0.f, 0.f}; asm volatile("" : "+v"(z)); return z; }
__device__ __forceinline__ u32x4 uone4() { u32x4 z = {0x3F80u, 0u, 0u, 0u}; asm volatile("" : "+v"(z)); return z; }
__device__ __forceinline__ u32x4 uzero4() { u32x4 z = {0u, 0u, 0u, 0u}; asm volatile("" : "+v"(z)); return z; }
#define MFMA16(a, b, c) __builtin_amdgcn_mfma_f32_16x16x32_bf16((a), (b), (c), 0, 0, 0)
__device__ __forceinline__ u32x4 scale8(u32x4 w, float s) {
    u32x4 o;
    o.x = pk2(bf2f(w.x & 0xffffu) * s, bf2f(w.x >> 16) * s); o.y = pk2(bf2f(w.y & 0xffffu) * s, bf2f(w.y >> 16) * s);
    o.z = pk2(bf2f(w.z & 0xffffu) * s, bf2f(w.z >> 16) * s); o.w = pk2(bf2f(w.w & 0xffffu) * s, bf2f(w.w >> 16) * s);
    return o;
}
__device__ __forceinline__ float wscan_add(float v, int lane) {
#pragma unroll
    for (int o = 1; o < 64; o <<= 1) { const float t = __shfl_up(v, o); if (lane >= o) v += t; }
    return v;
}
__device__ __forceinline__ float wscan_max(float v, int lane) {
#pragma unroll
    for (int o = 1; o < 64; o <<= 1) { const float t = __shfl_up(v, o); if (lane >= o) v = fmaxf(v, t); }
    return v;
}

#ifndef GEMM_ALIGN
#define GEMM_ALIGN true
#endif
enum { PH_W = 0, PH_INPROJ, PH_M0, PH_M1, PH_M2, PH_M3, PH_LIFT, PH_OUT, PH_UP, PH_DOWN, PH_FINAL, PH_COUNT };
enum { I_X = 0, I_MIXG, I_WIN, I_AIB, I_AFB, I_ANG, I_BCW, I_CCW, I_CCB, I_CDTB, I_CALOG, I_CDSKIP, I_CNG, I_WLIFT, I_WOUT, I_FFNG, I_WUP, I_FCW, I_FCB, I_WDOWN, I_FING, N_IN };
struct Args { const float* in[N_IN]; float* out; unsigned char* ws; int l_lo, l_hi, g_lo, g_hi, ph_lo, ph_hi, use_bar, pad; };

__device__ __forceinline__ void transpose_item(const float* W, int ldw, int nsrc0, int k0, bf16* WT, int ldt, int ndst0, LAS float* scr, int lane, const float* kscale = nullptr, int gate_tile = -1) {
    int scol = nsrc0 + (lane & 31);
    if (gate_tile >= 0) {
        const int c = (ndst0 & 255) + (lane & 31), wc = c >> 6, bj = (c >> 5) & 1, fq = (c >> 3) & 3, n = (c >> 2) & 1, e = c & 3;
        scol = 6160 + (2 * bj + n) * 1024 + 64 * gate_tile + 16 * wc + 4 * fq + e; }
#pragma unroll 8
    for (int i = 0; i < 32; ++i) { const int kk = 2 * i + (lane >> 5); scr[kk * 33 + (lane & 31)] = W[(size_t)(k0 + kk) * ldw + scol] * (kscale ? kscale[k0 + kk] : 1.f); }
    LDS_WAIT(); asm volatile("" ::: "memory");
    const int c = lane & 7;
#pragma unroll
    for (int j = 0; j < 4; ++j) { const int n = (lane >> 3) + 8 * j; const LAS float* s = scr + (8 * c) * 33 + n;
        u32x4 o; o.x = pk2(s[0 * 33], s[1 * 33]); o.y = pk2(s[2 * 33], s[3 * 33]); o.z = pk2(s[4 * 33], s[5 * 33]); o.w = pk2(s[6 * 33], s[7 * 33]);
        *(u32x4*)(WT + (size_t)(ndst0 + n) * ldt + k0 + 8 * c) = o; }
    LDS_WAIT(); asm volatile("" ::: "memory");
}

__global__ void __launch_bounds__(NTHR, 2) fwd(Args args) {
    extern __shared__ __attribute__((aligned(16))) unsigned char lds_raw[];
    LAS unsigned char* lds = (LAS unsigned char*)lds_raw;
    const int NBLK = gridDim.x, blk = blockIdx.x;
    {
        volatile LAS unsigned* MISC0 = (volatile LAS unsigned*)(lds + MISC_OFF);
        if (threadIdx.x < 16) MISC0[threadIdx.x] = 0u;
        __syncthreads();
    }
    XcdBarrier bar; bar.bar = (unsigned*)(args.ws + WS_CTL) + 4096; bar.x = 0; bar.st = nullptr;
    if (args.use_bar) bar = xcd_barrier_post((unsigned*)(args.ws + WS_CTL) + 4096, (volatile LAS unsigned*)(lds + MISC_OFF) + 8);
#define GRID_BAR() do { if (args.use_bar) xcd_barrier(bar); } while (0)
#ifndef REPMASK
#define REPMASK 0
#endif
#define IN(k) (args.ph_lo <= (k) && (k) < args.ph_hi)
#define REPS(k) for (int rep_ = 0; rep_ < 1 + ((REPMASK >> (k)) & 1); ++rep_)
#define PHASE_BEGIN() int tid = threadIdx.x; asm volatile("" : "+v"(tid)); const int lane = tid & 63, wave = __builtin_amdgcn_readfirstlane(tid >> 6); \
    const __attribute__((address_space(4))) Args* ka = (const __attribute__((address_space(4))) Args*)__builtin_amdgcn_kernarg_segment_ptr(); asm volatile("" : "+s"(ka)); \
    unsigned char* ws = ka->ws; \
    const size_t grow0 = (size_t)grp * T; const float* xsrc = (l == 0) ? ka->in[I_X] : ka->out; (void)grow0; (void)xsrc; \
    const int gw = blk * NWAVES + wave, NGW = NBLK * NWAVES, gt = blk * NTHR + tid, NGT = NBLK * NTHR; (void)lane; (void)gw; (void)NGW; (void)gt; (void)NGT; \
    bf16* const WinT = (bf16*)(ws + WS_WIN); bf16* const WliftT = (bf16*)(ws + WS_WLIFT); bf16* const WoutT = (bf16*)(ws + WS_WOUT); \
    bf16* const WupT = (bf16*)(ws + WS_WUP); bf16* const WdownT = (bf16*)(ws + WS_WDOWN); bf16* const W16B = (bf16*)(ws + WS_W16); \
    bf16* const XN = (bf16*)(ws + WS_XN); bf16* const P = (bf16*)(ws + WS_P); bf16* const U = (bf16*)(ws + WS_U); bf16* const ACT = (bf16*)(ws + WS_ACT); \
    bf16* const YCAT = (bf16*)(ws + WS_YCAT); bf16* const XG = (bf16*)(ws + WS_XG); bf16* const MB = (bf16*)(ws + WS_MB); float* const SP = (float*)(ws + WS_SP); \
    float* const SSQ1 = (float*)(ws + WS_SSQ1); float* const SSQ2 = (float*)(ws + WS_SSQ2); float* const SSQC = (float*)(ws + WS_SSQC); float* const RAWH = (float*)(ws + WS_RAWH); (void)SSQ1; (void)SSQ2; (void)SSQC; (void)RAWH; \
    float* const GBc = (float*)(ws + WS_GB); float* const GGc = (float*)(ws + WS_GG); float* const GMT = (float*)(ws + WS_GMT); \
    float* const MCAR = (float*)(ws + WS_MCAR); float* const MNEW = (float*)(ws + WS_MNEW); float* const MSC = (float*)(ws + WS_MSC); float* const SUMB = (float*)(ws + WS_SUMB); float* const SUMG = (float*)(ws + WS_SUMG); (void)SUMB; (void)SUMG; \
    float* const DTB = (float*)(ws + WS_DT); float* const ACB = (float*)(ws + WS_AC); bf16* const XBC = (bf16*)(ws + WS_XBC); \
    bf16* const DC = (bf16*)(ws + WS_DC); bf16* const CS = (bf16*)(ws + WS_CS); bf16* const DH = (bf16*)(ws + WS_DH); bf16* const HS = (bf16*)(ws + WS_HS); \
    (void)WinT; (void)WliftT; (void)WoutT; (void)WupT; (void)WdownT; (void)W16B; (void)XN; (void)P; (void)U; (void)ACT; (void)YCAT; (void)XG; (void)MB; (void)SP; (void)GBc; (void)GGc; (void)GMT; \
    (void)MCAR; (void)MNEW; (void)MSC; (void)DTB; (void)ACB; (void)XBC; (void)DC; (void)CS; (void)DH; (void)HS

    for (int l = args.l_lo; l < args.l_hi; ++l)
    for (int grp = args.g_lo; grp < args.g_hi; ++grp) {

        REPS(PH_W) if (IN(PH_W) && grp == 0) {
            PHASE_BEGIN();
            LAS float* scr = (LAS float*)(lds + wave * 16384);
            constexpr int I_IN = 16 * 320, I_LF = 4 * 8 * 32, I_OUT = 16 * 32, I_UP = 16 * 176, I_DN = 44 * 32, NIT = I_IN + I_LF + I_OUT + I_UP + I_DN;
            for (int it = gw; it < NIT; it += NGW) {
                int r = it;
                if (r < I_IN) { const int kb = r / 320, nb = r % 320, n0 = 32 * nb, ns = n0 + (n0 >= P_SQ ? 16 : (n0 >= P_BB ? 8 : 0));
                    transpose_item(ka->in[I_WIN] + (size_t)l * DM * PIN, PIN, ns, 64 * kb, WinT, DM, n0, scr, lane, ka->in[I_MIXG] + (size_t)l * DM, n0 >= P_G ? (n0 - P_G) >> 8 : -1); continue; } r -= I_IN;
                if (r < I_LF) { const int br = r / 256, q = r % 256, kb = q / 32, nb = q % 32;
                    transpose_item(ka->in[I_WLIFT] + (size_t)(l * 4 + br) * 512 * DM, DM, 32 * nb, 64 * kb, WliftT + (size_t)br * DM * 512, 512, 32 * nb, scr, lane, br == 2 ? ka->in[I_CNG] + (size_t)l * 512 : nullptr); continue; } r -= I_LF;
                if (r < I_OUT) { const int kb = r / 32, nb = r % 32;
                    transpose_item(ka->in[I_WOUT] + (size_t)l * DM * DM, DM, 32 * nb, 64 * kb, WoutT, DM, 32 * nb, scr, lane); continue; } r -= I_OUT;
                if (r < I_UP) { const int kb = r / 176, nb = r % 176, n0 = 32 * nb, tp = n0 >> 8, j = n0 & 255, ns = (j < 128) ? 128 * tp + j : 2816 + 128 * tp + (j - 128);
                    transpose_item(ka->in[I_WUP] + (size_t)l * DM * DFF2, DFF2, ns, 64 * kb, WupT, DM, n0, scr, lane, ka->in[I_FFNG] + (size_t)l * DM); continue; } r -= I_UP;
                { const int kb = r / 32, nb = r % 32;
                    transpose_item(ka->in[I_WDOWN] + (size_t)l * DFF * DM, DM, 32 * nb, 64 * kb, WdownT, DFF, 32 * nb, scr, lane); }
            }
            for (int i = gt; i < 16 * DM; i += NGT) { const int c = i >> 10, k = i & 1023; const int oc = (c < 8) ? (1536 + c) : (4616 + (c - 8));
                const float w = ka->in[I_WIN][(size_t)l * DM * PIN + (size_t)k * PIN + oc] * ka->in[I_MIXG][(size_t)l * DM + k]; const unsigned hi = f2bf(w);
                W16B[i] = (bf16)hi; W16B[16 * DM + i] = (bf16)f2bf(w - bf2f(hi)); }
            if (l == 0) {
                for (int m = gw; m < BATCH * SEQ; m += NGW) {
                    const f32x4* xr = (const f32x4*)(ka->in[I_X] + (size_t)m * DM) + lane;
                    f32x4 v[4]; float sq = 0.f;
#pragma unroll
                    for (int j = 0; j < 4; ++j) { v[j] = xr[64 * j]; sq += (v[j].x * v[j].x + v[j].y * v[j].y) + (v[j].z * v[j].z + v[j].w * v[j].w); }
                    sq = wave_sum(sq); if (lane < 16) SSQ1[(size_t)m * 16 + lane] = (lane == 0) ? sq : 0.f;
                    u32x2* o8 = (u32x2*)(XG + (size_t)m * DM) + lane;
#pragma unroll
                    for (int j = 0; j < 4; ++j) o8[64 * j] = (u32x2){pk2(v[j].x, v[j].y), pk2(v[j].z, v[j].w)};
                }
            }
            GRID_BAR();
        }

        REPS(PH_INPROJ) if (IN(PH_INPROJ)) {
            PHASE_BEGIN();
            const bf16* XGg = XG + grow0 * DM; const float* ssq = SSQ1 + grow0 * 16;
            if (tid == 0) *(volatile LAS int*)(lds + 143360 + 1024) = -1;
            for (int rb = blk; rb < T / 64; rb += NBLK) {
                const int r0 = rb * 64 + 16 * (wave & 3), kh = (wave >> 2) * 512; f32x4 acc = zero4(), acc2 = zero4();
#pragma unroll 8
                for (int ks = 0; ks < 16; ++ks) { const bf16x8 a = gfrag_kc(XGg, DM, r0, kh + 32 * ks, lane);
                    acc = MFMA16(a, gfrag_kc(W16B, DM, 0, kh + 32 * ks, lane), acc); acc2 = MFMA16(a, gfrag_kc(W16B + 16 * DM, DM, 0, kh + 32 * ks, lane), acc2); }
                acc += acc2;
                LAS f32x4* xch = (LAS f32x4*)lds;
                if (wave >= 4) xch[(wave - 4) * 64 + lane] = acc;
                __syncthreads();
                if (wave < 4) { acc += xch[wave * 64 + lane];
#pragma unroll
                    for (int i = 0; i < 4; ++i) { const int row = r0 + 4 * (lane >> 4) + i; SP[(size_t)row * 16 + (lane & 15)] = acc[i] * row_rstd(ssq + (size_t)row * 16); } }
                __syncthreads();
            }
            pg8::Gemm g{XGg, WinT, DM, DM, DM, 0, 0}; pg8::Order S; S.init(T, PW, NBLK, blk, 1);
            pg8::EpiBf16 E{(LAS float*)(lds + 143360), P, PW, ssq, P_G / 256};
            pg8::gemm_phase<pg8::EpiBf16, GEMM_ALIGN>(lds, g, S, E);
            GRID_BAR();
        }

        REPS(PH_M0) if (IN(PH_M0)) {
            PHASE_BEGIN();
            for (int task = gw; task < GB * 4 * NCH; task += NGW) {
                const int bh = task >> 5, c = task & 31, bl = bh >> 2, h = bh & 3;
                const size_t m = (size_t)bl * SEQ + c * 64 + lane;
                const float ig = SP[m * 16 + h] + ka->in[I_AIB][l * 4 + h], fg = SP[m * 16 + 4 + h] + ka->in[I_AFB][l * 4 + h];
                const float b = wscan_add(logsigf_(fg), lane);
                const float gg = ig - b;
                const float pm = wscan_max(gg, lane);
                GBc[m * 4 + h] = b; GGc[m * 4 + h] = gg; GMT[m * 4 + h] = pm;
                if (lane == 63) { SUMB[task] = b; SUMG[task] = pm; }
            }
            for (int task = gw; task < GB * NCH * 8; task += NGW) {
                const int hd = task & 7; const size_t m = (size_t)(task >> 3) * 64 + lane;
                const float dt = softplusf_(SP[m * 16 + 8 + hd] + ka->in[I_CDTB][l * 8 + hd]);
                const float a = wscan_add(-dt * __expf(ka->in[I_CALOG][l * 8 + hd]), lane);
                DTB[m * 8 + hd] = dt; ACB[m * 8 + hd] = a;
            }
            {
                const float* cw = ka->in[I_CCW] + (size_t)l * 4 * 1024; const float* cb = ka->in[I_CCB] + (size_t)l * 1024;
                constexpr int RUN = 16;
                for (int i = gt; i < (T / RUN) * 128; i += NGT) {
                    const int rb = i >> 7, c8 = (i & 127) * 8, m0 = rb * RUN, t0 = m0 & (SEQ - 1);
                    float w[4][8], bb[8];
#pragma unroll
                    for (int e = 0; e < 8; ++e) { bb[e] = cb[c8 + e];
#pragma unroll
                        for (int j = 0; j < 4; ++j) w[j][e] = cw[j * 1024 + c8 + e]; }
                    const u32x4 zz = uzero4(); u32x4 win[4]; win[0] = zz; win[1] = zz; win[2] = zz;
                    if (t0 >= 3) { const bf16* pr = P + (size_t)(m0 - 3) * PW + P_CX + c8; win[0] = *(const u32x4*)pr; win[1] = *(const u32x4*)(pr + PW); win[2] = *(const u32x4*)(pr + 2 * PW); }
#pragma unroll 4
                    for (int rr = 0; rr < RUN; ++rr) {
                        win[3] = *(const u32x4*)(P + (size_t)(m0 + rr) * PW + P_CX + c8);
                        float acc[8];
#pragma unroll
                        for (int e = 0; e < 8; ++e) acc[e] = bb[e];
#pragma unroll
                        for (int j = 0; j < 4; ++j) {
                            acc[0] += w[j][0] * bf2f(win[j].x & 0xffffu); acc[1] += w[j][1] * bf2f(win[j].x >> 16); acc[2] += w[j][2] * bf2f(win[j].y & 0xffffu); acc[3] += w[j][3] * bf2f(win[j].y >> 16);
                            acc[4] += w[j][4] * bf2f(win[j].z & 0xffffu); acc[5] += w[j][5] * bf2f(win[j].z >> 16); acc[6] += w[j][6] * bf2f(win[j].w & 0xffffu); acc[7] += w[j][7] * bf2f(win[j].w >> 16); }
                        u32x4 o; o.x = pk2(siluf_(acc[0]), siluf_(acc[1])); o.y = pk2(siluf_(acc[2]), siluf_(acc[3])); o.z = pk2(siluf_(acc[4]), siluf_(acc[5])); o.w = pk2(siluf_(acc[6]), siluf_(acc[7]));
                        *(u32x4*)(XBC + (size_t)(m0 + rr) * 1024 + c8) = o;
                        win[0] = win[1]; win[1] = win[2]; win[2] = win[3];
                    }
                }
            }
            {
                const float* bw = ka->in[I_BCW] + (size_t)l * 3 * 512;
                constexpr int RUN = 16;
                for (int i = gt; i < (T / RUN) * 64; i += NGT) {
                    const int rb = i >> 6, c8 = (i & 63) * 8, m0 = rb * RUN, t0 = m0 & (SEQ - 1);
                    float w[3][8];
#pragma unroll
                    for (int e = 0; e < 8; ++e)
#pragma unroll
                        for (int j = 0; j < 3; ++j) w[j][e] = bw[j * 512 + c8 + e];
                    float pw[3][8];
#pragma unroll
                    for (int e = 0; e < 8; ++e) { pw[0][e] = 0.f; pw[1][e] = 0.f; }
                    if (t0 >= 2) {
#pragma unroll
                        for (int j = 0; j < 2; ++j) { const bf16* pr = P + (size_t)(m0 - 2 + j) * PW; const u32x4 a = *(const u32x4*)(pr + P_BC + c8), b = *(const u32x4*)(pr + P_BX + c8);
                            pw[j][0] = bf2f(a.x & 0xffffu) * bf2f(b.x & 0xffffu); pw[j][1] = bf2f(a.x >> 16) * bf2f(b.x >> 16); pw[j][2] = bf2f(a.y & 0xffffu) * bf2f(b.y & 0xffffu); pw[j][3] = bf2f(a.y >> 16) * bf2f(b.y >> 16);
                            pw[j][4] = bf2f(a.z & 0xffffu) * bf2f(b.z & 0xffffu); pw[j][5] = bf2f(a.z >> 16) * bf2f(b.z >> 16); pw[j][6] = bf2f(a.w & 0xffffu) * bf2f(b.w & 0xffffu); pw[j][7] = bf2f(a.w >> 16) * bf2f(b.w >> 16); } }
#pragma unroll 4
                    for (int rr = 0; rr < RUN; ++rr) {
                        const bf16* pr = P + (size_t)(m0 + rr) * PW; const u32x4 a = *(const u32x4*)(pr + P_BC + c8), b = *(const u32x4*)(pr + P_BX + c8), g = *(const u32x4*)(pr + P_BB + c8);
                        pw[2][0] = bf2f(a.x & 0xffffu) * bf2f(b.x & 0xffffu); pw[2][1] = bf2f(a.x >> 16) * bf2f(b.x >> 16); pw[2][2] = bf2f(a.y & 0xffffu) * bf2f(b.y & 0xffffu); pw[2][3] = bf2f(a.y >> 16) * bf2f(b.y >> 16);
                        pw[2][4] = bf2f(a.z & 0xffffu) * bf2f(b.z & 0xffffu); pw[2][5] = bf2f(a.z >> 16) * bf2f(b.z >> 16); pw[2][6] = bf2f(a.w & 0xffffu) * bf2f(b.w & 0xffffu); pw[2][7] = bf2f(a.w >> 16) * bf2f(b.w >> 16);
                        float acc[8];
#pragma unroll
                        for (int e = 0; e < 8; ++e) acc[e] = w[0][e] * pw[0][e] + w[1][e] * pw[1][e] + w[2][e] * pw[2][e];
                        u32x4 o; o.x = pk2(acc[0] * bf2f(g.x & 0xffffu), acc[1] * bf2f(g.x >> 16)); o.y = pk2(acc[2] * bf2f(g.y & 0xffffu), acc[3] * bf2f(g.y >> 16));
                        o.z = pk2(acc[4] * bf2f(g.z & 0xffffu), acc[5] * bf2f(g.z >> 16)); o.w = pk2(acc[6] * bf2f(g.w & 0xffffu), acc[7] * bf2f(g.w >> 16));
                        *(u32x4*)(YCAT + (size_t)(m0 + rr) * YW + 512 + c8) = o;
#pragma unroll
                        for (int e = 0; e < 8; ++e) { pw[0][e] = pw[1][e]; pw[1][e] = pw[2][e]; }
                    }
                }
            }
            __syncthreads();
            {
            LAS bf16* Qs = (LAS bf16*)lds; LAS bf16* Ks = Qs + 128 * 136; LAS bf16* Vs = Ks + 64 * 136; LAS bf16* Aw = Vs + 64 * 136 + wave * (16 * 72);
            const int r = lane & 15, g4 = lane >> 4;
            for (int u = blk; u < GB * 4 * 16; u += NBLK) {
                const int bl = u >> 6, h = (u >> 4) & 3, qt = u & 15; const size_t mb = (size_t)bl * SEQ; const int q0 = qt * 128;
                volatile LAS unsigned* FLG = (volatile LAS unsigned*)(lds + MISC_OFF + 128);
                int par = 0;
                __syncthreads();
                if (lane == 0) { FLG[wave] = 0u; FLG[8 + wave] = 0u; }
                for (int i = tid; i < 2048; i += NTHR) { const int s = i >> 4, c8 = i & 15; *(LAS u32x4*)(Qs + s * 136 + c8 * 8) = *(const u32x4*)(P + (mb + q0 + s) * PW + P_SQ + h * 128 + c8 * 8); }
                f32x4 O[8];
#pragma unroll
                for (int d = 0; d < 8; ++d) O[d] = zero4();
                float racc = 0.f; const int tq = q0 + 16 * wave + r;
                u32x4 kreg[2], vreg[2];
                { const int s0f = (2 * qt + 1) * 64;
#pragma unroll
                  for (int k2 = 0; k2 < 2; ++k2) { const int i = tid + 512 * k2, s = i >> 4, c8 = i & 15; const bf16* pr = P + (mb + s0f + s) * PW + h * 128 + c8 * 8; kreg[k2] = *(const u32x4*)(pr + P_SK); vreg[k2] = *(const u32x4*)(pr + P_SV); } }
                for (int kt = 2 * qt + 1; kt >= 0; --kt) {
                    const int s0 = kt * 64;
                    __syncthreads();
                    { unsigned alldone = 1u;
#pragma unroll
                      for (int w8 = 0; w8 < 8; ++w8) alldone &= FLG[par * 8 + w8];
                      if (__builtin_amdgcn_readfirstlane((int)alldone)) break; }
#pragma unroll
                    for (int k2 = 0; k2 < 2; ++k2) { const int i = tid + 512 * k2, s = i >> 4, c8 = i & 15; *(LAS u32x4*)(Ks + s * 136 + c8 * 8) = kreg[k2]; *(LAS u32x4*)(Vs + s * 136 + c8 * 8) = vreg[k2]; }
                    if (kt > 0) {
#pragma unroll
                        for (int k2 = 0; k2 < 2; ++k2) { const int i = tid + 512 * k2, s = i >> 4, c8 = i & 15; const bf16* pr = P + (mb + s0 - 64 + s) * PW + h * 128 + c8 * 8; kreg[k2] = *(const u32x4*)(pr + P_SK); vreg[k2] = *(const u32x4*)(pr + P_SV); } }
                    __syncthreads();
                    if (s0 < q0 + 16 * wave + 15) {
                        f32x4 z[4];
#pragma unroll
                        for (int j = 0; j < 4; ++j) z[j] = zero4();
#pragma unroll
                        for (int ks = 0; ks < 4; ++ks) { const bf16x8 fq = frag_kc(Qs, 136, 16 * wave, 32 * ks, lane);
#pragma unroll
                            for (int j = 0; j < 4; ++j) z[j] = MFMA16(frag_kc(Ks, 136, 16 * j, 32 * ks, lane), fq, z[j]); }
                        float ls[4][4], x[4][4], tsum[4];
#pragma unroll
                        for (int j = 0; j < 4; ++j) { float tj = 0.f;
#pragma unroll
                            for (int i = 0; i < 4; ++i) { const int s = s0 + 16 * j + 4 * g4 + i; const float zz = z[j][i] * 0.08838834764831845f;
                                const float l1 = fminf(zz, 0.f) - __logf(1.f + __expf(-fabsf(zz)));
                                ls[j][i] = l1; x[j][i] = (s < tq) ? (l1 - zz) : 0.f; tj += x[j][i]; }
                            tsum[j] = tj; }
                        float above[4], tot[4];
#pragma unroll
                        for (int j = 0; j < 4; ++j) { const float y1 = __shfl_xor(tsum[j], 16), y2 = __shfl_xor(tsum[j], 32), y3 = __shfl_xor(tsum[j], 48);
                            tot[j] = tsum[j] + y1 + y2 + y3;
                            above[j] = (g4 == 0) ? (y1 + y2 + y3) : (g4 == 1) ? (y2 + y3) : (g4 == 2) ? y1 : 0.f; }
                        float hi = racc;
#pragma unroll
                        for (int j = 3; j >= 0; --j) { float run = hi + above[j]; float av[4];
#pragma unroll
                            for (int i = 3; i >= 0; --i) { const int s = s0 + 16 * j + 4 * g4 + i; av[i] = (s < tq) ? __expf(ls[j][i] + run) : 0.f; run += x[j][i]; }
                            *(LAS u32x2*)(Aw + r * 72 + 16 * j + 4 * g4) = (u32x2){pk2(av[0], av[1]), pk2(av[2], av[3])};
                            hi += tot[j]; }
                        racc = hi;
                        LDS_WAIT(); asm volatile("" ::: "memory");
#pragma unroll
                        for (int ks = 0; ks < 2; ++ks) { const bf16x8 fa = frag_kc(Aw, 72, 0, 32 * ks, lane);
#pragma unroll
                            for (int d = 0; d < 8; ++d) O[d] = MFMA16(fa, frag_ks(Vs, 136, 16 * d, 32 * ks, lane), O[d]); }
                    }
                    par ^= 1;
                    { const bool wd = __all(racc < -104.f); if (lane == 0) FLG[par * 8 + wave] = wd ? 1u : 0u; }
                }
#pragma unroll
                for (int d = 0; d < 8; ++d)
#pragma unroll
                    for (int i = 0; i < 4; ++i) YCAT[(mb + q0 + 16 * wave + 4 * g4 + i) * YW + 1536 + h * 128 + 16 * d + r] = (bf16)f2bf(O[d][i]);
            }
            }
            GRID_BAR();
        }

        REPS(PH_M1) if (IN(PH_M1)) {
            PHASE_BEGIN();
            constexpr int NUA = GB * 4 * NCH, NUC = GB * NCH;
            for (int u = blk; u < NUA + NUC; u += NBLK) {
                if (u < NUA) {
                    const int ua = u, bh = ua >> 5, c = ua & 31, bl = bh >> 2, h = bh & 3; const size_t m0 = (size_t)bl * SEQ + c * 64;
                    LAS bf16* VP = (LAS bf16*)lds; LAS bf16* WK = (LAS bf16*)(lds + 64 * 152 * 2);
                    float bLj = 0.f, gmj = -1e30f;
                    if (lane < 32) { bLj = SUMB[bh * 32 + lane]; gmj = SUMG[bh * 32 + lane]; }
                    float pa = bLj, pq = gmj + bLj;
#pragma unroll
                    for (int o = 1; o < 32; o <<= 1) { const float ta = __shfl_up(pa, o), tq = __shfl_up(pq, o); if (lane >= o) { pq = fmaxf(tq + pa, pq); pa = ta + pa; } }
                    const float mall = fmaxf(pa, pq);
                    const float mnew = __shfl(mall, c), mprev = (c == 0) ? 0.f : __shfl(mall, (c + 63) & 63);
                    const float bL = GBc[(m0 + 63) * 4 + h];
                    if (tid == 0) { MCAR[ua] = mprev; MNEW[ua] = mnew; MSC[ua] = __expf(bL + mprev - mnew); }
                    for (int i = tid; i < 1024; i += NTHR) { const int s = i >> 4, c8 = i & 15; *(LAS u32x4*)(VP + s * 152 + c8 * 8) = *(const u32x4*)(P + (m0 + s) * PW + P_AV + h * 128 + c8 * 8); }
                    if (tid < 64) { *(LAS u32x4*)(VP + tid * 152 + 128) = uone4(); *(LAS u32x4*)(VP + tid * 152 + 136) = uzero4(); }
                    { const int s = tid >> 3, c8 = tid & 7; const float w = __expf(bL + GGc[(m0 + s) * 4 + h] - mnew);
                      *(LAS u32x4*)(WK + s * 72 + c8 * 8) = scale8(*(const u32x4*)(P + (m0 + s) * PW + P_AK + h * 64 + c8 * 8), w); }
                    __syncthreads();
                    for (int ti = wave; ti < 36; ti += NWAVES) { const int mt = ti >> 2, nt = ti & 3; f32x4 acc = zero4();
#pragma unroll
                        for (int ks = 0; ks < 2; ++ks) acc = MFMA16(frag_ks(VP, 152, 16 * mt, 32 * ks, lane), frag_ks(WK, 72, 16 * nt, 32 * ks, lane), acc);
                        bf16* d = DC + (size_t)ua * 9216 + (16 * mt + 4 * (lane >> 4)) * 64 + 16 * nt + (lane & 15);
#pragma unroll
                        for (int i = 0; i < 4; ++i) d[i * 64] = (bf16)f2bf(acc[i]); }
                    __syncthreads();
                } else {
                    const int uc = u - NUA, bl = uc >> 5, c = uc & 31, hd = wave, gi = hd >> 2; const size_t m0 = (size_t)bl * SEQ + c * 64;
                    LAS bf16* XW = (LAS bf16*)(lds + hd * (64 * 72 * 2)); LAS bf16* BMs = (LAS bf16*)(lds + 8 * 64 * 72 * 2);
                    const float alast = ACB[(m0 + 63) * 8 + hd];
#pragma unroll
                    for (int k = 0; k < 8; ++k) { const int i = lane + 64 * k, s = i >> 3, c8 = i & 7; const float wd = __expf(alast - ACB[(m0 + s) * 8 + hd]) * DTB[(m0 + s) * 8 + hd];
                        *(LAS u32x4*)(XW + s * 72 + c8 * 8) = scale8(*(const u32x4*)(XBC + (m0 + s) * 1024 + hd * 64 + c8 * 8), wd); }
                    for (int i = tid; i < 2048; i += NTHR) { const int g2 = i >> 10, rem = i & 1023, s = rem >> 4, c8 = rem & 15;
                        *(LAS u32x4*)(BMs + g2 * (64 * 136) + s * 136 + c8 * 8) = *(const u32x4*)(XBC + (m0 + s) * 1024 + 512 + g2 * 128 + c8 * 8); }
                    __syncthreads();
                    const LAS bf16* BMg = BMs + gi * (64 * 136);
                    for (int pt = 0; pt < 4; ++pt) { f32x4 acc[8];
#pragma unroll
                        for (int n = 0; n < 8; ++n) acc[n] = zero4();
#pragma unroll
                        for (int ks = 0; ks < 2; ++ks) { const bf16x8 a = frag_ks(XW, 72, 16 * pt, 32 * ks, lane);
#pragma unroll
                            for (int n = 0; n < 8; ++n) acc[n] = MFMA16(a, frag_ks(BMg, 136, 16 * n, 32 * ks, lane), acc[n]); }
                        bf16* d = DH + ((size_t)(uc * 8 + hd) * 64 + 16 * pt + 4 * (lane >> 4)) * 128 + (lane & 15);
#pragma unroll
                        for (int n = 0; n < 8; ++n)
#pragma unroll
                            for (int i = 0; i < 4; ++i) d[i * 128 + 16 * n] = (bf16)f2bf(acc[n][i]); }
                    __syncthreads();
                }
            }
            GRID_BAR();
        }

        REPS(PH_M2) if (IN(PH_M2)) {
            PHASE_BEGIN();
            constexpr int NA = GB * 4 * 2304, NC = GB * 8 * 2048;
            for (int i = gt; i < NA + NC; i += NGT) {
                f32x4 st = zero4();
                if (i < NA) { const int bh = i / 2304, e = (i - bh * 2304) * 4;
                    for (int c = 0; c < NCH; ++c) { const size_t ua = (size_t)bh * NCH + c;
                        *(u32x2*)(CS + ua * 9216 + e) = (u32x2){pk2(st.x, st.y), pk2(st.z, st.w)};
                        { const u32x2 dw = *(const u32x2*)(DC + ua * 9216 + e); st = st * MSC[ua] + (f32x4){bf2f(dw.x & 0xffffu), bf2f(dw.x >> 16), bf2f(dw.y & 0xffffu), bf2f(dw.y >> 16)}; } }
                } else { const int j = i - NA, bhd = j >> 11, e = (j & 2047) * 4, bl = bhd >> 3, hd = bhd & 7;
                    for (int c = 0; c < NCH; ++c) { const size_t uh = (size_t)(bl * NCH + c) * 8 + hd;
                        *(u32x2*)(HS + uh * 8192 + e) = (u32x2){pk2(st.x, st.y), pk2(st.z, st.w)};
                        { const u32x2 dw = *(const u32x2*)(DH + uh * 8192 + e); st = st * __expf(ACB[((size_t)bl * SEQ + c * 64 + 63) * 8 + hd]) + (f32x4){bf2f(dw.x & 0xffffu), bf2f(dw.x >> 16), bf2f(dw.y & 0xffffu), bf2f(dw.y >> 16)}; } }
                }
            }
            GRID_BAR();
        }

        REPS(PH_M3) if (IN(PH_M3)) {
            PHASE_BEGIN();
            constexpr int NUA = GB * 4 * NCH, NUC = 2 * GB * NCH;
            for (int u = blk; u < NUA + NUC; u += NBLK) {
                const int r = lane & 15, g4 = lane >> 4;
                if (u < NUA) {
                    const int ua = u, bh = ua >> 5, c = ua & 31, bl = bh >> 2, h = bh & 3; const size_t m0 = (size_t)bl * SEQ + c * 64;
                    LAS bf16* Qs = (LAS bf16*)lds; LAS bf16* Ks = Qs + 64 * 72; LAS bf16* VP = Ks + 64 * 72; LAS bf16* CST = VP + 64 * 152; LAS bf16* SMT = CST + 144 * 72; LAS bf16* AOT = SMT + 64 * 72;
                    LAS float* GS = (LAS float*)(AOT + 64 * 136);
                    LAS float* SSQ = GS + 256;
                    const float mcar = MCAR[ua];
                    { const int s = tid >> 3, c8 = tid & 7; const bf16* pr = P + (m0 + s) * PW + h * 64 + c8 * 8;
                      *(LAS u32x4*)(Qs + s * 72 + c8 * 8) = *(const u32x4*)(pr + P_AQ); *(LAS u32x4*)(Ks + s * 72 + c8 * 8) = *(const u32x4*)(pr + P_AK); }
                    for (int i = tid; i < 1024; i += NTHR) { const int s = i >> 4, c8 = i & 15; const bf16* pr = P + (m0 + s) * PW + h * 128 + c8 * 8;
                        *(LAS u32x4*)(VP + s * 152 + c8 * 8) = *(const u32x4*)(pr + P_AV); *(LAS u32x4*)(AOT + s * 136 + c8 * 8) = *(const u32x4*)(pr + P_AO); }
                    if (tid < 64) { *(LAS u32x4*)(VP + tid * 152 + 128) = uone4(); *(LAS u32x4*)(VP + tid * 152 + 136) = uzero4(); }
                    for (int i = tid; i < 1152; i += NTHR) { const int dv = i >> 3, c8 = i & 7; *(LAS u32x4*)(CST + dv * 72 + c8 * 8) = *(const u32x4*)(CS + (size_t)ua * 9216 + dv * 64 + c8 * 8); }
                    if (tid < 192) { const int arr = tid >> 6, s = tid & 63; const float* src = (arr == 0) ? GBc : (arr == 1) ? GGc : GMT; float v = src[(m0 + s) * 4 + h];
                        if (arr == 2) v = GBc[(m0 + s) * 4 + h] + fmaxf(mcar, v);
                        GS[arr * 64 + s] = v; }
                    __syncthreads();
#pragma unroll
                    for (int q2 = 0; q2 < 2; ++q2) { const int ti = 2 * wave + q2, tt = ti >> 2, st = ti & 3;
                        f32x4 acc = zero4();
                        if (st <= tt) {
#pragma unroll
                            for (int ks = 0; ks < 2; ++ks) acc = MFMA16(frag_kc(Qs, 72, 16 * tt, 32 * ks, lane), frag_kc(Ks, 72, 16 * st, 32 * ks, lane), acc);
                            const int s = 16 * st + r; const float gs = GS[64 + s];
#pragma unroll
                            for (int i = 0; i < 4; ++i) { const int t = 16 * tt + 4 * g4 + i; const float e = GS[t] - GS[128 + t] + gs;
                                acc[i] = (s <= t) ? acc[i] * 0.125f * __expf(e) : 0.f; }
                        }
                        *(LAS u32x2*)(SMT + (16 * st + r) * 72 + 16 * tt + 4 * g4) = (u32x2){pk2(acc[0], acc[1]), pk2(acc[2], acc[3])}; }
                    __syncthreads();
                    const int tt = wave & 3, half = wave >> 2;
                    f32x4 a1[5], a2[5];
#pragma unroll
                    for (int j = 0; j < 5; ++j) { a1[j] = zero4(); a2[j] = zero4(); }
#pragma unroll
                    for (int ks = 0; ks < 2; ++ks) { const bf16x8 fa1 = frag_ks(SMT, 72, 16 * tt, 32 * ks, lane), fa2 = frag_kc(Qs, 72, 16 * tt, 32 * ks, lane);
#pragma unroll
                        for (int j = 0; j < 5; ++j) { const int dvt = (j < 4) ? half * 4 + j : 8;
                            a1[j] = MFMA16(fa1, frag_ks(VP, 152, 16 * dvt, 32 * ks, lane), a1[j]);
                            a2[j] = MFMA16(fa2, frag_kc(CST, 72, 16 * dvt, 32 * ks, lane), a2[j]); } }
                    float hv[4][4], ssq[4];
#pragma unroll
                    for (int i = 0; i < 4; ++i) { const int t = 16 * tt + 4 * g4 + i; const float b = GS[t], mt = GS[128 + t];
                        const float is = 0.125f * __expf(b + mcar - mt);
                        float den = a1[4][i] + is * a2[4][i]; den = __shfl(den, lane & 48);
                        const float dn = __builtin_amdgcn_rcpf(fmaxf(fabsf(den), __expf(-mt))); float q = 0.f;
#pragma unroll
                        for (int j = 0; j < 4; ++j) { const float v = (a1[j][i] + is * a2[j][i]) * dn; hv[j][i] = v; q += v * v; }
                        q += __shfl_xor(q, 1); q += __shfl_xor(q, 2); q += __shfl_xor(q, 4); q += __shfl_xor(q, 8); ssq[i] = q; }
                    if (r == 0) {
#pragma unroll
                        for (int i = 0; i < 4; ++i) SSQ[half * 64 + 16 * tt + 4 * g4 + i] = ssq[i]; }
                    __syncthreads();
                    const float* ng = ka->in[I_ANG] + (size_t)l * 512 + h * 128;
#pragma unroll
                    for (int i = 0; i < 4; ++i) { const int t = 16 * tt + 4 * g4 + i; const float rstd = rsqrtf((SSQ[t] + SSQ[64 + t]) * (1.f / 128.f) + EPS);
#pragma unroll
                        for (int j = 0; j < 4; ++j) { const int dv = 16 * (half * 4 + j) + r; LAS bf16* op = AOT + t * 136 + dv;
                            *op = (bf16)f2bf(sigmoidf_(bf2f(*op)) * hv[j][i] * rstd * ng[dv]); } }
                    __syncthreads();
                    for (int i = tid; i < 1024; i += NTHR) { const int s = i >> 4, c8 = i & 15; *(u32x4*)(YCAT + (m0 + s) * YW + h * 128 + c8 * 8) = *(const LAS u32x4*)(AOT + s * 136 + c8 * 8); }
                    __syncthreads();
                } else {
                    const int uc2 = u - NUA, bl = uc2 >> 6, c = (uc2 >> 1) & 31, gi = uc2 & 1, hl = wave & 3, th = wave >> 2, hd = gi * 4 + hl; const size_t m0 = (size_t)bl * SEQ + c * 64;
                    LAS bf16* XHs = (LAS bf16*)lds;
                    LAS bf16* HTs = (LAS bf16*)(lds + 36864);
                    LAS bf16* BMg = (LAS bf16*)(lds + 36864 + 69632);
                    LAS bf16* MTt = (LAS bf16*)(lds + 36864 + 69632 + 17408 + wave * 3072);
                    LAS float* ADs = (LAS float*)(lds + 36864 + 69632 + 17408 + 24576);
                    const bf16* Xb = XBC + m0 * 1024;
                    for (int i = tid; i < 2048; i += NTHR) { const int h4 = i >> 9, rem = i & 511, s = rem >> 3, c8 = rem & 7;
                        *(LAS u32x4*)(XHs + h4 * (64 * 72) + s * 72 + c8 * 8) = *(const u32x4*)((Xb + gi * 256) + (unsigned)(s * 1024 + h4 * 64 + c8 * 8)); }
                    { const bf16* Hb = HS + (size_t)((bl * NCH + c) * 8 + gi * 4) * 8192;
                      for (int i = tid; i < 4096; i += NTHR) { const int h4 = i >> 10, rem = i & 1023, p = rem >> 4, c8 = rem & 15;
                        *(LAS u32x4*)(HTs + h4 * (64 * 136) + p * 136 + c8 * 8) = *(const u32x4*)(Hb + (unsigned)(h4 * 8192 + p * 128 + c8 * 8)); } }
                    for (int i = tid; i < 1024; i += NTHR) { const int s = i >> 4, c8 = i & 15; *(LAS u32x4*)(BMg + s * 136 + c8 * 8) = *(const u32x4*)((Xb + 512 + gi * 128) + (unsigned)(s * 1024 + c8 * 8)); }
                    { const int h4 = tid >> 7, arr = (tid >> 6) & 1, s = tid & 63; const float* src = arr ? DTB : ACB; ADs[tid] = (src + m0 * 8 + gi * 4)[(unsigned)(s * 8 + h4)]; }
                    const LAS bf16* XH = XHs + hl * (64 * 72); const LAS bf16* HT = HTs + hl * (64 * 136); const LAS float* AD = ADs + hl * 128;
                    const bf16* Cm = Xb + 768 + gi * 128; const bf16* Zp = P + m0 * PW + P_CZ + hd * 64; const unsigned zlane = (unsigned)(4 * g4 * PW + r), ylane = (unsigned)(4 * g4 * YW + r);
                    bf16* Yp = YCAT + m0 * YW + 1024 + hd * 64; float* Sp = SSQC + m0 * 8 + hd;
                    bf16x8 fcn[4];
#pragma unroll
                    for (int ks = 0; ks < 4; ++ks) fcn[ks] = gfrag_kc(Cm, 1024, 16 * th, 32 * ks, lane);
                    const float dsk = ka->in[I_CDSKIP][l * 8 + hd];
                    __syncthreads();
#pragma unroll 1
                    for (int k2 = 0; k2 < 2; ++k2) { const int tt = k2 ? 3 - th : th;
                        bf16x8 fcm[4]; unsigned short zc[4][4];
#pragma unroll
                        for (int ks = 0; ks < 4; ++ks) fcm[ks] = fcn[ks];
#pragma unroll
                        for (int p = 0; p < 4; ++p)
#pragma unroll
                            for (int i = 0; i < 4; ++i) zc[p][i] = (Zp + (size_t)(16 * tt + i) * PW + 16 * p)[zlane];
#pragma unroll
                        for (int ks = 0; ks < 4; ++ks) fcn[ks] = gfrag_kc(Cm, 1024, 16 * (3 - th), 32 * ks, lane);
                        float at[4];
#pragma unroll
                        for (int i = 0; i < 4; ++i) at[i] = AD[16 * tt + 4 * g4 + i];
#pragma unroll 1
                        for (int st = 0; st <= tt; ++st) { f32x4 acc = zero4();
#pragma unroll
                            for (int ks = 0; ks < 4; ++ks) acc = MFMA16(fcm[ks], frag_kc(BMg, 136, 16 * st, 32 * ks, lane), acc);
                            const int s = 16 * st + r; const float as = AD[s], dts = AD[64 + s];
#pragma unroll
                            for (int i = 0; i < 4; ++i) { const int t = 16 * tt + 4 * g4 + i; acc[i] = (s <= t) ? acc[i] * __expf(at[i] - as) * dts : 0.f; if (s == t) acc[i] += dsk; }
                            *(LAS u32x2*)(MTt + (16 * st + r) * 24 + 4 * g4) = (u32x2){pk2(acc[0], acc[1]), pk2(acc[2], acc[3])}; }
                        if ((tt & 1) == 0) *(LAS u32x2*)(MTt + (16 * (tt + 1) + r) * 24 + 4 * g4) = (u32x2){uzero4().x, uzero4().y};
                        LDS_WAIT(); asm volatile("" ::: "memory");
                        f32x4 ad[4], ao[4];
#pragma unroll
                        for (int p = 0; p < 4; ++p) { ad[p] = zero4(); ao[p] = zero4(); }
#pragma unroll 1
                        for (int ks = 0; ks <= (tt >> 1); ++ks) { const bf16x8 fa = frag_ks(MTt, 24, 0, 32 * ks, lane);
#pragma unroll
                            for (int p = 0; p < 4; ++p) ad[p] = MFMA16(fa, frag_ks(XH, 72, 16 * p, 32 * ks, lane), ad[p]); }
#pragma unroll
                        for (int ks = 0; ks < 4; ++ks)
#pragma unroll
                            for (int p = 0; p < 4; ++p) ao[p] = MFMA16(fcm[ks], frag_kc(HT, 136, 16 * p, 32 * ks, lane), ao[p]);
#pragma unroll
                        for (int i = 0; i < 4; ++i) { const float ea = __expf(at[i]); float q = 0.f;
#pragma unroll
                            for (int p = 0; p < 4; ++p) { const float y = (ad[p][i] + ea * ao[p][i]) * siluf_(bf2f(zc[p][i])); q += y * y;
                                (Yp + (size_t)(16 * tt + i) * YW + 16 * p)[ylane] = (bf16)f2bf(y); }
                            q += __shfl_xor(q, 1); q += __shfl_xor(q, 2); q += __shfl_xor(q, 4); q += __shfl_xor(q, 8);
                            if (r == 0) (Sp + (16 * tt + i) * 8)[(unsigned)(32 * g4)] = q; }
                        LDS_WAIT(); asm volatile("" ::: "memory");
                    }
                    __syncthreads();
                }
            }
            GRID_BAR();
        }

        REPS(PH_LIFT) if (IN(PH_LIFT)) {
            PHASE_BEGIN();
            pg8::Gemm g{YCAT, WliftT, 512, YW, 512, (size_t)512 * 2, (size_t)DM * 512 * 2}; pg8::Order S; S.init(T, DM, NBLK, blk, 4);
            pg8::EpiLift E{P + P_G, PW, MB + (size_t)(grp & 1) * T * DM, DM, SSQC};
            pg8::gemm_phase<pg8::EpiLift, GEMM_ALIGN>(lds, g, S, E);
            GRID_BAR();
        }
        REPS(PH_OUT) if (IN(PH_OUT) && (grp & 1)) {
            PHASE_BEGIN();
            const size_t prow0 = grow0 - T;
            pg8::Gemm g{MB, WoutT, DM, DM, DM, 0, 0}; pg8::Order S; S.init(2 * T, DM, NBLK, blk, 1);
            pg8::EpiResid E{XG + prow0 * DM, DM, SSQ2};
            pg8::gemm_phase<pg8::EpiResid, GEMM_ALIGN>(lds, g, S, E);
            GRID_BAR();
        }
        REPS(PH_UP) if (IN(PH_UP) && (grp & 1)) {
            PHASE_BEGIN();
            const size_t prow0 = grow0 - T;
            pg8::Gemm g{XG + prow0 * DM, WupT, DM, DM, DM, 0, 0}; pg8::Order S; S.init(2 * T, DFF2, NBLK, blk, 1);
            if (tid == 0) *(volatile LAS int*)(lds + 131072 + 12288 + 1024) = -1;
            pg8::EpiConvAct E{ACT, SSQ2, ka->in[I_FCW] + (size_t)l * 3 * DFF2, ka->in[I_FCB] + (size_t)l * DFF2, RAWH, lds + 131072, DFF2 / 256};
            pg8::gemm_phase<pg8::EpiConvAct, GEMM_ALIGN>(lds, g, S, E);
            GRID_BAR();
        }
        REPS(PH_DOWN) if (IN(PH_DOWN) && (grp & 1)) {
            PHASE_BEGIN();
            const size_t prow0 = grow0 - T;
            pg8::Gemm g{ACT, WdownT, DFF, DFF, DFF, 0, 0}; pg8::Order S; S.init(2 * T, DM, NBLK, blk, 1);
            {
                const float* fw = ka->in[I_FCW] + (size_t)l * 3 * DFF2; const float* fb = ka->in[I_FCB] + (size_t)l * DFF2;
                pg8::Unit uu;
                for (int i = 0; S.next(i, uu); ++i) { const int pm = uu.pm; if ((pm & 7) == 0) continue;
                    for (int ch = tid; ch < DFF; ch += NTHR) { const int tp = ch >> 7, j = ch & 127;
                        const float* own = RAWH + (size_t)(pm * 22 + tp) * 1024; const float* prv = RAWH + (size_t)((pm - 1) * 22 + tp) * 1024;
                        const float g254 = prv[2 * 256 + j], g255 = prv[3 * 256 + j], g0 = own[j], g1 = own[256 + j];
                        const float u254 = prv[2 * 256 + 128 + j], u255 = prv[3 * 256 + 128 + j], u0 = own[128 + j], u1 = own[256 + 128 + j];
                        const float wg0 = fw[ch], wg1 = fw[DFF2 + ch], wg2 = fw[2 * DFF2 + ch], wu0 = fw[DFF + ch], wu1 = fw[DFF2 + DFF + ch], wu2 = fw[2 * DFF2 + DFF + ch], bg = fb[ch], bu = fb[DFF + ch];
                        ACT[(size_t)(pm * 256) * DFF + ch] = (bf16)f2bf(siluf_(bg + wg0 * g254 + wg1 * g255 + wg2 * g0) * (bu + wu0 * u254 + wu1 * u255 + wu2 * u0));
                        ACT[(size_t)(pm * 256 + 1) * DFF + ch] = (bf16)f2bf(siluf_(bg + wg0 * g255 + wg1 * g0 + wg2 * g1) * (bu + wu0 * u255 + wu1 * u0 + wu2 * u1)); } }
                asm volatile("s_waitcnt vmcnt(0)" ::: "memory"); __syncthreads();
            }
            pg8::EpiResid E{XG + prow0 * DM, DM, SSQ1 + prow0 * 16};
            pg8::gemm_phase<pg8::EpiResid, GEMM_ALIGN>(lds, g, S, E);
            GRID_BAR();
        }
        REPS(PH_FINAL) if (IN(PH_FINAL) && l == DEPTH - 1 && (grp & 1)) {
            PHASE_BEGIN();
            const size_t prow0 = grow0 - T;
            const float* gain = ka->in[I_FING];
            f32x4 gv[4];
#pragma unroll
            for (int j = 0; j < 4; ++j) gv[j] = ((const f32x4*)gain)[lane + 64 * j];
            for (int m = gw; m < 2 * T; m += NGW) {
                const u32x2* xr = (const u32x2*)(XG + (prow0 + m) * DM) + lane;
                f32x4 v[4]; float sq = 0.f;
#pragma unroll
                for (int j = 0; j < 4; ++j) { const u32x2 w = xr[64 * j]; v[j] = (f32x4){bf2f(w.x & 0xffffu), bf2f(w.x >> 16), bf2f(w.y & 0xffffu), bf2f(w.y >> 16)};
                    sq += (v[j].x * v[j].x + v[j].y * v[j].y) + (v[j].z * v[j].z + v[j].w * v[j].w); }
                const float rstd = rsqrtf(wave_sum(sq) * (1.f / DM) + EPS);
                f32x4* orow = (f32x4*)(ka->out + (prow0 + m) * DM) + lane;
#pragma unroll
                for (int j = 0; j < 4; ++j) orow[64 * j] = v[j] * rstd * gv[j];
            }
            GRID_BAR();
        }
    }
#undef IN
#undef GRID_BAR
#undef PHASE_BEGIN
}

#ifndef ONE_LAUNCH
#define ONE_LAUNCH 1
#endif
extern "C" void kernel_launch(void* const* d_in, const int* in_sizes, int n_in, void* d_out, int out_size, void* d_ws, size_t ws_size, hipStream_t stream) {
    static int grid = 0;
    if (grid == 0) {
        if (n_in != N_IN || in_sizes[0] != BATCH * SEQ * DM || out_size != BATCH * SEQ * DM || ws_size < WS_END) {
            fprintf(stderr, "kernel_launch: unexpected shapes / workspace (n_in %d, ws %zu, need %zu); nothing launched\n", n_in, ws_size, (size_t)WS_END); grid = -1; return; }
        int dev = 0, cus = 0, per_cu = 0;
        if (hipGetDevice(&dev) != hipSuccess || hipDeviceGetAttribute(&cus, hipDeviceAttributeMultiprocessorCount, dev) != hipSuccess) { grid = -1; return; }
        if (hipFuncSetAttribute((const void*)fwd, hipFuncAttributeMaxDynamicSharedMemorySize, LDS_BYTES) != hipSuccess) { fprintf(stderr, "kernel_launch: hipFuncSetAttribute failed\n"); grid = -1; return; }
        if (hipOccupancyMaxActiveBlocksPerMultiprocessor(&per_cu, (const void*)fwd, NTHR, LDS_BYTES) != hipSuccess || per_cu < 1) { fprintf(stderr, "kernel_launch: occupancy query says %d\n", per_cu); (void)hipGetLastError(); }
        grid = cus;
    }
    if (grid < 0) return;
    (void)hipMemsetAsync((char*)d_ws + WS_CTL, 0, CTL_BYTES, stream);
    Args a{};
    for (int i = 0; i < N_IN; ++i) a.in[i] = (const float*)d_in[i];
    a.out = (float*)d_out; a.ws = (unsigned char*)d_ws; a.pad = 0;
#if ONE_LAUNCH
    a.l_lo = 0; a.l_hi = DEPTH; a.g_lo = 0; a.g_hi = NG; a.ph_lo = 0; a.ph_hi = PH_COUNT; a.use_bar = 1;
    hipLaunchKernelGGL(fwd, dim3(grid), dim3(NTHR), LDS_BYTES, stream, a);
#else
    a.use_bar = 0;
    for (int l = 0; l < DEPTH; ++l)
        for (int g = 0; g < NG; ++g)
            for (int ph = 0; ph < PH_COUNT; ++ph) {
                if (ph == PH_W && g != 0) continue;
                if (ph == PH_FINAL && l != DEPTH - 1) continue;
                if ((ph == PH_OUT || ph == PH_UP || ph == PH_DOWN || ph == PH_FINAL) && !(g & 1)) continue;
                a.l_lo = l; a.l_hi = l + 1; a.g_lo = g; a.g_hi = g + 1; a.ph_lo = ph; a.ph_hi = ph + 1;
                hipLaunchKernelGGL(fwd, dim3(grid), dim3(NTHR), LDS_BYTES, stream, a);
            }
#endif
}
```

```cpp
#include <hip/hip_runtime.h>
#include <cstdio>
#include <cstdint>

#define LAS __attribute__((address_space(3)))
#define GAS __attribute__((address_space(1)))
typedef unsigned short bf16;
typedef short bf16x8 __attribute__((ext_vector_type(8)));
typedef short s16x4 __attribute__((ext_vector_type(4)));
typedef float f32x4 __attribute__((ext_vector_type(4)));
typedef float f32x2 __attribute__((ext_vector_type(2)));
typedef unsigned u32x4 __attribute__((ext_vector_type(4)));
typedef unsigned u32x2 __attribute__((ext_vector_type(2)));

constexpr int DM = 1024, BATCH = 32, SEQ = 2048, DEPTH = 4;
constexpr int PIN = 10256, PW = 10240, PWS = 6144, DFF = 2816, DFF2 = 5632;
constexpr int GB = 8;
constexpr int NG = BATCH / GB;
constexpr int T = GB * SEQ;
constexpr int NCH = SEQ / 64;
constexpr float EPS = 1e-6f;
constexpr int P_AQ = 0, P_AK = 256, P_AV = 512, P_AO = 1024, P_BB = 1536, P_BC = 2048, P_BX = 2560, P_CZ = 3072, P_CX = 3584, P_SQ = 4608, P_SK = 5120, P_SV = 5632, P_G = 6144;
constexpr int YW = 2048;

constexpr size_t MiB = 1u << 20;
constexpr size_t WS_CTL = 0, CTL_BYTES = 1 * MiB;
constexpr size_t WS_WIN = 1 * MiB;
constexpr size_t WS_WLIFT = WS_WIN + (size_t)PW * DM * 2;
constexpr size_t WS_WOUT = WS_WLIFT + (size_t)4 * DM * 512 * 2;
constexpr size_t WS_WUP = WS_WOUT + (size_t)DM * DM * 2;
constexpr size_t WS_WDOWN = WS_WUP + (size_t)DFF2 * DM * 2;
constexpr size_t WS_W16 = WS_WDOWN + (size_t)DM * DFF * 2;
constexpr size_t WS_XN = WS_W16 + 65536;
constexpr size_t WS_P = WS_XN + (size_t)T * DM * 2;
constexpr size_t WS_U = WS_P, WS_ACT = WS_P;
constexpr size_t WS_YCAT = WS_P + (size_t)T * PW * 2;
constexpr size_t WS_XG = WS_YCAT + (size_t)T * YW * 2;
constexpr size_t WS_MB = WS_XG + (size_t)BATCH * SEQ * DM * 2;
constexpr size_t WS_SP = WS_MB + (size_t)2 * T * DM * 2;
constexpr size_t WS_GB = WS_SP + (size_t)T * 16 * 4;
constexpr size_t WS_GG = WS_GB + (size_t)T * 16;
constexpr size_t WS_GMT = WS_GG + (size_t)T * 16;
constexpr size_t WS_MCAR = WS_GMT + (size_t)T * 16;
constexpr size_t WS_MNEW = WS_MCAR + 4096;
constexpr size_t WS_MSC = WS_MNEW + 4096;
constexpr size_t WS_SUMB = WS_MSC + 4096, WS_SUMG = WS_SUMB + 4096;
constexpr size_t WS_DT = WS_SUMG + 4096;
constexpr size_t WS_AC = WS_DT + (size_t)T * 32;
constexpr size_t WS_XBC = WS_AC + (size_t)T * 32;
constexpr size_t WS_DC = WS_XBC + (size_t)T * DM * 2;
constexpr size_t WS_CS = WS_DC + (size_t)GB * 4 * NCH * 9216 * 4;
constexpr size_t WS_DH = WS_CS + (size_t)GB * 4 * NCH * 9216 * 2;
constexpr size_t WS_HS = WS_DH + (size_t)GB * NCH * 8 * 8192 * 4;
constexpr size_t WS_SSQ1 = WS_HS + (size_t)GB * NCH * 8 * 8192 * 2;
constexpr size_t WS_SSQ2 = WS_SSQ1 + (size_t)BATCH * SEQ * 64;
constexpr size_t WS_SSQC = WS_SSQ2 + (size_t)2 * T * 64;
constexpr size_t WS_RAWH = WS_SSQC + (size_t)T * 32;
constexpr size_t WS_END = WS_RAWH + (size_t)(2 * T / 256) * 22 * 4 * 256 * 4;

constexpr int NWAVES = 8, NTHR = 512;
constexpr int LDS_BYTES = 155648;
constexpr int MISC_OFF = 153600;

__device__ __forceinline__ float bf2f(unsigned b) { return __uint_as_float(b << 16); }
__device__ __forceinline__ unsigned f2bf(float f) { unsigned u = __float_as_uint(f); return (u + 0x7fffu + ((u >> 16) & 1u)) >> 16; }
__device__ __forceinline__ unsigned pk2(float lo, float hi) { return f2bf(lo) | (f2bf(hi) << 16); }
__device__ __forceinline__ float sigmoidf_(float x) { return __builtin_amdgcn_rcpf(1.f + __builtin_amdgcn_exp2f(-1.4426950408889634f * x)); }
__device__ __forceinline__ float siluf_(float x) { return x * __builtin_amdgcn_rcpf(1.f + __builtin_amdgcn_exp2f(-1.4426950408889634f * x)); }
__device__ __forceinline__ float logsigf_(float x) { return fminf(x, 0.f) - log1pf(expf(-fabsf(x))); }
__device__ __forceinline__ float softplusf_(float x) { return fmaxf(x, 0.f) + log1pf(expf(-fabsf(x))); }
__device__ __forceinline__ float wave_sum(float v) {
#pragma unroll
    for (int o = 1; o < 64; o <<= 1) v += __shfl_xor(v, o);
    return v;
}
#define LDS_WAIT() asm volatile("s_waitcnt lgkmcnt(0)" ::: "memory")
__device__ __forceinline__ float row_rstd(const float* ssq16) {
    const f32x4* p = (const f32x4*)ssq16; const f32x4 a = (p[0] + p[1]) + (p[2] + p[3]);
    return rsqrtf(((a.x + a.y) + (a.z + a.w)) * (1.f / 1024.f) + 1e-6f);
}

namespace pg8 {
constexpr int BM = 256, BK = 64, HALF = 128, HTB = HALF * BK * 2, STAGE_BYTES = 8 * HTB, NXCD = 8, WGM = 4;
__host__ __device__ __forceinline__ int lds_byte(int r, int c) { const int st = (r >> 4) * 2 + (c >> 5), rr = r & 15, cc = c & 31, ob = rr * 64 + cc * 2; return st * 1024 + (ob ^ (((ob >> 9) & 1) << 5)); }
__host__ __device__ __forceinline__ void stage_rc(int b, int& R, int& C) { const int st = b / 1024, sb = b % 1024, swz = sb ^ (((sb >> 9) & 1) << 5); R = (st >> 1) * 16 + swz / 64; C = (st & 1) * 32 + (swz % 64) / 2; }
__host__ __device__ __forceinline__ int perm32(int rho) { const int n = rho >> 4, i = rho & 15; return 8 * (i >> 2) + 4 * n + (i & 3); }

struct Unit { int pm, pn, z; };
struct Gemm { const bf16* A; const bf16* Bt; int K, lda, ldb; size_t zA, zB; };

struct Order {
    int nM, nN, nwg, G, c, Z;
    __device__ __forceinline__ void init(int M, int N, int G_, int c_, int Z_) { nM = M / BM; nN = N / BM; nwg = nM * nN; G = G_; c = c_; Z = Z_; }
    __device__ __forceinline__ bool next(int i, Unit& u) const {
        const int ti = i / Z; u.z = i - ti * Z;
        const long L = (long)ti * G + c; if (L >= nwg) return false;
        int wgid = (int)L; { const int q = nwg / NXCD, r = nwg % NXCD, xcd = wgid % NXCD, off = wgid / NXCD; wgid = (xcd < r ? xcd * (q + 1) : r * (q + 1) + (xcd - r) * q) + off; }
        const int nig = WGM * nN, gid = wgid / nig, fm = gid * WGM, gsz = (nM - fm) < WGM ? (nM - fm) : WGM;
        u.pm = fm + ((wgid % nig) % gsz); u.pn = (wgid % nig) / gsz; return true;
    }
};
__device__ __forceinline__ unsigned cvt_pk_bf16(float lo, float hi) { unsigned r; asm volatile("s_nop 0\n\tv_cvt_pk_bf16_f32 %0, %1, %2" : "=v"(r) : "v"(lo), "v"(hi)); return r; }

__device__ __forceinline__ void panel_rstd(LAS float* rsl, const float* ssq, int pm, int wr, int wc, int fr, int fq) {
    volatile LAS int* tag = (volatile LAS int*)(rsl + 256);
    if (__builtin_amdgcn_readfirstlane(*tag) != pm) {
        const int tidl = (wr * 4 + wc) * 64 + fq * 16 + fr, rr = tidl >> 1, hf = tidl & 1;
        const f32x4* p = (const f32x4*)(ssq + (size_t)(pm * BM + rr) * 16 + hf * 8); const f32x4 a = p[0] + p[1];
        float sq = (a.x + a.y) + (a.z + a.w); sq += __shfl_xor(sq, 1);
        __builtin_amdgcn_s_barrier();
        if (hf == 0) rsl[rr] = rsqrtf(sq * (1.f / 1024.f) + 1e-6f);
        if (tidl == 0) *tag = pm;
        asm volatile("s_waitcnt lgkmcnt(0)" ::: "memory"); __builtin_amdgcn_s_barrier(); asm volatile("" ::: "memory");
    }
}
struct EpiBf16 {
    static constexpr bool PERM = true, KEEP = false, CONTIG = true;
    LAS float* rsl;
    bf16* O; int ldc; const float* ssq; int gate_pn0; bf16* fac;
    static __device__ __forceinline__ float s1(float x) { return 1.f + __builtin_amdgcn_exp2f(-1.4426950408889634f * __builtin_amdgcn_fmed3f(x, -30.f, 30.f)); }
    __device__ __forceinline__ void operator()(f32x4 (&acc)[2][2][4][2], const Unit& u, int wr, int wc, int fr, int fq) const {
        panel_rstd(rsl, ssq, u.pm, wr, wc, fr, fq);
        if (u.pn >= gate_pn0) {
            const int row0g = u.pm * BM + wr * 64 + fr, d0 = 64 * (u.pn - gate_pn0) + 16 * wc + 4 * fq;
#pragma unroll
            for (int ai = 0; ai < 2; ++ai)
#pragma unroll
                for (int m = 0; m < 4; ++m) {
                    const float rs = rsl[wr * 64 + fr + ai * HALF + m * 16];
                    const int cc = d0 & 255, pnL = d0 >> 8, bjL = cc >> 7, wcL = (cc >> 5) & 3, fqL = (cc >> 3) & 3, nL = (cc >> 2) & 1;
                    bf16* rowp = fac + ((((((size_t)(u.pm * 4 + pnL) * 4) * 16 + (ai * 4 + m) * 2 + bjL) * 8 + (wr * 4 + wcL)) * 64 + fqL * 16 + fr) * 8 + nL * 4);
                    const size_t zstep = (size_t)16 * 8 * 512;
                    float one = 1.f; asm volatile("" : "+v"(one));
                    float f0[4], f1[4], f2[4], f3[4];
#pragma unroll
                    for (int e = 0; e < 4; ++e) { const float a0 = s1(acc[ai][0][m][0][e] * rs), a1 = s1(acc[ai][0][m][1][e] * rs), a2 = s1(acc[ai][1][m][0][e] * rs), a3 = s1(acc[ai][1][m][1][e] * rs);
                        f0[e] = a1 * __builtin_amdgcn_rcpf(a0); f1[e] = a2 * __builtin_amdgcn_rcpf(a1); f2[e] = a3 * __builtin_amdgcn_rcpf(a2); f3[e] = one * __builtin_amdgcn_rcpf(a3); }
                    *(u32x2*)(rowp) = (u32x2){cvt_pk_bf16(f0[0], f0[1]), cvt_pk_bf16(f0[2], f0[3])};
                    *(u32x2*)(rowp + zstep) = (u32x2){cvt_pk_bf16(f1[0], f1[1]), cvt_pk_bf16(f1[2], f1[3])};
                    *(u32x2*)(rowp + 2 * zstep) = (u32x2){cvt_pk_bf16(f2[0], f2[1]), cvt_pk_bf16(f2[2], f2[3])};
                    *(u32x2*)(rowp + 3 * zstep) = (u32x2){cvt_pk_bf16(f3[0], f3[1]), cvt_pk_bf16(f3[2], f3[3])}; }
            return; }
        const int row0 = u.pm * BM + wr * 64 + fr, col0 = u.pn * BM + wc * 64 + 8 * fq;
#pragma unroll
        for (int ai = 0; ai < 2; ++ai)
#pragma unroll
            for (int m = 0; m < 4; ++m) { const int row = row0 + ai * HALF + m * 16; bf16* rowp = O + (size_t)row * ldc + col0;
                const float rs = rsl[wr * 64 + fr + ai * HALF + m * 16];
#pragma unroll
                for (int bj = 0; bj < 2; ++bj) { const f32x4 v0 = acc[ai][bj][m][0] * rs, v1 = acc[ai][bj][m][1] * rs;
                    u32x4 w; w.x = cvt_pk_bf16(v0[0], v0[1]); w.y = cvt_pk_bf16(v0[2], v0[3]); w.z = cvt_pk_bf16(v1[0], v1[1]); w.w = cvt_pk_bf16(v1[2], v1[3]);
                    *(u32x4*)(rowp + bj * 32) = w; } }
    }
};
struct EpiResid {
    static constexpr bool PERM = true, KEEP = false, CONTIG = true;
    bf16* xb; int ldc; float* ssq;
    __device__ __forceinline__ void operator()(f32x4 (&acc)[2][2][4][2], const Unit& u, int wr, int wc, int fr, int fq) const {
        const int row0 = u.pm * BM + wr * 64 + fr, col0 = u.pn * BM + wc * 64 + 8 * fq;
#pragma unroll
        for (int ai = 0; ai < 2; ++ai)
#pragma unroll
            for (int m = 0; m < 4; ++m) { const int row = row0 + ai * HALF + m * 16; const size_t off = (size_t)row * ldc + col0; float q = 0.f;
#pragma unroll
                for (int bj = 0; bj < 2; ++bj) {
                    const u32x4 o = *(const u32x4*)(xb + off + bj * 32);
                    const f32x4 x0 = (f32x4){bf2f(o.x & 0xffffu), bf2f(o.x >> 16), bf2f(o.y & 0xffffu), bf2f(o.y >> 16)} + acc[ai][bj][m][0];
                    const f32x4 x1 = (f32x4){bf2f(o.z & 0xffffu), bf2f(o.z >> 16), bf2f(o.w & 0xffffu), bf2f(o.w >> 16)} + acc[ai][bj][m][1];
                    q += (x0[0] * x0[0] + x0[1] * x0[1]) + (x0[2] * x0[2] + x0[3] * x0[3]) + (x1[0] * x1[0] + x1[1] * x1[1]) + (x1[2] * x1[2] + x1[3] * x1[3]);
                    u32x4 w; w.x = cvt_pk_bf16(x0[0], x0[1]); w.y = cvt_pk_bf16(x0[2], x0[3]); w.z = cvt_pk_bf16(x1[0], x1[1]); w.w = cvt_pk_bf16(x1[2], x1[3]);
                    *(u32x4*)(xb + off + bj * 32) = w; }
                q += __shfl_xor(q, 16); q += __shfl_xor(q, 32); if (fq == 0) ssq[(size_t)row * 16 + u.pn * 4 + wc] = q;
            }
    }
};
struct EpiLift {
    static constexpr bool PERM = true, KEEP = true, CONTIG = false;
    const bf16* fac; bf16* mb; int ldc; const float* ssqc;
    __device__ __forceinline__ void operator()(f32x4 (&acc)[2][2][4][2], const Unit& u, int wr, int wc, int fr, int fq) const {
        const int row0 = u.pm * BM + wr * 64 + fr, col0 = u.pn * BM + wc * 32 + 8 * fq;
#pragma unroll
        for (int ai = 0; ai < 2; ++ai)
#pragma unroll
            for (int m = 0; m < 4; ++m) { const int row = row0 + ai * HALF + m * 16;
                float rsc = 1.f;
                if (u.z == 1 || u.z == 2) { const f32x2 p = *(const f32x2*)(ssqc + (size_t)row * 8 + 2 * fq); float sq = p.x + p.y; sq += __shfl_xor(sq, 16); sq += __shfl_xor(sq, 32);
                    const float v = sq * (1.f / 512.f) + 1e-6f; rsc = (u.z == 1) ? sqrtf(v) : rsqrtf(v); }
#pragma unroll
                for (int bj = 0; bj < 2; ++bj) { const int col = col0 + bj * HALF;
                    const u32x4 g0 = *(const u32x4*)(fac + (((((size_t)(u.pm * 4 + u.pn) * 4 + u.z) * 16 + (ai * 4 + m) * 2 + bj) * 8 + (wr * 4 + wc)) * 64 + fq * 16 + fr) * 8);
                    f32x4& v0 = acc[ai][bj][m][0]; f32x4& v1 = acc[ai][bj][m][1];
                    v0[0] *= rsc * bf2f(g0.x & 0xffffu); v0[1] *= rsc * bf2f(g0.x >> 16); v0[2] *= rsc * bf2f(g0.y & 0xffffu); v0[3] *= rsc * bf2f(g0.y >> 16);
                    v1[0] *= rsc * bf2f(g0.z & 0xffffu); v1[1] *= rsc * bf2f(g0.z >> 16); v1[2] *= rsc * bf2f(g0.w & 0xffffu); v1[3] *= rsc * bf2f(g0.w >> 16);
                    if (u.z == 3) { u32x4 w; w.x = cvt_pk_bf16(v0[0], v0[1]); w.y = cvt_pk_bf16(v0[2], v0[3]); w.z = cvt_pk_bf16(v1[0], v1[1]); w.w = cvt_pk_bf16(v1[2], v1[3]);
                        *(u32x4*)(mb + (size_t)row * ldc + col) = w; } } }
    }
};

__device__ __forceinline__ float dpp_ror1(float x) { return __int_as_float(__builtin_amdgcn_update_dpp(0, __float_as_int(x), 0x121, 0xf, 0xf, false)); }
__device__ __forceinline__ float dpp_ror2(float x) { return __int_as_float(__builtin_amdgcn_update_dpp(0, __float_as_int(x), 0x122, 0xf, 0xf, false)); }
__device__ __forceinline__ float dpp_prev1(float cur, float prev) { return __int_as_float(__builtin_amdgcn_update_dpp(__builtin_amdgcn_update_dpp(0, __float_as_int(prev), 0x121, 0xf, 0xf, false), __float_as_int(cur), 0x111, 0xf, 0xf, false)); }
__device__ __forceinline__ float dpp_prev2(float cur, float prev) { return __int_as_float(__builtin_amdgcn_update_dpp(__builtin_amdgcn_update_dpp(0, __float_as_int(prev), 0x122, 0xf, 0xf, false), __float_as_int(cur), 0x112, 0xf, 0xf, false)); }
struct EpiConvAct {
    static constexpr bool PERM = true, KEEP = false, CONTIG = false;
    bf16* act; const float* ssq; const float* cw; const float* cb; float* rawh; LAS unsigned char* halo; int ntn;
    __device__ __forceinline__ void operator()(f32x4 (&acc)[2][2][4][2], const Unit& u, int wr, int wc, int fr, int fq) const {
        asm volatile("" : "+v"(fr), "+v"(fq));
        const int row0 = u.pm * BM + wr * 64 + fr, ch0 = u.pn * 128 + wc * 32 + 8 * fq;
        LAS float* rsl = (LAS float*)(halo + 12288);
        panel_rstd(rsl, ssq, u.pm, wr, wc, fr, fq);
#pragma unroll
        for (int ai = 0; ai < 2; ++ai)
#pragma unroll
            for (int m = 0; m < 4; ++m) { const float rs = rsl[wr * 64 + fr + ai * HALF + m * 16];
#pragma unroll
                for (int bj = 0; bj < 2; ++bj) { acc[ai][bj][m][0] = acc[ai][bj][m][0] * rs; acc[ai][bj][m][1] = acc[ai][bj][m][1] * rs; } }
        LAS f32x4* H = (LAS f32x4*)halo;
        if (fr >= 14) {
#pragma unroll
            for (int ai = 0; ai < 2; ++ai) { const int b = 2 * ai + wr;
#pragma unroll
                for (int bj = 0; bj < 2; ++bj)
#pragma unroll
                    for (int n = 0; n < 2; ++n) H[((((b * 4 + wc) * 4 + fq) * 2 + (fr - 14)) * 2 + bj) * 2 + n] = acc[ai][bj][3][n]; } }
        { float* rw = rawh + (size_t)(u.pm * ntn + u.pn) * 1024;
          if (wr == 1 && fr >= 14) {
#pragma unroll
            for (int bj = 0; bj < 2; ++bj)
#pragma unroll
                for (int n = 0; n < 2; ++n) *(f32x4*)(rw + (2 + fr - 14) * 256 + bj * HALF + wc * 32 + 8 * fq + 4 * n) = acc[1][bj][3][n]; }
          if (wr == 0 && fr < 2) {
#pragma unroll
            for (int bj = 0; bj < 2; ++bj)
#pragma unroll
                for (int n = 0; n < 2; ++n) *(f32x4*)(rw + fr * 256 + bj * HALF + wc * 32 + 8 * fq + 4 * n) = acc[0][bj][0][n]; } }
        LAS float* WL = (LAS float*)(halo + 8192);
        { const int tidl = (wr * 4 + wc) * 64 + fq * 16 + fr, i2 = tidl * 2, kind = i2 >> 7, c = i2 & 127, k4 = kind & 3;
          const float* src = (k4 < 3 ? cw + k4 * 5632 : cb) + (kind >= 4 ? 2816 : 0) + u.pn * 128 + c;
          *(LAS f32x2*)(WL + i2) = *(const f32x2*)src; }
        asm volatile("s_waitcnt vmcnt(0) lgkmcnt(0)" ::: "memory"); __builtin_amdgcn_s_barrier(); asm volatile("" ::: "memory");
        bf16* actb = act + (size_t)(u.pm * BM + wr * 64) * 2816 + u.pn * 128 + wc * 32;
        const unsigned alane = (unsigned)(fr * 2816 + 8 * fq);
        unsigned pkw[2][4][3];
#pragma unroll
        for (int n = 0; n < 2; ++n) {
#pragma unroll
            for (int eh = 0; eh < 2; ++eh) {
                const int cl = wc * 32 + 8 * fq + 4 * n + 2 * eh;
                f32x2 wg[3], wu[3], bg, bu;
#pragma unroll
                for (int j = 0; j < 3; ++j) { wg[j] = *(const LAS f32x2*)(WL + j * 128 + cl); wu[j] = *(const LAS f32x2*)(WL + (4 + j) * 128 + cl); }
                bg = *(const LAS f32x2*)(WL + 3 * 128 + cl); bu = *(const LAS f32x2*)(WL + 7 * 128 + cl);
#pragma unroll
                for (int ai = 0; ai < 2; ++ai) { const int b = 2 * ai + wr;
#pragma unroll
                    for (int m = 3; m >= 0; --m) {
                        float r2[2];
#pragma unroll
                        for (int e2 = 0; e2 < 2; ++e2) { const int e = 2 * eh + e2;
                            const float gc = acc[ai][0][m][n][e], uc = acc[ai][1][m][n][e];
                            float gp = 0.f, up = 0.f; asm volatile("" : "+v"(gp), "+v"(up));
                            if (m > 0) { gp = acc[ai][0][m - 1][n][e]; up = acc[ai][1][m - 1][n][e]; }
                            else if (b >= 1) { const int fk = fr >= 14 ? fr - 14 : 0; const LAS float* hp = (const LAS float*)(H + ((((b - 1) * 4 + wc) * 4 + fq) * 2 + fk) * 4 + n); gp = hp[e]; up = hp[8 + e]; }
                            const float g1 = dpp_prev1(gc, gp), g2 = dpp_prev2(gc, gp), u1 = dpp_prev1(uc, up), u2 = dpp_prev2(uc, up);
                            const float vg = bg[e2] + wg[0][e2] * g2 + wg[1][e2] * g1 + wg[2][e2] * gc;
                            const float vu = bu[e2] + wu[0][e2] * u2 + wu[1][e2] * u1 + wu[2][e2] * uc;
                            r2[e2] = siluf_(vg) * vu; }
                        const unsigned pk = cvt_pk_bf16(r2[0], r2[1]);
                        if (2 * n + eh < 3) pkw[ai][m][2 * n + eh] = pk;
                        else *(u32x4*)(actb + (size_t)(ai * HALF + m * 16) * 2816 + alane) = (u32x4){pkw[ai][m][0], pkw[ai][m][1], pkw[ai][m][2], pk};
                    }
                }
            }
        }
    }
};

template <class Epi, bool ALIGN_EPI = true>
__device__ __forceinline__ void gemm_phase(LAS unsigned char* lds, const Gemm g, const Order& S, const Epi& E) {
    int tid = threadIdx.x; asm volatile("" : "+v"(tid));
    const int wid = __builtin_amdgcn_readfirstlane(tid >> 6), lane = tid & 63, wr = wid >> 2, wc = wid & 3, fr = lane & 15, fq = lane >> 4;
    const int K = g.K, nt = K / BK;
    unsigned voffA[2], voffB[2];
#pragma unroll
    for (int i = 0; i < 2; ++i) { int R, C; stage_rc(tid * 16 + i * 8192, R, C);
        const int Rb = Epi::CONTIG ? (64 * (R >> 5) + perm32(R & 31)) : (Epi::PERM ? ((R & ~31) + perm32(R & 31)) : R);
        voffA[i] = (unsigned)(R * g.lda + C) * 2u; voffB[i] = (unsigned)(Rb * g.ldb + C) * 2u; }
    const size_t kstep = (size_t)(BK * 2);
    const size_t hstepA = (size_t)HALF * g.lda * 2, hstepB = (size_t)(Epi::CONTIG ? 32 : HALF) * g.ldb * 2;
    const size_t tstepA = 2 * hstepA, tstepB = (size_t)BM * g.ldb * 2;
    const unsigned ldsw = (unsigned)wid * 1024u;
    const int aoff = lds_byte(wr * 64 + fr, fq * 8), boff = lds_byte(wc * 32 + fr, fq * 8);
#define PG8_SA(b, h) (((b) * 2 + (h)) * HTB)
#define PG8_SB(b, h) ((4 + (b) * 2 + (h)) * HTB)
#define PG8_STAGE(bufoff, gbase, voff) do { _Pragma("unroll") for (int _i = 0; _i < 2; ++_i) \
        __builtin_amdgcn_global_load_lds((const unsigned*)((const char*)(gbase) + (voff)[_i]), (LAS unsigned*)(lds + (bufoff) + ldsw + _i * 8192), 16, 0, 0); } while (0)
#define PG8_LDA(dst, b, h) do { _Pragma("unroll") for (int m = 0; m < 4; ++m) _Pragma("unroll") for (int k = 0; k < 2; ++k) dst[m][k] = *(const LAS bf16x8*)(lds + PG8_SA(b, h) + aoff + m * 2048 + k * 1024); } while (0)
#define PG8_LDB(dst, b, h) do { _Pragma("unroll") for (int n = 0; n < 2; ++n) _Pragma("unroll") for (int k = 0; k < 2; ++k) dst[n][k] = *(const LAS bf16x8*)(lds + PG8_SB(b, h) + boff + n * 2048 + k * 1024); } while (0)
#define PG8_MMA(ai, bj, At, Bt) do { __builtin_amdgcn_s_setprio(1); _Pragma("unroll") for (int m = 0; m < 4; ++m) _Pragma("unroll") for (int n = 0; n < 2; ++n) _Pragma("unroll") for (int k = 0; k < 2; ++k) \
        acc[ai][bj][m][n] = __builtin_amdgcn_mfma_f32_16x16x32_bf16(Bt[n][k], At[m][k], acc[ai][bj][m][n], 0, 0, 0); __builtin_amdgcn_s_setprio(0); } while (0)
#define PG8_WAIT_V(n) asm volatile("s_waitcnt vmcnt(" #n ")" ::: "memory")
#define PG8_WAIT_L(n) asm volatile("s_waitcnt lgkmcnt(" #n ")" ::: "memory")
#define PG8_BAR __builtin_amdgcn_s_barrier()
#define PG8_SCHED __builtin_amdgcn_sched_barrier(0)
    Unit cur, nxt; int ui = 0;
    if (!S.next(0, cur)) return;
    f32x4 acc[2][2][4][2];
#pragma unroll
    for (int a = 0; a < 2; ++a)
#pragma unroll
        for (int b = 0; b < 2; ++b)
#pragma unroll
            for (int m = 0; m < 4; ++m)
#pragma unroll
                for (int n = 0; n < 2; ++n) acc[a][b][m][n] = (f32x4){0.f, 0.f, 0.f, 0.f};
    bf16x8 At[4][2], B0[2][2], B1[2][2];
    const char* cA = (const char*)g.A + (size_t)cur.pm * tstepA + (size_t)cur.z * g.zA; const char* cB = (const char*)g.Bt + (size_t)cur.pn * tstepB + (size_t)cur.z * g.zB;
    PG8_STAGE(PG8_SB(0, 0), cB, voffB); PG8_STAGE(PG8_SB(0, 1), cB + hstepB, voffB); PG8_STAGE(PG8_SA(0, 0), cA, voffA); PG8_STAGE(PG8_SA(0, 1), cA + hstepA, voffA);
    if (wr == 1) PG8_BAR;
    PG8_WAIT_V(2); PG8_BAR;
    PG8_STAGE(PG8_SB(1, 0), cB + kstep, voffB); PG8_STAGE(PG8_SA(1, 0), cA + kstep, voffA); PG8_STAGE(PG8_SB(1, 1), cB + hstepB + kstep, voffB);
    PG8_WAIT_V(6); PG8_BAR;
    for (;;) {
        const bool has_next = S.next(ui + 1, nxt);
        const char* nA = has_next ? (const char*)g.A + (size_t)nxt.pm * tstepA + (size_t)nxt.z * g.zA : cA; const char* nB = has_next ? (const char*)g.Bt + (size_t)nxt.pn * tstepB + (size_t)nxt.z * g.zB : cB;
        for (int t = 0; t < nt; t += 2) {
            const bool last = (t == nt - 2);
            const char* a1 = cA + (size_t)(t + 1) * kstep;
            const char* a2 = last ? nA : cA + (size_t)(t + 2) * kstep; const char* b2 = last ? nB : cB + (size_t)(t + 2) * kstep;
            const char* a3 = a2 + kstep; const char* b3 = b2 + kstep;
            PG8_LDB(B0, 0, 0); PG8_LDB(B1, 0, 1); PG8_SCHED; PG8_LDA(At, 0, 0); PG8_STAGE(PG8_SA(1, 1), a1 + hstepA, voffA);
            PG8_WAIT_V(8); PG8_WAIT_L(0); PG8_BAR; PG8_MMA(0, 0, At, B0); PG8_MMA(0, 1, At, B1); PG8_BAR; PG8_SCHED;
            PG8_LDA(At, 0, 1); PG8_STAGE(PG8_SB(0, 0), b2, voffB); PG8_STAGE(PG8_SB(0, 1), b2 + hstepB, voffB); PG8_STAGE(PG8_SA(0, 0), a2, voffA);
            PG8_WAIT_V(8); PG8_WAIT_L(0); PG8_BAR; PG8_MMA(1, 0, At, B0); PG8_MMA(1, 1, At, B1); PG8_BAR; PG8_SCHED;
            PG8_LDB(B0, 1, 0); PG8_LDB(B1, 1, 1); PG8_SCHED; PG8_LDA(At, 1, 0); PG8_STAGE(PG8_SA(0, 1), a2 + hstepA, voffA);
            PG8_WAIT_V(8); PG8_WAIT_L(0); PG8_BAR; PG8_MMA(0, 0, At, B0); PG8_MMA(0, 1, At, B1); PG8_BAR; PG8_SCHED;
            PG8_LDA(At, 1, 1); PG8_STAGE(PG8_SB(1, 0), b3, voffB); PG8_STAGE(PG8_SB(1, 1), b3 + hstepB, voffB); PG8_STAGE(PG8_SA(1, 0), a3, voffA);
            PG8_WAIT_V(8); PG8_WAIT_L(0); PG8_BAR; PG8_MMA(1, 0, At, B0); PG8_MMA(1, 1, At, B1); PG8_BAR; PG8_SCHED;
        }
        if constexpr (ALIGN_EPI) { if (wr == 0) PG8_BAR; }
        E(acc, cur, wr, wc, fr, fq);
        if (!has_next) break;
        if (!(Epi::KEEP && nxt.z != 0))
#pragma unroll
        for (int a = 0; a < 2; ++a)
#pragma unroll
            for (int b = 0; b < 2; ++b)
#pragma unroll
                for (int m = 0; m < 4; ++m)
#pragma unroll
                    for (int n = 0; n < 2; ++n) acc[a][b][m][n] = (f32x4){0.f, 0.f, 0.f, 0.f};
        cur = nxt; cA = nA; cB = nB; ++ui;
        if constexpr (ALIGN_EPI) { if (wr == 1) PG8_BAR; }
    }
    PG8_WAIT_V(0);
    if constexpr (!ALIGN_EPI) { if (wr == 0) PG8_BAR; }
    PG8_BAR;
#undef PG8_SA
#undef PG8_SB
#undef PG8_STAGE
#undef PG8_LDA
#undef PG8_LDB
#undef PG8_MMA
#undef PG8_WAIT_V
#undef PG8_WAIT_L
#undef PG8_BAR
#undef PG8_SCHED
}
}

#define XB_TMO      128
#define XB_XCNT(j)  (256  + 64 * (j))
#define XB_XSUB(j)  (1280 + 64 * (j))
#define XB_XGEN(j)  (2304 + 64 * (j))
#define XB_TOP      3328
#define XB_TOPGEN   3392
#define XCD_BAR_WORDS 3456
#define XB_SPIN_CAP (1u << 18)
__device__ __forceinline__ unsigned xb_ld(unsigned* p)              { return __hip_atomic_load(p, __ATOMIC_RELAXED, __HIP_MEMORY_SCOPE_AGENT); }
__device__ __forceinline__ unsigned xb_add(unsigned* p, unsigned v) { return __hip_atomic_fetch_add(p, v, __ATOMIC_RELAXED, __HIP_MEMORY_SCOPE_AGENT); }
__device__ __forceinline__ unsigned xb_xcc_id() { return (unsigned)__builtin_amdgcn_s_getreg((3 << 11) | 20) & 0xFu; }
#define XB_SPIN(cond, bar) do { unsigned _sp = 0; while (cond) { __builtin_amdgcn_s_sleep(1); \
    if ((++_sp & 255u) == 0u) { if (xb_ld(&(bar)[XB_TMO])) break; if (_sp > XB_SPIN_CAP) { atomicAdd(&(bar)[XB_TMO], 1u); break; } } } } while (0)
struct XcdBarrier { unsigned* bar; unsigned x; volatile LAS unsigned* st; };
__device__ __forceinline__ XcdBarrier xcd_barrier_post(unsigned* bar, volatile LAS unsigned* st) {
    XcdBarrier b; b.bar = bar; b.x = xb_xcc_id(); b.st = st;
    if (threadIdx.x == 0) (void)xb_add(&bar[XB_XCNT(b.x)], 1u);
    return b;
}
__device__ __forceinline__ void xcd_barrier_complete(unsigned* bar, unsigned x, unsigned& nloc, unsigned& nx) {
    const unsigned G = gridDim.x * gridDim.y * gridDim.z;
    unsigned sum, cnt, mine, sp = 0u;
    for (;;) {
        sum = 0u; cnt = 0u; mine = 0u;
#pragma unroll
        for (unsigned j = 0; j < 16; ++j) { const unsigned c = xb_ld(&bar[XB_XCNT(j)]); sum += c; cnt += (c > 0u) ? 1u : 0u; mine = (j == x) ? c : mine; }
        if (sum == G) break;
        __builtin_amdgcn_s_sleep(1);
        if ((++sp & 255u) == 0u) { if (xb_ld(&bar[XB_TMO])) break; if (sp > XB_SPIN_CAP) { atomicAdd(&bar[XB_TMO], 1u); break; } }
    }
    nloc = mine > 0u ? mine : 1u; nx = cnt > 0u ? cnt : 1u;
}
__device__ __forceinline__ void xcd_barrier(const XcdBarrier& b) {
    asm volatile("s_waitcnt vmcnt(0)" ::: "memory");
    __syncthreads();
    if (threadIdx.x == 0) {
        unsigned* bar = b.bar;
        __builtin_amdgcn_s_waitcnt(0);
        unsigned nloc = b.st[0], nx = b.st[1];
        if (nloc == 0u) { xcd_barrier_complete(bar, b.x, nloc, nx); b.st[0] = nloc; b.st[1] = nx; }
        const unsigned old = xb_add(&bar[XB_XSUB(b.x)], 1u);
        const unsigned gen = old / nloc;
        if (old + 1u == (gen + 1u) * nloc) {
            __builtin_amdgcn_fence(__ATOMIC_RELEASE, "agent");
            asm volatile("s_waitcnt vmcnt(0)" ::: "memory");
            const unsigned og = xb_add(&bar[XB_TOP], 1u);
            const unsigned tg = og / nx;
            if (og + 1u == (tg + 1u) * nx) xb_add(&bar[XB_TOPGEN], 1u);
            else XB_SPIN(xb_ld(&bar[XB_TOPGEN]) == tg, bar);
            __builtin_amdgcn_fence(__ATOMIC_ACQUIRE, "agent");
            xb_add(&bar[XB_XGEN(b.x)], 1u);
            asm volatile("s_waitcnt vmcnt(0)" ::: "memory");
        } else {
            XB_SPIN(xb_ld(&bar[XB_XGEN(b.x)]) == gen, bar);
            __builtin_amdgcn_fence(__ATOMIC_ACQUIRE, "agent");
            asm volatile("s_waitcnt vmcnt(0)" ::: "memory");
        }
    }
    __syncthreads();
}

__device__ __forceinline__ bf16x8 frag_kc(const LAS bf16* X, int ld, int mn0, int k0, int lane) { return *(const LAS bf16x8*)(X + (mn0 + (lane & 15)) * ld + k0 + 8 * (lane >> 4)); }
__device__ __forceinline__ bf16x8 gfrag_kc(const bf16* X, int ld, int mn0, int k0, int lane) { const bf16* b = X + (size_t)mn0 * ld + k0; const unsigned lo = (unsigned)((lane & 15) * ld + 8 * (lane >> 4)); return *(const bf16x8*)(b + lo); }
__device__ __forceinline__ s16x4 trr(const LAS bf16* p) { return __builtin_bit_cast(s16x4, __builtin_amdgcn_ds_read_tr16_b64_v4i16((LAS s16x4*)p)); }
__device__ __forceinline__ bf16x8 frag_ks(const LAS bf16* X, int ld, int mn0, int k0, int lane) {
    const int r = lane & 15, g = lane >> 4;
    const LAS bf16* p = X + (k0 + 8 * g + (r >> 2)) * ld + mn0 + 4 * (r & 3);
    const s16x4 lo = trr(p), hi = trr(p + 4 * ld);
    return (bf16x8){lo[0], lo[1], lo[2], lo[3], hi[0], hi[1], hi[2], hi[3]};
}
__device__ __forceinline__ f32x4 zero4() { f32x4 z = {0.f, 0.f, 0.f, 0.f}; asm volatile("" : "+v"(z)); return z; }
__device__ __forceinline__ u32x4 uone4() { u32x4 z = {0x3F80u, 0u, 0u, 0u}; asm volatile("" : "+v"(z)); return z; }
__device__ __forceinline__ u32x4 uzero4() { u32x4 z = {0u, 0u, 0u, 0u}; asm volatile("" : "+v"(z)); return z; }
#define MFMA16(a, b, c) __builtin_amdgcn_mfma_f32_16x16x32_bf16((a), (b), (c), 0, 0, 0)
__device__ __forceinline__ u32x4 scale8(u32x4 w, float s) {
    u32x4 o;
    o.x = pk2(bf2f(w.x & 0xffffu) * s, bf2f(w.x >> 16) * s); o.y = pk2(bf2f(w.y & 0xffffu) * s, bf2f(w.y >> 16) * s);
    o.z = pk2(bf2f(w.z & 0xffffu) * s, bf2f(w.z >> 16) * s); o.w = pk2(bf2f(w.w & 0xffffu) * s, bf2f(w.w >> 16) * s);
    return o;
}
__device__ __forceinline__ float wscan_add(float v, int lane) {
#pragma unroll
    for (int o = 1; o < 64; o <<= 1) { const float t = __shfl_up(v, o); if (lane >= o) v += t; }
    return v;
}
__device__ __forceinline__ float wscan_max(float v, int lane) {
#pragma unroll
    for (int o = 1; o < 64; o <<= 1) { const float t = __shfl_up(v, o); if (lane >= o) v = fmaxf(v, t); }
    return v;
}

#ifndef GEMM_ALIGN
#define GEMM_ALIGN true
#endif
enum { PH_W = 0, PH_INPROJ, PH_M0, PH_M1, PH_M2, PH_M3, PH_LIFT, PH_OUT, PH_UP, PH_DOWN, PH_FINAL, PH_COUNT };
enum { I_X = 0, I_MIXG, I_WIN, I_AIB, I_AFB, I_ANG, I_BCW, I_CCW, I_CCB, I_CDTB, I_CALOG, I_CDSKIP, I_CNG, I_WLIFT, I_WOUT, I_FFNG, I_WUP, I_FCW, I_FCB, I_WDOWN, I_FING, N_IN };
struct Args { const float* in[N_IN]; float* out; unsigned char* ws; int l_lo, l_hi, g_lo, g_hi, ph_lo, ph_hi, use_bar, pad; };

__device__ __forceinline__ void transpose_item(const float* W, int ldw, int nsrc0, int k0, bf16* WT, int ldt, int ndst0, LAS float* scr, int lane, const float* kscale = nullptr, int gate_tile = -1) {
    int scol = nsrc0 + (lane & 31);
    if (gate_tile >= 0) {
        const int c = (ndst0 & 255) + (lane & 31), wc = c >> 6, bj = (c >> 5) & 1, fq = (c >> 3) & 3, n = (c >> 2) & 1, e = c & 3;
        scol = 6160 + (2 * bj + n) * 1024 + 64 * gate_tile + 16 * wc + 4 * fq + e; }
#pragma unroll 8
    for (int i = 0; i < 32; ++i) { const int kk = 2 * i + (lane >> 5); scr[kk * 33 + (lane & 31)] = W[(size_t)(k0 + kk) * ldw + scol] * (kscale ? kscale[k0 + kk] : 1.f); }
    LDS_WAIT(); asm volatile("" ::: "memory");
    const int c = lane & 7;
#pragma unroll
    for (int j = 0; j < 4; ++j) { const int n = (lane >> 3) + 8 * j; const LAS float* s = scr + (8 * c) * 33 + n;
        u32x4 o; o.x = pk2(s[0 * 33], s[1 * 33]); o.y = pk2(s[2 * 33], s[3 * 33]); o.z = pk2(s[4 * 33], s[5 * 33]); o.w = pk2(s[6 * 33], s[7 * 33]);
        *(u32x4*)(WT + (size_t)(ndst0 + n) * ldt + k0 + 8 * c) = o; }
    LDS_WAIT(); asm volatile("" ::: "memory");
}

__global__ void __launch_bounds__(NTHR, 2) fwd(Args args) {
    extern __shared__ __attribute__((aligned(16))) unsigned char lds_raw[];
    LAS unsigned char* lds = (LAS unsigned char*)lds_raw;
    const int NBLK = gridDim.x, blk = blockIdx.x;
    {
        volatile LAS unsigned* MISC0 = (volatile LAS unsigned*)(lds + MISC_OFF);
        if (threadIdx.x < 16) MISC0[threadIdx.x] = 0u;
        __syncthreads();
    }
    XcdBarrier bar; bar.bar = (unsigned*)(args.ws + WS_CTL) + 4096; bar.x = 0; bar.st = nullptr;
    if (args.use_bar) bar = xcd_barrier_post((unsigned*)(args.ws + WS_CTL) + 4096, (volatile LAS unsigned*)(lds + MISC_OFF) + 8);
#define GRID_BAR() do { if (args.use_bar) xcd_barrier(bar); } while (0)
#ifndef REPMASK
#define REPMASK 0
#endif
#define IN(k) (args.ph_lo <= (k) && (k) < args.ph_hi)
#define REPS(k) for (int rep_ = 0; rep_ < 1 + ((REPMASK >> (k)) & 1); ++rep_)
#define PHASE_BEGIN() int tid = threadIdx.x; asm volatile("" : "+v"(tid)); const int lane = tid & 63, wave = __builtin_amdgcn_readfirstlane(tid >> 6); \
    const __attribute__((address_space(4))) Args* ka = (const __attribute__((address_space(4))) Args*)__builtin_amdgcn_kernarg_segment_ptr(); asm volatile("" : "+s"(ka)); \
    unsigned char* ws = ka->ws; \
    const size_t grow0 = (size_t)grp * T; const float* xsrc = (l == 0) ? ka->in[I_X] : ka->out; (void)grow0; (void)xsrc; \
    const int gw = blk * NWAVES + wave, NGW = NBLK * NWAVES, gt = blk * NTHR + tid, NGT = NBLK * NTHR; (void)lane; (void)gw; (void)NGW; (void)gt; (void)NGT; \
    bf16* const WinT = (bf16*)(ws + WS_WIN); bf16* const WliftT = (bf16*)(ws + WS_WLIFT); bf16* const WoutT = (bf16*)(ws + WS_WOUT); \
    bf16* const WupT = (bf16*)(ws + WS_WUP); bf16* const WdownT = (bf16*)(ws + WS_WDOWN); bf16* const W16B = (bf16*)(ws + WS_W16); \
    bf16* const XN = (bf16*)(ws + WS_XN); bf16* const P = (bf16*)(ws + WS_P); bf16* const FAC = (bf16*)(ws + WS_P) + (size_t)T * PWS; (void)FAC; bf16* const U = (bf16*)(ws + WS_U); bf16* const ACT = (bf16*)(ws + WS_ACT); \
    bf16* const YCAT = (bf16*)(ws + WS_YCAT); bf16* const XG = (bf16*)(ws + WS_XG); bf16* const MB = (bf16*)(ws + WS_MB); float* const SP = (float*)(ws + WS_SP); \
    float* const SSQ1 = (float*)(ws + WS_SSQ1); float* const SSQ2 = (float*)(ws + WS_SSQ2); float* const SSQC = (float*)(ws + WS_SSQC); float* const RAWH = (float*)(ws + WS_RAWH); (void)SSQ1; (void)SSQ2; (void)SSQC; (void)RAWH; \
    float* const GBc = (float*)(ws + WS_GB); float* const GGc = (float*)(ws + WS_GG); float* const GMT = (float*)(ws + WS_GMT); \
    float* const MCAR = (float*)(ws + WS_MCAR); float* const MNEW = (float*)(ws + WS_MNEW); float* const MSC = (float*)(ws + WS_MSC); float* const SUMB = (float*)(ws + WS_SUMB); float* const SUMG = (float*)(ws + WS_SUMG); (void)SUMB; (void)SUMG; \
    float* const DTB = (float*)(ws + WS_DT); float* const ACB = (float*)(ws + WS_AC); bf16* const XBC = (bf16*)(ws + WS_XBC); \
    bf16* const DC = (bf16*)(ws + WS_DC); bf16* const CS = (bf16*)(ws + WS_CS); bf16* const DH = (bf16*)(ws + WS_DH); bf16* const HS = (bf16*)(ws + WS_HS); \
    (void)WinT; (void)WliftT; (void)WoutT; (void)WupT; (void)WdownT; (void)W16B; (void)XN; (void)P; (void)U; (void)ACT; (void)YCAT; (void)XG; (void)MB; (void)SP; (void)GBc; (void)GGc; (void)GMT; \
    (void)MCAR; (void)MNEW; (void)MSC; (void)DTB; (void)ACB; (void)XBC; (void)DC; (void)CS; (void)DH; (void)HS

    for (int l = args.l_lo; l < args.l_hi; ++l)
    for (int grp = args.g_lo; grp < args.g_hi; ++grp) {

        REPS(PH_W) if (IN(PH_W) && grp == 0) {
            PHASE_BEGIN();
            LAS float* scr = (LAS float*)(lds + wave * 16384);
            constexpr int I_IN = 16 * 320, I_LF = 4 * 8 * 32, I_OUT = 16 * 32, I_UP = 16 * 176, I_DN = 44 * 32, NIT = I_IN + I_LF + I_OUT + I_UP + I_DN;
            for (int it = gw; it < NIT; it += NGW) {
                int r = it;
                if (r < I_IN) { const int kb = r / 320, nb = r % 320, n0 = 32 * nb, ns = n0 + (n0 >= P_SQ ? 16 : (n0 >= P_BB ? 8 : 0));
                    transpose_item(ka->in[I_WIN] + (size_t)l * DM * PIN, PIN, ns, 64 * kb, WinT, DM, n0, scr, lane, ka->in[I_MIXG] + (size_t)l * DM, n0 >= P_G ? (n0 - P_G) >> 8 : -1); continue; } r -= I_IN;
                if (r < I_LF) { const int br = r / 256, q = r % 256, kb = q / 32, nb = q % 32;
                    transpose_item(ka->in[I_WLIFT] + (size_t)(l * 4 + br) * 512 * DM, DM, 32 * nb, 64 * kb, WliftT + (size_t)br * DM * 512, 512, 32 * nb, scr, lane, br == 2 ? ka->in[I_CNG] + (size_t)l * 512 : nullptr); continue; } r -= I_LF;
                if (r < I_OUT) { const int kb = r / 32, nb = r % 32;
                    transpose_item(ka->in[I_WOUT] + (size_t)l * DM * DM, DM, 32 * nb, 64 * kb, WoutT, DM, 32 * nb, scr, lane); continue; } r -= I_OUT;
                if (r < I_UP) { const int kb = r / 176, nb = r % 176, n0 = 32 * nb, tp = n0 >> 8, j = n0 & 255, ns = (j < 128) ? 128 * tp + j : 2816 + 128 * tp + (j - 128);
                    transpose_item(ka->in[I_WUP] + (size_t)l * DM * DFF2, DFF2, ns, 64 * kb, WupT, DM, n0, scr, lane, ka->in[I_FFNG] + (size_t)l * DM); continue; } r -= I_UP;
                { const int kb = r / 32, nb = r % 32;
                    transpose_item(ka->in[I_WDOWN] + (size_t)l * DFF * DM, DM, 32 * nb, 64 * kb, WdownT, DFF, 32 * nb, scr, lane); }
            }
            for (int i = gt; i < 16 * DM; i += NGT) { const int c = i >> 10, k = i & 1023; const int oc = (c < 8) ? (1536 + c) : (4616 + (c - 8));
                const float w = ka->in[I_WIN][(size_t)l * DM * PIN + (size_t)k * PIN + oc] * ka->in[I_MIXG][(size_t)l * DM + k]; const unsigned hi = f2bf(w);
                W16B[i] = (bf16)hi; W16B[16 * DM + i] = (bf16)f2bf(w - bf2f(hi)); }
            if (l == 0) {
                for (int m = gw; m < BATCH * SEQ; m += NGW) {
                    const f32x4* xr = (const f32x4*)(ka->in[I_X] + (size_t)m * DM) + lane;
                    f32x4 v[4]; float sq = 0.f;
#pragma unroll
                    for (int j = 0; j < 4; ++j) { v[j] = xr[64 * j]; sq += (v[j].x * v[j].x + v[j].y * v[j].y) + (v[j].z * v[j].z + v[j].w * v[j].w); }
                    sq = wave_sum(sq); if (lane < 16) SSQ1[(size_t)m * 16 + lane] = (lane == 0) ? sq : 0.f;
                    u32x2* o8 = (u32x2*)(XG + (size_t)m * DM) + lane;
#pragma unroll
                    for (int j = 0; j < 4; ++j) o8[64 * j] = (u32x2){pk2(v[j].x, v[j].y), pk2(v[j].z, v[j].w)};
                }
            }
            GRID_BAR();
        }

        REPS(PH_INPROJ) if (IN(PH_INPROJ)) {
            PHASE_BEGIN();
            const bf16* XGg = XG + grow0 * DM; const float* ssq = SSQ1 + grow0 * 16;
            if (tid == 0) *(volatile LAS int*)(lds + 143360 + 1024) = -1;
            for (int rb = blk; rb < T / 64; rb += NBLK) {
                const int r0 = rb * 64 + 16 * (wave & 3), kh = (wave >> 2) * 512; f32x4 acc = zero4(), acc2 = zero4();
#pragma unroll 8
                for (int ks = 0; ks < 16; ++ks) { const bf16x8 a = gfrag_kc(XGg, DM, r0, kh + 32 * ks, lane);
                    acc = MFMA16(a, gfrag_kc(W16B, DM, 0, kh + 32 * ks, lane), acc); acc2 = MFMA16(a, gfrag_kc(W16B + 16 * DM, DM, 0, kh + 32 * ks, lane), acc2); }
                acc += acc2;
                LAS f32x4* xch = (LAS f32x4*)lds;
                if (wave >= 4) xch[(wave - 4) * 64 + lane] = acc;
                __syncthreads();
                if (wave < 4) { acc += xch[wave * 64 + lane];
#pragma unroll
                    for (int i = 0; i < 4; ++i) { const int row = r0 + 4 * (lane >> 4) + i; SP[(size_t)row * 16 + (lane & 15)] = acc[i] * row_rstd(ssq + (size_t)row * 16); } }
                __syncthreads();
            }
            pg8::Gemm g{XGg, WinT, DM, DM, DM, 0, 0}; pg8::Order S; S.init(T, PW, NBLK, blk, 1);
            pg8::EpiBf16 E{(LAS float*)(lds + 143360), P, PWS, ssq, P_G / 256, FAC};
            pg8::gemm_phase<pg8::EpiBf16, GEMM_ALIGN>(lds, g, S, E);
            GRID_BAR();
        }

        REPS(PH_M0) if (IN(PH_M0)) {
            PHASE_BEGIN();
            for (int task = gw; task < GB * 4 * NCH; task += NGW) {
                const int bh = task >> 5, c = task & 31, bl = bh >> 2, h = bh & 3;
                const size_t m = (size_t)bl * SEQ + c * 64 + lane;
                const float ig = SP[m * 16 + h] + ka->in[I_AIB][l * 4 + h], fg = SP[m * 16 + 4 + h] + ka->in[I_AFB][l * 4 + h];
                const float b = wscan_add(logsigf_(fg), lane);
                const float gg = ig - b;
                const float pm = wscan_max(gg, lane);
                GBc[m * 4 + h] = b; GGc[m * 4 + h] = gg; GMT[m * 4 + h] = pm;
                if (lane == 63) { SUMB[task] = b; SUMG[task] = pm; }
            }
            for (int task = gw; task < GB * NCH * 8; task += NGW) {
                const int hd = task & 7; const size_t m = (size_t)(task >> 3) * 64 + lane;
                const float dt = softplusf_(SP[m * 16 + 8 + hd] + ka->in[I_CDTB][l * 8 + hd]);
                const float a = wscan_add(-dt * __expf(ka->in[I_CALOG][l * 8 + hd]), lane);
                DTB[m * 8 + hd] = dt; ACB[m * 8 + hd] = a;
            }
            {
                const float* cw = ka->in[I_CCW] + (size_t)l * 4 * 1024; const float* cb = ka->in[I_CCB] + (size_t)l * 1024;
                constexpr int RUN = 16;
                for (int i = gt; i < (T / RUN) * 128; i += NGT) {
                    const int rb = i >> 7, c8 = (i & 127) * 8, m0 = rb * RUN, t0 = m0 & (SEQ - 1);
                    float w[4][8], bb[8];
#pragma unroll
                    for (int e = 0; e < 8; ++e) { bb[e] = cb[c8 + e];
#pragma unroll
                        for (int j = 0; j < 4; ++j) w[j][e] = cw[j * 1024 + c8 + e]; }
                    const u32x4 zz = uzero4(); u32x4 win[4]; win[0] = zz; win[1] = zz; win[2] = zz;
                    if (t0 >= 3) { const bf16* pr = P + (size_t)(m0 - 3) * PWS + P_CX + c8; win[0] = *(const u32x4*)pr; win[1] = *(const u32x4*)(pr + PWS); win[2] = *(const u32x4*)(pr + 2 * PWS); }
#pragma unroll 4
                    for (int rr = 0; rr < RUN; ++rr) {
                        win[3] = *(const u32x4*)(P + (size_t)(m0 + rr) * PWS + P_CX + c8);
                        float acc[8];
#pragma unroll
                        for (int e = 0; e < 8; ++e) acc[e] = bb[e];
#pragma unroll
                        for (int j = 0; j < 4; ++j) {
                            acc[0] += w[j][0] * bf2f(win[j].x & 0xffffu); acc[1] += w[j][1] * bf2f(win[j].x >> 16); acc[2] += w[j][2] * bf2f(win[j].y & 0xffffu); acc[3] += w[j][3] * bf2f(win[j].y >> 16);
                            acc[4] += w[j][4] * bf2f(win[j].z & 0xffffu); acc[5] += w[j][5] * bf2f(win[j].z >> 16); acc[6] += w[j][6] * bf2f(win[j].w & 0xffffu); acc[7] += w[j][7] * bf2f(win[j].w >> 16); }
                        u32x4 o; o.x = pk2(siluf_(acc[0]), siluf_(acc[1])); o.y = pk2(siluf_(acc[2]), siluf_(acc[3])); o.z = pk2(siluf_(acc[4]), siluf_(acc[5])); o.w = pk2(siluf_(acc[6]), siluf_(acc[7]));
                        *(u32x4*)(XBC + (size_t)(m0 + rr) * 1024 + c8) = o;
                        win[0] = win[1]; win[1] = win[2]; win[2] = win[3];
                    }
                }
            }
            {
                const float* bw = ka->in[I_BCW] + (size_t)l * 3 * 512;
                constexpr int RUN = 16;
                for (int i = gt; i < (T / RUN) * 64; i += NGT) {
                    const int rb = i >> 6, c8 = (i & 63) * 8, m0 = rb * RUN, t0 = m0 & (SEQ - 1);
                    float w[3][8];
#pragma unroll
                    for (int e = 0; e < 8; ++e)
#pragma unroll
                        for (int j = 0; j < 3; ++j) w[j][e] = bw[j * 512 + c8 + e];
                    float pw[3][8];
#pragma unroll
                    for (int e = 0; e < 8; ++e) { pw[0][e] = 0.f; pw[1][e] = 0.f; }
                    if (t0 >= 2) {
#pragma unroll
                        for (int j = 0; j < 2; ++j) { const bf16* pr = P + (size_t)(m0 - 2 + j) * PWS; const u32x4 a = *(const u32x4*)(pr + P_BC + c8), b = *(const u32x4*)(pr + P_BX + c8);
                            pw[j][0] = bf2f(a.x & 0xffffu) * bf2f(b.x & 0xffffu); pw[j][1] = bf2f(a.x >> 16) * bf2f(b.x >> 16); pw[j][2] = bf2f(a.y & 0xffffu) * bf2f(b.y & 0xffffu); pw[j][3] = bf2f(a.y >> 16) * bf2f(b.y >> 16);
                            pw[j][4] = bf2f(a.z & 0xffffu) * bf2f(b.z & 0xffffu); pw[j][5] = bf2f(a.z >> 16) * bf2f(b.z >> 16); pw[j][6] = bf2f(a.w & 0xffffu) * bf2f(b.w & 0xffffu); pw[j][7] = bf2f(a.w >> 16) * bf2f(b.w >> 16); } }
#pragma unroll 4
                    for (int rr = 0; rr < RUN; ++rr) {
                        const bf16* pr = P + (size_t)(m0 + rr) * PWS; const u32x4 a = *(const u32x4*)(pr + P_BC + c8), b = *(const u32x4*)(pr + P_BX + c8), g = *(const u32x4*)(pr + P_BB + c8);
                        pw[2][0] = bf2f(a.x & 0xffffu) * bf2f(b.x & 0xffffu); pw[2][1] = bf2f(a.x >> 16) * bf2f(b.x >> 16); pw[2][2] = bf2f(a.y & 0xffffu) * bf2f(b.y & 0xffffu); pw[2][3] = bf2f(a.y >> 16) * bf2f(b.y >> 16);
                        pw[2][4] = bf2f(a.z & 0xffffu) * bf2f(b.z & 0xffffu); pw[2][5] = bf2f(a.z >> 16) * bf2f(b.z >> 16); pw[2][6] = bf2f(a.w & 0xffffu) * bf2f(b.w & 0xffffu); pw[2][7] = bf2f(a.w >> 16) * bf2f(b.w >> 16);
                        float acc[8];
#pragma unroll
                        for (int e = 0; e < 8; ++e) acc[e] = w[0][e] * pw[0][e] + w[1][e] * pw[1][e] + w[2][e] * pw[2][e];
                        u32x4 o; o.x = pk2(acc[0] * bf2f(g.x & 0xffffu), acc[1] * bf2f(g.x >> 16)); o.y = pk2(acc[2] * bf2f(g.y & 0xffffu), acc[3] * bf2f(g.y >> 16));
                        o.z = pk2(acc[4] * bf2f(g.z & 0xffffu), acc[5] * bf2f(g.z >> 16)); o.w = pk2(acc[6] * bf2f(g.w & 0xffffu), acc[7] * bf2f(g.w >> 16));
                        *(u32x4*)(YCAT + (size_t)(m0 + rr) * YW + 512 + c8) = o;
#pragma unroll
                        for (int e = 0; e < 8; ++e) { pw[0][e] = pw[1][e]; pw[1][e] = pw[2][e]; }
                    }
                }
            }
            __syncthreads();
            {
            LAS bf16* Qs = (LAS bf16*)lds; LAS bf16* Ks = Qs + 128 * 136; LAS bf16* Vs = Ks + 64 * 136; LAS bf16* Aw = Vs + 64 * 136 + wave * (16 * 72);
            const int r = lane & 15, g4 = lane >> 4;
            for (int u = blk; u < GB * 4 * 16; u += NBLK) {
                const int bl = u >> 6, h = (u >> 4) & 3, qt = u & 15; const size_t mb = (size_t)bl * SEQ; const int q0 = qt * 128;
                volatile LAS unsigned* FLG = (volatile LAS unsigned*)(lds + MISC_OFF + 128);
                int par = 0;
                __syncthreads();
                if (lane == 0) { FLG[wave] = 0u; FLG[8 + wave] = 0u; }
                for (int i = tid; i < 2048; i += NTHR) { const int s = i >> 4, c8 = i & 15; *(LAS u32x4*)(Qs + s * 136 + c8 * 8) = *(const u32x4*)(P + (mb + q0 + s) * PWS + P_SQ + h * 128 + c8 * 8); }
                f32x4 O[8];
#pragma unroll
                for (int d = 0; d < 8; ++d) O[d] = zero4();
                float racc = 0.f; const int tq = q0 + 16 * wave + r;
                u32x4 kreg[2], vreg[2];
                { const int s0f = (2 * qt + 1) * 64;
#pragma unroll
                  for (int k2 = 0; k2 < 2; ++k2) { const int i = tid + 512 * k2, s = i >> 4, c8 = i & 15; const bf16* pr = P + (mb + s0f + s) * PWS + h * 128 + c8 * 8; kreg[k2] = *(const u32x4*)(pr + P_SK); vreg[k2] = *(const u32x4*)(pr + P_SV); } }
                for (int kt = 2 * qt + 1; kt >= 0; --kt) {
                    const int s0 = kt * 64;
                    __syncthreads();
                    { unsigned alldone = 1u;
#pragma unroll
                      for (int w8 = 0; w8 < 8; ++w8) alldone &= FLG[par * 8 + w8];
                      if (__builtin_amdgcn_readfirstlane((int)alldone)) break; }
#pragma unroll
                    for (int k2 = 0; k2 < 2; ++k2) { const int i = tid + 512 * k2, s = i >> 4, c8 = i & 15; *(LAS u32x4*)(Ks + s * 136 + c8 * 8) = kreg[k2]; *(LAS u32x4*)(Vs + s * 136 + c8 * 8) = vreg[k2]; }
                    if (kt > 0) {
#pragma unroll
                        for (int k2 = 0; k2 < 2; ++k2) { const int i = tid + 512 * k2, s = i >> 4, c8 = i & 15; const bf16* pr = P + (mb + s0 - 64 + s) * PWS + h * 128 + c8 * 8; kreg[k2] = *(const u32x4*)(pr + P_SK); vreg[k2] = *(const u32x4*)(pr + P_SV); } }
                    __syncthreads();
                    if (s0 < q0 + 16 * wave + 15) {
                        f32x4 z[4];
#pragma unroll
                        for (int j = 0; j < 4; ++j) z[j] = zero4();
#pragma unroll
                        for (int ks = 0; ks < 4; ++ks) { const bf16x8 fq = frag_kc(Qs, 136, 16 * wave, 32 * ks, lane);
#pragma unroll
                            for (int j = 0; j < 4; ++j) z[j] = MFMA16(frag_kc(Ks, 136, 16 * j, 32 * ks, lane), fq, z[j]); }
                        float ls[4][4], x[4][4], tsum[4];
#pragma unroll
                        for (int j = 0; j < 4; ++j) { float tj = 0.f;
#pragma unroll
                            for (int i = 0; i < 4; ++i) { const int s = s0 + 16 * j + 4 * g4 + i; const float zz = z[j][i] * 0.08838834764831845f;
                                const float l1 = fminf(zz, 0.f) - __logf(1.f + __expf(-fabsf(zz)));
                                ls[j][i] = l1; x[j][i] = (s < tq) ? (l1 - zz) : 0.f; tj += x[j][i]; }
                            tsum[j] = tj; }
                        float above[4], tot[4];
#pragma unroll
                        for (int j = 0; j < 4; ++j) { const float y1 = __shfl_xor(tsum[j], 16), y2 = __shfl_xor(tsum[j], 32), y3 = __shfl_xor(tsum[j], 48);
                            tot[j] = tsum[j] + y1 + y2 + y3;
                            above[j] = (g4 == 0) ? (y1 + y2 + y3) : (g4 == 1) ? (y2 + y3) : (g4 == 2) ? y1 : 0.f; }
                        float hi = racc;
#pragma unroll
                        for (int j = 3; j >= 0; --j) { float run = hi + above[j]; float av[4];
#pragma unroll
                            for (int i = 3; i >= 0; --i) { const int s = s0 + 16 * j + 4 * g4 + i; av[i] = (s < tq) ? __expf(ls[j][i] + run) : 0.f; run += x[j][i]; }
                            *(LAS u32x2*)(Aw + r * 72 + 16 * j + 4 * g4) = (u32x2){pk2(av[0], av[1]), pk2(av[2], av[3])};
                            hi += tot[j]; }
                        racc = hi;
                        LDS_WAIT(); asm volatile("" ::: "memory");
#pragma unroll
                        for (int ks = 0; ks < 2; ++ks) { const bf16x8 fa = frag_kc(Aw, 72, 0, 32 * ks, lane);
#pragma unroll
                            for (int d = 0; d < 8; ++d) O[d] = MFMA16(fa, frag_ks(Vs, 136, 16 * d, 32 * ks, lane), O[d]); }
                    }
                    par ^= 1;
                    { const bool wd = __all(racc < -104.f); if (lane == 0) FLG[par * 8 + wave] = wd ? 1u : 0u; }
                }
#pragma unroll
                for (int d = 0; d < 8; ++d)
#pragma unroll
                    for (int i = 0; i < 4; ++i) YCAT[(mb + q0 + 16 * wave + 4 * g4 + i) * YW + 1536 + h * 128 + 16 * d + r] = (bf16)f2bf(O[d][i]);
            }
            }
            GRID_BAR();
        }

        REPS(PH_M1) if (IN(PH_M1)) {
            PHASE_BEGIN();
            constexpr int NUA = GB * 4 * NCH, NUC = GB * NCH;
            for (int u = blk; u < NUA + NUC; u += NBLK) {
                if (u < NUA) {
                    const int ua = u, bh = ua >> 5, c = ua & 31, bl = bh >> 2, h = bh & 3; const size_t m0 = (size_t)bl * SEQ + c * 64;
                    LAS bf16* VP = (LAS bf16*)lds; LAS bf16* WK = (LAS bf16*)(lds + 64 * 152 * 2);
                    float bLj = 0.f, gmj = -1e30f;
                    if (lane < 32) { bLj = SUMB[bh * 32 + lane]; gmj = SUMG[bh * 32 + lane]; }
                    float pa = bLj, pq = gmj + bLj;
#pragma unroll
                    for (int o = 1; o < 32; o <<= 1) { const float ta = __shfl_up(pa, o), tq = __shfl_up(pq, o); if (lane >= o) { pq = fmaxf(tq + pa, pq); pa = ta + pa; } }
                    const float mall = fmaxf(pa, pq);
                    const float mnew = __shfl(mall, c), mprev = (c == 0) ? 0.f : __shfl(mall, (c + 63) & 63);
                    const float bL = GBc[(m0 + 63) * 4 + h];
                    if (tid == 0) { MCAR[ua] = mprev; MNEW[ua] = mnew; MSC[ua] = __expf(bL + mprev - mnew); }
                    for (int i = tid; i < 1024; i += NTHR) { const int s = i >> 4, c8 = i & 15; *(LAS u32x4*)(VP + s * 152 + c8 * 8) = *(const u32x4*)(P + (m0 + s) * PWS + P_AV + h * 128 + c8 * 8); }
                    if (tid < 64) { *(LAS u32x4*)(VP + tid * 152 + 128) = uone4(); *(LAS u32x4*)(VP + tid * 152 + 136) = uzero4(); }
                    { const int s = tid >> 3, c8 = tid & 7; const float w = __expf(bL + GGc[(m0 + s) * 4 + h] - mnew);
                      *(LAS u32x4*)(WK + s * 72 + c8 * 8) = scale8(*(const u32x4*)(P + (m0 + s) * PWS + P_AK + h * 64 + c8 * 8), w); }
                    __syncthreads();
                    for (int ti = wave; ti < 36; ti += NWAVES) { const int mt = ti >> 2, nt = ti & 3; f32x4 acc = zero4();
#pragma unroll
                        for (int ks = 0; ks < 2; ++ks) acc = MFMA16(frag_ks(VP, 152, 16 * mt, 32 * ks, lane), frag_ks(WK, 72, 16 * nt, 32 * ks, lane), acc);
                        bf16* d = DC + (size_t)ua * 9216 + (16 * mt + 4 * (lane >> 4)) * 64 + 16 * nt + (lane & 15);
#pragma unroll
                        for (int i = 0; i < 4; ++i) d[i * 64] = (bf16)f2bf(acc[i]); }
                    __syncthreads();
                } else {
                    const int uc = u - NUA, bl = uc >> 5, c = uc & 31, hd = wave, gi = hd >> 2; const size_t m0 = (size_t)bl * SEQ + c * 64;
                    LAS bf16* XW = (LAS bf16*)(lds + hd * (64 * 72 * 2)); LAS bf16* BMs = (LAS bf16*)(lds + 8 * 64 * 72 * 2);
                    const float alast = ACB[(m0 + 63) * 8 + hd];
#pragma unroll
                    for (int k = 0; k < 8; ++k) { const int i = lane + 64 * k, s = i >> 3, c8 = i & 7; const float wd = __expf(alast - ACB[(m0 + s) * 8 + hd]) * DTB[(m0 + s) * 8 + hd];
                        *(LAS u32x4*)(XW + s * 72 + c8 * 8) = scale8(*(const u32x4*)(XBC + (m0 + s) * 1024 + hd * 64 + c8 * 8), wd); }
                    for (int i = tid; i < 2048; i += NTHR) { const int g2 = i >> 10, rem = i & 1023, s = rem >> 4, c8 = rem & 15;
                        *(LAS u32x4*)(BMs + g2 * (64 * 136) + s * 136 + c8 * 8) = *(const u32x4*)(XBC + (m0 + s) * 1024 + 512 + g2 * 128 + c8 * 8); }
                    __syncthreads();
                    const LAS bf16* BMg = BMs + gi * (64 * 136);
                    for (int pt = 0; pt < 4; ++pt) { f32x4 acc[8];
#pragma unroll
                        for (int n = 0; n < 8; ++n) acc[n] = zero4();
#pragma unroll
                        for (int ks = 0; ks < 2; ++ks) { const bf16x8 a = frag_ks(XW, 72, 16 * pt, 32 * ks, lane);
#pragma unroll
                            for (int n = 0; n < 8; ++n) acc[n] = MFMA16(a, frag_ks(BMg, 136, 16 * n, 32 * ks, lane), acc[n]); }
                        bf16* d = DH + ((size_t)(uc * 8 + hd) * 64 + 16 * pt + 4 * (lane >> 4)) * 128 + (lane & 15);
#pragma unroll
                        for (int n = 0; n < 8; ++n)
#pragma unroll
                            for (int i = 0; i < 4; ++i) d[i * 128 + 16 * n] = (bf16)f2bf(acc[n][i]); }
                    __syncthreads();
                }
            }
            GRID_BAR();
        }

        REPS(PH_M2) if (IN(PH_M2)) {
            PHASE_BEGIN();
            constexpr int NA = GB * 4 * 2304, NC = GB * 8 * 2048;
            for (int i = gt; i < NA + NC; i += NGT) {
                f32x4 st = zero4();
                if (i < NA) { const int bh = i / 2304, e = (i - bh * 2304) * 4;
                    for (int c = 0; c < NCH; ++c) { const size_t ua = (size_t)bh * NCH + c;
                        *(u32x2*)(CS + ua * 9216 + e) = (u32x2){pk2(st.x, st.y), pk2(st.z, st.w)};
                        { const u32x2 dw = *(const u32x2*)(DC + ua * 9216 + e); st = st * MSC[ua] + (f32x4){bf2f(dw.x & 0xffffu), bf2f(dw.x >> 16), bf2f(dw.y & 0xffffu), bf2f(dw.y >> 16)}; } }
                } else { const int j = i - NA, bhd = j >> 11, e = (j & 2047) * 4, bl = bhd >> 3, hd = bhd & 7;
                    for (int c = 0; c < NCH; ++c) { const size_t uh = (size_t)(bl * NCH + c) * 8 + hd;
                        *(u32x2*)(HS + uh * 8192 + e) = (u32x2){pk2(st.x, st.y), pk2(st.z, st.w)};
                        { const u32x2 dw = *(const u32x2*)(DH + uh * 8192 + e); st = st * __expf(ACB[((size_t)bl * SEQ + c * 64 + 63) * 8 + hd]) + (f32x4){bf2f(dw.x & 0xffffu), bf2f(dw.x >> 16), bf2f(dw.y & 0xffffu), bf2f(dw.y >> 16)}; } }
                }
            }
            GRID_BAR();
        }

        REPS(PH_M3) if (IN(PH_M3)) {
            PHASE_BEGIN();
            constexpr int NUA = GB * 4 * NCH, NUC = 2 * GB * NCH;
            for (int u = blk; u < NUA + NUC; u += NBLK) {
                const int r = lane & 15, g4 = lane >> 4;
                if (u < NUA) {
                    const int ua = u, bh = ua >> 5, c = ua & 31, bl = bh >> 2, h = bh & 3; const size_t m0 = (size_t)bl * SEQ + c * 64;
                    LAS bf16* Qs = (LAS bf16*)lds; LAS bf16* Ks = Qs + 64 * 72; LAS bf16* VP = Ks + 64 * 72; LAS bf16* CST = VP + 64 * 152; LAS bf16* SMT = CST + 144 * 72; LAS bf16* AOT = SMT + 64 * 72;
                    LAS float* GS = (LAS float*)(AOT + 64 * 136);
                    LAS float* SSQ = GS + 256;
                    const float mcar = MCAR[ua];
                    { const int s = tid >> 3, c8 = tid & 7; const bf16* pr = P + (m0 + s) * PWS + h * 64 + c8 * 8;
                      *(LAS u32x4*)(Qs + s * 72 + c8 * 8) = *(const u32x4*)(pr + P_AQ); *(LAS u32x4*)(Ks + s * 72 + c8 * 8) = *(const u32x4*)(pr + P_AK); }
                    for (int i = tid; i < 1024; i += NTHR) { const int s = i >> 4, c8 = i & 15; const bf16* pr = P + (m0 + s) * PWS + h * 128 + c8 * 8;
                        *(LAS u32x4*)(VP + s * 152 + c8 * 8) = *(const u32x4*)(pr + P_AV); *(LAS u32x4*)(AOT + s * 136 + c8 * 8) = *(const u32x4*)(pr + P_AO); }
                    if (tid < 64) { *(LAS u32x4*)(VP + tid * 152 + 128) = uone4(); *(LAS u32x4*)(VP + tid * 152 + 136) = uzero4(); }
                    for (int i = tid; i < 1152; i += NTHR) { const int dv = i >> 3, c8 = i & 7; *(LAS u32x4*)(CST + dv * 72 + c8 * 8) = *(const u32x4*)(CS + (size_t)ua * 9216 + dv * 64 + c8 * 8); }
                    if (tid < 192) { const int arr = tid >> 6, s = tid & 63; const float* src = (arr == 0) ? GBc : (arr == 1) ? GGc : GMT; float v = src[(m0 + s) * 4 + h];
                        if (arr == 2) v = GBc[(m0 + s) * 4 + h] + fmaxf(mcar, v);
                        GS[arr * 64 + s] = v; }
                    __syncthreads();
#pragma unroll
                    for (int q2 = 0; q2 < 2; ++q2) { const int ti = 2 * wave + q2, tt = ti >> 2, st = ti & 3;
                        f32x4 acc = zero4();
                        if (st <= tt) {
#pragma unroll
                            for (int ks = 0; ks < 2; ++ks) acc = MFMA16(frag_kc(Qs, 72, 16 * tt, 32 * ks, lane), frag_kc(Ks, 72, 16 * st, 32 * ks, lane), acc);
                            const int s = 16 * st + r; const float gs = GS[64 + s];
#pragma unroll
                            for (int i = 0; i < 4; ++i) { const int t = 16 * tt + 4 * g4 + i; const float e = GS[t] - GS[128 + t] + gs;
                                acc[i] = (s <= t) ? acc[i] * 0.125f * __expf(e) : 0.f; }
                        }
                        *(LAS u32x2*)(SMT + (16 * st + r) * 72 + 16 * tt + 4 * g4) = (u32x2){pk2(acc[0], acc[1]), pk2(acc[2], acc[3])}; }
                    __syncthreads();
                    const int tt = wave & 3, half = wave >> 2;
                    f32x4 a1[5], a2[5];
#pragma unroll
                    for (int j = 0; j < 5; ++j) { a1[j] = zero4(); a2[j] = zero4(); }
#pragma unroll
                    for (int ks = 0; ks < 2; ++ks) { const bf16x8 fa1 = frag_ks(SMT, 72, 16 * tt, 32 * ks, lane), fa2 = frag_kc(Qs, 72, 16 * tt, 32 * ks, lane);
#pragma unroll
                        for (int j = 0; j < 5; ++j) { const int dvt = (j < 4) ? half * 4 + j : 8;
                            a1[j] = MFMA16(fa1, frag_ks(VP, 152, 16 * dvt, 32 * ks, lane), a1[j]);
                            a2[j] = MFMA16(fa2, frag_kc(CST, 72, 16 * dvt, 32 * ks, lane), a2[j]); } }
                    float hv[4][4], ssq[4];
#pragma unroll
                    for (int i = 0; i < 4; ++i) { const int t = 16 * tt + 4 * g4 + i; const float b = GS[t], mt = GS[128 + t];
                        const float is = 0.125f * __expf(b + mcar - mt);
                        float den = a1[4][i] + is * a2[4][i]; den = __shfl(den, lane & 48);
                        const float dn = __builtin_amdgcn_rcpf(fmaxf(fabsf(den), __expf(-mt))); float q = 0.f;
#pragma unroll
                        for (int j = 0; j < 4; ++j) { const float v = (a1[j][i] + is * a2[j][i]) * dn; hv[j][i] = v; q += v * v; }
                        q += __shfl_xor(q, 1); q += __shfl_xor(q, 2); q += __shfl_xor(q, 4); q += __shfl_xor(q, 8); ssq[i] = q; }
                    if (r == 0) {
#pragma unroll
                        for (int i = 0; i < 4; ++i) SSQ[half * 64 + 16 * tt + 4 * g4 + i] = ssq[i]; }
                    __syncthreads();
                    const float* ng = ka->in[I_ANG] + (size_t)l * 512 + h * 128;
#pragma unroll
                    for (int i = 0; i < 4; ++i) { const int t = 16 * tt + 4 * g4 + i; const float rstd = rsqrtf((SSQ[t] + SSQ[64 + t]) * (1.f / 128.f) + EPS);
#pragma unroll
                        for (int j = 0; j < 4; ++j) { const int dv = 16 * (half * 4 + j) + r; LAS bf16* op = AOT + t * 136 + dv;
                            *op = (bf16)f2bf(sigmoidf_(bf2f(*op)) * hv[j][i] * rstd * ng[dv]); } }
                    __syncthreads();
                    for (int i = tid; i < 1024; i += NTHR) { const int s = i >> 4, c8 = i & 15; *(u32x4*)(YCAT + (m0 + s) * YW + h * 128 + c8 * 8) = *(const LAS u32x4*)(AOT + s * 136 + c8 * 8); }
                    __syncthreads();
                } else {
                    const int uc2 = u - NUA, bl = uc2 >> 6, c = (uc2 >> 1) & 31, gi = uc2 & 1, hl = wave & 3, th = wave >> 2, hd = gi * 4 + hl; const size_t m0 = (size_t)bl * SEQ + c * 64;
                    LAS bf16* XHs = (LAS bf16*)lds;
                    LAS bf16* HTs = (LAS bf16*)(lds + 36864);
                    LAS bf16* BMg = (LAS bf16*)(lds + 36864 + 69632);
                    LAS bf16* MTt = (LAS bf16*)(lds + 36864 + 69632 + 17408 + wave * 3072);
                    LAS float* ADs = (LAS float*)(lds + 36864 + 69632 + 17408 + 24576);
                    const bf16* Xb = XBC + m0 * 1024;
                    for (int i = tid; i < 2048; i += NTHR) { const int h4 = i >> 9, rem = i & 511, s = rem >> 3, c8 = rem & 7;
                        *(LAS u32x4*)(XHs + h4 * (64 * 72) + s * 72 + c8 * 8) = *(const u32x4*)((Xb + gi * 256) + (unsigned)(s * 1024 + h4 * 64 + c8 * 8)); }
                    { const bf16* Hb = HS + (size_t)((bl * NCH + c) * 8 + gi * 4) * 8192;
                      for (int i = tid; i < 4096; i += NTHR) { const int h4 = i >> 10, rem = i & 1023, p = rem >> 4, c8 = rem & 15;
                        *(LAS u32x4*)(HTs + h4 * (64 * 136) + p * 136 + c8 * 8) = *(const u32x4*)(Hb + (unsigned)(h4 * 8192 + p * 128 + c8 * 8)); } }
                    for (int i = tid; i < 1024; i += NTHR) { const int s = i >> 4, c8 = i & 15; *(LAS u32x4*)(BMg + s * 136 + c8 * 8) = *(const u32x4*)((Xb + 512 + gi * 128) + (unsigned)(s * 1024 + c8 * 8)); }
                    { const int h4 = tid >> 7, arr = (tid >> 6) & 1, s = tid & 63; const float* src = arr ? DTB : ACB; ADs[tid] = (src + m0 * 8 + gi * 4)[(unsigned)(s * 8 + h4)]; }
                    const LAS bf16* XH = XHs + hl * (64 * 72); const LAS bf16* HT = HTs + hl * (64 * 136); const LAS float* AD = ADs + hl * 128;
                    const bf16* Cm = Xb + 768 + gi * 128; const bf16* Zp = P + m0 * PWS + P_CZ + hd * 64; const unsigned zlane = (unsigned)(4 * g4 * PWS + r), ylane = (unsigned)(4 * g4 * YW + r);
                    bf16* Yp = YCAT + m0 * YW + 1024 + hd * 64; float* Sp = SSQC + m0 * 8 + hd;
                    bf16x8 fcn[4];
#pragma unroll
                    for (int ks = 0; ks < 4; ++ks) fcn[ks] = gfrag_kc(Cm, 1024, 16 * th, 32 * ks, lane);
                    const float dsk = ka->in[I_CDSKIP][l * 8 + hd];
                    __syncthreads();
#pragma unroll 1
                    for (int k2 = 0; k2 < 2; ++k2) { const int tt = k2 ? 3 - th : th;
                        bf16x8 fcm[4]; unsigned short zc[4][4];
#pragma unroll
                        for (int ks = 0; ks < 4; ++ks) fcm[ks] = fcn[ks];
#pragma unroll
                        for (int p = 0; p < 4; ++p)
#pragma unroll
                            for (int i = 0; i < 4; ++i) zc[p][i] = (Zp + (size_t)(16 * tt + i) * PWS + 16 * p)[zlane];
#pragma unroll
                        for (int ks = 0; ks < 4; ++ks) fcn[ks] = gfrag_kc(Cm, 1024, 16 * (3 - th), 32 * ks, lane);
                        float at[4];
#pragma unroll
                        for (int i = 0; i < 4; ++i) at[i] = AD[16 * tt + 4 * g4 + i];
#pragma unroll 1
                        for (int st = 0; st <= tt; ++st) { f32x4 acc = zero4();
#pragma unroll
                            for (int ks = 0; ks < 4; ++ks) acc = MFMA16(fcm[ks], frag_kc(BMg, 136, 16 * st, 32 * ks, lane), acc);
                            const int s = 16 * st + r; const float as = AD[s], dts = AD[64 + s];
#pragma unroll
                            for (int i = 0; i < 4; ++i) { const int t = 16 * tt + 4 * g4 + i; acc[i] = (s <= t) ? acc[i] * __expf(at[i] - as) * dts : 0.f; if (s == t) acc[i] += dsk; }
                            *(LAS u32x2*)(MTt + (16 * st + r) * 24 + 4 * g4) = (u32x2){pk2(acc[0], acc[1]), pk2(acc[2], acc[3])}; }
                        if ((tt & 1) == 0) *(LAS u32x2*)(MTt + (16 * (tt + 1) + r) * 24 + 4 * g4) = (u32x2){uzero4().x, uzero4().y};
                        LDS_WAIT(); asm volatile("" ::: "memory");
                        f32x4 ad[4], ao[4];
#pragma unroll
                        for (int p = 0; p < 4; ++p) { ad[p] = zero4(); ao[p] = zero4(); }
#pragma unroll 1
                        for (int ks = 0; ks <= (tt >> 1); ++ks) { const bf16x8 fa = frag_ks(MTt, 24, 0, 32 * ks, lane);
#pragma unroll
                            for (int p = 0; p < 4; ++p) ad[p] = MFMA16(fa, frag_ks(XH, 72, 16 * p, 32 * ks, lane), ad[p]); }
#pragma unroll
                        for (int ks = 0; ks < 4; ++ks)
#pragma unroll
                            for (int p = 0; p < 4; ++p) ao[p] = MFMA16(fcm[ks], frag_kc(HT, 136, 16 * p, 32 * ks, lane), ao[p]);
#pragma unroll
                        for (int i = 0; i < 4; ++i) { const float ea = __expf(at[i]); float q = 0.f;
#pragma unroll
                            for (int p = 0; p < 4; ++p) { const float y = (ad[p][i] + ea * ao[p][i]) * siluf_(bf2f(zc[p][i])); q += y * y;
                                (Yp + (size_t)(16 * tt + i) * YW + 16 * p)[ylane] = (bf16)f2bf(y); }
                            q += __shfl_xor(q, 1); q += __shfl_xor(q, 2); q += __shfl_xor(q, 4); q += __shfl_xor(q, 8);
                            if (r == 0) (Sp + (16 * tt + i) * 8)[(unsigned)(32 * g4)] = q; }
                        LDS_WAIT(); asm volatile("" ::: "memory");
                    }
                    __syncthreads();
                }
            }
            GRID_BAR();
        }

        REPS(PH_LIFT) if (IN(PH_LIFT)) {
            PHASE_BEGIN();
            pg8::Gemm g{YCAT, WliftT, 512, YW, 512, (size_t)512 * 2, (size_t)DM * 512 * 2}; pg8::Order S; S.init(T, DM, NBLK, blk, 4);
            pg8::EpiLift E{FAC, MB + (size_t)(grp & 1) * T * DM, DM, SSQC};
            pg8::gemm_phase<pg8::EpiLift, GEMM_ALIGN>(lds, g, S, E);
            GRID_BAR();
        }
        REPS(PH_OUT) if (IN(PH_OUT) && (grp & 1)) {
            PHASE_BEGIN();
            const size_t prow0 = grow0 - T;
            pg8::Gemm g{MB, WoutT, DM, DM, DM, 0, 0}; pg8::Order S; S.init(2 * T, DM, NBLK, blk, 1);
            pg8::EpiResid E{XG + prow0 * DM, DM, SSQ2};
            pg8::gemm_phase<pg8::EpiResid, GEMM_ALIGN>(lds, g, S, E);
            GRID_BAR();
        }
        REPS(PH_UP) if (IN(PH_UP) && (grp & 1)) {
            PHASE_BEGIN();
            const size_t prow0 = grow0 - T;
            pg8::Gemm g{XG + prow0 * DM, WupT, DM, DM, DM, 0, 0}; pg8::Order S; S.init(2 * T, DFF2, NBLK, blk, 1);
            if (tid == 0) *(volatile LAS int*)(lds + 131072 + 12288 + 1024) = -1;
            pg8::EpiConvAct E{ACT, SSQ2, ka->in[I_FCW] + (size_t)l * 3 * DFF2, ka->in[I_FCB] + (size_t)l * DFF2, RAWH, lds + 131072, DFF2 / 256};
            pg8::gemm_phase<pg8::EpiConvAct, GEMM_ALIGN>(lds, g, S, E);
            GRID_BAR();
        }
        REPS(PH_DOWN) if (IN(PH_DOWN) && (grp & 1)) {
            PHASE_BEGIN();
            const size_t prow0 = grow0 - T;
            pg8::Gemm g{ACT, WdownT, DFF, DFF, DFF, 0, 0}; pg8::Order S; S.init(2 * T, DM, NBLK, blk, 1);
            {
                const float* fw = ka->in[I_FCW] + (size_t)l * 3 * DFF2; const float* fb = ka->in[I_FCB] + (size_t)l * DFF2;
                pg8::Unit uu;
                for (int i = 0; S.next(i, uu); ++i) { const int pm = uu.pm; if ((pm & 7) == 0) continue;
                    for (int ch = tid; ch < DFF; ch += NTHR) { const int tp = ch >> 7, j = ch & 127;
                        const float* own = RAWH + (size_t)(pm * 22 + tp) * 1024; const float* prv = RAWH + (size_t)((pm - 1) * 22 + tp) * 1024;
                        const float g254 = prv[2 * 256 + j], g255 = prv[3 * 256 + j], g0 = own[j], g1 = own[256 + j];
                        const float u254 = prv[2 * 256 + 128 + j], u255 = prv[3 * 256 + 128 + j], u0 = own[128 + j], u1 = own[256 + 128 + j];
                        const float wg0 = fw[ch], wg1 = fw[DFF2 + ch], wg2 = fw[2 * DFF2 + ch], wu0 = fw[DFF + ch], wu1 = fw[DFF2 + DFF + ch], wu2 = fw[2 * DFF2 + DFF + ch], bg = fb[ch], bu = fb[DFF + ch];
                        ACT[(size_t)(pm * 256) * DFF + ch] = (bf16)f2bf(siluf_(bg + wg0 * g254 + wg1 * g255 + wg2 * g0) * (bu + wu0 * u254 + wu1 * u255 + wu2 * u0));
                        ACT[(size_t)(pm * 256 + 1) * DFF + ch] = (bf16)f2bf(siluf_(bg + wg0 * g255 + wg1 * g0 + wg2 * g1) * (bu + wu0 * u255 + wu1 * u0 + wu2 * u1)); } }
                asm volatile("s_waitcnt vmcnt(0)" ::: "memory"); __syncthreads();
            }
            pg8::EpiResid E{XG + prow0 * DM, DM, SSQ1 + prow0 * 16};
            pg8::gemm_phase<pg8::EpiResid, GEMM_ALIGN>(lds, g, S, E);
            GRID_BAR();
        }
        REPS(PH_FINAL) if (IN(PH_FINAL) && l == DEPTH - 1 && (grp & 1)) {
            PHASE_BEGIN();
            const size_t prow0 = grow0 - T;
            const float* gain = ka->in[I_FING];
            f32x4 gv[4];
#pragma unroll
            for (int j = 0; j < 4; ++j) gv[j] = ((const f32x4*)gain)[lane + 64 * j];
            for (int m = gw; m < 2 * T; m += NGW) {
                const u32x2* xr = (const u32x2*)(XG + (prow0 + m) * DM) + lane;
                f32x4 v[4]; float sq = 0.f;
#pragma unroll
                for (int j = 0; j < 4; ++j) { const u32x2 w = xr[64 * j]; v[j] = (f32x4){bf2f(w.x & 0xffffu), bf2f(w.x >> 16), bf2f(w.y & 0xffffu), bf2f(w.y >> 16)};
                    sq += (v[j].x * v[j].x + v[j].y * v[j].y) + (v[j].z * v[j].z + v[j].w * v[j].w); }
                const float rstd = rsqrtf(wave_sum(sq) * (1.f / DM) + EPS);
                f32x4* orow = (f32x4*)(ka->out + (prow0 + m) * DM) + lane;
#pragma unroll
                for (int j = 0; j < 4; ++j) orow[64 * j] = v[j] * rstd * gv[j];
            }
            GRID_BAR();
        }
    }
#undef IN
#undef GRID_BAR
#undef PHASE_BEGIN
}

#ifndef ONE_LAUNCH
#define ONE_LAUNCH 1
#endif
extern "C" void kernel_launch(void* const* d_in, const int* in_sizes, int n_in, void* d_out, int out_size, void* d_ws, size_t ws_size, hipStream_t stream) {
    static int grid = 0;
    if (grid == 0) {
        if (n_in != N_IN || in_sizes[0] != BATCH * SEQ * DM || out_size != BATCH * SEQ * DM || ws_size < WS_END) {
            fprintf(stderr, "kernel_launch: unexpected shapes / workspace (n_in %d, ws %zu, need %zu); nothing launched\n", n_in, ws_size, (size_t)WS_END); grid = -1; return; }
        int dev = 0, cus = 0, per_cu = 0;
        if (hipGetDevice(&dev) != hipSuccess || hipDeviceGetAttribute(&cus, hipDeviceAttributeMultiprocessorCount, dev) != hipSuccess) { grid = -1; return; }
        if (hipFuncSetAttribute((const void*)fwd, hipFuncAttributeMaxDynamicSharedMemorySize, LDS_BYTES) != hipSuccess) { fprintf(stderr, "kernel_launch: hipFuncSetAttribute failed\n"); grid = -1; return; }
        if (hipOccupancyMaxActiveBlocksPerMultiprocessor(&per_cu, (const void*)fwd, NTHR, LDS_BYTES) != hipSuccess || per_cu < 1) { fprintf(stderr, "kernel_launch: occupancy query says %d\n", per_cu); (void)hipGetLastError(); }
        grid = cus;
    }
    if (grid < 0) return;
    (void)hipMemsetAsync((char*)d_ws + WS_CTL, 0, CTL_BYTES, stream);
    Args a{};
    for (int i = 0; i < N_IN; ++i) a.in[i] = (const float*)d_in[i];
    a.out = (float*)d_out; a.ws = (unsigned char*)d_ws; a.pad = 0;
#if ONE_LAUNCH
    a.l_lo = 0; a.l_hi = DEPTH; a.g_lo = 0; a.g_hi = NG; a.ph_lo = 0; a.ph_hi = PH_COUNT; a.use_bar = 1;
    hipLaunchKernelGGL(fwd, dim3(grid), dim3(NTHR), LDS_BYTES, stream, a);
#else
    a.use_bar = 0;
    for (int l = 0; l < DEPTH; ++l)
        for (int g = 0; g < NG; ++g)
            for (int ph = 0; ph < PH_COUNT; ++ph) {
                if (ph == PH_W && g != 0) continue;
                if (ph == PH_FINAL && l != DEPTH - 1) continue;
                if ((ph == PH_OUT || ph == PH_UP || ph == PH_DOWN || ph == PH_FINAL) && !(g & 1)) continue;
                a.l_lo = l; a.l_hi = l + 1; a.g_lo = g; a.g_hi = g + 1; a.ph_lo = ph; a.ph_hi = ph + 1;
                hipLaunchKernelGGL(fwd, dim3(grid), dim3(NTHR), LDS_BYTES, stream, a);
            }
#endif
}
```

```cpp
#include <hip/hip_runtime.h>
#include <cstdio>
#include <cstdint>

#define LAS __attribute__((address_space(3)))
#define GAS __attribute__((address_space(1)))
typedef unsigned short bf16;
typedef short bf16x8 __attribute__((ext_vector_type(8)));
typedef short s16x4 __attribute__((ext_vector_type(4)));
typedef float f32x4 __attribute__((ext_vector_type(4)));
typedef float f32x2 __attribute__((ext_vector_type(2)));
typedef unsigned u32x4 __attribute__((ext_vector_type(4)));
typedef unsigned u32x2 __attribute__((ext_vector_type(2)));

constexpr int DM = 1024, BATCH = 32, SEQ = 2048, DEPTH = 4;
constexpr int PIN = 10256, PW = 10240, PWS = 6144, DFF = 2816, DFF2 = 5632;
constexpr int GB = 8;
constexpr int NG = BATCH / GB;
constexpr int T = GB * SEQ;
constexpr int NCH = SEQ / 64;
constexpr float EPS = 1e-6f;
constexpr int P_AQ = 0, P_AK = 256, P_AV = 512, P_AO = 1024, P_BB = 1536, P_BC = 2048, P_BX = 2560, P_CZ = 3072, P_CX = 3584, P_SQ = 4608, P_SK = 5120, P_SV = 5632, P_G = 6144;
constexpr int YW = 2048;

constexpr size_t MiB = 1u << 20;
constexpr size_t WS_CTL = 0, CTL_BYTES = 1 * MiB;
constexpr size_t WS_WIN = 1 * MiB;
constexpr size_t WS_WLIFT = WS_WIN + (size_t)PW * DM * 2;
constexpr size_t WS_WOUT = WS_WLIFT + (size_t)4 * DM * 512 * 2;
constexpr size_t WS_WUP = WS_WOUT + (size_t)DM * DM * 2;
constexpr size_t WS_WDOWN = WS_WUP + (size_t)DFF2 * DM * 2;
constexpr size_t WS_W16 = WS_WDOWN + (size_t)DM * DFF * 2;
constexpr size_t WS_XN = WS_W16 + 65536;
constexpr size_t WS_P = WS_XN + (size_t)T * DM * 2;
constexpr size_t WS_U = WS_P, WS_ACT = WS_P;
constexpr size_t WS_YCAT = WS_P + (size_t)T * PW * 2;
constexpr size_t WS_XG = WS_YCAT + (size_t)T * YW * 2;
constexpr size_t WS_MB = WS_XG + (size_t)BATCH * SEQ * DM * 2;
constexpr size_t WS_SP = WS_MB + (size_t)2 * T * DM * 2;
constexpr size_t WS_GB = WS_SP + (size_t)T * 16 * 4;
constexpr size_t WS_GG = WS_GB + (size_t)T * 16;
constexpr size_t WS_GMT = WS_GG + (size_t)T * 16;
constexpr size_t WS_MCAR = WS_GMT + (size_t)T * 16;
constexpr size_t WS_MNEW = WS_MCAR + 4096;
constexpr size_t WS_MSC = WS_MNEW + 4096;
constexpr size_t WS_SUMB = WS_MSC + 4096, WS_SUMG = WS_SUMB + 4096;
constexpr size_t WS_DT = WS_SUMG + 4096;
constexpr size_t WS_AC = WS_DT + (size_t)T * 32;
constexpr size_t WS_XBC = WS_AC + (size_t)T * 32;
constexpr size_t WS_DC = WS_XBC + (size_t)T * DM * 2;
constexpr size_t WS_CS = WS_DC + (size_t)GB * 4 * NCH * 9216 * 4;
constexpr size_t WS_DH = WS_CS + (size_t)GB * 4 * NCH * 9216 * 2;
constexpr size_t WS_HS = WS_DH + (size_t)GB * NCH * 8 * 8192 * 4;
constexpr size_t WS_SSQ1 = WS_HS + (size_t)GB * NCH * 8 * 8192 * 2;
constexpr size_t WS_SSQ2 = WS_SSQ1 + (size_t)BATCH * SEQ * 64;
constexpr size_t WS_SSQC = WS_SSQ2 + (size_t)2 * T * 64;
constexpr size_t WS_RAWH = WS_SSQC + (size_t)T * 32;
constexpr size_t WS_END = WS_RAWH + (size_t)(2 * T / 256) * 22 * 4 * 256 * 4;

constexpr int NWAVES = 8, NTHR = 512;
constexpr int LDS_BYTES = 155648;
constexpr int MISC_OFF = 153600;

__device__ __forceinline__ float bf2f(unsigned b) { return __uint_as_float(b << 16); }
__device__ __forceinline__ unsigned f2bf(float f) { unsigned u = __float_as_uint(f); return (u + 0x7fffu + ((u >> 16) & 1u)) >> 16; }
__device__ __forceinline__ unsigned pk2(float lo, float hi) { return f2bf(lo) | (f2bf(hi) << 16); }
__device__ __forceinline__ float sigmoidf_(float x) { return __builtin_amdgcn_rcpf(1.f + __builtin_amdgcn_exp2f(-1.4426950408889634f * x)); }
__device__ __forceinline__ float siluf_(float x) { return x * __builtin_amdgcn_rcpf(1.f + __builtin_amdgcn_exp2f(-1.4426950408889634f * x)); }
__device__ __forceinline__ float logsigf_(float x) { return fminf(x, 0.f) - log1pf(expf(-fabsf(x))); }
__device__ __forceinline__ float softplusf_(float x) { return fmaxf(x, 0.f) + log1pf(expf(-fabsf(x))); }
__device__ __forceinline__ float wave_sum(float v) {
#pragma unroll
    for (int o = 1; o < 64; o <<= 1) v += __shfl_xor(v, o);
    return v;
}
#define LDS_WAIT() asm volatile("s_waitcnt lgkmcnt(0)" ::: "memory")
__device__ __forceinline__ float row_rstd(const float* ssq16) {
    const f32x4* p = (const f32x4*)ssq16; const f32x4 a = (p[0] + p[1]) + (p[2] + p[3]);
    return rsqrtf(((a.x + a.y) + (a.z + a.w)) * (1.f / 1024.f) + 1e-6f);
}

namespace pg8 {
constexpr int BM = 256, BK = 64, HALF = 128, HTB = HALF * BK * 2, STAGE_BYTES = 8 * HTB, NXCD = 8, WGM = 4;
__host__ __device__ __forceinline__ int lds_byte(int r, int c) { const int st = (r >> 4) * 2 + (c >> 5), rr = r & 15, cc = c & 31, ob = rr * 64 + cc * 2; return st * 1024 + (ob ^ (((ob >> 9) & 1) << 5)); }
__host__ __device__ __forceinline__ void stage_rc(int b, int& R, int& C) { const int st = b / 1024, sb = b % 1024, swz = sb ^ (((sb >> 9) & 1) << 5); R = (st >> 1) * 16 + swz / 64; C = (st & 1) * 32 + (swz % 64) / 2; }
__host__ __device__ __forceinline__ int perm32(int rho) { const int n = rho >> 4, i = rho & 15; return 8 * (i >> 2) + 4 * n + (i & 3); }

struct Unit { int pm, pn, z; };
struct Gemm { const bf16* A; const bf16* Bt; int K, lda, ldb; size_t zA, zB; size_t ablk = 256, atile = 0; };

struct Order {
    int nM, nN, nwg, G, c, Z;
    __device__ __forceinline__ void init(int M, int N, int G_, int c_, int Z_) { nM = M / BM; nN = N / BM; nwg = nM * nN; G = G_; c = c_; Z = Z_; }
    __device__ __forceinline__ bool next(int i, Unit& u) const {
        const int ti = i / Z; u.z = i - ti * Z;
        const long L = (long)ti * G + c; if (L >= nwg) return false;
        int wgid = (int)L; { const int q = nwg / NXCD, r = nwg % NXCD, xcd = wgid % NXCD, off = wgid / NXCD; wgid = (xcd < r ? xcd * (q + 1) : r * (q + 1) + (xcd - r) * q) + off; }
        const int nig = WGM * nN, gid = wgid / nig, fm = gid * WGM, gsz = (nM - fm) < WGM ? (nM - fm) : WGM;
        u.pm = fm + ((wgid % nig) % gsz); u.pn = (wgid % nig) / gsz; return true;
    }
};
__device__ __forceinline__ unsigned cvt_pk_bf16(float lo, float hi) { unsigned r; asm volatile("s_nop 0\n\tv_cvt_pk_bf16_f32 %0, %1, %2" : "=v"(r) : "v"(lo), "v"(hi)); return r; }

__device__ __forceinline__ void panel_rstd(LAS float* rsl, const float* ssq, int pm, int wr, int wc, int fr, int fq) {
    volatile LAS int* tag = (volatile LAS int*)(rsl + 256);
    if (__builtin_amdgcn_readfirstlane(*tag) != pm) {
        const int tidl = (wr * 4 + wc) * 64 + fq * 16 + fr, rr = tidl >> 1, hf = tidl & 1;
        const f32x4* p = (const f32x4*)(ssq + (size_t)(pm * BM + rr) * 16 + hf * 8); const f32x4 a = p[0] + p[1];
        float sq = (a.x + a.y) + (a.z + a.w); sq += __shfl_xor(sq, 1);
        __builtin_amdgcn_s_barrier();
        if (hf == 0) rsl[rr] = rsqrtf(sq * (1.f / 1024.f) + 1e-6f);
        if (tidl == 0) *tag = pm;
        asm volatile("s_waitcnt lgkmcnt(0)" ::: "memory"); __builtin_amdgcn_s_barrier(); asm volatile("" ::: "memory");
    }
}
struct EpiBf16 {
    static constexpr bool PERM = true, KEEP = false, CONTIG = true;
    LAS float* rsl;
    bf16* O; int ldc; const float* ssq; int gate_pn0; bf16* fac;
    static __device__ __forceinline__ float s1(float x) { return 1.f + __builtin_amdgcn_exp2f(-1.4426950408889634f * __builtin_amdgcn_fmed3f(x, -30.f, 30.f)); }
    __device__ __forceinline__ void operator()(f32x4 (&acc)[2][2][4][2], const Unit& u, int wr, int wc, int fr, int fq) const {
        panel_rstd(rsl, ssq, u.pm, wr, wc, fr, fq);
        if (u.pn >= gate_pn0) {
            const int row0g = u.pm * BM + wr * 64 + fr, d0 = 64 * (u.pn - gate_pn0) + 16 * wc + 4 * fq;
#pragma unroll
            for (int ai = 0; ai < 2; ++ai)
#pragma unroll
                for (int m = 0; m < 4; ++m) {
                    const float rs = rsl[wr * 64 + fr + ai * HALF + m * 16];
                    const int cc = d0 & 255, pnL = d0 >> 8, bjL = cc >> 7, wcL = (cc >> 5) & 3, fqL = (cc >> 3) & 3, nL = (cc >> 2) & 1;
                    bf16* rowp = fac + ((((((size_t)(u.pm * 4 + pnL) * 4) * 16 + (ai * 4 + m) * 2 + bjL) * 8 + (wr * 4 + wcL)) * 64 + fqL * 16 + fr) * 8 + nL * 4);
                    const size_t zstep = (size_t)16 * 8 * 512;
                    float one = 1.f; asm volatile("" : "+v"(one));
                    float f0[4], f1[4], f2[4], f3[4];
#pragma unroll
                    for (int e = 0; e < 4; ++e) { const float a0 = s1(acc[ai][0][m][0][e] * rs), a1 = s1(acc[ai][0][m][1][e] * rs), a2 = s1(acc[ai][1][m][0][e] * rs), a3 = s1(acc[ai][1][m][1][e] * rs);
                        f0[e] = a1 * __builtin_amdgcn_rcpf(a0); f1[e] = a2 * __builtin_amdgcn_rcpf(a1); f2[e] = a3 * __builtin_amdgcn_rcpf(a2); f3[e] = one * __builtin_amdgcn_rcpf(a3); }
                    *(u32x2*)(rowp) = (u32x2){cvt_pk_bf16(f0[0], f0[1]), cvt_pk_bf16(f0[2], f0[3])};
                    *(u32x2*)(rowp + zstep) = (u32x2){cvt_pk_bf16(f1[0], f1[1]), cvt_pk_bf16(f1[2], f1[3])};
                    *(u32x2*)(rowp + 2 * zstep) = (u32x2){cvt_pk_bf16(f2[0], f2[1]), cvt_pk_bf16(f2[2], f2[3])};
                    *(u32x2*)(rowp + 3 * zstep) = (u32x2){cvt_pk_bf16(f3[0], f3[1]), cvt_pk_bf16(f3[2], f3[3])}; }
            return; }
        const int row0 = u.pm * BM + wr * 64 + fr, col0 = u.pn * BM + wc * 64 + 8 * fq;
#pragma unroll
        for (int ai = 0; ai < 2; ++ai)
#pragma unroll
            for (int m = 0; m < 4; ++m) { const int row = row0 + ai * HALF + m * 16; bf16* rowp = O + (size_t)row * ldc + col0;
                const float rs = rsl[wr * 64 + fr + ai * HALF + m * 16];
#pragma unroll
                for (int bj = 0; bj < 2; ++bj) { const f32x4 v0 = acc[ai][bj][m][0] * rs, v1 = acc[ai][bj][m][1] * rs;
                    u32x4 w; w.x = cvt_pk_bf16(v0[0], v0[1]); w.y = cvt_pk_bf16(v0[2], v0[3]); w.z = cvt_pk_bf16(v1[0], v1[1]); w.w = cvt_pk_bf16(v1[2], v1[3]);
                    *(u32x4*)(rowp + bj * 32) = w; } }
    }
};
struct EpiResid {
    static constexpr bool PERM = true, KEEP = false, CONTIG = true;
    bf16* xb; int ldc; float* ssq;
    __device__ __forceinline__ void operator()(f32x4 (&acc)[2][2][4][2], const Unit& u, int wr, int wc, int fr, int fq) const {
        const int row0 = u.pm * BM + wr * 64 + fr, col0 = u.pn * BM + wc * 64 + 8 * fq;
#pragma unroll
        for (int ai = 0; ai < 2; ++ai)
#pragma unroll
            for (int m = 0; m < 4; ++m) { const int row = row0 + ai * HALF + m * 16; const size_t off = (size_t)row * ldc + col0; float q = 0.f;
#pragma unroll
                for (int bj = 0; bj < 2; ++bj) {
                    const u32x4 o = *(const u32x4*)(xb + off + bj * 32);
                    const f32x4 x0 = (f32x4){bf2f(o.x & 0xffffu), bf2f(o.x >> 16), bf2f(o.y & 0xffffu), bf2f(o.y >> 16)} + acc[ai][bj][m][0];
                    const f32x4 x1 = (f32x4){bf2f(o.z & 0xffffu), bf2f(o.z >> 16), bf2f(o.w & 0xffffu), bf2f(o.w >> 16)} + acc[ai][bj][m][1];
                    q += (x0[0] * x0[0] + x0[1] * x0[1]) + (x0[2] * x0[2] + x0[3] * x0[3]) + (x1[0] * x1[0] + x1[1] * x1[1]) + (x1[2] * x1[2] + x1[3] * x1[3]);
                    u32x4 w; w.x = cvt_pk_bf16(x0[0], x0[1]); w.y = cvt_pk_bf16(x0[2], x0[3]); w.z = cvt_pk_bf16(x1[0], x1[1]); w.w = cvt_pk_bf16(x1[2], x1[3]);
                    *(u32x4*)(xb + off + bj * 32) = w; }
                q += __shfl_xor(q, 16); q += __shfl_xor(q, 32); if (fq == 0) ssq[(size_t)row * 16 + u.pn * 4 + wc] = q;
            }
    }
};
struct EpiLift {
    static constexpr bool PERM = true, KEEP = true, CONTIG = false;
    const bf16* fac; bf16* mb; int ldc; const float* ssqc;
    __device__ __forceinline__ void operator()(f32x4 (&acc)[2][2][4][2], const Unit& u, int wr, int wc, int fr, int fq) const {
        const int row0 = u.pm * BM + wr * 64 + fr, col0 = u.pn * BM + wc * 32 + 8 * fq;
#pragma unroll
        for (int ai = 0; ai < 2; ++ai)
#pragma unroll
            for (int m = 0; m < 4; ++m) { const int row = row0 + ai * HALF + m * 16;
                float rsc = 1.f;
                if (u.z == 1 || u.z == 2) { const f32x2 p = *(const f32x2*)(ssqc + (size_t)row * 8 + 2 * fq); float sq = p.x + p.y; sq += __shfl_xor(sq, 16); sq += __shfl_xor(sq, 32);
                    const float v = sq * (1.f / 512.f) + 1e-6f; rsc = (u.z == 1) ? sqrtf(v) : rsqrtf(v); }
#pragma unroll
                for (int bj = 0; bj < 2; ++bj) { const int col = col0 + bj * HALF;
                    const u32x4 g0 = *(const u32x4*)(fac + (((((size_t)(u.pm * 4 + u.pn) * 4 + u.z) * 16 + (ai * 4 + m) * 2 + bj) * 8 + (wr * 4 + wc)) * 64 + fq * 16 + fr) * 8);
                    f32x4& v0 = acc[ai][bj][m][0]; f32x4& v1 = acc[ai][bj][m][1];
                    v0[0] *= rsc * bf2f(g0.x & 0xffffu); v0[1] *= rsc * bf2f(g0.x >> 16); v0[2] *= rsc * bf2f(g0.y & 0xffffu); v0[3] *= rsc * bf2f(g0.y >> 16);
                    v1[0] *= rsc * bf2f(g0.z & 0xffffu); v1[1] *= rsc * bf2f(g0.z >> 16); v1[2] *= rsc * bf2f(g0.w & 0xffffu); v1[3] *= rsc * bf2f(g0.w >> 16);
                    if (u.z == 3) { u32x4 w; w.x = cvt_pk_bf16(v0[0], v0[1]); w.y = cvt_pk_bf16(v0[2], v0[3]); w.z = cvt_pk_bf16(v1[0], v1[1]); w.w = cvt_pk_bf16(v1[2], v1[3]);
                        *(u32x4*)(mb + (size_t)row * ldc + col) = w; } } }
    }
};

__device__ __forceinline__ float dpp_ror1(float x) { return __int_as_float(__builtin_amdgcn_update_dpp(0, __float_as_int(x), 0x121, 0xf, 0xf, false)); }
__device__ __forceinline__ float dpp_ror2(float x) { return __int_as_float(__builtin_amdgcn_update_dpp(0, __float_as_int(x), 0x122, 0xf, 0xf, false)); }
__device__ __forceinline__ float dpp_prev1(float cur, float prev) { return __int_as_float(__builtin_amdgcn_update_dpp(__builtin_amdgcn_update_dpp(0, __float_as_int(prev), 0x121, 0xf, 0xf, false), __float_as_int(cur), 0x111, 0xf, 0xf, false)); }
__device__ __forceinline__ float dpp_prev2(float cur, float prev) { return __int_as_float(__builtin_amdgcn_update_dpp(__builtin_amdgcn_update_dpp(0, __float_as_int(prev), 0x122, 0xf, 0xf, false), __float_as_int(cur), 0x112, 0xf, 0xf, false)); }
struct EpiConvAct {
    static constexpr bool PERM = true, KEEP = false, CONTIG = false;
    bf16* act; const float* ssq; const float* cw; const float* cb; float* rawh; LAS unsigned char* halo; int ntn;
    __device__ __forceinline__ void operator()(f32x4 (&acc)[2][2][4][2], const Unit& u, int wr, int wc, int fr, int fq) const {
        asm volatile("" : "+v"(fr), "+v"(fq));
        const int row0 = u.pm * BM + wr * 64 + fr, ch0 = u.pn * 128 + wc * 32 + 8 * fq;
        LAS float* rsl = (LAS float*)(halo + 12288);
        panel_rstd(rsl, ssq, u.pm, wr, wc, fr, fq);
#pragma unroll
        for (int ai = 0; ai < 2; ++ai)
#pragma unroll
            for (int m = 0; m < 4; ++m) { const float rs = rsl[wr * 64 + fr + ai * HALF + m * 16];
#pragma unroll
                for (int bj = 0; bj < 2; ++bj) { acc[ai][bj][m][0] = acc[ai][bj][m][0] * rs; acc[ai][bj][m][1] = acc[ai][bj][m][1] * rs; } }
        LAS f32x4* H = (LAS f32x4*)halo;
        if (fr >= 14) {
#pragma unroll
            for (int ai = 0; ai < 2; ++ai) { const int b = 2 * ai + wr;
#pragma unroll
                for (int bj = 0; bj < 2; ++bj)
#pragma unroll
                    for (int n = 0; n < 2; ++n) H[((((b * 4 + wc) * 4 + fq) * 2 + (fr - 14)) * 2 + bj) * 2 + n] = acc[ai][bj][3][n]; } }
        { float* rw = rawh + (size_t)(u.pm * ntn + u.pn) * 1024;
          if (wr == 1 && fr >= 14) {
#pragma unroll
            for (int bj = 0; bj < 2; ++bj)
#pragma unroll
                for (int n = 0; n < 2; ++n) *(f32x4*)(rw + (2 + fr - 14) * 256 + bj * HALF + wc * 32 + 8 * fq + 4 * n) = acc[1][bj][3][n]; }
          if (wr == 0 && fr < 2) {
#pragma unroll
            for (int bj = 0; bj < 2; ++bj)
#pragma unroll
                for (int n = 0; n < 2; ++n) *(f32x4*)(rw + fr * 256 + bj * HALF + wc * 32 + 8 * fq + 4 * n) = acc[0][bj][0][n]; } }
        LAS float* WL = (LAS float*)(halo + 8192);
        { const int tidl = (wr * 4 + wc) * 64 + fq * 16 + fr, i2 = tidl * 2, kind = i2 >> 7, c = i2 & 127, k4 = kind & 3;
          const float* src = (k4 < 3 ? cw + k4 * 5632 : cb) + (kind >= 4 ? 2816 : 0) + u.pn * 128 + c;
          *(LAS f32x2*)(WL + i2) = *(const f32x2*)src; }
        asm volatile("s_waitcnt vmcnt(0) lgkmcnt(0)" ::: "memory"); __builtin_amdgcn_s_barrier(); asm volatile("" ::: "memory");
        bf16* actb = act + ((size_t)(u.pm * ntn + u.pn) * BM + wr * 64) * 128 + wc * 32;
        const unsigned alane = (unsigned)(fr * 128 + 8 * fq);
        unsigned pkw[2][4][3];
#pragma unroll
        for (int n = 0; n < 2; ++n) {
#pragma unroll
            for (int eh = 0; eh < 2; ++eh) {
                const int cl = wc * 32 + 8 * fq + 4 * n + 2 * eh;
                f32x2 wg[3], wu[3], bg, bu;
#pragma unroll
                for (int j = 0; j < 3; ++j) { wg[j] = *(const LAS f32x2*)(WL + j * 128 + cl); wu[j] = *(const LAS f32x2*)(WL + (4 + j) * 128 + cl); }
                bg = *(const LAS f32x2*)(WL + 3 * 128 + cl); bu = *(const LAS f32x2*)(WL + 7 * 128 + cl);
#pragma unroll
                for (int ai = 0; ai < 2; ++ai) { const int b = 2 * ai + wr;
#pragma unroll
                    for (int m = 3; m >= 0; --m) {
                        float r2[2];
#pragma unroll
                        for (int e2 = 0; e2 < 2; ++e2) { const int e = 2 * eh + e2;
                            const float gc = acc[ai][0][m][n][e], uc = acc[ai][1][m][n][e];
                            float gp = 0.f, up = 0.f; asm volatile("" : "+v"(gp), "+v"(up));
                            if (m > 0) { gp = acc[ai][0][m - 1][n][e]; up = acc[ai][1][m - 1][n][e]; }
                            else if (b >= 1) { const int fk = fr >= 14 ? fr - 14 : 0; const LAS float* hp = (const LAS float*)(H + ((((b - 1) * 4 + wc) * 4 + fq) * 2 + fk) * 4 + n); gp = hp[e]; up = hp[8 + e]; }
                            const float g1 = dpp_prev1(gc, gp), g2 = dpp_prev2(gc, gp), u1 = dpp_prev1(uc, up), u2 = dpp_prev2(uc, up);
                            const float vg = bg[e2] + wg[0][e2] * g2 + wg[1][e2] * g1 + wg[2][e2] * gc;
                            const float vu = bu[e2] + wu[0][e2] * u2 + wu[1][e2] * u1 + wu[2][e2] * uc;
                            r2[e2] = siluf_(vg) * vu; }
                        const unsigned pk = cvt_pk_bf16(r2[0], r2[1]);
                        if (2 * n + eh < 3) pkw[ai][m][2 * n + eh] = pk;
                        else *(u32x4*)(actb + (size_t)(ai * HALF + m * 16) * 128 + alane) = (u32x4){pkw[ai][m][0], pkw[ai][m][1], pkw[ai][m][2], pk};
                    }
                }
            }
        }
    }
};

template <class Epi, bool ALIGN_EPI = true>
__device__ __forceinline__ void gemm_phase(LAS unsigned char* lds, const Gemm g, const Order& S, const Epi& E) {
    int tid = threadIdx.x; asm volatile("" : "+v"(tid));
    const int wid = __builtin_amdgcn_readfirstlane(tid >> 6), lane = tid & 63, wr = wid >> 2, wc = wid & 3, fr = lane & 15, fq = lane >> 4;
    const int K = g.K, nt = K / BK;
    unsigned voffA[2], voffB[2];
#pragma unroll
    for (int i = 0; i < 2; ++i) { int R, C; stage_rc(tid * 16 + i * 8192, R, C);
        const int Rb = Epi::CONTIG ? (64 * (R >> 5) + perm32(R & 31)) : (Epi::PERM ? ((R & ~31) + perm32(R & 31)) : R);
        voffA[i] = (unsigned)(R * g.lda + C) * 2u; voffB[i] = (unsigned)(Rb * g.ldb + C) * 2u; }
    const size_t kstep = (size_t)(BK * 2);
    const size_t hstepA = (size_t)HALF * g.lda * 2, hstepB = (size_t)(Epi::CONTIG ? 32 : HALF) * g.ldb * 2;
    const size_t tstepA = g.atile ? g.atile : 2 * hstepA, tstepB = (size_t)BM * g.ldb * 2;
    const unsigned ldsw = (unsigned)wid * 1024u;
    const int aoff = lds_byte(wr * 64 + fr, fq * 8), boff = lds_byte(wc * 32 + fr, fq * 8);
#define PG8_SA(b, h) (((b) * 2 + (h)) * HTB)
#define PG8_SB(b, h) ((4 + (b) * 2 + (h)) * HTB)
#define PG8_STAGE(bufoff, gbase, voff) do { _Pragma("unroll") for (int _i = 0; _i < 2; ++_i) \
        __builtin_amdgcn_global_load_lds((const unsigned*)((const char*)(gbase) + (voff)[_i]), (LAS unsigned*)(lds + (bufoff) + ldsw + _i * 8192), 16, 0, 0); } while (0)
#define PG8_LDA(dst, b, h) do { _Pragma("unroll") for (int m = 0; m < 4; ++m) _Pragma("unroll") for (int k = 0; k < 2; ++k) dst[m][k] = *(const LAS bf16x8*)(lds + PG8_SA(b, h) + aoff + m * 2048 + k * 1024); } while (0)
#define PG8_LDB(dst, b, h) do { _Pragma("unroll") for (int n = 0; n < 2; ++n) _Pragma("unroll") for (int k = 0; k < 2; ++k) dst[n][k] = *(const LAS bf16x8*)(lds + PG8_SB(b, h) + boff + n * 2048 + k * 1024); } while (0)
#define PG8_MMA(ai, bj, At, Bt) do { __builtin_amdgcn_s_setprio(1); _Pragma("unroll") for (int m = 0; m < 4; ++m) _Pragma("unroll") for (int n = 0; n < 2; ++n) _Pragma("unroll") for (int k = 0; k < 2; ++k) \
        acc[ai][bj][m][n] = __builtin_amdgcn_mfma_f32_16x16x32_bf16(Bt[n][k], At[m][k], acc[ai][bj][m][n], 0, 0, 0); __builtin_amdgcn_s_setprio(0); } while (0)
#define PG8_WAIT_V(n) asm volatile("s_waitcnt vmcnt(" #n ")" ::: "memory")
#define PG8_WAIT_L(n) asm volatile("s_waitcnt lgkmcnt(" #n ")" ::: "memory")
#define PG8_BAR __builtin_amdgcn_s_barrier()
#define PG8_SCHED __builtin_amdgcn_sched_barrier(0)
    Unit cur, nxt; int ui = 0;
    if (!S.next(0, cur)) return;
    f32x4 acc[2][2][4][2];
#pragma unroll
    for (int a = 0; a < 2; ++a)
#pragma unroll
        for (int b = 0; b < 2; ++b)
#pragma unroll
            for (int m = 0; m < 4; ++m)
#pragma unroll
                for (int n = 0; n < 2; ++n) acc[a][b][m][n] = (f32x4){0.f, 0.f, 0.f, 0.f};
    bf16x8 At[4][2], B0[2][2], B1[2][2];
    const char* cA = (const char*)g.A + (size_t)cur.pm * tstepA + (size_t)cur.z * g.zA; const char* cB = (const char*)g.Bt + (size_t)cur.pn * tstepB + (size_t)cur.z * g.zB;
    PG8_STAGE(PG8_SB(0, 0), cB, voffB); PG8_STAGE(PG8_SB(0, 1), cB + hstepB, voffB); PG8_STAGE(PG8_SA(0, 0), cA, voffA); PG8_STAGE(PG8_SA(0, 1), cA + hstepA, voffA);
    if (wr == 1) PG8_BAR;
    PG8_WAIT_V(2); PG8_BAR;
    PG8_STAGE(PG8_SB(1, 0), cB + kstep, voffB); PG8_STAGE(PG8_SA(1, 0), cA + kstep, voffA); PG8_STAGE(PG8_SB(1, 1), cB + hstepB + kstep, voffB);
    PG8_WAIT_V(6); PG8_BAR;
    for (;;) {
        const bool has_next = S.next(ui + 1, nxt);
        const char* nA = has_next ? (const char*)g.A + (size_t)nxt.pm * tstepA + (size_t)nxt.z * g.zA : cA; const char* nB = has_next ? (const char*)g.Bt + (size_t)nxt.pn * tstepB + (size_t)nxt.z * g.zB : cB;
        for (int t = 0; t < nt; t += 2) {
            const bool last = (t == nt - 2);
            const char* a1 = cA + (size_t)(t >> 1) * g.ablk + kstep;
            const char* a2 = last ? nA : cA + (size_t)((t >> 1) + 1) * g.ablk; const char* b2 = last ? nB : cB + (size_t)(t + 2) * kstep;
            const char* a3 = a2 + kstep; const char* b3 = b2 + kstep;
            PG8_LDB(B0, 0, 0); PG8_LDB(B1, 0, 1); PG8_SCHED; PG8_LDA(At, 0, 0); PG8_STAGE(PG8_SA(1, 1), a1 + hstepA, voffA);
            PG8_WAIT_V(8); PG8_WAIT_L(0); PG8_BAR; PG8_MMA(0, 0, At, B0); PG8_MMA(0, 1, At, B1); PG8_BAR; PG8_SCHED;
            PG8_LDA(At, 0, 1); PG8_STAGE(PG8_SB(0, 0), b2, voffB); PG8_STAGE(PG8_SB(0, 1), b2 + hstepB, voffB); PG8_STAGE(PG8_SA(0, 0), a2, voffA);
            PG8_WAIT_V(8); PG8_WAIT_L(0); PG8_BAR; PG8_MMA(1, 0, At, B0); PG8_MMA(1, 1, At, B1); PG8_BAR; PG8_SCHED;
            PG8_LDB(B0, 1, 0); PG8_LDB(B1, 1, 1); PG8_SCHED; PG8_LDA(At, 1, 0); PG8_STAGE(PG8_SA(0, 1), a2 + hstepA, voffA);
            PG8_WAIT_V(8); PG8_WAIT_L(0); PG8_BAR; PG8_MMA(0, 0, At, B0); PG8_MMA(0, 1, At, B1); PG8_BAR; PG8_SCHED;
            PG8_LDA(At, 1, 1); PG8_STAGE(PG8_SB(1, 0), b3, voffB); PG8_STAGE(PG8_SB(1, 1), b3 + hstepB, voffB); PG8_STAGE(PG8_SA(1, 0), a3, voffA);
            PG8_WAIT_V(8); PG8_WAIT_L(0); PG8_BAR; PG8_MMA(1, 0, At, B0); PG8_MMA(1, 1, At, B1); PG8_BAR; PG8_SCHED;
        }
        if constexpr (ALIGN_EPI) { if (wr == 0) PG8_BAR; }
        E(acc, cur, wr, wc, fr, fq);
        if (!has_next) break;
        if (!(Epi::KEEP && nxt.z != 0))
#pragma unroll
        for (int a = 0; a < 2; ++a)
#pragma unroll
            for (int b = 0; b < 2; ++b)
#pragma unroll
                for (int m = 0; m < 4; ++m)
#pragma unroll
                    for (int n = 0; n < 2; ++n) acc[a][b][m][n] = (f32x4){0.f, 0.f, 0.f, 0.f};
        cur = nxt; cA = nA; cB = nB; ++ui;
        if constexpr (ALIGN_EPI) { if (wr == 1) PG8_BAR; }
    }
    PG8_WAIT_V(0);
    if constexpr (!ALIGN_EPI) { if (wr == 0) PG8_BAR; }
    PG8_BAR;
#undef PG8_SA
#undef PG8_SB
#undef PG8_STAGE
#undef PG8_LDA
#undef PG8_LDB
#undef PG8_MMA
#undef PG8_WAIT_V
#undef PG8_WAIT_L
#undef PG8_BAR
#undef PG8_SCHED
}
}

#define XB_TMO      128
#define XB_XCNT(j)  (256  + 64 * (j))
#define XB_XSUB(j)  (1280 + 64 * (j))
#define XB_XGEN(j)  (2304 + 64 * (j))
#define XB_TOP      3328
#define XB_TOPGEN   3392
#define XCD_BAR_WORDS 3456
#define XB_SPIN_CAP (1u << 18)
__device__ __forceinline__ unsigned xb_ld(unsigned* p)              { return __hip_atomic_load(p, __ATOMIC_RELAXED, __HIP_MEMORY_SCOPE_AGENT); }
__device__ __forceinline__ unsigned xb_add(unsigned* p, unsigned v) { return __hip_atomic_fetch_add(p, v, __ATOMIC_RELAXED, __HIP_MEMORY_SCOPE_AGENT); }
__device__ __forceinline__ unsigned xb_xcc_id() { return (unsigned)__builtin_amdgcn_s_getreg((3 << 11) | 20) & 0xFu; }
#define XB_SPIN(cond, bar) do { unsigned _sp = 0; while (cond) { __builtin_amdgcn_s_sleep(1); \
    if ((++_sp & 255u) == 0u) { if (xb_ld(&(bar)[XB_TMO])) break; if (_sp > XB_SPIN_CAP) { atomicAdd(&(bar)[XB_TMO], 1u); break; } } } } while (0)
struct XcdBarrier { unsigned* bar; unsigned x; volatile LAS unsigned* st; };
__device__ __forceinline__ XcdBarrier xcd_barrier_post(unsigned* bar, volatile LAS unsigned* st) {
    XcdBarrier b; b.bar = bar; b.x = xb_xcc_id(); b.st = st;
    if (threadIdx.x == 0) (void)xb_add(&bar[XB_XCNT(b.x)], 1u);
    return b;
}
__device__ __forceinline__ void xcd_barrier_complete(unsigned* bar, unsigned x, unsigned& nloc, unsigned& nx) {
    const unsigned G = gridDim.x * gridDim.y * gridDim.z;
    unsigned sum, cnt, mine, sp = 0u;
    for (;;) {
        sum = 0u; cnt = 0u; mine = 0u;
#pragma unroll
        for (unsigned j = 0; j < 16; ++j) { const unsigned c = xb_ld(&bar[XB_XCNT(j)]); sum += c; cnt += (c > 0u) ? 1u : 0u; mine = (j == x) ? c : mine; }
        if (sum == G) break;
        __builtin_amdgcn_s_sleep(1);
        if ((++sp & 255u) == 0u) { if (xb_ld(&bar[XB_TMO])) break; if (sp > XB_SPIN_CAP) { atomicAdd(&bar[XB_TMO], 1u); break; } }
    }
    nloc = mine > 0u ? mine : 1u; nx = cnt > 0u ? cnt : 1u;
}
__device__ __forceinline__ void xcd_barrier(const XcdBarrier& b) {
    asm volatile("s_waitcnt vmcnt(0)" ::: "memory");
    __syncthreads();
    if (threadIdx.x == 0) {
        unsigned* bar = b.bar;
        __builtin_amdgcn_s_waitcnt(0);
        unsigned nloc = b.st[0], nx = b.st[1];
        if (nloc == 0u) { xcd_barrier_complete(bar, b.x, nloc, nx); b.st[0] = nloc; b.st[1] = nx; }
        const unsigned old = xb_add(&bar[XB_XSUB(b.x)], 1u);
        const unsigned gen = old / nloc;
        if (old + 1u == (gen + 1u) * nloc) {
            __builtin_amdgcn_fence(__ATOMIC_RELEASE, "agent");
            asm volatile("s_waitcnt vmcnt(0)" ::: "memory");
            const unsigned og = xb_add(&bar[XB_TOP], 1u);
            const unsigned tg = og / nx;
            if (og + 1u == (tg + 1u) * nx) xb_add(&bar[XB_TOPGEN], 1u);
            else XB_SPIN(xb_ld(&bar[XB_TOPGEN]) == tg, bar);
            __builtin_amdgcn_fence(__ATOMIC_ACQUIRE, "agent");
            xb_add(&bar[XB_XGEN(b.x)], 1u);
            asm volatile("s_waitcnt vmcnt(0)" ::: "memory");
        } else {
            XB_SPIN(xb_ld(&bar[XB_XGEN(b.x)]) == gen, bar);
            __builtin_amdgcn_fence(__ATOMIC_ACQUIRE, "agent");
            asm volatile("s_waitcnt vmcnt(0)" ::: "memory");
        }
    }
    __syncthreads();
}

__device__ __forceinline__ bf16x8 frag_kc(const LAS bf16* X, int ld, int mn0, int k0, int lane) { return *(const LAS bf16x8*)(X + (mn0 + (lane & 15)) * ld + k0 + 8 * (lane >> 4)); }
__device__ __forceinline__ bf16x8 gfrag_kc(const bf16* X, int ld, int mn0, int k0, int lane) { const bf16* b = X + (size_t)mn0 * ld + k0; const unsigned lo = (unsigned)((lane & 15) * ld + 8 * (lane >> 4)); return *(const bf16x8*)(b + lo); }
__device__ __forceinline__ s16x4 trr(const LAS bf16* p) { return __builtin_bit_cast(s16x4, __builtin_amdgcn_ds_read_tr16_b64_v4i16((LAS s16x4*)p)); }
__device__ __forceinline__ bf16x8 frag_ks(const LAS bf16* X, int ld, int mn0, int k0, int lane) {
    const int r = lane & 15, g = lane >> 4;
    const LAS bf16* p = X + (k0 + 8 * g + (r >> 2)) * ld + mn0 + 4 * (r & 3);
    const s16x4 lo = trr(p), hi = trr(p + 4 * ld);
    return (bf16x8){lo[0], lo[1], lo[2], lo[3], hi[0], hi[1], hi[2], hi[3]};
}
__device__ __forceinline__ f32x4 zero4() { f32x4 z = {0.f, 0.f, 0.f, 0.f}; asm volatile("" : "+v"(z)); return z; }
__device__ __forceinline__ u32x4 uone4() { u32x4 z = {0x3F80u, 0u, 0u, 0u}; asm volatile("" : "+v"(z)); return z; }
__device__ __forceinline__ u32x4 uzero4() { u32x4 z = {0u, 0u, 0u, 0u}; asm volatile("" : "+v"(z)); return z; }
#define MFMA16(a, b, c) __builtin_amdgcn_mfma_f32_16x16x32_bf16((a), (b), (c), 0, 0, 0)
__device__ __forceinline__ u32x4 scale8(u32x4 w, float s) {
    u32x4 o;
    o.x = pk2(bf2f(w.x & 0xffffu) * s, bf2f(w.x >> 16) * s); o.y = pk2(bf2f(w.y & 0xffffu) * s, bf2f(w.y >> 16) * s);
    o.z = pk2(bf2f(w.z & 0xffffu) * s, bf2f(w.z >> 16) * s); o.w = pk2(bf2f(w.w & 0xffffu) * s, bf2f(w.w >> 16) * s);
    return o;
}
__device__ __forceinline__ float wscan_add(float v, int lane) {
#pragma unroll
    for (int o = 1; o < 64; o <<= 1) { const float t = __shfl_up(v, o); if (lane >= o) v += t; }
    return v;
}
__device__ __forceinline__ float wscan_max(float v, int lane) {
#pragma unroll
    for (int o = 1; o < 64; o <<= 1) { const float t = __shfl_up(v, o); if (lane >= o) v = fmaxf(v, t); }
    return v;
}

#ifndef GEMM_ALIGN
#define GEMM_ALIGN true
#endif
enum { PH_W = 0, PH_INPROJ, PH_M0, PH_M1, PH_M2, PH_M3, PH_LIFT, PH_OUT, PH_UP, PH_DOWN, PH_FINAL, PH_COUNT };
enum { I_X = 0, I_MIXG, I_WIN, I_AIB, I_AFB, I_ANG, I_BCW, I_CCW, I_CCB, I_CDTB, I_CALOG, I_CDSKIP, I_CNG, I_WLIFT, I_WOUT, I_FFNG, I_WUP, I_FCW, I_FCB, I_WDOWN, I_FING, N_IN };
struct Args { const float* in[N_IN]; float* out; unsigned char* ws; int l_lo, l_hi, g_lo, g_hi, ph_lo, ph_hi, use_bar, pad; };

__device__ __forceinline__ void transpose_item(const float* W, int ldw, int nsrc0, int k0, bf16* WT, int ldt, int ndst0, LAS float* scr, int lane, const float* kscale = nullptr, int gate_tile = -1) {
    int scol = nsrc0 + (lane & 31);
    if (gate_tile >= 0) {
        const int c = (ndst0 & 255) + (lane & 31), wc = c >> 6, bj = (c >> 5) & 1, fq = (c >> 3) & 3, n = (c >> 2) & 1, e = c & 3;
        scol = 6160 + (2 * bj + n) * 1024 + 64 * gate_tile + 16 * wc + 4 * fq + e; }
#pragma unroll 8
    for (int i = 0; i < 32; ++i) { const int kk = 2 * i + (lane >> 5); scr[kk * 33 + (lane & 31)] = W[(size_t)(k0 + kk) * ldw + scol] * (kscale ? kscale[k0 + kk] : 1.f); }
    LDS_WAIT(); asm volatile("" ::: "memory");
    const int c = lane & 7;
#pragma unroll
    for (int j = 0; j < 4; ++j) { const int n = (lane >> 3) + 8 * j; const LAS float* s = scr + (8 * c) * 33 + n;
        u32x4 o; o.x = pk2(s[0 * 33], s[1 * 33]); o.y = pk2(s[2 * 33], s[3 * 33]); o.z = pk2(s[4 * 33], s[5 * 33]); o.w = pk2(s[6 * 33], s[7 * 33]);
        *(u32x4*)(WT + (size_t)(ndst0 + n) * ldt + k0 + 8 * c) = o; }
    LDS_WAIT(); asm volatile("" ::: "memory");
}

__global__ void __launch_bounds__(NTHR, 2) fwd(Args args) {
    extern __shared__ __attribute__((aligned(16))) unsigned char lds_raw[];
    LAS unsigned char* lds = (LAS unsigned char*)lds_raw;
    const int NBLK = gridDim.x, blk = blockIdx.x;
    {
        volatile LAS unsigned* MISC0 = (volatile LAS unsigned*)(lds + MISC_OFF);
        if (threadIdx.x < 16) MISC0[threadIdx.x] = 0u;
        __syncthreads();
    }
    XcdBarrier bar; bar.bar = (unsigned*)(args.ws + WS_CTL) + 4096; bar.x = 0; bar.st = nullptr;
    if (args.use_bar) bar = xcd_barrier_post((unsigned*)(args.ws + WS_CTL) + 4096, (volatile LAS unsigned*)(lds + MISC_OFF) + 8);
#define GRID_BAR() do { if (args.use_bar) xcd_barrier(bar); } while (0)
#ifndef REPMASK
#define REPMASK 0
#endif
#define IN(k) (args.ph_lo <= (k) && (k) < args.ph_hi)
#define REPS(k) for (int rep_ = 0; rep_ < 1 + ((REPMASK >> (k)) & 1); ++rep_)
#define PHASE_BEGIN() int tid = threadIdx.x; asm volatile("" : "+v"(tid)); const int lane = tid & 63, wave = __builtin_amdgcn_readfirstlane(tid >> 6); \
    const __attribute__((address_space(4))) Args* ka = (const __attribute__((address_space(4))) Args*)__builtin_amdgcn_kernarg_segment_ptr(); asm volatile("" : "+s"(ka)); \
    unsigned char* ws = ka->ws; \
    const size_t grow0 = (size_t)grp * T; const float* xsrc = (l == 0) ? ka->in[I_X] : ka->out; (void)grow0; (void)xsrc; \
    const int gw = blk * NWAVES + wave, NGW = NBLK * NWAVES, gt = blk * NTHR + tid, NGT = NBLK * NTHR; (void)lane; (void)gw; (void)NGW; (void)gt; (void)NGT; \
    bf16* const WinT = (bf16*)(ws + WS_WIN); bf16* const WliftT = (bf16*)(ws + WS_WLIFT); bf16* const WoutT = (bf16*)(ws + WS_WOUT); \
    bf16* const WupT = (bf16*)(ws + WS_WUP); bf16* const WdownT = (bf16*)(ws + WS_WDOWN); bf16* const W16B = (bf16*)(ws + WS_W16); \
    bf16* const XN = (bf16*)(ws + WS_XN); bf16* const P = (bf16*)(ws + WS_P); bf16* const FAC = (bf16*)(ws + WS_P) + (size_t)T * PWS; (void)FAC; bf16* const U = (bf16*)(ws + WS_U); bf16* const ACT = (bf16*)(ws + WS_ACT); \
    bf16* const YCAT = (bf16*)(ws + WS_YCAT); bf16* const XG = (bf16*)(ws + WS_XG); bf16* const MB = (bf16*)(ws + WS_MB); float* const SP = (float*)(ws + WS_SP); \
    float* const SSQ1 = (float*)(ws + WS_SSQ1); float* const SSQ2 = (float*)(ws + WS_SSQ2); float* const SSQC = (float*)(ws + WS_SSQC); float* const RAWH = (float*)(ws + WS_RAWH); (void)SSQ1; (void)SSQ2; (void)SSQC; (void)RAWH; \
    float* const GBc = (float*)(ws + WS_GB); float* const GGc = (float*)(ws + WS_GG); float* const GMT = (float*)(ws + WS_GMT); \
    float* const MCAR = (float*)(ws + WS_MCAR); float* const MNEW = (float*)(ws + WS_MNEW); float* const MSC = (float*)(ws + WS_MSC); float* const SUMB = (float*)(ws + WS_SUMB); float* const SUMG = (float*)(ws + WS_SUMG); (void)SUMB; (void)SUMG; \
    float* const DTB = (float*)(ws + WS_DT); float* const ACB = (float*)(ws + WS_AC); bf16* const XBC = (bf16*)(ws + WS_XBC); \
    bf16* const DC = (bf16*)(ws + WS_DC); bf16* const CS = (bf16*)(ws + WS_CS); bf16* const DH = (bf16*)(ws + WS_DH); bf16* const HS = (bf16*)(ws + WS_HS); \
    (void)WinT; (void)WliftT; (void)WoutT; (void)WupT; (void)WdownT; (void)W16B; (void)XN; (void)P; (void)U; (void)ACT; (void)YCAT; (void)XG; (void)MB; (void)SP; (void)GBc; (void)GGc; (void)GMT; \
    (void)MCAR; (void)MNEW; (void)MSC; (void)DTB; (void)ACB; (void)XBC; (void)DC; (void)CS; (void)DH; (void)HS

    for (int l = args.l_lo; l < args.l_hi; ++l)
    for (int grp = args.g_lo; grp < args.g_hi; ++grp) {

        REPS(PH_W) if (IN(PH_W) && grp == 0) {
            PHASE_BEGIN();
            LAS float* scr = (LAS float*)(lds + wave * 16384);
            constexpr int I_IN = 16 * 320, I_LF = 4 * 8 * 32, I_OUT = 16 * 32, I_UP = 16 * 176, I_DN = 44 * 32, NIT = I_IN + I_LF + I_OUT + I_UP + I_DN;
            for (int it = gw; it < NIT; it += NGW) {
                int r = it;
                if (r < I_IN) { const int kb = r / 320, nb = r % 320, n0 = 32 * nb, ns = n0 + (n0 >= P_SQ ? 16 : (n0 >= P_BB ? 8 : 0));
                    transpose_item(ka->in[I_WIN] + (size_t)l * DM * PIN, PIN, ns, 64 * kb, WinT, DM, n0, scr, lane, ka->in[I_MIXG] + (size_t)l * DM, n0 >= P_G ? (n0 - P_G) >> 8 : -1); continue; } r -= I_IN;
                if (r < I_LF) { const int br = r / 256, q = r % 256, kb = q / 32, nb = q % 32;
                    transpose_item(ka->in[I_WLIFT] + (size_t)(l * 4 + br) * 512 * DM, DM, 32 * nb, 64 * kb, WliftT + (size_t)br * DM * 512, 512, 32 * nb, scr, lane, br == 2 ? ka->in[I_CNG] + (size_t)l * 512 : nullptr); continue; } r -= I_LF;
                if (r < I_OUT) { const int kb = r / 32, nb = r % 32;
                    transpose_item(ka->in[I_WOUT] + (size_t)l * DM * DM, DM, 32 * nb, 64 * kb, WoutT, DM, 32 * nb, scr, lane); continue; } r -= I_OUT;
                if (r < I_UP) { const int kb = r / 176, nb = r % 176, n0 = 32 * nb, tp = n0 >> 8, j = n0 & 255, ns = (j < 128) ? 128 * tp + j : 2816 + 128 * tp + (j - 128);
                    transpose_item(ka->in[I_WUP] + (size_t)l * DM * DFF2, DFF2, ns, 64 * kb, WupT, DM, n0, scr, lane, ka->in[I_FFNG] + (size_t)l * DM); continue; } r -= I_UP;
                { const int kb = r / 32, nb = r % 32;
                    transpose_item(ka->in[I_WDOWN] + (size_t)l * DFF * DM, DM, 32 * nb, 64 * kb, WdownT, DFF, 32 * nb, scr, lane); }
            }
            for (int i = gt; i < 16 * DM; i += NGT) { const int c = i >> 10, k = i & 1023; const int oc = (c < 8) ? (1536 + c) : (4616 + (c - 8));
                const float w = ka->in[I_WIN][(size_t)l * DM * PIN + (size_t)k * PIN + oc] * ka->in[I_MIXG][(size_t)l * DM + k]; const unsigned hi = f2bf(w);
                W16B[i] = (bf16)hi; W16B[16 * DM + i] = (bf16)f2bf(w - bf2f(hi)); }
            if (l == 0) {
                for (int m = gw; m < BATCH * SEQ; m += NGW) {
                    const f32x4* xr = (const f32x4*)(ka->in[I_X] + (size_t)m * DM) + lane;
                    f32x4 v[4]; float sq = 0.f;
#pragma unroll
                    for (int j = 0; j < 4; ++j) { v[j] = xr[64 * j]; sq += (v[j].x * v[j].x + v[j].y * v[j].y) + (v[j].z * v[j].z + v[j].w * v[j].w); }
                    sq = wave_sum(sq); if (lane < 16) SSQ1[(size_t)m * 16 + lane] = (lane == 0) ? sq : 0.f;
                    u32x2* o8 = (u32x2*)(XG + (size_t)m * DM) + lane;
#pragma unroll
                    for (int j = 0; j < 4; ++j) o8[64 * j] = (u32x2){pk2(v[j].x, v[j].y), pk2(v[j].z, v[j].w)};
                }
            }
            GRID_BAR();
        }

        REPS(PH_INPROJ) if (IN(PH_INPROJ)) {
            PHASE_BEGIN();
            const bf16* XGg = XG + grow0 * DM; const float* ssq = SSQ1 + grow0 * 16;
            if (tid == 0) *(volatile LAS int*)(lds + 143360 + 1024) = -1;
            for (int rb = blk; rb < T / 64; rb += NBLK) {
                const int r0 = rb * 64 + 16 * (wave & 3), kh = (wave >> 2) * 512; f32x4 acc = zero4(), acc2 = zero4();
#pragma unroll 8
                for (int ks = 0; ks < 16; ++ks) { const bf16x8 a = gfrag_kc(XGg, DM, r0, kh + 32 * ks, lane);
                    acc = MFMA16(a, gfrag_kc(W16B, DM, 0, kh + 32 * ks, lane), acc); acc2 = MFMA16(a, gfrag_kc(W16B + 16 * DM, DM, 0, kh + 32 * ks, lane), acc2); }
                acc += acc2;
                LAS f32x4* xch = (LAS f32x4*)lds;
                if (wave >= 4) xch[(wave - 4) * 64 + lane] = acc;
                __syncthreads();
                if (wave < 4) { acc += xch[wave * 64 + lane];
#pragma unroll
                    for (int i = 0; i < 4; ++i) { const int row = r0 + 4 * (lane >> 4) + i; SP[(size_t)row * 16 + (lane & 15)] = acc[i] * row_rstd(ssq + (size_t)row * 16); } }
                __syncthreads();
            }
            pg8::Gemm g{XGg, WinT, DM, DM, DM, 0, 0}; pg8::Order S; S.init(T, PW, NBLK, blk, 1);
            pg8::EpiBf16 E{(LAS float*)(lds + 143360), P, PWS, ssq, P_G / 256, FAC};
            pg8::gemm_phase<pg8::EpiBf16, GEMM_ALIGN>(lds, g, S, E);
            GRID_BAR();
        }

        REPS(PH_M0) if (IN(PH_M0)) {
            PHASE_BEGIN();
            for (int task = gw; task < GB * 4 * NCH; task += NGW) {
                const int bh = task >> 5, c = task & 31, bl = bh >> 2, h = bh & 3;
                const size_t m = (size_t)bl * SEQ + c * 64 + lane;
                const float ig = SP[m * 16 + h] + ka->in[I_AIB][l * 4 + h], fg = SP[m * 16 + 4 + h] + ka->in[I_AFB][l * 4 + h];
                const float b = wscan_add(logsigf_(fg), lane);
                const float gg = ig - b;
                const float pm = wscan_max(gg, lane);
                GBc[m * 4 + h] = b; GGc[m * 4 + h] = gg; GMT[m * 4 + h] = pm;
                if (lane == 63) { SUMB[task] = b; SUMG[task] = pm; }
            }
            for (int task = gw; task < GB * NCH * 8; task += NGW) {
                const int hd = task & 7; const size_t m = (size_t)(task >> 3) * 64 + lane;
                const float dt = softplusf_(SP[m * 16 + 8 + hd] + ka->in[I_CDTB][l * 8 + hd]);
                const float a = wscan_add(-dt * __expf(ka->in[I_CALOG][l * 8 + hd]), lane);
                DTB[m * 8 + hd] = dt; ACB[m * 8 + hd] = a;
            }
            {
                const float* cw = ka->in[I_CCW] + (size_t)l * 4 * 1024; const float* cb = ka->in[I_CCB] + (size_t)l * 1024;
                constexpr int RUN = 16;
                for (int i = gt; i < (T / RUN) * 128; i += NGT) {
                    const int rb = i >> 7, c8 = (i & 127) * 8, m0 = rb * RUN, t0 = m0 & (SEQ - 1);
                    float w[4][8], bb[8];
#pragma unroll
                    for (int e = 0; e < 8; ++e) { bb[e] = cb[c8 + e];
#pragma unroll
                        for (int j = 0; j < 4; ++j) w[j][e] = cw[j * 1024 + c8 + e]; }
                    const u32x4 zz = uzero4(); u32x4 win[4]; win[0] = zz; win[1] = zz; win[2] = zz;
                    if (t0 >= 3) { const bf16* pr = P + (size_t)(m0 - 3) * PWS + P_CX + c8; win[0] = *(const u32x4*)pr; win[1] = *(const u32x4*)(pr + PWS); win[2] = *(const u32x4*)(pr + 2 * PWS); }
#pragma unroll 4
                    for (int rr = 0; rr < RUN; ++rr) {
                        win[3] = *(const u32x4*)(P + (size_t)(m0 + rr) * PWS + P_CX + c8);
                        float acc[8];
#pragma unroll
                        for (int e = 0; e < 8; ++e) acc[e] = bb[e];
#pragma unroll
                        for (int j = 0; j < 4; ++j) {
                            acc[0] += w[j][0] * bf2f(win[j].x & 0xffffu); acc[1] += w[j][1] * bf2f(win[j].x >> 16); acc[2] += w[j][2] * bf2f(win[j].y & 0xffffu); acc[3] += w[j][3] * bf2f(win[j].y >> 16);
                            acc[4] += w[j][4] * bf2f(win[j].z & 0xffffu); acc[5] += w[j][5] * bf2f(win[j].z >> 16); acc[6] += w[j][6] * bf2f(win[j].w & 0xffffu); acc[7] += w[j][7] * bf2f(win[j].w >> 16); }
                        u32x4 o; o.x = pk2(siluf_(acc[0]), siluf_(acc[1])); o.y = pk2(siluf_(acc[2]), siluf_(acc[3])); o.z = pk2(siluf_(acc[4]), siluf_(acc[5])); o.w = pk2(siluf_(acc[6]), siluf_(acc[7]));
                        *(u32x4*)(XBC + (size_t)(m0 + rr) * 1024 + c8) = o;
                        win[0] = win[1]; win[1] = win[2]; win[2] = win[3];
                    }
                }
            }
            {
                const float* bw = ka->in[I_BCW] + (size_t)l * 3 * 512;
                constexpr int RUN = 16;
                for (int i = gt; i < (T / RUN) * 64; i += NGT) {
                    const int rb = i >> 6, c8 = (i & 63) * 8, m0 = rb * RUN, t0 = m0 & (SEQ - 1);
                    float w[3][8];
#pragma unroll
                    for (int e = 0; e < 8; ++e)
#pragma unroll
                        for (int j = 0; j < 3; ++j) w[j][e] = bw[j * 512 + c8 + e];
                    float pw[3][8];
#pragma unroll
                    for (int e = 0; e < 8; ++e) { pw[0][e] = 0.f; pw[1][e] = 0.f; }
                    if (t0 >= 2) {
#pragma unroll
                        for (int j = 0; j < 2; ++j) { const bf16* pr = P + (size_t)(m0 - 2 + j) * PWS; const u32x4 a = *(const u32x4*)(pr + P_BC + c8), b = *(const u32x4*)(pr + P_BX + c8);
                            pw[j][0] = bf2f(a.x & 0xffffu) * bf2f(b.x & 0xffffu); pw[j][1] = bf2f(a.x >> 16) * bf2f(b.x >> 16); pw[j][2] = bf2f(a.y & 0xffffu) * bf2f(b.y & 0xffffu); pw[j][3] = bf2f(a.y >> 16) * bf2f(b.y >> 16);
                            pw[j][4] = bf2f(a.z & 0xffffu) * bf2f(b.z & 0xffffu); pw[j][5] = bf2f(a.z >> 16) * bf2f(b.z >> 16); pw[j][6] = bf2f(a.w & 0xffffu) * bf2f(b.w & 0xffffu); pw[j][7] = bf2f(a.w >> 16) * bf2f(b.w >> 16); } }
#pragma unroll 4
                    for (int rr = 0; rr < RUN; ++rr) {
                        const bf16* pr = P + (size_t)(m0 + rr) * PWS; const u32x4 a = *(const u32x4*)(pr + P_BC + c8), b = *(const u32x4*)(pr + P_BX + c8), g = *(const u32x4*)(pr + P_BB + c8);
                        pw[2][0] = bf2f(a.x & 0xffffu) * bf2f(b.x & 0xffffu); pw[2][1] = bf2f(a.x >> 16) * bf2f(b.x >> 16); pw[2][2] = bf2f(a.y & 0xffffu) * bf2f(b.y & 0xffffu); pw[2][3] = bf2f(a.y >> 16) * bf2f(b.y >> 16);
                        pw[2][4] = bf2f(a.z & 0xffffu) * bf2f(b.z & 0xffffu); pw[2][5] = bf2f(a.z >> 16) * bf2f(b.z >> 16); pw[2][6] = bf2f(a.w & 0xffffu) * bf2f(b.w & 0xffffu); pw[2][7] = bf2f(a.w >> 16) * bf2f(b.w >> 16);
                        float acc[8];
#pragma unroll
                        for (int e = 0; e < 8; ++e) acc[e] = w[0][e] * pw[0][e] + w[1][e] * pw[1][e] + w[2][e] * pw[2][e];
                        u32x4 o; o.x = pk2(acc[0] * bf2f(g.x & 0xffffu), acc[1] * bf2f(g.x >> 16)); o.y = pk2(acc[2] * bf2f(g.y & 0xffffu), acc[3] * bf2f(g.y >> 16));
                        o.z = pk2(acc[4] * bf2f(g.z & 0xffffu), acc[5] * bf2f(g.z >> 16)); o.w = pk2(acc[6] * bf2f(g.w & 0xffffu), acc[7] * bf2f(g.w >> 16));
                        *(u32x4*)(YCAT + (size_t)(m0 + rr) * YW + 512 + c8) = o;
#pragma unroll
                        for (int e = 0; e < 8; ++e) { pw[0][e] = pw[1][e]; pw[1][e] = pw[2][e]; }
                    }
                }
            }
            __syncthreads();
            {
            LAS bf16* Qs = (LAS bf16*)lds; LAS bf16* Ks = Qs + 128 * 136; LAS bf16* Vs = Ks + 64 * 136; LAS bf16* Aw = Vs + 64 * 136 + wave * (16 * 72);
            const int r = lane & 15, g4 = lane >> 4;
            for (int u = blk; u < GB * 4 * 16; u += NBLK) {
                const int bl = u >> 6, h = (u >> 4) & 3, qt = u & 15; const size_t mb = (size_t)bl * SEQ; const int q0 = qt * 128;
                volatile LAS unsigned* FLG = (volatile LAS unsigned*)(lds + MISC_OFF + 128);
                int par = 0;
                __syncthreads();
                if (lane == 0) { FLG[wave] = 0u; FLG[8 + wave] = 0u; }
                for (int i = tid; i < 2048; i += NTHR) { const int s = i >> 4, c8 = i & 15; *(LAS u32x4*)(Qs + s * 136 + c8 * 8) = *(const u32x4*)(P + (mb + q0 + s) * PWS + P_SQ + h * 128 + c8 * 8); }
                f32x4 O[8];
#pragma unroll
                for (int d = 0; d < 8; ++d) O[d] = zero4();
                float racc = 0.f; const int tq = q0 + 16 * wave + r;
                u32x4 kreg[2], vreg[2];
                { const int s0f = (2 * qt + 1) * 64;
#pragma unroll
                  for (int k2 = 0; k2 < 2; ++k2) { const int i = tid + 512 * k2, s = i >> 4, c8 = i & 15; const bf16* pr = P + (mb + s0f + s) * PWS + h * 128 + c8 * 8; kreg[k2] = *(const u32x4*)(pr + P_SK); vreg[k2] = *(const u32x4*)(pr + P_SV); } }
                for (int kt = 2 * qt + 1; kt >= 0; --kt) {
                    const int s0 = kt * 64;
                    __syncthreads();
                    { unsigned alldone = 1u;
#pragma unroll
                      for (int w8 = 0; w8 < 8; ++w8) alldone &= FLG[par * 8 + w8];
                      if (__builtin_amdgcn_readfirstlane((int)alldone)) break; }
#pragma unroll
                    for (int k2 = 0; k2 < 2; ++k2) { const int i = tid + 512 * k2, s = i >> 4, c8 = i & 15; *(LAS u32x4*)(Ks + s * 136 + c8 * 8) = kreg[k2]; *(LAS u32x4*)(Vs + s * 136 + c8 * 8) = vreg[k2]; }
                    if (kt > 0) {
#pragma unroll
                        for (int k2 = 0; k2 < 2; ++k2) { const int i = tid + 512 * k2, s = i >> 4, c8 = i & 15; const bf16* pr = P + (mb + s0 - 64 + s) * PWS + h * 128 + c8 * 8; kreg[k2] = *(const u32x4*)(pr + P_SK); vreg[k2] = *(const u32x4*)(pr + P_SV); } }
                    __syncthreads();
                    if (s0 < q0 + 16 * wave + 15) {
                        f32x4 z[4];
#pragma unroll
                        for (int j = 0; j < 4; ++j) z[j] = zero4();
#pragma unroll
                        for (int ks = 0; ks < 4; ++ks) { const bf16x8 fq = frag_kc(Qs, 136, 16 * wave, 32 * ks, lane);
#pragma unroll
                            for (int j = 0; j < 4; ++j) z[j] = MFMA16(frag_kc(Ks, 136, 16 * j, 32 * ks, lane), fq, z[j]); }
                        float ls[4][4], x[4][4], tsum[4];
#pragma unroll
                        for (int j = 0; j < 4; ++j) { float tj = 0.f;
#pragma unroll
                            for (int i = 0; i < 4; ++i) { const int s = s0 + 16 * j + 4 * g4 + i; const float zz = z[j][i] * 0.08838834764831845f;
                                const float l1 = fminf(zz, 0.f) - __logf(1.f + __expf(-fabsf(zz)));
                                ls[j][i] = l1; x[j][i] = (s < tq) ? (l1 - zz) : 0.f; tj += x[j][i]; }
                            tsum[j] = tj; }
                        float above[4], tot[4];
#pragma unroll
                        for (int j = 0; j < 4; ++j) { const float y1 = __shfl_xor(tsum[j], 16), y2 = __shfl_xor(tsum[j], 32), y3 = __shfl_xor(tsum[j], 48);
                            tot[j] = tsum[j] + y1 + y2 + y3;
                            above[j] = (g4 == 0) ? (y1 + y2 + y3) : (g4 == 1) ? (y2 + y3) : (g4 == 2) ? y1 : 0.f; }
                        float hi = racc;
#pragma unroll
                        for (int j = 3; j >= 0; --j) { float run = hi + above[j]; float av[4];
#pragma unroll
                            for (int i = 3; i >= 0; --i) { const int s = s0 + 16 * j + 4 * g4 + i; av[i] = (s < tq) ? __expf(ls[j][i] + run) : 0.f; run += x[j][i]; }
                            *(LAS u32x2*)(Aw + r * 72 + 16 * j + 4 * g4) = (u32x2){pk2(av[0], av[1]), pk2(av[2], av[3])};
                            hi += tot[j]; }
                        racc = hi;
                        LDS_WAIT(); asm volatile("" ::: "memory");
#pragma unroll
                        for (int ks = 0; ks < 2; ++ks) { const bf16x8 fa = frag_kc(Aw, 72, 0, 32 * ks, lane);
#pragma unroll
                            for (int d = 0; d < 8; ++d) O[d] = MFMA16(fa, frag_ks(Vs, 136, 16 * d, 32 * ks, lane), O[d]); }
                    }
                    par ^= 1;
                    { const bool wd = __all(racc < -104.f); if (lane == 0) FLG[par * 8 + wave] = wd ? 1u : 0u; }
                }
#pragma unroll
                for (int d = 0; d < 8; ++d)
#pragma unroll
                    for (int i = 0; i < 4; ++i) YCAT[(mb + q0 + 16 * wave + 4 * g4 + i) * YW + 1536 + h * 128 + 16 * d + r] = (bf16)f2bf(O[d][i]);
            }
            }
            GRID_BAR();
        }

        REPS(PH_M1) if (IN(PH_M1)) {
            PHASE_BEGIN();
            constexpr int NUA = GB * 4 * NCH, NUC = GB * NCH;
            for (int u = blk; u < NUA + NUC; u += NBLK) {
                if (u < NUA) {
                    const int ua = u, bh = ua >> 5, c = ua & 31, bl = bh >> 2, h = bh & 3; const size_t m0 = (size_t)bl * SEQ + c * 64;
                    LAS bf16* VP = (LAS bf16*)lds; LAS bf16* WK = (LAS bf16*)(lds + 64 * 152 * 2);
                    float bLj = 0.f, gmj = -1e30f;
                    if (lane < 32) { bLj = SUMB[bh * 32 + lane]; gmj = SUMG[bh * 32 + lane]; }
                    float pa = bLj, pq = gmj + bLj;
#pragma unroll
                    for (int o = 1; o < 32; o <<= 1) { const float ta = __shfl_up(pa, o), tq = __shfl_up(pq, o); if (lane >= o) { pq = fmaxf(tq + pa, pq); pa = ta + pa; } }
                    const float mall = fmaxf(pa, pq);
                    const float mnew = __shfl(mall, c), mprev = (c == 0) ? 0.f : __shfl(mall, (c + 63) & 63);
                    const float bL = GBc[(m0 + 63) * 4 + h];
                    if (tid == 0) { MCAR[ua] = mprev; MNEW[ua] = mnew; MSC[ua] = __expf(bL + mprev - mnew); }
                    for (int i = tid; i < 1024; i += NTHR) { const int s = i >> 4, c8 = i & 15; *(LAS u32x4*)(VP + s * 152 + c8 * 8) = *(const u32x4*)(P + (m0 + s) * PWS + P_AV + h * 128 + c8 * 8); }
                    if (tid < 64) { *(LAS u32x4*)(VP + tid * 152 + 128) = uone4(); *(LAS u32x4*)(VP + tid * 152 + 136) = uzero4(); }
                    { const int s = tid >> 3, c8 = tid & 7; const float w = __expf(bL + GGc[(m0 + s) * 4 + h] - mnew);
                      *(LAS u32x4*)(WK + s * 72 + c8 * 8) = scale8(*(const u32x4*)(P + (m0 + s) * PWS + P_AK + h * 64 + c8 * 8), w); }
                    __syncthreads();
                    for (int ti = wave; ti < 36; ti += NWAVES) { const int mt = ti >> 2, nt = ti & 3; f32x4 acc = zero4();
#pragma unroll
                        for (int ks = 0; ks < 2; ++ks) acc = MFMA16(frag_ks(VP, 152, 16 * mt, 32 * ks, lane), frag_ks(WK, 72, 16 * nt, 32 * ks, lane), acc);
                        bf16* d = DC + (size_t)ua * 9216 + (16 * mt + 4 * (lane >> 4)) * 64 + 16 * nt + (lane & 15);
#pragma unroll
                        for (int i = 0; i < 4; ++i) d[i * 64] = (bf16)f2bf(acc[i]); }
                    __syncthreads();
                } else {
                    const int uc = u - NUA, bl = uc >> 5, c = uc & 31, hd = wave, gi = hd >> 2; const size_t m0 = (size_t)bl * SEQ + c * 64;
                    LAS bf16* XW = (LAS bf16*)(lds + hd * (64 * 72 * 2)); LAS bf16* BMs = (LAS bf16*)(lds + 8 * 64 * 72 * 2);
                    const float alast = ACB[(m0 + 63) * 8 + hd];
#pragma unroll
                    for (int k = 0; k < 8; ++k) { const int i = lane + 64 * k, s = i >> 3, c8 = i & 7; const float wd = __expf(alast - ACB[(m0 + s) * 8 + hd]) * DTB[(m0 + s) * 8 + hd];
                        *(LAS u32x4*)(XW + s * 72 + c8 * 8) = scale8(*(const u32x4*)(XBC + (m0 + s) * 1024 + hd * 64 + c8 * 8), wd); }
                    for (int i = tid; i < 2048; i += NTHR) { const int g2 = i >> 10, rem = i & 1023, s = rem >> 4, c8 = rem & 15;
                        *(LAS u32x4*)(BMs + g2 * (64 * 136) + s * 136 + c8 * 8) = *(const u32x4*)(XBC + (m0 + s) * 1024 + 512 + g2 * 128 + c8 * 8); }
                    __syncthreads();
                    const LAS bf16* BMg = BMs + gi * (64 * 136);
                    for (int pt = 0; pt < 4; ++pt) { f32x4 acc[8];
#pragma unroll
                        for (int n = 0; n < 8; ++n) acc[n] = zero4();
#pragma unroll
                        for (int ks = 0; ks < 2; ++ks) { const bf16x8 a = frag_ks(XW, 72, 16 * pt, 32 * ks, lane);
#pragma unroll
                            for (int n = 0; n < 8; ++n) acc[n] = MFMA16(a, frag_ks(BMg, 136, 16 * n, 32 * ks, lane), acc[n]); }
                        bf16* d = DH + ((size_t)(uc * 8 + hd) * 64 + 16 * pt + 4 * (lane >> 4)) * 128 + (lane & 15);
#pragma unroll
                        for (int n = 0; n < 8; ++n)
#pragma unroll
                            for (int i = 0; i < 4; ++i) d[i * 128 + 16 * n] = (bf16)f2bf(acc[n][i]); }
                    __syncthreads();
                }
            }
            GRID_BAR();
        }

        REPS(PH_M2) if (IN(PH_M2)) {
            PHASE_BEGIN();
            constexpr int NA = GB * 4 * 2304, NC = GB * 8 * 2048;
            for (int i = gt; i < NA + NC; i += NGT) {
                f32x4 st = zero4();
                if (i < NA) { const int bh = i / 2304, e = (i - bh * 2304) * 4; const bf16* dp = DC + (size_t)bh * NCH * 9216 + e; bf16* cp = CS + (size_t)bh * NCH * 9216 + e; const float* sp = MSC + (size_t)bh * NCH;
#pragma unroll 1
                    for (int c0 = 0; c0 < NCH; c0 += 4) { u32x2 dw[4]; float sc[4];
#pragma unroll
                        for (int k = 0; k < 4; ++k) { dw[k] = *(const u32x2*)(dp + (size_t)(c0 + k) * 9216); sc[k] = sp[c0 + k]; }
#pragma unroll
                        for (int k = 0; k < 4; ++k) { *(u32x2*)(cp + (size_t)(c0 + k) * 9216) = (u32x2){pk2(st.x, st.y), pk2(st.z, st.w)};
                            st = st * sc[k] + (f32x4){bf2f(dw[k].x & 0xffffu), bf2f(dw[k].x >> 16), bf2f(dw[k].y & 0xffffu), bf2f(dw[k].y >> 16)}; } }
                } else { const int j = i - NA, bhd = j >> 11, e = (j & 2047) * 4, bl = bhd >> 3, hd = bhd & 7;
                    const bf16* dp = DH + ((size_t)(bl * NCH) * 8 + hd) * 8192 + e; bf16* cp = HS + ((size_t)(bl * NCH) * 8 + hd) * 8192 + e; const float* ap = ACB + ((size_t)bl * SEQ + 63) * 8 + hd;
#pragma unroll 1
                    for (int c0 = 0; c0 < NCH; c0 += 4) { u32x2 dw[4]; float sc[4];
#pragma unroll
                        for (int k = 0; k < 4; ++k) { dw[k] = *(const u32x2*)(dp + (size_t)(c0 + k) * 8 * 8192); sc[k] = __expf(ap[(size_t)(c0 + k) * 64 * 8]); }
#pragma unroll
                        for (int k = 0; k < 4; ++k) { *(u32x2*)(cp + (size_t)(c0 + k) * 8 * 8192) = (u32x2){pk2(st.x, st.y), pk2(st.z, st.w)};
                            st = st * sc[k] + (f32x4){bf2f(dw[k].x & 0xffffu), bf2f(dw[k].x >> 16), bf2f(dw[k].y & 0xffffu), bf2f(dw[k].y >> 16)}; } }
                }
            }
            GRID_BAR();
        }

        REPS(PH_M3) if (IN(PH_M3)) {
            PHASE_BEGIN();
            constexpr int NUA = GB * 4 * NCH, NUC = 2 * GB * NCH;
            for (int u = blk; u < NUA + NUC; u += NBLK) {
                const int r = lane & 15, g4 = lane >> 4;
                if (u < NUA) {
                    const int ua = u, bh = ua >> 5, c = ua & 31, bl = bh >> 2, h = bh & 3; const size_t m0 = (size_t)bl * SEQ + c * 64;
                    LAS bf16* Qs = (LAS bf16*)lds; LAS bf16* Ks = Qs + 64 * 72; LAS bf16* VP = Ks + 64 * 72; LAS bf16* CST = VP + 64 * 152; LAS bf16* SMT = CST + 144 * 72; LAS bf16* AOT = SMT + 64 * 72;
                    LAS float* GS = (LAS float*)(AOT + 64 * 136);
                    LAS float* SSQ = GS + 256;
                    const float mcar = MCAR[ua];
                    { const int s = tid >> 3, c8 = tid & 7; const bf16* pr = P + (m0 + s) * PWS + h * 64 + c8 * 8;
                      *(LAS u32x4*)(Qs + s * 72 + c8 * 8) = *(const u32x4*)(pr + P_AQ); *(LAS u32x4*)(Ks + s * 72 + c8 * 8) = *(const u32x4*)(pr + P_AK); }
                    for (int i = tid; i < 1024; i += NTHR) { const int s = i >> 4, c8 = i & 15; const bf16* pr = P + (m0 + s) * PWS + h * 128 + c8 * 8;
                        *(LAS u32x4*)(VP + s * 152 + c8 * 8) = *(const u32x4*)(pr + P_AV); *(LAS u32x4*)(AOT + s * 136 + c8 * 8) = *(const u32x4*)(pr + P_AO); }
                    if (tid < 64) { *(LAS u32x4*)(VP + tid * 152 + 128) = uone4(); *(LAS u32x4*)(VP + tid * 152 + 136) = uzero4(); }
                    for (int i = tid; i < 1152; i += NTHR) { const int dv = i >> 3, c8 = i & 7; *(LAS u32x4*)(CST + dv * 72 + c8 * 8) = *(const u32x4*)(CS + (size_t)ua * 9216 + dv * 64 + c8 * 8); }
                    if (tid < 192) { const int arr = tid >> 6, s = tid & 63; const float* src = (arr == 0) ? GBc : (arr == 1) ? GGc : GMT; float v = src[(m0 + s) * 4 + h];
                        if (arr == 2) v = GBc[(m0 + s) * 4 + h] + fmaxf(mcar, v);
                        GS[arr * 64 + s] = v; }
                    __syncthreads();
#pragma unroll
                    for (int q2 = 0; q2 < 2; ++q2) { const int ti = 2 * wave + q2, tt = ti >> 2, st = ti & 3;
                        f32x4 acc = zero4();
                        if (st <= tt) {
#pragma unroll
                            for (int ks = 0; ks < 2; ++ks) acc = MFMA16(frag_kc(Qs, 72, 16 * tt, 32 * ks, lane), frag_kc(Ks, 72, 16 * st, 32 * ks, lane), acc);
                            const int s = 16 * st + r; const float gs = GS[64 + s];
#pragma unroll
                            for (int i = 0; i < 4; ++i) { const int t = 16 * tt + 4 * g4 + i; const float e = GS[t] - GS[128 + t] + gs;
                                acc[i] = (s <= t) ? acc[i] * 0.125f * __expf(e) : 0.f; }
                        }
                        *(LAS u32x2*)(SMT + (16 * st + r) * 72 + 16 * tt + 4 * g4) = (u32x2){pk2(acc[0], acc[1]), pk2(acc[2], acc[3])}; }
                    __syncthreads();
                    const int tt = wave & 3, half = wave >> 2;
                    f32x4 a1[5], a2[5];
#pragma unroll
                    for (int j = 0; j < 5; ++j) { a1[j] = zero4(); a2[j] = zero4(); }
#pragma unroll
                    for (int ks = 0; ks < 2; ++ks) { const bf16x8 fa1 = frag_ks(SMT, 72, 16 * tt, 32 * ks, lane), fa2 = frag_kc(Qs, 72, 16 * tt, 32 * ks, lane);
#pragma unroll
                        for (int j = 0; j < 5; ++j) { const int dvt = (j < 4) ? half * 4 + j : 8;
                            a1[j] = MFMA16(fa1, frag_ks(VP, 152, 16 * dvt, 32 * ks, lane), a1[j]);
                            a2[j] = MFMA16(fa2, frag_kc(CST, 72, 16 * dvt, 32 * ks, lane), a2[j]); } }
                    float hv[4][4], ssq[4];
#pragma unroll
                    for (int i = 0; i < 4; ++i) { const int t = 16 * tt + 4 * g4 + i; const float b = GS[t], mt = GS[128 + t];
                        const float is = 0.125f * __expf(b + mcar - mt);
                        float den = a1[4][i] + is * a2[4][i]; den = __shfl(den, lane & 48);
                        const float dn = __builtin_amdgcn_rcpf(fmaxf(fabsf(den), __expf(-mt))); float q = 0.f;
#pragma unroll
                        for (int j = 0; j < 4; ++j) { const float v = (a1[j][i] + is * a2[j][i]) * dn; hv[j][i] = v; q += v * v; }
                        q += __shfl_xor(q, 1); q += __shfl_xor(q, 2); q += __shfl_xor(q, 4); q += __shfl_xor(q, 8); ssq[i] = q; }
                    if (r == 0) {
#pragma unroll
                        for (int i = 0; i < 4; ++i) SSQ[half * 64 + 16 * tt + 4 * g4 + i] = ssq[i]; }
                    __syncthreads();
                    const float* ng = ka->in[I_ANG] + (size_t)l * 512 + h * 128;
#pragma unroll
                    for (int i = 0; i < 4; ++i) { const int t = 16 * tt + 4 * g4 + i; const float rstd = rsqrtf((SSQ[t] + SSQ[64 + t]) * (1.f / 128.f) + EPS);
#pragma unroll
                        for (int j = 0; j < 4; ++j) { const int dv = 16 * (half * 4 + j) + r; LAS bf16* op = AOT + t * 136 + dv;
                            *op = (bf16)f2bf(sigmoidf_(bf2f(*op)) * hv[j][i] * rstd * ng[dv]); } }
                    __syncthreads();
                    for (int i = tid; i < 1024; i += NTHR) { const int s = i >> 4, c8 = i & 15; *(u32x4*)(YCAT + (m0 + s) * YW + h * 128 + c8 * 8) = *(const LAS u32x4*)(AOT + s * 136 + c8 * 8); }
                    __syncthreads();
                } else {
                    const int uc2 = u - NUA, bl = uc2 >> 6, c = (uc2 >> 1) & 31, gi = uc2 & 1, hl = wave & 3, th = wave >> 2, hd = gi * 4 + hl; const size_t m0 = (size_t)bl * SEQ + c * 64;
                    LAS bf16* XHs = (LAS bf16*)lds;
                    LAS bf16* HTs = (LAS bf16*)(lds + 36864);
                    LAS bf16* BMg = (LAS bf16*)(lds + 36864 + 69632);
                    LAS bf16* MTt = (LAS bf16*)(lds + 36864 + 69632 + 17408 + wave * 3072);
                    LAS float* ADs = (LAS float*)(lds + 36864 + 69632 + 17408 + 24576);
                    const bf16* Xb = XBC + m0 * 1024;
                    for (int i = tid; i < 2048; i += NTHR) { const int h4 = i >> 9, rem = i & 511, s = rem >> 3, c8 = rem & 7;
                        *(LAS u32x4*)(XHs + h4 * (64 * 72) + s * 72 + c8 * 8) = *(const u32x4*)((Xb + gi * 256) + (unsigned)(s * 1024 + h4 * 64 + c8 * 8)); }
                    { const bf16* Hb = HS + (size_t)((bl * NCH + c) * 8 + gi * 4) * 8192;
                      for (int i = tid; i < 4096; i += NTHR) { const int h4 = i >> 10, rem = i & 1023, p = rem >> 4, c8 = rem & 15;
                        *(LAS u32x4*)(HTs + h4 * (64 * 136) + p * 136 + c8 * 8) = *(const u32x4*)(Hb + (unsigned)(h4 * 8192 + p * 128 + c8 * 8)); } }
                    for (int i = tid; i < 1024; i += NTHR) { const int s = i >> 4, c8 = i & 15; *(LAS u32x4*)(BMg + s * 136 + c8 * 8) = *(const u32x4*)((Xb + 512 + gi * 128) + (unsigned)(s * 1024 + c8 * 8)); }
                    { const int h4 = tid >> 7, arr = (tid >> 6) & 1, s = tid & 63; const float* src = arr ? DTB : ACB; ADs[tid] = (src + m0 * 8 + gi * 4)[(unsigned)(s * 8 + h4)]; }
                    const LAS bf16* XH = XHs + hl * (64 * 72); const LAS bf16* HT = HTs + hl * (64 * 136); const LAS float* AD = ADs + hl * 128;
                    const bf16* Cm = Xb + 768 + gi * 128; const bf16* Zp = P + m0 * PWS + P_CZ + hd * 64; const unsigned zlane = (unsigned)(4 * g4 * PWS + r), ylane = (unsigned)(4 * g4 * YW + r);
                    bf16* Yp = YCAT + m0 * YW + 1024 + hd * 64; float* Sp = SSQC + m0 * 8 + hd;
                    bf16x8 fcn[4];
#pragma unroll
                    for (int ks = 0; ks < 4; ++ks) fcn[ks] = gfrag_kc(Cm, 1024, 16 * th, 32 * ks, lane);
                    const float dsk = ka->in[I_CDSKIP][l * 8 + hd];
                    __syncthreads();
#pragma unroll 1
                    for (int k2 = 0; k2 < 2; ++k2) { const int tt = k2 ? 3 - th : th;
                        bf16x8 fcm[4]; unsigned short zc[4][4];
#pragma unroll
                        for (int ks = 0; ks < 4; ++ks) fcm[ks] = fcn[ks];
#pragma unroll
                        for (int p = 0; p < 4; ++p)
#pragma unroll
                            for (int i = 0; i < 4; ++i) zc[p][i] = (Zp + (size_t)(16 * tt + i) * PWS + 16 * p)[zlane];
#pragma unroll
                        for (int ks = 0; ks < 4; ++ks) fcn[ks] = gfrag_kc(Cm, 1024, 16 * (3 - th), 32 * ks, lane);
                        float at[4];
#pragma unroll
                        for (int i = 0; i < 4; ++i) at[i] = AD[16 * tt + 4 * g4 + i];
#pragma unroll 1
                        for (int st = 0; st <= tt; ++st) { f32x4 acc = zero4();
#pragma unroll
                            for (int ks = 0; ks < 4; ++ks) acc = MFMA16(fcm[ks], frag_kc(BMg, 136, 16 * st, 32 * ks, lane), acc);
                            const int s = 16 * st + r; const float as = AD[s], dts = AD[64 + s];
#pragma unroll
                            for (int i = 0; i < 4; ++i) { const int t = 16 * tt + 4 * g4 + i; acc[i] = (s <= t) ? acc[i] * __expf(at[i] - as) * dts : 0.f; if (s == t) acc[i] += dsk; }
                            *(LAS u32x2*)(MTt + (16 * st + r) * 24 + 4 * g4) = (u32x2){pk2(acc[0], acc[1]), pk2(acc[2], acc[3])}; }
                        if ((tt & 1) == 0) *(LAS u32x2*)(MTt + (16 * (tt + 1) + r) * 24 + 4 * g4) = (u32x2){uzero4().x, uzero4().y};
                        LDS_WAIT(); asm volatile("" ::: "memory");
                        f32x4 ad[4], ao[4];
#pragma unroll
                        for (int p = 0; p < 4; ++p) { ad[p] = zero4(); ao[p] = zero4(); }
#pragma unroll 1
                        for (int ks = 0; ks <= (tt >> 1); ++ks) { const bf16x8 fa = frag_ks(MTt, 24, 0, 32 * ks, lane);
#pragma unroll
                            for (int p = 0; p < 4; ++p) ad[p] = MFMA16(fa, frag_ks(XH, 72, 16 * p, 32 * ks, lane), ad[p]); }
#pragma unroll
                        for (int ks = 0; ks < 4; ++ks)
#pragma unroll
                            for (int p = 0; p < 4; ++p) ao[p] = MFMA16(fcm[ks], frag_kc(HT, 136, 16 * p, 32 * ks, lane), ao[p]);
#pragma unroll
                        for (int i = 0; i < 4; ++i) { const float ea = __expf(at[i]); float q = 0.f;
#pragma unroll
                            for (int p = 0; p < 4; ++p) { const float y = (ad[p][i] + ea * ao[p][i]) * siluf_(bf2f(zc[p][i])); q += y * y;
                                (Yp + (size_t)(16 * tt + i) * YW + 16 * p)[ylane] = (bf16)f2bf(y); }
                            q += __shfl_xor(q, 1); q += __shfl_xor(q, 2); q += __shfl_xor(q, 4); q += __shfl_xor(q, 8);
                            if (r == 0) (Sp + (16 * tt + i) * 8)[(unsigned)(32 * g4)] = q; }
                        LDS_WAIT(); asm volatile("" ::: "memory");
                    }
                    __syncthreads();
                }
            }
            GRID_BAR();
        }

        REPS(PH_LIFT) if (IN(PH_LIFT)) {
            PHASE_BEGIN();
            pg8::Gemm g{YCAT, WliftT, 512, YW, 512, (size_t)512 * 2, (size_t)DM * 512 * 2}; pg8::Order S; S.init(T, DM, NBLK, blk, 4);
            pg8::EpiLift E{FAC, MB + (size_t)(grp & 1) * T * DM, DM, SSQC};
            pg8::gemm_phase<pg8::EpiLift, GEMM_ALIGN>(lds, g, S, E);
            GRID_BAR();
        }
        REPS(PH_OUT) if (IN(PH_OUT) && (grp & 1)) {
            PHASE_BEGIN();
            const size_t prow0 = grow0 - T;
            pg8::Gemm g{MB, WoutT, DM, DM, DM, 0, 0}; pg8::Order S; S.init(2 * T, DM, NBLK, blk, 1);
            pg8::EpiResid E{XG + prow0 * DM, DM, SSQ2};
            pg8::gemm_phase<pg8::EpiResid, GEMM_ALIGN>(lds, g, S, E);
            GRID_BAR();
        }
        REPS(PH_UP) if (IN(PH_UP) && (grp & 1)) {
            PHASE_BEGIN();
            const size_t prow0 = grow0 - T;
            pg8::Gemm g{XG + prow0 * DM, WupT, DM, DM, DM, 0, 0}; pg8::Order S; S.init(2 * T, DFF2, NBLK, blk, 1);
            if (tid == 0) *(volatile LAS int*)(lds + 131072 + 12288 + 1024) = -1;
            pg8::EpiConvAct E{ACT, SSQ2, ka->in[I_FCW] + (size_t)l * 3 * DFF2, ka->in[I_FCB] + (size_t)l * DFF2, RAWH, lds + 131072, DFF2 / 256};
            pg8::gemm_phase<pg8::EpiConvAct, GEMM_ALIGN>(lds, g, S, E);
            GRID_BAR();
        }
        REPS(PH_DOWN) if (IN(PH_DOWN) && (grp & 1)) {
            PHASE_BEGIN();
            const size_t prow0 = grow0 - T;
            pg8::Gemm g{ACT, WdownT, DFF, 128, DFF, 0, 0, 65536, (size_t)22 * 65536}; pg8::Order S; S.init(2 * T, DM, NBLK, blk, 1);
            {
                const float* fw = ka->in[I_FCW] + (size_t)l * 3 * DFF2; const float* fb = ka->in[I_FCB] + (size_t)l * DFF2;
                pg8::Unit uu;
                for (int i = 0; S.next(i, uu); ++i) { const int pm = uu.pm; if ((pm & 7) == 0) continue;
                    for (int ch = tid; ch < DFF; ch += NTHR) { const int tp = ch >> 7, j = ch & 127;
                        const float* own = RAWH + (size_t)(pm * 22 + tp) * 1024; const float* prv = RAWH + (size_t)((pm - 1) * 22 + tp) * 1024;
                        const float g254 = prv[2 * 256 + j], g255 = prv[3 * 256 + j], g0 = own[j], g1 = own[256 + j];
                        const float u254 = prv[2 * 256 + 128 + j], u255 = prv[3 * 256 + 128 + j], u0 = own[128 + j], u1 = own[256 + 128 + j];
                        const float wg0 = fw[ch], wg1 = fw[DFF2 + ch], wg2 = fw[2 * DFF2 + ch], wu0 = fw[DFF + ch], wu1 = fw[DFF2 + DFF + ch], wu2 = fw[2 * DFF2 + DFF + ch], bg = fb[ch], bu = fb[DFF + ch];
                        ACT[((size_t)(pm * 22 + tp) * 256) * 128 + j] = (bf16)f2bf(siluf_(bg + wg0 * g254 + wg1 * g255 + wg2 * g0) * (bu + wu0 * u254 + wu1 * u255 + wu2 * u0));
                        ACT[((size_t)(pm * 22 + tp) * 256 + 1) * 128 + j] = (bf16)f2bf(siluf_(bg + wg0 * g255 + wg1 * g0 + wg2 * g1) * (bu + wu0 * u255 + wu1 * u0 + wu2 * u1)); } }
                asm volatile("s_waitcnt vmcnt(0)" ::: "memory"); __syncthreads();
            }
            pg8::EpiResid E{XG + prow0 * DM, DM, SSQ1 + prow0 * 16};
            pg8::gemm_phase<pg8::EpiResid, GEMM_ALIGN>(lds, g, S, E);
            GRID_BAR();
        }
        REPS(PH_FINAL) if (IN(PH_FINAL) && l == DEPTH - 1 && (grp & 1)) {
            PHASE_BEGIN();
            const size_t prow0 = grow0 - T;
            const float* gain = ka->in[I_FING];
            f32x4 gv[4];
#pragma unroll
            for (int j = 0; j < 4; ++j) gv[j] = ((const f32x4*)gain)[lane + 64 * j];
            for (int m = gw; m < 2 * T; m += NGW) {
                const u32x2* xr = (const u32x2*)(XG + (prow0 + m) * DM) + lane;
                f32x4 v[4]; float sq = 0.f;
#pragma unroll
                for (int j = 0; j < 4; ++j) { const u32x2 w = xr[64 * j]; v[j] = (f32x4){bf2f(w.x & 0xffffu), bf2f(w.x >> 16), bf2f(w.y & 0xffffu), bf2f(w.y >> 16)};
                    sq += (v[j].x * v[j].x + v[j].y * v[j].y) + (v[j].z * v[j].z + v[j].w * v[j].w); }
                const float rstd = rsqrtf(wave_sum(sq) * (1.f / DM) + EPS);
                f32x4* orow = (f32x4*)(ka->out + (prow0 + m) * DM) + lane;
#pragma unroll
                for (int j = 0; j < 4; ++j) orow[64 * j] = v[j] * rstd * gv[j];
            }
            GRID_BAR();
        }
    }
#undef IN
#undef GRID_BAR
#undef PHASE_BEGIN
}

#ifndef ONE_LAUNCH
#define ONE_LAUNCH 1
#endif
extern "C" void kernel_launch(void* const* d_in, const int* in_sizes, int n_in, void* d_out, int out_size, void* d_ws, size_t ws_size, hipStream_t stream) {
    static int grid = 0;
    if (grid == 0) {
        if (n_in != N_IN || in_sizes[0] != BATCH * SEQ * DM || out_size != BATCH * SEQ * DM || ws_size < WS_END) {
            fprintf(stderr, "kernel_launch: unexpected shapes / workspace (n_in %d, ws %zu, need %zu); nothing launched\n", n_in, ws_size, (size_t)WS_END); grid = -1; return; }
        int dev = 0, cus = 0, per_cu = 0;
        if (hipGetDevice(&dev) != hipSuccess || hipDeviceGetAttribute(&cus, hipDeviceAttributeMultiprocessorCount, dev) != hipSuccess) { grid = -1; return; }
        if (hipFuncSetAttribute((const void*)fwd, hipFuncAttributeMaxDynamicSharedMemorySize, LDS_BYTES) != hipSuccess) { fprintf(stderr, "kernel_launch: hipFuncSetAttribute failed\n"); grid = -1; return; }
        if (hipOccupancyMaxActiveBlocksPerMultiprocessor(&per_cu, (const void*)fwd, NTHR, LDS_BYTES) != hipSuccess || per_cu < 1) { fprintf(stderr, "kernel_launch: occupancy query says %d\n", per_cu); (void)hipGetLastError(); }
        grid = cus;
    }
    if (grid < 0) return;
    (void)hipMemsetAsync((char*)d_ws + WS_CTL, 0, CTL_BYTES, stream);
    Args a{};
    for (int i = 0; i < N_IN; ++i) a.in[i] = (const float*)d_in[i];
    a.out = (float*)d_out; a.ws = (unsigned char*)d_ws; a.pad = 0;
#if ONE_LAUNCH
    a.l_lo = 0; a.l_hi = DEPTH; a.g_lo = 0; a.g_hi = NG; a.ph_lo = 0; a.ph_hi = PH_COUNT; a.use_bar = 1;
    hipLaunchKernelGGL(fwd, dim3(grid), dim3(NTHR), LDS_BYTES, stream, a);
#else
    a.use_bar = 0;
    for (int l = 0; l < DEPTH; ++l)
        for (int g = 0; g < NG; ++g)
            for (int ph = 0; ph < PH_COUNT; ++ph) {
                if (ph == PH_W && g != 0) continue;
                if (ph == PH_FINAL && l != DEPTH - 1) continue;
                if ((ph == PH_OUT || ph == PH_UP || ph == PH_DOWN || ph == PH_FINAL) && !(g & 1)) continue;
                a.l_lo = l; a.l_hi = l + 1; a.g_lo = g; a.g_hi = g + 1; a.ph_lo = ph; a.ph_hi = ph + 1;
                hipLaunchKernelGGL(fwd, dim3(grid), dim3(NTHR), LDS_BYTES, stream, a);
            }
#endif
}
```

```cpp
#include <hip/hip_runtime.h>
#include <cstdio>
#include <cstdint>

#define LAS __attribute__((address_space(3)))
#define GAS __attribute__((address_space(1)))
typedef unsigned short bf16;
typedef short bf16x8 __attribute__((ext_vector_type(8)));
typedef short s16x4 __attribute__((ext_vector_type(4)));
typedef float f32x4 __attribute__((ext_vector_type(4)));
typedef float f32x2 __attribute__((ext_vector_type(2)));
typedef unsigned u32x4 __attribute__((ext_vector_type(4)));
typedef unsigned u32x2 __attribute__((ext_vector_type(2)));

constexpr int DM = 1024, BATCH = 32, SEQ = 2048, DEPTH = 4;
constexpr int PIN = 10256, PW = 10240, PWS = 6144, DFF = 2816, DFF2 = 5632;
constexpr int GB = 8;
constexpr int NG = BATCH / GB;
constexpr int T = GB * SEQ;
constexpr int NCH = SEQ / 64;
constexpr float EPS = 1e-6f;
constexpr int P_AQ = 0, P_AK = 256, P_AV = 512, P_AO = 1024, P_BB = 1536, P_BC = 2048, P_BX = 2560, P_CZ = 3072, P_CX = 3584, P_SQ = 4608, P_SK = 5120, P_SV = 5632, P_G = 6144;
constexpr int YW = 2048;

constexpr size_t MiB = 1u << 20;
constexpr size_t WS_CTL = 0, CTL_BYTES = 1 * MiB;
constexpr size_t WS_WIN = 1 * MiB;
constexpr size_t WS_WLIFT = WS_WIN + (size_t)PW * DM * 2;
constexpr size_t WS_WOUT = WS_WLIFT + (size_t)4 * DM * 512 * 2;
constexpr size_t WS_WUP = WS_WOUT + (size_t)DM * DM * 2;
constexpr size_t WS_WDOWN = WS_WUP + (size_t)DFF2 * DM * 2;
constexpr size_t WS_W16 = WS_WDOWN + (size_t)DM * DFF * 2;
constexpr size_t WS_XN = WS_W16 + 65536;
constexpr size_t WS_P = WS_XN + (size_t)T * DM * 2;
constexpr size_t WS_U = WS_P, WS_ACT = WS_P;
constexpr size_t WS_YCAT = WS_P + (size_t)T * PW * 2;
constexpr size_t WS_XG = WS_YCAT + (size_t)T * YW * 2;
constexpr size_t WS_MB = WS_XG + (size_t)BATCH * SEQ * DM * 2;
constexpr size_t WS_SP = WS_MB + (size_t)2 * T * DM * 2;
constexpr size_t WS_GB = WS_SP + (size_t)T * 16 * 4;
constexpr size_t WS_GG = WS_GB + (size_t)T * 16;
constexpr size_t WS_GMT = WS_GG + (size_t)T * 16;
constexpr size_t WS_MCAR = WS_GMT + (size_t)T * 16;
constexpr size_t WS_MNEW = WS_MCAR + 4096;
constexpr size_t WS_MSC = WS_MNEW + 4096;
constexpr size_t WS_SUMB = WS_MSC + 4096, WS_SUMG = WS_SUMB + 4096;
constexpr size_t WS_DT = WS_SUMG + 4096;
constexpr size_t WS_AC = WS_DT + (size_t)T * 32;
constexpr size_t WS_XBC = WS_AC + (size_t)T * 32;
constexpr size_t WS_DC = WS_XBC + (size_t)T * DM * 2;
constexpr size_t WS_CS = WS_DC + (size_t)GB * 4 * NCH * 9216 * 4;
constexpr size_t WS_DH = WS_CS + (size_t)GB * 4 * NCH * 9216 * 2;
constexpr size_t WS_HS = WS_DH + (size_t)GB * NCH * 8 * 8192 * 4;
constexpr size_t WS_SSQ1 = WS_HS + (size_t)GB * NCH * 8 * 8192 * 2;
constexpr size_t WS_SSQ2 = WS_SSQ1 + (size_t)BATCH * SEQ * 64;
constexpr size_t WS_SSQC = WS_SSQ2 + (size_t)2 * T * 64;
constexpr size_t WS_RAWH = WS_SSQC + (size_t)T * 32;
constexpr size_t WS_END = WS_RAWH + (size_t)(2 * T / 256) * 22 * 4 * 256 * 4;

constexpr int NWAVES = 8, NTHR = 512;
constexpr int LDS_BYTES = 155648;
constexpr int MISC_OFF = 153600;

__device__ __forceinline__ float bf2f(unsigned b) { return __uint_as_float(b << 16); }
__device__ __forceinline__ unsigned f2bf(float f) { unsigned u = __float_as_uint(f); return (u + 0x7fffu + ((u >> 16) & 1u)) >> 16; }
__device__ __forceinline__ unsigned pk2(float lo, float hi) { return f2bf(lo) | (f2bf(hi) << 16); }
__device__ __forceinline__ float sigmoidf_(float x) { return __builtin_amdgcn_rcpf(1.f + __builtin_amdgcn_exp2f(-1.4426950408889634f * x)); }
__device__ __forceinline__ float siluf_(float x) { return x * __builtin_amdgcn_rcpf(1.f + __builtin_amdgcn_exp2f(-1.4426950408889634f * x)); }
__device__ __forceinline__ float logsigf_(float x) { return fminf(x, 0.f) - log1pf(expf(-fabsf(x))); }
__device__ __forceinline__ float softplusf_(float x) { return fmaxf(x, 0.f) + log1pf(expf(-fabsf(x))); }
__device__ __forceinline__ float wave_sum(float v) {
#pragma unroll
    for (int o = 1; o < 64; o <<= 1) v += __shfl_xor(v, o);
    return v;
}
#define LDS_WAIT() asm volatile("s_waitcnt lgkmcnt(0)" ::: "memory")
__device__ __forceinline__ float row_rstd(const float* ssq16) {
    const f32x4* p = (const f32x4*)ssq16; const f32x4 a = (p[0] + p[1]) + (p[2] + p[3]);
    return rsqrtf(((a.x + a.y) + (a.z + a.w)) * (1.f / 1024.f) + 1e-6f);
}

namespace pg8 {
constexpr int BM = 256, BK = 64, HALF = 128, HTB = HALF * BK * 2, STAGE_BYTES = 8 * HTB, NXCD = 8, WGM = 4;
__host__ __device__ __forceinline__ int lds_byte(int r, int c) { const int st = (r >> 4) * 2 + (c >> 5), rr = r & 15, cc = c & 31, ob = rr * 64 + cc * 2; return st * 1024 + (ob ^ (((ob >> 9) & 1) << 5)); }
__host__ __device__ __forceinline__ void stage_rc(int b, int& R, int& C) { const int st = b / 1024, sb = b % 1024, swz = sb ^ (((sb >> 9) & 1) << 5); R = (st >> 1) * 16 + swz / 64; C = (st & 1) * 32 + (swz % 64) / 2; }
__host__ __device__ __forceinline__ int perm32(int rho) { const int n = rho >> 4, i = rho & 15; return 8 * (i >> 2) + 4 * n + (i & 3); }

struct Unit { int pm, pn, z; };
struct Gemm { const bf16* A; const bf16* Bt; int K, lda, ldb; size_t zA, zB; size_t ablk = 256, atile = 0; };

struct Order {
    int nM, nN, nwg, G, c, Z;
    __device__ __forceinline__ void init(int M, int N, int G_, int c_, int Z_) { nM = M / BM; nN = N / BM; nwg = nM * nN; G = G_; c = c_; Z = Z_; }
    __device__ __forceinline__ bool next(int i, Unit& u) const {
        const int ti = i / Z; u.z = i - ti * Z;
        const long L = (long)ti * G + c; if (L >= nwg) return false;
        int wgid = (int)L; { const int q = nwg / NXCD, r = nwg % NXCD, xcd = wgid % NXCD, off = wgid / NXCD; wgid = (xcd < r ? xcd * (q + 1) : r * (q + 1) + (xcd - r) * q) + off; }
        const int nig = WGM * nN, gid = wgid / nig, fm = gid * WGM, gsz = (nM - fm) < WGM ? (nM - fm) : WGM;
        u.pm = fm + ((wgid % nig) % gsz); u.pn = (wgid % nig) / gsz; return true;
    }
};
__device__ __forceinline__ unsigned cvt_pk_bf16(float lo, float hi) { unsigned r; asm volatile("s_nop 0\n\tv_cvt_pk_bf16_f32 %0, %1, %2" : "=v"(r) : "v"(lo), "v"(hi)); return r; }

__device__ __forceinline__ void panel_rstd(LAS float* rsl, const float* ssq, int pm, int wr, int wc, int fr, int fq) {
    volatile LAS int* tag = (volatile LAS int*)(rsl + 256);
    if (__builtin_amdgcn_readfirstlane(*tag) != pm) {
        const int tidl = (wr * 4 + wc) * 64 + fq * 16 + fr, rr = tidl >> 1, hf = tidl & 1;
        const f32x4* p = (const f32x4*)(ssq + (size_t)(pm * BM + rr) * 16 + hf * 8); const f32x4 a = p[0] + p[1];
        float sq = (a.x + a.y) + (a.z + a.w); sq += __shfl_xor(sq, 1);
        __builtin_amdgcn_s_barrier();
        if (hf == 0) rsl[rr] = rsqrtf(sq * (1.f / 1024.f) + 1e-6f);
        if (tidl == 0) *tag = pm;
        asm volatile("s_waitcnt lgkmcnt(0)" ::: "memory"); __builtin_amdgcn_s_barrier(); asm volatile("" ::: "memory");
    }
}
struct EpiBf16 {
    static constexpr int MIN_STORES = 16;
    static constexpr bool PERM = true, KEEP = false, CONTIG = true;
    LAS float* rsl;
    bf16* O; int ldc; const float* ssq; int gate_pn0; bf16* fac;
    static __device__ __forceinline__ float s1(float x) { return 1.f + __builtin_amdgcn_exp2f(-1.4426950408889634f * __builtin_amdgcn_fmed3f(x, -30.f, 30.f)); }
    __device__ __forceinline__ void operator()(f32x4 (&acc)[2][2][4][2], const Unit& u, int wr, int wc, int fr, int fq) const {
        panel_rstd(rsl, ssq, u.pm, wr, wc, fr, fq);
        if (u.pn >= gate_pn0) {
            const int row0g = u.pm * BM + wr * 64 + fr, d0 = 64 * (u.pn - gate_pn0) + 16 * wc + 4 * fq;
#pragma unroll
            for (int ai = 0; ai < 2; ++ai)
#pragma unroll
                for (int m = 0; m < 4; ++m) {
                    const float rs = rsl[wr * 64 + fr + ai * HALF + m * 16];
                    const int cc = d0 & 255, pnL = d0 >> 8, bjL = cc >> 7, wcL = (cc >> 5) & 3, fqL = (cc >> 3) & 3, nL = (cc >> 2) & 1;
                    bf16* rowp = fac + ((((((size_t)(u.pm * 4 + pnL) * 4) * 16 + (ai * 4 + m) * 2 + bjL) * 8 + (wr * 4 + wcL)) * 64 + fqL * 16 + fr) * 8 + nL * 4);
                    const size_t zstep = (size_t)16 * 8 * 512;
                    float one = 1.f; asm volatile("" : "+v"(one));
                    float f0[4], f1[4], f2[4], f3[4];
#pragma unroll
                    for (int e = 0; e < 4; ++e) { const float a0 = s1(acc[ai][0][m][0][e] * rs), a1 = s1(acc[ai][0][m][1][e] * rs), a2 = s1(acc[ai][1][m][0][e] * rs), a3 = s1(acc[ai][1][m][1][e] * rs);
                        f0[e] = a1 * __builtin_amdgcn_rcpf(a0); f1[e] = a2 * __builtin_amdgcn_rcpf(a1); f2[e] = a3 * __builtin_amdgcn_rcpf(a2); f3[e] = one * __builtin_amdgcn_rcpf(a3); }
                    *(u32x2*)(rowp) = (u32x2){cvt_pk_bf16(f0[0], f0[1]), cvt_pk_bf16(f0[2], f0[3])};
                    *(u32x2*)(rowp + zstep) = (u32x2){cvt_pk_bf16(f1[0], f1[1]), cvt_pk_bf16(f1[2], f1[3])};
                    *(u32x2*)(rowp + 2 * zstep) = (u32x2){cvt_pk_bf16(f2[0], f2[1]), cvt_pk_bf16(f2[2], f2[3])};
                    *(u32x2*)(rowp + 3 * zstep) = (u32x2){cvt_pk_bf16(f3[0], f3[1]), cvt_pk_bf16(f3[2], f3[3])}; }
            return; }
        const int row0 = u.pm * BM + wr * 64 + fr, col0 = u.pn * BM + wc * 64 + 8 * fq;
#pragma unroll
        for (int ai = 0; ai < 2; ++ai)
#pragma unroll
            for (int m = 0; m < 4; ++m) { const int row = row0 + ai * HALF + m * 16; bf16* rowp = O + (size_t)row * ldc + col0;
                const float rs = rsl[wr * 64 + fr + ai * HALF + m * 16];
#pragma unroll
                for (int bj = 0; bj < 2; ++bj) { const f32x4 v0 = acc[ai][bj][m][0] * rs, v1 = acc[ai][bj][m][1] * rs;
                    u32x4 w; w.x = cvt_pk_bf16(v0[0], v0[1]); w.y = cvt_pk_bf16(v0[2], v0[3]); w.z = cvt_pk_bf16(v1[0], v1[1]); w.w = cvt_pk_bf16(v1[2], v1[3]);
                    *(u32x4*)(rowp + bj * 32) = w; } }
    }
};
struct EpiResid {
    static constexpr int MIN_STORES = 16;
    static constexpr bool PERM = true, KEEP = false, CONTIG = true;
    bf16* xb; int ldc; float* ssq;
    __device__ __forceinline__ void operator()(f32x4 (&acc)[2][2][4][2], const Unit& u, int wr, int wc, int fr, int fq) const {
        const int row0 = u.pm * BM + wr * 64 + fr, col0 = u.pn * BM + wc * 64 + 8 * fq;
#pragma unroll
        for (int ai = 0; ai < 2; ++ai)
#pragma unroll
            for (int m = 0; m < 4; ++m) { const int row = row0 + ai * HALF + m * 16; const size_t off = (size_t)row * ldc + col0; float q = 0.f;
#pragma unroll
                for (int bj = 0; bj < 2; ++bj) {
                    const u32x4 o = *(const u32x4*)(xb + off + bj * 32);
                    const f32x4 x0 = (f32x4){bf2f(o.x & 0xffffu), bf2f(o.x >> 16), bf2f(o.y & 0xffffu), bf2f(o.y >> 16)} + acc[ai][bj][m][0];
                    const f32x4 x1 = (f32x4){bf2f(o.z & 0xffffu), bf2f(o.z >> 16), bf2f(o.w & 0xffffu), bf2f(o.w >> 16)} + acc[ai][bj][m][1];
                    q += (x0[0] * x0[0] + x0[1] * x0[1]) + (x0[2] * x0[2] + x0[3] * x0[3]) + (x1[0] * x1[0] + x1[1] * x1[1]) + (x1[2] * x1[2] + x1[3] * x1[3]);
                    u32x4 w; w.x = cvt_pk_bf16(x0[0], x0[1]); w.y = cvt_pk_bf16(x0[2], x0[3]); w.z = cvt_pk_bf16(x1[0], x1[1]); w.w = cvt_pk_bf16(x1[2], x1[3]);
                    *(u32x4*)(xb + off + bj * 32) = w; }
                q += __shfl_xor(q, 16); q += __shfl_xor(q, 32); if (fq == 0) ssq[(size_t)row * 16 + u.pn * 4 + wc] = q;
            }
    }
};
struct EpiLift {
    static constexpr int MIN_STORES = 0;
    static constexpr bool PERM = true, KEEP = true, CONTIG = false;
    const bf16* fac; bf16* mb; int ldc; const float* ssqc;
    __device__ __forceinline__ void operator()(f32x4 (&acc)[2][2][4][2], const Unit& u, int wr, int wc, int fr, int fq) const {
        const int row0 = u.pm * BM + wr * 64 + fr, col0 = u.pn * BM + wc * 32 + 8 * fq;
#pragma unroll
        for (int ai = 0; ai < 2; ++ai)
#pragma unroll
            for (int m = 0; m < 4; ++m) { const int row = row0 + ai * HALF + m * 16;
                float rsc = 1.f;
                if (u.z == 1 || u.z == 2) { const f32x2 p = *(const f32x2*)(ssqc + (size_t)row * 8 + 2 * fq); float sq = p.x + p.y; sq += __shfl_xor(sq, 16); sq += __shfl_xor(sq, 32);
                    const float v = sq * (1.f / 512.f) + 1e-6f; rsc = (u.z == 1) ? sqrtf(v) : rsqrtf(v); }
#pragma unroll
                for (int bj = 0; bj < 2; ++bj) { const int col = col0 + bj * HALF;
                    const u32x4 g0 = *(const u32x4*)(fac + (((((size_t)(u.pm * 4 + u.pn) * 4 + u.z) * 16 + (ai * 4 + m) * 2 + bj) * 8 + (wr * 4 + wc)) * 64 + fq * 16 + fr) * 8);
                    f32x4& v0 = acc[ai][bj][m][0]; f32x4& v1 = acc[ai][bj][m][1];
                    v0[0] *= rsc * bf2f(g0.x & 0xffffu); v0[1] *= rsc * bf2f(g0.x >> 16); v0[2] *= rsc * bf2f(g0.y & 0xffffu); v0[3] *= rsc * bf2f(g0.y >> 16);
                    v1[0] *= rsc * bf2f(g0.z & 0xffffu); v1[1] *= rsc * bf2f(g0.z >> 16); v1[2] *= rsc * bf2f(g0.w & 0xffffu); v1[3] *= rsc * bf2f(g0.w >> 16);
                    if (u.z == 3) { u32x4 w; w.x = cvt_pk_bf16(v0[0], v0[1]); w.y = cvt_pk_bf16(v0[2], v0[3]); w.z = cvt_pk_bf16(v1[0], v1[1]); w.w = cvt_pk_bf16(v1[2], v1[3]);
                        *(u32x4*)(mb + (size_t)row * ldc + col) = w; } } }
    }
};

__device__ __forceinline__ float dpp_ror1(float x) { return __int_as_float(__builtin_amdgcn_update_dpp(0, __float_as_int(x), 0x121, 0xf, 0xf, false)); }
__device__ __forceinline__ float dpp_ror2(float x) { return __int_as_float(__builtin_amdgcn_update_dpp(0, __float_as_int(x), 0x122, 0xf, 0xf, false)); }
__device__ __forceinline__ float dpp_shr1(float x) { return __int_as_float(__builtin_amdgcn_update_dpp(0, __float_as_int(x), 0x111, 0xf, 0xf, true)); }
__device__ __forceinline__ float dpp_shr2(float x) { return __int_as_float(__builtin_amdgcn_update_dpp(0, __float_as_int(x), 0x112, 0xf, 0xf, true)); }
__device__ __forceinline__ float dpp_prev1(float cur, float prev) { return __int_as_float(__builtin_amdgcn_update_dpp(__builtin_amdgcn_update_dpp(0, __float_as_int(prev), 0x121, 0xf, 0xf, false), __float_as_int(cur), 0x111, 0xf, 0xf, false)); }
__device__ __forceinline__ float dpp_prev2(float cur, float prev) { return __int_as_float(__builtin_amdgcn_update_dpp(__builtin_amdgcn_update_dpp(0, __float_as_int(prev), 0x122, 0xf, 0xf, false), __float_as_int(cur), 0x112, 0xf, 0xf, false)); }
struct EpiConvAct {
    static constexpr int MIN_STORES = 12;
    static constexpr bool PERM = true, KEEP = false, CONTIG = false;
    bf16* act; const float* ssq; const float* cw; const float* cb; float* rawh; LAS unsigned char* halo; int ntn;
    __device__ __forceinline__ void operator()(f32x4 (&acc)[2][2][4][2], const Unit& u, int wr, int wc, int fr, int fq) const {
        asm volatile("" : "+v"(fr), "+v"(fq));
        const int row0 = u.pm * BM + wr * 64 + fr, ch0 = u.pn * 128 + wc * 32 + 8 * fq;
        LAS float* rsl = (LAS float*)(halo + 12288);
        LAS float* WL = (LAS float*)(halo + 8192);
        const int wl_i2 = ((wr * 4 + wc) * 64 + fq * 16 + fr) * 2;
        f32x2 wlv;
        { const int kind = wl_i2 >> 7, c = wl_i2 & 127, k4 = kind & 3; const float* src = (k4 < 3 ? cw + k4 * 5632 : cb) + (kind >= 4 ? 2816 : 0) + u.pn * 128 + c; wlv = *(const f32x2*)src; }
        panel_rstd(rsl, ssq, u.pm, wr, wc, fr, fq);
#pragma unroll
        for (int ai = 0; ai < 2; ++ai)
#pragma unroll
            for (int m = 0; m < 4; ++m) { const float rs = rsl[wr * 64 + fr + ai * HALF + m * 16];
#pragma unroll
                for (int bj = 0; bj < 2; ++bj) { acc[ai][bj][m][0] = acc[ai][bj][m][0] * rs; acc[ai][bj][m][1] = acc[ai][bj][m][1] * rs; } }
        LAS f32x4* H = (LAS f32x4*)halo;
        if (fr >= 14) {
#pragma unroll
            for (int ai = 0; ai < 2; ++ai) { const int b = 2 * ai + wr;
#pragma unroll
                for (int bj = 0; bj < 2; ++bj)
#pragma unroll
                    for (int n = 0; n < 2; ++n) H[((((b * 4 + wc) * 4 + fq) * 2 + (fr - 14)) * 2 + bj) * 2 + n] = acc[ai][bj][3][n]; } }
        { float* rw = rawh + (size_t)(u.pm * ntn + u.pn) * 1024;
          if (wr == 1 && fr >= 14) {
#pragma unroll
            for (int bj = 0; bj < 2; ++bj)
#pragma unroll
                for (int n = 0; n < 2; ++n) *(f32x4*)(rw + (2 + fr - 14) * 256 + bj * HALF + wc * 32 + 8 * fq + 4 * n) = acc[1][bj][3][n]; }
          if (wr == 0 && fr < 2) {
#pragma unroll
            for (int bj = 0; bj < 2; ++bj)
#pragma unroll
                for (int n = 0; n < 2; ++n) *(f32x4*)(rw + fr * 256 + bj * HALF + wc * 32 + 8 * fq + 4 * n) = acc[0][bj][0][n]; } }
        *(LAS f32x2*)(WL + wl_i2) = wlv;
        asm volatile("s_waitcnt lgkmcnt(0)" ::: "memory"); __builtin_amdgcn_s_barrier(); asm volatile("" ::: "memory");
        bf16* actb = act + ((size_t)(u.pm * ntn + u.pn) * BM + wr * 64) * 128 + wc * 32;
        const unsigned alane = (unsigned)(fr * 128 + 8 * fq);
        const float lm1 = (fr == 0) ? 1.f : 0.f, lm2 = (fr < 2) ? 1.f : 0.f;
        unsigned pkw[2][4][3];
#pragma unroll
        for (int n = 0; n < 2; ++n) {
#pragma unroll
            for (int eh = 0; eh < 2; ++eh) {
                const int cl = wc * 32 + 8 * fq + 4 * n + 2 * eh;
                f32x2 wg[3], wu[3], bg, bu;
#pragma unroll
                for (int j = 0; j < 3; ++j) { wg[j] = *(const LAS f32x2*)(WL + j * 128 + cl); wu[j] = *(const LAS f32x2*)(WL + (4 + j) * 128 + cl); }
                bg = *(const LAS f32x2*)(WL + 3 * 128 + cl); bu = *(const LAS f32x2*)(WL + 7 * 128 + cl);
                f32x2 wg1m = wg[1] * lm1, wg0m = wg[0] * lm2, wu1m = wu[1] * lm1, wu0m = wu[0] * lm2;
                asm volatile("" : "+v"(wg1m), "+v"(wg0m), "+v"(wu1m), "+v"(wu0m));
#pragma unroll
                for (int ai = 0; ai < 2; ++ai) { const int b = 2 * ai + wr;
#pragma unroll
                    for (int m = 3; m >= 0; --m) {
                        float r2[2];
#pragma unroll
                        for (int e2 = 0; e2 < 2; ++e2) { const int e = 2 * eh + e2;
                            const float gc = acc[ai][0][m][n][e], uc = acc[ai][1][m][n][e];
                            float gp = 0.f, up = 0.f; asm volatile("" : "+v"(gp), "+v"(up));
                            if (m > 0) { gp = acc[ai][0][m - 1][n][e]; up = acc[ai][1][m - 1][n][e]; }
                            else if (b >= 1) { const int fk = fr >= 14 ? fr - 14 : 0; const LAS float* hp = (const LAS float*)(H + ((((b - 1) * 4 + wc) * 4 + fq) * 2 + fk) * 4 + n); gp = hp[e]; up = hp[8 + e]; }
                            float vg = fmaf(wg[2][e2], gc, bg[e2]), vu = fmaf(wu[2][e2], uc, bu[e2]);
                            asm volatile("s_nop 1\n\t"
                                         "v_fmac_f32_dpp %0, %2, %4 row_shr:1 row_mask:0xf bank_mask:0xf bound_ctrl:0\n\t"
                                         "v_fmac_f32_dpp %1, %3, %5 row_shr:1 row_mask:0xf bank_mask:0xf bound_ctrl:0\n\t"
                                         "v_fmac_f32_dpp %0, %2, %6 row_shr:2 row_mask:0xf bank_mask:0xf bound_ctrl:0\n\t"
                                         "v_fmac_f32_dpp %1, %3, %7 row_shr:2 row_mask:0xf bank_mask:0xf bound_ctrl:0\n\t"
                                         "v_fmac_f32_dpp %0, %8, %10 row_ror:1 row_mask:0xf bank_mask:0xf\n\t"
                                         "v_fmac_f32_dpp %1, %9, %11 row_ror:1 row_mask:0xf bank_mask:0xf\n\t"
                                         "v_fmac_f32_dpp %0, %8, %12 row_ror:2 row_mask:0xf bank_mask:0xf\n\t"
                                         "v_fmac_f32_dpp %1, %9, %13 row_ror:2 row_mask:0xf bank_mask:0xf"
                                         : "+v"(vg), "+v"(vu)
                                         : "v"(gc), "v"(uc), "v"(wg[1][e2]), "v"(wu[1][e2]), "v"(wg[0][e2]), "v"(wu[0][e2]), "v"(gp), "v"(up), "v"(wg1m[e2]), "v"(wu1m[e2]), "v"(wg0m[e2]), "v"(wu0m[e2]));
                            r2[e2] = siluf_(vg) * vu; }
                        const unsigned pk = cvt_pk_bf16(r2[0], r2[1]);
                        if (2 * n + eh < 3) pkw[ai][m][2 * n + eh] = pk;
                        else *(u32x4*)(actb + (size_t)(ai * HALF + m * 16) * 128 + alane) = (u32x4){pkw[ai][m][0], pkw[ai][m][1], pkw[ai][m][2], pk};
                    }
                }
            }
        }
    }
};

template <class Epi, bool ALIGN_EPI = true>
__device__ __forceinline__ void gemm_phase(LAS unsigned char* lds, const Gemm g, const Order& S, const Epi& E) {
    int tid = threadIdx.x; asm volatile("" : "+v"(tid));
    const int wid = __builtin_amdgcn_readfirstlane(tid >> 6), lane = tid & 63, wr = wid >> 2, wc = wid & 3, fr = lane & 15, fq = lane >> 4;
    const int K = g.K, nt = K / BK;
    unsigned voffA[2], voffB[2];
#pragma unroll
    for (int i = 0; i < 2; ++i) { int R, C; stage_rc(tid * 16 + i * 8192, R, C);
        const int Rb = Epi::CONTIG ? (64 * (R >> 5) + perm32(R & 31)) : (Epi::PERM ? ((R & ~31) + perm32(R & 31)) : R);
        voffA[i] = (unsigned)(R * g.lda + C) * 2u; voffB[i] = (unsigned)(Rb * g.ldb + C) * 2u; }
    const size_t kstep = (size_t)(BK * 2);
    const size_t hstepA = (size_t)HALF * g.lda * 2, hstepB = (size_t)(Epi::CONTIG ? 32 : HALF) * g.ldb * 2;
    const size_t tstepA = g.atile ? g.atile : 2 * hstepA, tstepB = (size_t)BM * g.ldb * 2;
    const unsigned ldsw = (unsigned)wid * 1024u;
    const int aoff = lds_byte(wr * 64 + fr, fq * 8), boff = lds_byte(wc * 32 + fr, fq * 8);
#define PG8_SA(b, h) (((b) * 2 + (h)) * HTB)
#define PG8_SB(b, h) ((4 + (b) * 2 + (h)) * HTB)
#define PG8_STAGE(bufoff, gbase, voff) do { _Pragma("unroll") for (int _i = 0; _i < 2; ++_i) \
        __builtin_amdgcn_global_load_lds((const unsigned*)((const char*)(gbase) + (voff)[_i]), (LAS unsigned*)(lds + (bufoff) + ldsw + _i * 8192), 16, 0, 0); } while (0)
#define PG8_LDA(dst, b, h) do { _Pragma("unroll") for (int m = 0; m < 4; ++m) _Pragma("unroll") for (int k = 0; k < 2; ++k) dst[m][k] = *(const LAS bf16x8*)(lds + PG8_SA(b, h) + aoff + m * 2048 + k * 1024); } while (0)
#define PG8_LDB(dst, b, h) do { _Pragma("unroll") for (int n = 0; n < 2; ++n) _Pragma("unroll") for (int k = 0; k < 2; ++k) dst[n][k] = *(const LAS bf16x8*)(lds + PG8_SB(b, h) + boff + n * 2048 + k * 1024); } while (0)
#define PG8_MMA(ai, bj, At, Bt) do { __builtin_amdgcn_s_setprio(1); _Pragma("unroll") for (int m = 0; m < 4; ++m) _Pragma("unroll") for (int n = 0; n < 2; ++n) _Pragma("unroll") for (int k = 0; k < 2; ++k) \
        acc[ai][bj][m][n] = __builtin_amdgcn_mfma_f32_16x16x32_bf16(Bt[n][k], At[m][k], acc[ai][bj][m][n], 0, 0, 0); __builtin_amdgcn_s_setprio(0); } while (0)
#define PG8_WAIT_V(n) asm volatile("s_waitcnt vmcnt(" #n ")" ::: "memory")
#define PG8_WAIT_L(n) asm volatile("s_waitcnt lgkmcnt(" #n ")" ::: "memory")
#define PG8_WAIT_V8R(r) asm volatile("s_cmp_lg_u32 %0, 0\n\ts_cbranch_scc0 .Lw8_%=\n\ts_waitcnt vmcnt(%1)\n\ts_branch .Lwd_%=\n.Lw8_%=:\n\ts_waitcnt vmcnt(8)\n.Lwd_%=:" :: "s"(__builtin_amdgcn_readfirstlane(r)), "n"(8 + Epi::MIN_STORES) : "memory", "scc")
#define PG8_BAR __builtin_amdgcn_s_barrier()
#define PG8_SCHED __builtin_amdgcn_sched_barrier(0)
    Unit cur, nxt; int ui = 0;
    if (!S.next(0, cur)) return;
    f32x4 acc[2][2][4][2];
#pragma unroll
    for (int a = 0; a < 2; ++a)
#pragma unroll
        for (int b = 0; b < 2; ++b)
#pragma unroll
            for (int m = 0; m < 4; ++m)
#pragma unroll
                for (int n = 0; n < 2; ++n) acc[a][b][m][n] = (f32x4){0.f, 0.f, 0.f, 0.f};
    bf16x8 At[4][2], B0[2][2], B1[2][2];
    const char* cA = (const char*)g.A + (size_t)cur.pm * tstepA + (size_t)cur.z * g.zA; const char* cB = (const char*)g.Bt + (size_t)cur.pn * tstepB + (size_t)cur.z * g.zB;
    PG8_STAGE(PG8_SB(0, 0), cB, voffB); PG8_STAGE(PG8_SB(0, 1), cB + hstepB, voffB); PG8_STAGE(PG8_SA(0, 0), cA, voffA); PG8_STAGE(PG8_SA(0, 1), cA + hstepA, voffA);
    if (wr == 1) PG8_BAR;
    PG8_WAIT_V(2); PG8_BAR;
    PG8_STAGE(PG8_SB(1, 0), cB + kstep, voffB); PG8_STAGE(PG8_SA(1, 0), cA + kstep, voffA); PG8_STAGE(PG8_SB(1, 1), cB + hstepB + kstep, voffB);
    PG8_WAIT_V(6); PG8_BAR;
    for (;;) {
        const bool has_next = S.next(ui + 1, nxt);
        const char* nA = has_next ? (const char*)g.A + (size_t)nxt.pm * tstepA + (size_t)nxt.z * g.zA : cA; const char* nB = has_next ? (const char*)g.Bt + (size_t)nxt.pn * tstepB + (size_t)nxt.z * g.zB : cB;
        for (int t = 0; t < nt; t += 2) {
            const bool last = (t == nt - 2);
            const char* a1 = cA + (size_t)(t >> 1) * g.ablk + kstep;
            const char* a2 = last ? nA : cA + (size_t)((t >> 1) + 1) * g.ablk; const char* b2 = last ? nB : cB + (size_t)(t + 2) * kstep;
            const char* a3 = a2 + kstep; const char* b3 = b2 + kstep;
            const int relax = ((t == 0) && (ui > 0)) ? 1 : 0; (void)relax;
            PG8_LDB(B0, 0, 0); PG8_LDB(B1, 0, 1); PG8_SCHED; PG8_LDA(At, 0, 0); PG8_STAGE(PG8_SA(1, 1), a1 + hstepA, voffA);
            if constexpr (Epi::MIN_STORES > 0) PG8_WAIT_V8R(relax); else PG8_WAIT_V(8);
            PG8_WAIT_L(0); PG8_BAR; PG8_MMA(0, 0, At, B0); PG8_MMA(0, 1, At, B1); PG8_BAR; PG8_SCHED;
            PG8_LDA(At, 0, 1); PG8_STAGE(PG8_SB(0, 0), b2, voffB); PG8_STAGE(PG8_SB(0, 1), b2 + hstepB, voffB); PG8_STAGE(PG8_SA(0, 0), a2, voffA);
            if constexpr (Epi::MIN_STORES > 0) PG8_WAIT_V8R(relax); else PG8_WAIT_V(8);
            PG8_WAIT_L(0); PG8_BAR; PG8_MMA(1, 0, At, B0); PG8_MMA(1, 1, At, B1); PG8_BAR; PG8_SCHED;
            PG8_LDB(B0, 1, 0); PG8_LDB(B1, 1, 1); PG8_SCHED; PG8_LDA(At, 1, 0); PG8_STAGE(PG8_SA(0, 1), a2 + hstepA, voffA);
            PG8_WAIT_V(8); PG8_WAIT_L(0); PG8_BAR; PG8_MMA(0, 0, At, B0); PG8_MMA(0, 1, At, B1); PG8_BAR; PG8_SCHED;
            PG8_LDA(At, 1, 1); PG8_STAGE(PG8_SB(1, 0), b3, voffB); PG8_STAGE(PG8_SB(1, 1), b3 + hstepB, voffB); PG8_STAGE(PG8_SA(1, 0), a3, voffA);
            PG8_WAIT_V(8); PG8_WAIT_L(0); PG8_BAR; PG8_MMA(1, 0, At, B0); PG8_MMA(1, 1, At, B1); PG8_BAR; PG8_SCHED;
        }
        if constexpr (ALIGN_EPI) { if (wr == 0) PG8_BAR; }
        E(acc, cur, wr, wc, fr, fq);
        if (!has_next) break;
        if (!(Epi::KEEP && nxt.z != 0))
#pragma unroll
        for (int a = 0; a < 2; ++a)
#pragma unroll
            for (int b = 0; b < 2; ++b)
#pragma unroll
                for (int m = 0; m < 4; ++m)
#pragma unroll
                    for (int n = 0; n < 2; ++n) acc[a][b][m][n] = (f32x4){0.f, 0.f, 0.f, 0.f};
        cur = nxt; cA = nA; cB = nB; ++ui;
        if constexpr (ALIGN_EPI) { if (wr == 1) PG8_BAR; }
    }
    PG8_WAIT_V(0);
    if constexpr (!ALIGN_EPI) { if (wr == 0) PG8_BAR; }
    PG8_BAR;
#undef PG8_SA
#undef PG8_SB
#undef PG8_STAGE
#undef PG8_LDA
#undef PG8_LDB
#undef PG8_MMA
#undef PG8_WAIT_V
#undef PG8_WAIT_L
#undef PG8_WAIT_V8R
#undef PG8_BAR
#undef PG8_SCHED
}
}

#define XB_TMO      128
#define XB_XCNT(j)  (256  + 64 * (j))
#define XB_XSUB(j)  (1280 + 64 * (j))
#define XB_XGEN(j)  (2304 + 64 * (j))
#define XB_TOP      3328
#define XB_TOPGEN   3392
#define XCD_BAR_WORDS 3456
#define XB_SPIN_CAP (1u << 18)
__device__ __forceinline__ unsigned xb_ld(unsigned* p)              { return __hip_atomic_load(p, __ATOMIC_RELAXED, __HIP_MEMORY_SCOPE_AGENT); }
__device__ __forceinline__ unsigned xb_add(unsigned* p, unsigned v) { return __hip_atomic_fetch_add(p, v, __ATOMIC_RELAXED, __HIP_MEMORY_SCOPE_AGENT); }
__device__ __forceinline__ unsigned xb_xcc_id() { return (unsigned)__builtin_amdgcn_s_getreg((3 << 11) | 20) & 0xFu; }
#define XB_SPIN(cond, bar) do { unsigned _sp = 0; while (cond) { __builtin_amdgcn_s_sleep(1); \
    if ((++_sp & 255u) == 0u) { if (xb_ld(&(bar)[XB_TMO])) break; if (_sp > XB_SPIN_CAP) { atomicAdd(&(bar)[XB_TMO], 1u); break; } } } } while (0)
struct XcdBarrier { unsigned* bar; unsigned x; volatile LAS unsigned* st; };
__device__ __forceinline__ XcdBarrier xcd_barrier_post(unsigned* bar, volatile LAS unsigned* st) {
    XcdBarrier b; b.bar = bar; b.x = xb_xcc_id(); b.st = st;
    if (threadIdx.x == 0) (void)xb_add(&bar[XB_XCNT(b.x)], 1u);
    return b;
}
__device__ __forceinline__ void xcd_barrier_complete(unsigned* bar, unsigned x, unsigned& nloc, unsigned& nx) {
    const unsigned G = gridDim.x * gridDim.y * gridDim.z;
    unsigned sum, cnt, mine, sp = 0u;
    for (;;) {
        sum = 0u; cnt = 0u; mine = 0u;
#pragma unroll
        for (unsigned j = 0; j < 16; ++j) { const unsigned c = xb_ld(&bar[XB_XCNT(j)]); sum += c; cnt += (c > 0u) ? 1u : 0u; mine = (j == x) ? c : mine; }
        if (sum == G) break;
        __builtin_amdgcn_s_sleep(1);
        if ((++sp & 255u) == 0u) { if (xb_ld(&bar[XB_TMO])) break; if (sp > XB_SPIN_CAP) { atomicAdd(&bar[XB_TMO], 1u); break; } }
    }
    nloc = mine > 0u ? mine : 1u; nx = cnt > 0u ? cnt : 1u;
}
__device__ __forceinline__ void xcd_barrier(const XcdBarrier& b) {
    asm volatile("s_waitcnt vmcnt(0)" ::: "memory");
    __syncthreads();
    if (threadIdx.x == 0) {
        unsigned* bar = b.bar;
        __builtin_amdgcn_s_waitcnt(0);
        unsigned nloc = b.st[0], nx = b.st[1];
        if (nloc == 0u) { xcd_barrier_complete(bar, b.x, nloc, nx); b.st[0] = nloc; b.st[1] = nx; }
        const unsigned old = xb_add(&bar[XB_XSUB(b.x)], 1u);
        const unsigned gen = old / nloc;
        if (old + 1u == (gen + 1u) * nloc) {
            __builtin_amdgcn_fence(__ATOMIC_RELEASE, "agent");
            asm volatile("s_waitcnt vmcnt(0)" ::: "memory");
            const unsigned og = xb_add(&bar[XB_TOP], 1u);
            const unsigned tg = og / nx;
            if (og + 1u == (tg + 1u) * nx) xb_add(&bar[XB_TOPGEN], 1u);
            else XB_SPIN(xb_ld(&bar[XB_TOPGEN]) == tg, bar);
            __builtin_amdgcn_fence(__ATOMIC_ACQUIRE, "agent");
            xb_add(&bar[XB_XGEN(b.x)], 1u);
            asm volatile("s_waitcnt vmcnt(0)" ::: "memory");
        } else {
            XB_SPIN(xb_ld(&bar[XB_XGEN(b.x)]) == gen, bar);
            __builtin_amdgcn_fence(__ATOMIC_ACQUIRE, "agent");
            asm volatile("s_waitcnt vmcnt(0)" ::: "memory");
        }
    }
    __syncthreads();
}

__device__ __forceinline__ bf16x8 frag_kc(const LAS bf16* X, int ld, int mn0, int k0, int lane) { return *(const LAS bf16x8*)(X + (mn0 + (lane & 15)) * ld + k0 + 8 * (lane >> 4)); }
__device__ __forceinline__ bf16x8 gfrag_kc(const bf16* X, int ld, int mn0, int k0, int lane) { const bf16* b = X + (size_t)mn0 * ld + k0; const unsigned lo = (unsigned)((lane & 15) * ld + 8 * (lane >> 4)); return *(const bf16x8*)(b + lo); }
__device__ __forceinline__ s16x4 trr(const LAS bf16* p) { return __builtin_bit_cast(s16x4, __builtin_amdgcn_ds_read_tr16_b64_v4i16((LAS s16x4*)p)); }
__device__ __forceinline__ bf16x8 frag_ks(const LAS bf16* X, int ld, int mn0, int k0, int lane) {
    const int r = lane & 15, g = lane >> 4;
    const LAS bf16* p = X + (k0 + 8 * g + (r >> 2)) * ld + mn0 + 4 * (r & 3);
    const s16x4 lo = trr(p), hi = trr(p + 4 * ld);
    return (bf16x8){lo[0], lo[1], lo[2], lo[3], hi[0], hi[1], hi[2], hi[3]};
}
__device__ __forceinline__ f32x4 zero4() { f32x4 z = {0.f, 0.f, 0.f, 0.f}; asm volatile("" : "+v"(z)); return z; }
__device__ __forceinline__ u32x4 uone4() { u32x4 z = {0x3F80u, 0u, 0u, 0u}; asm volatile("" : "+v"(z)); return z; }
__device__ __forceinline__ u32x4 uzero4() { u32x4 z = {0u, 0u, 0u, 0u}; asm volatile("" : "+v"(z)); return z; }
#define MFMA16(a, b, c) __builtin_amdgcn_mfma_f32_16x16x32_bf16((a), (b), (c), 0, 0, 0)
__device__ __forceinline__ u32x4 scale8(u32x4 w, float s) {
    u32x4 o;
    o.x = pk2(bf2f(w.x & 0xffffu) * s, bf2f(w.x >> 16) * s); o.y = pk2(bf2f(w.y & 0xffffu) * s, bf2f(w.y >> 16) * s);
    o.z = pk2(bf2f(w.z & 0xffffu) * s, bf2f(w.z >> 16) * s); o.w = pk2(bf2f(w.w & 0xffffu) * s, bf2f(w.w >> 16) * s);
    return o;
}
__device__ __forceinline__ float wscan_add(float v, int lane) {
#pragma unroll
    for (int o = 1; o < 64; o <<= 1) { const float t = __shfl_up(v, o); if (lane >= o) v += t; }
    return v;
}
__device__ __forceinline__ float wscan_max(float v, int lane) {
#pragma unroll
    for (int o = 1; o < 64; o <<= 1) { const float t = __shfl_up(v, o); if (lane >= o) v = fmaxf(v, t); }
    return v;
}

#ifndef GEMM_ALIGN
#define GEMM_ALIGN true
#endif
enum { PH_W = 0, PH_INPROJ, PH_M0, PH_M1, PH_M2, PH_M3, PH_LIFT, PH_OUT, PH_UP, PH_DOWN, PH_FINAL, PH_COUNT };
enum { I_X = 0, I_MIXG, I_WIN, I_AIB, I_AFB, I_ANG, I_BCW, I_CCW, I_CCB, I_CDTB, I_CALOG, I_CDSKIP, I_CNG, I_WLIFT, I_WOUT, I_FFNG, I_WUP, I_FCW, I_FCB, I_WDOWN, I_FING, N_IN };
struct Args { const float* in[N_IN]; float* out; unsigned char* ws; int l_lo, l_hi, g_lo, g_hi, ph_lo, ph_hi, use_bar, pad; };

__device__ __forceinline__ void transpose_item(const float* W, int ldw, int nsrc0, int k0, bf16* WT, int ldt, int ndst0, LAS float* scr, int lane, const float* kscale = nullptr, int gate_tile = -1) {
    int scol = nsrc0 + (lane & 31);
    if (gate_tile >= 0) {
        const int c = (ndst0 & 255) + (lane & 31), wc = c >> 6, bj = (c >> 5) & 1, fq = (c >> 3) & 3, n = (c >> 2) & 1, e = c & 3;
        scol = 6160 + (2 * bj + n) * 1024 + 64 * gate_tile + 16 * wc + 4 * fq + e; }
#pragma unroll 8
    for (int i = 0; i < 32; ++i) { const int kk = 2 * i + (lane >> 5); scr[kk * 33 + (lane & 31)] = W[(size_t)(k0 + kk) * ldw + scol] * (kscale ? kscale[k0 + kk] : 1.f); }
    LDS_WAIT(); asm volatile("" ::: "memory");
    const int c = lane & 7;
#pragma unroll
    for (int j = 0; j < 4; ++j) { const int n = (lane >> 3) + 8 * j; const LAS float* s = scr + (8 * c) * 33 + n;
        u32x4 o; o.x = pk2(s[0 * 33], s[1 * 33]); o.y = pk2(s[2 * 33], s[3 * 33]); o.z = pk2(s[4 * 33], s[5 * 33]); o.w = pk2(s[6 * 33], s[7 * 33]);
        *(u32x4*)(WT + (size_t)(ndst0 + n) * ldt + k0 + 8 * c) = o; }
    LDS_WAIT(); asm volatile("" ::: "memory");
}

__global__ void __launch_bounds__(NTHR, 2) fwd(Args args) {
    extern __shared__ __attribute__((aligned(16))) unsigned char lds_raw[];
    LAS unsigned char* lds = (LAS unsigned char*)lds_raw;
    const int NBLK = gridDim.x, blk = blockIdx.x;
    {
        volatile LAS unsigned* MISC0 = (volatile LAS unsigned*)(lds + MISC_OFF);
        if (threadIdx.x < 16) MISC0[threadIdx.x] = 0u;
        __syncthreads();
    }
    XcdBarrier bar; bar.bar = (unsigned*)(args.ws + WS_CTL) + 4096; bar.x = 0; bar.st = nullptr;
    if (args.use_bar) bar = xcd_barrier_post((unsigned*)(args.ws + WS_CTL) + 4096, (volatile LAS unsigned*)(lds + MISC_OFF) + 8);
#define GRID_BAR() do { if (args.use_bar) xcd_barrier(bar); } while (0)
#ifndef REPMASK
#define REPMASK 0
#endif
#define IN(k) (args.ph_lo <= (k) && (k) < args.ph_hi)
#define REPS(k) for (int rep_ = 0; rep_ < 1 + ((REPMASK >> (k)) & 1); ++rep_)
#define PHASE_BEGIN() int tid = threadIdx.x; asm volatile("" : "+v"(tid)); const int lane = tid & 63, wave = __builtin_amdgcn_readfirstlane(tid >> 6); \
    const __attribute__((address_space(4))) Args* ka = (const __attribute__((address_space(4))) Args*)__builtin_amdgcn_kernarg_segment_ptr(); asm volatile("" : "+s"(ka)); \
    unsigned char* ws = ka->ws; \
    const size_t grow0 = (size_t)grp * T; const float* xsrc = (l == 0) ? ka->in[I_X] : ka->out; (void)grow0; (void)xsrc; \
    const int gw = blk * NWAVES + wave, NGW = NBLK * NWAVES, gt = blk * NTHR + tid, NGT = NBLK * NTHR; (void)lane; (void)gw; (void)NGW; (void)gt; (void)NGT; \
    bf16* const WinT = (bf16*)(ws + WS_WIN); bf16* const WliftT = (bf16*)(ws + WS_WLIFT); bf16* const WoutT = (bf16*)(ws + WS_WOUT); \
    bf16* const WupT = (bf16*)(ws + WS_WUP); bf16* const WdownT = (bf16*)(ws + WS_WDOWN); bf16* const W16B = (bf16*)(ws + WS_W16); \
    bf16* const XN = (bf16*)(ws + WS_XN); bf16* const P = (bf16*)(ws + WS_P); bf16* const FAC = (bf16*)(ws + WS_P) + (size_t)T * PWS; (void)FAC; bf16* const U = (bf16*)(ws + WS_U); bf16* const ACT = (bf16*)(ws + WS_ACT); \
    bf16* const YCAT = (bf16*)(ws + WS_YCAT); bf16* const XG = (bf16*)(ws + WS_XG); bf16* const MB = (bf16*)(ws + WS_MB); float* const SP = (float*)(ws + WS_SP); \
    float* const SSQ1 = (float*)(ws + WS_SSQ1); float* const SSQ2 = (float*)(ws + WS_SSQ2); float* const SSQC = (float*)(ws + WS_SSQC); float* const RAWH = (float*)(ws + WS_RAWH); (void)SSQ1; (void)SSQ2; (void)SSQC; (void)RAWH; \
    float* const GBc = (float*)(ws + WS_GB); float* const GGc = (float*)(ws + WS_GG); float* const GMT = (float*)(ws + WS_GMT); \
    float* const MCAR = (float*)(ws + WS_MCAR); float* const MNEW = (float*)(ws + WS_MNEW); float* const MSC = (float*)(ws + WS_MSC); float* const SUMB = (float*)(ws + WS_SUMB); float* const SUMG = (float*)(ws + WS_SUMG); (void)SUMB; (void)SUMG; \
    float* const DTB = (float*)(ws + WS_DT); float* const ACB = (float*)(ws + WS_AC); bf16* const XBC = (bf16*)(ws + WS_XBC); \
    bf16* const DC = (bf16*)(ws + WS_DC); bf16* const CS = (bf16*)(ws + WS_CS); bf16* const DH = (bf16*)(ws + WS_DH); bf16* const HS = (bf16*)(ws + WS_HS); \
    (void)WinT; (void)WliftT; (void)WoutT; (void)WupT; (void)WdownT; (void)W16B; (void)XN; (void)P; (void)U; (void)ACT; (void)YCAT; (void)XG; (void)MB; (void)SP; (void)GBc; (void)GGc; (void)GMT; \
    (void)MCAR; (void)MNEW; (void)MSC; (void)DTB; (void)ACB; (void)XBC; (void)DC; (void)CS; (void)DH; (void)HS

    for (int l = args.l_lo; l < args.l_hi; ++l)
    for (int grp = args.g_lo; grp < args.g_hi; ++grp) {

        REPS(PH_W) if (IN(PH_W) && grp == 0) {
            PHASE_BEGIN();
            LAS float* scr = (LAS float*)(lds + wave * 16384);
            constexpr int I_IN = 16 * 320, I_LF = 4 * 8 * 32, I_OUT = 16 * 32, I_UP = 16 * 176, I_DN = 44 * 32, NIT = I_IN + I_LF + I_OUT + I_UP + I_DN;
            for (int it = gw; it < NIT; it += NGW) {
                int r = it;
                if (r < I_IN) { const int kb = r / 320, nb = r % 320, n0 = 32 * nb, ns = n0 + (n0 >= P_SQ ? 16 : (n0 >= P_BB ? 8 : 0));
                    transpose_item(ka->in[I_WIN] + (size_t)l * DM * PIN, PIN, ns, 64 * kb, WinT, DM, n0, scr, lane, ka->in[I_MIXG] + (size_t)l * DM, n0 >= P_G ? (n0 - P_G) >> 8 : -1); continue; } r -= I_IN;
                if (r < I_LF) { const int br = r / 256, q = r % 256, kb = q / 32, nb = q % 32;
                    transpose_item(ka->in[I_WLIFT] + (size_t)(l * 4 + br) * 512 * DM, DM, 32 * nb, 64 * kb, WliftT + (size_t)br * DM * 512, 512, 32 * nb, scr, lane, br == 2 ? ka->in[I_CNG] + (size_t)l * 512 : nullptr); continue; } r -= I_LF;
                if (r < I_OUT) { const int kb = r / 32, nb = r % 32;
                    transpose_item(ka->in[I_WOUT] + (size_t)l * DM * DM, DM, 32 * nb, 64 * kb, WoutT, DM, 32 * nb, scr, lane); continue; } r -= I_OUT;
                if (r < I_UP) { const int kb = r / 176, nb = r % 176, n0 = 32 * nb, tp = n0 >> 8, j = n0 & 255, ns = (j < 128) ? 128 * tp + j : 2816 + 128 * tp + (j - 128);
                    transpose_item(ka->in[I_WUP] + (size_t)l * DM * DFF2, DFF2, ns, 64 * kb, WupT, DM, n0, scr, lane, ka->in[I_FFNG] + (size_t)l * DM); continue; } r -= I_UP;
                { const int kb = r / 32, nb = r % 32;
                    transpose_item(ka->in[I_WDOWN] + (size_t)l * DFF * DM, DM, 32 * nb, 64 * kb, WdownT, DFF, 32 * nb, scr, lane); }
            }
            for (int i = gt; i < 16 * DM; i += NGT) { const int c = i >> 10, k = i & 1023; const int oc = (c < 8) ? (1536 + c) : (4616 + (c - 8));
                const float w = ka->in[I_WIN][(size_t)l * DM * PIN + (size_t)k * PIN + oc] * ka->in[I_MIXG][(size_t)l * DM + k]; const unsigned hi = f2bf(w);
                W16B[i] = (bf16)hi; W16B[16 * DM + i] = (bf16)f2bf(w - bf2f(hi)); }
            if (l == 0) {
                for (int m = gw; m < BATCH * SEQ; m += NGW) {
                    const f32x4* xr = (const f32x4*)(ka->in[I_X] + (size_t)m * DM) + lane;
                    f32x4 v[4]; float sq = 0.f;
#pragma unroll
                    for (int j = 0; j < 4; ++j) { v[j] = xr[64 * j]; sq += (v[j].x * v[j].x + v[j].y * v[j].y) + (v[j].z * v[j].z + v[j].w * v[j].w); }
                    sq = wave_sum(sq); if (lane < 16) SSQ1[(size_t)m * 16 + lane] = (lane == 0) ? sq : 0.f;
                    u32x2* o8 = (u32x2*)(XG + (size_t)m * DM) + lane;
#pragma unroll
                    for (int j = 0; j < 4; ++j) o8[64 * j] = (u32x2){pk2(v[j].x, v[j].y), pk2(v[j].z, v[j].w)};
                }
            }
            GRID_BAR();
        }

        REPS(PH_INPROJ) if (IN(PH_INPROJ)) {
            PHASE_BEGIN();
            const bf16* XGg = XG + grow0 * DM; const float* ssq = SSQ1 + grow0 * 16;
            if (tid == 0) *(volatile LAS int*)(lds + 143360 + 1024) = -1;
            for (int rb = blk; rb < T / 64; rb += NBLK) {
                const int r0 = rb * 64 + 16 * (wave & 3), kh = (wave >> 2) * 512; f32x4 acc = zero4(), acc2 = zero4();
#pragma unroll 8
                for (int ks = 0; ks < 16; ++ks) { const bf16x8 a = gfrag_kc(XGg, DM, r0, kh + 32 * ks, lane);
                    acc = MFMA16(a, gfrag_kc(W16B, DM, 0, kh + 32 * ks, lane), acc); acc2 = MFMA16(a, gfrag_kc(W16B + 16 * DM, DM, 0, kh + 32 * ks, lane), acc2); }
                acc += acc2;
                LAS f32x4* xch = (LAS f32x4*)lds;
                if (wave >= 4) xch[(wave - 4) * 64 + lane] = acc;
                __syncthreads();
                if (wave < 4) { acc += xch[wave * 64 + lane];
#pragma unroll
                    for (int i = 0; i < 4; ++i) { const int row = r0 + 4 * (lane >> 4) + i; SP[(size_t)row * 16 + (lane & 15)] = acc[i] * row_rstd(ssq + (size_t)row * 16); } }
                __syncthreads();
            }
            pg8::Gemm g{XGg, WinT, DM, DM, DM, 0, 0}; pg8::Order S; S.init(T, PW, NBLK, blk, 1);
            pg8::EpiBf16 E{(LAS float*)(lds + 143360), P, PWS, ssq, P_G / 256, FAC};
            pg8::gemm_phase<pg8::EpiBf16, GEMM_ALIGN>(lds, g, S, E);
            GRID_BAR();
        }

        REPS(PH_M0) if (IN(PH_M0)) {
            PHASE_BEGIN();
#pragma unroll 1
            for (int pass = 0; pass < 2; ++pass) {
            if ((pass ^ (blk & 1)) == 0) {
            for (int task = gw; task < GB * 4 * NCH; task += NGW) {
                const int bh = task >> 5, c = task & 31, bl = bh >> 2, h = bh & 3;
                const size_t m = (size_t)bl * SEQ + c * 64 + lane;
                const float ig = SP[m * 16 + h] + ka->in[I_AIB][l * 4 + h], fg = SP[m * 16 + 4 + h] + ka->in[I_AFB][l * 4 + h];
                const float b = wscan_add(logsigf_(fg), lane);
                const float gg = ig - b;
                const float pm = wscan_max(gg, lane);
                GBc[m * 4 + h] = b; GGc[m * 4 + h] = gg; GMT[m * 4 + h] = pm;
                if (lane == 63) { SUMB[task] = b; SUMG[task] = pm; }
            }
            for (int task = gw; task < GB * NCH * 8; task += NGW) {
                const int hd = task & 7; const size_t m = (size_t)(task >> 3) * 64 + lane;
                const float dt = softplusf_(SP[m * 16 + 8 + hd] + ka->in[I_CDTB][l * 8 + hd]);
                const float a = wscan_add(-dt * __expf(ka->in[I_CALOG][l * 8 + hd]), lane);
                DTB[m * 8 + hd] = dt; ACB[m * 8 + hd] = a;
            }
            {
                const float* cw = ka->in[I_CCW] + (size_t)l * 4 * 1024; const float* cb = ka->in[I_CCB] + (size_t)l * 1024;
                constexpr int RUN = 16;
                for (int i = gt; i < (T / RUN) * 128; i += NGT) {
                    const int rb = i >> 7, c8 = (i & 127) * 8, m0 = rb * RUN, t0 = m0 & (SEQ - 1);
                    float w[4][8], bb[8];
#pragma unroll
                    for (int e = 0; e < 8; ++e) { bb[e] = cb[c8 + e];
#pragma unroll
                        for (int j = 0; j < 4; ++j) w[j][e] = cw[j * 1024 + c8 + e]; }
                    const u32x4 zz = uzero4(); u32x4 win[4]; win[0] = zz; win[1] = zz; win[2] = zz;
                    if (t0 >= 3) { const bf16* pr = P + (size_t)(m0 - 3) * PWS + P_CX + c8; win[0] = *(const u32x4*)pr; win[1] = *(const u32x4*)(pr + PWS); win[2] = *(const u32x4*)(pr + 2 * PWS); }
#pragma unroll 4
                    for (int rr = 0; rr < RUN; ++rr) {
                        win[3] = *(const u32x4*)(P + (size_t)(m0 + rr) * PWS + P_CX + c8);
                        float acc[8];
#pragma unroll
                        for (int e = 0; e < 8; ++e) acc[e] = bb[e];
#pragma unroll
                        for (int j = 0; j < 4; ++j) {
                            acc[0] += w[j][0] * bf2f(win[j].x & 0xffffu); acc[1] += w[j][1] * bf2f(win[j].x >> 16); acc[2] += w[j][2] * bf2f(win[j].y & 0xffffu); acc[3] += w[j][3] * bf2f(win[j].y >> 16);
                            acc[4] += w[j][4] * bf2f(win[j].z & 0xffffu); acc[5] += w[j][5] * bf2f(win[j].z >> 16); acc[6] += w[j][6] * bf2f(win[j].w & 0xffffu); acc[7] += w[j][7] * bf2f(win[j].w >> 16); }
                        u32x4 o; o.x = pk2(siluf_(acc[0]), siluf_(acc[1])); o.y = pk2(siluf_(acc[2]), siluf_(acc[3])); o.z = pk2(siluf_(acc[4]), siluf_(acc[5])); o.w = pk2(siluf_(acc[6]), siluf_(acc[7]));
                        *(u32x4*)(XBC + (size_t)(m0 + rr) * 1024 + c8) = o;
                        win[0] = win[1]; win[1] = win[2]; win[2] = win[3];
                    }
                }
            }
            {
                const float* bw = ka->in[I_BCW] + (size_t)l * 3 * 512;
                constexpr int RUN = 16;
                for (int i = gt; i < (T / RUN) * 64; i += NGT) {
                    const int rb = i >> 6, c8 = (i & 63) * 8, m0 = rb * RUN, t0 = m0 & (SEQ - 1);
                    float w[3][8];
#pragma unroll
                    for (int e = 0; e < 8; ++e)
#pragma unroll
                        for (int j = 0; j < 3; ++j) w[j][e] = bw[j * 512 + c8 + e];
                    float pw[3][8];
#pragma unroll
                    for (int e = 0; e < 8; ++e) { pw[0][e] = 0.f; pw[1][e] = 0.f; }
                    if (t0 >= 2) {
#pragma unroll
                        for (int j = 0; j < 2; ++j) { const bf16* pr = P + (size_t)(m0 - 2 + j) * PWS; const u32x4 a = *(const u32x4*)(pr + P_BC + c8), b = *(const u32x4*)(pr + P_BX + c8);
                            pw[j][0] = bf2f(a.x & 0xffffu) * bf2f(b.x & 0xffffu); pw[j][1] = bf2f(a.x >> 16) * bf2f(b.x >> 16); pw[j][2] = bf2f(a.y & 0xffffu) * bf2f(b.y & 0xffffu); pw[j][3] = bf2f(a.y >> 16) * bf2f(b.y >> 16);
                            pw[j][4] = bf2f(a.z & 0xffffu) * bf2f(b.z & 0xffffu); pw[j][5] = bf2f(a.z >> 16) * bf2f(b.z >> 16); pw[j][6] = bf2f(a.w & 0xffffu) * bf2f(b.w & 0xffffu); pw[j][7] = bf2f(a.w >> 16) * bf2f(b.w >> 16); } }
#pragma unroll 4
                    for (int rr = 0; rr < RUN; ++rr) {
                        const bf16* pr = P + (size_t)(m0 + rr) * PWS; const u32x4 a = *(const u32x4*)(pr + P_BC + c8), b = *(const u32x4*)(pr + P_BX + c8), g = *(const u32x4*)(pr + P_BB + c8);
                        pw[2][0] = bf2f(a.x & 0xffffu) * bf2f(b.x & 0xffffu); pw[2][1] = bf2f(a.x >> 16) * bf2f(b.x >> 16); pw[2][2] = bf2f(a.y & 0xffffu) * bf2f(b.y & 0xffffu); pw[2][3] = bf2f(a.y >> 16) * bf2f(b.y >> 16);
                        pw[2][4] = bf2f(a.z & 0xffffu) * bf2f(b.z & 0xffffu); pw[2][5] = bf2f(a.z >> 16) * bf2f(b.z >> 16); pw[2][6] = bf2f(a.w & 0xffffu) * bf2f(b.w & 0xffffu); pw[2][7] = bf2f(a.w >> 16) * bf2f(b.w >> 16);
                        float acc[8];
#pragma unroll
                        for (int e = 0; e < 8; ++e) acc[e] = w[0][e] * pw[0][e] + w[1][e] * pw[1][e] + w[2][e] * pw[2][e];
                        u32x4 o; o.x = pk2(acc[0] * bf2f(g.x & 0xffffu), acc[1] * bf2f(g.x >> 16)); o.y = pk2(acc[2] * bf2f(g.y & 0xffffu), acc[3] * bf2f(g.y >> 16));
                        o.z = pk2(acc[4] * bf2f(g.z & 0xffffu), acc[5] * bf2f(g.z >> 16)); o.w = pk2(acc[6] * bf2f(g.w & 0xffffu), acc[7] * bf2f(g.w >> 16));
                        *(u32x4*)(YCAT + (size_t)(m0 + rr) * YW + 512 + c8) = o;
#pragma unroll
                        for (int e = 0; e < 8; ++e) { pw[0][e] = pw[1][e]; pw[1][e] = pw[2][e]; }
                    }
                }
            }
            } else {
            __syncthreads();
            {
            LAS bf16* Qs = (LAS bf16*)lds; LAS bf16* Ks = Qs + 128 * 136; LAS bf16* Vs = Ks + 64 * 136; LAS bf16* Aw = Vs + 64 * 136 + wave * (16 * 72);
            const int r = lane & 15, g4 = lane >> 4;
            for (int u = blk; u < GB * 4 * 16; u += NBLK) {
                const int bl = u >> 6, h = (u >> 4) & 3, qt = u & 15; const size_t mb = (size_t)bl * SEQ; const int q0 = qt * 128;
                volatile LAS unsigned* FLG = (volatile LAS unsigned*)(lds + MISC_OFF + 128);
                int par = 0;
                __syncthreads();
                if (lane == 0) { FLG[wave] = 0u; FLG[8 + wave] = 0u; }
                for (int i = tid; i < 2048; i += NTHR) { const int s = i >> 4, c8 = i & 15; *(LAS u32x4*)(Qs + s * 136 + c8 * 8) = *(const u32x4*)(P + (mb + q0 + s) * PWS + P_SQ + h * 128 + c8 * 8); }
                f32x4 O[8];
#pragma unroll
                for (int d = 0; d < 8; ++d) O[d] = zero4();
                float racc = 0.f; const int tq = q0 + 16 * wave + r;
                u32x4 kreg[2], vreg[2];
                { const int s0f = (2 * qt + 1) * 64;
#pragma unroll
                  for (int k2 = 0; k2 < 2; ++k2) { const int i = tid + 512 * k2, s = i >> 4, c8 = i & 15; const bf16* pr = P + (mb + s0f + s) * PWS + h * 128 + c8 * 8; kreg[k2] = *(const u32x4*)(pr + P_SK); vreg[k2] = *(const u32x4*)(pr + P_SV); } }
                for (int kt = 2 * qt + 1; kt >= 0; --kt) {
                    const int s0 = kt * 64;
                    __syncthreads();
                    { unsigned alldone = 1u;
#pragma unroll
                      for (int w8 = 0; w8 < 8; ++w8) alldone &= FLG[par * 8 + w8];
                      if (__builtin_amdgcn_readfirstlane((int)alldone)) break; }
#pragma unroll
                    for (int k2 = 0; k2 < 2; ++k2) { const int i = tid + 512 * k2, s = i >> 4, c8 = i & 15; *(LAS u32x4*)(Ks + s * 136 + c8 * 8) = kreg[k2]; *(LAS u32x4*)(Vs + s * 136 + c8 * 8) = vreg[k2]; }
                    if (kt > 0) {
#pragma unroll
                        for (int k2 = 0; k2 < 2; ++k2) { const int i = tid + 512 * k2, s = i >> 4, c8 = i & 15; const bf16* pr = P + (mb + s0 - 64 + s) * PWS + h * 128 + c8 * 8; kreg[k2] = *(const u32x4*)(pr + P_SK); vreg[k2] = *(const u32x4*)(pr + P_SV); } }
                    __syncthreads();
                    if (s0 < q0 + 16 * wave + 15) {
                        f32x4 z[4];
#pragma unroll
                        for (int j = 0; j < 4; ++j) z[j] = zero4();
#pragma unroll
                        for (int ks = 0; ks < 4; ++ks) { const bf16x8 fq = frag_kc(Qs, 136, 16 * wave, 32 * ks, lane);
#pragma unroll
                            for (int j = 0; j < 4; ++j) z[j] = MFMA16(frag_kc(Ks, 136, 16 * j, 32 * ks, lane), fq, z[j]); }
                        float ls[4][4], x[4][4], tsum[4];
#pragma unroll
                        for (int j = 0; j < 4; ++j) { float tj = 0.f;
#pragma unroll
                            for (int i = 0; i < 4; ++i) { const int s = s0 + 16 * j + 4 * g4 + i; const float zz = z[j][i] * 0.08838834764831845f;
                                const float l1 = fminf(zz, 0.f) - __logf(1.f + __expf(-fabsf(zz)));
                                ls[j][i] = l1; x[j][i] = (s < tq) ? (l1 - zz) : 0.f; tj += x[j][i]; }
                            tsum[j] = tj; }
                        float above[4], tot[4];
#pragma unroll
                        for (int j = 0; j < 4; ++j) { const float y1 = __shfl_xor(tsum[j], 16), y2 = __shfl_xor(tsum[j], 32), y3 = __shfl_xor(tsum[j], 48);
                            tot[j] = tsum[j] + y1 + y2 + y3;
                            above[j] = (g4 == 0) ? (y1 + y2 + y3) : (g4 == 1) ? (y2 + y3) : (g4 == 2) ? y1 : 0.f; }
                        float hi = racc;
#pragma unroll
                        for (int j = 3; j >= 0; --j) { float run = hi + above[j]; float av[4];
#pragma unroll
                            for (int i = 3; i >= 0; --i) { const int s = s0 + 16 * j + 4 * g4 + i; av[i] = (s < tq) ? __expf(ls[j][i] + run) : 0.f; run += x[j][i]; }
                            *(LAS u32x2*)(Aw + r * 72 + 16 * j + 4 * g4) = (u32x2){pk2(av[0], av[1]), pk2(av[2], av[3])};
                            hi += tot[j]; }
                        racc = hi;
                        LDS_WAIT(); asm volatile("" ::: "memory");
#pragma unroll
                        for (int ks = 0; ks < 2; ++ks) { const bf16x8 fa = frag_kc(Aw, 72, 0, 32 * ks, lane);
#pragma unroll
                            for (int d = 0; d < 8; ++d) O[d] = MFMA16(fa, frag_ks(Vs, 136, 16 * d, 32 * ks, lane), O[d]); }
                    }
                    par ^= 1;
                    { const bool wd = __all(racc < -104.f); if (lane == 0) FLG[par * 8 + wave] = wd ? 1u : 0u; }
                }
#pragma unroll
                for (int d = 0; d < 8; ++d)
#pragma unroll
                    for (int i = 0; i < 4; ++i) YCAT[(mb + q0 + 16 * wave + 4 * g4 + i) * YW + 1536 + h * 128 + 16 * d + r] = (bf16)f2bf(O[d][i]);
            }
            }
            }
            }
            GRID_BAR();
        }

        REPS(PH_M1) if (IN(PH_M1)) {
            PHASE_BEGIN();
            constexpr int NUA = GB * 4 * NCH, NUC = GB * NCH;
            for (int u = blk; u < NUA + NUC; u += NBLK) {
                if (u < NUA) {
                    const int ua = u, bh = ua >> 5, c = ua & 31, bl = bh >> 2, h = bh & 3; const size_t m0 = (size_t)bl * SEQ + c * 64;
                    LAS bf16* VP = (LAS bf16*)lds; LAS bf16* WK = (LAS bf16*)(lds + 64 * 152 * 2);
                    float bLj = 0.f, gmj = -1e30f;
                    if (lane < 32) { bLj = SUMB[bh * 32 + lane]; gmj = SUMG[bh * 32 + lane]; }
                    float pa = bLj, pq = gmj + bLj;
#pragma unroll
                    for (int o = 1; o < 32; o <<= 1) { const float ta = __shfl_up(pa, o), tq = __shfl_up(pq, o); if (lane >= o) { pq = fmaxf(tq + pa, pq); pa = ta + pa; } }
                    const float mall = fmaxf(pa, pq);
                    const float mnew = __shfl(mall, c), mprev = (c == 0) ? 0.f : __shfl(mall, (c + 63) & 63);
                    const float bL = GBc[(m0 + 63) * 4 + h];
                    if (tid == 0) { MCAR[ua] = mprev; MNEW[ua] = mnew; MSC[ua] = __expf(bL + mprev - mnew); }
                    for (int i = tid; i < 1024; i += NTHR) { const int s = i >> 4, c8 = i & 15; *(LAS u32x4*)(VP + s * 152 + c8 * 8) = *(const u32x4*)(P + (m0 + s) * PWS + P_AV + h * 128 + c8 * 8); }
                    if (tid < 64) { *(LAS u32x4*)(VP + tid * 152 + 128) = uone4(); *(LAS u32x4*)(VP + tid * 152 + 136) = uzero4(); }
                    { const int s = tid >> 3, c8 = tid & 7; const float w = __expf(bL + GGc[(m0 + s) * 4 + h] - mnew);
                      *(LAS u32x4*)(WK + s * 72 + c8 * 8) = scale8(*(const u32x4*)(P + (m0 + s) * PWS + P_AK + h * 64 + c8 * 8), w); }
                    __syncthreads();
                    for (int ti = wave; ti < 36; ti += NWAVES) { const int mt = ti >> 2, nt = ti & 3; f32x4 acc = zero4();
#pragma unroll
                        for (int ks = 0; ks < 2; ++ks) acc = MFMA16(frag_ks(VP, 152, 16 * mt, 32 * ks, lane), frag_ks(WK, 72, 16 * nt, 32 * ks, lane), acc);
                        bf16* d = DC + (size_t)ua * 9216 + (16 * mt + 4 * (lane >> 4)) * 64 + 16 * nt + (lane & 15);
#pragma unroll
                        for (int i = 0; i < 4; ++i) d[i * 64] = (bf16)f2bf(acc[i]); }
                    __syncthreads();
                } else {
                    const int uc = u - NUA, bl = uc >> 5, c = uc & 31, hd = wave, gi = hd >> 2; const size_t m0 = (size_t)bl * SEQ + c * 64;
                    LAS bf16* XW = (LAS bf16*)(lds + hd * (64 * 72 * 2)); LAS bf16* BMs = (LAS bf16*)(lds + 8 * 64 * 72 * 2);
                    const float alast = ACB[(m0 + 63) * 8 + hd];
#pragma unroll
                    for (int k = 0; k < 8; ++k) { const int i = lane + 64 * k, s = i >> 3, c8 = i & 7; const float wd = __expf(alast - ACB[(m0 + s) * 8 + hd]) * DTB[(m0 + s) * 8 + hd];
                        *(LAS u32x4*)(XW + s * 72 + c8 * 8) = scale8(*(const u32x4*)(XBC + (m0 + s) * 1024 + hd * 64 + c8 * 8), wd); }
                    for (int i = tid; i < 2048; i += NTHR) { const int g2 = i >> 10, rem = i & 1023, s = rem >> 4, c8 = rem & 15;
                        *(LAS u32x4*)(BMs + g2 * (64 * 136) + s * 136 + c8 * 8) = *(const u32x4*)(XBC + (m0 + s) * 1024 + 512 + g2 * 128 + c8 * 8); }
                    __syncthreads();
                    const LAS bf16* BMg = BMs + gi * (64 * 136);
                    for (int pt = 0; pt < 4; ++pt) { f32x4 acc[8];
#pragma unroll
                        for (int n = 0; n < 8; ++n) acc[n] = zero4();
#pragma unroll
                        for (int ks = 0; ks < 2; ++ks) { const bf16x8 a = frag_ks(XW, 72, 16 * pt, 32 * ks, lane);
#pragma unroll
                            for (int n = 0; n < 8; ++n) acc[n] = MFMA16(a, frag_ks(BMg, 136, 16 * n, 32 * ks, lane), acc[n]); }
                        bf16* d = DH + ((size_t)(uc * 8 + hd) * 64 + 16 * pt + 4 * (lane >> 4)) * 128 + (lane & 15);
#pragma unroll
                        for (int n = 0; n < 8; ++n)
#pragma unroll
                            for (int i = 0; i < 4; ++i) d[i * 128 + 16 * n] = (bf16)f2bf(acc[n][i]); }
                    __syncthreads();
                }
            }
            GRID_BAR();
        }

        REPS(PH_M2) if (IN(PH_M2)) {
            PHASE_BEGIN();
            constexpr int NA = GB * 4 * 2304, NC = GB * 8 * 2048;
            for (int i = gt; i < NA + NC; i += NGT) {
                f32x4 st = zero4();
                if (i < NA) { const int bh = i / 2304, e = (i - bh * 2304) * 4; const bf16* dp = DC + (size_t)bh * NCH * 9216 + e; bf16* cp = CS + (size_t)bh * NCH * 9216 + e; const float* sp = MSC + (size_t)bh * NCH;
#pragma unroll 1
                    for (int c0 = 0; c0 < NCH; c0 += 4) { u32x2 dw[4]; float sc[4];
#pragma unroll
                        for (int k = 0; k < 4; ++k) { dw[k] = *(const u32x2*)(dp + (size_t)(c0 + k) * 9216); sc[k] = sp[c0 + k]; }
#pragma unroll
                        for (int k = 0; k < 4; ++k) { *(u32x2*)(cp + (size_t)(c0 + k) * 9216) = (u32x2){pk2(st.x, st.y), pk2(st.z, st.w)};
                            st = st * sc[k] + (f32x4){bf2f(dw[k].x & 0xffffu), bf2f(dw[k].x >> 16), bf2f(dw[k].y & 0xffffu), bf2f(dw[k].y >> 16)}; } }
                } else { const int j = i - NA, bhd = j >> 11, e = (j & 2047) * 4, bl = bhd >> 3, hd = bhd & 7;
                    const bf16* dp = DH + ((size_t)(bl * NCH) * 8 + hd) * 8192 + e; bf16* cp = HS + ((size_t)(bl * NCH) * 8 + hd) * 8192 + e; const float* ap = ACB + ((size_t)bl * SEQ + 63) * 8 + hd;
#pragma unroll 1
                    for (int c0 = 0; c0 < NCH; c0 += 4) { u32x2 dw[4]; float sc[4];
#pragma unroll
                        for (int k = 0; k < 4; ++k) { dw[k] = *(const u32x2*)(dp + (size_t)(c0 + k) * 8 * 8192); sc[k] = __expf(ap[(size_t)(c0 + k) * 64 * 8]); }
#pragma unroll
                        for (int k = 0; k < 4; ++k) { *(u32x2*)(cp + (size_t)(c0 + k) * 8 * 8192) = (u32x2){pk2(st.x, st.y), pk2(st.z, st.w)};
                            st = st * sc[k] + (f32x4){bf2f(dw[k].x & 0xffffu), bf2f(dw[k].x >> 16), bf2f(dw[k].y & 0xffffu), bf2f(dw[k].y >> 16)}; } }
                }
            }
            GRID_BAR();
        }

        REPS(PH_M3) if (IN(PH_M3)) {
            PHASE_BEGIN();
            constexpr int NUA = GB * 4 * NCH, NUC = 2 * GB * NCH;
            for (int u = blk; u < NUA + NUC; u += NBLK) {
                const int r = lane & 15, g4 = lane >> 4;
                if (u < NUA) {
                    const int ua = u, bh = ua >> 5, c = ua & 31, bl = bh >> 2, h = bh & 3; const size_t m0 = (size_t)bl * SEQ + c * 64;
                    LAS bf16* Qs = (LAS bf16*)lds; LAS bf16* Ks = Qs + 64 * 72; LAS bf16* VP = Ks + 64 * 72; LAS bf16* CST = VP + 64 * 152; LAS bf16* SMT = CST + 144 * 72; LAS bf16* AOT = SMT + 64 * 72;
                    LAS float* GS = (LAS float*)(AOT + 64 * 136);
                    LAS float* SSQ = GS + 256;
                    const float mcar = MCAR[ua];
                    { const int s = tid >> 3, c8 = tid & 7; const bf16* pr = P + (m0 + s) * PWS + h * 64 + c8 * 8;
                      *(LAS u32x4*)(Qs + s * 72 + c8 * 8) = *(const u32x4*)(pr + P_AQ); *(LAS u32x4*)(Ks + s * 72 + c8 * 8) = *(const u32x4*)(pr + P_AK); }
                    for (int i = tid; i < 1024; i += NTHR) { const int s = i >> 4, c8 = i & 15; const bf16* pr = P + (m0 + s) * PWS + h * 128 + c8 * 8;
                        *(LAS u32x4*)(VP + s * 152 + c8 * 8) = *(const u32x4*)(pr + P_AV); *(LAS u32x4*)(AOT + s * 136 + c8 * 8) = *(const u32x4*)(pr + P_AO); }
                    if (tid < 64) { *(LAS u32x4*)(VP + tid * 152 + 128) = uone4(); *(LAS u32x4*)(VP + tid * 152 + 136) = uzero4(); }
                    for (int i = tid; i < 1152; i += NTHR) { const int dv = i >> 3, c8 = i & 7; *(LAS u32x4*)(CST + dv * 72 + c8 * 8) = *(const u32x4*)(CS + (size_t)ua * 9216 + dv * 64 + c8 * 8); }
                    if (tid < 192) { const int arr = tid >> 6, s = tid & 63; const float* src = (arr == 0) ? GBc : (arr == 1) ? GGc : GMT; float v = src[(m0 + s) * 4 + h];
                        if (arr == 2) v = GBc[(m0 + s) * 4 + h] + fmaxf(mcar, v);
                        GS[arr * 64 + s] = v; }
                    __syncthreads();
#pragma unroll
                    for (int q2 = 0; q2 < 2; ++q2) { const int ti = 2 * wave + q2, tt = ti >> 2, st = ti & 3;
                        f32x4 acc = zero4();
                        if (st <= tt) {
#pragma unroll
                            for (int ks = 0; ks < 2; ++ks) acc = MFMA16(frag_kc(Qs, 72, 16 * tt, 32 * ks, lane), frag_kc(Ks, 72, 16 * st, 32 * ks, lane), acc);
                            const int s = 16 * st + r; const float gs = GS[64 + s];
#pragma unroll
                            for (int i = 0; i < 4; ++i) { const int t = 16 * tt + 4 * g4 + i; const float e = GS[t] - GS[128 + t] + gs;
                                acc[i] = (s <= t) ? acc[i] * 0.125f * __expf(e) : 0.f; }
                        }
                        *(LAS u32x2*)(SMT + (16 * st + r) * 72 + 16 * tt + 4 * g4) = (u32x2){pk2(acc[0], acc[1]), pk2(acc[2], acc[3])}; }
                    __syncthreads();
                    const int tt = wave & 3, half = wave >> 2;
                    f32x4 a1[5], a2[5];
#pragma unroll
                    for (int j = 0; j < 5; ++j) { a1[j] = zero4(); a2[j] = zero4(); }
#pragma unroll
                    for (int ks = 0; ks < 2; ++ks) { const bf16x8 fa1 = frag_ks(SMT, 72, 16 * tt, 32 * ks, lane), fa2 = frag_kc(Qs, 72, 16 * tt, 32 * ks, lane);
#pragma unroll
                        for (int j = 0; j < 5; ++j) { const int dvt = (j < 4) ? half * 4 + j : 8;
                            a1[j] = MFMA16(fa1, frag_ks(VP, 152, 16 * dvt, 32 * ks, lane), a1[j]);
                            a2[j] = MFMA16(fa2, frag_kc(CST, 72, 16 * dvt, 32 * ks, lane), a2[j]); } }
                    float hv[4][4], ssq[4];
#pragma unroll
                    for (int i = 0; i < 4; ++i) { const int t = 16 * tt + 4 * g4 + i; const float b = GS[t], mt = GS[128 + t];
                        const float is = 0.125f * __expf(b + mcar - mt);
                        float den = a1[4][i] + is * a2[4][i]; den = __shfl(den, lane & 48);
                        const float dn = __builtin_amdgcn_rcpf(fmaxf(fabsf(den), __expf(-mt))); float q = 0.f;
#pragma unroll
                        for (int j = 0; j < 4; ++j) { const float v = (a1[j][i] + is * a2[j][i]) * dn; hv[j][i] = v; q += v * v; }
                        q += __shfl_xor(q, 1); q += __shfl_xor(q, 2); q += __shfl_xor(q, 4); q += __shfl_xor(q, 8); ssq[i] = q; }
                    if (r == 0) {
#pragma unroll
                        for (int i = 0; i < 4; ++i) SSQ[half * 64 + 16 * tt + 4 * g4 + i] = ssq[i]; }
                    __syncthreads();
                    const float* ng = ka->in[I_ANG] + (size_t)l * 512 + h * 128;
#pragma unroll
                    for (int i = 0; i < 4; ++i) { const int t = 16 * tt + 4 * g4 + i; const float rstd = rsqrtf((SSQ[t] + SSQ[64 + t]) * (1.f / 128.f) + EPS);
#pragma unroll
                        for (int j = 0; j < 4; ++j) { const int dv = 16 * (half * 4 + j) + r; LAS bf16* op = AOT + t * 136 + dv;
                            *op = (bf16)f2bf(sigmoidf_(bf2f(*op)) * hv[j][i] * rstd * ng[dv]); } }
                    __syncthreads();
                    for (int i = tid; i < 1024; i += NTHR) { const int s = i >> 4, c8 = i & 15; *(u32x4*)(YCAT + (m0 + s) * YW + h * 128 + c8 * 8) = *(const LAS u32x4*)(AOT + s * 136 + c8 * 8); }
                    __syncthreads();
                } else {
                    const int uc2 = u - NUA, bl = uc2 >> 6, c = (uc2 >> 1) & 31, gi = uc2 & 1, hl = wave & 3, th = wave >> 2, hd = gi * 4 + hl; const size_t m0 = (size_t)bl * SEQ + c * 64;
                    LAS bf16* XHs = (LAS bf16*)lds;
                    LAS bf16* HTs = (LAS bf16*)(lds + 36864);
                    LAS bf16* BMg = (LAS bf16*)(lds + 36864 + 69632);
                    LAS bf16* MTt = (LAS bf16*)(lds + 36864 + 69632 + 17408 + wave * 3072);
                    LAS float* ADs = (LAS float*)(lds + 36864 + 69632 + 17408 + 24576);
                    const bf16* Xb = XBC + m0 * 1024;
                    for (int i = tid; i < 2048; i += NTHR) { const int h4 = i >> 9, rem = i & 511, s = rem >> 3, c8 = rem & 7;
                        *(LAS u32x4*)(XHs + h4 * (64 * 72) + s * 72 + c8 * 8) = *(const u32x4*)((Xb + gi * 256) + (unsigned)(s * 1024 + h4 * 64 + c8 * 8)); }
                    { const bf16* Hb = HS + (size_t)((bl * NCH + c) * 8 + gi * 4) * 8192;
                      for (int i = tid; i < 4096; i += NTHR) { const int h4 = i >> 10, rem = i & 1023, p = rem >> 4, c8 = rem & 15;
                        *(LAS u32x4*)(HTs + h4 * (64 * 136) + p * 136 + c8 * 8) = *(const u32x4*)(Hb + (unsigned)(h4 * 8192 + p * 128 + c8 * 8)); } }
                    for (int i = tid; i < 1024; i += NTHR) { const int s = i >> 4, c8 = i & 15; *(LAS u32x4*)(BMg + s * 136 + c8 * 8) = *(const u32x4*)((Xb + 512 + gi * 128) + (unsigned)(s * 1024 + c8 * 8)); }
                    { const int h4 = tid >> 7, arr = (tid >> 6) & 1, s = tid & 63; const float* src = arr ? DTB : ACB; ADs[tid] = (src + m0 * 8 + gi * 4)[(unsigned)(s * 8 + h4)]; }
                    const LAS bf16* XH = XHs + hl * (64 * 72); const LAS bf16* HT = HTs + hl * (64 * 136); const LAS float* AD = ADs + hl * 128;
                    const bf16* Cm = Xb + 768 + gi * 128; const bf16* Zp = P + m0 * PWS + P_CZ + hd * 64; const unsigned zlane = (unsigned)(4 * g4 * PWS + r), ylane = (unsigned)(4 * g4 * YW + r);
                    bf16* Yp = YCAT + m0 * YW + 1024 + hd * 64; float* Sp = SSQC + m0 * 8 + hd;
                    bf16x8 fcn[4];
#pragma unroll
                    for (int ks = 0; ks < 4; ++ks) fcn[ks] = gfrag_kc(Cm, 1024, 16 * th, 32 * ks, lane);
                    const float dsk = ka->in[I_CDSKIP][l * 8 + hd];
                    __syncthreads();
#pragma unroll 1
                    for (int k2 = 0; k2 < 2; ++k2) { const int tt = k2 ? 3 - th : th;
                        bf16x8 fcm[4]; unsigned short zc[4][4];
#pragma unroll
                        for (int ks = 0; ks < 4; ++ks) fcm[ks] = fcn[ks];
#pragma unroll
                        for (int p = 0; p < 4; ++p)
#pragma unroll
                            for (int i = 0; i < 4; ++i) zc[p][i] = (Zp + (size_t)(16 * tt + i) * PWS + 16 * p)[zlane];
#pragma unroll
                        for (int ks = 0; ks < 4; ++ks) fcn[ks] = gfrag_kc(Cm, 1024, 16 * (3 - th), 32 * ks, lane);
                        float at[4];
#pragma unroll
                        for (int i = 0; i < 4; ++i) at[i] = AD[16 * tt + 4 * g4 + i];
#pragma unroll 1
                        for (int st = 0; st <= tt; ++st) { f32x4 acc = zero4();
#pragma unroll
                            for (int ks = 0; ks < 4; ++ks) acc = MFMA16(fcm[ks], frag_kc(BMg, 136, 16 * st, 32 * ks, lane), acc);
                            const int s = 16 * st + r; const float as = AD[s], dts = AD[64 + s];
#pragma unroll
                            for (int i = 0; i < 4; ++i) { const int t = 16 * tt + 4 * g4 + i; acc[i] = (s <= t) ? acc[i] * __expf(at[i] - as) * dts : 0.f; if (s == t) acc[i] += dsk; }
                            *(LAS u32x2*)(MTt + (16 * st + r) * 24 + 4 * g4) = (u32x2){pk2(acc[0], acc[1]), pk2(acc[2], acc[3])}; }
                        if ((tt & 1) == 0) *(LAS u32x2*)(MTt + (16 * (tt + 1) + r) * 24 + 4 * g4) = (u32x2){uzero4().x, uzero4().y};
                        LDS_WAIT(); asm volatile("" ::: "memory");
                        f32x4 ad[4], ao[4];
#pragma unroll
                        for (int p = 0; p < 4; ++p) { ad[p] = zero4(); ao[p] = zero4(); }
#pragma unroll 1
                        for (int ks = 0; ks <= (tt >> 1); ++ks) { const bf16x8 fa = frag_ks(MTt, 24, 0, 32 * ks, lane);
#pragma unroll
                            for (int p = 0; p < 4; ++p) ad[p] = MFMA16(fa, frag_ks(XH, 72, 16 * p, 32 * ks, lane), ad[p]); }
#pragma unroll
                        for (int ks = 0; ks < 4; ++ks)
#pragma unroll
                            for (int p = 0; p < 4; ++p) ao[p] = MFMA16(fcm[ks], frag_kc(HT, 136, 16 * p, 32 * ks, lane), ao[p]);
#pragma unroll
                        for (int i = 0; i < 4; ++i) { const float ea = __expf(at[i]); float q = 0.f;
#pragma unroll
                            for (int p = 0; p < 4; ++p) { const float y = (ad[p][i] + ea * ao[p][i]) * siluf_(bf2f(zc[p][i])); q += y * y;
                                (Yp + (size_t)(16 * tt + i) * YW + 16 * p)[ylane] = (bf16)f2bf(y); }
                            q += __shfl_xor(q, 1); q += __shfl_xor(q, 2); q += __shfl_xor(q, 4); q += __shfl_xor(q, 8);
                            if (r == 0) (Sp + (16 * tt + i) * 8)[(unsigned)(32 * g4)] = q; }
                        LDS_WAIT(); asm volatile("" ::: "memory");
                    }
                    __syncthreads();
                }
            }
            GRID_BAR();
        }

        REPS(PH_LIFT) if (IN(PH_LIFT)) {
            PHASE_BEGIN();
            pg8::Gemm g{YCAT, WliftT, 512, YW, 512, (size_t)512 * 2, (size_t)DM * 512 * 2}; pg8::Order S; S.init(T, DM, NBLK, blk, 4);
            pg8::EpiLift E{FAC, MB + (size_t)(grp & 1) * T * DM, DM, SSQC};
            pg8::gemm_phase<pg8::EpiLift, GEMM_ALIGN>(lds, g, S, E);
            GRID_BAR();
        }
        REPS(PH_OUT) if (IN(PH_OUT) && (grp & 1)) {
            PHASE_BEGIN();
            const size_t prow0 = grow0 - T;
            pg8::Gemm g{MB, WoutT, DM, DM, DM, 0, 0}; pg8::Order S; S.init(2 * T, DM, NBLK, blk, 1);
            pg8::EpiResid E{XG + prow0 * DM, DM, SSQ2};
            pg8::gemm_phase<pg8::EpiResid, GEMM_ALIGN>(lds, g, S, E);
            GRID_BAR();
        }
        REPS(PH_UP) if (IN(PH_UP) && (grp & 1)) {
            PHASE_BEGIN();
            const size_t prow0 = grow0 - T;
            pg8::Gemm g{XG + prow0 * DM, WupT, DM, DM, DM, 0, 0}; pg8::Order S; S.init(2 * T, DFF2, NBLK, blk, 1);
            if (tid == 0) *(volatile LAS int*)(lds + 131072 + 12288 + 1024) = -1;
            pg8::EpiConvAct E{ACT, SSQ2, ka->in[I_FCW] + (size_t)l * 3 * DFF2, ka->in[I_FCB] + (size_t)l * DFF2, RAWH, lds + 131072, DFF2 / 256};
            pg8::gemm_phase<pg8::EpiConvAct, GEMM_ALIGN>(lds, g, S, E);
            GRID_BAR();
        }
        REPS(PH_DOWN) if (IN(PH_DOWN) && (grp & 1)) {
            PHASE_BEGIN();
            const size_t prow0 = grow0 - T;
            pg8::Gemm g{ACT, WdownT, DFF, 128, DFF, 0, 0, 65536, (size_t)22 * 65536}; pg8::Order S; S.init(2 * T, DM, NBLK, blk, 1);
            {
                const float* fw = ka->in[I_FCW] + (size_t)l * 3 * DFF2; const float* fb = ka->in[I_FCB] + (size_t)l * DFF2;
                pg8::Unit uu;
                for (int i = 0; S.next(i, uu); ++i) { const int pm = uu.pm; if ((pm & 7) == 0) continue;
                    for (int ch = tid; ch < DFF; ch += NTHR) { const int tp = ch >> 7, j = ch & 127;
                        const float* own = RAWH + (size_t)(pm * 22 + tp) * 1024; const float* prv = RAWH + (size_t)((pm - 1) * 22 + tp) * 1024;
                        const float g254 = prv[2 * 256 + j], g255 = prv[3 * 256 + j], g0 = own[j], g1 = own[256 + j];
                        const float u254 = prv[2 * 256 + 128 + j], u255 = prv[3 * 256 + 128 + j], u0 = own[128 + j], u1 = own[256 + 128 + j];
                        const float wg0 = fw[ch], wg1 = fw[DFF2 + ch], wg2 = fw[2 * DFF2 + ch], wu0 = fw[DFF + ch], wu1 = fw[DFF2 + DFF + ch], wu2 = fw[2 * DFF2 + DFF + ch], bg = fb[ch], bu = fb[DFF + ch];
                        ACT[((size_t)(pm * 22 + tp) * 256) * 128 + j] = (bf16)f2bf(siluf_(bg + wg0 * g254 + wg1 * g255 + wg2 * g0) * (bu + wu0 * u254 + wu1 * u255 + wu2 * u0));
                        ACT[((size_t)(pm * 22 + tp) * 256 + 1) * 128 + j] = (bf16)f2bf(siluf_(bg + wg0 * g255 + wg1 * g0 + wg2 * g1) * (bu + wu0 * u255 + wu1 * u0 + wu2 * u1)); } }
                asm volatile("s_waitcnt vmcnt(0)" ::: "memory"); __syncthreads();
            }
            pg8::EpiResid E{XG + prow0 * DM, DM, SSQ1 + prow0 * 16};
            pg8::gemm_phase<pg8::EpiResid, GEMM_ALIGN>(lds, g, S, E);
            GRID_BAR();
        }
        REPS(PH_FINAL) if (IN(PH_FINAL) && l == DEPTH - 1 && (grp & 1)) {
            PHASE_BEGIN();
            const size_t prow0 = grow0 - T;
            const float* gain = ka->in[I_FING];
            f32x4 gv[4];
#pragma unroll
            for (int j = 0; j < 4; ++j) gv[j] = ((const f32x4*)gain)[lane + 64 * j];
            for (int m = gw; m < 2 * T; m += NGW) {
                const u32x2* xr = (const u32x2*)(XG + (prow0 + m) * DM) + lane;
                f32x4 v[4]; float sq = 0.f;
#pragma unroll
                for (int j = 0; j < 4; ++j) { const u32x2 w = xr[64 * j]; v[j] = (f32x4){bf2f(w.x & 0xffffu), bf2f(w.x >> 16), bf2f(w.y & 0xffffu), bf2f(w.y >> 16)};
                    sq += (v[j].x * v[j].x + v[j].y * v[j].y) + (v[j].z * v[j].z + v[j].w * v[j].w); }
                const float rstd = rsqrtf(wave_sum(sq) * (1.f / DM) + EPS);
                f32x4* orow = (f32x4*)(ka->out + (prow0 + m) * DM) + lane;
#pragma unroll
                for (int j = 0; j < 4; ++j) orow[64 * j] = v[j] * rstd * gv[j];
            }
            GRID_BAR();
        }
    }
#undef IN
#undef GRID_BAR
#undef PHASE_BEGIN
}

#ifndef ONE_LAUNCH
#define ONE_LAUNCH 1
#endif
extern "C" void kernel_launch(void* const* d_in, const int* in_sizes, int n_in, void* d_out, int out_size, void* d_ws, size_t ws_size, hipStream_t stream) {
    static int grid = 0;
    if (grid == 0) {
        if (n_in != N_IN || in_sizes[0] != BATCH * SEQ * DM || out_size != BATCH * SEQ * DM || ws_size < WS_END) {
            fprintf(stderr, "kernel_launch: unexpected shapes / workspace (n_in %d, ws %zu, need %zu); nothing launched\n", n_in, ws_size, (size_t)WS_END); grid = -1; return; }
        int dev = 0, cus = 0, per_cu = 0;
        if (hipGetDevice(&dev) != hipSuccess || hipDeviceGetAttribute(&cus, hipDeviceAttributeMultiprocessorCount, dev) != hipSuccess) { grid = -1; return; }
        if (hipFuncSetAttribute((const void*)fwd, hipFuncAttributeMaxDynamicSharedMemorySize, LDS_BYTES) != hipSuccess) { fprintf(stderr, "kernel_launch: hipFuncSetAttribute failed\n"); grid = -1; return; }
        if (hipOccupancyMaxActiveBlocksPerMultiprocessor(&per_cu, (const void*)fwd, NTHR, LDS_BYTES) != hipSuccess || per_cu < 1) { fprintf(stderr, "kernel_launch: occupancy query says %d\n", per_cu); (void)hipGetLastError(); }
        grid = cus;
    }
    if (grid < 0) return;
    (void)hipMemsetAsync((char*)d_ws + WS_CTL, 0, (size_t)(4096 + XCD_BAR_WORDS) * 4, stream);
    Args a{};
    for (int i = 0; i < N_IN; ++i) a.in[i] = (const float*)d_in[i];
    a.out = (float*)d_out; a.ws = (unsigned char*)d_ws; a.pad = 0;
#if ONE_LAUNCH
    a.l_lo = 0; a.l_hi = DEPTH; a.g_lo = 0; a.g_hi = NG; a.ph_lo = 0; a.ph_hi = PH_COUNT; a.use_bar = 1;
    hipLaunchKernelGGL(fwd, dim3(grid), dim3(NTHR), LDS_BYTES, stream, a);
#else
    a.use_bar = 0;
    for (int l = 0; l < DEPTH; ++l)
        for (int g = 0; g < NG; ++g)
            for (int ph = 0; ph < PH_COUNT; ++ph) {
                if (ph == PH_W && g != 0) continue;
                if (ph == PH_FINAL && l != DEPTH - 1) continue;
                if ((ph == PH_OUT || ph == PH_UP || ph == PH_DOWN || ph == PH_FINAL) && !(g & 1)) continue;
                a.l_lo = l; a.l_hi = l + 1; a.g_lo = g; a.g_hi = g + 1; a.ph_lo = ph; a.ph_hi = ph + 1;
                hipLaunchKernelGGL(fwd, dim3(grid), dim3(NTHR), LDS_BYTES, stream, a);
            }
#endif
}
```

```cpp
#include <hip/hip_runtime.h>
#include <cstdio>
#include <cstdint>

#define LAS __attribute__((address_space(3)))
#define GAS __attribute__((address_space(1)))
typedef unsigned short bf16;
typedef short bf16x8 __attribute__((ext_vector_type(8)));
typedef short s16x4 __attribute__((ext_vector_type(4)));
typedef float f32x4 __attribute__((ext_vector_type(4)));
typedef float f32x2 __attribute__((ext_vector_type(2)));
typedef unsigned u32x4 __attribute__((ext_vector_type(4)));
typedef unsigned u32x2 __attribute__((ext_vector_type(2)));

constexpr int DM = 1024, BATCH = 32, SEQ = 2048, DEPTH = 4;
constexpr int PIN = 10256, PW = 10240, PWS = 6144, DFF = 2816, DFF2 = 5632;
constexpr int GB = 8;
constexpr int NG = BATCH / GB;
constexpr int T = GB * SEQ;
constexpr int NCH = SEQ / 64;
constexpr float EPS = 1e-6f;
constexpr int P_AQ = 0, P_AK = 256, P_AV = 512, P_AO = 1024, P_BB = 1536, P_BC = 2048, P_BX = 2560, P_CZ = 3072, P_CX = 3584, P_SQ = 4608, P_SK = 5120, P_SV = 5632, P_G = 6144;
constexpr int YW = 2048;

constexpr size_t MiB = 1u << 20;
constexpr size_t WS_CTL = 0, CTL_BYTES = 1 * MiB;
constexpr size_t WS_WIN = 1 * MiB;
constexpr size_t WS_WLIFT = WS_WIN + (size_t)PW * DM * 2;
constexpr size_t WS_WOUT = WS_WLIFT + (size_t)4 * DM * 512 * 2;
constexpr size_t WS_WUP = WS_WOUT + (size_t)DM * DM * 2;
constexpr size_t WS_WDOWN = WS_WUP + (size_t)DFF2 * DM * 2;
constexpr size_t WS_W16 = WS_WDOWN + (size_t)DM * DFF * 2;
constexpr size_t WS_XN = WS_W16 + 65536;
constexpr size_t WS_P = WS_XN + (size_t)T * DM * 2;
constexpr size_t WS_U = WS_P, WS_ACT = WS_P;
constexpr size_t WS_YCAT = WS_P + (size_t)T * PW * 2;
constexpr size_t WS_XG = WS_YCAT + (size_t)T * YW * 2;
constexpr size_t WS_MB = WS_XG + (size_t)BATCH * SEQ * DM * 2;
constexpr size_t WS_SP = WS_MB + (size_t)2 * T * DM * 2;
constexpr size_t WS_GB = WS_SP + (size_t)T * 16 * 4;
constexpr size_t WS_GG = WS_GB + (size_t)T * 16;
constexpr size_t WS_GMT = WS_GG + (size_t)T * 16;
constexpr size_t WS_MCAR = WS_GMT + (size_t)T * 16;
constexpr size_t WS_MNEW = WS_MCAR + 4096;
constexpr size_t WS_MSC = WS_MNEW + 4096;
constexpr size_t WS_SUMB = WS_MSC + 4096, WS_SUMG = WS_SUMB + 4096;
constexpr size_t WS_DT = WS_SUMG + 4096;
constexpr size_t WS_AC = WS_DT + (size_t)T * 32;
constexpr size_t WS_XBC = WS_AC + (size_t)T * 32;
constexpr size_t WS_DC = WS_XBC + (size_t)T * DM * 2;
constexpr size_t WS_CS = WS_DC + (size_t)GB * 4 * NCH * 9216 * 4;
constexpr size_t WS_DH = WS_CS + (size_t)GB * 4 * NCH * 9216 * 2;
constexpr size_t WS_HS = WS_DH + (size_t)GB * NCH * 8 * 8192 * 4;
constexpr size_t WS_SSQ1 = WS_HS + (size_t)GB * NCH * 8 * 8192 * 2;
constexpr size_t WS_SSQ2 = WS_SSQ1 + (size_t)BATCH * SEQ * 64;
constexpr size_t WS_SSQC = WS_SSQ2 + (size_t)2 * T * 64;
constexpr size_t WS_RAWH = WS_SSQC + (size_t)T * 32;
constexpr size_t WS_END = WS_RAWH + (size_t)(2 * T / 256) * 22 * 4 * 256 * 4;

constexpr int NWAVES = 8, NTHR = 512;
constexpr int LDS_BYTES = 155648;
constexpr int MISC_OFF = 153600;

__device__ __forceinline__ float bf2f(unsigned b) { return __uint_as_float(b << 16); }
__device__ __forceinline__ unsigned f2bf(float f) { unsigned u = __float_as_uint(f); return (u + 0x7fffu + ((u >> 16) & 1u)) >> 16; }
__device__ __forceinline__ unsigned pk2(float lo, float hi) { return f2bf(lo) | (f2bf(hi) << 16); }
__device__ __forceinline__ float sigmoidf_(float x) { return __builtin_amdgcn_rcpf(1.f + __builtin_amdgcn_exp2f(-1.4426950408889634f * x)); }
__device__ __forceinline__ float siluf_(float x) { return x * __builtin_amdgcn_rcpf(1.f + __builtin_amdgcn_exp2f(-1.4426950408889634f * x)); }
__device__ __forceinline__ float logsigf_(float x) { return fminf(x, 0.f) - log1pf(expf(-fabsf(x))); }
__device__ __forceinline__ float softplusf_(float x) { return fmaxf(x, 0.f) + log1pf(expf(-fabsf(x))); }
__device__ __forceinline__ float wave_sum(float v) {
#pragma unroll
    for (int o = 1; o < 64; o <<= 1) v += __shfl_xor(v, o);
    return v;
}
#define LDS_WAIT() asm volatile("s_waitcnt lgkmcnt(0)" ::: "memory")
__device__ __forceinline__ float row_rstd(const float* ssq16) {
    const f32x4* p = (const f32x4*)ssq16; const f32x4 a = (p[0] + p[1]) + (p[2] + p[3]);
    return rsqrtf(((a.x + a.y) + (a.z + a.w)) * (1.f / 1024.f) + 1e-6f);
}

namespace pg8 {
constexpr int BM = 256, BK = 64, HALF = 128, HTB = HALF * BK * 2, STAGE_BYTES = 8 * HTB, NXCD = 8, WGM = 4;
__host__ __device__ __forceinline__ int lds_byte(int r, int c) { const int st = (r >> 4) * 2 + (c >> 5), rr = r & 15, cc = c & 31, ob = rr * 64 + cc * 2; return st * 1024 + (ob ^ (((ob >> 9) & 1) << 5)); }
__host__ __device__ __forceinline__ void stage_rc(int b, int& R, int& C) { const int st = b / 1024, sb = b % 1024, swz = sb ^ (((sb >> 9) & 1) << 5); R = (st >> 1) * 16 + swz / 64; C = (st & 1) * 32 + (swz % 64) / 2; }
__host__ __device__ __forceinline__ int perm32(int rho) { const int n = rho >> 4, i = rho & 15; return 8 * (i >> 2) + 4 * n + (i & 3); }

struct Unit { int pm, pn, z; };
struct Gemm { const bf16* A; const bf16* Bt; int K, lda, ldb; size_t zA, zB; size_t ablk = 256, atile = 0; };

struct Order {
    int nM, nN, nwg, G, c, Z;
    __device__ __forceinline__ void init(int M, int N, int G_, int c_, int Z_) { nM = M / BM; nN = N / BM; nwg = nM * nN; G = G_; c = c_; Z = Z_; }
    __device__ __forceinline__ bool next(int i, Unit& u) const {
        const int ti = i / Z; u.z = i - ti * Z;
        const long L = (long)ti * G + c; if (L >= nwg) return false;
        int wgid = (int)L; { const int q = nwg / NXCD, r = nwg % NXCD, xcd = wgid % NXCD, off = wgid / NXCD; wgid = (xcd < r ? xcd * (q + 1) : r * (q + 1) + (xcd - r) * q) + off; }
        const int nig = WGM * nN, gid = wgid / nig, fm = gid * WGM, gsz = (nM - fm) < WGM ? (nM - fm) : WGM;
        u.pm = fm + ((wgid % nig) % gsz); u.pn = (wgid % nig) / gsz; return true;
    }
};
__device__ __forceinline__ unsigned cvt_pk_bf16(float lo, float hi) { unsigned r; asm volatile("s_nop 0\n\tv_cvt_pk_bf16_f32 %0, %1, %2" : "=v"(r) : "v"(lo), "v"(hi)); return r; }

__device__ __forceinline__ void panel_rstd(LAS float* rsl, const float* ssq, int pm, int wr, int wc, int fr, int fq) {
    volatile LAS int* tag = (volatile LAS int*)(rsl + 256);
    if (__builtin_amdgcn_readfirstlane(*tag) != pm) {
        const int tidl = (wr * 4 + wc) * 64 + fq * 16 + fr, rr = tidl >> 1, hf = tidl & 1;
        const f32x4* p = (const f32x4*)(ssq + (size_t)(pm * BM + rr) * 16 + hf * 8); const f32x4 a = p[0] + p[1];
        float sq = (a.x + a.y) + (a.z + a.w); sq += __shfl_xor(sq, 1);
        __builtin_amdgcn_s_barrier();
        if (hf == 0) rsl[rr] = rsqrtf(sq * (1.f / 1024.f) + 1e-6f);
        if (tidl == 0) *tag = pm;
        asm volatile("s_waitcnt lgkmcnt(0)" ::: "memory"); __builtin_amdgcn_s_barrier(); asm volatile("" ::: "memory");
    }
}
struct EpiBf16 {
    static constexpr int MIN_STORES = 16;
    static constexpr bool PERM = true, KEEP = false, CONTIG = true;
    LAS float* rsl;
    bf16* O; int ldc; const float* ssq; int gate_pn0; bf16* fac;
    static __device__ __forceinline__ float s1(float xs) { return 1.f + __builtin_amdgcn_exp2f(__builtin_amdgcn_fmed3f(xs, -43.28085122666891f, 43.28085122666891f)); }
    __device__ __forceinline__ void operator()(f32x4 (&acc)[2][2][4][2], const Unit& u, int wr, int wc, int fr, int fq) const {
        panel_rstd(rsl, ssq, u.pm, wr, wc, fr, fq);
        if (u.pn >= gate_pn0) {
            const int row0g = u.pm * BM + wr * 64 + fr, d0 = 64 * (u.pn - gate_pn0) + 16 * wc + 4 * fq;
#pragma unroll
            for (int ai = 0; ai < 2; ++ai)
#pragma unroll
                for (int m = 0; m < 4; ++m) {
                    const float rs = -1.4426950408889634f * rsl[wr * 64 + fr + ai * HALF + m * 16];
                    const int cc = d0 & 255, pnL = d0 >> 8, bjL = cc >> 7, wcL = (cc >> 5) & 3, fqL = (cc >> 3) & 3, nL = (cc >> 2) & 1;
                    bf16* rowp = fac + ((((((size_t)(u.pm * 4 + pnL) * 4) * 16 + (ai * 4 + m) * 2 + bjL) * 8 + (wr * 4 + wcL)) * 64 + fqL * 16 + fr) * 8 + nL * 4);
                    const size_t zstep = (size_t)16 * 8 * 512;
                    float one = 1.f; asm volatile("" : "+v"(one));
                    float f0[4], f1[4], f2[4], f3[4];
#pragma unroll
                    for (int e = 0; e < 4; ++e) { const float a0 = s1(acc[ai][0][m][0][e] * rs), a1 = s1(acc[ai][0][m][1][e] * rs), a2 = s1(acc[ai][1][m][0][e] * rs), a3 = s1(acc[ai][1][m][1][e] * rs);
                        f0[e] = a1 * __builtin_amdgcn_rcpf(a0); f1[e] = a2 * __builtin_amdgcn_rcpf(a1); f2[e] = a3 * __builtin_amdgcn_rcpf(a2); f3[e] = one * __builtin_amdgcn_rcpf(a3); }
                    *(u32x2*)(rowp) = (u32x2){cvt_pk_bf16(f0[0], f0[1]), cvt_pk_bf16(f0[2], f0[3])};
                    *(u32x2*)(rowp + zstep) = (u32x2){cvt_pk_bf16(f1[0], f1[1]), cvt_pk_bf16(f1[2], f1[3])};
                    *(u32x2*)(rowp + 2 * zstep) = (u32x2){cvt_pk_bf16(f2[0], f2[1]), cvt_pk_bf16(f2[2], f2[3])};
                    *(u32x2*)(rowp + 3 * zstep) = (u32x2){cvt_pk_bf16(f3[0], f3[1]), cvt_pk_bf16(f3[2], f3[3])}; }
            return; }
        const int row0 = u.pm * BM + wr * 64 + fr, col0 = u.pn * BM + wc * 64 + 8 * fq;
#pragma unroll
        for (int ai = 0; ai < 2; ++ai)
#pragma unroll
            for (int m = 0; m < 4; ++m) { const int row = row0 + ai * HALF + m * 16; bf16* rowp = O + (size_t)row * ldc + col0;
                const float rs = rsl[wr * 64 + fr + ai * HALF + m * 16];
#pragma unroll
                for (int bj = 0; bj < 2; ++bj) { const f32x4 v0 = acc[ai][bj][m][0] * rs, v1 = acc[ai][bj][m][1] * rs;
                    u32x4 w; w.x = cvt_pk_bf16(v0[0], v0[1]); w.y = cvt_pk_bf16(v0[2], v0[3]); w.z = cvt_pk_bf16(v1[0], v1[1]); w.w = cvt_pk_bf16(v1[2], v1[3]);
                    *(u32x4*)(rowp + bj * 32) = w; } }
    }
};
struct EpiResid {
    static constexpr int MIN_STORES = 16;
    static constexpr bool PERM = true, KEEP = false, CONTIG = true;
    bf16* xb; int ldc; float* ssq;
    __device__ __forceinline__ void operator()(f32x4 (&acc)[2][2][4][2], const Unit& u, int wr, int wc, int fr, int fq) const {
        const int row0 = u.pm * BM + wr * 64 + fr, col0 = u.pn * BM + wc * 64 + 8 * fq;
#pragma unroll
        for (int ai = 0; ai < 2; ++ai) {
            u32x4 ov[4][2];
#pragma unroll
            for (int m = 0; m < 4; ++m)
#pragma unroll
                for (int bj = 0; bj < 2; ++bj) ov[m][bj] = *(const u32x4*)(xb + (size_t)(row0 + ai * HALF + m * 16) * ldc + col0 + bj * 32);
            asm volatile("" ::: "memory");
#pragma unroll
            for (int m = 0; m < 4; ++m) { const int row = row0 + ai * HALF + m * 16; const size_t off = (size_t)row * ldc + col0; float q = 0.f;
#pragma unroll
                for (int bj = 0; bj < 2; ++bj) {
                    const u32x4 o = ov[m][bj];
                    const f32x4 x0 = (f32x4){bf2f(o.x & 0xffffu), bf2f(o.x >> 16), bf2f(o.y & 0xffffu), bf2f(o.y >> 16)} + acc[ai][bj][m][0];
                    const f32x4 x1 = (f32x4){bf2f(o.z & 0xffffu), bf2f(o.z >> 16), bf2f(o.w & 0xffffu), bf2f(o.w >> 16)} + acc[ai][bj][m][1];
                    q += (x0[0] * x0[0] + x0[1] * x0[1]) + (x0[2] * x0[2] + x0[3] * x0[3]) + (x1[0] * x1[0] + x1[1] * x1[1]) + (x1[2] * x1[2] + x1[3] * x1[3]);
                    u32x4 w; w.x = cvt_pk_bf16(x0[0], x0[1]); w.y = cvt_pk_bf16(x0[2], x0[3]); w.z = cvt_pk_bf16(x1[0], x1[1]); w.w = cvt_pk_bf16(x1[2], x1[3]);
                    *(u32x4*)(xb + off + bj * 32) = w; }
                q += __shfl_xor(q, 16); q += __shfl_xor(q, 32); if (fq == 0) ssq[(size_t)row * 16 + u.pn * 4 + wc] = q;
            }
            asm volatile("" ::: "memory");
        }
    }
};
struct EpiLift {
    static constexpr int MIN_STORES = 0;
    static constexpr bool PERM = true, KEEP = true, CONTIG = false;
    const bf16* fac; bf16* mb; int ldc; const float* ssqc;
    __device__ __forceinline__ void operator()(f32x4 (&acc)[2][2][4][2], const Unit& u, int wr, int wc, int fr, int fq) const {
        const int row0 = u.pm * BM + wr * 64 + fr, col0 = u.pn * BM + wc * 32 + 8 * fq;
        f32x2 sc[2][4];
        if (u.z == 1 || u.z == 2) {
#pragma unroll
            for (int ai = 0; ai < 2; ++ai)
#pragma unroll
                for (int m = 0; m < 4; ++m) sc[ai][m] = *(const f32x2*)(ssqc + (size_t)(row0 + ai * HALF + m * 16) * 8 + 2 * fq); }
#pragma unroll
        for (int ai = 0; ai < 2; ++ai) {
            u32x4 gv[4][2];
#pragma unroll
            for (int m = 0; m < 4; ++m)
#pragma unroll
                for (int bj = 0; bj < 2; ++bj) gv[m][bj] = *(const u32x4*)(fac + (((((size_t)(u.pm * 4 + u.pn) * 4 + u.z) * 16 + (ai * 4 + m) * 2 + bj) * 8 + (wr * 4 + wc)) * 64 + fq * 16 + fr) * 8);
            asm volatile("" ::: "memory");
#pragma unroll
            for (int m = 0; m < 4; ++m) { const int row = row0 + ai * HALF + m * 16;
                float rsc = 1.f;
                if (u.z == 1 || u.z == 2) { float sq = sc[ai][m].x + sc[ai][m].y; sq += __shfl_xor(sq, 16); sq += __shfl_xor(sq, 32);
                    const float v = sq * (1.f / 512.f) + 1e-6f; rsc = (u.z == 1) ? sqrtf(v) : rsqrtf(v); }
#pragma unroll
                for (int bj = 0; bj < 2; ++bj) { const int col = col0 + bj * HALF;
                    const u32x4 g0 = gv[m][bj];
                    f32x4& v0 = acc[ai][bj][m][0]; f32x4& v1 = acc[ai][bj][m][1];
                    v0[0] *= rsc * bf2f(g0.x & 0xffffu); v0[1] *= rsc * bf2f(g0.x >> 16); v0[2] *= rsc * bf2f(g0.y & 0xffffu); v0[3] *= rsc * bf2f(g0.y >> 16);
                    v1[0] *= rsc * bf2f(g0.z & 0xffffu); v1[1] *= rsc * bf2f(g0.z >> 16); v1[2] *= rsc * bf2f(g0.w & 0xffffu); v1[3] *= rsc * bf2f(g0.w >> 16);
                    if (u.z == 3) { u32x4 w; w.x = cvt_pk_bf16(v0[0], v0[1]); w.y = cvt_pk_bf16(v0[2], v0[3]); w.z = cvt_pk_bf16(v1[0], v1[1]); w.w = cvt_pk_bf16(v1[2], v1[3]);
                        *(u32x4*)(mb + (size_t)row * ldc + col) = w; } } }
            asm volatile("" ::: "memory");
        }
    }
};

__device__ __forceinline__ float dpp_ror1(float x) { return __int_as_float(__builtin_amdgcn_update_dpp(0, __float_as_int(x), 0x121, 0xf, 0xf, false)); }
__device__ __forceinline__ float dpp_ror2(float x) { return __int_as_float(__builtin_amdgcn_update_dpp(0, __float_as_int(x), 0x122, 0xf, 0xf, false)); }
__device__ __forceinline__ float dpp_shr1(float x) { return __int_as_float(__builtin_amdgcn_update_dpp(0, __float_as_int(x), 0x111, 0xf, 0xf, true)); }
__device__ __forceinline__ float dpp_shr2(float x) { return __int_as_float(__builtin_amdgcn_update_dpp(0, __float_as_int(x), 0x112, 0xf, 0xf, true)); }
__device__ __forceinline__ float dpp_prev1(float cur, float prev) { return __int_as_float(__builtin_amdgcn_update_dpp(__builtin_amdgcn_update_dpp(0, __float_as_int(prev), 0x121, 0xf, 0xf, false), __float_as_int(cur), 0x111, 0xf, 0xf, false)); }
__device__ __forceinline__ float dpp_prev2(float cur, float prev) { return __int_as_float(__builtin_amdgcn_update_dpp(__builtin_amdgcn_update_dpp(0, __float_as_int(prev), 0x122, 0xf, 0xf, false), __float_as_int(cur), 0x112, 0xf, 0xf, false)); }
struct EpiConvAct {
    static constexpr int MIN_STORES = 12;
    static constexpr bool PERM = true, KEEP = false, CONTIG = false;
    bf16* act; const float* ssq; const float* cw; const float* cb; float* rawh; LAS unsigned char* halo; int ntn;
    __device__ __forceinline__ void operator()(f32x4 (&acc)[2][2][4][2], const Unit& u, int wr, int wc, int fr, int fq) const {
        asm volatile("" : "+v"(fr), "+v"(fq));
        const int row0 = u.pm * BM + wr * 64 + fr, ch0 = u.pn * 128 + wc * 32 + 8 * fq;
        LAS float* rsl = (LAS float*)(halo + 12288);
        LAS float* WL = (LAS float*)(halo + 8192);
        const int wl_i2 = ((wr * 4 + wc) * 64 + fq * 16 + fr) * 2;
        f32x2 wlv;
        { const int kind = wl_i2 >> 7, c = wl_i2 & 127, k4 = kind & 3; const float* src = (k4 < 3 ? cw + k4 * 5632 : cb) + (kind >= 4 ? 2816 : 0) + u.pn * 128 + c; wlv = *(const f32x2*)src; }
        panel_rstd(rsl, ssq, u.pm, wr, wc, fr, fq);
#pragma unroll
        for (int ai = 0; ai < 2; ++ai)
#pragma unroll
            for (int m = 0; m < 4; ++m) { const float rs = rsl[wr * 64 + fr + ai * HALF + m * 16];
#pragma unroll
                for (int bj = 0; bj < 2; ++bj) { acc[ai][bj][m][0] = acc[ai][bj][m][0] * rs; acc[ai][bj][m][1] = acc[ai][bj][m][1] * rs; } }
        LAS f32x4* H = (LAS f32x4*)halo;
        if (fr >= 14) {
#pragma unroll
            for (int ai = 0; ai < 2; ++ai) { const int b = 2 * ai + wr;
#pragma unroll
                for (int bj = 0; bj < 2; ++bj)
#pragma unroll
                    for (int n = 0; n < 2; ++n) H[((((b * 4 + wc) * 4 + fq) * 2 + (fr - 14)) * 2 + bj) * 2 + n] = acc[ai][bj][3][n]; } }
        { float* rw = rawh + (size_t)(u.pm * ntn + u.pn) * 1024;
          if (wr == 1 && fr >= 14) {
#pragma unroll
            for (int bj = 0; bj < 2; ++bj)
#pragma unroll
                for (int n = 0; n < 2; ++n) *(f32x4*)(rw + (2 + fr - 14) * 256 + bj * HALF + wc * 32 + 8 * fq + 4 * n) = acc[1][bj][3][n]; }
          if (wr == 0 && fr < 2) {
#pragma unroll
            for (int bj = 0; bj < 2; ++bj)
#pragma unroll
                for (int n = 0; n < 2; ++n) *(f32x4*)(rw + fr * 256 + bj * HALF + wc * 32 + 8 * fq + 4 * n) = acc[0][bj][0][n]; } }
        *(LAS f32x2*)(WL + wl_i2) = wlv;
        asm volatile("s_waitcnt lgkmcnt(0)" ::: "memory"); __builtin_amdgcn_s_barrier(); asm volatile("" ::: "memory");
        bf16* actb = act + ((size_t)(u.pm * ntn + u.pn) * BM + wr * 64) * 128 + wc * 32;
        const unsigned alane = (unsigned)(fr * 128 + 8 * fq);
        const float lm1 = (fr == 0) ? 1.f : 0.f, lm2 = (fr < 2) ? 1.f : 0.f;
        float zf = 0.f; asm volatile("" : "+v"(zf));
        unsigned pkw[2][4][3];
#pragma unroll
        for (int n = 0; n < 2; ++n) {
#pragma unroll
            for (int eh = 0; eh < 2; ++eh) {
                const int cl = wc * 32 + 8 * fq + 4 * n + 2 * eh;
                f32x2 wg[3], wu[3], bg, bu;
#pragma unroll
                for (int j = 0; j < 3; ++j) { wg[j] = *(const LAS f32x2*)(WL + j * 128 + cl); wu[j] = *(const LAS f32x2*)(WL + (4 + j) * 128 + cl); }
                bg = *(const LAS f32x2*)(WL + 3 * 128 + cl); bu = *(const LAS f32x2*)(WL + 7 * 128 + cl);
#pragma unroll
                for (int j = 0; j < 3; ++j) { wg[j] = wg[j] * 1.4426950408889634f; wu[j] = wu[j] * 0.6931471805599453f; }
                bg = bg * 1.4426950408889634f; bu = bu * 0.6931471805599453f;
                f32x2 wg1m = wg[1] * lm1, wg0m = wg[0] * lm2, wu1m = wu[1] * lm1, wu0m = wu[0] * lm2;
                asm volatile("" : "+v"(wg1m), "+v"(wg0m), "+v"(wu1m), "+v"(wu0m));
#pragma unroll
                for (int ai = 0; ai < 2; ++ai) { const int b = 2 * ai + wr;
#pragma unroll
                    for (int m = 3; m >= 0; --m) {
                        float r2[2];
#pragma unroll
                        for (int e2 = 0; e2 < 2; ++e2) { const int e = 2 * eh + e2;
                            const float gc = acc[ai][0][m][n][e], uc = acc[ai][1][m][n][e];
                            float gp = zf, up = zf;
                            if (m > 0) { gp = acc[ai][0][m - 1][n][e]; up = acc[ai][1][m - 1][n][e]; }
                            else if (b >= 1) { const int fk = fr >= 14 ? fr - 14 : 0; const LAS float* hp = (const LAS float*)(H + ((((b - 1) * 4 + wc) * 4 + fq) * 2 + fk) * 4 + n); gp = hp[e]; up = hp[8 + e]; }
                            float vg = fmaf(wg[2][e2], gc, bg[e2]), vu = fmaf(wu[2][e2], uc, bu[e2]);
                            asm volatile("s_nop 1\n\t"
                                         "v_fmac_f32_dpp %0, %2, %4 row_shr:1 row_mask:0xf bank_mask:0xf bound_ctrl:0\n\t"
                                         "v_fmac_f32_dpp %1, %3, %5 row_shr:1 row_mask:0xf bank_mask:0xf bound_ctrl:0\n\t"
                                         "v_fmac_f32_dpp %0, %2, %6 row_shr:2 row_mask:0xf bank_mask:0xf bound_ctrl:0\n\t"
                                         "v_fmac_f32_dpp %1, %3, %7 row_shr:2 row_mask:0xf bank_mask:0xf bound_ctrl:0\n\t"
                                         "v_fmac_f32_dpp %0, %8, %10 row_ror:1 row_mask:0xf bank_mask:0xf\n\t"
                                         "v_fmac_f32_dpp %1, %9, %11 row_ror:1 row_mask:0xf bank_mask:0xf\n\t"
                                         "v_fmac_f32_dpp %0, %8, %12 row_ror:2 row_mask:0xf bank_mask:0xf\n\t"
                                         "v_fmac_f32_dpp %1, %9, %13 row_ror:2 row_mask:0xf bank_mask:0xf"
                                         : "+v"(vg), "+v"(vu)
                                         : "v"(gc), "v"(uc), "v"(wg[1][e2]), "v"(wu[1][e2]), "v"(wg[0][e2]), "v"(wu[0][e2]), "v"(gp), "v"(up), "v"(wg1m[e2]), "v"(wu1m[e2]), "v"(wg0m[e2]), "v"(wu0m[e2]));
                            r2[e2] = (vg * vu) * __builtin_amdgcn_rcpf(1.f + __builtin_amdgcn_exp2f(-vg)); }
                        const unsigned pk = cvt_pk_bf16(r2[0], r2[1]);
                        if (2 * n + eh < 3) pkw[ai][m][2 * n + eh] = pk;
                        else *(u32x4*)(actb + (size_t)(ai * HALF + m * 16) * 128 + alane) = (u32x4){pkw[ai][m][0], pkw[ai][m][1], pkw[ai][m][2], pk};
                    }
                }
            }
        }
    }
};

template <class Epi, bool ALIGN_EPI = true>
__device__ __forceinline__ void gemm_phase(LAS unsigned char* lds, const Gemm g, const Order& S, const Epi& E) {
    int tid = threadIdx.x; asm volatile("" : "+v"(tid));
    const int wid = __builtin_amdgcn_readfirstlane(tid >> 6), lane = tid & 63, wr = wid >> 2, wc = wid & 3, fr = lane & 15, fq = lane >> 4;
    const int K = g.K, nt = K / BK;
    unsigned voffA[2], voffB[2];
#pragma unroll
    for (int i = 0; i < 2; ++i) { int R, C; stage_rc(tid * 16 + i * 8192, R, C);
        const int Rb = Epi::CONTIG ? (64 * (R >> 5) + perm32(R & 31)) : (Epi::PERM ? ((R & ~31) + perm32(R & 31)) : R);
        voffA[i] = (unsigned)(R * g.lda + C) * 2u; voffB[i] = (unsigned)(Rb * g.ldb + C) * 2u; }
    const size_t kstep = (size_t)(BK * 2);
    const size_t hstepA = (size_t)HALF * g.lda * 2, hstepB = (size_t)(Epi::CONTIG ? 32 : HALF) * g.ldb * 2;
    const size_t tstepA = g.atile ? g.atile : 2 * hstepA, tstepB = (size_t)BM * g.ldb * 2;
    const unsigned ldsw = (unsigned)wid * 1024u;
    const int aoff = lds_byte(wr * 64 + fr, fq * 8), boff = lds_byte(wc * 32 + fr, fq * 8);
#define PG8_SA(b, h) (((b) * 2 + (h)) * HTB)
#define PG8_SB(b, h) ((4 + (b) * 2 + (h)) * HTB)
#define PG8_STAGE(bufoff, gbase, voff) do { _Pragma("unroll") for (int _i = 0; _i < 2; ++_i) \
        __builtin_amdgcn_global_load_lds((const unsigned*)((const char*)(gbase) + (voff)[_i]), (LAS unsigned*)(lds + (bufoff) + ldsw + _i * 8192), 16, 0, 0); } while (0)
#define PG8_LDA(dst, b, h) do { _Pragma("unroll") for (int m = 0; m < 4; ++m) _Pragma("unroll") for (int k = 0; k < 2; ++k) dst[m][k] = *(const LAS bf16x8*)(lds + PG8_SA(b, h) + aoff + m * 2048 + k * 1024); } while (0)
#define PG8_LDB(dst, b, h) do { _Pragma("unroll") for (int n = 0; n < 2; ++n) _Pragma("unroll") for (int k = 0; k < 2; ++k) dst[n][k] = *(const LAS bf16x8*)(lds + PG8_SB(b, h) + boff + n * 2048 + k * 1024); } while (0)
#define PG8_MMA(ai, bj, At, Bt) do { __builtin_amdgcn_s_setprio(1); _Pragma("unroll") for (int m = 0; m < 4; ++m) _Pragma("unroll") for (int n = 0; n < 2; ++n) _Pragma("unroll") for (int k = 0; k < 2; ++k) \
        acc[ai][bj][m][n] = __builtin_amdgcn_mfma_f32_16x16x32_bf16(Bt[n][k], At[m][k], acc[ai][bj][m][n], 0, 0, 0); __builtin_amdgcn_s_setprio(0); } while (0)
#define PG8_WAIT_V(n) asm volatile("s_waitcnt vmcnt(" #n ")" ::: "memory")
#define PG8_WAIT_L(n) asm volatile("s_waitcnt lgkmcnt(" #n ")" ::: "memory")
#define PG8_WAIT_V8R(r) asm volatile("s_cmp_lg_u32 %0, 0\n\ts_cbranch_scc0 .Lw8_%=\n\ts_waitcnt vmcnt(%1)\n\ts_branch .Lwd_%=\n.Lw8_%=:\n\ts_waitcnt vmcnt(8)\n.Lwd_%=:" :: "s"(__builtin_amdgcn_readfirstlane(r)), "n"(8 + Epi::MIN_STORES) : "memory", "scc")
#define PG8_BAR __builtin_amdgcn_s_barrier()
#define PG8_SCHED __builtin_amdgcn_sched_barrier(0)
    Unit cur, nxt; int ui = 0;
    if (!S.next(0, cur)) return;
    f32x4 acc[2][2][4][2];
#pragma unroll
    for (int a = 0; a < 2; ++a)
#pragma unroll
        for (int b = 0; b < 2; ++b)
#pragma unroll
            for (int m = 0; m < 4; ++m)
#pragma unroll
                for (int n = 0; n < 2; ++n) acc[a][b][m][n] = (f32x4){0.f, 0.f, 0.f, 0.f};
    bf16x8 At[4][2], B0[2][2], B1[2][2];
    const char* cA = (const char*)g.A + (size_t)cur.pm * tstepA + (size_t)cur.z * g.zA; const char* cB = (const char*)g.Bt + (size_t)cur.pn * tstepB + (size_t)cur.z * g.zB;
    PG8_STAGE(PG8_SB(0, 0), cB, voffB); PG8_STAGE(PG8_SB(0, 1), cB + hstepB, voffB); PG8_STAGE(PG8_SA(0, 0), cA, voffA); PG8_STAGE(PG8_SA(0, 1), cA + hstepA, voffA);
    if (wr == 1) PG8_BAR;
    PG8_WAIT_V(2); PG8_BAR;
    PG8_STAGE(PG8_SB(1, 0), cB + kstep, voffB); PG8_STAGE(PG8_SA(1, 0), cA + kstep, voffA); PG8_STAGE(PG8_SB(1, 1), cB + hstepB + kstep, voffB);
    PG8_WAIT_V(6); PG8_BAR;
    for (;;) {
        const bool has_next = S.next(ui + 1, nxt);
        const char* nA = has_next ? (const char*)g.A + (size_t)nxt.pm * tstepA + (size_t)nxt.z * g.zA : cA; const char* nB = has_next ? (const char*)g.Bt + (size_t)nxt.pn * tstepB + (size_t)nxt.z * g.zB : cB;
        for (int t = 0; t < nt; t += 2) {
            const bool last = (t == nt - 2);
            const char* a1 = cA + (size_t)(t >> 1) * g.ablk + kstep;
            const char* a2 = last ? nA : cA + (size_t)((t >> 1) + 1) * g.ablk; const char* b2 = last ? nB : cB + (size_t)(t + 2) * kstep;
            const char* a3 = a2 + kstep; const char* b3 = b2 + kstep;
            const int relax = ((t == 0) && (ui > 0)) ? 1 : 0; (void)relax;
            PG8_LDB(B0, 0, 0); PG8_LDB(B1, 0, 1); PG8_SCHED; PG8_LDA(At, 0, 0); PG8_STAGE(PG8_SA(1, 1), a1 + hstepA, voffA);
            if constexpr (Epi::MIN_STORES > 0) PG8_WAIT_V8R(relax); else PG8_WAIT_V(8);
            PG8_WAIT_L(0); PG8_BAR; PG8_MMA(0, 0, At, B0); PG8_MMA(0, 1, At, B1); PG8_BAR; PG8_SCHED;
            PG8_LDA(At, 0, 1); PG8_STAGE(PG8_SB(0, 0), b2, voffB); PG8_STAGE(PG8_SB(0, 1), b2 + hstepB, voffB); PG8_STAGE(PG8_SA(0, 0), a2, voffA);
            if constexpr (Epi::MIN_STORES > 0) PG8_WAIT_V8R(relax); else PG8_WAIT_V(8);
            PG8_WAIT_L(0); PG8_BAR; PG8_MMA(1, 0, At, B0); PG8_MMA(1, 1, At, B1); PG8_BAR; PG8_SCHED;
            PG8_LDB(B0, 1, 0); PG8_LDB(B1, 1, 1); PG8_SCHED; PG8_LDA(At, 1, 0); PG8_STAGE(PG8_SA(0, 1), a2 + hstepA, voffA);
            PG8_WAIT_V(8); PG8_WAIT_L(0); PG8_BAR; PG8_MMA(0, 0, At, B0); PG8_MMA(0, 1, At, B1); PG8_BAR; PG8_SCHED;
            PG8_LDA(At, 1, 1); PG8_STAGE(PG8_SB(1, 0), b3, voffB); PG8_STAGE(PG8_SB(1, 1), b3 + hstepB, voffB); PG8_STAGE(PG8_SA(1, 0), a3, voffA);
            PG8_WAIT_V(8); PG8_WAIT_L(0); PG8_BAR; PG8_MMA(1, 0, At, B0); PG8_MMA(1, 1, At, B1); PG8_BAR; PG8_SCHED;
        }
        if constexpr (ALIGN_EPI) { if (wr == 0) PG8_BAR; }
        E(acc, cur, wr, wc, fr, fq);
        if (!has_next) break;
        if (!(Epi::KEEP && nxt.z != 0))
#pragma unroll
        for (int a = 0; a < 2; ++a)
#pragma unroll
            for (int b = 0; b < 2; ++b)
#pragma unroll
                for (int m = 0; m < 4; ++m)
#pragma unroll
                    for (int n = 0; n < 2; ++n) acc[a][b][m][n] = (f32x4){0.f, 0.f, 0.f, 0.f};
        cur = nxt; cA = nA; cB = nB; ++ui;
        if constexpr (ALIGN_EPI) { if (wr == 1) PG8_BAR; }
    }
    PG8_WAIT_V(0);
    if constexpr (!ALIGN_EPI) { if (wr == 0) PG8_BAR; }
    PG8_BAR;
#undef PG8_SA
#undef PG8_SB
#undef PG8_STAGE
#undef PG8_LDA
#undef PG8_LDB
#undef PG8_MMA
#undef PG8_WAIT_V
#undef PG8_WAIT_L
#undef PG8_WAIT_V8R
#undef PG8_BAR
#undef PG8_SCHED
}
}

#define XB_TMO      128
#define XB_XCNT(j)  (256  + 64 * (j))
#define XB_XSUB(j)  (1280 + 64 * (j))
#define XB_XGEN(j)  (2304 + 64 * (j))
#define XB_TOP      3328
#define XB_TOPGEN   3392
#define XCD_BAR_WORDS 3456
#define XB_SPIN_CAP (1u << 18)
__device__ __forceinline__ unsigned xb_ld(unsigned* p)              { return __hip_atomic_load(p, __ATOMIC_RELAXED, __HIP_MEMORY_SCOPE_AGENT); }
__device__ __forceinline__ unsigned xb_add(unsigned* p, unsigned v) { return __hip_atomic_fetch_add(p, v, __ATOMIC_RELAXED, __HIP_MEMORY_SCOPE_AGENT); }
__device__ __forceinline__ unsigned xb_xcc_id() { return (unsigned)__builtin_amdgcn_s_getreg((3 << 11) | 20) & 0xFu; }
#define XB_SPIN(cond, bar) do { unsigned _sp = 0; while (cond) { __builtin_amdgcn_s_sleep(1); \
    if ((++_sp & 255u) == 0u) { if (xb_ld(&(bar)[XB_TMO])) break; if (_sp > XB_SPIN_CAP) { atomicAdd(&(bar)[XB_TMO], 1u); break; } } } } while (0)
struct XcdBarrier { unsigned* bar; unsigned x; volatile LAS unsigned* st; };
__device__ __forceinline__ XcdBarrier xcd_barrier_post(unsigned* bar, volatile LAS unsigned* st) {
    XcdBarrier b; b.bar = bar; b.x = xb_xcc_id(); b.st = st;
    if (threadIdx.x == 0) (void)xb_add(&bar[XB_XCNT(b.x)], 1u);
    return b;
}
__device__ __forceinline__ void xcd_barrier_complete(unsigned* bar, unsigned x, unsigned& nloc, unsigned& nx) {
    const unsigned G = gridDim.x * gridDim.y * gridDim.z;
    unsigned sum, cnt, mine, sp = 0u;
    for (;;) {
        sum = 0u; cnt = 0u; mine = 0u;
#pragma unroll
        for (unsigned j = 0; j < 16; ++j) { const unsigned c = xb_ld(&bar[XB_XCNT(j)]); sum += c; cnt += (c > 0u) ? 1u : 0u; mine = (j == x) ? c : mine; }
        if (sum == G) break;
        __builtin_amdgcn_s_sleep(1);
        if ((++sp & 255u) == 0u) { if (xb_ld(&bar[XB_TMO])) break; if (sp > XB_SPIN_CAP) { atomicAdd(&bar[XB_TMO], 1u); break; } }
    }
    nloc = mine > 0u ? mine : 1u; nx = cnt > 0u ? cnt : 1u;
}
__device__ __forceinline__ void xcd_barrier(const XcdBarrier& b) {
    asm volatile("s_waitcnt vmcnt(0)" ::: "memory");
    __syncthreads();
    if (threadIdx.x == 0) {
        unsigned* bar = b.bar;
        __builtin_amdgcn_s_waitcnt(0);
        unsigned nloc = b.st[0], nx = b.st[1];
        if (nloc == 0u) { xcd_barrier_complete(bar, b.x, nloc, nx); b.st[0] = nloc; b.st[1] = nx; }
        const unsigned old = xb_add(&bar[XB_XSUB(b.x)], 1u);
        const unsigned gen = old / nloc;
        if (old + 1u == (gen + 1u) * nloc) {
            __builtin_amdgcn_fence(__ATOMIC_RELEASE, "agent");
            asm volatile("s_waitcnt vmcnt(0)" ::: "memory");
            const unsigned og = xb_add(&bar[XB_TOP], 1u);
            const unsigned tg = og / nx;
            if (og + 1u == (tg + 1u) * nx) xb_add(&bar[XB_TOPGEN], 1u);
            else XB_SPIN(xb_ld(&bar[XB_TOPGEN]) == tg, bar);
            __builtin_amdgcn_fence(__ATOMIC_ACQUIRE, "agent");
            xb_add(&bar[XB_XGEN(b.x)], 1u);
            asm volatile("s_waitcnt vmcnt(0)" ::: "memory");
        } else {
            XB_SPIN(xb_ld(&bar[XB_XGEN(b.x)]) == gen, bar);
            __builtin_amdgcn_fence(__ATOMIC_ACQUIRE, "agent");
            asm volatile("s_waitcnt vmcnt(0)" ::: "memory");
        }
    }
    __syncthreads();
}

__device__ __forceinline__ bf16x8 frag_kc(const LAS bf16* X, int ld, int mn0, int k0, int lane) { return *(const LAS bf16x8*)(X + (mn0 + (lane & 15)) * ld + k0 + 8 * (lane >> 4)); }
__device__ __forceinline__ bf16x8 gfrag_kc(const bf16* X, int ld, int mn0, int k0, int lane) { const bf16* b = X + (size_t)mn0 * ld + k0; const unsigned lo = (unsigned)((lane & 15) * ld + 8 * (lane >> 4)); return *(const bf16x8*)(b + lo); }
__device__ __forceinline__ s16x4 trr(const LAS bf16* p) { return __builtin_bit_cast(s16x4, __builtin_amdgcn_ds_read_tr16_b64_v4i16((LAS s16x4*)p)); }
__device__ __forceinline__ bf16x8 frag_ks(const LAS bf16* X, int ld, int mn0, int k0, int lane) {
    const int r = lane & 15, g = lane >> 4;
    const LAS bf16* p = X + (k0 + 8 * g + (r >> 2)) * ld + mn0 + 4 * (r & 3);
    const s16x4 lo = trr(p), hi = trr(p + 4 * ld);
    return (bf16x8){lo[0], lo[1], lo[2], lo[3], hi[0], hi[1], hi[2], hi[3]};
}
__device__ __forceinline__ f32x4 zero4() { f32x4 z = {0.f, 0.f, 0.f, 0.f}; asm volatile("" : "+v"(z)); return z; }
__device__ __forceinline__ u32x4 uone4() { u32x4 z = {0x3F80u, 0u, 0u, 0u}; asm volatile("" : "+v"(z)); return z; }
__device__ __forceinline__ u32x4 uzero4() { u32x4 z = {0u, 0u, 0u, 0u}; asm volatile("" : "+v"(z)); return z; }
#define MFMA16(a, b, c) __builtin_amdgcn_mfma_f32_16x16x32_bf16((a), (b), (c), 0, 0, 0)
__device__ __forceinline__ u32x4 scale8(u32x4 w, float s) {
    u32x4 o;
    o.x = pk2(bf2f(w.x & 0xffffu) * s, bf2f(w.x >> 16) * s); o.y = pk2(bf2f(w.y & 0xffffu) * s, bf2f(w.y >> 16) * s);
    o.z = pk2(bf2f(w.z & 0xffffu) * s, bf2f(w.z >> 16) * s); o.w = pk2(bf2f(w.w & 0xffffu) * s, bf2f(w.w >> 16) * s);
    return o;
}
__device__ __forceinline__ float wscan_add(float v, int lane) {
#pragma unroll
    for (int o = 1; o < 64; o <<= 1) { const float t = __shfl_up(v, o); if (lane >= o) v += t; }
    return v;
}
__device__ __forceinline__ float wscan_max(float v, int lane) {
#pragma unroll
    for (int o = 1; o < 64; o <<= 1) { const float t = __shfl_up(v, o); if (lane >= o) v = fmaxf(v, t); }
    return v;
}

#ifndef GEMM_ALIGN
#define GEMM_ALIGN true
#endif
enum { PH_W = 0, PH_INPROJ, PH_M0, PH_M1, PH_M2, PH_M3, PH_LIFT, PH_OUT, PH_UP, PH_DOWN, PH_FINAL, PH_COUNT };
enum { I_X = 0, I_MIXG, I_WIN, I_AIB, I_AFB, I_ANG, I_BCW, I_CCW, I_CCB, I_CDTB, I_CALOG, I_CDSKIP, I_CNG, I_WLIFT, I_WOUT, I_FFNG, I_WUP, I_FCW, I_FCB, I_WDOWN, I_FING, N_IN };
struct Args { const float* in[N_IN]; float* out; unsigned char* ws; int l_lo, l_hi, g_lo, g_hi, ph_lo, ph_hi, use_bar, pad; };

__device__ __forceinline__ void transpose_item(const float* W, int ldw, int nsrc0, int k0, bf16* WT, int ldt, int ndst0, LAS float* scr, int lane, const float* kscale = nullptr, int gate_tile = -1) {
    int scol = nsrc0 + (lane & 31);
    if (gate_tile >= 0) {
        const int c = (ndst0 & 255) + (lane & 31), wc = c >> 6, bj = (c >> 5) & 1, fq = (c >> 3) & 3, n = (c >> 2) & 1, e = c & 3;
        scol = 6160 + (2 * bj + n) * 1024 + 64 * gate_tile + 16 * wc + 4 * fq + e; }
#pragma unroll 8
    for (int i = 0; i < 32; ++i) { const int kk = 2 * i + (lane >> 5); scr[kk * 33 + (lane & 31)] = W[(size_t)(k0 + kk) * ldw + scol] * (kscale ? kscale[k0 + kk] : 1.f); }
    LDS_WAIT(); asm volatile("" ::: "memory");
    const int c = lane & 7;
#pragma unroll
    for (int j = 0; j < 4; ++j) { const int n = (lane >> 3) + 8 * j; const LAS float* s = scr + (8 * c) * 33 + n;
        u32x4 o; o.x = pk2(s[0 * 33], s[1 * 33]); o.y = pk2(s[2 * 33], s[3 * 33]); o.z = pk2(s[4 * 33], s[5 * 33]); o.w = pk2(s[6 * 33], s[7 * 33]);
        *(u32x4*)(WT + (size_t)(ndst0 + n) * ldt + k0 + 8 * c) = o; }
    LDS_WAIT(); asm volatile("" ::: "memory");
}

__global__ void __launch_bounds__(NTHR, 2) fwd(Args args) {
    extern __shared__ __attribute__((aligned(16))) unsigned char lds_raw[];
    LAS unsigned char* lds = (LAS unsigned char*)lds_raw;
    const int NBLK = gridDim.x, blk = blockIdx.x;
    {
        volatile LAS unsigned* MISC0 = (volatile LAS unsigned*)(lds + MISC_OFF);
        if (threadIdx.x < 16) MISC0[threadIdx.x] = 0u;
        __syncthreads();
    }
    XcdBarrier bar; bar.bar = (unsigned*)(args.ws + WS_CTL) + 4096; bar.x = 0; bar.st = nullptr;
    if (args.use_bar) bar = xcd_barrier_post((unsigned*)(args.ws + WS_CTL) + 4096, (volatile LAS unsigned*)(lds + MISC_OFF) + 8);
#define GRID_BAR() do { if (args.use_bar) xcd_barrier(bar); } while (0)
#ifndef REPMASK
#define REPMASK 0
#endif
#define IN(k) (args.ph_lo <= (k) && (k) < args.ph_hi)
#define REPS(k) for (int rep_ = 0; rep_ < 1 + ((REPMASK >> (k)) & 1); ++rep_)
#define PHASE_BEGIN() int tid = threadIdx.x; asm volatile("" : "+v"(tid)); const int lane = tid & 63, wave = __builtin_amdgcn_readfirstlane(tid >> 6); \
    const __attribute__((address_space(4))) Args* ka = (const __attribute__((address_space(4))) Args*)__builtin_amdgcn_kernarg_segment_ptr(); asm volatile("" : "+s"(ka)); \
    unsigned char* ws = ka->ws; \
    const size_t grow0 = (size_t)grp * T; const float* xsrc = (l == 0) ? ka->in[I_X] : ka->out; (void)grow0; (void)xsrc; \
    const int gw = blk * NWAVES + wave, NGW = NBLK * NWAVES, gt = blk * NTHR + tid, NGT = NBLK * NTHR; (void)lane; (void)gw; (void)NGW; (void)gt; (void)NGT; \
    bf16* const WinT = (bf16*)(ws + WS_WIN); bf16* const WliftT = (bf16*)(ws + WS_WLIFT); bf16* const WoutT = (bf16*)(ws + WS_WOUT); \
    bf16* const WupT = (bf16*)(ws + WS_WUP); bf16* const WdownT = (bf16*)(ws + WS_WDOWN); bf16* const W16B = (bf16*)(ws + WS_W16); \
    bf16* const XN = (bf16*)(ws + WS_XN); bf16* const P = (bf16*)(ws + WS_P); bf16* const FAC = (bf16*)(ws + WS_P) + (size_t)T * PWS; (void)FAC; bf16* const U = (bf16*)(ws + WS_U); bf16* const ACT = (bf16*)(ws + WS_ACT); \
    bf16* const YCAT = (bf16*)(ws + WS_YCAT); bf16* const XG = (bf16*)(ws + WS_XG); bf16* const MB = (bf16*)(ws + WS_MB); float* const SP = (float*)(ws + WS_SP); \
    float* const SSQ1 = (float*)(ws + WS_SSQ1); float* const SSQ2 = (float*)(ws + WS_SSQ2); float* const SSQC = (float*)(ws + WS_SSQC); float* const RAWH = (float*)(ws + WS_RAWH); (void)SSQ1; (void)SSQ2; (void)SSQC; (void)RAWH; \
    float* const GBc = (float*)(ws + WS_GB); float* const GGc = (float*)(ws + WS_GG); float* const GMT = (float*)(ws + WS_GMT); \
    float* const MCAR = (float*)(ws + WS_MCAR); float* const MNEW = (float*)(ws + WS_MNEW); float* const MSC = (float*)(ws + WS_MSC); float* const SUMB = (float*)(ws + WS_SUMB); float* const SUMG = (float*)(ws + WS_SUMG); (void)SUMB; (void)SUMG; \
    float* const DTB = (float*)(ws + WS_DT); float* const ACB = (float*)(ws + WS_AC); bf16* const XBC = (bf16*)(ws + WS_XBC); \
    bf16* const DC = (bf16*)(ws + WS_DC); bf16* const CS = (bf16*)(ws + WS_CS); bf16* const DH = (bf16*)(ws + WS_DH); bf16* const HS = (bf16*)(ws + WS_HS); \
    (void)WinT; (void)WliftT; (void)WoutT; (void)WupT; (void)WdownT; (void)W16B; (void)XN; (void)P; (void)U; (void)ACT; (void)YCAT; (void)XG; (void)MB; (void)SP; (void)GBc; (void)GGc; (void)GMT; \
    (void)MCAR; (void)MNEW; (void)MSC; (void)DTB; (void)ACB; (void)XBC; (void)DC; (void)CS; (void)DH; (void)HS

    for (int l = args.l_lo; l < args.l_hi; ++l)
    for (int grp = args.g_lo; grp < args.g_hi; ++grp) {

        REPS(PH_W) if (IN(PH_W) && grp == 0) {
            PHASE_BEGIN();
            LAS float* scr = (LAS float*)(lds + wave * 16384);
            constexpr int I_IN = 16 * 320, I_LF = 4 * 8 * 32, I_OUT = 16 * 32, I_UP = 16 * 176, I_DN = 44 * 32, NIT = I_IN + I_LF + I_OUT + I_UP + I_DN;
            for (int it = gw; it < NIT; it += NGW) {
                int r = it;
                if (r < I_IN) { const int kb = r / 320, nb = r % 320, n0 = 32 * nb, ns = n0 + (n0 >= P_SQ ? 16 : (n0 >= P_BB ? 8 : 0));
                    transpose_item(ka->in[I_WIN] + (size_t)l * DM * PIN, PIN, ns, 64 * kb, WinT, DM, n0, scr, lane, ka->in[I_MIXG] + (size_t)l * DM, n0 >= P_G ? (n0 - P_G) >> 8 : -1); continue; } r -= I_IN;
                if (r < I_LF) { const int br = r / 256, q = r % 256, kb = q / 32, nb = q % 32;
                    transpose_item(ka->in[I_WLIFT] + (size_t)(l * 4 + br) * 512 * DM, DM, 32 * nb, 64 * kb, WliftT + (size_t)br * DM * 512, 512, 32 * nb, scr, lane, br == 2 ? ka->in[I_CNG] + (size_t)l * 512 : nullptr); continue; } r -= I_LF;
                if (r < I_OUT) { const int kb = r / 32, nb = r % 32;
                    transpose_item(ka->in[I_WOUT] + (size_t)l * DM * DM, DM, 32 * nb, 64 * kb, WoutT, DM, 32 * nb, scr, lane); continue; } r -= I_OUT;
                if (r < I_UP) { const int kb = r / 176, nb = r % 176, n0 = 32 * nb, tp = n0 >> 8, j = n0 & 255, ns = (j < 128) ? 128 * tp + j : 2816 + 128 * tp + (j - 128);
                    transpose_item(ka->in[I_WUP] + (size_t)l * DM * DFF2, DFF2, ns, 64 * kb, WupT, DM, n0, scr, lane, ka->in[I_FFNG] + (size_t)l * DM); continue; } r -= I_UP;
                { const int kb = r / 32, nb = r % 32;
                    transpose_item(ka->in[I_WDOWN] + (size_t)l * DFF * DM, DM, 32 * nb, 64 * kb, WdownT, DFF, 32 * nb, scr, lane); }
            }
            for (int i = gt; i < 16 * DM; i += NGT) { const int c = i >> 10, k = i & 1023; const int oc = (c < 8) ? (1536 + c) : (4616 + (c - 8));
                const float w = ka->in[I_WIN][(size_t)l * DM * PIN + (size_t)k * PIN + oc] * ka->in[I_MIXG][(size_t)l * DM + k]; const unsigned hi = f2bf(w);
                W16B[i] = (bf16)hi; W16B[16 * DM + i] = (bf16)f2bf(w - bf2f(hi)); }
            if (l == 0) {
                for (int m = gw; m < BATCH * SEQ; m += NGW) {
                    const f32x4* xr = (const f32x4*)(ka->in[I_X] + (size_t)m * DM) + lane;
                    f32x4 v[4]; float sq = 0.f;
#pragma unroll
                    for (int j = 0; j < 4; ++j) { v[j] = xr[64 * j]; sq += (v[j].x * v[j].x + v[j].y * v[j].y) + (v[j].z * v[j].z + v[j].w * v[j].w); }
                    sq = wave_sum(sq); if (lane < 16) SSQ1[(size_t)m * 16 + lane] = (lane == 0) ? sq : 0.f;
                    u32x2* o8 = (u32x2*)(XG + (size_t)m * DM) + lane;
#pragma unroll
                    for (int j = 0; j < 4; ++j) o8[64 * j] = (u32x2){pk2(v[j].x, v[j].y), pk2(v[j].z, v[j].w)};
                }
            }
            GRID_BAR();
        }

        REPS(PH_INPROJ) if (IN(PH_INPROJ)) {
            PHASE_BEGIN();
            const bf16* XGg = XG + grow0 * DM; const float* ssq = SSQ1 + grow0 * 16;
            if (tid == 0) *(volatile LAS int*)(lds + 143360 + 1024) = -1;
            for (int rb = blk; rb < T / 64; rb += NBLK) {
                const int r0 = rb * 64 + 16 * (wave & 3), kh = (wave >> 2) * 512; f32x4 acc = zero4(), acc2 = zero4();
                float rsd[4];
#pragma unroll
                for (int i = 0; i < 4; ++i) rsd[i] = row_rstd(ssq + (size_t)(r0 + 4 * (lane >> 4) + i) * 16);
#pragma unroll 8
                for (int ks = 0; ks < 16; ++ks) { const bf16x8 a = gfrag_kc(XGg, DM, r0, kh + 32 * ks, lane);
                    acc = MFMA16(a, gfrag_kc(W16B, DM, 0, kh + 32 * ks, lane), acc); acc2 = MFMA16(a, gfrag_kc(W16B + 16 * DM, DM, 0, kh + 32 * ks, lane), acc2); }
                acc += acc2;
                LAS f32x4* xch = (LAS f32x4*)lds;
                if (wave >= 4) xch[(wave - 4) * 64 + lane] = acc;
                __syncthreads();
                if (wave < 4) { acc += xch[wave * 64 + lane];
#pragma unroll
                    for (int i = 0; i < 4; ++i) { const int row = r0 + 4 * (lane >> 4) + i; SP[(size_t)row * 16 + (lane & 15)] = acc[i] * rsd[i]; } }
                __syncthreads();
            }
            pg8::Gemm g{XGg, WinT, DM, DM, DM, 0, 0}; pg8::Order S; S.init(T, PW, NBLK, blk, 1);
            pg8::EpiBf16 E{(LAS float*)(lds + 143360), P, PWS, ssq, P_G / 256, FAC};
            pg8::gemm_phase<pg8::EpiBf16, GEMM_ALIGN>(lds, g, S, E);
            GRID_BAR();
        }

        REPS(PH_M0) if (IN(PH_M0)) {
            PHASE_BEGIN();
#pragma unroll 1
            for (int pass = 0; pass < 2; ++pass) {
            if ((pass ^ (blk & 1)) == 0) {
            for (int task = gw; task < GB * 4 * NCH; task += NGW) {
                const int bh = task >> 5, c = task & 31, bl = bh >> 2, h = bh & 3;
                const size_t m = (size_t)bl * SEQ + c * 64 + lane;
                const float ig = SP[m * 16 + h] + ka->in[I_AIB][l * 4 + h], fg = SP[m * 16 + 4 + h] + ka->in[I_AFB][l * 4 + h];
                const float b = wscan_add(logsigf_(fg), lane);
                const float gg = ig - b;
                const float pm = wscan_max(gg, lane);
                GBc[m * 4 + h] = b; GGc[m * 4 + h] = gg; GMT[m * 4 + h] = pm;
                if (lane == 63) { SUMB[task] = b; SUMG[task] = pm; }
            }
            for (int task = gw; task < GB * NCH * 8; task += NGW) {
                const int hd = task & 7; const size_t m = (size_t)(task >> 3) * 64 + lane;
                const float dt = softplusf_(SP[m * 16 + 8 + hd] + ka->in[I_CDTB][l * 8 + hd]);
                const float a = wscan_add(-dt * __expf(ka->in[I_CALOG][l * 8 + hd]), lane);
                DTB[m * 8 + hd] = dt; ACB[m * 8 + hd] = a;
            }
            {
                const float* cw = ka->in[I_CCW] + (size_t)l * 4 * 1024; const float* cb = ka->in[I_CCB] + (size_t)l * 1024;
                constexpr int RUN = 16;
                for (int i = gt; i < (T / RUN) * 128; i += NGT) {
                    const int rb = i >> 7, c8 = (i & 127) * 8, m0 = rb * RUN, t0 = m0 & (SEQ - 1);
                    float w[4][8], bb[8];
#pragma unroll
                    for (int e = 0; e < 8; ++e) { bb[e] = cb[c8 + e];
#pragma unroll
                        for (int j = 0; j < 4; ++j) w[j][e] = cw[j * 1024 + c8 + e]; }
                    const u32x4 zz = uzero4(); u32x4 rowv[RUN + 3];
                    { const bf16* pr = P + (size_t)(t0 >= 3 ? m0 - 3 : m0) * PWS + P_CX + c8;
#pragma unroll
                      for (int j = 0; j < 3; ++j) { const u32x4 ld = *(const u32x4*)(pr + (size_t)j * PWS); rowv[j] = (t0 >= 3) ? ld : zz; } }
#pragma unroll
                    for (int rr = 0; rr < RUN; ++rr) rowv[3 + rr] = *(const u32x4*)(P + (size_t)(m0 + rr) * PWS + P_CX + c8);
                    asm volatile("" ::: "memory");
#pragma unroll
                    for (int rr = 0; rr < RUN; ++rr) {
                        float acc[8];
#pragma unroll
                        for (int e = 0; e < 8; ++e) acc[e] = bb[e];
#pragma unroll
                        for (int j = 0; j < 4; ++j) { const u32x4 wv = rowv[rr + j];
                            acc[0] += w[j][0] * bf2f(wv.x & 0xffffu); acc[1] += w[j][1] * bf2f(wv.x >> 16); acc[2] += w[j][2] * bf2f(wv.y & 0xffffu); acc[3] += w[j][3] * bf2f(wv.y >> 16);
                            acc[4] += w[j][4] * bf2f(wv.z & 0xffffu); acc[5] += w[j][5] * bf2f(wv.z >> 16); acc[6] += w[j][6] * bf2f(wv.w & 0xffffu); acc[7] += w[j][7] * bf2f(wv.w >> 16); }
                        u32x4 o; o.x = pk2(siluf_(acc[0]), siluf_(acc[1])); o.y = pk2(siluf_(acc[2]), siluf_(acc[3])); o.z = pk2(siluf_(acc[4]), siluf_(acc[5])); o.w = pk2(siluf_(acc[6]), siluf_(acc[7]));
                        *(u32x4*)(XBC + (size_t)(m0 + rr) * 1024 + c8) = o;
                    }
                }
            }
            {
                const float* bw = ka->in[I_BCW] + (size_t)l * 3 * 512;
                constexpr int RUN = 8;
                for (int i = gt; i < (T / RUN) * 64; i += NGT) {
                    const int rb = i >> 6, c8 = (i & 63) * 8, m0 = rb * RUN, t0 = m0 & (SEQ - 1);
                    float w[3][8];
#pragma unroll
                    for (int e = 0; e < 8; ++e)
#pragma unroll
                        for (int j = 0; j < 3; ++j) w[j][e] = bw[j * 512 + c8 + e];
                    const u32x4 zz = uzero4(); u32x4 av[RUN + 2], bv[RUN + 2], gv[RUN];
                    { const bf16* pr = P + (size_t)(t0 >= 2 ? m0 - 2 : m0) * PWS;
#pragma unroll
                      for (int j = 0; j < 2; ++j) { const u32x4 la = *(const u32x4*)(pr + (size_t)j * PWS + P_BC + c8), lb = *(const u32x4*)(pr + (size_t)j * PWS + P_BX + c8); av[j] = (t0 >= 2) ? la : zz; bv[j] = (t0 >= 2) ? lb : zz; } }
#pragma unroll
                    for (int rr = 0; rr < RUN; ++rr) { const bf16* pr = P + (size_t)(m0 + rr) * PWS; av[2 + rr] = *(const u32x4*)(pr + P_BC + c8); bv[2 + rr] = *(const u32x4*)(pr + P_BX + c8); gv[rr] = *(const u32x4*)(pr + P_BB + c8); }
                    asm volatile("" ::: "memory");
                    float pw[3][8];
#pragma unroll
                    for (int j = 0; j < 2; ++j) { const u32x4 a = av[j], b = bv[j];
                        pw[j][0] = bf2f(a.x & 0xffffu) * bf2f(b.x & 0xffffu); pw[j][1] = bf2f(a.x >> 16) * bf2f(b.x >> 16); pw[j][2] = bf2f(a.y & 0xffffu) * bf2f(b.y & 0xffffu); pw[j][3] = bf2f(a.y >> 16) * bf2f(b.y >> 16);
                        pw[j][4] = bf2f(a.z & 0xffffu) * bf2f(b.z & 0xffffu); pw[j][5] = bf2f(a.z >> 16) * bf2f(b.z >> 16); pw[j][6] = bf2f(a.w & 0xffffu) * bf2f(b.w & 0xffffu); pw[j][7] = bf2f(a.w >> 16) * bf2f(b.w >> 16); }
#pragma unroll
                    for (int rr = 0; rr < RUN; ++rr) {
                        const u32x4 a = av[2 + rr], b = bv[2 + rr], g = gv[rr];
                        pw[2][0] = bf2f(a.x & 0xffffu) * bf2f(b.x & 0xffffu); pw[2][1] = bf2f(a.x >> 16) * bf2f(b.x >> 16); pw[2][2] = bf2f(a.y & 0xffffu) * bf2f(b.y & 0xffffu); pw[2][3] = bf2f(a.y >> 16) * bf2f(b.y >> 16);
                        pw[2][4] = bf2f(a.z & 0xffffu) * bf2f(b.z & 0xffffu); pw[2][5] = bf2f(a.z >> 16) * bf2f(b.z >> 16); pw[2][6] = bf2f(a.w & 0xffffu) * bf2f(b.w & 0xffffu); pw[2][7] = bf2f(a.w >> 16) * bf2f(b.w >> 16);
                        float acc[8];
#pragma unroll
                        for (int e = 0; e < 8; ++e) acc[e] = w[0][e] * pw[0][e] + w[1][e] * pw[1][e] + w[2][e] * pw[2][e];
                        u32x4 o; o.x = pk2(acc[0] * bf2f(g.x & 0xffffu), acc[1] * bf2f(g.x >> 16)); o.y = pk2(acc[2] * bf2f(g.y & 0xffffu), acc[3] * bf2f(g.y >> 16));
                        o.z = pk2(acc[4] * bf2f(g.z & 0xffffu), acc[5] * bf2f(g.z >> 16)); o.w = pk2(acc[6] * bf2f(g.w & 0xffffu), acc[7] * bf2f(g.w >> 16));
                        *(u32x4*)(YCAT + (size_t)(m0 + rr) * YW + 512 + c8) = o;
#pragma unroll
                        for (int e = 0; e < 8; ++e) { pw[0][e] = pw[1][e]; pw[1][e] = pw[2][e]; }
                    }
                }
            }
            } else {
            __syncthreads();
            {
            LAS bf16* Qs = (LAS bf16*)lds; LAS bf16* Ks = Qs + 128 * 136; LAS bf16* Vs = Ks + 64 * 136; LAS bf16* Aw = Vs + 64 * 136 + wave * (16 * 72);
            const int r = lane & 15, g4 = lane >> 4;
            for (int u = blk; u < GB * 4 * 16; u += NBLK) {
                const int bl = u >> 6, h = (u >> 4) & 3, qt = u & 15; const size_t mb = (size_t)bl * SEQ; const int q0 = qt * 128;
                volatile LAS unsigned* FLG = (volatile LAS unsigned*)(lds + MISC_OFF + 128);
                int par = 0;
                __syncthreads();
                if (lane == 0) { FLG[wave] = 0u; FLG[8 + wave] = 0u; }
                for (int i = tid; i < 2048; i += NTHR) { const int s = i >> 4, c8 = i & 15; *(LAS u32x4*)(Qs + s * 136 + c8 * 8) = *(const u32x4*)(P + (mb + q0 + s) * PWS + P_SQ + h * 128 + c8 * 8); }
                f32x4 O[8];
#pragma unroll
                for (int d = 0; d < 8; ++d) O[d] = zero4();
                float racc = 0.f; const int tq = q0 + 16 * wave + r;
                u32x4 kreg[2], vreg[2];
                { const int s0f = (2 * qt + 1) * 64;
#pragma unroll
                  for (int k2 = 0; k2 < 2; ++k2) { const int i = tid + 512 * k2, s = i >> 4, c8 = i & 15; const bf16* pr = P + (mb + s0f + s) * PWS + h * 128 + c8 * 8; kreg[k2] = *(const u32x4*)(pr + P_SK); vreg[k2] = *(const u32x4*)(pr + P_SV); } }
                for (int kt = 2 * qt + 1; kt >= 0; --kt) {
                    const int s0 = kt * 64;
                    __syncthreads();
                    { unsigned alldone = 1u;
#pragma unroll
                      for (int w8 = 0; w8 < 8; ++w8) alldone &= FLG[par * 8 + w8];
                      if (__builtin_amdgcn_readfirstlane((int)alldone)) break; }
#pragma unroll
                    for (int k2 = 0; k2 < 2; ++k2) { const int i = tid + 512 * k2, s = i >> 4, c8 = i & 15; *(LAS u32x4*)(Ks + s * 136 + c8 * 8) = kreg[k2]; *(LAS u32x4*)(Vs + s * 136 + c8 * 8) = vreg[k2]; }
                    if (kt > 0) {
#pragma unroll
                        for (int k2 = 0; k2 < 2; ++k2) { const int i = tid + 512 * k2, s = i >> 4, c8 = i & 15; const bf16* pr = P + (mb + s0 - 64 + s) * PWS + h * 128 + c8 * 8; kreg[k2] = *(const u32x4*)(pr + P_SK); vreg[k2] = *(const u32x4*)(pr + P_SV); } }
                    __syncthreads();
                    if (s0 < q0 + 16 * wave + 15) {
                        f32x4 z[4];
#pragma unroll
                        for (int j = 0; j < 4; ++j) z[j] = zero4();
#pragma unroll
                        for (int ks = 0; ks < 4; ++ks) { const bf16x8 fq = frag_kc(Qs, 136, 16 * wave, 32 * ks, lane);
#pragma unroll
                            for (int j = 0; j < 4; ++j) z[j] = MFMA16(frag_kc(Ks, 136, 16 * j, 32 * ks, lane), fq, z[j]); }
                        float ls[4][4], x[4][4], tsum[4];
#pragma unroll
                        for (int j = 0; j < 4; ++j) { float tj = 0.f;
#pragma unroll
                            for (int i = 0; i < 4; ++i) { const int s = s0 + 16 * j + 4 * g4 + i; const float zz = z[j][i] * 0.08838834764831845f;
                                const float l1 = fminf(zz, 0.f) - __logf(1.f + __expf(-fabsf(zz)));
                                ls[j][i] = l1; x[j][i] = (s < tq) ? (l1 - zz) : 0.f; tj += x[j][i]; }
                            tsum[j] = tj; }
                        float above[4], tot[4];
#pragma unroll
                        for (int j = 0; j < 4; ++j) { const float y1 = __shfl_xor(tsum[j], 16), y2 = __shfl_xor(tsum[j], 32), y3 = __shfl_xor(tsum[j], 48);
                            tot[j] = tsum[j] + y1 + y2 + y3;
                            above[j] = (g4 == 0) ? (y1 + y2 + y3) : (g4 == 1) ? (y2 + y3) : (g4 == 2) ? y1 : 0.f; }
                        float hi = racc;
#pragma unroll
                        for (int j = 3; j >= 0; --j) { float run = hi + above[j]; float av[4];
#pragma unroll
                            for (int i = 3; i >= 0; --i) { const int s = s0 + 16 * j + 4 * g4 + i; av[i] = (s < tq) ? __expf(ls[j][i] + run) : 0.f; run += x[j][i]; }
                            *(LAS u32x2*)(Aw + r * 72 + 16 * j + 4 * g4) = (u32x2){pk2(av[0], av[1]), pk2(av[2], av[3])};
                            hi += tot[j]; }
                        racc = hi;
                        LDS_WAIT(); asm volatile("" ::: "memory");
#pragma unroll
                        for (int ks = 0; ks < 2; ++ks) { const bf16x8 fa = frag_kc(Aw, 72, 0, 32 * ks, lane);
#pragma unroll
                            for (int d = 0; d < 8; ++d) O[d] = MFMA16(fa, frag_ks(Vs, 136, 16 * d, 32 * ks, lane), O[d]); }
                    }
                    par ^= 1;
                    { const bool wd = __all(racc < -104.f); if (lane == 0) FLG[par * 8 + wave] = wd ? 1u : 0u; }
                }
#pragma unroll
                for (int d = 0; d < 8; ++d)
#pragma unroll
                    for (int i = 0; i < 4; ++i) YCAT[(mb + q0 + 16 * wave + 4 * g4 + i) * YW + 1536 + h * 128 + 16 * d + r] = (bf16)f2bf(O[d][i]);
            }
            }
            }
            }
            GRID_BAR();
        }

        REPS(PH_M1) if (IN(PH_M1)) {
            PHASE_BEGIN();
            constexpr int NUA = GB * 4 * NCH, NUC = GB * NCH;
            for (int u = blk; u < NUA + NUC; u += NBLK) {
                if (u < NUA) {
                    const int ua = u, bh = ua >> 5, c = ua & 31, bl = bh >> 2, h = bh & 3; const size_t m0 = (size_t)bl * SEQ + c * 64;
                    LAS bf16* VP = (LAS bf16*)lds; LAS bf16* WK = (LAS bf16*)(lds + 64 * 152 * 2);
                    float bLj = 0.f, gmj = -1e30f;
                    if (lane < 32) { bLj = SUMB[bh * 32 + lane]; gmj = SUMG[bh * 32 + lane]; }
                    float pa = bLj, pq = gmj + bLj;
#pragma unroll
                    for (int o = 1; o < 32; o <<= 1) { const float ta = __shfl_up(pa, o), tq = __shfl_up(pq, o); if (lane >= o) { pq = fmaxf(tq + pa, pq); pa = ta + pa; } }
                    const float mall = fmaxf(pa, pq);
                    const float mnew = __shfl(mall, c), mprev = (c == 0) ? 0.f : __shfl(mall, (c + 63) & 63);
                    const float bL = GBc[(m0 + 63) * 4 + h];
                    if (tid == 0) { MCAR[ua] = mprev; MNEW[ua] = mnew; MSC[ua] = __expf(bL + mprev - mnew); }
                    for (int i = tid; i < 1024; i += NTHR) { const int s = i >> 4, c8 = i & 15; *(LAS u32x4*)(VP + s * 152 + c8 * 8) = *(const u32x4*)(P + (m0 + s) * PWS + P_AV + h * 128 + c8 * 8); }
                    if (tid < 64) { *(LAS u32x4*)(VP + tid * 152 + 128) = uone4(); *(LAS u32x4*)(VP + tid * 152 + 136) = uzero4(); }
                    { const int s = tid >> 3, c8 = tid & 7; const float w = __expf(bL + GGc[(m0 + s) * 4 + h] - mnew);
                      *(LAS u32x4*)(WK + s * 72 + c8 * 8) = scale8(*(const u32x4*)(P + (m0 + s) * PWS + P_AK + h * 64 + c8 * 8), w); }
                    __syncthreads();
                    for (int ti = wave; ti < 36; ti += NWAVES) { const int mt = ti >> 2, nt = ti & 3; f32x4 acc = zero4();
#pragma unroll
                        for (int ks = 0; ks < 2; ++ks) acc = MFMA16(frag_ks(VP, 152, 16 * mt, 32 * ks, lane), frag_ks(WK, 72, 16 * nt, 32 * ks, lane), acc);
                        bf16* d = DC + (size_t)ua * 9216 + (16 * mt + 4 * (lane >> 4)) * 64 + 16 * nt + (lane & 15);
#pragma unroll
                        for (int i = 0; i < 4; ++i) d[i * 64] = (bf16)f2bf(acc[i]); }
                    __syncthreads();
                } else {
                    const int uc = u - NUA, bl = uc >> 5, c = uc & 31, hd = wave, gi = hd >> 2; const size_t m0 = (size_t)bl * SEQ + c * 64;
                    LAS bf16* XW = (LAS bf16*)(lds + hd * (64 * 72 * 2)); LAS bf16* BMs = (LAS bf16*)(lds + 8 * 64 * 72 * 2);
                    const float alast = ACB[(m0 + 63) * 8 + hd];
#pragma unroll
                    for (int k = 0; k < 8; ++k) { const int i = lane + 64 * k, s = i >> 3, c8 = i & 7; const float wd = __expf(alast - ACB[(m0 + s) * 8 + hd]) * DTB[(m0 + s) * 8 + hd];
                        *(LAS u32x4*)(XW + s * 72 + c8 * 8) = scale8(*(const u32x4*)(XBC + (m0 + s) * 1024 + hd * 64 + c8 * 8), wd); }
                    for (int i = tid; i < 2048; i += NTHR) { const int g2 = i >> 10, rem = i & 1023, s = rem >> 4, c8 = rem & 15;
                        *(LAS u32x4*)(BMs + g2 * (64 * 136) + s * 136 + c8 * 8) = *(const u32x4*)(XBC + (m0 + s) * 1024 + 512 + g2 * 128 + c8 * 8); }
                    __syncthreads();
                    const LAS bf16* BMg = BMs + gi * (64 * 136);
                    for (int pt = 0; pt < 4; ++pt) { f32x4 acc[8];
#pragma unroll
                        for (int n = 0; n < 8; ++n) acc[n] = zero4();
#pragma unroll
                        for (int ks = 0; ks < 2; ++ks) { const bf16x8 a = frag_ks(XW, 72, 16 * pt, 32 * ks, lane);
#pragma unroll
                            for (int n = 0; n < 8; ++n) acc[n] = MFMA16(a, frag_ks(BMg, 136, 16 * n, 32 * ks, lane), acc[n]); }
                        bf16* d = DH + ((size_t)(uc * 8 + hd) * 64 + 16 * pt + 4 * (lane >> 4)) * 128 + (lane & 15);
#pragma unroll
                        for (int n = 0; n < 8; ++n)
#pragma unroll
                            for (int i = 0; i < 4; ++i) d[i * 128 + 16 * n] = (bf16)f2bf(acc[n][i]); }
                    __syncthreads();
                }
            }
            GRID_BAR();
        }

        REPS(PH_M2) if (IN(PH_M2)) {
            PHASE_BEGIN();
            constexpr int NA = GB * 4 * 2304, NC = GB * 8 * 2048;
            for (int i = gt; i < NA + NC; i += NGT) {
                f32x4 st = zero4();
                if (i < NA) { const int bh = i / 2304, e = (i - bh * 2304) * 4; const bf16* dp = DC + (size_t)bh * NCH * 9216 + e; bf16* cp = CS + (size_t)bh * NCH * 9216 + e; const float* sp = MSC + (size_t)bh * NCH;
#pragma unroll 1
                    for (int c0 = 0; c0 < NCH; c0 += 4) { u32x2 dw[4]; float sc[4];
#pragma unroll
                        for (int k = 0; k < 4; ++k) { dw[k] = *(const u32x2*)(dp + (size_t)(c0 + k) * 9216); sc[k] = sp[c0 + k]; }
#pragma unroll
                        for (int k = 0; k < 4; ++k) { *(u32x2*)(cp + (size_t)(c0 + k) * 9216) = (u32x2){pk2(st.x, st.y), pk2(st.z, st.w)};
                            st = st * sc[k] + (f32x4){bf2f(dw[k].x & 0xffffu), bf2f(dw[k].x >> 16), bf2f(dw[k].y & 0xffffu), bf2f(dw[k].y >> 16)}; } }
                } else { const int j = i - NA, bhd = j >> 11, e = (j & 2047) * 4, bl = bhd >> 3, hd = bhd & 7;
                    const bf16* dp = DH + ((size_t)(bl * NCH) * 8 + hd) * 8192 + e; bf16* cp = HS + ((size_t)(bl * NCH) * 8 + hd) * 8192 + e; const float* ap = ACB + ((size_t)bl * SEQ + 63) * 8 + hd;
#pragma unroll 1
                    for (int c0 = 0; c0 < NCH; c0 += 4) { u32x2 dw[4]; float sc[4];
#pragma unroll
                        for (int k = 0; k < 4; ++k) { dw[k] = *(const u32x2*)(dp + (size_t)(c0 + k) * 8 * 8192); sc[k] = __expf(ap[(size_t)(c0 + k) * 64 * 8]); }
#pragma unroll
                        for (int k = 0; k < 4; ++k) { *(u32x2*)(cp + (size_t)(c0 + k) * 8 * 8192) = (u32x2){pk2(st.x, st.y), pk2(st.z, st.w)};
                            st = st * sc[k] + (f32x4){bf2f(dw[k].x & 0xffffu), bf2f(dw[k].x >> 16), bf2f(dw[k].y & 0xffffu), bf2f(dw[k].y >> 16)}; } }
                }
            }
            GRID_BAR();
        }

        REPS(PH_M3) if (IN(PH_M3)) {
            PHASE_BEGIN();
            constexpr int NUA = GB * 4 * NCH, NUC = 2 * GB * NCH;
            for (int u = blk; u < NUA + NUC; u += NBLK) {
                const int r = lane & 15, g4 = lane >> 4;
                if (u < NUA) {
                    const int ua = u, bh = ua >> 5, c = ua & 31, bl = bh >> 2, h = bh & 3; const size_t m0 = (size_t)bl * SEQ + c * 64;
                    LAS bf16* Qs = (LAS bf16*)lds; LAS bf16* Ks = Qs + 64 * 72; LAS bf16* VP = Ks + 64 * 72; LAS bf16* CST = VP + 64 * 152; LAS bf16* SMT = CST + 144 * 72; LAS bf16* AOT = SMT + 64 * 72;
                    LAS float* GS = (LAS float*)(AOT + 64 * 136);
                    LAS float* SSQ = GS + 256;
                    const float mcar = MCAR[ua];
                    { const int s = tid >> 3, c8 = tid & 7; const bf16* pr = P + (m0 + s) * PWS + h * 64 + c8 * 8;
                      *(LAS u32x4*)(Qs + s * 72 + c8 * 8) = *(const u32x4*)(pr + P_AQ); *(LAS u32x4*)(Ks + s * 72 + c8 * 8) = *(const u32x4*)(pr + P_AK); }
                    for (int i = tid; i < 1024; i += NTHR) { const int s = i >> 4, c8 = i & 15; const bf16* pr = P + (m0 + s) * PWS + h * 128 + c8 * 8;
                        *(LAS u32x4*)(VP + s * 152 + c8 * 8) = *(const u32x4*)(pr + P_AV); *(LAS u32x4*)(AOT + s * 136 + c8 * 8) = *(const u32x4*)(pr + P_AO); }
                    if (tid < 64) { *(LAS u32x4*)(VP + tid * 152 + 128) = uone4(); *(LAS u32x4*)(VP + tid * 152 + 136) = uzero4(); }
                    for (int i = tid; i < 1152; i += NTHR) { const int dv = i >> 3, c8 = i & 7; *(LAS u32x4*)(CST + dv * 72 + c8 * 8) = *(const u32x4*)(CS + (size_t)ua * 9216 + dv * 64 + c8 * 8); }
                    if (tid < 192) { const int arr = tid >> 6, s = tid & 63; const float* src = (arr == 0) ? GBc : (arr == 1) ? GGc : GMT; float v = src[(m0 + s) * 4 + h];
                        if (arr == 2) v = GBc[(m0 + s) * 4 + h] + fmaxf(mcar, v);
                        GS[arr * 64 + s] = v; }
                    __syncthreads();
#pragma unroll
                    for (int q2 = 0; q2 < 2; ++q2) { const int ti = 2 * wave + q2, tt = ti >> 2, st = ti & 3;
                        f32x4 acc = zero4();
                        if (st <= tt) {
#pragma unroll
                            for (int ks = 0; ks < 2; ++ks) acc = MFMA16(frag_kc(Qs, 72, 16 * tt, 32 * ks, lane), frag_kc(Ks, 72, 16 * st, 32 * ks, lane), acc);
                            const int s = 16 * st + r; const float gs = GS[64 + s];
#pragma unroll
                            for (int i = 0; i < 4; ++i) { const int t = 16 * tt + 4 * g4 + i; const float e = GS[t] - GS[128 + t] + gs;
                                acc[i] = (s <= t) ? acc[i] * 0.125f * __expf(e) : 0.f; }
                        }
                        *(LAS u32x2*)(SMT + (16 * st + r) * 72 + 16 * tt + 4 * g4) = (u32x2){pk2(acc[0], acc[1]), pk2(acc[2], acc[3])}; }
                    __syncthreads();
                    const int tt = wave & 3, half = wave >> 2;
                    f32x4 a1[5], a2[5];
#pragma unroll
                    for (int j = 0; j < 5; ++j) { a1[j] = zero4(); a2[j] = zero4(); }
#pragma unroll
                    for (int ks = 0; ks < 2; ++ks) { const bf16x8 fa1 = frag_ks(SMT, 72, 16 * tt, 32 * ks, lane), fa2 = frag_kc(Qs, 72, 16 * tt, 32 * ks, lane);
#pragma unroll
                        for (int j = 0; j < 5; ++j) { const int dvt = (j < 4) ? half * 4 + j : 8;
                            a1[j] = MFMA16(fa1, frag_ks(VP, 152, 16 * dvt, 32 * ks, lane), a1[j]);
                            a2[j] = MFMA16(fa2, frag_kc(CST, 72, 16 * dvt, 32 * ks, lane), a2[j]); } }
                    float hv[4][4], ssq[4];
#pragma unroll
                    for (int i = 0; i < 4; ++i) { const int t = 16 * tt + 4 * g4 + i; const float b = GS[t], mt = GS[128 + t];
                        const float is = 0.125f * __expf(b + mcar - mt);
                        float den = a1[4][i] + is * a2[4][i]; den = __shfl(den, lane & 48);
                        const float dn = __builtin_amdgcn_rcpf(fmaxf(fabsf(den), __expf(-mt))); float q = 0.f;
#pragma unroll
                        for (int j = 0; j < 4; ++j) { const float v = (a1[j][i] + is * a2[j][i]) * dn; hv[j][i] = v; q += v * v; }
                        q += __shfl_xor(q, 1); q += __shfl_xor(q, 2); q += __shfl_xor(q, 4); q += __shfl_xor(q, 8); ssq[i] = q; }
                    if (r == 0) {
#pragma unroll
                        for (int i = 0; i < 4; ++i) SSQ[half * 64 + 16 * tt + 4 * g4 + i] = ssq[i]; }
                    __syncthreads();
                    const float* ng = ka->in[I_ANG] + (size_t)l * 512 + h * 128;
#pragma unroll
                    for (int i = 0; i < 4; ++i) { const int t = 16 * tt + 4 * g4 + i; const float rstd = rsqrtf((SSQ[t] + SSQ[64 + t]) * (1.f / 128.f) + EPS);
#pragma unroll
                        for (int j = 0; j < 4; ++j) { const int dv = 16 * (half * 4 + j) + r; LAS bf16* op = AOT + t * 136 + dv;
                            *op = (bf16)f2bf(sigmoidf_(bf2f(*op)) * hv[j][i] * rstd * ng[dv]); } }
                    __syncthreads();
                    for (int i = tid; i < 1024; i += NTHR) { const int s = i >> 4, c8 = i & 15; *(u32x4*)(YCAT + (m0 + s) * YW + h * 128 + c8 * 8) = *(const LAS u32x4*)(AOT + s * 136 + c8 * 8); }
                    __syncthreads();
                } else {
                    const int uc2 = u - NUA, bl = uc2 >> 6, c = (uc2 >> 1) & 31, gi = uc2 & 1, hl = wave & 3, th = wave >> 2, hd = gi * 4 + hl; const size_t m0 = (size_t)bl * SEQ + c * 64;
                    LAS bf16* XHs = (LAS bf16*)lds;
                    LAS bf16* HTs = (LAS bf16*)(lds + 36864);
                    LAS bf16* BMg = (LAS bf16*)(lds + 36864 + 69632);
                    LAS bf16* MTt = (LAS bf16*)(lds + 36864 + 69632 + 17408 + wave * 3072);
                    LAS float* ADs = (LAS float*)(lds + 36864 + 69632 + 17408 + 24576);
                    const bf16* Xb = XBC + m0 * 1024;
                    for (int i = tid; i < 2048; i += NTHR) { const int h4 = i >> 9, rem = i & 511, s = rem >> 3, c8 = rem & 7;
                        *(LAS u32x4*)(XHs + h4 * (64 * 72) + s * 72 + c8 * 8) = *(const u32x4*)((Xb + gi * 256) + (unsigned)(s * 1024 + h4 * 64 + c8 * 8)); }
                    { const bf16* Hb = HS + (size_t)((bl * NCH + c) * 8 + gi * 4) * 8192;
                      for (int i = tid; i < 4096; i += NTHR) { const int h4 = i >> 10, rem = i & 1023, p = rem >> 4, c8 = rem & 15;
                        *(LAS u32x4*)(HTs + h4 * (64 * 136) + p * 136 + c8 * 8) = *(const u32x4*)(Hb + (unsigned)(h4 * 8192 + p * 128 + c8 * 8)); } }
                    for (int i = tid; i < 1024; i += NTHR) { const int s = i >> 4, c8 = i & 15; *(LAS u32x4*)(BMg + s * 136 + c8 * 8) = *(const u32x4*)((Xb + 512 + gi * 128) + (unsigned)(s * 1024 + c8 * 8)); }
                    { const int h4 = tid >> 7, arr = (tid >> 6) & 1, s = tid & 63; const float* src = arr ? DTB : ACB; ADs[tid] = (src + m0 * 8 + gi * 4)[(unsigned)(s * 8 + h4)]; }
                    const LAS bf16* XH = XHs + hl * (64 * 72); const LAS bf16* HT = HTs + hl * (64 * 136); const LAS float* AD = ADs + hl * 128;
                    const bf16* Cm = Xb + 768 + gi * 128; const bf16* Zp = P + m0 * PWS + P_CZ + hd * 64; const unsigned zlane = (unsigned)(4 * g4 * PWS + r), ylane = (unsigned)(4 * g4 * YW + r);
                    bf16* Yp = YCAT + m0 * YW + 1024 + hd * 64; float* Sp = SSQC + m0 * 8 + hd;
                    bf16x8 fcn[4];
#pragma unroll
                    for (int ks = 0; ks < 4; ++ks) fcn[ks] = gfrag_kc(Cm, 1024, 16 * th, 32 * ks, lane);
                    const float dsk = ka->in[I_CDSKIP][l * 8 + hd];
                    __syncthreads();
#pragma unroll 1
                    for (int k2 = 0; k2 < 2; ++k2) { const int tt = k2 ? 3 - th : th;
                        bf16x8 fcm[4]; unsigned short zc[4][4];
#pragma unroll
                        for (int ks = 0; ks < 4; ++ks) fcm[ks] = fcn[ks];
#pragma unroll
                        for (int p = 0; p < 4; ++p)
#pragma unroll
                            for (int i = 0; i < 4; ++i) zc[p][i] = (Zp + (size_t)(16 * tt + i) * PWS + 16 * p)[zlane];
#pragma unroll
                        for (int ks = 0; ks < 4; ++ks) fcn[ks] = gfrag_kc(Cm, 1024, 16 * (3 - th), 32 * ks, lane);
                        float at[4];
#pragma unroll
                        for (int i = 0; i < 4; ++i) at[i] = AD[16 * tt + 4 * g4 + i];
#pragma unroll 1
                        for (int st = 0; st <= tt; ++st) { f32x4 acc = zero4();
#pragma unroll
                            for (int ks = 0; ks < 4; ++ks) acc = MFMA16(fcm[ks], frag_kc(BMg, 136, 16 * st, 32 * ks, lane), acc);
                            const int s = 16 * st + r; const float as = AD[s], dts = AD[64 + s];
#pragma unroll
                            for (int i = 0; i < 4; ++i) { const int t = 16 * tt + 4 * g4 + i; acc[i] = (s <= t) ? acc[i] * __expf(at[i] - as) * dts : 0.f; if (s == t) acc[i] += dsk; }
                            *(LAS u32x2*)(MTt + (16 * st + r) * 24 + 4 * g4) = (u32x2){pk2(acc[0], acc[1]), pk2(acc[2], acc[3])}; }
                        if ((tt & 1) == 0) *(LAS u32x2*)(MTt + (16 * (tt + 1) + r) * 24 + 4 * g4) = (u32x2){uzero4().x, uzero4().y};
                        LDS_WAIT(); asm volatile("" ::: "memory");
                        f32x4 ad[4], ao[4];
#pragma unroll
                        for (int p = 0; p < 4; ++p) { ad[p] = zero4(); ao[p] = zero4(); }
#pragma unroll 1
                        for (int ks = 0; ks <= (tt >> 1); ++ks) { const bf16x8 fa = frag_ks(MTt, 24, 0, 32 * ks, lane);
#pragma unroll
                            for (int p = 0; p < 4; ++p) ad[p] = MFMA16(fa, frag_ks(XH, 72, 16 * p, 32 * ks, lane), ad[p]); }
#pragma unroll
                        for (int ks = 0; ks < 4; ++ks)
#pragma unroll
                            for (int p = 0; p < 4; ++p) ao[p] = MFMA16(fcm[ks], frag_kc(HT, 136, 16 * p, 32 * ks, lane), ao[p]);
#pragma unroll
                        for (int i = 0; i < 4; ++i) { const float ea = __expf(at[i]); float q = 0.f;
#pragma unroll
                            for (int p = 0; p < 4; ++p) { const float y = (ad[p][i] + ea * ao[p][i]) * siluf_(bf2f(zc[p][i])); q += y * y;
                                (Yp + (size_t)(16 * tt + i) * YW + 16 * p)[ylane] = (bf16)f2bf(y); }
                            q += __shfl_xor(q, 1); q += __shfl_xor(q, 2); q += __shfl_xor(q, 4); q += __shfl_xor(q, 8);
                            if (r == 0) (Sp + (16 * tt + i) * 8)[(unsigned)(32 * g4)] = q; }
                        LDS_WAIT(); asm volatile("" ::: "memory");
                    }
                    __syncthreads();
                }
            }
            GRID_BAR();
        }

        REPS(PH_LIFT) if (IN(PH_LIFT)) {
            PHASE_BEGIN();
            pg8::Gemm g{YCAT, WliftT, 512, YW, 512, (size_t)512 * 2, (size_t)DM * 512 * 2}; pg8::Order S; S.init(T, DM, NBLK, blk, 4);
            pg8::EpiLift E{FAC, MB + (size_t)(grp & 1) * T * DM, DM, SSQC};
            pg8::gemm_phase<pg8::EpiLift, GEMM_ALIGN>(lds, g, S, E);
            GRID_BAR();
        }
        REPS(PH_OUT) if (IN(PH_OUT) && (grp & 1)) {
            PHASE_BEGIN();
            const size_t prow0 = grow0 - T;
            pg8::Gemm g{MB, WoutT, DM, DM, DM, 0, 0}; pg8::Order S; S.init(2 * T, DM, NBLK, blk, 1);
            pg8::EpiResid E{XG + prow0 * DM, DM, SSQ2};
            pg8::gemm_phase<pg8::EpiResid, GEMM_ALIGN>(lds, g, S, E);
            GRID_BAR();
        }
        REPS(PH_UP) if (IN(PH_UP) && (grp & 1)) {
            PHASE_BEGIN();
            const size_t prow0 = grow0 - T;
            pg8::Gemm g{XG + prow0 * DM, WupT, DM, DM, DM, 0, 0}; pg8::Order S; S.init(2 * T, DFF2, NBLK, blk, 1);
            if (tid == 0) *(volatile LAS int*)(lds + 131072 + 12288 + 1024) = -1;
            pg8::EpiConvAct E{ACT, SSQ2, ka->in[I_FCW] + (size_t)l * 3 * DFF2, ka->in[I_FCB] + (size_t)l * DFF2, RAWH, lds + 131072, DFF2 / 256};
            pg8::gemm_phase<pg8::EpiConvAct, GEMM_ALIGN>(lds, g, S, E);
            GRID_BAR();
        }
        REPS(PH_DOWN) if (IN(PH_DOWN) && (grp & 1)) {
            PHASE_BEGIN();
            const size_t prow0 = grow0 - T;
            pg8::Gemm g{ACT, WdownT, DFF, 128, DFF, 0, 0, 65536, (size_t)22 * 65536}; pg8::Order S; S.init(2 * T, DM, NBLK, blk, 1);
            {
                const float* fw = ka->in[I_FCW] + (size_t)l * 3 * DFF2; const float* fb = ka->in[I_FCB] + (size_t)l * DFF2;
                pg8::Unit uu;
                for (int i = 0; S.next(i, uu); ++i) { const int pm = uu.pm; if ((pm & 7) == 0) continue;
                    for (int ch = tid; ch < DFF; ch += NTHR) { const int tp = ch >> 7, j = ch & 127;
                        const float* own = RAWH + (size_t)(pm * 22 + tp) * 1024; const float* prv = RAWH + (size_t)((pm - 1) * 22 + tp) * 1024;
                        const float g254 = prv[2 * 256 + j], g255 = prv[3 * 256 + j], g0 = own[j], g1 = own[256 + j];
                        const float u254 = prv[2 * 256 + 128 + j], u255 = prv[3 * 256 + 128 + j], u0 = own[128 + j], u1 = own[256 + 128 + j];
                        const float wg0 = fw[ch], wg1 = fw[DFF2 + ch], wg2 = fw[2 * DFF2 + ch], wu0 = fw[DFF + ch], wu1 = fw[DFF2 + DFF + ch], wu2 = fw[2 * DFF2 + DFF + ch], bg = fb[ch], bu = fb[DFF + ch];
                        ACT[((size_t)(pm * 22 + tp) * 256) * 128 + j] = (bf16)f2bf(siluf_(bg + wg0 * g254 + wg1 * g255 + wg2 * g0) * (bu + wu0 * u254 + wu1 * u255 + wu2 * u0));
                        ACT[((size_t)(pm * 22 + tp) * 256 + 1) * 128 + j] = (bf16)f2bf(siluf_(bg + wg0 * g255 + wg1 * g0 + wg2 * g1) * (bu + wu0 * u255 + wu1 * u0 + wu2 * u1)); } }
                asm volatile("s_waitcnt vmcnt(0)" ::: "memory"); __syncthreads();
            }
            pg8::EpiResid E{XG + prow0 * DM, DM, SSQ1 + prow0 * 16};
            pg8::gemm_phase<pg8::EpiResid, GEMM_ALIGN>(lds, g, S, E);
            GRID_BAR();
        }
        REPS(PH_FINAL) if (IN(PH_FINAL) && l == DEPTH - 1 && (grp & 1)) {
            PHASE_BEGIN();
            const size_t prow0 = grow0 - T;
            const float* gain = ka->in[I_FING];
            f32x4 gv[4];
#pragma unroll
            for (int j = 0; j < 4; ++j) gv[j] = ((const f32x4*)gain)[lane + 64 * j];
            for (int m = gw; m < 2 * T; m += NGW) {
                const u32x2* xr = (const u32x2*)(XG + (prow0 + m) * DM) + lane;
                f32x4 v[4]; float sq = 0.f;
#pragma unroll
                for (int j = 0; j < 4; ++j) { const u32x2 w = xr[64 * j]; v[j] = (f32x4){bf2f(w.x & 0xffffu), bf2f(w.x >> 16), bf2f(w.y & 0xffffu), bf2f(w.y >> 16)};
                    sq += (v[j].x * v[j].x + v[j].y * v[j].y) + (v[j].z * v[j].z + v[j].w * v[j].w); }
                const float rstd = rsqrtf(wave_sum(sq) * (1.f / DM) + EPS);
                f32x4* orow = (f32x4*)(ka->out + (prow0 + m) * DM) + lane;
#pragma unroll
                for (int j = 0; j < 4; ++j) orow[64 * j] = v[j] * rstd * gv[j];
            }
            GRID_BAR();
        }
    }
#undef IN
#undef GRID_BAR
#undef PHASE_BEGIN
}

#ifndef ONE_LAUNCH
#define ONE_LAUNCH 1
#endif
extern "C" void kernel_launch(void* const* d_in, const int* in_sizes, int n_in, void* d_out, int out_size, void* d_ws, size_t ws_size, hipStream_t stream) {
    static int grid = 0;
    if (grid == 0) {
        if (n_in != N_IN || in_sizes[0] != BATCH * SEQ * DM || out_size != BATCH * SEQ * DM || ws_size < WS_END) {
            fprintf(stderr, "kernel_launch: unexpected shapes / workspace (n_in %d, ws %zu, need %zu); nothing launched\n", n_in, ws_size, (size_t)WS_END); grid = -1; return; }
        int dev = 0, cus = 0, per_cu = 0;
        if (hipGetDevice(&dev) != hipSuccess || hipDeviceGetAttribute(&cus, hipDeviceAttributeMultiprocessorCount, dev) != hipSuccess) { grid = -1; return; }
        if (hipFuncSetAttribute((const void*)fwd, hipFuncAttributeMaxDynamicSharedMemorySize, LDS_BYTES) != hipSuccess) { fprintf(stderr, "kernel_launch: hipFuncSetAttribute failed\n"); grid = -1; return; }
        if (hipOccupancyMaxActiveBlocksPerMultiprocessor(&per_cu, (const void*)fwd, NTHR, LDS_BYTES) != hipSuccess || per_cu < 1) { fprintf(stderr, "kernel_launch: occupancy query says %d\n", per_cu); (void)hipGetLastError(); }
        grid = cus;
    }
    if (grid < 0) return;
    (void)hipMemsetAsync((char*)d_ws + WS_CTL, 0, (size_t)(4096 + XCD_BAR_WORDS) * 4, stream);
    Args a{};
    for (int i = 0; i < N_IN; ++i) a.in[i] = (const float*)d_in[i];
    a.out = (float*)d_out; a.ws = (unsigned char*)d_ws; a.pad = 0;
#if ONE_LAUNCH
    a.l_lo = 0; a.l_hi = DEPTH; a.g_lo = 0; a.g_hi = NG; a.ph_lo = 0; a.ph_hi = PH_COUNT; a.use_bar = 1;
    hipLaunchKernelGGL(fwd, dim3(grid), dim3(NTHR), LDS_BYTES, stream, a);
#else
    a.use_bar = 0;
    for (int l = 0; l < DEPTH; ++l)
        for (int g = 0; g < NG; ++g)
            for (int ph = 0; ph < PH_COUNT; ++ph) {
                if (ph == PH_W && g != 0) continue;
                if (ph == PH_FINAL && l != DEPTH - 1) continue;
                if ((ph == PH_OUT || ph == PH_UP || ph == PH_DOWN || ph == PH_FINAL) && !(g & 1)) continue;
                a.l_lo = l; a.l_hi = l + 1; a.g_lo = g; a.g_hi = g + 1; a.ph_lo = ph; a.ph_hi = ph + 1;
                hipLaunchKernelGGL(fwd, dim3(grid), dim3(NTHR), LDS_BYTES, stream, a);
            }
#endif
}
```

```cpp
#include <hip/hip_runtime.h>
#include <cstdio>
#include <cstdint>

#define LAS __attribute__((address_space(3)))
#define GAS __attribute__((address_space(1)))
typedef unsigned short bf16;
typedef short bf16x8 __attribute__((ext_vector_type(8)));
typedef short s16x4 __attribute__((ext_vector_type(4)));
typedef float f32x4 __attribute__((ext_vector_type(4)));
typedef float f32x2 __attribute__((ext_vector_type(2)));
typedef unsigned u32x4 __attribute__((ext_vector_type(4)));
typedef unsigned u32x2 __attribute__((ext_vector_type(2)));

constexpr int DM = 1024, BATCH = 32, SEQ = 2048, DEPTH = 4;
constexpr int PIN = 10256, PW = 10240, PWS = 6144, DFF = 2816, DFF2 = 5632;
constexpr int GB = 8;
constexpr int NG = BATCH / GB;
constexpr int T = GB * SEQ;
constexpr int NCH = SEQ / 64;
constexpr float EPS = 1e-6f;
constexpr int P_AQ = 0, P_AK = 256, P_AV = 512, P_AO = 1024, P_BB = 1536, P_BC = 2048, P_BX = 2560, P_CZ = 3072, P_CX = 3584, P_SQ = 4608, P_SK = 5120, P_SV = 5632, P_G = 6144;
constexpr int YW = 2048;

constexpr size_t MiB = 1u << 20;
constexpr size_t WS_CTL = 0, CTL_BYTES = 1 * MiB;
constexpr size_t WS_WIN = 1 * MiB;
constexpr size_t WS_WLIFT = WS_WIN + (size_t)PW * DM * 2;
constexpr size_t WS_WOUT = WS_WLIFT + (size_t)4 * DM * 512 * 2;
constexpr size_t WS_WUP = WS_WOUT + (size_t)DM * DM * 2;
constexpr size_t WS_WDOWN = WS_WUP + (size_t)DFF2 * DM * 2;
constexpr size_t WS_W16 = WS_WDOWN + (size_t)DM * DFF * 2;
constexpr size_t WS_XN = WS_W16 + 65536;
constexpr size_t WS_P = WS_XN + (size_t)T * DM * 2;
constexpr size_t WS_U = WS_P, WS_ACT = WS_P;
constexpr size_t WS_YCAT = WS_P + (size_t)T * PW * 2;
constexpr size_t WS_XG = WS_YCAT + (size_t)T * YW * 2;
constexpr size_t WS_MB = WS_XG + (size_t)BATCH * SEQ * DM * 2;
constexpr size_t WS_SP = WS_MB + (size_t)2 * T * DM * 2;
constexpr size_t WS_GB = WS_SP + (size_t)T * 16 * 4;
constexpr size_t WS_GG = WS_GB + (size_t)T * 16;
constexpr size_t WS_GMT = WS_GG + (size_t)T * 16;
constexpr size_t WS_MCAR = WS_GMT + (size_t)T * 16;
constexpr size_t WS_MNEW = WS_MCAR + 4096;
constexpr size_t WS_MSC = WS_MNEW + 4096;
constexpr size_t WS_SUMB = WS_MSC + 4096, WS_SUMG = WS_SUMB + 4096;
constexpr size_t WS_DT = WS_SUMG + 4096;
constexpr size_t WS_AC = WS_DT + (size_t)T * 32;
constexpr size_t WS_XBC = WS_AC + (size_t)T * 32;
constexpr size_t WS_DC = WS_XBC + (size_t)T * DM * 2;
constexpr size_t WS_CS = WS_DC + (size_t)GB * 4 * NCH * 9216 * 4;
constexpr size_t WS_DH = WS_CS + (size_t)GB * 4 * NCH * 9216 * 2;
constexpr size_t WS_HS = WS_DH + (size_t)GB * NCH * 8 * 8192 * 4;
constexpr size_t WS_SSQ1 = WS_HS + (size_t)GB * NCH * 8 * 8192 * 2;
constexpr size_t WS_SSQ2 = WS_SSQ1 + (size_t)BATCH * SEQ * 64;
constexpr size_t WS_SSQC = WS_SSQ2 + (size_t)2 * T * 64;
constexpr size_t WS_RAWH = WS_SSQC + (size_t)T * 32;
constexpr size_t WS_END = WS_RAWH + (size_t)(2 * T / 256) * 22 * 4 * 256 * 4;

constexpr int NWAVES = 8, NTHR = 512;
constexpr int LDS_BYTES = 155648;
constexpr int MISC_OFF = 153600;

__device__ __forceinline__ float bf2f(unsigned b) { return __uint_as_float(b << 16); }
__device__ __forceinline__ unsigned f2bf(float f) { unsigned u = __float_as_uint(f); return (u + 0x7fffu + ((u >> 16) & 1u)) >> 16; }
__device__ __forceinline__ unsigned pk2(float lo, float hi) { return f2bf(lo) | (f2bf(hi) << 16); }
__device__ __forceinline__ float sigmoidf_(float x) { return __builtin_amdgcn_rcpf(1.f + __builtin_amdgcn_exp2f(-1.4426950408889634f * x)); }
__device__ __forceinline__ float siluf_(float x) { return x * __builtin_amdgcn_rcpf(1.f + __builtin_amdgcn_exp2f(-1.4426950408889634f * x)); }
__device__ __forceinline__ float logsigf_(float x) { return fminf(x, 0.f) - log1pf(expf(-fabsf(x))); }
__device__ __forceinline__ float softplusf_(float x) { return fmaxf(x, 0.f) + log1pf(expf(-fabsf(x))); }
__device__ __forceinline__ float wave_sum(float v) {
#pragma unroll
    for (int o = 1; o < 64; o <<= 1) v += __shfl_xor(v, o);
    return v;
}
#define LDS_WAIT() asm volatile("s_waitcnt lgkmcnt(0)" ::: "memory")
__device__ __forceinline__ float row_rstd(const float* ssq16) {
    const f32x4* p = (const f32x4*)ssq16; const f32x4 a = (p[0] + p[1]) + (p[2] + p[3]);
    return rsqrtf(((a.x + a.y) + (a.z + a.w)) * (1.f / 1024.f) + 1e-6f);
}

namespace pg8 {
constexpr int BM = 256, BK = 64, HALF = 128, HTB = HALF * BK * 2, STAGE_BYTES = 8 * HTB, NXCD = 8, WGM = 4;
__host__ __device__ __forceinline__ int lds_byte(int r, int c) { const int st = (r >> 4) * 2 + (c >> 5), rr = r & 15, cc = c & 31, ob = rr * 64 + cc * 2; return st * 1024 + (ob ^ (((ob >> 9) & 1) << 5)); }
__host__ __device__ __forceinline__ void stage_rc(int b, int& R, int& C) { const int st = b / 1024, sb = b % 1024, swz = sb ^ (((sb >> 9) & 1) << 5); R = (st >> 1) * 16 + swz / 64; C = (st & 1) * 32 + (swz % 64) / 2; }
__host__ __device__ __forceinline__ int perm32(int rho) { const int n = rho >> 4, i = rho & 15; return 8 * (i >> 2) + 4 * n + (i & 3); }

struct Unit { int pm, pn, z; };
struct Gemm { const bf16* A; const bf16* Bt; int K, lda, ldb; size_t zA, zB; size_t ablk = 256, atile = 0; };

struct Order {
    int nM, nN, nwg, G, c, Z;
    __device__ __forceinline__ void init(int M, int N, int G_, int c_, int Z_) { nM = M / BM; nN = N / BM; nwg = nM * nN; G = G_; c = c_; Z = Z_; }
    __device__ __forceinline__ bool next(int i, Unit& u) const {
        const int ti = i / Z; u.z = i - ti * Z;
        const long L = (long)ti * G + c; if (L >= nwg) return false;
        int wgid = (int)L; { const int q = nwg / NXCD, r = nwg % NXCD, xcd = wgid % NXCD, off = wgid / NXCD; wgid = (xcd < r ? xcd * (q + 1) : r * (q + 1) + (xcd - r) * q) + off; }
        const int nig = WGM * nN, gid = wgid / nig, fm = gid * WGM, gsz = (nM - fm) < WGM ? (nM - fm) : WGM;
        u.pm = fm + ((wgid % nig) % gsz); u.pn = (wgid % nig) / gsz; return true;
    }
};
__device__ __forceinline__ unsigned cvt_pk_bf16(float lo, float hi) { unsigned r; asm volatile("s_nop 0\n\tv_cvt_pk_bf16_f32 %0, %1, %2" : "=v"(r) : "v"(lo), "v"(hi)); return r; }

__device__ __forceinline__ void panel_rstd(LAS float* rsl, const float* ssq, int pm, int wr, int wc, int fr, int fq) {
    volatile LAS int* tag = (volatile LAS int*)(rsl + 256);
    if (__builtin_amdgcn_readfirstlane(*tag) != pm) {
        const int tidl = (wr * 4 + wc) * 64 + fq * 16 + fr, rr = tidl >> 1, hf = tidl & 1;
        const f32x4* p = (const f32x4*)(ssq + (size_t)(pm * BM + rr) * 16 + hf * 8); const f32x4 a = p[0] + p[1];
        float sq = (a.x + a.y) + (a.z + a.w); sq += __shfl_xor(sq, 1);
        __builtin_amdgcn_s_barrier();
        if (hf == 0) rsl[rr] = rsqrtf(sq * (1.f / 1024.f) + 1e-6f);
        if (tidl == 0) *tag = pm;
        asm volatile("s_waitcnt lgkmcnt(0)" ::: "memory"); __builtin_amdgcn_s_barrier(); asm volatile("" ::: "memory");
    }
}
struct EpiBf16 {
    static constexpr int MIN_STORES = 16;
    static constexpr bool PERM = true, KEEP = false, CONTIG = true;
    LAS float* rsl;
    bf16* O; int ldc; const float* ssq; int gate_pn0; bf16* fac;
    static __device__ __forceinline__ float s1(float xs) { return 1.f + __builtin_amdgcn_exp2f(__builtin_amdgcn_fmed3f(xs, -43.28085122666891f, 43.28085122666891f)); }
    __device__ __forceinline__ void operator()(f32x4 (&acc)[2][2][4][2], const Unit& u, int wr, int wc, int fr, int fq) const {
        panel_rstd(rsl, ssq, u.pm, wr, wc, fr, fq);
        if (u.pn >= gate_pn0) {
            const int row0g = u.pm * BM + wr * 64 + fr, d0 = 64 * (u.pn - gate_pn0) + 16 * wc + 4 * fq;
#pragma unroll
            for (int ai = 0; ai < 2; ++ai)
#pragma unroll
                for (int m = 0; m < 4; ++m) {
                    const float rs = -1.4426950408889634f * rsl[wr * 64 + fr + ai * HALF + m * 16];
                    const int cc = d0 & 255, pnL = d0 >> 8, bjL = cc >> 7, wcL = (cc >> 5) & 3, fqL = (cc >> 3) & 3, nL = (cc >> 2) & 1;
                    bf16* rowp = fac + ((((((size_t)(u.pm * 4 + pnL) * 4) * 16 + (ai * 4 + m) * 2 + bjL) * 8 + (wr * 4 + wcL)) * 64 + fqL * 16 + fr) * 8 + nL * 4);
                    const size_t zstep = (size_t)16 * 8 * 512;
                    float one = 1.f; asm volatile("" : "+v"(one));
                    float f0[4], f1[4], f2[4], f3[4];
#pragma unroll
                    for (int e = 0; e < 4; ++e) { const float a0 = s1(acc[ai][0][m][0][e] * rs), a1 = s1(acc[ai][0][m][1][e] * rs), a2 = s1(acc[ai][1][m][0][e] * rs), a3 = s1(acc[ai][1][m][1][e] * rs);
                        f0[e] = a1 * __builtin_amdgcn_rcpf(a0); f1[e] = a2 * __builtin_amdgcn_rcpf(a1); f2[e] = a3 * __builtin_amdgcn_rcpf(a2); f3[e] = one * __builtin_amdgcn_rcpf(a3); }
                    *(u32x2*)(rowp) = (u32x2){cvt_pk_bf16(f0[0], f0[1]), cvt_pk_bf16(f0[2], f0[3])};
                    *(u32x2*)(rowp + zstep) = (u32x2){cvt_pk_bf16(f1[0], f1[1]), cvt_pk_bf16(f1[2], f1[3])};
                    *(u32x2*)(rowp + 2 * zstep) = (u32x2){cvt_pk_bf16(f2[0], f2[1]), cvt_pk_bf16(f2[2], f2[3])};
                    *(u32x2*)(rowp + 3 * zstep) = (u32x2){cvt_pk_bf16(f3[0], f3[1]), cvt_pk_bf16(f3[2], f3[3])}; }
            return; }
        const int row0 = u.pm * BM + wr * 64 + fr, col0 = u.pn * BM + wc * 64 + 8 * fq;
#pragma unroll
        for (int ai = 0; ai < 2; ++ai)
#pragma unroll
            for (int m = 0; m < 4; ++m) { const int row = row0 + ai * HALF + m * 16; bf16* rowp = O + (size_t)row * ldc + col0;
                const float rs = rsl[wr * 64 + fr + ai * HALF + m * 16];
#pragma unroll
                for (int bj = 0; bj < 2; ++bj) { const f32x4 v0 = acc[ai][bj][m][0] * rs, v1 = acc[ai][bj][m][1] * rs;
                    u32x4 w; w.x = cvt_pk_bf16(v0[0], v0[1]); w.y = cvt_pk_bf16(v0[2], v0[3]); w.z = cvt_pk_bf16(v1[0], v1[1]); w.w = cvt_pk_bf16(v1[2], v1[3]);
                    *(u32x4*)(rowp + bj * 32) = w; } }
    }
};
struct EpiResid {
    static constexpr int MIN_STORES = 16;
    static constexpr bool PERM = true, KEEP = false, CONTIG = true;
    bf16* xb; int ldc; float* ssq;
    __device__ __forceinline__ void operator()(f32x4 (&acc)[2][2][4][2], const Unit& u, int wr, int wc, int fr, int fq) const {
        const int row0 = u.pm * BM + wr * 64 + fr, col0 = u.pn * BM + wc * 64 + 8 * fq;
#pragma unroll
        for (int ai = 0; ai < 2; ++ai) {
            u32x4 ov[4][2];
#pragma unroll
            for (int m = 0; m < 4; ++m)
#pragma unroll
                for (int bj = 0; bj < 2; ++bj) ov[m][bj] = *(const u32x4*)(xb + (size_t)(row0 + ai * HALF + m * 16) * ldc + col0 + bj * 32);
            asm volatile("" ::: "memory");
#pragma unroll
            for (int m = 0; m < 4; ++m) { const int row = row0 + ai * HALF + m * 16; const size_t off = (size_t)row * ldc + col0; float q = 0.f;
#pragma unroll
                for (int bj = 0; bj < 2; ++bj) {
                    const u32x4 o = ov[m][bj];
                    const f32x4 x0 = (f32x4){bf2f(o.x & 0xffffu), bf2f(o.x >> 16), bf2f(o.y & 0xffffu), bf2f(o.y >> 16)} + acc[ai][bj][m][0];
                    const f32x4 x1 = (f32x4){bf2f(o.z & 0xffffu), bf2f(o.z >> 16), bf2f(o.w & 0xffffu), bf2f(o.w >> 16)} + acc[ai][bj][m][1];
                    q += (x0[0] * x0[0] + x0[1] * x0[1]) + (x0[2] * x0[2] + x0[3] * x0[3]) + (x1[0] * x1[0] + x1[1] * x1[1]) + (x1[2] * x1[2] + x1[3] * x1[3]);
                    u32x4 w; w.x = cvt_pk_bf16(x0[0], x0[1]); w.y = cvt_pk_bf16(x0[2], x0[3]); w.z = cvt_pk_bf16(x1[0], x1[1]); w.w = cvt_pk_bf16(x1[2], x1[3]);
                    *(u32x4*)(xb + off + bj * 32) = w; }
                q += __shfl_xor(q, 16); q += __shfl_xor(q, 32); if (fq == 0) ssq[(size_t)row * 16 + u.pn * 4 + wc] = q;
            }
            asm volatile("" ::: "memory");
        }
    }
};
struct EpiLift {
    static constexpr int MIN_STORES = 0;
    static constexpr bool PERM = true, KEEP = true, CONTIG = false;
    const bf16* fac; bf16* mb; int ldc; const float* ssqc;
    __device__ __forceinline__ void operator()(f32x4 (&acc)[2][2][4][2], const Unit& u, int wr, int wc, int fr, int fq) const {
        const int row0 = u.pm * BM + wr * 64 + fr, col0 = u.pn * BM + wc * 32 + 8 * fq;
        f32x2 sc[2][4];
        if (u.z == 1 || u.z == 2) {
#pragma unroll
            for (int ai = 0; ai < 2; ++ai)
#pragma unroll
                for (int m = 0; m < 4; ++m) sc[ai][m] = *(const f32x2*)(ssqc + (size_t)(row0 + ai * HALF + m * 16) * 8 + 2 * fq); }
#pragma unroll
        for (int ai = 0; ai < 2; ++ai) {
            u32x4 gv[4][2];
#pragma unroll
            for (int m = 0; m < 4; ++m)
#pragma unroll
                for (int bj = 0; bj < 2; ++bj) gv[m][bj] = *(const u32x4*)(fac + (((((size_t)(u.pm * 4 + u.pn) * 4 + u.z) * 16 + (ai * 4 + m) * 2 + bj) * 8 + (wr * 4 + wc)) * 64 + fq * 16 + fr) * 8);
            asm volatile("" ::: "memory");
#pragma unroll
            for (int m = 0; m < 4; ++m) { const int row = row0 + ai * HALF + m * 16;
                float rsc = 1.f;
                if (u.z == 1 || u.z == 2) { float sq = sc[ai][m].x + sc[ai][m].y; sq += __shfl_xor(sq, 16); sq += __shfl_xor(sq, 32);
                    const float v = sq * (1.f / 512.f) + 1e-6f; rsc = (u.z == 1) ? sqrtf(v) : rsqrtf(v); }
#pragma unroll
                for (int bj = 0; bj < 2; ++bj) { const int col = col0 + bj * HALF;
                    const u32x4 g0 = gv[m][bj];
                    f32x4& v0 = acc[ai][bj][m][0]; f32x4& v1 = acc[ai][bj][m][1];
                    v0[0] *= rsc * bf2f(g0.x & 0xffffu); v0[1] *= rsc * bf2f(g0.x >> 16); v0[2] *= rsc * bf2f(g0.y & 0xffffu); v0[3] *= rsc * bf2f(g0.y >> 16);
                    v1[0] *= rsc * bf2f(g0.z & 0xffffu); v1[1] *= rsc * bf2f(g0.z >> 16); v1[2] *= rsc * bf2f(g0.w & 0xffffu); v1[3] *= rsc * bf2f(g0.w >> 16);
                    if (u.z == 3) { u32x4 w; w.x = cvt_pk_bf16(v0[0], v0[1]); w.y = cvt_pk_bf16(v0[2], v0[3]); w.z = cvt_pk_bf16(v1[0], v1[1]); w.w = cvt_pk_bf16(v1[2], v1[3]);
                        *(u32x4*)(mb + (size_t)row * ldc + col) = w; } } }
            asm volatile("" ::: "memory");
        }
    }
};

__device__ __forceinline__ float dpp_ror1(float x) { return __int_as_float(__builtin_amdgcn_update_dpp(0, __float_as_int(x), 0x121, 0xf, 0xf, false)); }
__device__ __forceinline__ float dpp_ror2(float x) { return __int_as_float(__builtin_amdgcn_update_dpp(0, __float_as_int(x), 0x122, 0xf, 0xf, false)); }
__device__ __forceinline__ float dpp_shr1(float x) { return __int_as_float(__builtin_amdgcn_update_dpp(0, __float_as_int(x), 0x111, 0xf, 0xf, true)); }
__device__ __forceinline__ float dpp_shr2(float x) { return __int_as_float(__builtin_amdgcn_update_dpp(0, __float_as_int(x), 0x112, 0xf, 0xf, true)); }
__device__ __forceinline__ float dpp_prev1(float cur, float prev) { return __int_as_float(__builtin_amdgcn_update_dpp(__builtin_amdgcn_update_dpp(0, __float_as_int(prev), 0x121, 0xf, 0xf, false), __float_as_int(cur), 0x111, 0xf, 0xf, false)); }
__device__ __forceinline__ float dpp_prev2(float cur, float prev) { return __int_as_float(__builtin_amdgcn_update_dpp(__builtin_amdgcn_update_dpp(0, __float_as_int(prev), 0x122, 0xf, 0xf, false), __float_as_int(cur), 0x112, 0xf, 0xf, false)); }
struct EpiConvAct {
    static constexpr int MIN_STORES = 12;
    static constexpr bool PERM = true, KEEP = false, CONTIG = false;
    bf16* act; const float* ssq; const float* cw; const float* cb; float* rawh; LAS unsigned char* halo; int ntn;
    __device__ __forceinline__ void operator()(f32x4 (&acc)[2][2][4][2], const Unit& u, int wr, int wc, int fr, int fq) const {
        asm volatile("" : "+v"(fr), "+v"(fq));
        const int row0 = u.pm * BM + wr * 64 + fr, ch0 = u.pn * 128 + wc * 32 + 8 * fq;
        LAS float* rsl = (LAS float*)(halo + 12288);
        LAS float* WL = (LAS float*)(halo + 8192);
        const int wl_i2 = ((wr * 4 + wc) * 64 + fq * 16 + fr) * 2;
        f32x2 wlv;
        { const int kind = wl_i2 >> 7, c = wl_i2 & 127, k4 = kind & 3; const float* src = (k4 < 3 ? cw + k4 * 5632 : cb) + (kind >= 4 ? 2816 : 0) + u.pn * 128 + c; wlv = *(const f32x2*)src; }
        panel_rstd(rsl, ssq, u.pm, wr, wc, fr, fq);
#pragma unroll
        for (int ai = 0; ai < 2; ++ai)
#pragma unroll
            for (int m = 0; m < 4; ++m) { const float rs = rsl[wr * 64 + fr + ai * HALF + m * 16];
#pragma unroll
                for (int bj = 0; bj < 2; ++bj) { acc[ai][bj][m][0] = acc[ai][bj][m][0] * rs; acc[ai][bj][m][1] = acc[ai][bj][m][1] * rs; } }
        LAS f32x4* H = (LAS f32x4*)halo;
        if (fr >= 14) {
#pragma unroll
            for (int ai = 0; ai < 2; ++ai) { const int b = 2 * ai + wr;
#pragma unroll
                for (int bj = 0; bj < 2; ++bj)
#pragma unroll
                    for (int n = 0; n < 2; ++n) H[((((b * 4 + wc) * 4 + fq) * 2 + (fr - 14)) * 2 + bj) * 2 + n] = acc[ai][bj][3][n]; } }
        { float* rw = rawh + (size_t)(u.pm * ntn + u.pn) * 1024;
          if (wr == 1 && fr >= 14) {
#pragma unroll
            for (int bj = 0; bj < 2; ++bj)
#pragma unroll
                for (int n = 0; n < 2; ++n) *(f32x4*)(rw + (2 + fr - 14) * 256 + bj * HALF + wc * 32 + 8 * fq + 4 * n) = acc[1][bj][3][n]; }
          if (wr == 0 && fr < 2) {
#pragma unroll
            for (int bj = 0; bj < 2; ++bj)
#pragma unroll
                for (int n = 0; n < 2; ++n) *(f32x4*)(rw + fr * 256 + bj * HALF + wc * 32 + 8 * fq + 4 * n) = acc[0][bj][0][n]; } }
        *(LAS f32x2*)(WL + wl_i2) = wlv;
        asm volatile("s_waitcnt lgkmcnt(0)" ::: "memory"); __builtin_amdgcn_s_barrier(); asm volatile("" ::: "memory");
        bf16* actb = act + ((size_t)(u.pm * ntn + u.pn) * BM + wr * 64) * 128 + wc * 32;
        const unsigned alane = (unsigned)(fr * 128 + 8 * fq);
        const float lm1 = (fr == 0) ? 1.f : 0.f, lm2 = (fr < 2) ? 1.f : 0.f;
        float zf = 0.f; asm volatile("" : "+v"(zf));
        unsigned pkw[2][4][3];
#pragma unroll
        for (int n = 0; n < 2; ++n) {
#pragma unroll
            for (int eh = 0; eh < 2; ++eh) {
                const int cl = wc * 32 + 8 * fq + 4 * n + 2 * eh;
                f32x2 wg[3], wu[3], bg, bu;
#pragma unroll
                for (int j = 0; j < 3; ++j) { wg[j] = *(const LAS f32x2*)(WL + j * 128 + cl); wu[j] = *(const LAS f32x2*)(WL + (4 + j) * 128 + cl); }
                bg = *(const LAS f32x2*)(WL + 3 * 128 + cl); bu = *(const LAS f32x2*)(WL + 7 * 128 + cl);
#pragma unroll
                for (int j = 0; j < 3; ++j) { wg[j] = wg[j] * 1.4426950408889634f; wu[j] = wu[j] * 0.6931471805599453f; }
                bg = bg * 1.4426950408889634f; bu = bu * 0.6931471805599453f;
                f32x2 wg1m = wg[1] * lm1, wg0m = wg[0] * lm2, wu1m = wu[1] * lm1, wu0m = wu[0] * lm2;
                asm volatile("" : "+v"(wg1m), "+v"(wg0m), "+v"(wu1m), "+v"(wu0m));
#pragma unroll
                for (int ai = 0; ai < 2; ++ai) { const int b = 2 * ai + wr;
#pragma unroll
                    for (int m = 3; m >= 0; --m) {
                        float r2[2];
#pragma unroll
                        for (int e2 = 0; e2 < 2; ++e2) { const int e = 2 * eh + e2;
                            const float gc = acc[ai][0][m][n][e], uc = acc[ai][1][m][n][e];
                            float gp = zf, up = zf;
                            if (m > 0) { gp = acc[ai][0][m - 1][n][e]; up = acc[ai][1][m - 1][n][e]; }
                            else if (b >= 1) { const int fk = fr >= 14 ? fr - 14 : 0; const LAS float* hp = (const LAS float*)(H + ((((b - 1) * 4 + wc) * 4 + fq) * 2 + fk) * 4 + n); gp = hp[e]; up = hp[8 + e]; }
                            float vg = fmaf(wg[2][e2], gc, bg[e2]), vu = fmaf(wu[2][e2], uc, bu[e2]);
                            asm volatile("s_nop 1\n\t"
                                         "v_fmac_f32_dpp %0, %2, %4 row_shr:1 row_mask:0xf bank_mask:0xf bound_ctrl:0\n\t"
                                         "v_fmac_f32_dpp %1, %3, %5 row_shr:1 row_mask:0xf bank_mask:0xf bound_ctrl:0\n\t"
                                         "v_fmac_f32_dpp %0, %2, %6 row_shr:2 row_mask:0xf bank_mask:0xf bound_ctrl:0\n\t"
                                         "v_fmac_f32_dpp %1, %3, %7 row_shr:2 row_mask:0xf bank_mask:0xf bound_ctrl:0\n\t"
                                         "v_fmac_f32_dpp %0, %8, %10 row_ror:1 row_mask:0xf bank_mask:0xf\n\t"
                                         "v_fmac_f32_dpp %1, %9, %11 row_ror:1 row_mask:0xf bank_mask:0xf\n\t"
                                         "v_fmac_f32_dpp %0, %8, %12 row_ror:2 row_mask:0xf bank_mask:0xf\n\t"
                                         "v_fmac_f32_dpp %1, %9, %13 row_ror:2 row_mask:0xf bank_mask:0xf"
                                         : "+v"(vg), "+v"(vu)
                                         : "v"(gc), "v"(uc), "v"(wg[1][e2]), "v"(wu[1][e2]), "v"(wg[0][e2]), "v"(wu[0][e2]), "v"(gp), "v"(up), "v"(wg1m[e2]), "v"(wu1m[e2]), "v"(wg0m[e2]), "v"(wu0m[e2]));
                            r2[e2] = (vg * vu) * __builtin_amdgcn_rcpf(1.f + __builtin_amdgcn_exp2f(-vg)); }
                        const unsigned pk = cvt_pk_bf16(r2[0], r2[1]);
                        if (2 * n + eh < 3) pkw[ai][m][2 * n + eh] = pk;
                        else *(u32x4*)(actb + (size_t)(ai * HALF + m * 16) * 128 + alane) = (u32x4){pkw[ai][m][0], pkw[ai][m][1], pkw[ai][m][2], pk};
                    }
                }
            }
        }
    }
};

template <class Epi, bool ALIGN_EPI = true>
__device__ __forceinline__ void gemm_phase(LAS unsigned char* lds, const Gemm g, const Order& S, const Epi& E) {
    int tid = threadIdx.x; asm volatile("" : "+v"(tid));
    const int wid = __builtin_amdgcn_readfirstlane(tid >> 6), lane = tid & 63, wr = wid >> 2, wc = wid & 3, fr = lane & 15, fq = lane >> 4;
    const int K = g.K, nt = K / BK;
    unsigned voffA[2], voffB[2];
#pragma unroll
    for (int i = 0; i < 2; ++i) { int R, C; stage_rc(tid * 16 + i * 8192, R, C);
        const int Rb = Epi::CONTIG ? (64 * (R >> 5) + perm32(R & 31)) : (Epi::PERM ? ((R & ~31) + perm32(R & 31)) : R);
        voffA[i] = (unsigned)(R * g.lda + C) * 2u; voffB[i] = (unsigned)(Rb * g.ldb + C) * 2u; }
    const size_t kstep = (size_t)(BK * 2);
    const size_t hstepA = (size_t)HALF * g.lda * 2, hstepB = (size_t)(Epi::CONTIG ? 32 : HALF) * g.ldb * 2;
    const size_t tstepA = g.atile ? g.atile : 2 * hstepA, tstepB = (size_t)BM * g.ldb * 2;
    const unsigned ldsw = (unsigned)wid * 1024u;
    const int aoff = lds_byte(wr * 64 + fr, fq * 8), boff = lds_byte(wc * 32 + fr, fq * 8);
#define PG8_SA(b, h) (((b) * 2 + (h)) * HTB)
#define PG8_SB(b, h) ((4 + (b) * 2 + (h)) * HTB)
#define PG8_STAGE(bufoff, gbase, voff) do { _Pragma("unroll") for (int _i = 0; _i < 2; ++_i) \
        __builtin_amdgcn_global_load_lds((const unsigned*)((const char*)(gbase) + (voff)[_i]), (LAS unsigned*)(lds + (bufoff) + ldsw + _i * 8192), 16, 0, 0); } while (0)
#define PG8_LDA(dst, b, h) do { _Pragma("unroll") for (int m = 0; m < 4; ++m) _Pragma("unroll") for (int k = 0; k < 2; ++k) dst[m][k] = *(const LAS bf16x8*)(lds + PG8_SA(b, h) + aoff + m * 2048 + k * 1024); } while (0)
#define PG8_LDB(dst, b, h) do { _Pragma("unroll") for (int n = 0; n < 2; ++n) _Pragma("unroll") for (int k = 0; k < 2; ++k) dst[n][k] = *(const LAS bf16x8*)(lds + PG8_SB(b, h) + boff + n * 2048 + k * 1024); } while (0)
#define PG8_MMA(ai, bj, At, Bt) do { __builtin_amdgcn_s_setprio(1); _Pragma("unroll") for (int m = 0; m < 4; ++m) _Pragma("unroll") for (int n = 0; n < 2; ++n) _Pragma("unroll") for (int k = 0; k < 2; ++k) \
        acc[ai][bj][m][n] = __builtin_amdgcn_mfma_f32_16x16x32_bf16(Bt[n][k], At[m][k], acc[ai][bj][m][n], 0, 0, 0); __builtin_amdgcn_s_setprio(0); } while (0)
#define PG8_WAIT_V(n) asm volatile("s_waitcnt vmcnt(" #n ")" ::: "memory")
#define PG8_WAIT_L(n) asm volatile("s_waitcnt lgkmcnt(" #n ")" ::: "memory")
#define PG8_WAIT_V8R(r) asm volatile("s_cmp_lg_u32 %0, 0\n\ts_cbranch_scc0 .Lw8_%=\n\ts_waitcnt vmcnt(%1)\n\ts_branch .Lwd_%=\n.Lw8_%=:\n\ts_waitcnt vmcnt(8)\n.Lwd_%=:" :: "s"(__builtin_amdgcn_readfirstlane(r)), "n"(8 + Epi::MIN_STORES) : "memory", "scc")
#define PG8_BAR __builtin_amdgcn_s_barrier()
#define PG8_SCHED __builtin_amdgcn_sched_barrier(0)
    Unit cur, nxt; int ui = 0;
    if (!S.next(0, cur)) return;
    f32x4 acc[2][2][4][2];
#pragma unroll
    for (int a = 0; a < 2; ++a)
#pragma unroll
        for (int b = 0; b < 2; ++b)
#pragma unroll
            for (int m = 0; m < 4; ++m)
#pragma unroll
                for (int n = 0; n < 2; ++n) acc[a][b][m][n] = (f32x4){0.f, 0.f, 0.f, 0.f};
    bf16x8 At[4][2], B0[2][2], B1[2][2];
    const char* cA = (const char*)g.A + (size_t)cur.pm * tstepA + (size_t)cur.z * g.zA; const char* cB = (const char*)g.Bt + (size_t)cur.pn * tstepB + (size_t)cur.z * g.zB;
    PG8_STAGE(PG8_SB(0, 0), cB, voffB); PG8_STAGE(PG8_SB(0, 1), cB + hstepB, voffB); PG8_STAGE(PG8_SA(0, 0), cA, voffA); PG8_STAGE(PG8_SA(0, 1), cA + hstepA, voffA);
    if (wr == 1) PG8_BAR;
    PG8_WAIT_V(2); PG8_BAR;
    PG8_STAGE(PG8_SB(1, 0), cB + kstep, voffB); PG8_STAGE(PG8_SA(1, 0), cA + kstep, voffA); PG8_STAGE(PG8_SB(1, 1), cB + hstepB + kstep, voffB);
    PG8_WAIT_V(6); PG8_BAR;
    for (;;) {
        const bool has_next = S.next(ui + 1, nxt);
        const char* nA = has_next ? (const char*)g.A + (size_t)nxt.pm * tstepA + (size_t)nxt.z * g.zA : cA; const char* nB = has_next ? (const char*)g.Bt + (size_t)nxt.pn * tstepB + (size_t)nxt.z * g.zB : cB;
        for (int t = 0; t < nt; t += 2) {
            const bool last = (t == nt - 2);
            const char* a1 = cA + (size_t)(t >> 1) * g.ablk + kstep;
            const char* a2 = last ? nA : cA + (size_t)((t >> 1) + 1) * g.ablk; const char* b2 = last ? nB : cB + (size_t)(t + 2) * kstep;
            const char* a3 = a2 + kstep; const char* b3 = b2 + kstep;
            const int relax = ((t == 0) && (ui > 0)) ? 1 : 0; (void)relax;
            PG8_LDB(B0, 0, 0); PG8_LDB(B1, 0, 1); PG8_SCHED; PG8_LDA(At, 0, 0); PG8_STAGE(PG8_SA(1, 1), a1 + hstepA, voffA);
            if constexpr (Epi::MIN_STORES > 0) PG8_WAIT_V8R(relax); else PG8_WAIT_V(8);
            PG8_WAIT_L(0); PG8_BAR; PG8_MMA(0, 0, At, B0); PG8_MMA(0, 1, At, B1); PG8_BAR; PG8_SCHED;
            PG8_LDA(At, 0, 1); PG8_STAGE(PG8_SB(0, 0), b2, voffB); PG8_STAGE(PG8_SB(0, 1), b2 + hstepB, voffB); PG8_STAGE(PG8_SA(0, 0), a2, voffA);
            if constexpr (Epi::MIN_STORES > 0) PG8_WAIT_V8R(relax); else PG8_WAIT_V(8);
            PG8_WAIT_L(0); PG8_BAR; PG8_MMA(1, 0, At, B0); PG8_MMA(1, 1, At, B1); PG8_BAR; PG8_SCHED;
            PG8_LDB(B0, 1, 0); PG8_LDB(B1, 1, 1); PG8_SCHED; PG8_LDA(At, 1, 0); PG8_STAGE(PG8_SA(0, 1), a2 + hstepA, voffA);
            PG8_WAIT_V(8); PG8_WAIT_L(0); PG8_BAR; PG8_MMA(0, 0, At, B0); PG8_MMA(0, 1, At, B1); PG8_BAR; PG8_SCHED;
            PG8_LDA(At, 1, 1); PG8_STAGE(PG8_SB(1, 0), b3, voffB); PG8_STAGE(PG8_SB(1, 1), b3 + hstepB, voffB); PG8_STAGE(PG8_SA(1, 0), a3, voffA);
            PG8_WAIT_V(8); PG8_WAIT_L(0); PG8_BAR; PG8_MMA(1, 0, At, B0); PG8_MMA(1, 1, At, B1); PG8_BAR; PG8_SCHED;
        }
        if constexpr (ALIGN_EPI) { if (wr == 0) PG8_BAR; }
        E(acc, cur, wr, wc, fr, fq);
        if (!has_next) break;
        if (!(Epi::KEEP && nxt.z != 0))
#pragma unroll
        for (int a = 0; a < 2; ++a)
#pragma unroll
            for (int b = 0; b < 2; ++b)
#pragma unroll
                for (int m = 0; m < 4; ++m)
#pragma unroll
                    for (int n = 0; n < 2; ++n) acc[a][b][m][n] = (f32x4){0.f, 0.f, 0.f, 0.f};
        cur = nxt; cA = nA; cB = nB; ++ui;
        if constexpr (ALIGN_EPI) { if (wr == 1) PG8_BAR; }
    }
    PG8_WAIT_V(0);
    if constexpr (!ALIGN_EPI) { if (wr == 0) PG8_BAR; }
    PG8_BAR;
#undef PG8_SA
#undef PG8_SB
#undef PG8_STAGE
#undef PG8_LDA
#undef PG8_LDB
#undef PG8_MMA
#undef PG8_WAIT_V
#undef PG8_WAIT_L
#undef PG8_WAIT_V8R
#undef PG8_BAR
#undef PG8_SCHED
}
}

#define XB_TMO      128
#define XB_XCNT(j)  (256  + 64 * (j))
#define XB_XSUB(j)  (1280 + 64 * (j))
#define XB_XGEN(j)  (2304 + 64 * (j))
#define XB_TOP      3328
#define XB_TOPGEN   3392
#define XCD_BAR_WORDS 3456
#define XB_SPIN_CAP (1u << 18)
__device__ __forceinline__ unsigned xb_ld(unsigned* p)              { return __hip_atomic_load(p, __ATOMIC_RELAXED, __HIP_MEMORY_SCOPE_AGENT); }
__device__ __forceinline__ unsigned xb_add(unsigned* p, unsigned v) { return __hip_atomic_fetch_add(p, v, __ATOMIC_RELAXED, __HIP_MEMORY_SCOPE_AGENT); }
__device__ __forceinline__ unsigned xb_xcc_id() { return (unsigned)__builtin_amdgcn_s_getreg((3 << 11) | 20) & 0xFu; }
#define XB_SPIN(cond, bar) do { unsigned _sp = 0; while (cond) { __builtin_amdgcn_s_sleep(1); \
    if ((++_sp & 255u) == 0u) { if (xb_ld(&(bar)[XB_TMO])) break; if (_sp > XB_SPIN_CAP) { atomicAdd(&(bar)[XB_TMO], 1u); break; } } } } while (0)
struct XcdBarrier { unsigned* bar; unsigned x; volatile LAS unsigned* st; };
__device__ __forceinline__ XcdBarrier xcd_barrier_post(unsigned* bar, volatile LAS unsigned* st) {
    XcdBarrier b; b.bar = bar; b.x = xb_xcc_id(); b.st = st;
    if (threadIdx.x == 0) (void)xb_add(&bar[XB_XCNT(b.x)], 1u);
    return b;
}
__device__ __forceinline__ void xcd_barrier_complete(unsigned* bar, unsigned x, unsigned& nloc, unsigned& nx) {
    const unsigned G = gridDim.x * gridDim.y * gridDim.z;
    unsigned sum, cnt, mine, sp = 0u;
    for (;;) {
        sum = 0u; cnt = 0u; mine = 0u;
#pragma unroll
        for (unsigned j = 0; j < 16; ++j) { const unsigned c = xb_ld(&bar[XB_XCNT(j)]); sum += c; cnt += (c > 0u) ? 1u : 0u; mine = (j == x) ? c : mine; }
        if (sum == G) break;
        __builtin_amdgcn_s_sleep(1);
        if ((++sp & 255u) == 0u) { if (xb_ld(&bar[XB_TMO])) break; if (sp > XB_SPIN_CAP) { atomicAdd(&bar[XB_TMO], 1u); break; } }
    }
    nloc = mine > 0u ? mine : 1u; nx = cnt > 0u ? cnt : 1u;
}
__device__ __forceinline__ void xcd_barrier(const XcdBarrier& b) {
    asm volatile("s_waitcnt vmcnt(0)" ::: "memory");
    __syncthreads();
    if (threadIdx.x == 0) {
        unsigned* bar = b.bar;
        __builtin_amdgcn_s_waitcnt(0);
        unsigned nloc = b.st[0], nx = b.st[1];
        if (nloc == 0u) { xcd_barrier_complete(bar, b.x, nloc, nx); b.st[0] = nloc; b.st[1] = nx; }
        const unsigned old = xb_add(&bar[XB_XSUB(b.x)], 1u);
        const unsigned gen = old / nloc;
        if (old + 1u == (gen + 1u) * nloc) {
            __builtin_amdgcn_fence(__ATOMIC_RELEASE, "agent");
            asm volatile("s_waitcnt vmcnt(0)" ::: "memory");
            const unsigned og = xb_add(&bar[XB_TOP], 1u);
            const unsigned tg = og / nx;
            if (og + 1u == (tg + 1u) * nx) xb_add(&bar[XB_TOPGEN], 1u);
            else XB_SPIN(xb_ld(&bar[XB_TOPGEN]) == tg, bar);
            __builtin_amdgcn_fence(__ATOMIC_ACQUIRE, "agent");
            xb_add(&bar[XB_XGEN(b.x)], 1u);
            asm volatile("s_waitcnt vmcnt(0)" ::: "memory");
        } else {
            XB_SPIN(xb_ld(&bar[XB_XGEN(b.x)]) == gen, bar);
            __builtin_amdgcn_fence(__ATOMIC_ACQUIRE, "agent");
            asm volatile("s_waitcnt vmcnt(0)" ::: "memory");
        }
    }
    __syncthreads();
}

__device__ __forceinline__ bf16x8 frag_kc(const LAS bf16* X, int ld, int mn0, int k0, int lane) { return *(const LAS bf16x8*)(X + (mn0 + (lane & 15)) * ld + k0 + 8 * (lane >> 4)); }
__device__ __forceinline__ bf16x8 gfrag_kc(const bf16* X, int ld, int mn0, int k0, int lane) { const bf16* b = X + (size_t)mn0 * ld + k0; const unsigned lo = (unsigned)((lane & 15) * ld + 8 * (lane >> 4)); return *(const bf16x8*)(b + lo); }
__device__ __forceinline__ s16x4 trr(const LAS bf16* p) { return __builtin_bit_cast(s16x4, __builtin_amdgcn_ds_read_tr16_b64_v4i16((LAS s16x4*)p)); }
__device__ __forceinline__ bf16x8 frag_ks(const LAS bf16* X, int ld, int mn0, int k0, int lane) {
    const int r = lane & 15, g = lane >> 4;
    const LAS bf16* p = X + (k0 + 8 * g + (r >> 2)) * ld + mn0 + 4 * (r & 3);
    const s16x4 lo = trr(p), hi = trr(p + 4 * ld);
    return (bf16x8){lo[0], lo[1], lo[2], lo[3], hi[0], hi[1], hi[2], hi[3]};
}
__device__ __forceinline__ f32x4 zero4() { f32x4 z = {0.f, 0.f, 0.f, 0.f}; asm volatile("" : "+v"(z)); return z; }
__device__ __forceinline__ u32x4 uone4() { u32x4 z = {0x3F80u, 0u, 0u, 0u}; asm volatile("" : "+v"(z)); return z; }
__device__ __forceinline__ u32x4 uzero4() { u32x4 z = {0u, 0u, 0u, 0u}; asm volatile("" : "+v"(z)); return z; }
#define MFMA16(a, b, c) __builtin_amdgcn_mfma_f32_16x16x32_bf16((a), (b), (c), 0, 0, 0)
__device__ __forceinline__ u32x4 scale8(u32x4 w, float s) {
    u32x4 o;
    o.x = pk2(bf2f(w.x & 0xffffu) * s, bf2f(w.x >> 16) * s); o.y = pk2(bf2f(w.y & 0xffffu) * s, bf2f(w.y >> 16) * s);
    o.z = pk2(bf2f(w.z & 0xffffu) * s, bf2f(w.z >> 16) * s); o.w = pk2(bf2f(w.w & 0xffffu) * s, bf2f(w.w >> 16) * s);
    return o;
}
__device__ __forceinline__ float wscan_add(float v, int lane) {
#pragma unroll
    for (int o = 1; o < 64; o <<= 1) { const float t = __shfl_up(v, o); if (lane >= o) v += t; }
    return v;
}
__device__ __forceinline__ float wscan_max(float v, int lane) {
#pragma unroll
    for (int o = 1; o < 64; o <<= 1) { const float t = __shfl_up(v, o); if (lane >= o) v = fmaxf(v, t); }
    return v;
}

#ifndef GEMM_ALIGN
#define GEMM_ALIGN true
#endif
enum { PH_W = 0, PH_INPROJ, PH_M0, PH_M1, PH_M2, PH_M3, PH_LIFT, PH_OUT, PH_UP, PH_DOWN, PH_FINAL, PH_COUNT };
enum { I_X = 0, I_MIXG, I_WIN, I_AIB, I_AFB, I_ANG, I_BCW, I_CCW, I_CCB, I_CDTB, I_CALOG, I_CDSKIP, I_CNG, I_WLIFT, I_WOUT, I_FFNG, I_WUP, I_FCW, I_FCB, I_WDOWN, I_FING, N_IN };
struct Args { const float* in[N_IN]; float* out; unsigned char* ws; int l_lo, l_hi, g_lo, g_hi, ph_lo, ph_hi, use_bar, pad; };

__device__ __forceinline__ void transpose_item(const float* W, int ldw, int nsrc0, int k0, bf16* WT, int ldt, int ndst0, LAS float* scr, int lane, const float* kscale = nullptr, int gate_tile = -1) {
    int scol = nsrc0 + (lane & 31);
    if (gate_tile >= 0) {
        const int c = (ndst0 & 255) + (lane & 31), wc = c >> 6, bj = (c >> 5) & 1, fq = (c >> 3) & 3, n = (c >> 2) & 1, e = c & 3;
        scol = 6160 + (2 * bj + n) * 1024 + 64 * gate_tile + 16 * wc + 4 * fq + e; }
#pragma unroll 8
    for (int i = 0; i < 32; ++i) { const int kk = 2 * i + (lane >> 5); scr[kk * 33 + (lane & 31)] = W[(size_t)(k0 + kk) * ldw + scol] * (kscale ? kscale[k0 + kk] : 1.f); }
    LDS_WAIT(); asm volatile("" ::: "memory");
    const int c = lane & 7;
#pragma unroll
    for (int j = 0; j < 4; ++j) { const int n = (lane >> 3) + 8 * j; const LAS float* s = scr + (8 * c) * 33 + n;
        u32x4 o; o.x = pk2(s[0 * 33], s[1 * 33]); o.y = pk2(s[2 * 33], s[3 * 33]); o.z = pk2(s[4 * 33], s[5 * 33]); o.w = pk2(s[6 * 33], s[7 * 33]);
        *(u32x4*)(WT + (size_t)(ndst0 + n) * ldt + k0 + 8 * c) = o; }
    LDS_WAIT(); asm volatile("" ::: "memory");
}

__global__ void __launch_bounds__(NTHR, 2) fwd(Args args) {
    extern __shared__ __attribute__((aligned(16))) unsigned char lds_raw[];
    LAS unsigned char* lds = (LAS unsigned char*)lds_raw;
    const int NBLK = gridDim.x, blk = blockIdx.x;
    {
        volatile LAS unsigned* MISC0 = (volatile LAS unsigned*)(lds + MISC_OFF);
        if (threadIdx.x < 16) MISC0[threadIdx.x] = 0u;
        __syncthreads();
    }
    XcdBarrier bar; bar.bar = (unsigned*)(args.ws + WS_CTL) + 4096; bar.x = 0; bar.st = nullptr;
    if (args.use_bar) bar = xcd_barrier_post((unsigned*)(args.ws + WS_CTL) + 4096, (volatile LAS unsigned*)(lds + MISC_OFF) + 8);
#define GRID_BAR() do { if (args.use_bar) xcd_barrier(bar); } while (0)
#ifndef REPMASK
#define REPMASK 0
#endif
#define IN(k) (args.ph_lo <= (k) && (k) < args.ph_hi)
#define REPS(k) for (int rep_ = 0; rep_ < 1 + ((REPMASK >> (k)) & 1); ++rep_)
#define PHASE_BEGIN() int tid = threadIdx.x; asm volatile("" : "+v"(tid)); const int lane = tid & 63, wave = __builtin_amdgcn_readfirstlane(tid >> 6); \
    const __attribute__((address_space(4))) Args* ka = (const __attribute__((address_space(4))) Args*)__builtin_amdgcn_kernarg_segment_ptr(); asm volatile("" : "+s"(ka)); \
    unsigned char* ws = ka->ws; \
    const size_t grow0 = (size_t)grp * T; const float* xsrc = (l == 0) ? ka->in[I_X] : ka->out; (void)grow0; (void)xsrc; \
    const int gw = blk * NWAVES + wave, NGW = NBLK * NWAVES, gt = blk * NTHR + tid, NGT = NBLK * NTHR; (void)lane; (void)gw; (void)NGW; (void)gt; (void)NGT; \
    bf16* const WinT = (bf16*)(ws + WS_WIN); bf16* const WliftT = (bf16*)(ws + WS_WLIFT); bf16* const WoutT = (bf16*)(ws + WS_WOUT); \
    bf16* const WupT = (bf16*)(ws + WS_WUP); bf16* const WdownT = (bf16*)(ws + WS_WDOWN); bf16* const W16B = (bf16*)(ws + WS_W16); \
    bf16* const XN = (bf16*)(ws + WS_XN); bf16* const P = (bf16*)(ws + WS_P); bf16* const FAC = (bf16*)(ws + WS_P) + (size_t)T * PWS; (void)FAC; bf16* const U = (bf16*)(ws + WS_U); bf16* const ACT = (bf16*)(ws + WS_ACT); \
    bf16* const YCAT = (bf16*)(ws + WS_YCAT); bf16* const XG = (bf16*)(ws + WS_XG); bf16* const MB = (bf16*)(ws + WS_MB); float* const SP = (float*)(ws + WS_SP); \
    float* const SSQ1 = (float*)(ws + WS_SSQ1); float* const SSQ2 = (float*)(ws + WS_SSQ2); float* const SSQC = (float*)(ws + WS_SSQC); float* const RAWH = (float*)(ws + WS_RAWH); (void)SSQ1; (void)SSQ2; (void)SSQC; (void)RAWH; \
    float* const GBc = (float*)(ws + WS_GB); float* const GGc = (float*)(ws + WS_GG); float* const GMT = (float*)(ws + WS_GMT); \
    float* const MCAR = (float*)(ws + WS_MCAR); float* const MNEW = (float*)(ws + WS_MNEW); float* const MSC = (float*)(ws + WS_MSC); float* const SUMB = (float*)(ws + WS_SUMB); float* const SUMG = (float*)(ws + WS_SUMG); (void)SUMB; (void)SUMG; \
    float* const DTB = (float*)(ws + WS_DT); float* const ACB = (float*)(ws + WS_AC); bf16* const XBC = (bf16*)(ws + WS_XBC); \
    bf16* const DC = (bf16*)(ws + WS_DC); bf16* const CS = (bf16*)(ws + WS_CS); bf16* const DH = (bf16*)(ws + WS_DH); bf16* const HS = (bf16*)(ws + WS_HS); \
    (void)WinT; (void)WliftT; (void)WoutT; (void)WupT; (void)WdownT; (void)W16B; (void)XN; (void)P; (void)U; (void)ACT; (void)YCAT; (void)XG; (void)MB; (void)SP; (void)GBc; (void)GGc; (void)GMT; \
    (void)MCAR; (void)MNEW; (void)MSC; (void)DTB; (void)ACB; (void)XBC; (void)DC; (void)CS; (void)DH; (void)HS

    for (int l = args.l_lo; l < args.l_hi; ++l)
    for (int grp = args.g_lo; grp < args.g_hi; ++grp) {

        REPS(PH_W) if (IN(PH_W) && grp == 0) {
            PHASE_BEGIN();
            LAS float* scr = (LAS float*)(lds + wave * 16384);
            constexpr int I_IN = 16 * 320, I_LF = 4 * 8 * 32, I_OUT = 16 * 32, I_UP = 16 * 176, I_DN = 44 * 32, NIT = I_IN + I_LF + I_OUT + I_UP + I_DN;
            for (int it = gw; it < NIT; it += NGW) {
                int r = it;
                if (r < I_IN) { const int kb = r / 320, nb = r % 320, n0 = 32 * nb, ns = n0 + (n0 >= P_SQ ? 16 : (n0 >= P_BB ? 8 : 0));
                    transpose_item(ka->in[I_WIN] + (size_t)l * DM * PIN, PIN, ns, 64 * kb, WinT, DM, n0, scr, lane, ka->in[I_MIXG] + (size_t)l * DM, n0 >= P_G ? (n0 - P_G) >> 8 : -1); continue; } r -= I_IN;
                if (r < I_LF) { const int br = r / 256, q = r % 256, kb = q / 32, nb = q % 32;
                    transpose_item(ka->in[I_WLIFT] + (size_t)(l * 4 + br) * 512 * DM, DM, 32 * nb, 64 * kb, WliftT + (size_t)br * DM * 512, 512, 32 * nb, scr, lane, br == 2 ? ka->in[I_CNG] + (size_t)l * 512 : nullptr); continue; } r -= I_LF;
                if (r < I_OUT) { const int kb = r / 32, nb = r % 32;
                    transpose_item(ka->in[I_WOUT] + (size_t)l * DM * DM, DM, 32 * nb, 64 * kb, WoutT, DM, 32 * nb, scr, lane); continue; } r -= I_OUT;
                if (r < I_UP) { const int kb = r / 176, nb = r % 176, n0 = 32 * nb, tp = n0 >> 8, j = n0 & 255, ns = (j < 128) ? 128 * tp + j : 2816 + 128 * tp + (j - 128);
                    transpose_item(ka->in[I_WUP] + (size_t)l * DM * DFF2, DFF2, ns, 64 * kb, WupT, DM, n0, scr, lane, ka->in[I_FFNG] + (size_t)l * DM); continue; } r -= I_UP;
                { const int kb = r / 32, nb = r % 32;
                    transpose_item(ka->in[I_WDOWN] + (size_t)l * DFF * DM, DM, 32 * nb, 64 * kb, WdownT, DFF, 32 * nb, scr, lane); }
            }
            for (int i = gt; i < 16 * DM; i += NGT) { const int c = i >> 10, k = i & 1023; const int oc = (c < 8) ? (1536 + c) : (4616 + (c - 8));
                const float w = ka->in[I_WIN][(size_t)l * DM * PIN + (size_t)k * PIN + oc] * ka->in[I_MIXG][(size_t)l * DM + k]; const unsigned hi = f2bf(w);
                W16B[i] = (bf16)hi; W16B[16 * DM + i] = (bf16)f2bf(w - bf2f(hi)); }
            if (l == 0) {
                for (int m = gw; m < BATCH * SEQ; m += NGW) {
                    const f32x4* xr = (const f32x4*)(ka->in[I_X] + (size_t)m * DM) + lane;
                    f32x4 v[4]; float sq = 0.f;
#pragma unroll
                    for (int j = 0; j < 4; ++j) { v[j] = xr[64 * j]; sq += (v[j].x * v[j].x + v[j].y * v[j].y) + (v[j].z * v[j].z + v[j].w * v[j].w); }
                    sq = wave_sum(sq); if (lane < 16) SSQ1[(size_t)m * 16 + lane] = (lane == 0) ? sq : 0.f;
                    u32x2* o8 = (u32x2*)(XG + (size_t)m * DM) + lane;
#pragma unroll
                    for (int j = 0; j < 4; ++j) o8[64 * j] = (u32x2){pk2(v[j].x, v[j].y), pk2(v[j].z, v[j].w)};
                }
            }
            GRID_BAR();
        }

        REPS(PH_INPROJ) if (IN(PH_INPROJ)) {
            PHASE_BEGIN();
            const bf16* XGg = XG + grow0 * DM; const float* ssq = SSQ1 + grow0 * 16;
            if (tid == 0) *(volatile LAS int*)(lds + 143360 + 1024) = -1;
            for (int rb = blk; rb < T / 64; rb += NBLK) {
                const int r0 = rb * 64 + 16 * (wave & 3), kh = (wave >> 2) * 512; f32x4 acc = zero4(), acc2 = zero4();
                float rsd[4];
#pragma unroll
                for (int i = 0; i < 4; ++i) rsd[i] = row_rstd(ssq + (size_t)(r0 + 4 * (lane >> 4) + i) * 16);
#pragma unroll 8
                for (int ks = 0; ks < 16; ++ks) { const bf16x8 a = gfrag_kc(XGg, DM, r0, kh + 32 * ks, lane);
                    acc = MFMA16(a, gfrag_kc(W16B, DM, 0, kh + 32 * ks, lane), acc); acc2 = MFMA16(a, gfrag_kc(W16B + 16 * DM, DM, 0, kh + 32 * ks, lane), acc2); }
                acc += acc2;
                LAS f32x4* xch = (LAS f32x4*)lds;
                if (wave >= 4) xch[(wave - 4) * 64 + lane] = acc;
                __syncthreads();
                if (wave < 4) { acc += xch[wave * 64 + lane];
#pragma unroll
                    for (int i = 0; i < 4; ++i) { const int row = r0 + 4 * (lane >> 4) + i; SP[(size_t)row * 16 + (lane & 15)] = acc[i] * rsd[i]; } }
                __syncthreads();
            }
            pg8::Gemm g{XGg, WinT, DM, DM, DM, 0, 0}; pg8::Order S; S.init(T, PW, NBLK, blk, 1);
            pg8::EpiBf16 E{(LAS float*)(lds + 143360), P, PWS, ssq, P_G / 256, FAC};
            pg8::gemm_phase<pg8::EpiBf16, GEMM_ALIGN>(lds, g, S, E);
            GRID_BAR();
        }

        REPS(PH_M0) if (IN(PH_M0)) {
            PHASE_BEGIN();
#pragma unroll 1
            for (int pass = 0; pass < 2; ++pass) {
            if ((pass ^ (blk & 1)) == 0) {
            for (int task = gw; task < GB * 4 * NCH; task += NGW) {
                const int bh = task >> 5, c = task & 31, bl = bh >> 2, h = bh & 3;
                const size_t m = (size_t)bl * SEQ + c * 64 + lane;
                const float ig = SP[m * 16 + h] + ka->in[I_AIB][l * 4 + h], fg = SP[m * 16 + 4 + h] + ka->in[I_AFB][l * 4 + h];
                const float b = wscan_add(logsigf_(fg), lane);
                const float gg = ig - b;
                const float pm = wscan_max(gg, lane);
                GBc[m * 4 + h] = b; GGc[m * 4 + h] = gg; GMT[m * 4 + h] = pm;
                if (lane == 63) { SUMB[task] = b; SUMG[task] = pm; }
            }
            for (int task = gw; task < GB * NCH * 8; task += NGW) {
                const int hd = task & 7; const size_t m = (size_t)(task >> 3) * 64 + lane;
                const float dt = softplusf_(SP[m * 16 + 8 + hd] + ka->in[I_CDTB][l * 8 + hd]);
                const float a = wscan_add(-dt * __expf(ka->in[I_CALOG][l * 8 + hd]), lane);
                DTB[m * 8 + hd] = dt; ACB[m * 8 + hd] = a;
            }
            {
                const float* cw = ka->in[I_CCW] + (size_t)l * 4 * 1024; const float* cb = ka->in[I_CCB] + (size_t)l * 1024;
                constexpr int RUN = 16;
                for (int i = gt; i < (T / RUN) * 128; i += NGT) {
                    const int rb = i >> 7, c8 = (i & 127) * 8, m0 = rb * RUN, t0 = m0 & (SEQ - 1);
                    float w[4][8], bb[8];
#pragma unroll
                    for (int e = 0; e < 8; ++e) { bb[e] = cb[c8 + e];
#pragma unroll
                        for (int j = 0; j < 4; ++j) w[j][e] = cw[j * 1024 + c8 + e]; }
                    const u32x4 zz = uzero4(); u32x4 rowv[RUN + 3];
                    { const bf16* pr = P + (size_t)(t0 >= 3 ? m0 - 3 : m0) * PWS + P_CX + c8;
#pragma unroll
                      for (int j = 0; j < 3; ++j) { const u32x4 ld = *(const u32x4*)(pr + (size_t)j * PWS); rowv[j] = (t0 >= 3) ? ld : zz; } }
#pragma unroll
                    for (int rr = 0; rr < RUN; ++rr) rowv[3 + rr] = *(const u32x4*)(P + (size_t)(m0 + rr) * PWS + P_CX + c8);
                    asm volatile("" ::: "memory");
#pragma unroll
                    for (int rr = 0; rr < RUN; ++rr) {
                        float acc[8];
#pragma unroll
                        for (int e = 0; e < 8; ++e) acc[e] = bb[e];
#pragma unroll
                        for (int j = 0; j < 4; ++j) { const u32x4 wv = rowv[rr + j];
                            acc[0] += w[j][0] * bf2f(wv.x & 0xffffu); acc[1] += w[j][1] * bf2f(wv.x >> 16); acc[2] += w[j][2] * bf2f(wv.y & 0xffffu); acc[3] += w[j][3] * bf2f(wv.y >> 16);
                            acc[4] += w[j][4] * bf2f(wv.z & 0xffffu); acc[5] += w[j][5] * bf2f(wv.z >> 16); acc[6] += w[j][6] * bf2f(wv.w & 0xffffu); acc[7] += w[j][7] * bf2f(wv.w >> 16); }
                        u32x4 o; o.x = pk2(siluf_(acc[0]), siluf_(acc[1])); o.y = pk2(siluf_(acc[2]), siluf_(acc[3])); o.z = pk2(siluf_(acc[4]), siluf_(acc[5])); o.w = pk2(siluf_(acc[6]), siluf_(acc[7]));
                        *(u32x4*)(XBC + (size_t)(m0 + rr) * 1024 + c8) = o;
                    }
                }
            }
            {
                const float* bw = ka->in[I_BCW] + (size_t)l * 3 * 512;
                constexpr int RUN = 8;
                for (int i = gt; i < (T / RUN) * 64; i += NGT) {
                    const int rb = i >> 6, c8 = (i & 63) * 8, m0 = rb * RUN, t0 = m0 & (SEQ - 1);
                    float w[3][8];
#pragma unroll
                    for (int e = 0; e < 8; ++e)
#pragma unroll
                        for (int j = 0; j < 3; ++j) w[j][e] = bw[j * 512 + c8 + e];
                    const u32x4 zz = uzero4(); u32x4 av[RUN + 2], bv[RUN + 2], gv[RUN];
                    { const bf16* pr = P + (size_t)(t0 >= 2 ? m0 - 2 : m0) * PWS;
#pragma unroll
                      for (int j = 0; j < 2; ++j) { const u32x4 la = *(const u32x4*)(pr + (size_t)j * PWS + P_BC + c8), lb = *(const u32x4*)(pr + (size_t)j * PWS + P_BX + c8); av[j] = (t0 >= 2) ? la : zz; bv[j] = (t0 >= 2) ? lb : zz; } }
#pragma unroll
                    for (int rr = 0; rr < RUN; ++rr) { const bf16* pr = P + (size_t)(m0 + rr) * PWS; av[2 + rr] = *(const u32x4*)(pr + P_BC + c8); bv[2 + rr] = *(const u32x4*)(pr + P_BX + c8); gv[rr] = *(const u32x4*)(pr + P_BB + c8); }
                    asm volatile("" ::: "memory");
                    float pw[3][8];
#pragma unroll
                    for (int j = 0; j < 2; ++j) { const u32x4 a = av[j], b = bv[j];
                        pw[j][0] = bf2f(a.x & 0xffffu) * bf2f(b.x & 0xffffu); pw[j][1] = bf2f(a.x >> 16) * bf2f(b.x >> 16); pw[j][2] = bf2f(a.y & 0xffffu) * bf2f(b.y & 0xffffu); pw[j][3] = bf2f(a.y >> 16) * bf2f(b.y >> 16);
                        pw[j][4] = bf2f(a.z & 0xffffu) * bf2f(b.z & 0xffffu); pw[j][5] = bf2f(a.z >> 16) * bf2f(b.z >> 16); pw[j][6] = bf2f(a.w & 0xffffu) * bf2f(b.w & 0xffffu); pw[j][7] = bf2f(a.w >> 16) * bf2f(b.w >> 16); }
#pragma unroll
                    for (int rr = 0; rr < RUN; ++rr) {
                        const u32x4 a = av[2 + rr], b = bv[2 + rr], g = gv[rr];
                        pw[2][0] = bf2f(a.x & 0xffffu) * bf2f(b.x & 0xffffu); pw[2][1] = bf2f(a.x >> 16) * bf2f(b.x >> 16); pw[2][2] = bf2f(a.y & 0xffffu) * bf2f(b.y & 0xffffu); pw[2][3] = bf2f(a.y >> 16) * bf2f(b.y >> 16);
                        pw[2][4] = bf2f(a.z & 0xffffu) * bf2f(b.z & 0xffffu); pw[2][5] = bf2f(a.z >> 16) * bf2f(b.z >> 16); pw[2][6] = bf2f(a.w & 0xffffu) * bf2f(b.w & 0xffffu); pw[2][7] = bf2f(a.w >> 16) * bf2f(b.w >> 16);
                        float acc[8];
#pragma unroll
                        for (int e = 0; e < 8; ++e) acc[e] = w[0][e] * pw[0][e] + w[1][e] * pw[1][e] + w[2][e] * pw[2][e];
                        u32x4 o; o.x = pk2(acc[0] * bf2f(g.x & 0xffffu), acc[1] * bf2f(g.x >> 16)); o.y = pk2(acc[2] * bf2f(g.y & 0xffffu), acc[3] * bf2f(g.y >> 16));
                        o.z = pk2(acc[4] * bf2f(g.z & 0xffffu), acc[5] * bf2f(g.z >> 16)); o.w = pk2(acc[6] * bf2f(g.w & 0xffffu), acc[7] * bf2f(g.w >> 16));
                        *(u32x4*)(YCAT + (size_t)(m0 + rr) * YW + 512 + c8) = o;
#pragma unroll
                        for (int e = 0; e < 8; ++e) { pw[0][e] = pw[1][e]; pw[1][e] = pw[2][e]; }
                    }
                }
            }
            } else {
            __syncthreads();
            {
            LAS bf16* Qs = (LAS bf16*)lds; LAS bf16* Ks = Qs + 128 * 136; LAS bf16* Vs = Ks + 64 * 136; LAS bf16* Aw = Vs + 64 * 136 + wave * (16 * 72);
            const int r = lane & 15, g4 = lane >> 4;
            for (int u = blk; u < GB * 4 * 16; u += NBLK) {
                const int bl = u >> 6, h = (u >> 4) & 3, qt = u & 15; const size_t mb = (size_t)bl * SEQ; const int q0 = qt * 128;
                volatile LAS unsigned* FLG = (volatile LAS unsigned*)(lds + MISC_OFF + 128);
                int par = 0;
                __syncthreads();
                if (lane == 0) { FLG[wave] = 0u; FLG[8 + wave] = 0u; }
                for (int i = tid; i < 2048; i += NTHR) { const int s = i >> 4, c8 = i & 15; *(LAS u32x4*)(Qs + s * 136 + c8 * 8) = *(const u32x4*)(P + (mb + q0 + s) * PWS + P_SQ + h * 128 + c8 * 8); }
                f32x4 O[8];
#pragma unroll
                for (int d = 0; d < 8; ++d) O[d] = zero4();
                float racc = 0.f; const int tq = q0 + 16 * wave + r;
                u32x4 kreg[2], vreg[2];
                { const int s0f = (2 * qt + 1) * 64;
#pragma unroll
                  for (int k2 = 0; k2 < 2; ++k2) { const int i = tid + 512 * k2, s = i >> 4, c8 = i & 15; const bf16* pr = P + (mb + s0f + s) * PWS + h * 128 + c8 * 8; kreg[k2] = *(const u32x4*)(pr + P_SK); vreg[k2] = *(const u32x4*)(pr + P_SV); } }
                for (int kt = 2 * qt + 1; kt >= 0; --kt) {
                    const int s0 = kt * 64;
                    __syncthreads();
                    { unsigned alldone = 1u;
#pragma unroll
                      for (int w8 = 0; w8 < 8; ++w8) alldone &= FLG[par * 8 + w8];
                      if (__builtin_amdgcn_readfirstlane((int)alldone)) break; }
#pragma unroll
                    for (int k2 = 0; k2 < 2; ++k2) { const int i = tid + 512 * k2, s = i >> 4, c8 = i & 15; *(LAS u32x4*)(Ks + s * 136 + c8 * 8) = kreg[k2]; *(LAS u32x4*)(Vs + s * 136 + c8 * 8) = vreg[k2]; }
                    if (kt > 0) {
#pragma unroll
                        for (int k2 = 0; k2 < 2; ++k2) { const int i = tid + 512 * k2, s = i >> 4, c8 = i & 15; const bf16* pr = P + (mb + s0 - 64 + s) * PWS + h * 128 + c8 * 8; kreg[k2] = *(const u32x4*)(pr + P_SK); vreg[k2] = *(const u32x4*)(pr + P_SV); } }
                    __syncthreads();
                    if (s0 < q0 + 16 * wave + 15) {
                        f32x4 z[4];
#pragma unroll
                        for (int j = 0; j < 4; ++j) z[j] = zero4();
#pragma unroll
                        for (int ks = 0; ks < 4; ++ks) { const bf16x8 fq = frag_kc(Qs, 136, 16 * wave, 32 * ks, lane);
#pragma unroll
                            for (int j = 0; j < 4; ++j) z[j] = MFMA16(frag_kc(Ks, 136, 16 * j, 32 * ks, lane), fq, z[j]); }
                        float ls[4][4], x[4][4], tsum[4];
#pragma unroll
                        for (int j = 0; j < 4; ++j) { float tj = 0.f;
#pragma unroll
                            for (int i = 0; i < 4; ++i) { const int s = s0 + 16 * j + 4 * g4 + i; const float zz = z[j][i] * 0.08838834764831845f;
                                const float l1 = fminf(zz, 0.f) - __logf(1.f + __expf(-fabsf(zz)));
                                ls[j][i] = l1; x[j][i] = (s < tq) ? (l1 - zz) : 0.f; tj += x[j][i]; }
                            tsum[j] = tj; }
                        float above[4], tot[4];
#pragma unroll
                        for (int j = 0; j < 4; ++j) { const float y1 = __shfl_xor(tsum[j], 16), y2 = __shfl_xor(tsum[j], 32), y3 = __shfl_xor(tsum[j], 48);
                            tot[j] = tsum[j] + y1 + y2 + y3;
                            above[j] = (g4 == 0) ? (y1 + y2 + y3) : (g4 == 1) ? (y2 + y3) : (g4 == 2) ? y1 : 0.f; }
                        float hi = racc;
#pragma unroll
                        for (int j = 3; j >= 0; --j) { float run = hi + above[j]; float av[4];
#pragma unroll
                            for (int i = 3; i >= 0; --i) { const int s = s0 + 16 * j + 4 * g4 + i; av[i] = (s < tq) ? __expf(ls[j][i] + run) : 0.f; run += x[j][i]; }
                            *(LAS u32x2*)(Aw + r * 72 + 16 * j + 4 * g4) = (u32x2){pk2(av[0], av[1]), pk2(av[2], av[3])};
                            hi += tot[j]; }
                        racc = hi;
                        LDS_WAIT(); asm volatile("" ::: "memory");
#pragma unroll
                        for (int ks = 0; ks < 2; ++ks) { const bf16x8 fa = frag_kc(Aw, 72, 0, 32 * ks, lane);
#pragma unroll
                            for (int d = 0; d < 8; ++d) O[d] = MFMA16(fa, frag_ks(Vs, 136, 16 * d, 32 * ks, lane), O[d]); }
                    }
                    par ^= 1;
                    { const bool wd = __all(racc < -104.f); if (lane == 0) FLG[par * 8 + wave] = wd ? 1u : 0u; }
                }
#pragma unroll
                for (int d = 0; d < 8; ++d)
#pragma unroll
                    for (int i = 0; i < 4; ++i) YCAT[(mb + q0 + 16 * wave + 4 * g4 + i) * YW + 1536 + h * 128 + 16 * d + r] = (bf16)f2bf(O[d][i]);
            }
            }
            }
            }
            GRID_BAR();
        }

        REPS(PH_M1) if (IN(PH_M1)) {
            PHASE_BEGIN();
            constexpr int NUA = GB * 4 * NCH, NUC = GB * NCH;
            LAS unsigned char* RAW = lds + 32768;
#define M1_DMA(uu) do { const int bh_ = (uu) >> 5, c_ = (uu) & 31, bl_ = bh_ >> 2, h_ = bh_ & 3; const size_t m0_ = (size_t)bl_ * SEQ + c_ * 64; \
                _Pragma("unroll") for (int t_ = 0; t_ < 3; ++t_) { const int j_ = wave * 3 + t_; \
                    const bf16* src_ = (j_ < 16) ? P + (m0_ + ((j_ * 64 + lane) >> 4)) * PWS + P_AV + h_ * 128 + ((j_ * 64 + lane) & 15) * 8 \
                                                 : P + (m0_ + (((j_ - 16) * 64 + lane) >> 3)) * PWS + P_AK + h_ * 64 + (((j_ - 16) * 64 + lane) & 7) * 8; \
                    __builtin_amdgcn_global_load_lds((const unsigned*)src_, (LAS unsigned*)(RAW + j_ * 1024), 16, 0, 0); } \
                if (wave < 4) { const float* s4_ = (wave == 0) ? SUMB + bh_ * 32 + (lane & 31) : (wave == 1) ? SUMG + bh_ * 32 + (lane & 31) : (wave == 2) ? GGc + (m0_ + lane) * 4 + h_ : GBc + (m0_ + 63) * 4 + h_; \
                    __builtin_amdgcn_global_load_lds((const unsigned*)s4_, (LAS unsigned*)(RAW + 24576 + wave * 256), 4, 0, 0); } } while (0)
            if (blk < NUA) M1_DMA(blk);
            for (int u = blk; u < NUA + NUC; u += NBLK) {
                if (u < NUA) {
                    const int ua = u, bh = ua >> 5, c = ua & 31;
                    LAS bf16* VP = (LAS bf16*)lds; LAS bf16* WK = (LAS bf16*)(lds + 64 * 152 * 2); const LAS float* SC = (const LAS float*)(RAW + 24576);
                    asm volatile("s_waitcnt vmcnt(0)" ::: "memory"); __syncthreads();
                    float bLj = 0.f, gmj = -1e30f;
                    if (lane < 32) { bLj = SC[lane]; gmj = SC[64 + lane]; }
                    float pa = bLj, pq = gmj + bLj;
#pragma unroll
                    for (int o = 1; o < 32; o <<= 1) { const float ta = __shfl_up(pa, o), tq = __shfl_up(pq, o); if (lane >= o) { pq = fmaxf(tq + pa, pq); pa = ta + pa; } }
                    const float mall = fmaxf(pa, pq);
                    const float mnew = __shfl(mall, c), mprev = (c == 0) ? 0.f : __shfl(mall, (c + 63) & 63);
                    const float bL = SC[192];
                    if (tid == 0) { MCAR[ua] = mprev; MNEW[ua] = mnew; MSC[ua] = __expf(bL + mprev - mnew); }
#pragma unroll
                    for (int k = 0; k < 2; ++k) { const int i = tid + k * NTHR, s = i >> 4, c8 = i & 15; *(LAS u32x4*)(VP + s * 152 + c8 * 8) = *(const LAS u32x4*)(RAW + i * 16); }
                    if (tid < 64) { *(LAS u32x4*)(VP + tid * 152 + 128) = uone4(); *(LAS u32x4*)(VP + tid * 152 + 136) = uzero4(); }
                    { const int s = tid >> 3, c8 = tid & 7; const float w = __expf(bL + SC[128 + s] - mnew);
                      *(LAS u32x4*)(WK + s * 72 + c8 * 8) = scale8(*(const LAS u32x4*)(RAW + 16384 + tid * 16), w); }
                    __syncthreads();
                    if (u + NBLK < NUA) M1_DMA(u + NBLK);
                    for (int ti = wave; ti < 36; ti += NWAVES) { const int mt = ti >> 2, nt = ti & 3; f32x4 acc = zero4();
#pragma unroll
                        for (int ks = 0; ks < 2; ++ks) acc = MFMA16(frag_ks(VP, 152, 16 * mt, 32 * ks, lane), frag_ks(WK, 72, 16 * nt, 32 * ks, lane), acc);
                        bf16* d = DC + (size_t)ua * 9216 + (16 * mt + 4 * (lane >> 4)) * 64 + 16 * nt + (lane & 15);
#pragma unroll
                        for (int i = 0; i < 4; ++i) d[i * 64] = (bf16)f2bf(acc[i]); }
                } else {
                    __syncthreads();
                    const int uc = u - NUA, bl = uc >> 5, c = uc & 31, hd = wave, gi = hd >> 2; const size_t m0 = (size_t)bl * SEQ + c * 64;
                    LAS bf16* XW = (LAS bf16*)(lds + hd * (64 * 72 * 2)); LAS bf16* BMs = (LAS bf16*)(lds + 8 * 64 * 72 * 2);
                    const float alast = ACB[(m0 + 63) * 8 + hd];
#pragma unroll
                    for (int k = 0; k < 8; ++k) { const int i = lane + 64 * k, s = i >> 3, c8 = i & 7; const float wd = __expf(alast - ACB[(m0 + s) * 8 + hd]) * DTB[(m0 + s) * 8 + hd];
                        *(LAS u32x4*)(XW + s * 72 + c8 * 8) = scale8(*(const u32x4*)(XBC + (m0 + s) * 1024 + hd * 64 + c8 * 8), wd); }
                    for (int i = tid; i < 2048; i += NTHR) { const int g2 = i >> 10, rem = i & 1023, s = rem >> 4, c8 = rem & 15;
                        *(LAS u32x4*)(BMs + g2 * (64 * 136) + s * 136 + c8 * 8) = *(const u32x4*)(XBC + (m0 + s) * 1024 + 512 + g2 * 128 + c8 * 8); }
                    __syncthreads();
                    const LAS bf16* BMg = BMs + gi * (64 * 136);
                    for (int pt = 0; pt < 4; ++pt) { f32x4 acc[8];
#pragma unroll
                        for (int n = 0; n < 8; ++n) acc[n] = zero4();
#pragma unroll
                        for (int ks = 0; ks < 2; ++ks) { const bf16x8 a = frag_ks(XW, 72, 16 * pt, 32 * ks, lane);
#pragma unroll
                            for (int n = 0; n < 8; ++n) acc[n] = MFMA16(a, frag_ks(BMg, 136, 16 * n, 32 * ks, lane), acc[n]); }
                        bf16* d = DH + ((size_t)(uc * 8 + hd) * 64 + 16 * pt + 4 * (lane >> 4)) * 128 + (lane & 15);
#pragma unroll
                        for (int n = 0; n < 8; ++n)
#pragma unroll
                            for (int i = 0; i < 4; ++i) d[i * 128 + 16 * n] = (bf16)f2bf(acc[n][i]); }
                    __syncthreads();
                }
            }
            GRID_BAR();
        }

#undef M1_DMA
        REPS(PH_M2) if (IN(PH_M2)) {
            PHASE_BEGIN();
            constexpr int NA = GB * 4 * 2304, NC = GB * 8 * 2048;
            for (int i = gt; i < NA + NC; i += NGT) {
                f32x4 st = zero4();
                if (i < NA) { const int bh = i / 2304, e = (i - bh * 2304) * 4; const bf16* dp = DC + (size_t)bh * NCH * 9216 + e; bf16* cp = CS + (size_t)bh * NCH * 9216 + e; const float* sp = MSC + (size_t)bh * NCH;
#pragma unroll 1
                    for (int c0 = 0; c0 < NCH; c0 += 4) { u32x2 dw[4]; float sc[4];
#pragma unroll
                        for (int k = 0; k < 4; ++k) { dw[k] = *(const u32x2*)(dp + (size_t)(c0 + k) * 9216); sc[k] = sp[c0 + k]; }
#pragma unroll
                        for (int k = 0; k < 4; ++k) { *(u32x2*)(cp + (size_t)(c0 + k) * 9216) = (u32x2){pk2(st.x, st.y), pk2(st.z, st.w)};
                            st = st * sc[k] + (f32x4){bf2f(dw[k].x & 0xffffu), bf2f(dw[k].x >> 16), bf2f(dw[k].y & 0xffffu), bf2f(dw[k].y >> 16)}; } }
                } else { const int j = i - NA, bhd = j >> 11, e = (j & 2047) * 4, bl = bhd >> 3, hd = bhd & 7;
                    const bf16* dp = DH + ((size_t)(bl * NCH) * 8 + hd) * 8192 + e; bf16* cp = HS + ((size_t)(bl * NCH) * 8 + hd) * 8192 + e; const float* ap = ACB + ((size_t)bl * SEQ + 63) * 8 + hd;
#pragma unroll 1
                    for (int c0 = 0; c0 < NCH; c0 += 4) { u32x2 dw[4]; float sc[4];
#pragma unroll
                        for (int k = 0; k < 4; ++k) { dw[k] = *(const u32x2*)(dp + (size_t)(c0 + k) * 8 * 8192); sc[k] = __expf(ap[(size_t)(c0 + k) * 64 * 8]); }
#pragma unroll
                        for (int k = 0; k < 4; ++k) { *(u32x2*)(cp + (size_t)(c0 + k) * 8 * 8192) = (u32x2){pk2(st.x, st.y), pk2(st.z, st.w)};
                            st = st * sc[k] + (f32x4){bf2f(dw[k].x & 0xffffu), bf2f(dw[k].x >> 16), bf2f(dw[k].y & 0xffffu), bf2f(dw[k].y >> 16)}; } }
                }
            }
            GRID_BAR();
        }

        REPS(PH_M3) if (IN(PH_M3)) {
            PHASE_BEGIN();
            constexpr int NUA = GB * 4 * NCH, NUC = 2 * GB * NCH;
            for (int u = blk; u < NUA + NUC; u += NBLK) {
                const int r = lane & 15, g4 = lane >> 4;
                if (u < NUA) {
                    const int ua = u, bh = ua >> 5, c = ua & 31, bl = bh >> 2, h = bh & 3; const size_t m0 = (size_t)bl * SEQ + c * 64;
                    LAS bf16* Qs = (LAS bf16*)lds; LAS bf16* Ks = Qs + 64 * 72; LAS bf16* VP = Ks + 64 * 72; LAS bf16* CST = VP + 64 * 152; LAS bf16* SMT = CST + 144 * 72; LAS bf16* AOT = SMT + 64 * 72;
                    LAS float* GS = (LAS float*)(AOT + 64 * 136);
                    LAS float* SSQ = GS + 256;
                    const float mcar = MCAR[ua];
                    { const int s = tid >> 3, c8 = tid & 7; const bf16* pr = P + (m0 + s) * PWS + h * 64 + c8 * 8;
                      *(LAS u32x4*)(Qs + s * 72 + c8 * 8) = *(const u32x4*)(pr + P_AQ); *(LAS u32x4*)(Ks + s * 72 + c8 * 8) = *(const u32x4*)(pr + P_AK); }
                    for (int i = tid; i < 1024; i += NTHR) { const int s = i >> 4, c8 = i & 15; const bf16* pr = P + (m0 + s) * PWS + h * 128 + c8 * 8;
                        *(LAS u32x4*)(VP + s * 152 + c8 * 8) = *(const u32x4*)(pr + P_AV); *(LAS u32x4*)(AOT + s * 136 + c8 * 8) = *(const u32x4*)(pr + P_AO); }
                    if (tid < 64) { *(LAS u32x4*)(VP + tid * 152 + 128) = uone4(); *(LAS u32x4*)(VP + tid * 152 + 136) = uzero4(); }
                    for (int i = tid; i < 1152; i += NTHR) { const int dv = i >> 3, c8 = i & 7; *(LAS u32x4*)(CST + dv * 72 + c8 * 8) = *(const u32x4*)(CS + (size_t)ua * 9216 + dv * 64 + c8 * 8); }
                    if (tid < 192) { const int arr = tid >> 6, s = tid & 63; const float* src = (arr == 0) ? GBc : (arr == 1) ? GGc : GMT; float v = src[(m0 + s) * 4 + h];
                        if (arr == 2) v = GBc[(m0 + s) * 4 + h] + fmaxf(mcar, v);
                        GS[arr * 64 + s] = v; }
                    __syncthreads();
#pragma unroll
                    for (int q2 = 0; q2 < 2; ++q2) { const int ti = 2 * wave + q2, tt = ti >> 2, st = ti & 3;
                        f32x4 acc = zero4();
                        if (st <= tt) {
#pragma unroll
                            for (int ks = 0; ks < 2; ++ks) acc = MFMA16(frag_kc(Qs, 72, 16 * tt, 32 * ks, lane), frag_kc(Ks, 72, 16 * st, 32 * ks, lane), acc);
                            const int s = 16 * st + r; const float gs = GS[64 + s];
#pragma unroll
                            for (int i = 0; i < 4; ++i) { const int t = 16 * tt + 4 * g4 + i; const float e = GS[t] - GS[128 + t] + gs;
                                acc[i] = (s <= t) ? acc[i] * 0.125f * __expf(e) : 0.f; }
                        }
                        *(LAS u32x2*)(SMT + (16 * st + r) * 72 + 16 * tt + 4 * g4) = (u32x2){pk2(acc[0], acc[1]), pk2(acc[2], acc[3])}; }
                    __syncthreads();
                    const int tt = wave & 3, half = wave >> 2;
                    f32x4 a1[5], a2[5];
#pragma unroll
                    for (int j = 0; j < 5; ++j) { a1[j] = zero4(); a2[j] = zero4(); }
#pragma unroll
                    for (int ks = 0; ks < 2; ++ks) { const bf16x8 fa1 = frag_ks(SMT, 72, 16 * tt, 32 * ks, lane), fa2 = frag_kc(Qs, 72, 16 * tt, 32 * ks, lane);
#pragma unroll
                        for (int j = 0; j < 5; ++j) { const int dvt = (j < 4) ? half * 4 + j : 8;
                            a1[j] = MFMA16(fa1, frag_ks(VP, 152, 16 * dvt, 32 * ks, lane), a1[j]);
                            a2[j] = MFMA16(fa2, frag_kc(CST, 72, 16 * dvt, 32 * ks, lane), a2[j]); } }
                    float hv[4][4], ssq[4];
#pragma unroll
                    for (int i = 0; i < 4; ++i) { const int t = 16 * tt + 4 * g4 + i; const float b = GS[t], mt = GS[128 + t];
                        const float is = 0.125f * __expf(b + mcar - mt);
                        float den = a1[4][i] + is * a2[4][i]; den = __shfl(den, lane & 48);
                        const float dn = __builtin_amdgcn_rcpf(fmaxf(fabsf(den), __expf(-mt))); float q = 0.f;
#pragma unroll
                        for (int j = 0; j < 4; ++j) { const float v = (a1[j][i] + is * a2[j][i]) * dn; hv[j][i] = v; q += v * v; }
                        q += __shfl_xor(q, 1); q += __shfl_xor(q, 2); q += __shfl_xor(q, 4); q += __shfl_xor(q, 8); ssq[i] = q; }
                    if (r == 0) {
#pragma unroll
                        for (int i = 0; i < 4; ++i) SSQ[half * 64 + 16 * tt + 4 * g4 + i] = ssq[i]; }
                    __syncthreads();
                    const float* ng = ka->in[I_ANG] + (size_t)l * 512 + h * 128;
#pragma unroll
                    for (int i = 0; i < 4; ++i) { const int t = 16 * tt + 4 * g4 + i; const float rstd = rsqrtf((SSQ[t] + SSQ[64 + t]) * (1.f / 128.f) + EPS);
#pragma unroll
                        for (int j = 0; j < 4; ++j) { const int dv = 16 * (half * 4 + j) + r; LAS bf16* op = AOT + t * 136 + dv;
                            *op = (bf16)f2bf(sigmoidf_(bf2f(*op)) * hv[j][i] * rstd * ng[dv]); } }
                    __syncthreads();
                    for (int i = tid; i < 1024; i += NTHR) { const int s = i >> 4, c8 = i & 15; *(u32x4*)(YCAT + (m0 + s) * YW + h * 128 + c8 * 8) = *(const LAS u32x4*)(AOT + s * 136 + c8 * 8); }
                    __syncthreads();
                } else {
                    const int uc2 = u - NUA, bl = uc2 >> 6, c = (uc2 >> 1) & 31, gi = uc2 & 1, hl = wave & 3, th = wave >> 2, hd = gi * 4 + hl; const size_t m0 = (size_t)bl * SEQ + c * 64;
                    LAS bf16* XHs = (LAS bf16*)lds;
                    LAS bf16* HTs = (LAS bf16*)(lds + 36864);
                    LAS bf16* BMg = (LAS bf16*)(lds + 36864 + 69632);
                    LAS bf16* MTt = (LAS bf16*)(lds + 36864 + 69632 + 17408 + wave * 3072);
                    LAS float* ADs = (LAS float*)(lds + 36864 + 69632 + 17408 + 24576);
                    const bf16* Xb = XBC + m0 * 1024;
                    for (int i = tid; i < 2048; i += NTHR) { const int h4 = i >> 9, rem = i & 511, s = rem >> 3, c8 = rem & 7;
                        *(LAS u32x4*)(XHs + h4 * (64 * 72) + s * 72 + c8 * 8) = *(const u32x4*)((Xb + gi * 256) + (unsigned)(s * 1024 + h4 * 64 + c8 * 8)); }
                    { const bf16* Hb = HS + (size_t)((bl * NCH + c) * 8 + gi * 4) * 8192;
                      for (int i = tid; i < 4096; i += NTHR) { const int h4 = i >> 10, rem = i & 1023, p = rem >> 4, c8 = rem & 15;
                        *(LAS u32x4*)(HTs + h4 * (64 * 136) + p * 136 + c8 * 8) = *(const u32x4*)(Hb + (unsigned)(h4 * 8192 + p * 128 + c8 * 8)); } }
                    for (int i = tid; i < 1024; i += NTHR) { const int s = i >> 4, c8 = i & 15; *(LAS u32x4*)(BMg + s * 136 + c8 * 8) = *(const u32x4*)((Xb + 512 + gi * 128) + (unsigned)(s * 1024 + c8 * 8)); }
                    { const int h4 = tid >> 7, arr = (tid >> 6) & 1, s = tid & 63; const float* src = arr ? DTB : ACB; ADs[tid] = (src + m0 * 8 + gi * 4)[(unsigned)(s * 8 + h4)]; }
                    const LAS bf16* XH = XHs + hl * (64 * 72); const LAS bf16* HT = HTs + hl * (64 * 136); const LAS float* AD = ADs + hl * 128;
                    const bf16* Cm = Xb + 768 + gi * 128; const bf16* Zp = P + m0 * PWS + P_CZ + hd * 64; const unsigned zlane = (unsigned)(4 * g4 * PWS + r), ylane = (unsigned)(4 * g4 * YW + r);
                    bf16* Yp = YCAT + m0 * YW + 1024 + hd * 64; float* Sp = SSQC + m0 * 8 + hd;
                    bf16x8 fcn[4];
#pragma unroll
                    for (int ks = 0; ks < 4; ++ks) fcn[ks] = gfrag_kc(Cm, 1024, 16 * th, 32 * ks, lane);
                    const float dsk = ka->in[I_CDSKIP][l * 8 + hd];
                    __syncthreads();
#pragma unroll 1
                    for (int k2 = 0; k2 < 2; ++k2) { const int tt = k2 ? 3 - th : th;
                        bf16x8 fcm[4]; unsigned short zc[4][4];
#pragma unroll
                        for (int ks = 0; ks < 4; ++ks) fcm[ks] = fcn[ks];
#pragma unroll
                        for (int p = 0; p < 4; ++p)
#pragma unroll
                            for (int i = 0; i < 4; ++i) zc[p][i] = (Zp + (size_t)(16 * tt + i) * PWS + 16 * p)[zlane];
#pragma unroll
                        for (int ks = 0; ks < 4; ++ks) fcn[ks] = gfrag_kc(Cm, 1024, 16 * (3 - th), 32 * ks, lane);
                        float at[4];
#pragma unroll
                        for (int i = 0; i < 4; ++i) at[i] = AD[16 * tt + 4 * g4 + i];
#pragma unroll 1
                        for (int st = 0; st <= tt; ++st) { f32x4 acc = zero4();
#pragma unroll
                            for (int ks = 0; ks < 4; ++ks) acc = MFMA16(fcm[ks], frag_kc(BMg, 136, 16 * st, 32 * ks, lane), acc);
                            const int s = 16 * st + r; const float as = AD[s], dts = AD[64 + s];
#pragma unroll
                            for (int i = 0; i < 4; ++i) { const int t = 16 * tt + 4 * g4 + i; acc[i] = (s <= t) ? acc[i] * __expf(at[i] - as) * dts : 0.f; if (s == t) acc[i] += dsk; }
                            *(LAS u32x2*)(MTt + (16 * st + r) * 24 + 4 * g4) = (u32x2){pk2(acc[0], acc[1]), pk2(acc[2], acc[3])}; }
                        if ((tt & 1) == 0) *(LAS u32x2*)(MTt + (16 * (tt + 1) + r) * 24 + 4 * g4) = (u32x2){uzero4().x, uzero4().y};
                        LDS_WAIT(); asm volatile("" ::: "memory");
                        f32x4 ad[4], ao[4];
#pragma unroll
                        for (int p = 0; p < 4; ++p) { ad[p] = zero4(); ao[p] = zero4(); }
#pragma unroll 1
                        for (int ks = 0; ks <= (tt >> 1); ++ks) { const bf16x8 fa = frag_ks(MTt, 24, 0, 32 * ks, lane);
#pragma unroll
                            for (int p = 0; p < 4; ++p) ad[p] = MFMA16(fa, frag_ks(XH, 72, 16 * p, 32 * ks, lane), ad[p]); }
#pragma unroll
                        for (int ks = 0; ks < 4; ++ks)
#pragma unroll
                            for (int p = 0; p < 4; ++p) ao[p] = MFMA16(fcm[ks], frag_kc(HT, 136, 16 * p, 32 * ks, lane), ao[p]);
#pragma unroll
                        for (int i = 0; i < 4; ++i) { const float ea = __expf(at[i]); float q = 0.f;
#pragma unroll
                            for (int p = 0; p < 4; ++p) { const float y = (ad[p][i] + ea * ao[p][i]) * siluf_(bf2f(zc[p][i])); q += y * y;
                                (Yp + (size_t)(16 * tt + i) * YW + 16 * p)[ylane] = (bf16)f2bf(y); }
                            q += __shfl_xor(q, 1); q += __shfl_xor(q, 2); q += __shfl_xor(q, 4); q += __shfl_xor(q, 8);
                            if (r == 0) (Sp + (16 * tt + i) * 8)[(unsigned)(32 * g4)] = q; }
                        LDS_WAIT(); asm volatile("" ::: "memory");
                    }
                    __syncthreads();
                }
            }
            GRID_BAR();
        }

        REPS(PH_LIFT) if (IN(PH_LIFT)) {
            PHASE_BEGIN();
            pg8::Gemm g{YCAT, WliftT, 512, YW, 512, (size_t)512 * 2, (size_t)DM * 512 * 2}; pg8::Order S; S.init(T, DM, NBLK, blk, 4);
            pg8::EpiLift E{FAC, MB + (size_t)(grp & 1) * T * DM, DM, SSQC};
            pg8::gemm_phase<pg8::EpiLift, GEMM_ALIGN>(lds, g, S, E);
            GRID_BAR();
        }
        REPS(PH_OUT) if (IN(PH_OUT) && (grp & 1)) {
            PHASE_BEGIN();
            const size_t prow0 = grow0 - T;
            pg8::Gemm g{MB, WoutT, DM, DM, DM, 0, 0}; pg8::Order S; S.init(2 * T, DM, NBLK, blk, 1);
            pg8::EpiResid E{XG + prow0 * DM, DM, SSQ2};
            pg8::gemm_phase<pg8::EpiResid, GEMM_ALIGN>(lds, g, S, E);
            GRID_BAR();
        }
        REPS(PH_UP) if (IN(PH_UP) && (grp & 1)) {
            PHASE_BEGIN();
            const size_t prow0 = grow0 - T;
            pg8::Gemm g{XG + prow0 * DM, WupT, DM, DM, DM, 0, 0}; pg8::Order S; S.init(2 * T, DFF2, NBLK, blk, 1);
            if (tid == 0) *(volatile LAS int*)(lds + 131072 + 12288 + 1024) = -1;
            pg8::EpiConvAct E{ACT, SSQ2, ka->in[I_FCW] + (size_t)l * 3 * DFF2, ka->in[I_FCB] + (size_t)l * DFF2, RAWH, lds + 131072, DFF2 / 256};
            pg8::gemm_phase<pg8::EpiConvAct, GEMM_ALIGN>(lds, g, S, E);
            GRID_BAR();
        }
        REPS(PH_DOWN) if (IN(PH_DOWN) && (grp & 1)) {
            PHASE_BEGIN();
            const size_t prow0 = grow0 - T;
            pg8::Gemm g{ACT, WdownT, DFF, 128, DFF, 0, 0, 65536, (size_t)22 * 65536}; pg8::Order S; S.init(2 * T, DM, NBLK, blk, 1);
            {
                const float* fw = ka->in[I_FCW] + (size_t)l * 3 * DFF2; const float* fb = ka->in[I_FCB] + (size_t)l * DFF2;
                pg8::Unit uu;
                for (int i = 0; S.next(i, uu); ++i) { const int pm = uu.pm; if ((pm & 7) == 0) continue;
                    for (int ch = tid; ch < DFF; ch += NTHR) { const int tp = ch >> 7, j = ch & 127;
                        const float* own = RAWH + (size_t)(pm * 22 + tp) * 1024; const float* prv = RAWH + (size_t)((pm - 1) * 22 + tp) * 1024;
                        const float g254 = prv[2 * 256 + j], g255 = prv[3 * 256 + j], g0 = own[j], g1 = own[256 + j];
                        const float u254 = prv[2 * 256 + 128 + j], u255 = prv[3 * 256 + 128 + j], u0 = own[128 + j], u1 = own[256 + 128 + j];
                        const float wg0 = fw[ch], wg1 = fw[DFF2 + ch], wg2 = fw[2 * DFF2 + ch], wu0 = fw[DFF + ch], wu1 = fw[DFF2 + DFF + ch], wu2 = fw[2 * DFF2 + DFF + ch], bg = fb[ch], bu = fb[DFF + ch];
                        ACT[((size_t)(pm * 22 + tp) * 256) * 128 + j] = (bf16)f2bf(siluf_(bg + wg0 * g254 + wg1 * g255 + wg2 * g0) * (bu + wu0 * u254 + wu1 * u255 + wu2 * u0));
                        ACT[((size_t)(pm * 22 + tp) * 256 + 1) * 128 + j] = (bf16)f2bf(siluf_(bg + wg0 * g255 + wg1 * g0 + wg2 * g1) * (bu + wu0 * u255 + wu1 * u0 + wu2 * u1)); } }
                asm volatile("s_waitcnt vmcnt(0)" ::: "memory"); __syncthreads();
            }
            pg8::EpiResid E{XG + prow0 * DM, DM, SSQ1 + prow0 * 16};
            pg8::gemm_phase<pg8::EpiResid, GEMM_ALIGN>(lds, g, S, E);
            GRID_BAR();
        }
        REPS(PH_FINAL) if (IN(PH_FINAL) && l == DEPTH - 1 && (grp & 1)) {
            PHASE_BEGIN();
            const size_t prow0 = grow0 - T;
            const float* gain = ka->in[I_FING];
            f32x4 gv[4];
#pragma unroll
            for (int j = 0; j < 4; ++j) gv[j] = ((const f32x4*)gain)[lane + 64 * j];
            for (int m = gw; m < 2 * T; m += NGW) {
                const u32x2* xr = (const u32x2*)(XG + (prow0 + m) * DM) + lane;
                f32x4 v[4]; float sq = 0.f;
#pragma unroll
                for (int j = 0; j < 4; ++j) { const u32x2 w = xr[64 * j]; v[j] = (f32x4){bf2f(w.x & 0xffffu), bf2f(w.x >> 16), bf2f(w.y & 0xffffu), bf2f(w.y >> 16)};
                    sq += (v[j].x * v[j].x + v[j].y * v[j].y) + (v[j].z * v[j].z + v[j].w * v[j].w); }
                const float rstd = rsqrtf(wave_sum(sq) * (1.f / DM) + EPS);
                f32x4* orow = (f32x4*)(ka->out + (prow0 + m) * DM) + lane;
#pragma unroll
                for (int j = 0; j < 4; ++j) orow[64 * j] = v[j] * rstd * gv[j];
            }
            GRID_BAR();
        }
    }
#undef IN
#undef GRID_BAR
#undef PHASE_BEGIN
}

#ifndef ONE_LAUNCH
#define ONE_LAUNCH 1
#endif
extern "C" void kernel_launch(void* const* d_in, const int* in_sizes, int n_in, void* d_out, int out_size, void* d_ws, size_t ws_size, hipStream_t stream) {
    static int grid = 0;
    if (grid == 0) {
        if (n_in != N_IN || in_sizes[0] != BATCH * SEQ * DM || out_size != BATCH * SEQ * DM || ws_size < WS_END) {
            fprintf(stderr, "kernel_launch: unexpected shapes / workspace (n_in %d, ws %zu, need %zu); nothing launched\n", n_in, ws_size, (size_t)WS_END); grid = -1; return; }
        int dev = 0, cus = 0, per_cu = 0;
        if (hipGetDevice(&dev) != hipSuccess || hipDeviceGetAttribute(&cus, hipDeviceAttributeMultiprocessorCount, dev) != hipSuccess) { grid = -1; return; }
        if (hipFuncSetAttribute((const void*)fwd, hipFuncAttributeMaxDynamicSharedMemorySize, LDS_BYTES) != hipSuccess) { fprintf(stderr, "kernel_launch: hipFuncSetAttribute failed\n"); grid = -1; return; }
        if (hipOccupancyMaxActiveBlocksPerMultiprocessor(&per_cu, (const void*)fwd, NTHR, LDS_BYTES) != hipSuccess || per_cu < 1) { fprintf(stderr, "kernel_launch: occupancy query says %d\n", per_cu); (void)hipGetLastError(); }
        grid = cus;
    }
    if (grid < 0) return;
    (void)hipMemsetAsync((char*)d_ws + WS_CTL, 0, (size_t)(4096 + XCD_BAR_WORDS) * 4, stream);
    Args a{};
    for (int i = 0; i < N_IN; ++i) a.in[i] = (const float*)d_in[i];
    a.out = (float*)d_out; a.ws = (unsigned char*)d_ws; a.pad = 0;
#if ONE_LAUNCH
    a.l_lo = 0; a.l_hi = DEPTH; a.g_lo = 0; a.g_hi = NG; a.ph_lo = 0; a.ph_hi = PH_COUNT; a.use_bar = 1;
    hipLaunchKernelGGL(fwd, dim3(grid), dim3(NTHR), LDS_BYTES, stream, a);
#else
    a.use_bar = 0;
    for (int l = 0; l < DEPTH; ++l)
        for (int g = 0; g < NG; ++g)
            for (int ph = 0; ph < PH_COUNT; ++ph) {
                if (ph == PH_W && g != 0) continue;
                if (ph == PH_FINAL && l != DEPTH - 1) continue;
                if ((ph == PH_OUT || ph == PH_UP || ph == PH_DOWN || ph == PH_FINAL) && !(g & 1)) continue;
                a.l_lo = l; a.l_hi = l + 1; a.g_lo = g; a.g_hi = g + 1; a.ph_lo = ph; a.ph_hi = ph + 1;
                hipLaunchKernelGGL(fwd, dim3(grid), dim3(NTHR), LDS_BYTES, stream, a);
            }
#endif
}
```

```cpp
#include <hip/hip_runtime.h>
#include <cstdio>
#include <cstdint>

#define LAS __attribute__((address_space(3)))
#define GAS __attribute__((address_space(1)))
typedef unsigned short bf16;
typedef short bf16x8 __attribute__((ext_vector_type(8)));
typedef short s16x4 __attribute__((ext_vector_type(4)));
typedef float f32x4 __attribute__((ext_vector_type(4)));
typedef float f32x2 __attribute__((ext_vector_type(2)));
typedef unsigned u32x4 __attribute__((ext_vector_type(4)));
typedef unsigned u32x2 __attribute__((ext_vector_type(2)));

constexpr int DM = 1024, BATCH = 32, SEQ = 2048, DEPTH = 4;
constexpr int PIN = 10256, PW = 10240, PWS = 6144, DFF = 2816, DFF2 = 5632;
constexpr int GB = 8;
constexpr int NG = BATCH / GB;
constexpr int FG = 4;
constexpr int T = GB * SEQ;
constexpr int NCH = SEQ / 64;
constexpr float EPS = 1e-6f;
constexpr int P_AQ = 0, P_AK = 256, P_AV = 512, P_AO = 1024, P_BB = 1536, P_BC = 2048, P_BX = 2560, P_CZ = 3072, P_CX = 3584, P_SQ = 4608, P_SK = 5120, P_SV = 5632, P_G = 6144;
constexpr int YW = 2048;

constexpr size_t MiB = 1u << 20;
constexpr size_t WS_CTL = 0, CTL_BYTES = 1 * MiB;
constexpr size_t WS_WIN = 1 * MiB;
constexpr size_t WS_WLIFT = WS_WIN + (size_t)PW * DM * 2;
constexpr size_t WS_WOUT = WS_WLIFT + (size_t)4 * DM * 512 * 2;
constexpr size_t WS_WUP = WS_WOUT + (size_t)DM * DM * 2;
constexpr size_t WS_WDOWN = WS_WUP + (size_t)DFF2 * DM * 2;
constexpr size_t WS_W16 = WS_WDOWN + (size_t)DM * DFF * 2;
constexpr size_t WS_XN = WS_W16 + 65536;
constexpr size_t WS_P = WS_XN + (size_t)T * DM * 2;
constexpr size_t WS_U = WS_P, WS_ACT = WS_P;
constexpr size_t WS_YCAT = WS_P + (size_t)T * PW * 2;
constexpr size_t WS_XG = WS_YCAT + (size_t)T * YW * 2;
constexpr size_t WS_MB = WS_XG + (size_t)BATCH * SEQ * DM * 2;
constexpr size_t WS_SP = WS_MB + (size_t)FG * T * DM * 2;
constexpr size_t WS_GB = WS_SP + (size_t)T * 16 * 4;
constexpr size_t WS_GG = WS_GB + (size_t)T * 16;
constexpr size_t WS_GMT = WS_GG + (size_t)T * 16;
constexpr size_t WS_MCAR = WS_GMT + (size_t)T * 16;
constexpr size_t WS_MNEW = WS_MCAR + 4096;
constexpr size_t WS_MSC = WS_MNEW + 4096;
constexpr size_t WS_SUMB = WS_MSC + 4096, WS_SUMG = WS_SUMB + 4096;
constexpr size_t WS_DT = WS_SUMG + 4096;
constexpr size_t WS_AC = WS_DT + (size_t)T * 32;
constexpr size_t WS_XBC = WS_AC + (size_t)T * 32;
constexpr size_t WS_DC = WS_XBC + (size_t)T * DM * 2;
constexpr size_t WS_CS = WS_DC + (size_t)GB * 4 * NCH * 9216 * 4;
constexpr size_t WS_DH = WS_CS + (size_t)GB * 4 * NCH * 9216 * 2;
constexpr size_t WS_HS = WS_DH + (size_t)GB * NCH * 8 * 8192 * 4;
constexpr size_t WS_SSQ1 = WS_HS + (size_t)GB * NCH * 8 * 8192 * 2;
constexpr size_t WS_SSQ2 = WS_SSQ1 + (size_t)BATCH * SEQ * 64;
constexpr size_t WS_SSQC = WS_SSQ2 + (size_t)FG * T * 64;
constexpr size_t WS_RAWH = WS_SSQC + (size_t)T * 32;
constexpr size_t WS_END = WS_RAWH + (size_t)(FG * T / 256) * 22 * 4 * 256 * 4;
static_assert((size_t)FG * T * DFF * 2 <= (size_t)T * PW * 2 + (size_t)T * YW * 2, "ACT overlays P and YCAT");

constexpr int NWAVES = 8, NTHR = 512;
constexpr int LDS_BYTES = 155648;
constexpr int MISC_OFF = 153600;

__device__ __forceinline__ float bf2f(unsigned b) { return __uint_as_float(b << 16); }
__device__ __forceinline__ unsigned f2bf(float f) { unsigned u = __float_as_uint(f); return (u + 0x7fffu + ((u >> 16) & 1u)) >> 16; }
__device__ __forceinline__ unsigned pk2(float lo, float hi) { return f2bf(lo) | (f2bf(hi) << 16); }
__device__ __forceinline__ float sigmoidf_(float x) { return __builtin_amdgcn_rcpf(1.f + __builtin_amdgcn_exp2f(-1.4426950408889634f * x)); }
__device__ __forceinline__ float siluf_(float x) { return x * __builtin_amdgcn_rcpf(1.f + __builtin_amdgcn_exp2f(-1.4426950408889634f * x)); }
__device__ __forceinline__ float logsigf_(float x) { return fminf(x, 0.f) - log1pf(expf(-fabsf(x))); }
__device__ __forceinline__ float softplusf_(float x) { return fmaxf(x, 0.f) + log1pf(expf(-fabsf(x))); }
__device__ __forceinline__ float wave_sum(float v) {
#pragma unroll
    for (int o = 1; o < 64; o <<= 1) v += __shfl_xor(v, o);
    return v;
}
#define LDS_WAIT() asm volatile("s_waitcnt lgkmcnt(0)" ::: "memory")
__device__ __forceinline__ float row_rstd(const float* ssq16) {
    const f32x4* p = (const f32x4*)ssq16; const f32x4 a = (p[0] + p[1]) + (p[2] + p[3]);
    return rsqrtf(((a.x + a.y) + (a.z + a.w)) * (1.f / 1024.f) + 1e-6f);
}

namespace pg8 {
constexpr int BM = 256, BK = 64, HALF = 128, HTB = HALF * BK * 2, STAGE_BYTES = 8 * HTB, NXCD = 8, WGM = 4;
__host__ __device__ __forceinline__ int lds_byte(int r, int c) { const int st = (r >> 4) * 2 + (c >> 5), rr = r & 15, cc = c & 31, ob = rr * 64 + cc * 2; return st * 1024 + (ob ^ (((ob >> 9) & 1) << 5)); }
__host__ __device__ __forceinline__ void stage_rc(int b, int& R, int& C) { const int st = b / 1024, sb = b % 1024, swz = sb ^ (((sb >> 9) & 1) << 5); R = (st >> 1) * 16 + swz / 64; C = (st & 1) * 32 + (swz % 64) / 2; }
__host__ __device__ __forceinline__ int perm32(int rho) { const int n = rho >> 4, i = rho & 15; return 8 * (i >> 2) + 4 * n + (i & 3); }

struct Unit { int pm, pn, z; };
struct Gemm { const bf16* A; const bf16* Bt; int K, lda, ldb; size_t zA, zB; size_t ablk = 256, atile = 0; };

struct Order {
    int nM, nN, nwg, G, c, Z;
    __device__ __forceinline__ void init(int M, int N, int G_, int c_, int Z_) { nM = M / BM; nN = N / BM; nwg = nM * nN; G = G_; c = c_; Z = Z_; }
    __device__ __forceinline__ bool next(int i, Unit& u) const {
        const int ti = i / Z; u.z = i - ti * Z;
        const long L = (long)ti * G + c; if (L >= nwg) return false;
        int wgid = (int)L; { const int q = nwg / NXCD, r = nwg % NXCD, xcd = wgid % NXCD, off = wgid / NXCD; wgid = (xcd < r ? xcd * (q + 1) : r * (q + 1) + (xcd - r) * q) + off; }
        const int nig = WGM * nN, gid = wgid / nig, fm = gid * WGM, gsz = (nM - fm) < WGM ? (nM - fm) : WGM;
        u.pm = fm + ((wgid % nig) % gsz); u.pn = (wgid % nig) / gsz; return true;
    }
};
__device__ __forceinline__ unsigned cvt_pk_bf16(float lo, float hi) { unsigned r; asm volatile("s_nop 0\n\tv_cvt_pk_bf16_f32 %0, %1, %2" : "=v"(r) : "v"(lo), "v"(hi)); return r; }

__device__ __forceinline__ void panel_rstd(LAS float* rsl, const float* ssq, int pm, int wr, int wc, int fr, int fq) {
    volatile LAS int* tag = (volatile LAS int*)(rsl + 256);
    if (__builtin_amdgcn_readfirstlane(*tag) != pm) {
        const int tidl = (wr * 4 + wc) * 64 + fq * 16 + fr, rr = tidl >> 1, hf = tidl & 1;
        const f32x4* p = (const f32x4*)(ssq + (size_t)(pm * BM + rr) * 16 + hf * 8); const f32x4 a = p[0] + p[1];
        float sq = (a.x + a.y) + (a.z + a.w); sq += __shfl_xor(sq, 1);
        __builtin_amdgcn_s_barrier();
        if (hf == 0) rsl[rr] = rsqrtf(sq * (1.f / 1024.f) + 1e-6f);
        if (tidl == 0) *tag = pm;
        asm volatile("s_waitcnt lgkmcnt(0)" ::: "memory"); __builtin_amdgcn_s_barrier(); asm volatile("" ::: "memory");
    }
}
struct EpiBf16 {
    static constexpr int MIN_STORES = 16;
    static constexpr bool PERM = true, KEEP = false, CONTIG = true;
    LAS float* rsl;
    bf16* O; int ldc; const float* ssq; int gate_pn0; bf16* fac;
    static __device__ __forceinline__ float s1(float xs) { return 1.f + __builtin_amdgcn_exp2f(__builtin_amdgcn_fmed3f(xs, -43.28085122666891f, 43.28085122666891f)); }
    __device__ __forceinline__ void operator()(f32x4 (&acc)[2][2][4][2], const Unit& u, int wr, int wc, int fr, int fq) const {
        panel_rstd(rsl, ssq, u.pm, wr, wc, fr, fq);
        if (u.pn >= gate_pn0) {
            const int row0g = u.pm * BM + wr * 64 + fr, d0 = 64 * (u.pn - gate_pn0) + 16 * wc + 4 * fq;
#pragma unroll
            for (int ai = 0; ai < 2; ++ai)
#pragma unroll
                for (int m = 0; m < 4; ++m) {
                    const float rs = -1.4426950408889634f * rsl[wr * 64 + fr + ai * HALF + m * 16];
                    const int cc = d0 & 255, pnL = d0 >> 8, bjL = cc >> 7, wcL = (cc >> 5) & 3, fqL = (cc >> 3) & 3, nL = (cc >> 2) & 1;
                    bf16* rowp = fac + ((((((size_t)(u.pm * 4 + pnL) * 4) * 16 + (ai * 4 + m) * 2 + bjL) * 8 + (wr * 4 + wcL)) * 64 + fqL * 16 + fr) * 8 + nL * 4);
                    const size_t zstep = (size_t)16 * 8 * 512;
                    float one = 1.f; asm volatile("" : "+v"(one));
                    float f0[4], f1[4], f2[4], f3[4];
#pragma unroll
                    for (int e = 0; e < 4; ++e) { const float a0 = s1(acc[ai][0][m][0][e] * rs), a1 = s1(acc[ai][0][m][1][e] * rs), a2 = s1(acc[ai][1][m][0][e] * rs), a3 = s1(acc[ai][1][m][1][e] * rs);
                        f0[e] = a1 * __builtin_amdgcn_rcpf(a0); f1[e] = a2 * __builtin_amdgcn_rcpf(a1); f2[e] = a3 * __builtin_amdgcn_rcpf(a2); f3[e] = one * __builtin_amdgcn_rcpf(a3); }
                    *(u32x2*)(rowp) = (u32x2){cvt_pk_bf16(f0[0], f0[1]), cvt_pk_bf16(f0[2], f0[3])};
                    *(u32x2*)(rowp + zstep) = (u32x2){cvt_pk_bf16(f1[0], f1[1]), cvt_pk_bf16(f1[2], f1[3])};
                    *(u32x2*)(rowp + 2 * zstep) = (u32x2){cvt_pk_bf16(f2[0], f2[1]), cvt_pk_bf16(f2[2], f2[3])};
                    *(u32x2*)(rowp + 3 * zstep) = (u32x2){cvt_pk_bf16(f3[0], f3[1]), cvt_pk_bf16(f3[2], f3[3])}; }
            return; }
        const int row0 = u.pm * BM + wr * 64 + fr, col0 = u.pn * BM + wc * 64 + 8 * fq;
#pragma unroll
        for (int ai = 0; ai < 2; ++ai)
#pragma unroll
            for (int m = 0; m < 4; ++m) { const int row = row0 + ai * HALF + m * 16; bf16* rowp = O + (size_t)row * ldc + col0;
                const float rs = rsl[wr * 64 + fr + ai * HALF + m * 16];
#pragma unroll
                for (int bj = 0; bj < 2; ++bj) { const f32x4 v0 = acc[ai][bj][m][0] * rs, v1 = acc[ai][bj][m][1] * rs;
                    u32x4 w; w.x = cvt_pk_bf16(v0[0], v0[1]); w.y = cvt_pk_bf16(v0[2], v0[3]); w.z = cvt_pk_bf16(v1[0], v1[1]); w.w = cvt_pk_bf16(v1[2], v1[3]);
                    *(u32x4*)(rowp + bj * 32) = w; } }
    }
};
struct EpiResid {
    static constexpr int MIN_STORES = 16;
    static constexpr bool PERM = true, KEEP = false, CONTIG = true;
    bf16* xb; int ldc; float* ssq;
    __device__ __forceinline__ void operator()(f32x4 (&acc)[2][2][4][2], const Unit& u, int wr, int wc, int fr, int fq) const {
        const int row0 = u.pm * BM + wr * 64 + fr, col0 = u.pn * BM + wc * 64 + 8 * fq;
#pragma unroll
        for (int ai = 0; ai < 2; ++ai) {
            u32x4 ov[4][2];
#pragma unroll
            for (int m = 0; m < 4; ++m)
#pragma unroll
                for (int bj = 0; bj < 2; ++bj) ov[m][bj] = *(const u32x4*)(xb + (size_t)(row0 + ai * HALF + m * 16) * ldc + col0 + bj * 32);
            asm volatile("" ::: "memory");
#pragma unroll
            for (int m = 0; m < 4; ++m) { const int row = row0 + ai * HALF + m * 16; const size_t off = (size_t)row * ldc + col0; float q = 0.f;
#pragma unroll
                for (int bj = 0; bj < 2; ++bj) {
                    const u32x4 o = ov[m][bj];
                    const f32x4 x0 = (f32x4){bf2f(o.x & 0xffffu), bf2f(o.x >> 16), bf2f(o.y & 0xffffu), bf2f(o.y >> 16)} + acc[ai][bj][m][0];
                    const f32x4 x1 = (f32x4){bf2f(o.z & 0xffffu), bf2f(o.z >> 16), bf2f(o.w & 0xffffu), bf2f(o.w >> 16)} + acc[ai][bj][m][1];
                    q += (x0[0] * x0[0] + x0[1] * x0[1]) + (x0[2] * x0[2] + x0[3] * x0[3]) + (x1[0] * x1[0] + x1[1] * x1[1]) + (x1[2] * x1[2] + x1[3] * x1[3]);
                    u32x4 w; w.x = cvt_pk_bf16(x0[0], x0[1]); w.y = cvt_pk_bf16(x0[2], x0[3]); w.z = cvt_pk_bf16(x1[0], x1[1]); w.w = cvt_pk_bf16(x1[2], x1[3]);
                    *(u32x4*)(xb + off + bj * 32) = w; }
                q += __shfl_xor(q, 16); q += __shfl_xor(q, 32); if (fq == 0) ssq[(size_t)row * 16 + u.pn * 4 + wc] = q;
            }
            asm volatile("" ::: "memory");
        }
    }
};
struct EpiLift {
    static constexpr int MIN_STORES = 0;
    static constexpr bool PERM = true, KEEP = true, CONTIG = false;
    const bf16* fac; bf16* mb; int ldc; const float* ssqc;
    __device__ __forceinline__ void operator()(f32x4 (&acc)[2][2][4][2], const Unit& u, int wr, int wc, int fr, int fq) const {
        const int row0 = u.pm * BM + wr * 64 + fr, col0 = u.pn * BM + wc * 32 + 8 * fq;
        f32x2 sc[2][4];
        if (u.z == 1 || u.z == 2) {
#pragma unroll
            for (int ai = 0; ai < 2; ++ai)
#pragma unroll
                for (int m = 0; m < 4; ++m) sc[ai][m] = *(const f32x2*)(ssqc + (size_t)(row0 + ai * HALF + m * 16) * 8 + 2 * fq); }
#pragma unroll
        for (int ai = 0; ai < 2; ++ai) {
            u32x4 gv[4][2];
#pragma unroll
            for (int m = 0; m < 4; ++m)
#pragma unroll
                for (int bj = 0; bj < 2; ++bj) gv[m][bj] = *(const u32x4*)(fac + (((((size_t)(u.pm * 4 + u.pn) * 4 + u.z) * 16 + (ai * 4 + m) * 2 + bj) * 8 + (wr * 4 + wc)) * 64 + fq * 16 + fr) * 8);
            asm volatile("" ::: "memory");
#pragma unroll
            for (int m = 0; m < 4; ++m) { const int row = row0 + ai * HALF + m * 16;
                float rsc = 1.f;
                if (u.z == 1 || u.z == 2) { float sq = sc[ai][m].x + sc[ai][m].y; sq += __shfl_xor(sq, 16); sq += __shfl_xor(sq, 32);
                    const float v = sq * (1.f / 512.f) + 1e-6f; rsc = (u.z == 1) ? sqrtf(v) : rsqrtf(v); }
#pragma unroll
                for (int bj = 0; bj < 2; ++bj) { const int col = col0 + bj * HALF;
                    const u32x4 g0 = gv[m][bj];
                    f32x4& v0 = acc[ai][bj][m][0]; f32x4& v1 = acc[ai][bj][m][1];
                    v0[0] *= rsc * bf2f(g0.x & 0xffffu); v0[1] *= rsc * bf2f(g0.x >> 16); v0[2] *= rsc * bf2f(g0.y & 0xffffu); v0[3] *= rsc * bf2f(g0.y >> 16);
                    v1[0] *= rsc * bf2f(g0.z & 0xffffu); v1[1] *= rsc * bf2f(g0.z >> 16); v1[2] *= rsc * bf2f(g0.w & 0xffffu); v1[3] *= rsc * bf2f(g0.w >> 16);
                    if (u.z == 3) { u32x4 w; w.x = cvt_pk_bf16(v0[0], v0[1]); w.y = cvt_pk_bf16(v0[2], v0[3]); w.z = cvt_pk_bf16(v1[0], v1[1]); w.w = cvt_pk_bf16(v1[2], v1[3]);
                        *(u32x4*)(mb + (size_t)row * ldc + col) = w; } } }
            asm volatile("" ::: "memory");
        }
    }
};

__device__ __forceinline__ float dpp_ror1(float x) { return __int_as_float(__builtin_amdgcn_update_dpp(0, __float_as_int(x), 0x121, 0xf, 0xf, false)); }
__device__ __forceinline__ float dpp_ror2(float x) { return __int_as_float(__builtin_amdgcn_update_dpp(0, __float_as_int(x), 0x122, 0xf, 0xf, false)); }
__device__ __forceinline__ float dpp_shr1(float x) { return __int_as_float(__builtin_amdgcn_update_dpp(0, __float_as_int(x), 0x111, 0xf, 0xf, true)); }
__device__ __forceinline__ float dpp_shr2(float x) { return __int_as_float(__builtin_amdgcn_update_dpp(0, __float_as_int(x), 0x112, 0xf, 0xf, true)); }
__device__ __forceinline__ float dpp_prev1(float cur, float prev) { return __int_as_float(__builtin_amdgcn_update_dpp(__builtin_amdgcn_update_dpp(0, __float_as_int(prev), 0x121, 0xf, 0xf, false), __float_as_int(cur), 0x111, 0xf, 0xf, false)); }
__device__ __forceinline__ float dpp_prev2(float cur, float prev) { return __int_as_float(__builtin_amdgcn_update_dpp(__builtin_amdgcn_update_dpp(0, __float_as_int(prev), 0x122, 0xf, 0xf, false), __float_as_int(cur), 0x112, 0xf, 0xf, false)); }
struct EpiConvAct {
    static constexpr int MIN_STORES = 12;
    static constexpr bool PERM = true, KEEP = false, CONTIG = false;
    bf16* act; const float* ssq; const float* cw; const float* cb; float* rawh; LAS unsigned char* halo; int ntn;
    __device__ __forceinline__ void operator()(f32x4 (&acc)[2][2][4][2], const Unit& u, int wr, int wc, int fr, int fq) const {
        asm volatile("" : "+v"(fr), "+v"(fq));
        const int row0 = u.pm * BM + wr * 64 + fr, ch0 = u.pn * 128 + wc * 32 + 8 * fq;
        LAS float* rsl = (LAS float*)(halo + 12288);
        LAS float* WL = (LAS float*)(halo + 8192);
        const int wl_i2 = ((wr * 4 + wc) * 64 + fq * 16 + fr) * 2;
        f32x2 wlv;
        { const int kind = wl_i2 >> 7, c = wl_i2 & 127, k4 = kind & 3; const float* src = (k4 < 3 ? cw + k4 * 5632 : cb) + (kind >= 4 ? 2816 : 0) + u.pn * 128 + c; wlv = *(const f32x2*)src; }
        panel_rstd(rsl, ssq, u.pm, wr, wc, fr, fq);
#pragma unroll
        for (int ai = 0; ai < 2; ++ai)
#pragma unroll
            for (int m = 0; m < 4; ++m) { const float rs = rsl[wr * 64 + fr + ai * HALF + m * 16];
#pragma unroll
                for (int bj = 0; bj < 2; ++bj) { acc[ai][bj][m][0] = acc[ai][bj][m][0] * rs; acc[ai][bj][m][1] = acc[ai][bj][m][1] * rs; } }
        LAS f32x4* H = (LAS f32x4*)halo;
        if (fr >= 14) {
#pragma unroll
            for (int ai = 0; ai < 2; ++ai) { const int b = 2 * ai + wr;
#pragma unroll
                for (int bj = 0; bj < 2; ++bj)
#pragma unroll
                    for (int n = 0; n < 2; ++n) H[((((b * 4 + wc) * 4 + fq) * 2 + (fr - 14)) * 2 + bj) * 2 + n] = acc[ai][bj][3][n]; } }
        { float* rw = rawh + (size_t)(u.pm * ntn + u.pn) * 1024;
          if (wr == 1 && fr >= 14) {
#pragma unroll
            for (int bj = 0; bj < 2; ++bj)
#pragma unroll
                for (int n = 0; n < 2; ++n) *(f32x4*)(rw + (2 + fr - 14) * 256 + bj * HALF + wc * 32 + 8 * fq + 4 * n) = acc[1][bj][3][n]; }
          if (wr == 0 && fr < 2) {
#pragma unroll
            for (int bj = 0; bj < 2; ++bj)
#pragma unroll
                for (int n = 0; n < 2; ++n) *(f32x4*)(rw + fr * 256 + bj * HALF + wc * 32 + 8 * fq + 4 * n) = acc[0][bj][0][n]; } }
        *(LAS f32x2*)(WL + wl_i2) = wlv;
        asm volatile("s_waitcnt lgkmcnt(0)" ::: "memory"); __builtin_amdgcn_s_barrier(); asm volatile("" ::: "memory");
        bf16* actb = act + ((size_t)(u.pm * ntn + u.pn) * BM + wr * 64) * 128 + wc * 32;
        const unsigned alane = (unsigned)(fr * 128 + 8 * fq);
        const float lm1 = (fr == 0) ? 1.f : 0.f, lm2 = (fr < 2) ? 1.f : 0.f;
        float zf = 0.f; asm volatile("" : "+v"(zf));
        unsigned pkw[2][4][3];
#pragma unroll
        for (int n = 0; n < 2; ++n) {
#pragma unroll
            for (int eh = 0; eh < 2; ++eh) {
                const int cl = wc * 32 + 8 * fq + 4 * n + 2 * eh;
                f32x2 wg[3], wu[3], bg, bu;
#pragma unroll
                for (int j = 0; j < 3; ++j) { wg[j] = *(const LAS f32x2*)(WL + j * 128 + cl); wu[j] = *(const LAS f32x2*)(WL + (4 + j) * 128 + cl); }
                bg = *(const LAS f32x2*)(WL + 3 * 128 + cl); bu = *(const LAS f32x2*)(WL + 7 * 128 + cl);
#pragma unroll
                for (int j = 0; j < 3; ++j) { wg[j] = wg[j] * 1.4426950408889634f; wu[j] = wu[j] * 0.6931471805599453f; }
                bg = bg * 1.4426950408889634f; bu = bu * 0.6931471805599453f;
                f32x2 wg1m = wg[1] * lm1, wg0m = wg[0] * lm2, wu1m = wu[1] * lm1, wu0m = wu[0] * lm2;
                asm volatile("" : "+v"(wg1m), "+v"(wg0m), "+v"(wu1m), "+v"(wu0m));
#pragma unroll
                for (int ai = 0; ai < 2; ++ai) { const int b = 2 * ai + wr;
#pragma unroll
                    for (int m = 3; m >= 0; --m) {
                        float r2[2];
#pragma unroll
                        for (int e2 = 0; e2 < 2; ++e2) { const int e = 2 * eh + e2;
                            const float gc = acc[ai][0][m][n][e], uc = acc[ai][1][m][n][e];
                            float gp = zf, up = zf;
                            if (m > 0) { gp = acc[ai][0][m - 1][n][e]; up = acc[ai][1][m - 1][n][e]; }
                            else if (b >= 1) { const int fk = fr >= 14 ? fr - 14 : 0; const LAS float* hp = (const LAS float*)(H + ((((b - 1) * 4 + wc) * 4 + fq) * 2 + fk) * 4 + n); gp = hp[e]; up = hp[8 + e]; }
                            float vg = fmaf(wg[2][e2], gc, bg[e2]), vu = fmaf(wu[2][e2], uc, bu[e2]);
                            asm volatile("s_nop 1\n\t"
                                         "v_fmac_f32_dpp %0, %2, %4 row_shr:1 row_mask:0xf bank_mask:0xf bound_ctrl:0\n\t"
                                         "v_fmac_f32_dpp %1, %3, %5 row_shr:1 row_mask:0xf bank_mask:0xf bound_ctrl:0\n\t"
                                         "v_fmac_f32_dpp %0, %2, %6 row_shr:2 row_mask:0xf bank_mask:0xf bound_ctrl:0\n\t"
                                         "v_fmac_f32_dpp %1, %3, %7 row_shr:2 row_mask:0xf bank_mask:0xf bound_ctrl:0\n\t"
                                         "v_fmac_f32_dpp %0, %8, %10 row_ror:1 row_mask:0xf bank_mask:0xf\n\t"
                                         "v_fmac_f32_dpp %1, %9, %11 row_ror:1 row_mask:0xf bank_mask:0xf\n\t"
                                         "v_fmac_f32_dpp %0, %8, %12 row_ror:2 row_mask:0xf bank_mask:0xf\n\t"
                                         "v_fmac_f32_dpp %1, %9, %13 row_ror:2 row_mask:0xf bank_mask:0xf"
                                         : "+v"(vg), "+v"(vu)
                                         : "v"(gc), "v"(uc), "v"(wg[1][e2]), "v"(wu[1][e2]), "v"(wg[0][e2]), "v"(wu[0][e2]), "v"(gp), "v"(up), "v"(wg1m[e2]), "v"(wu1m[e2]), "v"(wg0m[e2]), "v"(wu0m[e2]));
                            r2[e2] = (vg * vu) * __builtin_amdgcn_rcpf(1.f + __builtin_amdgcn_exp2f(-vg)); }
                        const unsigned pk = cvt_pk_bf16(r2[0], r2[1]);
                        if (2 * n + eh < 3) pkw[ai][m][2 * n + eh] = pk;
                        else *(u32x4*)(actb + (size_t)(ai * HALF + m * 16) * 128 + alane) = (u32x4){pkw[ai][m][0], pkw[ai][m][1], pkw[ai][m][2], pk};
                    }
                }
            }
        }
    }
};

template <class Epi, bool ALIGN_EPI = true>
__device__ __forceinline__ void gemm_phase(LAS unsigned char* lds, const Gemm g, const Order& S, const Epi& E) {
    int tid = threadIdx.x; asm volatile("" : "+v"(tid));
    const int wid = __builtin_amdgcn_readfirstlane(tid >> 6), lane = tid & 63, wr = wid >> 2, wc = wid & 3, fr = lane & 15, fq = lane >> 4;
    const int K = g.K, nt = K / BK;
    unsigned voffA[2], voffB[2];
#pragma unroll
    for (int i = 0; i < 2; ++i) { int R, C; stage_rc(tid * 16 + i * 8192, R, C);
        const int Rb = Epi::CONTIG ? (64 * (R >> 5) + perm32(R & 31)) : (Epi::PERM ? ((R & ~31) + perm32(R & 31)) : R);
        voffA[i] = (unsigned)(R * g.lda + C) * 2u; voffB[i] = (unsigned)(Rb * g.ldb + C) * 2u; }
    const size_t kstep = (size_t)(BK * 2);
    const size_t hstepA = (size_t)HALF * g.lda * 2, hstepB = (size_t)(Epi::CONTIG ? 32 : HALF) * g.ldb * 2;
    const size_t tstepA = g.atile ? g.atile : 2 * hstepA, tstepB = (size_t)BM * g.ldb * 2;
    const unsigned ldsw = (unsigned)wid * 1024u;
    const int aoff = lds_byte(wr * 64 + fr, fq * 8), boff = lds_byte(wc * 32 + fr, fq * 8);
#define PG8_SA(b, h) (((b) * 2 + (h)) * HTB)
#define PG8_SB(b, h) ((4 + (b) * 2 + (h)) * HTB)
#define PG8_STAGE(bufoff, gbase, voff) do { _Pragma("unroll") for (int _i = 0; _i < 2; ++_i) \
        __builtin_amdgcn_global_load_lds((const unsigned*)((const char*)(gbase) + (voff)[_i]), (LAS unsigned*)(lds + (bufoff) + ldsw + _i * 8192), 16, 0, 0); } while (0)
#define PG8_LDA(dst, b, h) do { _Pragma("unroll") for (int m = 0; m < 4; ++m) _Pragma("unroll") for (int k = 0; k < 2; ++k) dst[m][k] = *(const LAS bf16x8*)(lds + PG8_SA(b, h) + aoff + m * 2048 + k * 1024); } while (0)
#define PG8_LDB(dst, b, h) do { _Pragma("unroll") for (int n = 0; n < 2; ++n) _Pragma("unroll") for (int k = 0; k < 2; ++k) dst[n][k] = *(const LAS bf16x8*)(lds + PG8_SB(b, h) + boff + n * 2048 + k * 1024); } while (0)
#define PG8_MMA(ai, bj, At, Bt) do { __builtin_amdgcn_s_setprio(1); _Pragma("unroll") for (int m = 0; m < 4; ++m) _Pragma("unroll") for (int n = 0; n < 2; ++n) _Pragma("unroll") for (int k = 0; k < 2; ++k) \
        acc[ai][bj][m][n] = __builtin_amdgcn_mfma_f32_16x16x32_bf16(Bt[n][k], At[m][k], acc[ai][bj][m][n], 0, 0, 0); __builtin_amdgcn_s_setprio(0); } while (0)
#define PG8_WAIT_V(n) asm volatile("s_waitcnt vmcnt(" #n ")" ::: "memory")
#define PG8_WAIT_L(n) asm volatile("s_waitcnt lgkmcnt(" #n ")" ::: "memory")
#define PG8_WAIT_V8R(r) asm volatile("s_cmp_lg_u32 %0, 0\n\ts_cbranch_scc0 .Lw8_%=\n\ts_waitcnt vmcnt(%1)\n\ts_branch .Lwd_%=\n.Lw8_%=:\n\ts_waitcnt vmcnt(8)\n.Lwd_%=:" :: "s"(__builtin_amdgcn_readfirstlane(r)), "n"(8 + Epi::MIN_STORES) : "memory", "scc")
#define PG8_BAR __builtin_amdgcn_s_barrier()
#define PG8_SCHED __builtin_amdgcn_sched_barrier(0)
    Unit cur, nxt; int ui = 0;
    if (!S.next(0, cur)) return;
    f32x4 acc[2][2][4][2];
#pragma unroll
    for (int a = 0; a < 2; ++a)
#pragma unroll
        for (int b = 0; b < 2; ++b)
#pragma unroll
            for (int m = 0; m < 4; ++m)
#pragma unroll
                for (int n = 0; n < 2; ++n) acc[a][b][m][n] = (f32x4){0.f, 0.f, 0.f, 0.f};
    bf16x8 At[4][2], B0[2][2], B1[2][2];
    const char* cA = (const char*)g.A + (size_t)cur.pm * tstepA + (size_t)cur.z * g.zA; const char* cB = (const char*)g.Bt + (size_t)cur.pn * tstepB + (size_t)cur.z * g.zB;
    PG8_STAGE(PG8_SB(0, 0), cB, voffB); PG8_STAGE(PG8_SB(0, 1), cB + hstepB, voffB); PG8_STAGE(PG8_SA(0, 0), cA, voffA); PG8_STAGE(PG8_SA(0, 1), cA + hstepA, voffA);
    if (wr == 1) PG8_BAR;
    PG8_WAIT_V(2); PG8_BAR;
    PG8_STAGE(PG8_SB(1, 0), cB + kstep, voffB); PG8_STAGE(PG8_SA(1, 0), cA + kstep, voffA); PG8_STAGE(PG8_SB(1, 1), cB + hstepB + kstep, voffB);
    PG8_WAIT_V(6); PG8_BAR;
    for (;;) {
        const bool has_next = S.next(ui + 1, nxt);
        const char* nA = has_next ? (const char*)g.A + (size_t)nxt.pm * tstepA + (size_t)nxt.z * g.zA : cA; const char* nB = has_next ? (const char*)g.Bt + (size_t)nxt.pn * tstepB + (size_t)nxt.z * g.zB : cB;
        for (int t = 0; t < nt; t += 2) {
            const bool last = (t == nt - 2);
            const char* a1 = cA + (size_t)(t >> 1) * g.ablk + kstep;
            const char* a2 = last ? nA : cA + (size_t)((t >> 1) + 1) * g.ablk; const char* b2 = last ? nB : cB + (size_t)(t + 2) * kstep;
            const char* a3 = a2 + kstep; const char* b3 = b2 + kstep;
            const int relax = ((t == 0) && (ui > 0)) ? 1 : 0; (void)relax;
            PG8_LDB(B0, 0, 0); PG8_LDB(B1, 0, 1); PG8_SCHED; PG8_LDA(At, 0, 0); PG8_STAGE(PG8_SA(1, 1), a1 + hstepA, voffA);
            if constexpr (Epi::MIN_STORES > 0) PG8_WAIT_V8R(relax); else PG8_WAIT_V(8);
            PG8_WAIT_L(0); PG8_BAR; PG8_MMA(0, 0, At, B0); PG8_MMA(0, 1, At, B1); PG8_BAR; PG8_SCHED;
            PG8_LDA(At, 0, 1); PG8_STAGE(PG8_SB(0, 0), b2, voffB); PG8_STAGE(PG8_SB(0, 1), b2 + hstepB, voffB); PG8_STAGE(PG8_SA(0, 0), a2, voffA);
            if constexpr (Epi::MIN_STORES > 0) PG8_WAIT_V8R(relax); else PG8_WAIT_V(8);
            PG8_WAIT_L(0); PG8_BAR; PG8_MMA(1, 0, At, B0); PG8_MMA(1, 1, At, B1); PG8_BAR; PG8_SCHED;
            PG8_LDB(B0, 1, 0); PG8_LDB(B1, 1, 1); PG8_SCHED; PG8_LDA(At, 1, 0); PG8_STAGE(PG8_SA(0, 1), a2 + hstepA, voffA);
            PG8_WAIT_V(8); PG8_WAIT_L(0); PG8_BAR; PG8_MMA(0, 0, At, B0); PG8_MMA(0, 1, At, B1); PG8_BAR; PG8_SCHED;
            PG8_LDA(At, 1, 1); PG8_STAGE(PG8_SB(1, 0), b3, voffB); PG8_STAGE(PG8_SB(1, 1), b3 + hstepB, voffB); PG8_STAGE(PG8_SA(1, 0), a3, voffA);
            PG8_WAIT_V(8); PG8_WAIT_L(0); PG8_BAR; PG8_MMA(1, 0, At, B0); PG8_MMA(1, 1, At, B1); PG8_BAR; PG8_SCHED;
        }
        if constexpr (ALIGN_EPI) { if (wr == 0) PG8_BAR; }
        E(acc, cur, wr, wc, fr, fq);
        if (!has_next) break;
        if (!(Epi::KEEP && nxt.z != 0))
#pragma unroll
        for (int a = 0; a < 2; ++a)
#pragma unroll
            for (int b = 0; b < 2; ++b)
#pragma unroll
                for (int m = 0; m < 4; ++m)
#pragma unroll
                    for (int n = 0; n < 2; ++n) acc[a][b][m][n] = (f32x4){0.f, 0.f, 0.f, 0.f};
        cur = nxt; cA = nA; cB = nB; ++ui;
        if constexpr (ALIGN_EPI) { if (wr == 1) PG8_BAR; }
    }
    PG8_WAIT_V(0);
    if constexpr (!ALIGN_EPI) { if (wr == 0) PG8_BAR; }
    PG8_BAR;
#undef PG8_SA
#undef PG8_SB
#undef PG8_STAGE
#undef PG8_LDA
#undef PG8_LDB
#undef PG8_MMA
#undef PG8_WAIT_V
#undef PG8_WAIT_L
#undef PG8_WAIT_V8R
#undef PG8_BAR
#undef PG8_SCHED
}
}

#define XB_TMO      128
#define XB_XCNT(j)  (256  + 64 * (j))
#define XB_XSUB(j)  (1280 + 64 * (j))
#define XB_XGEN(j)  (2304 + 64 * (j))
#define XB_TOP      3328
#define XB_TOPGEN   3392
#define XCD_BAR_WORDS 3456
#define XB_SPIN_CAP (1u << 18)
__device__ __forceinline__ unsigned xb_ld(unsigned* p)              { return __hip_atomic_load(p, __ATOMIC_RELAXED, __HIP_MEMORY_SCOPE_AGENT); }
__device__ __forceinline__ unsigned xb_add(unsigned* p, unsigned v) { return __hip_atomic_fetch_add(p, v, __ATOMIC_RELAXED, __HIP_MEMORY_SCOPE_AGENT); }
__device__ __forceinline__ unsigned xb_xcc_id() { return (unsigned)__builtin_amdgcn_s_getreg((3 << 11) | 20) & 0xFu; }
#define XB_SPIN(cond, bar) do { unsigned _sp = 0; while (cond) { __builtin_amdgcn_s_sleep(1); \
    if ((++_sp & 255u) == 0u) { if (xb_ld(&(bar)[XB_TMO])) break; if (_sp > XB_SPIN_CAP) { atomicAdd(&(bar)[XB_TMO], 1u); break; } } } } while (0)
struct XcdBarrier { unsigned* bar; unsigned x; volatile LAS unsigned* st; };
__device__ __forceinline__ XcdBarrier xcd_barrier_post(unsigned* bar, volatile LAS unsigned* st) {
    XcdBarrier b; b.bar = bar; b.x = xb_xcc_id(); b.st = st;
    if (threadIdx.x == 0) (void)xb_add(&bar[XB_XCNT(b.x)], 1u);
    return b;
}
__device__ __forceinline__ void xcd_barrier_complete(unsigned* bar, unsigned x, unsigned& nloc, unsigned& nx) {
    const unsigned G = gridDim.x * gridDim.y * gridDim.z;
    unsigned sum, cnt, mine, sp = 0u;
    for (;;) {
        sum = 0u; cnt = 0u; mine = 0u;
#pragma unroll
        for (unsigned j = 0; j < 16; ++j) { const unsigned c = xb_ld(&bar[XB_XCNT(j)]); sum += c; cnt += (c > 0u) ? 1u : 0u; mine = (j == x) ? c : mine; }
        if (sum == G) break;
        __builtin_amdgcn_s_sleep(1);
        if ((++sp & 255u) == 0u) { if (xb_ld(&bar[XB_TMO])) break; if (sp > XB_SPIN_CAP) { atomicAdd(&bar[XB_TMO], 1u); break; } }
    }
    nloc = mine > 0u ? mine : 1u; nx = cnt > 0u ? cnt : 1u;
}
__device__ __forceinline__ void xcd_barrier(const XcdBarrier& b) {
    asm volatile("s_waitcnt vmcnt(0)" ::: "memory");
    __syncthreads();
    if (threadIdx.x == 0) {
        unsigned* bar = b.bar;
        __builtin_amdgcn_s_waitcnt(0);
        unsigned nloc = b.st[0], nx = b.st[1];
        if (nloc == 0u) { xcd_barrier_complete(bar, b.x, nloc, nx); b.st[0] = nloc; b.st[1] = nx; }
        const unsigned old = xb_add(&bar[XB_XSUB(b.x)], 1u);
        const unsigned gen = old / nloc;
        if (old + 1u == (gen + 1u) * nloc) {
            __builtin_amdgcn_fence(__ATOMIC_RELEASE, "agent");
            asm volatile("s_waitcnt vmcnt(0)" ::: "memory");
            const unsigned og = xb_add(&bar[XB_TOP], 1u);
            const unsigned tg = og / nx;
            if (og + 1u == (tg + 1u) * nx) xb_add(&bar[XB_TOPGEN], 1u);
            else XB_SPIN(xb_ld(&bar[XB_TOPGEN]) == tg, bar);
            __builtin_amdgcn_fence(__ATOMIC_ACQUIRE, "agent");
            xb_add(&bar[XB_XGEN(b.x)], 1u);
            asm volatile("s_waitcnt vmcnt(0)" ::: "memory");
        } else {
            XB_SPIN(xb_ld(&bar[XB_XGEN(b.x)]) == gen, bar);
            __builtin_amdgcn_fence(__ATOMIC_ACQUIRE, "agent");
            asm volatile("s_waitcnt vmcnt(0)" ::: "memory");
        }
    }
    __syncthreads();
}

__device__ __forceinline__ bf16x8 frag_kc(const LAS bf16* X, int ld, int mn0, int k0, int lane) { return *(const LAS bf16x8*)(X + (mn0 + (lane & 15)) * ld + k0 + 8 * (lane >> 4)); }
__device__ __forceinline__ bf16x8 gfrag_kc(const bf16* X, int ld, int mn0, int k0, int lane) { const bf16* b = X + (size_t)mn0 * ld + k0; const unsigned lo = (unsigned)((lane & 15) * ld + 8 * (lane >> 4)); return *(const bf16x8*)(b + lo); }
__device__ __forceinline__ s16x4 trr(const LAS bf16* p) { return __builtin_bit_cast(s16x4, __builtin_amdgcn_ds_read_tr16_b64_v4i16((LAS s16x4*)p)); }
__device__ __forceinline__ bf16x8 frag_ks(const LAS bf16* X, int ld, int mn0, int k0, int lane) {
    const int r = lane & 15, g = lane >> 4;
    const LAS bf16* p = X + (k0 + 8 * g + (r >> 2)) * ld + mn0 + 4 * (r & 3);
    const s16x4 lo = trr(p), hi = trr(p + 4 * ld);
    return (bf16x8){lo[0], lo[1], lo[2], lo[3], hi[0], hi[1], hi[2], hi[3]};
}
__device__ __forceinline__ f32x4 zero4() { f32x4 z = {0.f, 0.f, 0.f, 0.f}; asm volatile("" : "+v"(z)); return z; }
__device__ __forceinline__ u32x4 uone4() { u32x4 z = {0x3F80u, 0u, 0u, 0u}; asm volatile("" : "+v"(z)); return z; }
__device__ __forceinline__ u32x4 uzero4() { u32x4 z = {0u, 0u, 0u, 0u}; asm volatile("" : "+v"(z)); return z; }
#define MFMA16(a, b, c) __builtin_amdgcn_mfma_f32_16x16x32_bf16((a), (b), (c), 0, 0, 0)
__device__ __forceinline__ u32x4 scale8(u32x4 w, float s) {
    u32x4 o;
    o.x = pk2(bf2f(w.x & 0xffffu) * s, bf2f(w.x >> 16) * s); o.y = pk2(bf2f(w.y & 0xffffu) * s, bf2f(w.y >> 16) * s);
    o.z = pk2(bf2f(w.z & 0xffffu) * s, bf2f(w.z >> 16) * s); o.w = pk2(bf2f(w.w & 0xffffu) * s, bf2f(w.w >> 16) * s);
    return o;
}
__device__ __forceinline__ float wscan_add(float v, int lane) {
#pragma unroll
    for (int o = 1; o < 64; o <<= 1) { const float t = __shfl_up(v, o); if (lane >= o) v += t; }
    return v;
}
__device__ __forceinline__ float wscan_max(float v, int lane) {
#pragma unroll
    for (int o = 1; o < 64; o <<= 1) { const float t = __shfl_up(v, o); if (lane >= o) v = fmaxf(v, t); }
    return v;
}

#ifndef GEMM_ALIGN
#define GEMM_ALIGN true
#endif
enum { PH_W = 0, PH_INPROJ, PH_M0, PH_M1, PH_M2, PH_M3, PH_LIFT, PH_OUT, PH_UP, PH_DOWN, PH_FINAL, PH_COUNT };
enum { I_X = 0, I_MIXG, I_WIN, I_AIB, I_AFB, I_ANG, I_BCW, I_CCW, I_CCB, I_CDTB, I_CALOG, I_CDSKIP, I_CNG, I_WLIFT, I_WOUT, I_FFNG, I_WUP, I_FCW, I_FCB, I_WDOWN, I_FING, N_IN };
struct Args { const float* in[N_IN]; float* out; unsigned char* ws; int l_lo, l_hi, g_lo, g_hi, ph_lo, ph_hi, use_bar, pad; };

__device__ __forceinline__ void transpose_item(const float* W, int ldw, int nsrc0, int k0, bf16* WT, int ldt, int ndst0, LAS float* scr, int lane, const float* kscale = nullptr, int gate_tile = -1) {
    int scol = nsrc0 + (lane & 31);
    if (gate_tile >= 0) {
        const int c = (ndst0 & 255) + (lane & 31), wc = c >> 6, bj = (c >> 5) & 1, fq = (c >> 3) & 3, n = (c >> 2) & 1, e = c & 3;
        scol = 6160 + (2 * bj + n) * 1024 + 64 * gate_tile + 16 * wc + 4 * fq + e; }
#pragma unroll 8
    for (int i = 0; i < 32; ++i) { const int kk = 2 * i + (lane >> 5); scr[kk * 33 + (lane & 31)] = W[(size_t)(k0 + kk) * ldw + scol] * (kscale ? kscale[k0 + kk] : 1.f); }
    LDS_WAIT(); asm volatile("" ::: "memory");
    const int c = lane & 7;
#pragma unroll
    for (int j = 0; j < 4; ++j) { const int n = (lane >> 3) + 8 * j; const LAS float* s = scr + (8 * c) * 33 + n;
        u32x4 o; o.x = pk2(s[0 * 33], s[1 * 33]); o.y = pk2(s[2 * 33], s[3 * 33]); o.z = pk2(s[4 * 33], s[5 * 33]); o.w = pk2(s[6 * 33], s[7 * 33]);
        *(u32x4*)(WT + (size_t)(ndst0 + n) * ldt + k0 + 8 * c) = o; }
    LDS_WAIT(); asm volatile("" ::: "memory");
}

__global__ void __launch_bounds__(NTHR, 2) fwd(Args args) {
    extern __shared__ __attribute__((aligned(16))) unsigned char lds_raw[];
    LAS unsigned char* lds = (LAS unsigned char*)lds_raw;
    const int NBLK = gridDim.x, blk = blockIdx.x;
    {
        volatile LAS unsigned* MISC0 = (volatile LAS unsigned*)(lds + MISC_OFF);
        if (threadIdx.x < 16) MISC0[threadIdx.x] = 0u;
        __syncthreads();
    }
    XcdBarrier bar; bar.bar = (unsigned*)(args.ws + WS_CTL) + 4096; bar.x = 0; bar.st = nullptr;
    if (args.use_bar) bar = xcd_barrier_post((unsigned*)(args.ws + WS_CTL) + 4096, (volatile LAS unsigned*)(lds + MISC_OFF) + 8);
#define GRID_BAR() do { if (args.use_bar) xcd_barrier(bar); } while (0)
#ifndef REPMASK
#define REPMASK 0
#endif
#define IN(k) (args.ph_lo <= (k) && (k) < args.ph_hi)
#define REPS(k) for (int rep_ = 0; rep_ < 1 + ((REPMASK >> (k)) & 1); ++rep_)
#define PHASE_BEGIN() int tid = threadIdx.x; asm volatile("" : "+v"(tid)); const int lane = tid & 63, wave = __builtin_amdgcn_readfirstlane(tid >> 6); \
    const __attribute__((address_space(4))) Args* ka = (const __attribute__((address_space(4))) Args*)__builtin_amdgcn_kernarg_segment_ptr(); asm volatile("" : "+s"(ka)); \
    unsigned char* ws = ka->ws; \
    const size_t grow0 = (size_t)grp * T; const float* xsrc = (l == 0) ? ka->in[I_X] : ka->out; (void)grow0; (void)xsrc; \
    const int gw = blk * NWAVES + wave, NGW = NBLK * NWAVES, gt = blk * NTHR + tid, NGT = NBLK * NTHR; (void)lane; (void)gw; (void)NGW; (void)gt; (void)NGT; \
    bf16* const WinT = (bf16*)(ws + WS_WIN); bf16* const WliftT = (bf16*)(ws + WS_WLIFT); bf16* const WoutT = (bf16*)(ws + WS_WOUT); \
    bf16* const WupT = (bf16*)(ws + WS_WUP); bf16* const WdownT = (bf16*)(ws + WS_WDOWN); bf16* const W16B = (bf16*)(ws + WS_W16); \
    bf16* const XN = (bf16*)(ws + WS_XN); bf16* const P = (bf16*)(ws + WS_P); bf16* const FAC = (bf16*)(ws + WS_P) + (size_t)T * PWS; (void)FAC; bf16* const U = (bf16*)(ws + WS_U); bf16* const ACT = (bf16*)(ws + WS_ACT); \
    bf16* const YCAT = (bf16*)(ws + WS_YCAT); bf16* const XG = (bf16*)(ws + WS_XG); bf16* const MB = (bf16*)(ws + WS_MB); float* const SP = (float*)(ws + WS_SP); \
    float* const SSQ1 = (float*)(ws + WS_SSQ1); float* const SSQ2 = (float*)(ws + WS_SSQ2); float* const SSQC = (float*)(ws + WS_SSQC); float* const RAWH = (float*)(ws + WS_RAWH); (void)SSQ1; (void)SSQ2; (void)SSQC; (void)RAWH; \
    float* const GBc = (float*)(ws + WS_GB); float* const GGc = (float*)(ws + WS_GG); float* const GMT = (float*)(ws + WS_GMT); \
    float* const MCAR = (float*)(ws + WS_MCAR); float* const MNEW = (float*)(ws + WS_MNEW); float* const MSC = (float*)(ws + WS_MSC); float* const SUMB = (float*)(ws + WS_SUMB); float* const SUMG = (float*)(ws + WS_SUMG); (void)SUMB; (void)SUMG; \
    float* const DTB = (float*)(ws + WS_DT); float* const ACB = (float*)(ws + WS_AC); bf16* const XBC = (bf16*)(ws + WS_XBC); \
    bf16* const DC = (bf16*)(ws + WS_DC); bf16* const CS = (bf16*)(ws + WS_CS); bf16* const DH = (bf16*)(ws + WS_DH); bf16* const HS = (bf16*)(ws + WS_HS); \
    (void)WinT; (void)WliftT; (void)WoutT; (void)WupT; (void)WdownT; (void)W16B; (void)XN; (void)P; (void)U; (void)ACT; (void)YCAT; (void)XG; (void)MB; (void)SP; (void)GBc; (void)GGc; (void)GMT; \
    (void)MCAR; (void)MNEW; (void)MSC; (void)DTB; (void)ACB; (void)XBC; (void)DC; (void)CS; (void)DH; (void)HS

    for (int l = args.l_lo; l < args.l_hi; ++l)
    for (int grp = args.g_lo; grp < args.g_hi; ++grp) {

        REPS(PH_W) if (IN(PH_W) && grp == 0) {
            PHASE_BEGIN();
            LAS float* scr = (LAS float*)(lds + wave * 16384);
            constexpr int I_IN = 16 * 320, I_LF = 4 * 8 * 32, I_OUT = 16 * 32, I_UP = 16 * 176, I_DN = 44 * 32, NIT = I_IN + I_LF + I_OUT + I_UP + I_DN;
            for (int it = gw; it < NIT; it += NGW) {
                int r = it;
                if (r < I_IN) { const int kb = r / 320, nb = r % 320, n0 = 32 * nb, ns = n0 + (n0 >= P_SQ ? 16 : (n0 >= P_BB ? 8 : 0));
                    transpose_item(ka->in[I_WIN] + (size_t)l * DM * PIN, PIN, ns, 64 * kb, WinT, DM, n0, scr, lane, ka->in[I_MIXG] + (size_t)l * DM, n0 >= P_G ? (n0 - P_G) >> 8 : -1); continue; } r -= I_IN;
                if (r < I_LF) { const int br = r / 256, q = r % 256, kb = q / 32, nb = q % 32;
                    transpose_item(ka->in[I_WLIFT] + (size_t)(l * 4 + br) * 512 * DM, DM, 32 * nb, 64 * kb, WliftT + (size_t)br * DM * 512, 512, 32 * nb, scr, lane, br == 2 ? ka->in[I_CNG] + (size_t)l * 512 : nullptr); continue; } r -= I_LF;
                if (r < I_OUT) { const int kb = r / 32, nb = r % 32;
                    transpose_item(ka->in[I_WOUT] + (size_t)l * DM * DM, DM, 32 * nb, 64 * kb, WoutT, DM, 32 * nb, scr, lane); continue; } r -= I_OUT;
                if (r < I_UP) { const int kb = r / 176, nb = r % 176, n0 = 32 * nb, tp = n0 >> 8, j = n0 & 255, ns = (j < 128) ? 128 * tp + j : 2816 + 128 * tp + (j - 128);
                    transpose_item(ka->in[I_WUP] + (size_t)l * DM * DFF2, DFF2, ns, 64 * kb, WupT, DM, n0, scr, lane, ka->in[I_FFNG] + (size_t)l * DM); continue; } r -= I_UP;
                { const int kb = r / 32, nb = r % 32;
                    transpose_item(ka->in[I_WDOWN] + (size_t)l * DFF * DM, DM, 32 * nb, 64 * kb, WdownT, DFF, 32 * nb, scr, lane); }
            }
            for (int i = gt; i < 16 * DM; i += NGT) { const int c = i >> 10, k = i & 1023; const int oc = (c < 8) ? (1536 + c) : (4616 + (c - 8));
                const float w = ka->in[I_WIN][(size_t)l * DM * PIN + (size_t)k * PIN + oc] * ka->in[I_MIXG][(size_t)l * DM + k]; const unsigned hi = f2bf(w);
                W16B[i] = (bf16)hi; W16B[16 * DM + i] = (bf16)f2bf(w - bf2f(hi)); }
            if (l == 0) {
                for (int m = gw; m < BATCH * SEQ; m += NGW) {
                    const f32x4* xr = (const f32x4*)(ka->in[I_X] + (size_t)m * DM) + lane;
                    f32x4 v[4]; float sq = 0.f;
#pragma unroll
                    for (int j = 0; j < 4; ++j) { v[j] = xr[64 * j]; sq += (v[j].x * v[j].x + v[j].y * v[j].y) + (v[j].z * v[j].z + v[j].w * v[j].w); }
                    sq = wave_sum(sq); if (lane < 16) SSQ1[(size_t)m * 16 + lane] = (lane == 0) ? sq : 0.f;
                    u32x2* o8 = (u32x2*)(XG + (size_t)m * DM) + lane;
#pragma unroll
                    for (int j = 0; j < 4; ++j) o8[64 * j] = (u32x2){pk2(v[j].x, v[j].y), pk2(v[j].z, v[j].w)};
                }
            }
            GRID_BAR();
        }

        REPS(PH_INPROJ) if (IN(PH_INPROJ)) {
            PHASE_BEGIN();
            const bf16* XGg = XG + grow0 * DM; const float* ssq = SSQ1 + grow0 * 16;
            if (tid == 0) *(volatile LAS int*)(lds + 143360 + 1024) = -1;
            for (int rb = blk; rb < T / 64; rb += NBLK) {
                const int r0 = rb * 64 + 16 * (wave & 3), kh = (wave >> 2) * 512; f32x4 acc = zero4(), acc2 = zero4();
                float rsd[4];
#pragma unroll
                for (int i = 0; i < 4; ++i) rsd[i] = row_rstd(ssq + (size_t)(r0 + 4 * (lane >> 4) + i) * 16);
#pragma unroll 8
                for (int ks = 0; ks < 16; ++ks) { const bf16x8 a = gfrag_kc(XGg, DM, r0, kh + 32 * ks, lane);
                    acc = MFMA16(a, gfrag_kc(W16B, DM, 0, kh + 32 * ks, lane), acc); acc2 = MFMA16(a, gfrag_kc(W16B + 16 * DM, DM, 0, kh + 32 * ks, lane), acc2); }
                acc += acc2;
                LAS f32x4* xch = (LAS f32x4*)lds;
                if (wave >= 4) xch[(wave - 4) * 64 + lane] = acc;
                __syncthreads();
                if (wave < 4) { acc += xch[wave * 64 + lane];
#pragma unroll
                    for (int i = 0; i < 4; ++i) { const int row = r0 + 4 * (lane >> 4) + i; SP[(size_t)row * 16 + (lane & 15)] = acc[i] * rsd[i]; } }
                __syncthreads();
            }
            pg8::Gemm g{XGg, WinT, DM, DM, DM, 0, 0}; pg8::Order S; S.init(T, PW, NBLK, blk, 1);
            pg8::EpiBf16 E{(LAS float*)(lds + 143360), P, PWS, ssq, P_G / 256, FAC};
            pg8::gemm_phase<pg8::EpiBf16, GEMM_ALIGN>(lds, g, S, E);
            GRID_BAR();
        }

        REPS(PH_M0) if (IN(PH_M0)) {
            PHASE_BEGIN();
#pragma unroll 1
            for (int pass = 0; pass < 2; ++pass) {
            if ((pass ^ (blk & 1)) == 0) {
            for (int task = gw; task < GB * 4 * NCH; task += NGW) {
                const int bh = task >> 5, c = task & 31, bl = bh >> 2, h = bh & 3;
                const size_t m = (size_t)bl * SEQ + c * 64 + lane;
                const float ig = SP[m * 16 + h] + ka->in[I_AIB][l * 4 + h], fg = SP[m * 16 + 4 + h] + ka->in[I_AFB][l * 4 + h];
                const float b = wscan_add(logsigf_(fg), lane);
                const float gg = ig - b;
                const float pm = wscan_max(gg, lane);
                GBc[m * 4 + h] = b; GGc[m * 4 + h] = gg; GMT[m * 4 + h] = pm;
                if (lane == 63) { SUMB[task] = b; SUMG[task] = pm; }
            }
            for (int task = gw; task < GB * NCH * 8; task += NGW) {
                const int hd = task & 7; const size_t m = (size_t)(task >> 3) * 64 + lane;
                const float dt = softplusf_(SP[m * 16 + 8 + hd] + ka->in[I_CDTB][l * 8 + hd]);
                const float a = wscan_add(-dt * __expf(ka->in[I_CALOG][l * 8 + hd]), lane);
                DTB[m * 8 + hd] = dt; ACB[m * 8 + hd] = a;
            }
            {
                const float* cw = ka->in[I_CCW] + (size_t)l * 4 * 1024; const float* cb = ka->in[I_CCB] + (size_t)l * 1024;
                constexpr int RUN = 16;
                for (int i = gt; i < (T / RUN) * 128; i += NGT) {
                    const int rb = i >> 7, c8 = (i & 127) * 8, m0 = rb * RUN, t0 = m0 & (SEQ - 1);
                    float w[4][8], bb[8];
#pragma unroll
                    for (int e = 0; e < 8; ++e) { bb[e] = cb[c8 + e];
#pragma unroll
                        for (int j = 0; j < 4; ++j) w[j][e] = cw[j * 1024 + c8 + e]; }
                    const u32x4 zz = uzero4(); u32x4 rowv[RUN + 3];
                    { const bf16* pr = P + (size_t)(t0 >= 3 ? m0 - 3 : m0) * PWS + P_CX + c8;
#pragma unroll
                      for (int j = 0; j < 3; ++j) { const u32x4 ld = *(const u32x4*)(pr + (size_t)j * PWS); rowv[j] = (t0 >= 3) ? ld : zz; } }
#pragma unroll
                    for (int rr = 0; rr < RUN; ++rr) rowv[3 + rr] = *(const u32x4*)(P + (size_t)(m0 + rr) * PWS + P_CX + c8);
                    asm volatile("" ::: "memory");
#pragma unroll
                    for (int rr = 0; rr < RUN; ++rr) {
                        float acc[8];
#pragma unroll
                        for (int e = 0; e < 8; ++e) acc[e] = bb[e];
#pragma unroll
                        for (int j = 0; j < 4; ++j) { const u32x4 wv = rowv[rr + j];
                            acc[0] += w[j][0] * bf2f(wv.x & 0xffffu); acc[1] += w[j][1] * bf2f(wv.x >> 16); acc[2] += w[j][2] * bf2f(wv.y & 0xffffu); acc[3] += w[j][3] * bf2f(wv.y >> 16);
                            acc[4] += w[j][4] * bf2f(wv.z & 0xffffu); acc[5] += w[j][5] * bf2f(wv.z >> 16); acc[6] += w[j][6] * bf2f(wv.w & 0xffffu); acc[7] += w[j][7] * bf2f(wv.w >> 16); }
                        u32x4 o; o.x = pk2(siluf_(acc[0]), siluf_(acc[1])); o.y = pk2(siluf_(acc[2]), siluf_(acc[3])); o.z = pk2(siluf_(acc[4]), siluf_(acc[5])); o.w = pk2(siluf_(acc[6]), siluf_(acc[7]));
                        *(u32x4*)(XBC + (size_t)(m0 + rr) * 1024 + c8) = o;
                    }
                }
            }
            {
                const float* bw = ka->in[I_BCW] + (size_t)l * 3 * 512;
                constexpr int RUN = 8;
                for (int i = gt; i < (T / RUN) * 64; i += NGT) {
                    const int rb = i >> 6, c8 = (i & 63) * 8, m0 = rb * RUN, t0 = m0 & (SEQ - 1);
                    float w[3][8];
#pragma unroll
                    for (int e = 0; e < 8; ++e)
#pragma unroll
                        for (int j = 0; j < 3; ++j) w[j][e] = bw[j * 512 + c8 + e];
                    const u32x4 zz = uzero4(); u32x4 av[RUN + 2], bv[RUN + 2], gv[RUN];
                    { const bf16* pr = P + (size_t)(t0 >= 2 ? m0 - 2 : m0) * PWS;
#pragma unroll
                      for (int j = 0; j < 2; ++j) { const u32x4 la = *(const u32x4*)(pr + (size_t)j * PWS + P_BC + c8), lb = *(const u32x4*)(pr + (size_t)j * PWS + P_BX + c8); av[j] = (t0 >= 2) ? la : zz; bv[j] = (t0 >= 2) ? lb : zz; } }
#pragma unroll
                    for (int rr = 0; rr < RUN; ++rr) { const bf16* pr = P + (size_t)(m0 + rr) * PWS; av[2 + rr] = *(const u32x4*)(pr + P_BC + c8); bv[2 + rr] = *(const u32x4*)(pr + P_BX + c8); gv[rr] = *(const u32x4*)(pr + P_BB + c8); }
                    asm volatile("" ::: "memory");
                    float pw[3][8];
#pragma unroll
                    for (int j = 0; j < 2; ++j) { const u32x4 a = av[j], b = bv[j];
                        pw[j][0] = bf2f(a.x & 0xffffu) * bf2f(b.x & 0xffffu); pw[j][1] = bf2f(a.x >> 16) * bf2f(b.x >> 16); pw[j][2] = bf2f(a.y & 0xffffu) * bf2f(b.y & 0xffffu); pw[j][3] = bf2f(a.y >> 16) * bf2f(b.y >> 16);
                        pw[j][4] = bf2f(a.z & 0xffffu) * bf2f(b.z & 0xffffu); pw[j][5] = bf2f(a.z >> 16) * bf2f(b.z >> 16); pw[j][6] = bf2f(a.w & 0xffffu) * bf2f(b.w & 0xffffu); pw[j][7] = bf2f(a.w >> 16) * bf2f(b.w >> 16); }
#pragma unroll
                    for (int rr = 0; rr < RUN; ++rr) {
                        const u32x4 a = av[2 + rr], b = bv[2 + rr], g = gv[rr];
                        pw[2][0] = bf2f(a.x & 0xffffu) * bf2f(b.x & 0xffffu); pw[2][1] = bf2f(a.x >> 16) * bf2f(b.x >> 16); pw[2][2] = bf2f(a.y & 0xffffu) * bf2f(b.y & 0xffffu); pw[2][3] = bf2f(a.y >> 16) * bf2f(b.y >> 16);
                        pw[2][4] = bf2f(a.z & 0xffffu) * bf2f(b.z & 0xffffu); pw[2][5] = bf2f(a.z >> 16) * bf2f(b.z >> 16); pw[2][6] = bf2f(a.w & 0xffffu) * bf2f(b.w & 0xffffu); pw[2][7] = bf2f(a.w >> 16) * bf2f(b.w >> 16);
                        float acc[8];
#pragma unroll
                        for (int e = 0; e < 8; ++e) acc[e] = w[0][e] * pw[0][e] + w[1][e] * pw[1][e] + w[2][e] * pw[2][e];
                        u32x4 o; o.x = pk2(acc[0] * bf2f(g.x & 0xffffu), acc[1] * bf2f(g.x >> 16)); o.y = pk2(acc[2] * bf2f(g.y & 0xffffu), acc[3] * bf2f(g.y >> 16));
                        o.z = pk2(acc[4] * bf2f(g.z & 0xffffu), acc[5] * bf2f(g.z >> 16)); o.w = pk2(acc[6] * bf2f(g.w & 0xffffu), acc[7] * bf2f(g.w >> 16));
                        *(u32x4*)(YCAT + (size_t)(m0 + rr) * YW + 512 + c8) = o;
#pragma unroll
                        for (int e = 0; e < 8; ++e) { pw[0][e] = pw[1][e]; pw[1][e] = pw[2][e]; }
                    }
                }
            }
            } else {
            __syncthreads();
            {
            LAS bf16* Qs = (LAS bf16*)lds; LAS bf16* Ks = Qs + 128 * 136; LAS bf16* Vs = Ks + 64 * 136; LAS bf16* Aw = Vs + 64 * 136 + wave * (16 * 72);
            const int r = lane & 15, g4 = lane >> 4;
            for (int u = blk; u < GB * 4 * 16; u += NBLK) {
                const int bl = u >> 6, h = (u >> 4) & 3, qt = u & 15; const size_t mb = (size_t)bl * SEQ; const int q0 = qt * 128;
                volatile LAS unsigned* FLG = (volatile LAS unsigned*)(lds + MISC_OFF + 128);
                int par = 0;
                __syncthreads();
                if (lane == 0) { FLG[wave] = 0u; FLG[8 + wave] = 0u; }
                for (int i = tid; i < 2048; i += NTHR) { const int s = i >> 4, c8 = i & 15; *(LAS u32x4*)(Qs + s * 136 + c8 * 8) = *(const u32x4*)(P + (mb + q0 + s) * PWS + P_SQ + h * 128 + c8 * 8); }
                f32x4 O[8];
#pragma unroll
                for (int d = 0; d < 8; ++d) O[d] = zero4();
                float racc = 0.f; const int tq = q0 + 16 * wave + r;
                u32x4 kreg[2], vreg[2];
                { const int s0f = (2 * qt + 1) * 64;
#pragma unroll
                  for (int k2 = 0; k2 < 2; ++k2) { const int i = tid + 512 * k2, s = i >> 4, c8 = i & 15; const bf16* pr = P + (mb + s0f + s) * PWS + h * 128 + c8 * 8; kreg[k2] = *(const u32x4*)(pr + P_SK); vreg[k2] = *(const u32x4*)(pr + P_SV); } }
                for (int kt = 2 * qt + 1; kt >= 0; --kt) {
                    const int s0 = kt * 64;
                    __syncthreads();
                    { unsigned alldone = 1u;
#pragma unroll
                      for (int w8 = 0; w8 < 8; ++w8) alldone &= FLG[par * 8 + w8];
                      if (__builtin_amdgcn_readfirstlane((int)alldone)) break; }
#pragma unroll
                    for (int k2 = 0; k2 < 2; ++k2) { const int i = tid + 512 * k2, s = i >> 4, c8 = i & 15; *(LAS u32x4*)(Ks + s * 136 + c8 * 8) = kreg[k2]; *(LAS u32x4*)(Vs + s * 136 + c8 * 8) = vreg[k2]; }
                    if (kt > 0) {
#pragma unroll
                        for (int k2 = 0; k2 < 2; ++k2) { const int i = tid + 512 * k2, s = i >> 4, c8 = i & 15; const bf16* pr = P + (mb + s0 - 64 + s) * PWS + h * 128 + c8 * 8; kreg[k2] = *(const u32x4*)(pr + P_SK); vreg[k2] = *(const u32x4*)(pr + P_SV); } }
                    __syncthreads();
                    if (s0 < q0 + 16 * wave + 15) {
                        f32x4 z[4];
#pragma unroll
                        for (int j = 0; j < 4; ++j) z[j] = zero4();
#pragma unroll
                        for (int ks = 0; ks < 4; ++ks) { const bf16x8 fq = frag_kc(Qs, 136, 16 * wave, 32 * ks, lane);
#pragma unroll
                            for (int j = 0; j < 4; ++j) z[j] = MFMA16(frag_kc(Ks, 136, 16 * j, 32 * ks, lane), fq, z[j]); }
                        float ls[4][4], x[4][4], tsum[4];
#pragma unroll
                        for (int j = 0; j < 4; ++j) { float tj = 0.f;
#pragma unroll
                            for (int i = 0; i < 4; ++i) { const int s = s0 + 16 * j + 4 * g4 + i; const float zz = z[j][i] * 0.08838834764831845f;
                                const float l1 = fminf(zz, 0.f) - __logf(1.f + __expf(-fabsf(zz)));
                                ls[j][i] = l1; x[j][i] = (s < tq) ? (l1 - zz) : 0.f; tj += x[j][i]; }
                            tsum[j] = tj; }
                        float above[4], tot[4];
#pragma unroll
                        for (int j = 0; j < 4; ++j) { const float y1 = __shfl_xor(tsum[j], 16), y2 = __shfl_xor(tsum[j], 32), y3 = __shfl_xor(tsum[j], 48);
                            tot[j] = tsum[j] + y1 + y2 + y3;
                            above[j] = (g4 == 0) ? (y1 + y2 + y3) : (g4 == 1) ? (y2 + y3) : (g4 == 2) ? y1 : 0.f; }
                        float hi = racc;
#pragma unroll
                        for (int j = 3; j >= 0; --j) { float run = hi + above[j]; float av[4];
#pragma unroll
                            for (int i = 3; i >= 0; --i) { const int s = s0 + 16 * j + 4 * g4 + i; av[i] = (s < tq) ? __expf(ls[j][i] + run) : 0.f; run += x[j][i]; }
                            *(LAS u32x2*)(Aw + r * 72 + 16 * j + 4 * g4) = (u32x2){pk2(av[0], av[1]), pk2(av[2], av[3])};
                            hi += tot[j]; }
                        racc = hi;
                        LDS_WAIT(); asm volatile("" ::: "memory");
#pragma unroll
                        for (int ks = 0; ks < 2; ++ks) { const bf16x8 fa = frag_kc(Aw, 72, 0, 32 * ks, lane);
#pragma unroll
                            for (int d = 0; d < 8; ++d) O[d] = MFMA16(fa, frag_ks(Vs, 136, 16 * d, 32 * ks, lane), O[d]); }
                    }
                    par ^= 1;
                    { const bool wd = __all(racc < -104.f); if (lane == 0) FLG[par * 8 + wave] = wd ? 1u : 0u; }
                }
#pragma unroll
                for (int d = 0; d < 8; ++d)
#pragma unroll
                    for (int i = 0; i < 4; ++i) YCAT[(mb + q0 + 16 * wave + 4 * g4 + i) * YW + 1536 + h * 128 + 16 * d + r] = (bf16)f2bf(O[d][i]);
            }
            }
            }
            }
            GRID_BAR();
        }

        REPS(PH_M1) if (IN(PH_M1)) {
            PHASE_BEGIN();
            constexpr int NUA = GB * 4 * NCH, NUC = GB * NCH;
            LAS unsigned char* RAW = lds + 32768;
#define M1_DMA(uu) do { const int bh_ = (uu) >> 5, c_ = (uu) & 31, bl_ = bh_ >> 2, h_ = bh_ & 3; const size_t m0_ = (size_t)bl_ * SEQ + c_ * 64; \
                _Pragma("unroll") for (int t_ = 0; t_ < 3; ++t_) { const int j_ = wave * 3 + t_; \
                    const bf16* src_ = (j_ < 16) ? P + (m0_ + ((j_ * 64 + lane) >> 4)) * PWS + P_AV + h_ * 128 + ((j_ * 64 + lane) & 15) * 8 \
                                                 : P + (m0_ + (((j_ - 16) * 64 + lane) >> 3)) * PWS + P_AK + h_ * 64 + (((j_ - 16) * 64 + lane) & 7) * 8; \
                    __builtin_amdgcn_global_load_lds((const unsigned*)src_, (LAS unsigned*)(RAW + j_ * 1024), 16, 0, 0); } \
                if (wave < 4) { const float* s4_ = (wave == 0) ? SUMB + bh_ * 32 + (lane & 31) : (wave == 1) ? SUMG + bh_ * 32 + (lane & 31) : (wave == 2) ? GGc + (m0_ + lane) * 4 + h_ : GBc + (m0_ + 63) * 4 + h_; \
                    __builtin_amdgcn_global_load_lds((const unsigned*)s4_, (LAS unsigned*)(RAW + 24576 + wave * 256), 4, 0, 0); } } while (0)
            if (blk < NUA) M1_DMA(blk);
            for (int u = blk; u < NUA + NUC; u += NBLK) {
                if (u < NUA) {
                    const int ua = u, bh = ua >> 5, c = ua & 31;
                    LAS bf16* VP = (LAS bf16*)lds; LAS bf16* WK = (LAS bf16*)(lds + 64 * 152 * 2); const LAS float* SC = (const LAS float*)(RAW + 24576);
                    asm volatile("s_waitcnt vmcnt(0)" ::: "memory"); __syncthreads();
                    float bLj = 0.f, gmj = -1e30f;
                    if (lane < 32) { bLj = SC[lane]; gmj = SC[64 + lane]; }
                    float pa = bLj, pq = gmj + bLj;
#pragma unroll
                    for (int o = 1; o < 32; o <<= 1) { const float ta = __shfl_up(pa, o), tq = __shfl_up(pq, o); if (lane >= o) { pq = fmaxf(tq + pa, pq); pa = ta + pa; } }
                    const float mall = fmaxf(pa, pq);
                    const float mnew = __shfl(mall, c), mprev = (c == 0) ? 0.f : __shfl(mall, (c + 63) & 63);
                    const float bL = SC[192];
                    if (tid == 0) { MCAR[ua] = mprev; MNEW[ua] = mnew; MSC[ua] = __expf(bL + mprev - mnew); }
#pragma unroll
                    for (int k = 0; k < 2; ++k) { const int i = tid + k * NTHR, s = i >> 4, c8 = i & 15; *(LAS u32x4*)(VP + s * 152 + c8 * 8) = *(const LAS u32x4*)(RAW + i * 16); }
                    if (tid < 64) { *(LAS u32x4*)(VP + tid * 152 + 128) = uone4(); *(LAS u32x4*)(VP + tid * 152 + 136) = uzero4(); }
                    { const int s = tid >> 3, c8 = tid & 7; const float w = __expf(bL + SC[128 + s] - mnew);
                      *(LAS u32x4*)(WK + s * 72 + c8 * 8) = scale8(*(const LAS u32x4*)(RAW + 16384 + tid * 16), w); }
                    __syncthreads();
                    if (u + NBLK < NUA) M1_DMA(u + NBLK);
                    for (int ti = wave; ti < 36; ti += NWAVES) { const int mt = ti >> 2, nt = ti & 3; f32x4 acc = zero4();
#pragma unroll
                        for (int ks = 0; ks < 2; ++ks) acc = MFMA16(frag_ks(VP, 152, 16 * mt, 32 * ks, lane), frag_ks(WK, 72, 16 * nt, 32 * ks, lane), acc);
                        bf16* d = DC + (size_t)ua * 9216 + (16 * mt + 4 * (lane >> 4)) * 64 + 16 * nt + (lane & 15);
#pragma unroll
                        for (int i = 0; i < 4; ++i) d[i * 64] = (bf16)f2bf(acc[i]); }
                } else {
                    __syncthreads();
                    const int uc = u - NUA, bl = uc >> 5, c = uc & 31, hd = wave, gi = hd >> 2; const size_t m0 = (size_t)bl * SEQ + c * 64;
                    LAS bf16* XW = (LAS bf16*)(lds + hd * (64 * 72 * 2)); LAS bf16* BMs = (LAS bf16*)(lds + 8 * 64 * 72 * 2);
                    const float alast = ACB[(m0 + 63) * 8 + hd];
#pragma unroll
                    for (int k = 0; k < 8; ++k) { const int i = lane + 64 * k, s = i >> 3, c8 = i & 7; const float wd = __expf(alast - ACB[(m0 + s) * 8 + hd]) * DTB[(m0 + s) * 8 + hd];
                        *(LAS u32x4*)(XW + s * 72 + c8 * 8) = scale8(*(const u32x4*)(XBC + (m0 + s) * 1024 + hd * 64 + c8 * 8), wd); }
                    for (int i = tid; i < 2048; i += NTHR) { const int g2 = i >> 10, rem = i & 1023, s = rem >> 4, c8 = rem & 15;
                        *(LAS u32x4*)(BMs + g2 * (64 * 136) + s * 136 + c8 * 8) = *(const u32x4*)(XBC + (m0 + s) * 1024 + 512 + g2 * 128 + c8 * 8); }
                    __syncthreads();
                    const LAS bf16* BMg = BMs + gi * (64 * 136);
                    for (int pt = 0; pt < 4; ++pt) { f32x4 acc[8];
#pragma unroll
                        for (int n = 0; n < 8; ++n) acc[n] = zero4();
#pragma unroll
                        for (int ks = 0; ks < 2; ++ks) { const bf16x8 a = frag_ks(XW, 72, 16 * pt, 32 * ks, lane);
#pragma unroll
                            for (int n = 0; n < 8; ++n) acc[n] = MFMA16(a, frag_ks(BMg, 136, 16 * n, 32 * ks, lane), acc[n]); }
                        bf16* d = DH + ((size_t)(uc * 8 + hd) * 64 + 16 * pt + 4 * (lane >> 4)) * 128 + (lane & 15);
#pragma unroll
                        for (int n = 0; n < 8; ++n)
#pragma unroll
                            for (int i = 0; i < 4; ++i) d[i * 128 + 16 * n] = (bf16)f2bf(acc[n][i]); }
                    __syncthreads();
                }
            }
            GRID_BAR();
        }

#undef M1_DMA
        REPS(PH_M2) if (IN(PH_M2)) {
            PHASE_BEGIN();
            constexpr int NA = GB * 4 * 2304, NC = GB * 8 * 2048;
            for (int i = gt; i < NA + NC; i += NGT) {
                f32x4 st = zero4();
                if (i < NA) { const int bh = i / 2304, e = (i - bh * 2304) * 4; const bf16* dp = DC + (size_t)bh * NCH * 9216 + e; bf16* cp = CS + (size_t)bh * NCH * 9216 + e; const float* sp = MSC + (size_t)bh * NCH;
#pragma unroll 1
                    for (int c0 = 0; c0 < NCH; c0 += 4) { u32x2 dw[4]; float sc[4];
#pragma unroll
                        for (int k = 0; k < 4; ++k) { dw[k] = *(const u32x2*)(dp + (size_t)(c0 + k) * 9216); sc[k] = sp[c0 + k]; }
#pragma unroll
                        for (int k = 0; k < 4; ++k) { *(u32x2*)(cp + (size_t)(c0 + k) * 9216) = (u32x2){pk2(st.x, st.y), pk2(st.z, st.w)};
                            st = st * sc[k] + (f32x4){bf2f(dw[k].x & 0xffffu), bf2f(dw[k].x >> 16), bf2f(dw[k].y & 0xffffu), bf2f(dw[k].y >> 16)}; } }
                } else { const int j = i - NA, bhd = j >> 11, e = (j & 2047) * 4, bl = bhd >> 3, hd = bhd & 7;
                    const bf16* dp = DH + ((size_t)(bl * NCH) * 8 + hd) * 8192 + e; bf16* cp = HS + ((size_t)(bl * NCH) * 8 + hd) * 8192 + e; const float* ap = ACB + ((size_t)bl * SEQ + 63) * 8 + hd;
#pragma unroll 1
                    for (int c0 = 0; c0 < NCH; c0 += 4) { u32x2 dw[4]; float sc[4];
#pragma unroll
                        for (int k = 0; k < 4; ++k) { dw[k] = *(const u32x2*)(dp + (size_t)(c0 + k) * 8 * 8192); sc[k] = __expf(ap[(size_t)(c0 + k) * 64 * 8]); }
#pragma unroll
                        for (int k = 0; k < 4; ++k) { *(u32x2*)(cp + (size_t)(c0 + k) * 8 * 8192) = (u32x2){pk2(st.x, st.y), pk2(st.z, st.w)};
                            st = st * sc[k] + (f32x4){bf2f(dw[k].x & 0xffffu), bf2f(dw[k].x >> 16), bf2f(dw[k].y & 0xffffu), bf2f(dw[k].y >> 16)}; } }
                }
            }
            GRID_BAR();
        }

        REPS(PH_M3) if (IN(PH_M3)) {
            PHASE_BEGIN();
            constexpr int NUA = GB * 4 * NCH, NUC = 2 * GB * NCH;
            for (int u = blk; u < NUA + NUC; u += NBLK) {
                const int r = lane & 15, g4 = lane >> 4;
                if (u < NUA) {
                    const int ua = u, bh = ua >> 5, c = ua & 31, bl = bh >> 2, h = bh & 3; const size_t m0 = (size_t)bl * SEQ + c * 64;
                    LAS bf16* Qs = (LAS bf16*)lds; LAS bf16* Ks = Qs + 64 * 72; LAS bf16* VP = Ks + 64 * 72; LAS bf16* CST = VP + 64 * 152; LAS bf16* SMT = CST + 144 * 72; LAS bf16* AOT = SMT + 64 * 72;
                    LAS float* GS = (LAS float*)(AOT + 64 * 136);
                    LAS float* SSQ = GS + 256;
                    const float mcar = MCAR[ua];
                    { const int s = tid >> 3, c8 = tid & 7; const bf16* pr = P + (m0 + s) * PWS + h * 64 + c8 * 8;
                      *(LAS u32x4*)(Qs + s * 72 + c8 * 8) = *(const u32x4*)(pr + P_AQ); *(LAS u32x4*)(Ks + s * 72 + c8 * 8) = *(const u32x4*)(pr + P_AK); }
                    for (int i = tid; i < 1024; i += NTHR) { const int s = i >> 4, c8 = i & 15; const bf16* pr = P + (m0 + s) * PWS + h * 128 + c8 * 8;
                        *(LAS u32x4*)(VP + s * 152 + c8 * 8) = *(const u32x4*)(pr + P_AV); *(LAS u32x4*)(AOT + s * 136 + c8 * 8) = *(const u32x4*)(pr + P_AO); }
                    if (tid < 64) { *(LAS u32x4*)(VP + tid * 152 + 128) = uone4(); *(LAS u32x4*)(VP + tid * 152 + 136) = uzero4(); }
                    for (int i = tid; i < 1152; i += NTHR) { const int dv = i >> 3, c8 = i & 7; *(LAS u32x4*)(CST + dv * 72 + c8 * 8) = *(const u32x4*)(CS + (size_t)ua * 9216 + dv * 64 + c8 * 8); }
                    if (tid < 192) { const int arr = tid >> 6, s = tid & 63; const float* src = (arr == 0) ? GBc : (arr == 1) ? GGc : GMT; float v = src[(m0 + s) * 4 + h];
                        if (arr == 2) v = GBc[(m0 + s) * 4 + h] + fmaxf(mcar, v);
                        GS[arr * 64 + s] = v; }
                    __syncthreads();
#pragma unroll
                    for (int q2 = 0; q2 < 2; ++q2) { const int ti = 2 * wave + q2, tt = ti >> 2, st = ti & 3;
                        f32x4 acc = zero4();
                        if (st <= tt) {
#pragma unroll
                            for (int ks = 0; ks < 2; ++ks) acc = MFMA16(frag_kc(Qs, 72, 16 * tt, 32 * ks, lane), frag_kc(Ks, 72, 16 * st, 32 * ks, lane), acc);
                            const int s = 16 * st + r; const float gs = GS[64 + s];
#pragma unroll
                            for (int i = 0; i < 4; ++i) { const int t = 16 * tt + 4 * g4 + i; const float e = GS[t] - GS[128 + t] + gs;
                                acc[i] = (s <= t) ? acc[i] * 0.125f * __expf(e) : 0.f; }
                        }
                        *(LAS u32x2*)(SMT + (16 * st + r) * 72 + 16 * tt + 4 * g4) = (u32x2){pk2(acc[0], acc[1]), pk2(acc[2], acc[3])}; }
                    __syncthreads();
                    const int tt = wave & 3, half = wave >> 2;
                    f32x4 a1[5], a2[5];
#pragma unroll
                    for (int j = 0; j < 5; ++j) { a1[j] = zero4(); a2[j] = zero4(); }
#pragma unroll
                    for (int ks = 0; ks < 2; ++ks) { const bf16x8 fa1 = frag_ks(SMT, 72, 16 * tt, 32 * ks, lane), fa2 = frag_kc(Qs, 72, 16 * tt, 32 * ks, lane);
#pragma unroll
                        for (int j = 0; j < 5; ++j) { const int dvt = (j < 4) ? half * 4 + j : 8;
                            a1[j] = MFMA16(fa1, frag_ks(VP, 152, 16 * dvt, 32 * ks, lane), a1[j]);
                            a2[j] = MFMA16(fa2, frag_kc(CST, 72, 16 * dvt, 32 * ks, lane), a2[j]); } }
                    float hv[4][4], ssq[4];
#pragma unroll
                    for (int i = 0; i < 4; ++i) { const int t = 16 * tt + 4 * g4 + i; const float b = GS[t], mt = GS[128 + t];
                        const float is = 0.125f * __expf(b + mcar - mt);
                        float den = a1[4][i] + is * a2[4][i]; den = __shfl(den, lane & 48);
                        const float dn = __builtin_amdgcn_rcpf(fmaxf(fabsf(den), __expf(-mt))); float q = 0.f;
#pragma unroll
                        for (int j = 0; j < 4; ++j) { const float v = (a1[j][i] + is * a2[j][i]) * dn; hv[j][i] = v; q += v * v; }
                        q += __shfl_xor(q, 1); q += __shfl_xor(q, 2); q += __shfl_xor(q, 4); q += __shfl_xor(q, 8); ssq[i] = q; }
                    if (r == 0) {
#pragma unroll
                        for (int i = 0; i < 4; ++i) SSQ[half * 64 + 16 * tt + 4 * g4 + i] = ssq[i]; }
                    __syncthreads();
                    const float* ng = ka->in[I_ANG] + (size_t)l * 512 + h * 128;
#pragma unroll
                    for (int i = 0; i < 4; ++i) { const int t = 16 * tt + 4 * g4 + i; const float rstd = rsqrtf((SSQ[t] + SSQ[64 + t]) * (1.f / 128.f) + EPS);
#pragma unroll
                        for (int j = 0; j < 4; ++j) { const int dv = 16 * (half * 4 + j) + r; LAS bf16* op = AOT + t * 136 + dv;
                            *op = (bf16)f2bf(sigmoidf_(bf2f(*op)) * hv[j][i] * rstd * ng[dv]); } }
                    __syncthreads();
                    for (int i = tid; i < 1024; i += NTHR) { const int s = i >> 4, c8 = i & 15; *(u32x4*)(YCAT + (m0 + s) * YW + h * 128 + c8 * 8) = *(const LAS u32x4*)(AOT + s * 136 + c8 * 8); }
                    __syncthreads();
                } else {
                    const int uc2 = u - NUA, bl = uc2 >> 6, c = (uc2 >> 1) & 31, gi = uc2 & 1, hl = wave & 3, th = wave >> 2, hd = gi * 4 + hl; const size_t m0 = (size_t)bl * SEQ + c * 64;
                    LAS bf16* XHs = (LAS bf16*)lds;
                    LAS bf16* HTs = (LAS bf16*)(lds + 36864);
                    LAS bf16* BMg = (LAS bf16*)(lds + 36864 + 69632);
                    LAS bf16* MTt = (LAS bf16*)(lds + 36864 + 69632 + 17408 + wave * 3072);
                    LAS float* ADs = (LAS float*)(lds + 36864 + 69632 + 17408 + 24576);
                    const bf16* Xb = XBC + m0 * 1024;
                    for (int i = tid; i < 2048; i += NTHR) { const int h4 = i >> 9, rem = i & 511, s = rem >> 3, c8 = rem & 7;
                        *(LAS u32x4*)(XHs + h4 * (64 * 72) + s * 72 + c8 * 8) = *(const u32x4*)((Xb + gi * 256) + (unsigned)(s * 1024 + h4 * 64 + c8 * 8)); }
                    { const bf16* Hb = HS + (size_t)((bl * NCH + c) * 8 + gi * 4) * 8192;
                      for (int i = tid; i < 4096; i += NTHR) { const int h4 = i >> 10, rem = i & 1023, p = rem >> 4, c8 = rem & 15;
                        *(LAS u32x4*)(HTs + h4 * (64 * 136) + p * 136 + c8 * 8) = *(const u32x4*)(Hb + (unsigned)(h4 * 8192 + p * 128 + c8 * 8)); } }
                    for (int i = tid; i < 1024; i += NTHR) { const int s = i >> 4, c8 = i & 15; *(LAS u32x4*)(BMg + s * 136 + c8 * 8) = *(const u32x4*)((Xb + 512 + gi * 128) + (unsigned)(s * 1024 + c8 * 8)); }
                    { const int h4 = tid >> 7, arr = (tid >> 6) & 1, s = tid & 63; const float* src = arr ? DTB : ACB; ADs[tid] = (src + m0 * 8 + gi * 4)[(unsigned)(s * 8 + h4)]; }
                    const LAS bf16* XH = XHs + hl * (64 * 72); const LAS bf16* HT = HTs + hl * (64 * 136); const LAS float* AD = ADs + hl * 128;
                    const bf16* Cm = Xb + 768 + gi * 128; const bf16* Zp = P + m0 * PWS + P_CZ + hd * 64; const unsigned zlane = (unsigned)(4 * g4 * PWS + r), ylane = (unsigned)(4 * g4 * YW + r);
                    bf16* Yp = YCAT + m0 * YW + 1024 + hd * 64; float* Sp = SSQC + m0 * 8 + hd;
                    bf16x8 fcn[4];
#pragma unroll
                    for (int ks = 0; ks < 4; ++ks) fcn[ks] = gfrag_kc(Cm, 1024, 16 * th, 32 * ks, lane);
                    const float dsk = ka->in[I_CDSKIP][l * 8 + hd];
                    __syncthreads();
#pragma unroll 1
                    for (int k2 = 0; k2 < 2; ++k2) { const int tt = k2 ? 3 - th : th;
                        bf16x8 fcm[4]; unsigned short zc[4][4];
#pragma unroll
                        for (int ks = 0; ks < 4; ++ks) fcm[ks] = fcn[ks];
#pragma unroll
                        for (int p = 0; p < 4; ++p)
#pragma unroll
                            for (int i = 0; i < 4; ++i) zc[p][i] = (Zp + (size_t)(16 * tt + i) * PWS + 16 * p)[zlane];
#pragma unroll
                        for (int ks = 0; ks < 4; ++ks) fcn[ks] = gfrag_kc(Cm, 1024, 16 * (3 - th), 32 * ks, lane);
                        float at[4];
#pragma unroll
                        for (int i = 0; i < 4; ++i) at[i] = AD[16 * tt + 4 * g4 + i];
#pragma unroll 1
                        for (int st = 0; st <= tt; ++st) { f32x4 acc = zero4();
#pragma unroll
                            for (int ks = 0; ks < 4; ++ks) acc = MFMA16(fcm[ks], frag_kc(BMg, 136, 16 * st, 32 * ks, lane), acc);
                            const int s = 16 * st + r; const float as = AD[s], dts = AD[64 + s];
#pragma unroll
                            for (int i = 0; i < 4; ++i) { const int t = 16 * tt + 4 * g4 + i; acc[i] = (s <= t) ? acc[i] * __expf(at[i] - as) * dts : 0.f; if (s == t) acc[i] += dsk; }
                            *(LAS u32x2*)(MTt + (16 * st + r) * 24 + 4 * g4) = (u32x2){pk2(acc[0], acc[1]), pk2(acc[2], acc[3])}; }
                        if ((tt & 1) == 0) *(LAS u32x2*)(MTt + (16 * (tt + 1) + r) * 24 + 4 * g4) = (u32x2){uzero4().x, uzero4().y};
                        LDS_WAIT(); asm volatile("" ::: "memory");
                        f32x4 ad[4], ao[4];
#pragma unroll
                        for (int p = 0; p < 4; ++p) { ad[p] = zero4(); ao[p] = zero4(); }
#pragma unroll 1
                        for (int ks = 0; ks <= (tt >> 1); ++ks) { const bf16x8 fa = frag_ks(MTt, 24, 0, 32 * ks, lane);
#pragma unroll
                            for (int p = 0; p < 4; ++p) ad[p] = MFMA16(fa, frag_ks(XH, 72, 16 * p, 32 * ks, lane), ad[p]); }
#pragma unroll
                        for (int ks = 0; ks < 4; ++ks)
#pragma unroll
                            for (int p = 0; p < 4; ++p) ao[p] = MFMA16(fcm[ks], frag_kc(HT, 136, 16 * p, 32 * ks, lane), ao[p]);
#pragma unroll
                        for (int i = 0; i < 4; ++i) { const float ea = __expf(at[i]); float q = 0.f;
#pragma unroll
                            for (int p = 0; p < 4; ++p) { const float y = (ad[p][i] + ea * ao[p][i]) * siluf_(bf2f(zc[p][i])); q += y * y;
                                (Yp + (size_t)(16 * tt + i) * YW + 16 * p)[ylane] = (bf16)f2bf(y); }
                            q += __shfl_xor(q, 1); q += __shfl_xor(q, 2); q += __shfl_xor(q, 4); q += __shfl_xor(q, 8);
                            if (r == 0) (Sp + (16 * tt + i) * 8)[(unsigned)(32 * g4)] = q; }
                        LDS_WAIT(); asm volatile("" ::: "memory");
                    }
                    __syncthreads();
                }
            }
            GRID_BAR();
        }

        REPS(PH_LIFT) if (IN(PH_LIFT)) {
            PHASE_BEGIN();
            pg8::Gemm g{YCAT, WliftT, 512, YW, 512, (size_t)512 * 2, (size_t)DM * 512 * 2}; pg8::Order S; S.init(T, DM, NBLK, blk, 4);
            pg8::EpiLift E{FAC, MB + (size_t)(grp % FG) * T * DM, DM, SSQC};
            pg8::gemm_phase<pg8::EpiLift, GEMM_ALIGN>(lds, g, S, E);
            GRID_BAR();
        }
        REPS(PH_OUT) if (IN(PH_OUT) && (grp % FG) == FG - 1) {
            PHASE_BEGIN();
            const size_t prow0 = grow0 - (size_t)(FG - 1) * T;
            pg8::Gemm g{MB, WoutT, DM, DM, DM, 0, 0}; pg8::Order S; S.init(FG * T, DM, NBLK, blk, 1);
            pg8::EpiResid E{XG + prow0 * DM, DM, SSQ2};
            pg8::gemm_phase<pg8::EpiResid, GEMM_ALIGN>(lds, g, S, E);
            GRID_BAR();
        }
        REPS(PH_UP) if (IN(PH_UP) && (grp % FG) == FG - 1) {
            PHASE_BEGIN();
            const size_t prow0 = grow0 - (size_t)(FG - 1) * T;
            pg8::Gemm g{XG + prow0 * DM, WupT, DM, DM, DM, 0, 0}; pg8::Order S; S.init(FG * T, DFF2, NBLK, blk, 1);
            if (tid == 0) *(volatile LAS int*)(lds + 131072 + 12288 + 1024) = -1;
            pg8::EpiConvAct E{ACT, SSQ2, ka->in[I_FCW] + (size_t)l * 3 * DFF2, ka->in[I_FCB] + (size_t)l * DFF2, RAWH, lds + 131072, DFF2 / 256};
            pg8::gemm_phase<pg8::EpiConvAct, GEMM_ALIGN>(lds, g, S, E);
            GRID_BAR();
        }
        REPS(PH_DOWN) if (IN(PH_DOWN) && (grp % FG) == FG - 1) {
            PHASE_BEGIN();
            const size_t prow0 = grow0 - (size_t)(FG - 1) * T;
            pg8::Gemm g{ACT, WdownT, DFF, 128, DFF, 0, 0, 65536, (size_t)22 * 65536}; pg8::Order S; S.init(FG * T, DM, NBLK, blk, 1);
            {
                const float* fw = ka->in[I_FCW] + (size_t)l * 3 * DFF2; const float* fb = ka->in[I_FCB] + (size_t)l * DFF2;
                pg8::Unit uu;
                for (int i = 0; S.next(i, uu); ++i) { const int pm = uu.pm; if ((pm & 7) == 0) continue;
                    for (int ch = tid; ch < DFF; ch += NTHR) { const int tp = ch >> 7, j = ch & 127;
                        const float* own = RAWH + (size_t)(pm * 22 + tp) * 1024; const float* prv = RAWH + (size_t)((pm - 1) * 22 + tp) * 1024;
                        const float g254 = prv[2 * 256 + j], g255 = prv[3 * 256 + j], g0 = own[j], g1 = own[256 + j];
                        const float u254 = prv[2 * 256 + 128 + j], u255 = prv[3 * 256 + 128 + j], u0 = own[128 + j], u1 = own[256 + 128 + j];
                        const float wg0 = fw[ch], wg1 = fw[DFF2 + ch], wg2 = fw[2 * DFF2 + ch], wu0 = fw[DFF + ch], wu1 = fw[DFF2 + DFF + ch], wu2 = fw[2 * DFF2 + DFF + ch], bg = fb[ch], bu = fb[DFF + ch];
                        ACT[((size_t)(pm * 22 + tp) * 256) * 128 + j] = (bf16)f2bf(siluf_(bg + wg0 * g254 + wg1 * g255 + wg2 * g0) * (bu + wu0 * u254 + wu1 * u255 + wu2 * u0));
                        ACT[((size_t)(pm * 22 + tp) * 256 + 1) * 128 + j] = (bf16)f2bf(siluf_(bg + wg0 * g255 + wg1 * g0 + wg2 * g1) * (bu + wu0 * u255 + wu1 * u0 + wu2 * u1)); } }
                asm volatile("s_waitcnt vmcnt(0)" ::: "memory"); __syncthreads();
            }
            pg8::EpiResid E{XG + prow0 * DM, DM, SSQ1 + prow0 * 16};
            pg8::gemm_phase<pg8::EpiResid, GEMM_ALIGN>(lds, g, S, E);
            GRID_BAR();
        }
        REPS(PH_FINAL) if (IN(PH_FINAL) && l == DEPTH - 1 && (grp % FG) == FG - 1) {
            PHASE_BEGIN();
            const size_t prow0 = grow0 - (size_t)(FG - 1) * T;
            const float* gain = ka->in[I_FING];
            f32x4 gv[4];
#pragma unroll
            for (int j = 0; j < 4; ++j) gv[j] = ((const f32x4*)gain)[lane + 64 * j];
            for (int m = gw; m < FG * T; m += NGW) {
                const u32x2* xr = (const u32x2*)(XG + (prow0 + m) * DM) + lane;
                f32x4 v[4]; float sq = 0.f;
#pragma unroll
                for (int j = 0; j < 4; ++j) { const u32x2 w = xr[64 * j]; v[j] = (f32x4){bf2f(w.x & 0xffffu), bf2f(w.x >> 16), bf2f(w.y & 0xffffu), bf2f(w.y >> 16)};
                    sq += (v[j].x * v[j].x + v[j].y * v[j].y) + (v[j].z * v[j].z + v[j].w * v[j].w); }
                const float rstd = rsqrtf(wave_sum(sq) * (1.f / DM) + EPS);
                f32x4* orow = (f32x4*)(ka->out + (prow0 + m) * DM) + lane;
#pragma unroll
                for (int j = 0; j < 4; ++j) orow[64 * j] = v[j] * rstd * gv[j];
            }
            GRID_BAR();
        }
    }
#undef IN
#undef GRID_BAR
#undef PHASE_BEGIN
}

#ifndef ONE_LAUNCH
#define ONE_LAUNCH 1
#endif
extern "C" void kernel_launch(void* const* d_in, const int* in_sizes, int n_in, void* d_out, int out_size, void* d_ws, size_t ws_size, hipStream_t stream) {
    static int grid = 0;
    if (grid == 0) {
        if (n_in != N_IN || in_sizes[0] != BATCH * SEQ * DM || out_size != BATCH * SEQ * DM || ws_size < WS_END) {
            fprintf(stderr, "kernel_launch: unexpected shapes / workspace (n_in %d, ws %zu, need %zu); nothing launched\n", n_in, ws_size, (size_t)WS_END); grid = -1; return; }
        int dev = 0, cus = 0, per_cu = 0;
        if (hipGetDevice(&dev) != hipSuccess || hipDeviceGetAttribute(&cus, hipDeviceAttributeMultiprocessorCount, dev) != hipSuccess) { grid = -1; return; }
        if (hipFuncSetAttribute((const void*)fwd, hipFuncAttributeMaxDynamicSharedMemorySize, LDS_BYTES) != hipSuccess) { fprintf(stderr, "kernel_launch: hipFuncSetAttribute failed\n"); grid = -1; return; }
        if (hipOccupancyMaxActiveBlocksPerMultiprocessor(&per_cu, (const void*)fwd, NTHR, LDS_BYTES) != hipSuccess || per_cu < 1) { fprintf(stderr, "kernel_launch: occupancy query says %d\n", per_cu); (void)hipGetLastError(); }
        grid = cus;
    }
    if (grid < 0) return;
    (void)hipMemsetAsync((char*)d_ws + WS_CTL, 0, (size_t)(4096 + XCD_BAR_WORDS) * 4, stream);
    Args a{};
    for (int i = 0; i < N_IN; ++i) a.in[i] = (const float*)d_in[i];
    a.out = (float*)d_out; a.ws = (unsigned char*)d_ws; a.pad = 0;
#if ONE_LAUNCH
    a.l_lo = 0; a.l_hi = DEPTH; a.g_lo = 0; a.g_hi = NG; a.ph_lo = 0; a.ph_hi = PH_COUNT; a.use_bar = 1;
    hipLaunchKernelGGL(fwd, dim3(grid), dim3(NTHR), LDS_BYTES, stream, a);
#else
    a.use_bar = 0;
    for (int l = 0; l < DEPTH; ++l)
        for (int g = 0; g < NG; ++g)
            for (int ph = 0; ph < PH_COUNT; ++ph) {
                if (ph == PH_W && g != 0) continue;
                if (ph == PH_FINAL && l != DEPTH - 1) continue;
                if ((ph == PH_OUT || ph == PH_UP || ph == PH_DOWN || ph == PH_FINAL) && (g % FG) != FG - 1) continue;
                a.l_lo = l; a.l_hi = l + 1; a.g_lo = g; a.g_hi = g + 1; a.ph_lo = ph; a.ph_hi = ph + 1;
                hipLaunchKernelGGL(fwd, dim3(grid), dim3(NTHR), LDS_BYTES, stream, a);
            }
#endif
}
```

```cpp
#include <hip/hip_runtime.h>
#include <cstdio>
#include <cstdint>

#define LAS __attribute__((address_space(3)))
#define GAS __attribute__((address_space(1)))
typedef unsigned short bf16;
typedef short bf16x8 __attribute__((ext_vector_type(8)));
typedef short s16x4 __attribute__((ext_vector_type(4)));
typedef float f32x4 __attribute__((ext_vector_type(4)));
typedef float f32x2 __attribute__((ext_vector_type(2)));
typedef unsigned u32x4 __attribute__((ext_vector_type(4)));
typedef unsigned u32x2 __attribute__((ext_vector_type(2)));

constexpr int DM = 1024, BATCH = 32, SEQ = 2048, DEPTH = 4;
constexpr int PIN = 10256, PW = 10240, PWS = 6144, DFF = 2816, DFF2 = 5632;
constexpr int GB = 8;
constexpr int NG = BATCH / GB;
constexpr int FG = 4;
constexpr int T = GB * SEQ;
constexpr int NCH = SEQ / 64;
constexpr float EPS = 1e-6f;
constexpr int P_AQ = 0, P_AK = 256, P_AV = 512, P_AO = 1024, P_BB = 1536, P_BC = 2048, P_BX = 2560, P_CZ = 3072, P_CX = 3584, P_SQ = 4608, P_SK = 5120, P_SV = 5632, P_G = 6144;
constexpr int YW = 2048;

constexpr size_t MiB = 1u << 20;
constexpr size_t WS_CTL = 0, CTL_BYTES = 1 * MiB;
constexpr size_t WS_WIN = 1 * MiB;
constexpr size_t WS_WLIFT = WS_WIN + (size_t)PW * DM * 2;
constexpr size_t WS_WOUT = WS_WLIFT + (size_t)4 * DM * 512 * 2;
constexpr size_t WS_WUP = WS_WOUT + (size_t)DM * DM * 2;
constexpr size_t WS_WDOWN = WS_WUP + (size_t)DFF2 * DM * 2;
constexpr size_t WS_W16 = WS_WDOWN + (size_t)DM * DFF * 2;
constexpr size_t WS_XN = WS_W16 + 65536;
constexpr size_t WS_P = WS_XN + (size_t)T * DM * 2;
constexpr size_t WS_U = WS_P, WS_ACT = WS_P;
constexpr size_t WS_YCAT = WS_P + (size_t)T * PW * 2;
constexpr size_t WS_XG = WS_YCAT + (size_t)T * YW * 2;
constexpr size_t WS_MB = WS_XG + (size_t)BATCH * SEQ * DM * 2;
constexpr size_t WS_SP = WS_MB + (size_t)FG * T * DM * 2;
constexpr size_t WS_GB = WS_SP + (size_t)T * 16 * 4;
constexpr size_t WS_GG = WS_GB + (size_t)T * 16;
constexpr size_t WS_GMT = WS_GG + (size_t)T * 16;
constexpr size_t WS_MCAR = WS_GMT + (size_t)T * 16;
constexpr size_t WS_MNEW = WS_MCAR + 4096;
constexpr size_t WS_MSC = WS_MNEW + 4096;
constexpr size_t WS_SUMB = WS_MSC + 4096, WS_SUMG = WS_SUMB + 4096;
constexpr size_t WS_DT = WS_SUMG + 4096;
constexpr size_t WS_AC = WS_DT + (size_t)T * 32;
constexpr size_t WS_XBC = WS_AC + (size_t)T * 32;
constexpr size_t WS_DC = WS_XBC + (size_t)T * DM * 2;
constexpr size_t WS_CS = WS_DC + (size_t)GB * 4 * NCH * 9216 * 4;
constexpr size_t WS_DH = WS_CS + (size_t)GB * 4 * NCH * 9216 * 2;
constexpr size_t WS_HS = WS_DH + (size_t)GB * NCH * 8 * 8192 * 4;
constexpr size_t WS_SSQ1 = WS_HS + (size_t)GB * NCH * 8 * 8192 * 2;
constexpr size_t WS_SSQ2 = WS_SSQ1 + (size_t)BATCH * SEQ * 64;
constexpr size_t WS_SSQC = WS_SSQ2 + (size_t)FG * T * 64;
constexpr size_t WS_RAWH = WS_SSQC + (size_t)T * 32;
constexpr size_t WS_END = WS_RAWH + (size_t)(FG * T / 256) * 22 * 4 * 256 * 4;
static_assert((size_t)FG * T * DFF * 2 <= (size_t)T * PW * 2 + (size_t)T * YW * 2, "ACT overlays P and YCAT");

constexpr int NWAVES = 8, NTHR = 512;
constexpr int LDS_BYTES = 155648;
constexpr int MISC_OFF = 153600;

__device__ __forceinline__ float bf2f(unsigned b) { return __uint_as_float(b << 16); }
__device__ __forceinline__ unsigned f2bf(float f) { unsigned u = __float_as_uint(f); return (u + 0x7fffu + ((u >> 16) & 1u)) >> 16; }
__device__ __forceinline__ unsigned pk2(float lo, float hi) { return f2bf(lo) | (f2bf(hi) << 16); }
__device__ __forceinline__ float sigmoidf_(float x) { return __builtin_amdgcn_rcpf(1.f + __builtin_amdgcn_exp2f(-1.4426950408889634f * x)); }
__device__ __forceinline__ float siluf_(float x) { return x * __builtin_amdgcn_rcpf(1.f + __builtin_amdgcn_exp2f(-1.4426950408889634f * x)); }
__device__ __forceinline__ float logsigf_(float x) { return fminf(x, 0.f) - log1pf(expf(-fabsf(x))); }
__device__ __forceinline__ float softplusf_(float x) { return fmaxf(x, 0.f) + log1pf(expf(-fabsf(x))); }
__device__ __forceinline__ float wave_sum(float v) {
#pragma unroll
    for (int o = 1; o < 64; o <<= 1) v += __shfl_xor(v, o);
    return v;
}
#define LDS_WAIT() asm volatile("s_waitcnt lgkmcnt(0)" ::: "memory")
__device__ __forceinline__ float row_rstd(const float* ssq16) {
    const f32x4* p = (const f32x4*)ssq16; const f32x4 a = (p[0] + p[1]) + (p[2] + p[3]);
    return rsqrtf(((a.x + a.y) + (a.z + a.w)) * (1.f / 1024.f) + 1e-6f);
}

namespace pg8 {
constexpr int BM = 256, BK = 64, HALF = 128, HTB = HALF * BK * 2, STAGE_BYTES = 8 * HTB, NXCD = 8, WGM = 4;
__host__ __device__ __forceinline__ int lds_byte(int r, int c) { const int st = (r >> 4) * 2 + (c >> 5), rr = r & 15, cc = c & 31, ob = rr * 64 + cc * 2; return st * 1024 + (ob ^ (((ob >> 9) & 1) << 5)); }
__host__ __device__ __forceinline__ void stage_rc(int b, int& R, int& C) { const int st = b / 1024, sb = b % 1024, swz = sb ^ (((sb >> 9) & 1) << 5); R = (st >> 1) * 16 + swz / 64; C = (st & 1) * 32 + (swz % 64) / 2; }
__host__ __device__ __forceinline__ int perm32(int rho) { const int n = rho >> 4, i = rho & 15; return 8 * (i >> 2) + 4 * n + (i & 3); }

struct Unit { int pm, pn, z; };
struct Gemm { const bf16* A; const bf16* Bt; int K, lda, ldb; size_t zA, zB; size_t ablk = 256, atile = 0; };

struct Order {
    int nM, nN, nwg, G, c, Z, wgm;
    __device__ __forceinline__ void init(int M, int N, int G_, int c_, int Z_, int wgm_ = WGM) { nM = M / BM; nN = N / BM; nwg = nM * nN; G = G_; c = c_; Z = Z_; wgm = wgm_; }
    __device__ __forceinline__ bool next(int i, Unit& u) const {
        const int ti = i / Z; u.z = i - ti * Z;
        const long L = (long)ti * G + c; if (L >= nwg) return false;
        int wgid = (int)L; { const int q = nwg / NXCD, r = nwg % NXCD, xcd = wgid % NXCD, off = wgid / NXCD; wgid = (xcd < r ? xcd * (q + 1) : r * (q + 1) + (xcd - r) * q) + off; }
        const int nig = wgm * nN, gid = wgid / nig, fm = gid * wgm, gsz = (nM - fm) < wgm ? (nM - fm) : wgm;
        u.pm = fm + ((wgid % nig) % gsz); u.pn = (wgid % nig) / gsz; return true;
    }
};
__device__ __forceinline__ unsigned cvt_pk_bf16(float lo, float hi) { unsigned r; asm volatile("s_nop 0\n\tv_cvt_pk_bf16_f32 %0, %1, %2" : "=v"(r) : "v"(lo), "v"(hi)); return r; }

__device__ __forceinline__ void panel_rstd(LAS float* rsl, const float* ssq, int pm, int wr, int wc, int fr, int fq) {
    volatile LAS int* tag = (volatile LAS int*)(rsl + 256);
    if (__builtin_amdgcn_readfirstlane(*tag) != pm) {
        const int tidl = (wr * 4 + wc) * 64 + fq * 16 + fr, rr = tidl >> 1, hf = tidl & 1;
        const f32x4* p = (const f32x4*)(ssq + (size_t)(pm * BM + rr) * 16 + hf * 8); const f32x4 a = p[0] + p[1];
        float sq = (a.x + a.y) + (a.z + a.w); sq += __shfl_xor(sq, 1);
        __builtin_amdgcn_s_barrier();
        if (hf == 0) rsl[rr] = rsqrtf(sq * (1.f / 1024.f) + 1e-6f);
        if (tidl == 0) *tag = pm;
        asm volatile("s_waitcnt lgkmcnt(0)" ::: "memory"); __builtin_amdgcn_s_barrier(); asm volatile("" ::: "memory");
    }
}
struct EpiBf16 {
    static constexpr int MIN_STORES = 16;
    static constexpr bool PERM = true, KEEP = false, CONTIG = true;
    LAS float* rsl;
    bf16* O; int ldc; const float* ssq; int gate_pn0; bf16* fac;
    static __device__ __forceinline__ float s1(float xs) { return 1.f + __builtin_amdgcn_exp2f(__builtin_amdgcn_fmed3f(xs, -43.28085122666891f, 43.28085122666891f)); }
    __device__ __forceinline__ void operator()(f32x4 (&acc)[2][2][4][2], const Unit& u, int wr, int wc, int fr, int fq) const {
        panel_rstd(rsl, ssq, u.pm, wr, wc, fr, fq);
        if (u.pn >= gate_pn0) {
            const int row0g = u.pm * BM + wr * 64 + fr, d0 = 64 * (u.pn - gate_pn0) + 16 * wc + 4 * fq;
#pragma unroll
            for (int ai = 0; ai < 2; ++ai)
#pragma unroll
                for (int m = 0; m < 4; ++m) {
                    const float rs = -1.4426950408889634f * rsl[wr * 64 + fr + ai * HALF + m * 16];
                    const int cc = d0 & 255, pnL = d0 >> 8, bjL = cc >> 7, wcL = (cc >> 5) & 3, fqL = (cc >> 3) & 3, nL = (cc >> 2) & 1;
                    bf16* rowp = fac + ((((((size_t)(u.pm * 4 + pnL) * 4) * 16 + (ai * 4 + m) * 2 + bjL) * 8 + (wr * 4 + wcL)) * 64 + fqL * 16 + fr) * 8 + nL * 4);
                    const size_t zstep = (size_t)16 * 8 * 512;
                    float one = 1.f; asm volatile("" : "+v"(one));
                    float f0[4], f1[4], f2[4], f3[4];
#pragma unroll
                    for (int e = 0; e < 4; ++e) { const float a0 = s1(acc[ai][0][m][0][e] * rs), a1 = s1(acc[ai][0][m][1][e] * rs), a2 = s1(acc[ai][1][m][0][e] * rs), a3 = s1(acc[ai][1][m][1][e] * rs);
                        f0[e] = a1 * __builtin_amdgcn_rcpf(a0); f1[e] = a2 * __builtin_amdgcn_rcpf(a1); f2[e] = a3 * __builtin_amdgcn_rcpf(a2); f3[e] = one * __builtin_amdgcn_rcpf(a3); }
                    *(u32x2*)(rowp) = (u32x2){cvt_pk_bf16(f0[0], f0[1]), cvt_pk_bf16(f0[2], f0[3])};
                    *(u32x2*)(rowp + zstep) = (u32x2){cvt_pk_bf16(f1[0], f1[1]), cvt_pk_bf16(f1[2], f1[3])};
                    *(u32x2*)(rowp + 2 * zstep) = (u32x2){cvt_pk_bf16(f2[0], f2[1]), cvt_pk_bf16(f2[2], f2[3])};
                    *(u32x2*)(rowp + 3 * zstep) = (u32x2){cvt_pk_bf16(f3[0], f3[1]), cvt_pk_bf16(f3[2], f3[3])}; }
            return; }
        const int row0 = u.pm * BM + wr * 64 + fr, col0 = u.pn * BM + wc * 64 + 8 * fq;
#pragma unroll
        for (int ai = 0; ai < 2; ++ai)
#pragma unroll
            for (int m = 0; m < 4; ++m) { const int row = row0 + ai * HALF + m * 16; bf16* rowp = O + (size_t)row * ldc + col0;
                const float rs = rsl[wr * 64 + fr + ai * HALF + m * 16];
#pragma unroll
                for (int bj = 0; bj < 2; ++bj) { const f32x4 v0 = acc[ai][bj][m][0] * rs, v1 = acc[ai][bj][m][1] * rs;
                    u32x4 w; w.x = cvt_pk_bf16(v0[0], v0[1]); w.y = cvt_pk_bf16(v0[2], v0[3]); w.z = cvt_pk_bf16(v1[0], v1[1]); w.w = cvt_pk_bf16(v1[2], v1[3]);
                    *(u32x4*)(rowp + bj * 32) = w; } }
    }
};
struct EpiResid {
    static constexpr int MIN_STORES = 16;
    static constexpr bool PERM = true, KEEP = false, CONTIG = true;
    bf16* xb; int ldc; float* ssq;
    __device__ __forceinline__ void operator()(f32x4 (&acc)[2][2][4][2], const Unit& u, int wr, int wc, int fr, int fq) const {
        const int row0 = u.pm * BM + wr * 64 + fr, col0 = u.pn * BM + wc * 64 + 8 * fq;
#pragma unroll
        for (int ai = 0; ai < 2; ++ai) {
            u32x4 ov[4][2];
#pragma unroll
            for (int m = 0; m < 4; ++m)
#pragma unroll
                for (int bj = 0; bj < 2; ++bj) ov[m][bj] = *(const u32x4*)(xb + (size_t)(row0 + ai * HALF + m * 16) * ldc + col0 + bj * 32);
            asm volatile("" ::: "memory");
#pragma unroll
            for (int m = 0; m < 4; ++m) { const int row = row0 + ai * HALF + m * 16; const size_t off = (size_t)row * ldc + col0; float q = 0.f;
#pragma unroll
                for (int bj = 0; bj < 2; ++bj) {
                    const u32x4 o = ov[m][bj];
                    const f32x4 x0 = (f32x4){bf2f(o.x & 0xffffu), bf2f(o.x >> 16), bf2f(o.y & 0xffffu), bf2f(o.y >> 16)} + acc[ai][bj][m][0];
                    const f32x4 x1 = (f32x4){bf2f(o.z & 0xffffu), bf2f(o.z >> 16), bf2f(o.w & 0xffffu), bf2f(o.w >> 16)} + acc[ai][bj][m][1];
                    q += (x0[0] * x0[0] + x0[1] * x0[1]) + (x0[2] * x0[2] + x0[3] * x0[3]) + (x1[0] * x1[0] + x1[1] * x1[1]) + (x1[2] * x1[2] + x1[3] * x1[3]);
                    u32x4 w; w.x = cvt_pk_bf16(x0[0], x0[1]); w.y = cvt_pk_bf16(x0[2], x0[3]); w.z = cvt_pk_bf16(x1[0], x1[1]); w.w = cvt_pk_bf16(x1[2], x1[3]);
                    *(u32x4*)(xb + off + bj * 32) = w; }
                q += __shfl_xor(q, 16); q += __shfl_xor(q, 32); if (fq == 0) ssq[(size_t)row * 16 + u.pn * 4 + wc] = q;
            }
            asm volatile("" ::: "memory");
        }
    }
};
struct EpiLift {
    static constexpr int MIN_STORES = 0;
    static constexpr bool PERM = true, KEEP = true, CONTIG = false;
    const bf16* fac; bf16* mb; int ldc; const float* ssqc;
    __device__ __forceinline__ void operator()(f32x4 (&acc)[2][2][4][2], const Unit& u, int wr, int wc, int fr, int fq) const {
        const int row0 = u.pm * BM + wr * 64 + fr, col0 = u.pn * BM + wc * 32 + 8 * fq;
        f32x2 sc[2][4];
        if (u.z == 1 || u.z == 2) {
#pragma unroll
            for (int ai = 0; ai < 2; ++ai)
#pragma unroll
                for (int m = 0; m < 4; ++m) sc[ai][m] = *(const f32x2*)(ssqc + (size_t)(row0 + ai * HALF + m * 16) * 8 + 2 * fq); }
#pragma unroll
        for (int ai = 0; ai < 2; ++ai) {
            u32x4 gv[4][2];
#pragma unroll
            for (int m = 0; m < 4; ++m)
#pragma unroll
                for (int bj = 0; bj < 2; ++bj) gv[m][bj] = *(const u32x4*)(fac + (((((size_t)(u.pm * 4 + u.pn) * 4 + u.z) * 16 + (ai * 4 + m) * 2 + bj) * 8 + (wr * 4 + wc)) * 64 + fq * 16 + fr) * 8);
            asm volatile("" ::: "memory");
#pragma unroll
            for (int m = 0; m < 4; ++m) { const int row = row0 + ai * HALF + m * 16;
                float rsc = 1.f;
                if (u.z == 1 || u.z == 2) { float sq = sc[ai][m].x + sc[ai][m].y; sq += __shfl_xor(sq, 16); sq += __shfl_xor(sq, 32);
                    const float v = sq * (1.f / 512.f) + 1e-6f; rsc = (u.z == 1) ? sqrtf(v) : rsqrtf(v); }
#pragma unroll
                for (int bj = 0; bj < 2; ++bj) { const int col = col0 + bj * HALF;
                    const u32x4 g0 = gv[m][bj];
                    f32x4& v0 = acc[ai][bj][m][0]; f32x4& v1 = acc[ai][bj][m][1];
                    v0[0] *= rsc * bf2f(g0.x & 0xffffu); v0[1] *= rsc * bf2f(g0.x >> 16); v0[2] *= rsc * bf2f(g0.y & 0xffffu); v0[3] *= rsc * bf2f(g0.y >> 16);
                    v1[0] *= rsc * bf2f(g0.z & 0xffffu); v1[1] *= rsc * bf2f(g0.z >> 16); v1[2] *= rsc * bf2f(g0.w & 0xffffu); v1[3] *= rsc * bf2f(g0.w >> 16);
                    if (u.z == 3) { u32x4 w; w.x = cvt_pk_bf16(v0[0], v0[1]); w.y = cvt_pk_bf16(v0[2], v0[3]); w.z = cvt_pk_bf16(v1[0], v1[1]); w.w = cvt_pk_bf16(v1[2], v1[3]);
                        *(u32x4*)(mb + (size_t)row * ldc + col) = w; } } }
            asm volatile("" ::: "memory");
        }
    }
};

__device__ __forceinline__ float dpp_ror1(float x) { return __int_as_float(__builtin_amdgcn_update_dpp(0, __float_as_int(x), 0x121, 0xf, 0xf, false)); }
__device__ __forceinline__ float dpp_ror2(float x) { return __int_as_float(__builtin_amdgcn_update_dpp(0, __float_as_int(x), 0x122, 0xf, 0xf, false)); }
__device__ __forceinline__ float dpp_shr1(float x) { return __int_as_float(__builtin_amdgcn_update_dpp(0, __float_as_int(x), 0x111, 0xf, 0xf, true)); }
__device__ __forceinline__ float dpp_shr2(float x) { return __int_as_float(__builtin_amdgcn_update_dpp(0, __float_as_int(x), 0x112, 0xf, 0xf, true)); }
__device__ __forceinline__ float dpp_prev1(float cur, float prev) { return __int_as_float(__builtin_amdgcn_update_dpp(__builtin_amdgcn_update_dpp(0, __float_as_int(prev), 0x121, 0xf, 0xf, false), __float_as_int(cur), 0x111, 0xf, 0xf, false)); }
__device__ __forceinline__ float dpp_prev2(float cur, float prev) { return __int_as_float(__builtin_amdgcn_update_dpp(__builtin_amdgcn_update_dpp(0, __float_as_int(prev), 0x122, 0xf, 0xf, false), __float_as_int(cur), 0x112, 0xf, 0xf, false)); }
struct EpiConvAct {
    static constexpr int MIN_STORES = 12;
    static constexpr bool PERM = true, KEEP = false, CONTIG = false;
    bf16* act; const float* ssq; const float* cw; const float* cb; float* rawh; LAS unsigned char* halo; int ntn;
    __device__ __forceinline__ void operator()(f32x4 (&acc)[2][2][4][2], const Unit& u, int wr, int wc, int fr, int fq) const {
        asm volatile("" : "+v"(fr), "+v"(fq));
        const int row0 = u.pm * BM + wr * 64 + fr, ch0 = u.pn * 128 + wc * 32 + 8 * fq;
        LAS float* rsl = (LAS float*)(halo + 12288);
        LAS float* WL = (LAS float*)(halo + 8192);
        const int wl_i2 = ((wr * 4 + wc) * 64 + fq * 16 + fr) * 2;
        f32x2 wlv;
        { const int kind = wl_i2 >> 7, c = wl_i2 & 127, k4 = kind & 3; const float* src = (k4 < 3 ? cw + k4 * 5632 : cb) + (kind >= 4 ? 2816 : 0) + u.pn * 128 + c; wlv = *(const f32x2*)src; }
        panel_rstd(rsl, ssq, u.pm, wr, wc, fr, fq);
#pragma unroll
        for (int ai = 0; ai < 2; ++ai)
#pragma unroll
            for (int m = 0; m < 4; ++m) { const float rs = rsl[wr * 64 + fr + ai * HALF + m * 16];
#pragma unroll
                for (int bj = 0; bj < 2; ++bj) { acc[ai][bj][m][0] = acc[ai][bj][m][0] * rs; acc[ai][bj][m][1] = acc[ai][bj][m][1] * rs; } }
        LAS f32x4* H = (LAS f32x4*)halo;
        if (fr >= 14) {
#pragma unroll
            for (int ai = 0; ai < 2; ++ai) { const int b = 2 * ai + wr;
#pragma unroll
                for (int bj = 0; bj < 2; ++bj)
#pragma unroll
                    for (int n = 0; n < 2; ++n) H[((((b * 4 + wc) * 4 + fq) * 2 + (fr - 14)) * 2 + bj) * 2 + n] = acc[ai][bj][3][n]; } }
        { float* rw = rawh + (size_t)(u.pm * ntn + u.pn) * 1024;
          if (wr == 1 && fr >= 14) {
#pragma unroll
            for (int bj = 0; bj < 2; ++bj)
#pragma unroll
                for (int n = 0; n < 2; ++n) *(f32x4*)(rw + (2 + fr - 14) * 256 + bj * HALF + wc * 32 + 8 * fq + 4 * n) = acc[1][bj][3][n]; }
          if (wr == 0 && fr < 2) {
#pragma unroll
            for (int bj = 0; bj < 2; ++bj)
#pragma unroll
                for (int n = 0; n < 2; ++n) *(f32x4*)(rw + fr * 256 + bj * HALF + wc * 32 + 8 * fq + 4 * n) = acc[0][bj][0][n]; } }
        *(LAS f32x2*)(WL + wl_i2) = wlv;
        asm volatile("s_waitcnt lgkmcnt(0)" ::: "memory"); __builtin_amdgcn_s_barrier(); asm volatile("" ::: "memory");
        bf16* actb = act + ((size_t)(u.pm * ntn + u.pn) * BM + wr * 64) * 128 + wc * 32;
        const unsigned alane = (unsigned)(fr * 128 + 8 * fq);
        const float lm1 = (fr == 0) ? 1.f : 0.f, lm2 = (fr < 2) ? 1.f : 0.f;
        float zf = 0.f; asm volatile("" : "+v"(zf));
        unsigned pkw[2][4][3];
#pragma unroll
        for (int n = 0; n < 2; ++n) {
#pragma unroll
            for (int eh = 0; eh < 2; ++eh) {
                const int cl = wc * 32 + 8 * fq + 4 * n + 2 * eh;
                f32x2 wg[3], wu[3], bg, bu;
#pragma unroll
                for (int j = 0; j < 3; ++j) { wg[j] = *(const LAS f32x2*)(WL + j * 128 + cl); wu[j] = *(const LAS f32x2*)(WL + (4 + j) * 128 + cl); }
                bg = *(const LAS f32x2*)(WL + 3 * 128 + cl); bu = *(const LAS f32x2*)(WL + 7 * 128 + cl);
#pragma unroll
                for (int j = 0; j < 3; ++j) { wg[j] = wg[j] * 1.4426950408889634f; wu[j] = wu[j] * 0.6931471805599453f; }
                bg = bg * 1.4426950408889634f; bu = bu * 0.6931471805599453f;
                f32x2 wg1m = wg[1] * lm1, wg0m = wg[0] * lm2, wu1m = wu[1] * lm1, wu0m = wu[0] * lm2;
                asm volatile("" : "+v"(wg1m), "+v"(wg0m), "+v"(wu1m), "+v"(wu0m));
#pragma unroll
                for (int ai = 0; ai < 2; ++ai) { const int b = 2 * ai + wr;
#pragma unroll
                    for (int m = 3; m >= 0; --m) {
                        float r2[2];
#pragma unroll
                        for (int e2 = 0; e2 < 2; ++e2) { const int e = 2 * eh + e2;
                            const float gc = acc[ai][0][m][n][e], uc = acc[ai][1][m][n][e];
                            float gp = zf, up = zf;
                            if (m > 0) { gp = acc[ai][0][m - 1][n][e]; up = acc[ai][1][m - 1][n][e]; }
                            else if (b >= 1) { const int fk = fr >= 14 ? fr - 14 : 0; const LAS float* hp = (const LAS float*)(H + ((((b - 1) * 4 + wc) * 4 + fq) * 2 + fk) * 4 + n); gp = hp[e]; up = hp[8 + e]; }
                            float vg = fmaf(wg[2][e2], gc, bg[e2]), vu = fmaf(wu[2][e2], uc, bu[e2]);
                            asm volatile("s_nop 1\n\t"
                                         "v_fmac_f32_dpp %0, %2, %4 row_shr:1 row_mask:0xf bank_mask:0xf bound_ctrl:0\n\t"
                                         "v_fmac_f32_dpp %1, %3, %5 row_shr:1 row_mask:0xf bank_mask:0xf bound_ctrl:0\n\t"
                                         "v_fmac_f32_dpp %0, %2, %6 row_shr:2 row_mask:0xf bank_mask:0xf bound_ctrl:0\n\t"
                                         "v_fmac_f32_dpp %1, %3, %7 row_shr:2 row_mask:0xf bank_mask:0xf bound_ctrl:0\n\t"
                                         "v_fmac_f32_dpp %0, %8, %10 row_ror:1 row_mask:0xf bank_mask:0xf\n\t"
                                         "v_fmac_f32_dpp %1, %9, %11 row_ror:1 row_mask:0xf bank_mask:0xf\n\t"
                                         "v_fmac_f32_dpp %0, %8, %12 row_ror:2 row_mask:0xf bank_mask:0xf\n\t"
                                         "v_fmac_f32_dpp %1, %9, %13 row_ror:2 row_mask:0xf bank_mask:0xf"
                                         : "+v"(vg), "+v"(vu)
                                         : "v"(gc), "v"(uc), "v"(wg[1][e2]), "v"(wu[1][e2]), "v"(wg[0][e2]), "v"(wu[0][e2]), "v"(gp), "v"(up), "v"(wg1m[e2]), "v"(wu1m[e2]), "v"(wg0m[e2]), "v"(wu0m[e2]));
                            r2[e2] = (vg * vu) * __builtin_amdgcn_rcpf(1.f + __builtin_amdgcn_exp2f(-vg)); }
                        const unsigned pk = cvt_pk_bf16(r2[0], r2[1]);
                        if (2 * n + eh < 3) pkw[ai][m][2 * n + eh] = pk;
                        else *(u32x4*)(actb + (size_t)(ai * HALF + m * 16) * 128 + alane) = (u32x4){pkw[ai][m][0], pkw[ai][m][1], pkw[ai][m][2], pk};
                    }
                }
            }
        }
    }
};

template <class Epi, bool ALIGN_EPI = true>
__device__ __forceinline__ void gemm_phase(LAS unsigned char* lds, const Gemm g, const Order& S, const Epi& E) {
    int tid = threadIdx.x; asm volatile("" : "+v"(tid));
    const int wid = __builtin_amdgcn_readfirstlane(tid >> 6), lane = tid & 63, wr = wid >> 2, wc = wid & 3, fr = lane & 15, fq = lane >> 4;
    const int K = g.K, nt = K / BK;
    unsigned voffA[2], voffB[2];
#pragma unroll
    for (int i = 0; i < 2; ++i) { int R, C; stage_rc(tid * 16 + i * 8192, R, C);
        const int Rb = Epi::CONTIG ? (64 * (R >> 5) + perm32(R & 31)) : (Epi::PERM ? ((R & ~31) + perm32(R & 31)) : R);
        voffA[i] = (unsigned)(R * g.lda + C) * 2u; voffB[i] = (unsigned)(Rb * g.ldb + C) * 2u; }
    const size_t kstep = (size_t)(BK * 2);
    const size_t hstepA = (size_t)HALF * g.lda * 2, hstepB = (size_t)(Epi::CONTIG ? 32 : HALF) * g.ldb * 2;
    const size_t tstepA = g.atile ? g.atile : 2 * hstepA, tstepB = (size_t)BM * g.ldb * 2;
    const unsigned ldsw = (unsigned)wid * 1024u;
    const int aoff = lds_byte(wr * 64 + fr, fq * 8), boff = lds_byte(wc * 32 + fr, fq * 8);
#define PG8_SA(b, h) (((b) * 2 + (h)) * HTB)
#define PG8_SB(b, h) ((4 + (b) * 2 + (h)) * HTB)
#define PG8_STAGE(bufoff, gbase, voff) do { _Pragma("unroll") for (int _i = 0; _i < 2; ++_i) \
        __builtin_amdgcn_global_load_lds((const unsigned*)((const char*)(gbase) + (voff)[_i]), (LAS unsigned*)(lds + (bufoff) + ldsw + _i * 8192), 16, 0, 0); } while (0)
#define PG8_LDA(dst, b, h) do { _Pragma("unroll") for (int m = 0; m < 4; ++m) _Pragma("unroll") for (int k = 0; k < 2; ++k) dst[m][k] = *(const LAS bf16x8*)(lds + PG8_SA(b, h) + aoff + m * 2048 + k * 1024); } while (0)
#define PG8_LDB(dst, b, h) do { _Pragma("unroll") for (int n = 0; n < 2; ++n) _Pragma("unroll") for (int k = 0; k < 2; ++k) dst[n][k] = *(const LAS bf16x8*)(lds + PG8_SB(b, h) + boff + n * 2048 + k * 1024); } while (0)
#define PG8_MMA(ai, bj, At, Bt) do { __builtin_amdgcn_s_setprio(1); _Pragma("unroll") for (int m = 0; m < 4; ++m) _Pragma("unroll") for (int n = 0; n < 2; ++n) _Pragma("unroll") for (int k = 0; k < 2; ++k) \
        acc[ai][bj][m][n] = __builtin_amdgcn_mfma_f32_16x16x32_bf16(Bt[n][k], At[m][k], acc[ai][bj][m][n], 0, 0, 0); __builtin_amdgcn_s_setprio(0); } while (0)
#define PG8_WAIT_V(n) asm volatile("s_waitcnt vmcnt(" #n ")" ::: "memory")
#define PG8_WAIT_L(n) asm volatile("s_waitcnt lgkmcnt(" #n ")" ::: "memory")
#define PG8_WAIT_V8R(r) asm volatile("s_cmp_lg_u32 %0, 0\n\ts_cbranch_scc0 .Lw8_%=\n\ts_waitcnt vmcnt(%1)\n\ts_branch .Lwd_%=\n.Lw8_%=:\n\ts_waitcnt vmcnt(8)\n.Lwd_%=:" :: "s"(__builtin_amdgcn_readfirstlane(r)), "n"(8 + Epi::MIN_STORES) : "memory", "scc")
#define PG8_BAR __builtin_amdgcn_s_barrier()
#define PG8_SCHED __builtin_amdgcn_sched_barrier(0)
    Unit cur, nxt; int ui = 0;
    if (!S.next(0, cur)) return;
    f32x4 acc[2][2][4][2];
#pragma unroll
    for (int a = 0; a < 2; ++a)
#pragma unroll
        for (int b = 0; b < 2; ++b)
#pragma unroll
            for (int m = 0; m < 4; ++m)
#pragma unroll
                for (int n = 0; n < 2; ++n) acc[a][b][m][n] = (f32x4){0.f, 0.f, 0.f, 0.f};
    bf16x8 At[4][2], B0[2][2], B1[2][2];
    const char* cA = (const char*)g.A + (size_t)cur.pm * tstepA + (size_t)cur.z * g.zA; const char* cB = (const char*)g.Bt + (size_t)cur.pn * tstepB + (size_t)cur.z * g.zB;
    PG8_STAGE(PG8_SB(0, 0), cB, voffB); PG8_STAGE(PG8_SB(0, 1), cB + hstepB, voffB); PG8_STAGE(PG8_SA(0, 0), cA, voffA); PG8_STAGE(PG8_SA(0, 1), cA + hstepA, voffA);
    if (wr == 1) PG8_BAR;
    PG8_WAIT_V(2); PG8_BAR;
    PG8_STAGE(PG8_SB(1, 0), cB + kstep, voffB); PG8_STAGE(PG8_SA(1, 0), cA + kstep, voffA); PG8_STAGE(PG8_SB(1, 1), cB + hstepB + kstep, voffB);
    PG8_WAIT_V(6); PG8_BAR;
    for (;;) {
        const bool has_next = S.next(ui + 1, nxt);
        const char* nA = has_next ? (const char*)g.A + (size_t)nxt.pm * tstepA + (size_t)nxt.z * g.zA : cA; const char* nB = has_next ? (const char*)g.Bt + (size_t)nxt.pn * tstepB + (size_t)nxt.z * g.zB : cB;
        for (int t = 0; t < nt; t += 2) {
            const bool last = (t == nt - 2);
            const char* a1 = cA + (size_t)(t >> 1) * g.ablk + kstep;
            const char* a2 = last ? nA : cA + (size_t)((t >> 1) + 1) * g.ablk; const char* b2 = last ? nB : cB + (size_t)(t + 2) * kstep;
            const char* a3 = a2 + kstep; const char* b3 = b2 + kstep;
            const int relax = ((t == 0) && (ui > 0)) ? 1 : 0; (void)relax;
            PG8_LDB(B0, 0, 0); PG8_LDB(B1, 0, 1); PG8_SCHED; PG8_LDA(At, 0, 0); PG8_STAGE(PG8_SA(1, 1), a1 + hstepA, voffA);
            if constexpr (Epi::MIN_STORES > 0) PG8_WAIT_V8R(relax); else PG8_WAIT_V(8);
            PG8_WAIT_L(0); PG8_BAR; PG8_MMA(0, 0, At, B0); PG8_MMA(0, 1, At, B1); PG8_BAR; PG8_SCHED;
            PG8_LDA(At, 0, 1); PG8_STAGE(PG8_SB(0, 0), b2, voffB); PG8_STAGE(PG8_SB(0, 1), b2 + hstepB, voffB); PG8_STAGE(PG8_SA(0, 0), a2, voffA);
            if constexpr (Epi::MIN_STORES > 0) PG8_WAIT_V8R(relax); else PG8_WAIT_V(8);
            PG8_WAIT_L(0); PG8_BAR; PG8_MMA(1, 0, At, B0); PG8_MMA(1, 1, At, B1); PG8_BAR; PG8_SCHED;
            PG8_LDB(B0, 1, 0); PG8_LDB(B1, 1, 1); PG8_SCHED; PG8_LDA(At, 1, 0); PG8_STAGE(PG8_SA(0, 1), a2 + hstepA, voffA);
            PG8_WAIT_V(8); PG8_WAIT_L(0); PG8_BAR; PG8_MMA(0, 0, At, B0); PG8_MMA(0, 1, At, B1); PG8_BAR; PG8_SCHED;
            PG8_LDA(At, 1, 1); PG8_STAGE(PG8_SB(1, 0), b3, voffB); PG8_STAGE(PG8_SB(1, 1), b3 + hstepB, voffB); PG8_STAGE(PG8_SA(1, 0), a3, voffA);
            PG8_WAIT_V(8); PG8_WAIT_L(0); PG8_BAR; PG8_MMA(1, 0, At, B0); PG8_MMA(1, 1, At, B1); PG8_BAR; PG8_SCHED;
        }
        if constexpr (ALIGN_EPI) { if (wr == 0) PG8_BAR; }
        E(acc, cur, wr, wc, fr, fq);
        if (!has_next) break;
        if (!(Epi::KEEP && nxt.z != 0))
#pragma unroll
        for (int a = 0; a < 2; ++a)
#pragma unroll
            for (int b = 0; b < 2; ++b)
#pragma unroll
                for (int m = 0; m < 4; ++m)
#pragma unroll
                    for (int n = 0; n < 2; ++n) acc[a][b][m][n] = (f32x4){0.f, 0.f, 0.f, 0.f};
        cur = nxt; cA = nA; cB = nB; ++ui;
        if constexpr (ALIGN_EPI) { if (wr == 1) PG8_BAR; }
    }
    PG8_WAIT_V(0);
    if constexpr (!ALIGN_EPI) { if (wr == 0) PG8_BAR; }
    PG8_BAR;
#undef PG8_SA
#undef PG8_SB
#undef PG8_STAGE
#undef PG8_LDA
#undef PG8_LDB
#undef PG8_MMA
#undef PG8_WAIT_V
#undef PG8_WAIT_L
#undef PG8_WAIT_V8R
#undef PG8_BAR
#undef PG8_SCHED
}
}

#define XB_TMO      128
#define XB_XCNT(j)  (256  + 64 * (j))
#define XB_XSUB(j)  (1280 + 64 * (j))
#define XB_XGEN(j)  (2304 + 64 * (j))
#define XB_TOP      3328
#define XB_TOPGEN   3392
#define XCD_BAR_WORDS 3456
#define XB_SPIN_CAP (1u << 18)
__device__ __forceinline__ unsigned xb_ld(unsigned* p)              { return __hip_atomic_load(p, __ATOMIC_RELAXED, __HIP_MEMORY_SCOPE_AGENT); }
__device__ __forceinline__ unsigned xb_add(unsigned* p, unsigned v) { return __hip_atomic_fetch_add(p, v, __ATOMIC_RELAXED, __HIP_MEMORY_SCOPE_AGENT); }
__device__ __forceinline__ unsigned xb_xcc_id() { return (unsigned)__builtin_amdgcn_s_getreg((3 << 11) | 20) & 0xFu; }
#define XB_SPIN(cond, bar) do { unsigned _sp = 0; while (cond) { __builtin_amdgcn_s_sleep(1); \
    if ((++_sp & 255u) == 0u) { if (xb_ld(&(bar)[XB_TMO])) break; if (_sp > XB_SPIN_CAP) { atomicAdd(&(bar)[XB_TMO], 1u); break; } } } } while (0)
struct XcdBarrier { unsigned* bar; unsigned x; volatile LAS unsigned* st; };
__device__ __forceinline__ XcdBarrier xcd_barrier_post(unsigned* bar, volatile LAS unsigned* st) {
    XcdBarrier b; b.bar = bar; b.x = xb_xcc_id(); b.st = st;
    if (threadIdx.x == 0) (void)xb_add(&bar[XB_XCNT(b.x)], 1u);
    return b;
}
__device__ __forceinline__ void xcd_barrier_complete(unsigned* bar, unsigned x, unsigned& nloc, unsigned& nx) {
    const unsigned G = gridDim.x * gridDim.y * gridDim.z;
    unsigned sum, cnt, mine, sp = 0u;
    for (;;) {
        sum = 0u; cnt = 0u; mine = 0u;
#pragma unroll
        for (unsigned j = 0; j < 16; ++j) { const unsigned c = xb_ld(&bar[XB_XCNT(j)]); sum += c; cnt += (c > 0u) ? 1u : 0u; mine = (j == x) ? c : mine; }
        if (sum == G) break;
        __builtin_amdgcn_s_sleep(1);
        if ((++sp & 255u) == 0u) { if (xb_ld(&bar[XB_TMO])) break; if (sp > XB_SPIN_CAP) { atomicAdd(&bar[XB_TMO], 1u); break; } }
    }
    nloc = mine > 0u ? mine : 1u; nx = cnt > 0u ? cnt : 1u;
}
__device__ __forceinline__ void xcd_barrier(const XcdBarrier& b) {
    asm volatile("s_waitcnt vmcnt(0)" ::: "memory");
    __syncthreads();
    if (threadIdx.x == 0) {
        unsigned* bar = b.bar;
        __builtin_amdgcn_s_waitcnt(0);
        unsigned nloc = b.st[0], nx = b.st[1];
        if (nloc == 0u) { xcd_barrier_complete(bar, b.x, nloc, nx); b.st[0] = nloc; b.st[1] = nx; }
        const unsigned old = xb_add(&bar[XB_XSUB(b.x)], 1u);
        const unsigned gen = old / nloc;
        if (old + 1u == (gen + 1u) * nloc) {
            __builtin_amdgcn_fence(__ATOMIC_RELEASE, "agent");
            asm volatile("s_waitcnt vmcnt(0)" ::: "memory");
            const unsigned og = xb_add(&bar[XB_TOP], 1u);
            const unsigned tg = og / nx;
            if (og + 1u == (tg + 1u) * nx) xb_add(&bar[XB_TOPGEN], 1u);
            else XB_SPIN(xb_ld(&bar[XB_TOPGEN]) == tg, bar);
            __builtin_amdgcn_fence(__ATOMIC_ACQUIRE, "agent");
            xb_add(&bar[XB_XGEN(b.x)], 1u);
            asm volatile("s_waitcnt vmcnt(0)" ::: "memory");
        } else {
            XB_SPIN(xb_ld(&bar[XB_XGEN(b.x)]) == gen, bar);
            __builtin_amdgcn_fence(__ATOMIC_ACQUIRE, "agent");
            asm volatile("s_waitcnt vmcnt(0)" ::: "memory");
        }
    }
    __syncthreads();
}

__device__ __forceinline__ bf16x8 frag_kc(const LAS bf16* X, int ld, int mn0, int k0, int lane) { return *(const LAS bf16x8*)(X + (mn0 + (lane & 15)) * ld + k0 + 8 * (lane >> 4)); }
__device__ __forceinline__ bf16x8 gfrag_kc(const bf16* X, int ld, int mn0, int k0, int lane) { const bf16* b = X + (size_t)mn0 * ld + k0; const unsigned lo = (unsigned)((lane & 15) * ld + 8 * (lane >> 4)); return *(const bf16x8*)(b + lo); }
__device__ __forceinline__ s16x4 trr(const LAS bf16* p) { return __builtin_bit_cast(s16x4, __builtin_amdgcn_ds_read_tr16_b64_v4i16((LAS s16x4*)p)); }
__device__ __forceinline__ bf16x8 frag_ks(const LAS bf16* X, int ld, int mn0, int k0, int lane) {
    const int r = lane & 15, g = lane >> 4;
    const LAS bf16* p = X + (k0 + 8 * g + (r >> 2)) * ld + mn0 + 4 * (r & 3);
    const s16x4 lo = trr(p), hi = trr(p + 4 * ld);
    return (bf16x8){lo[0], lo[1], lo[2], lo[3], hi[0], hi[1], hi[2], hi[3]};
}
__device__ __forceinline__ f32x4 zero4() { f32x4 z = {0.f, 0.f, 0.f, 0.f}; asm volatile("" : "+v"(z)); return z; }
__device__ __forceinline__ u32x4 uone4() { u32x4 z = {0x3F80u, 0u, 0u, 0u}; asm volatile("" : "+v"(z)); return z; }
__device__ __forceinline__ u32x4 uzero4() { u32x4 z = {0u, 0u, 0u, 0u}; asm volatile("" : "+v"(z)); return z; }
#define MFMA16(a, b, c) __builtin_amdgcn_mfma_f32_16x16x32_bf16((a), (b), (c), 0, 0, 0)
__device__ __forceinline__ u32x4 scale8(u32x4 w, float s) {
    u32x4 o;
    o.x = pk2(bf2f(w.x & 0xffffu) * s, bf2f(w.x >> 16) * s); o.y = pk2(bf2f(w.y & 0xffffu) * s, bf2f(w.y >> 16) * s);
    o.z = pk2(bf2f(w.z & 0xffffu) * s, bf2f(w.z >> 16) * s); o.w = pk2(bf2f(w.w & 0xffffu) * s, bf2f(w.w >> 16) * s);
    return o;
}
__device__ __forceinline__ float wscan_add(float v, int lane) {
#pragma unroll
    for (int o = 1; o < 64; o <<= 1) { const float t = __shfl_up(v, o); if (lane >= o) v += t; }
    return v;
}
__device__ __forceinline__ float wscan_max(float v, int lane) {
#pragma unroll
    for (int o = 1; o < 64; o <<= 1) { const float t = __shfl_up(v, o); if (lane >= o) v = fmaxf(v, t); }
    return v;
}

#ifndef GEMM_ALIGN
#define GEMM_ALIGN true
#endif
enum { PH_W = 0, PH_INPROJ, PH_M0, PH_M1, PH_M2, PH_M3, PH_LIFT, PH_OUT, PH_UP, PH_DOWN, PH_FINAL, PH_COUNT };
enum { I_X = 0, I_MIXG, I_WIN, I_AIB, I_AFB, I_ANG, I_BCW, I_CCW, I_CCB, I_CDTB, I_CALOG, I_CDSKIP, I_CNG, I_WLIFT, I_WOUT, I_FFNG, I_WUP, I_FCW, I_FCB, I_WDOWN, I_FING, N_IN };
struct Args { const float* in[N_IN]; float* out; unsigned char* ws; int l_lo, l_hi, g_lo, g_hi, ph_lo, ph_hi, use_bar, pad; };

__device__ __forceinline__ void transpose_item(const float* W, int ldw, int nsrc0, int k0, bf16* WT, int ldt, int ndst0, LAS float* scr, int lane, const float* kscale = nullptr, int gate_tile = -1) {
    int scol = nsrc0 + (lane & 31);
    if (gate_tile >= 0) {
        const int c = (ndst0 & 255) + (lane & 31), wc = c >> 6, bj = (c >> 5) & 1, fq = (c >> 3) & 3, n = (c >> 2) & 1, e = c & 3;
        scol = 6160 + (2 * bj + n) * 1024 + 64 * gate_tile + 16 * wc + 4 * fq + e; }
#pragma unroll 8
    for (int i = 0; i < 32; ++i) { const int kk = 2 * i + (lane >> 5); scr[kk * 33 + (lane & 31)] = W[(size_t)(k0 + kk) * ldw + scol] * (kscale ? kscale[k0 + kk] : 1.f); }
    LDS_WAIT(); asm volatile("" ::: "memory");
    const int c = lane & 7;
#pragma unroll
    for (int j = 0; j < 4; ++j) { const int n = (lane >> 3) + 8 * j; const LAS float* s = scr + (8 * c) * 33 + n;
        u32x4 o; o.x = pk2(s[0 * 33], s[1 * 33]); o.y = pk2(s[2 * 33], s[3 * 33]); o.z = pk2(s[4 * 33], s[5 * 33]); o.w = pk2(s[6 * 33], s[7 * 33]);
        *(u32x4*)(WT + (size_t)(ndst0 + n) * ldt + k0 + 8 * c) = o; }
    LDS_WAIT(); asm volatile("" ::: "memory");
}

__global__ void __launch_bounds__(NTHR, 2) fwd(Args args) {
    extern __shared__ __attribute__((aligned(16))) unsigned char lds_raw[];
    LAS unsigned char* lds = (LAS unsigned char*)lds_raw;
    const int NBLK = gridDim.x, blk = blockIdx.x;
    {
        volatile LAS unsigned* MISC0 = (volatile LAS unsigned*)(lds + MISC_OFF);
        if (threadIdx.x < 16) MISC0[threadIdx.x] = 0u;
        __syncthreads();
    }
    XcdBarrier bar; bar.bar = (unsigned*)(args.ws + WS_CTL) + 4096; bar.x = 0; bar.st = nullptr;
    if (args.use_bar) bar = xcd_barrier_post((unsigned*)(args.ws + WS_CTL) + 4096, (volatile LAS unsigned*)(lds + MISC_OFF) + 8);
#define GRID_BAR() do { if (args.use_bar) xcd_barrier(bar); } while (0)
#ifndef REPMASK
#define REPMASK 0
#endif
#define IN(k) (args.ph_lo <= (k) && (k) < args.ph_hi)
#define REPS(k) for (int rep_ = 0; rep_ < 1 + ((REPMASK >> (k)) & 1); ++rep_)
#define PHASE_BEGIN() int tid = threadIdx.x; asm volatile("" : "+v"(tid)); const int lane = tid & 63, wave = __builtin_amdgcn_readfirstlane(tid >> 6); \
    const __attribute__((address_space(4))) Args* ka = (const __attribute__((address_space(4))) Args*)__builtin_amdgcn_kernarg_segment_ptr(); asm volatile("" : "+s"(ka)); \
    unsigned char* ws = ka->ws; \
    const size_t grow0 = (size_t)grp * T; const float* xsrc = (l == 0) ? ka->in[I_X] : ka->out; (void)grow0; (void)xsrc; \
    const int gw = blk * NWAVES + wave, NGW = NBLK * NWAVES, gt = blk * NTHR + tid, NGT = NBLK * NTHR; (void)lane; (void)gw; (void)NGW; (void)gt; (void)NGT; \
    bf16* const WinT = (bf16*)(ws + WS_WIN); bf16* const WliftT = (bf16*)(ws + WS_WLIFT); bf16* const WoutT = (bf16*)(ws + WS_WOUT); \
    bf16* const WupT = (bf16*)(ws + WS_WUP); bf16* const WdownT = (bf16*)(ws + WS_WDOWN); bf16* const W16B = (bf16*)(ws + WS_W16); \
    bf16* const XN = (bf16*)(ws + WS_XN); bf16* const P = (bf16*)(ws + WS_P); bf16* const FAC = (bf16*)(ws + WS_P) + (size_t)T * PWS; (void)FAC; bf16* const U = (bf16*)(ws + WS_U); bf16* const ACT = (bf16*)(ws + WS_ACT); \
    bf16* const YCAT = (bf16*)(ws + WS_YCAT); bf16* const XG = (bf16*)(ws + WS_XG); bf16* const MB = (bf16*)(ws + WS_MB); float* const SP = (float*)(ws + WS_SP); \
    float* const SSQ1 = (float*)(ws + WS_SSQ1); float* const SSQ2 = (float*)(ws + WS_SSQ2); float* const SSQC = (float*)(ws + WS_SSQC); float* const RAWH = (float*)(ws + WS_RAWH); (void)SSQ1; (void)SSQ2; (void)SSQC; (void)RAWH; \
    float* const GBc = (float*)(ws + WS_GB); float* const GGc = (float*)(ws + WS_GG); float* const GMT = (float*)(ws + WS_GMT); \
    float* const MCAR = (float*)(ws + WS_MCAR); float* const MNEW = (float*)(ws + WS_MNEW); float* const MSC = (float*)(ws + WS_MSC); float* const SUMB = (float*)(ws + WS_SUMB); float* const SUMG = (float*)(ws + WS_SUMG); (void)SUMB; (void)SUMG; \
    float* const DTB = (float*)(ws + WS_DT); float* const ACB = (float*)(ws + WS_AC); bf16* const XBC = (bf16*)(ws + WS_XBC); \
    bf16* const DC = (bf16*)(ws + WS_DC); bf16* const CS = (bf16*)(ws + WS_CS); bf16* const DH = (bf16*)(ws + WS_DH); bf16* const HS = (bf16*)(ws + WS_HS); \
    (void)WinT; (void)WliftT; (void)WoutT; (void)WupT; (void)WdownT; (void)W16B; (void)XN; (void)P; (void)U; (void)ACT; (void)YCAT; (void)XG; (void)MB; (void)SP; (void)GBc; (void)GGc; (void)GMT; \
    (void)MCAR; (void)MNEW; (void)MSC; (void)DTB; (void)ACB; (void)XBC; (void)DC; (void)CS; (void)DH; (void)HS

    for (int l = args.l_lo; l < args.l_hi; ++l)
    for (int grp = args.g_lo; grp < args.g_hi; ++grp) {

        REPS(PH_W) if (IN(PH_W) && grp == 0) {
            PHASE_BEGIN();
            LAS float* scr = (LAS float*)(lds + wave * 16384);
            constexpr int I_IN = 16 * 320, I_LF = 4 * 8 * 32, I_OUT = 16 * 32, I_UP = 16 * 176, I_DN = 44 * 32, NIT = I_IN + I_LF + I_OUT + I_UP + I_DN;
            for (int it = gw; it < NIT; it += NGW) {
                int r = it;
                if (r < I_IN) { const int kb = r / 320, nb = r % 320, n0 = 32 * nb, ns = n0 + (n0 >= P_SQ ? 16 : (n0 >= P_BB ? 8 : 0));
                    transpose_item(ka->in[I_WIN] + (size_t)l * DM * PIN, PIN, ns, 64 * kb, WinT, DM, n0, scr, lane, ka->in[I_MIXG] + (size_t)l * DM, n0 >= P_G ? (n0 - P_G) >> 8 : -1); continue; } r -= I_IN;
                if (r < I_LF) { const int br = r / 256, q = r % 256, kb = q / 32, nb = q % 32;
                    transpose_item(ka->in[I_WLIFT] + (size_t)(l * 4 + br) * 512 * DM, DM, 32 * nb, 64 * kb, WliftT + (size_t)br * DM * 512, 512, 32 * nb, scr, lane, br == 2 ? ka->in[I_CNG] + (size_t)l * 512 : nullptr); continue; } r -= I_LF;
                if (r < I_OUT) { const int kb = r / 32, nb = r % 32;
                    transpose_item(ka->in[I_WOUT] + (size_t)l * DM * DM, DM, 32 * nb, 64 * kb, WoutT, DM, 32 * nb, scr, lane); continue; } r -= I_OUT;
                if (r < I_UP) { const int kb = r / 176, nb = r % 176, n0 = 32 * nb, tp = n0 >> 8, j = n0 & 255, ns = (j < 128) ? 128 * tp + j : 2816 + 128 * tp + (j - 128);
                    transpose_item(ka->in[I_WUP] + (size_t)l * DM * DFF2, DFF2, ns, 64 * kb, WupT, DM, n0, scr, lane, ka->in[I_FFNG] + (size_t)l * DM); continue; } r -= I_UP;
                { const int kb = r / 32, nb = r % 32;
                    transpose_item(ka->in[I_WDOWN] + (size_t)l * DFF * DM, DM, 32 * nb, 64 * kb, WdownT, DFF, 32 * nb, scr, lane); }
            }
            for (int i = gt; i < 16 * DM; i += NGT) { const int c = i >> 10, k = i & 1023; const int oc = (c < 8) ? (1536 + c) : (4616 + (c - 8));
                const float w = ka->in[I_WIN][(size_t)l * DM * PIN + (size_t)k * PIN + oc] * ka->in[I_MIXG][(size_t)l * DM + k]; const unsigned hi = f2bf(w);
                W16B[i] = (bf16)hi; W16B[16 * DM + i] = (bf16)f2bf(w - bf2f(hi)); }
            if (l == 0) {
                for (int m = gw; m < BATCH * SEQ; m += NGW) {
                    const f32x4* xr = (const f32x4*)(ka->in[I_X] + (size_t)m * DM) + lane;
                    f32x4 v[4]; float sq = 0.f;
#pragma unroll
                    for (int j = 0; j < 4; ++j) { v[j] = xr[64 * j]; sq += (v[j].x * v[j].x + v[j].y * v[j].y) + (v[j].z * v[j].z + v[j].w * v[j].w); }
                    sq = wave_sum(sq); if (lane < 16) SSQ1[(size_t)m * 16 + lane] = (lane == 0) ? sq : 0.f;
                    u32x2* o8 = (u32x2*)(XG + (size_t)m * DM) + lane;
#pragma unroll
                    for (int j = 0; j < 4; ++j) o8[64 * j] = (u32x2){pk2(v[j].x, v[j].y), pk2(v[j].z, v[j].w)};
                }
            }
            GRID_BAR();
        }

        REPS(PH_INPROJ) if (IN(PH_INPROJ)) {
            PHASE_BEGIN();
            const bf16* XGg = XG + grow0 * DM; const float* ssq = SSQ1 + grow0 * 16;
            if (tid == 0) *(volatile LAS int*)(lds + 143360 + 1024) = -1;
            for (int rb = blk; rb < T / 64; rb += NBLK) {
                const int r0 = rb * 64 + 16 * (wave & 3), kh = (wave >> 2) * 512; f32x4 acc = zero4(), acc2 = zero4();
                float rsd[4];
#pragma unroll
                for (int i = 0; i < 4; ++i) rsd[i] = row_rstd(ssq + (size_t)(r0 + 4 * (lane >> 4) + i) * 16);
#pragma unroll 8
                for (int ks = 0; ks < 16; ++ks) { const bf16x8 a = gfrag_kc(XGg, DM, r0, kh + 32 * ks, lane);
                    acc = MFMA16(a, gfrag_kc(W16B, DM, 0, kh + 32 * ks, lane), acc); acc2 = MFMA16(a, gfrag_kc(W16B + 16 * DM, DM, 0, kh + 32 * ks, lane), acc2); }
                acc += acc2;
                LAS f32x4* xch = (LAS f32x4*)lds;
                if (wave >= 4) xch[(wave - 4) * 64 + lane] = acc;
                __syncthreads();
                if (wave < 4) { acc += xch[wave * 64 + lane];
#pragma unroll
                    for (int i = 0; i < 4; ++i) { const int row = r0 + 4 * (lane >> 4) + i; SP[(size_t)row * 16 + (lane & 15)] = acc[i] * rsd[i]; } }
                __syncthreads();
            }
            pg8::Gemm g{XGg, WinT, DM, DM, DM, 0, 0}; pg8::Order S; S.init(T, PW, NBLK, blk, 1);
            pg8::EpiBf16 E{(LAS float*)(lds + 143360), P, PWS, ssq, P_G / 256, FAC};
            pg8::gemm_phase<pg8::EpiBf16, GEMM_ALIGN>(lds, g, S, E);
            GRID_BAR();
        }

        REPS(PH_M0) if (IN(PH_M0)) {
            PHASE_BEGIN();
#pragma unroll 1
            for (int pass = 0; pass < 2; ++pass) {
            if ((pass ^ (blk & 1)) == 0) {
            for (int task = gw; task < GB * 4 * NCH; task += NGW) {
                const int bh = task >> 5, c = task & 31, bl = bh >> 2, h = bh & 3;
                const size_t m = (size_t)bl * SEQ + c * 64 + lane;
                const float ig = SP[m * 16 + h] + ka->in[I_AIB][l * 4 + h], fg = SP[m * 16 + 4 + h] + ka->in[I_AFB][l * 4 + h];
                const float b = wscan_add(logsigf_(fg), lane);
                const float gg = ig - b;
                const float pm = wscan_max(gg, lane);
                GBc[m * 4 + h] = b; GGc[m * 4 + h] = gg; GMT[m * 4 + h] = pm;
                if (lane == 63) { SUMB[task] = b; SUMG[task] = pm; }
            }
            for (int task = gw; task < GB * NCH * 8; task += NGW) {
                const int hd = task & 7; const size_t m = (size_t)(task >> 3) * 64 + lane;
                const float dt = softplusf_(SP[m * 16 + 8 + hd] + ka->in[I_CDTB][l * 8 + hd]);
                const float a = wscan_add(-dt * __expf(ka->in[I_CALOG][l * 8 + hd]), lane);
                DTB[m * 8 + hd] = dt; ACB[m * 8 + hd] = a;
            }
            {
                const float* cw = ka->in[I_CCW] + (size_t)l * 4 * 1024; const float* cb = ka->in[I_CCB] + (size_t)l * 1024;
                constexpr int RUN = 16;
                for (int i = gt; i < (T / RUN) * 128; i += NGT) {
                    const int rb = i >> 7, c8 = (i & 127) * 8, m0 = rb * RUN, t0 = m0 & (SEQ - 1);
                    float w[4][8], bb[8];
#pragma unroll
                    for (int e = 0; e < 8; ++e) { bb[e] = cb[c8 + e];
#pragma unroll
                        for (int j = 0; j < 4; ++j) w[j][e] = cw[j * 1024 + c8 + e]; }
                    const u32x4 zz = uzero4(); u32x4 rowv[RUN + 3];
                    { const bf16* pr = P + (size_t)(t0 >= 3 ? m0 - 3 : m0) * PWS + P_CX + c8;
#pragma unroll
                      for (int j = 0; j < 3; ++j) { const u32x4 ld = *(const u32x4*)(pr + (size_t)j * PWS); rowv[j] = (t0 >= 3) ? ld : zz; } }
#pragma unroll
                    for (int rr = 0; rr < RUN; ++rr) rowv[3 + rr] = *(const u32x4*)(P + (size_t)(m0 + rr) * PWS + P_CX + c8);
                    asm volatile("" ::: "memory");
#pragma unroll
                    for (int rr = 0; rr < RUN; ++rr) {
                        float acc[8];
#pragma unroll
                        for (int e = 0; e < 8; ++e) acc[e] = bb[e];
#pragma unroll
                        for (int j = 0; j < 4; ++j) { const u32x4 wv = rowv[rr + j];
                            acc[0] += w[j][0] * bf2f(wv.x & 0xffffu); acc[1] += w[j][1] * bf2f(wv.x >> 16); acc[2] += w[j][2] * bf2f(wv.y & 0xffffu); acc[3] += w[j][3] * bf2f(wv.y >> 16);
                            acc[4] += w[j][4] * bf2f(wv.z & 0xffffu); acc[5] += w[j][5] * bf2f(wv.z >> 16); acc[6] += w[j][6] * bf2f(wv.w & 0xffffu); acc[7] += w[j][7] * bf2f(wv.w >> 16); }
                        u32x4 o; o.x = pk2(siluf_(acc[0]), siluf_(acc[1])); o.y = pk2(siluf_(acc[2]), siluf_(acc[3])); o.z = pk2(siluf_(acc[4]), siluf_(acc[5])); o.w = pk2(siluf_(acc[6]), siluf_(acc[7]));
                        *(u32x4*)(XBC + (size_t)(m0 + rr) * 1024 + c8) = o;
                    }
                }
            }
            {
                const float* bw = ka->in[I_BCW] + (size_t)l * 3 * 512;
                constexpr int RUN = 8;
                for (int i = gt; i < (T / RUN) * 64; i += NGT) {
                    const int rb = i >> 6, c8 = (i & 63) * 8, m0 = rb * RUN, t0 = m0 & (SEQ - 1);
                    float w[3][8];
#pragma unroll
                    for (int e = 0; e < 8; ++e)
#pragma unroll
                        for (int j = 0; j < 3; ++j) w[j][e] = bw[j * 512 + c8 + e];
                    const u32x4 zz = uzero4(); u32x4 av[RUN + 2], bv[RUN + 2], gv[RUN];
                    { const bf16* pr = P + (size_t)(t0 >= 2 ? m0 - 2 : m0) * PWS;
#pragma unroll
                      for (int j = 0; j < 2; ++j) { const u32x4 la = *(const u32x4*)(pr + (size_t)j * PWS + P_BC + c8), lb = *(const u32x4*)(pr + (size_t)j * PWS + P_BX + c8); av[j] = (t0 >= 2) ? la : zz; bv[j] = (t0 >= 2) ? lb : zz; } }
#pragma unroll
                    for (int rr = 0; rr < RUN; ++rr) { const bf16* pr = P + (size_t)(m0 + rr) * PWS; av[2 + rr] = *(const u32x4*)(pr + P_BC + c8); bv[2 + rr] = *(const u32x4*)(pr + P_BX + c8); gv[rr] = *(const u32x4*)(pr + P_BB + c8); }
                    asm volatile("" ::: "memory");
                    float pw[3][8];
#pragma unroll
                    for (int j = 0; j < 2; ++j) { const u32x4 a = av[j], b = bv[j];
                        pw[j][0] = bf2f(a.x & 0xffffu) * bf2f(b.x & 0xffffu); pw[j][1] = bf2f(a.x >> 16) * bf2f(b.x >> 16); pw[j][2] = bf2f(a.y & 0xffffu) * bf2f(b.y & 0xffffu); pw[j][3] = bf2f(a.y >> 16) * bf2f(b.y >> 16);
                        pw[j][4] = bf2f(a.z & 0xffffu) * bf2f(b.z & 0xffffu); pw[j][5] = bf2f(a.z >> 16) * bf2f(b.z >> 16); pw[j][6] = bf2f(a.w & 0xffffu) * bf2f(b.w & 0xffffu); pw[j][7] = bf2f(a.w >> 16) * bf2f(b.w >> 16); }
#pragma unroll
                    for (int rr = 0; rr < RUN; ++rr) {
                        const u32x4 a = av[2 + rr], b = bv[2 + rr], g = gv[rr];
                        pw[2][0] = bf2f(a.x & 0xffffu) * bf2f(b.x & 0xffffu); pw[2][1] = bf2f(a.x >> 16) * bf2f(b.x >> 16); pw[2][2] = bf2f(a.y & 0xffffu) * bf2f(b.y & 0xffffu); pw[2][3] = bf2f(a.y >> 16) * bf2f(b.y >> 16);
                        pw[2][4] = bf2f(a.z & 0xffffu) * bf2f(b.z & 0xffffu); pw[2][5] = bf2f(a.z >> 16) * bf2f(b.z >> 16); pw[2][6] = bf2f(a.w & 0xffffu) * bf2f(b.w & 0xffffu); pw[2][7] = bf2f(a.w >> 16) * bf2f(b.w >> 16);
                        float acc[8];
#pragma unroll
                        for (int e = 0; e < 8; ++e) acc[e] = w[0][e] * pw[0][e] + w[1][e] * pw[1][e] + w[2][e] * pw[2][e];
                        u32x4 o; o.x = pk2(acc[0] * bf2f(g.x & 0xffffu), acc[1] * bf2f(g.x >> 16)); o.y = pk2(acc[2] * bf2f(g.y & 0xffffu), acc[3] * bf2f(g.y >> 16));
                        o.z = pk2(acc[4] * bf2f(g.z & 0xffffu), acc[5] * bf2f(g.z >> 16)); o.w = pk2(acc[6] * bf2f(g.w & 0xffffu), acc[7] * bf2f(g.w >> 16));
                        *(u32x4*)(YCAT + (size_t)(m0 + rr) * YW + 512 + c8) = o;
#pragma unroll
                        for (int e = 0; e < 8; ++e) { pw[0][e] = pw[1][e]; pw[1][e] = pw[2][e]; }
                    }
                }
            }
            } else {
            __syncthreads();
            {
            LAS bf16* Qs = (LAS bf16*)lds; LAS bf16* Ks = Qs + 128 * 136; LAS bf16* Vs = Ks + 64 * 136; LAS bf16* Aw = Vs + 64 * 136 + wave * (16 * 72);
            const int r = lane & 15, g4 = lane >> 4;
            for (int u = blk; u < GB * 4 * 16; u += NBLK) {
                const int bl = u >> 6, h = (u >> 4) & 3, qt = u & 15; const size_t mb = (size_t)bl * SEQ; const int q0 = qt * 128;
                volatile LAS unsigned* FLG = (volatile LAS unsigned*)(lds + MISC_OFF + 128);
                int par = 0;
                __syncthreads();
                if (lane == 0) { FLG[wave] = 0u; FLG[8 + wave] = 0u; }
                for (int i = tid; i < 2048; i += NTHR) { const int s = i >> 4, c8 = i & 15; *(LAS u32x4*)(Qs + s * 136 + c8 * 8) = *(const u32x4*)(P + (mb + q0 + s) * PWS + P_SQ + h * 128 + c8 * 8); }
                f32x4 O[8];
#pragma unroll
                for (int d = 0; d < 8; ++d) O[d] = zero4();
                float racc = 0.f; const int tq = q0 + 16 * wave + r;
                u32x4 kreg[2], vreg[2];
                { const int s0f = (2 * qt + 1) * 64;
#pragma unroll
                  for (int k2 = 0; k2 < 2; ++k2) { const int i = tid + 512 * k2, s = i >> 4, c8 = i & 15; const bf16* pr = P + (mb + s0f + s) * PWS + h * 128 + c8 * 8; kreg[k2] = *(const u32x4*)(pr + P_SK); vreg[k2] = *(const u32x4*)(pr + P_SV); } }
                for (int kt = 2 * qt + 1; kt >= 0; --kt) {
                    const int s0 = kt * 64;
                    __syncthreads();
                    { unsigned alldone = 1u;
#pragma unroll
                      for (int w8 = 0; w8 < 8; ++w8) alldone &= FLG[par * 8 + w8];
                      if (__builtin_amdgcn_readfirstlane((int)alldone)) break; }
#pragma unroll
                    for (int k2 = 0; k2 < 2; ++k2) { const int i = tid + 512 * k2, s = i >> 4, c8 = i & 15; *(LAS u32x4*)(Ks + s * 136 + c8 * 8) = kreg[k2]; *(LAS u32x4*)(Vs + s * 136 + c8 * 8) = vreg[k2]; }
                    if (kt > 0) {
#pragma unroll
                        for (int k2 = 0; k2 < 2; ++k2) { const int i = tid + 512 * k2, s = i >> 4, c8 = i & 15; const bf16* pr = P + (mb + s0 - 64 + s) * PWS + h * 128 + c8 * 8; kreg[k2] = *(const u32x4*)(pr + P_SK); vreg[k2] = *(const u32x4*)(pr + P_SV); } }
                    __syncthreads();
                    if (s0 < q0 + 16 * wave + 15) {
                        f32x4 z[4];
#pragma unroll
                        for (int j = 0; j < 4; ++j) z[j] = zero4();
#pragma unroll
                        for (int ks = 0; ks < 4; ++ks) { const bf16x8 fq = frag_kc(Qs, 136, 16 * wave, 32 * ks, lane);
#pragma unroll
                            for (int j = 0; j < 4; ++j) z[j] = MFMA16(frag_kc(Ks, 136, 16 * j, 32 * ks, lane), fq, z[j]); }
                        float ls[4][4], x[4][4], tsum[4];
#pragma unroll
                        for (int j = 0; j < 4; ++j) { float tj = 0.f;
#pragma unroll
                            for (int i = 0; i < 4; ++i) { const int s = s0 + 16 * j + 4 * g4 + i; const float zz = z[j][i] * 0.08838834764831845f;
                                const float l1 = fminf(zz, 0.f) - __logf(1.f + __expf(-fabsf(zz)));
                                ls[j][i] = l1; x[j][i] = (s < tq) ? (l1 - zz) : 0.f; tj += x[j][i]; }
                            tsum[j] = tj; }
                        float above[4], tot[4];
#pragma unroll
                        for (int j = 0; j < 4; ++j) { const float y1 = __shfl_xor(tsum[j], 16), y2 = __shfl_xor(tsum[j], 32), y3 = __shfl_xor(tsum[j], 48);
                            tot[j] = tsum[j] + y1 + y2 + y3;
                            above[j] = (g4 == 0) ? (y1 + y2 + y3) : (g4 == 1) ? (y2 + y3) : (g4 == 2) ? y1 : 0.f; }
                        float hi = racc;
#pragma unroll
                        for (int j = 3; j >= 0; --j) { float run = hi + above[j]; float av[4];
#pragma unroll
                            for (int i = 3; i >= 0; --i) { const int s = s0 + 16 * j + 4 * g4 + i; av[i] = (s < tq) ? __expf(ls[j][i] + run) : 0.f; run += x[j][i]; }
                            *(LAS u32x2*)(Aw + r * 72 + 16 * j + 4 * g4) = (u32x2){pk2(av[0], av[1]), pk2(av[2], av[3])};
                            hi += tot[j]; }
                        racc = hi;
                        LDS_WAIT(); asm volatile("" ::: "memory");
#pragma unroll
                        for (int ks = 0; ks < 2; ++ks) { const bf16x8 fa = frag_kc(Aw, 72, 0, 32 * ks, lane);
#pragma unroll
                            for (int d = 0; d < 8; ++d) O[d] = MFMA16(fa, frag_ks(Vs, 136, 16 * d, 32 * ks, lane), O[d]); }
                    }
                    par ^= 1;
                    { const bool wd = __all(racc < -104.f); if (lane == 0) FLG[par * 8 + wave] = wd ? 1u : 0u; }
                }
#pragma unroll
                for (int d = 0; d < 8; ++d)
#pragma unroll
                    for (int i = 0; i < 4; ++i) YCAT[(mb + q0 + 16 * wave + 4 * g4 + i) * YW + 1536 + h * 128 + 16 * d + r] = (bf16)f2bf(O[d][i]);
            }
            }
            }
            }
            GRID_BAR();
        }

        REPS(PH_M1) if (IN(PH_M1)) {
            PHASE_BEGIN();
            constexpr int NUA = GB * 4 * NCH, NUC = GB * NCH;
            LAS unsigned char* RAW = lds + 32768;
#define M1_DMA(uu) do { const int bh_ = (uu) >> 5, c_ = (uu) & 31, bl_ = bh_ >> 2, h_ = bh_ & 3; const size_t m0_ = (size_t)bl_ * SEQ + c_ * 64; \
                _Pragma("unroll") for (int t_ = 0; t_ < 3; ++t_) { const int j_ = wave * 3 + t_; \
                    const bf16* src_ = (j_ < 16) ? P + (m0_ + ((j_ * 64 + lane) >> 4)) * PWS + P_AV + h_ * 128 + ((j_ * 64 + lane) & 15) * 8 \
                                                 : P + (m0_ + (((j_ - 16) * 64 + lane) >> 3)) * PWS + P_AK + h_ * 64 + (((j_ - 16) * 64 + lane) & 7) * 8; \
                    __builtin_amdgcn_global_load_lds((const unsigned*)src_, (LAS unsigned*)(RAW + j_ * 1024), 16, 0, 0); } \
                if (wave < 4) { const float* s4_ = (wave == 0) ? SUMB + bh_ * 32 + (lane & 31) : (wave == 1) ? SUMG + bh_ * 32 + (lane & 31) : (wave == 2) ? GGc + (m0_ + lane) * 4 + h_ : GBc + (m0_ + 63) * 4 + h_; \
                    __builtin_amdgcn_global_load_lds((const unsigned*)s4_, (LAS unsigned*)(RAW + 24576 + wave * 256), 4, 0, 0); } } while (0)
            if (blk < NUA) M1_DMA(blk);
            for (int u = blk; u < NUA + NUC; u += NBLK) {
                if (u < NUA) {
                    const int ua = u, bh = ua >> 5, c = ua & 31;
                    LAS bf16* VP = (LAS bf16*)lds; LAS bf16* WK = (LAS bf16*)(lds + 64 * 152 * 2); const LAS float* SC = (const LAS float*)(RAW + 24576);
                    asm volatile("s_waitcnt vmcnt(0)" ::: "memory"); __syncthreads();
                    float bLj = 0.f, gmj = -1e30f;
                    if (lane < 32) { bLj = SC[lane]; gmj = SC[64 + lane]; }
                    float pa = bLj, pq = gmj + bLj;
#pragma unroll
                    for (int o = 1; o < 32; o <<= 1) { const float ta = __shfl_up(pa, o), tq = __shfl_up(pq, o); if (lane >= o) { pq = fmaxf(tq + pa, pq); pa = ta + pa; } }
                    const float mall = fmaxf(pa, pq);
                    const float mnew = __shfl(mall, c), mprev = (c == 0) ? 0.f : __shfl(mall, (c + 63) & 63);
                    const float bL = SC[192];
                    if (tid == 0) { MCAR[ua] = mprev; MNEW[ua] = mnew; MSC[ua] = __expf(bL + mprev - mnew); }
#pragma unroll
                    for (int k = 0; k < 2; ++k) { const int i = tid + k * NTHR, s = i >> 4, c8 = i & 15; *(LAS u32x4*)(VP + s * 152 + c8 * 8) = *(const LAS u32x4*)(RAW + i * 16); }
                    if (tid < 64) { *(LAS u32x4*)(VP + tid * 152 + 128) = uone4(); *(LAS u32x4*)(VP + tid * 152 + 136) = uzero4(); }
                    { const int s = tid >> 3, c8 = tid & 7; const float w = __expf(bL + SC[128 + s] - mnew);
                      *(LAS u32x4*)(WK + s * 72 + c8 * 8) = scale8(*(const LAS u32x4*)(RAW + 16384 + tid * 16), w); }
                    __syncthreads();
                    if (u + NBLK < NUA) M1_DMA(u + NBLK);
                    for (int ti = wave; ti < 36; ti += NWAVES) { const int mt = ti >> 2, nt = ti & 3; f32x4 acc = zero4();
#pragma unroll
                        for (int ks = 0; ks < 2; ++ks) acc = MFMA16(frag_ks(VP, 152, 16 * mt, 32 * ks, lane), frag_ks(WK, 72, 16 * nt, 32 * ks, lane), acc);
                        bf16* d = DC + (size_t)ua * 9216 + (16 * mt + 4 * (lane >> 4)) * 64 + 16 * nt + (lane & 15);
#pragma unroll
                        for (int i = 0; i < 4; ++i) d[i * 64] = (bf16)f2bf(acc[i]); }
                } else {
                    __syncthreads();
                    const int uc = u - NUA, bl = uc >> 5, c = uc & 31, hd = wave, gi = hd >> 2; const size_t m0 = (size_t)bl * SEQ + c * 64;
                    LAS bf16* XW = (LAS bf16*)(lds + hd * (64 * 72 * 2)); LAS bf16* BMs = (LAS bf16*)(lds + 8 * 64 * 72 * 2);
                    const float alast = ACB[(m0 + 63) * 8 + hd];
#pragma unroll
                    for (int k = 0; k < 8; ++k) { const int i = lane + 64 * k, s = i >> 3, c8 = i & 7; const float wd = __expf(alast - ACB[(m0 + s) * 8 + hd]) * DTB[(m0 + s) * 8 + hd];
                        *(LAS u32x4*)(XW + s * 72 + c8 * 8) = scale8(*(const u32x4*)(XBC + (m0 + s) * 1024 + hd * 64 + c8 * 8), wd); }
                    for (int i = tid; i < 2048; i += NTHR) { const int g2 = i >> 10, rem = i & 1023, s = rem >> 4, c8 = rem & 15;
                        *(LAS u32x4*)(BMs + g2 * (64 * 136) + s * 136 + c8 * 8) = *(const u32x4*)(XBC + (m0 + s) * 1024 + 512 + g2 * 128 + c8 * 8); }
                    __syncthreads();
                    const LAS bf16* BMg = BMs + gi * (64 * 136);
                    for (int pt = 0; pt < 4; ++pt) { f32x4 acc[8];
#pragma unroll
                        for (int n = 0; n < 8; ++n) acc[n] = zero4();
#pragma unroll
                        for (int ks = 0; ks < 2; ++ks) { const bf16x8 a = frag_ks(XW, 72, 16 * pt, 32 * ks, lane);
#pragma unroll
                            for (int n = 0; n < 8; ++n) acc[n] = MFMA16(a, frag_ks(BMg, 136, 16 * n, 32 * ks, lane), acc[n]); }
                        bf16* d = DH + ((size_t)(uc * 8 + hd) * 64 + 16 * pt + 4 * (lane >> 4)) * 128 + (lane & 15);
#pragma unroll
                        for (int n = 0; n < 8; ++n)
#pragma unroll
                            for (int i = 0; i < 4; ++i) d[i * 128 + 16 * n] = (bf16)f2bf(acc[n][i]); }
                    __syncthreads();
                }
            }
            GRID_BAR();
        }

#undef M1_DMA
        REPS(PH_M2) if (IN(PH_M2)) {
            PHASE_BEGIN();
            constexpr int NA = GB * 4 * 2304, NC = GB * 8 * 2048;
            for (int i = gt; i < NA + NC; i += NGT) {
                f32x4 st = zero4();
                if (i < NA) { const int bh = i / 2304, e = (i - bh * 2304) * 4; const bf16* dp = DC + (size_t)bh * NCH * 9216 + e; bf16* cp = CS + (size_t)bh * NCH * 9216 + e; const float* sp = MSC + (size_t)bh * NCH;
#pragma unroll 1
                    for (int c0 = 0; c0 < NCH; c0 += 4) { u32x2 dw[4]; float sc[4];
#pragma unroll
                        for (int k = 0; k < 4; ++k) { dw[k] = *(const u32x2*)(dp + (size_t)(c0 + k) * 9216); sc[k] = sp[c0 + k]; }
#pragma unroll
                        for (int k = 0; k < 4; ++k) { *(u32x2*)(cp + (size_t)(c0 + k) * 9216) = (u32x2){pk2(st.x, st.y), pk2(st.z, st.w)};
                            st = st * sc[k] + (f32x4){bf2f(dw[k].x & 0xffffu), bf2f(dw[k].x >> 16), bf2f(dw[k].y & 0xffffu), bf2f(dw[k].y >> 16)}; } }
                } else { const int j = i - NA, bhd = j >> 11, e = (j & 2047) * 4, bl = bhd >> 3, hd = bhd & 7;
                    const bf16* dp = DH + ((size_t)(bl * NCH) * 8 + hd) * 8192 + e; bf16* cp = HS + ((size_t)(bl * NCH) * 8 + hd) * 8192 + e; const float* ap = ACB + ((size_t)bl * SEQ + 63) * 8 + hd;
#pragma unroll 1
                    for (int c0 = 0; c0 < NCH; c0 += 4) { u32x2 dw[4]; float sc[4];
#pragma unroll
                        for (int k = 0; k < 4; ++k) { dw[k] = *(const u32x2*)(dp + (size_t)(c0 + k) * 8 * 8192); sc[k] = __expf(ap[(size_t)(c0 + k) * 64 * 8]); }
#pragma unroll
                        for (int k = 0; k < 4; ++k) { *(u32x2*)(cp + (size_t)(c0 + k) * 8 * 8192) = (u32x2){pk2(st.x, st.y), pk2(st.z, st.w)};
                            st = st * sc[k] + (f32x4){bf2f(dw[k].x & 0xffffu), bf2f(dw[k].x >> 16), bf2f(dw[k].y & 0xffffu), bf2f(dw[k].y >> 16)}; } }
                }
            }
            GRID_BAR();
        }

        REPS(PH_M3) if (IN(PH_M3)) {
            PHASE_BEGIN();
            constexpr int NUA = GB * 4 * NCH, NUC = 2 * GB * NCH;
            for (int u = blk; u < NUA + NUC; u += NBLK) {
                const int r = lane & 15, g4 = lane >> 4;
                if (u < NUA) {
                    const int ua = u, bh = ua >> 5, c = ua & 31, bl = bh >> 2, h = bh & 3; const size_t m0 = (size_t)bl * SEQ + c * 64;
                    LAS bf16* Qs = (LAS bf16*)lds; LAS bf16* Ks = Qs + 64 * 72; LAS bf16* VP = Ks + 64 * 72; LAS bf16* CST = VP + 64 * 152; LAS bf16* SMT = CST + 144 * 72; LAS bf16* AOT = SMT + 64 * 72;
                    LAS float* GS = (LAS float*)(AOT + 64 * 136);
                    LAS float* SSQ = GS + 256;
                    const float mcar = MCAR[ua];
                    { const int s = tid >> 3, c8 = tid & 7; const bf16* pr = P + (m0 + s) * PWS + h * 64 + c8 * 8;
                      *(LAS u32x4*)(Qs + s * 72 + c8 * 8) = *(const u32x4*)(pr + P_AQ); *(LAS u32x4*)(Ks + s * 72 + c8 * 8) = *(const u32x4*)(pr + P_AK); }
                    for (int i = tid; i < 1024; i += NTHR) { const int s = i >> 4, c8 = i & 15; const bf16* pr = P + (m0 + s) * PWS + h * 128 + c8 * 8;
                        *(LAS u32x4*)(VP + s * 152 + c8 * 8) = *(const u32x4*)(pr + P_AV); *(LAS u32x4*)(AOT + s * 136 + c8 * 8) = *(const u32x4*)(pr + P_AO); }
                    if (tid < 64) { *(LAS u32x4*)(VP + tid * 152 + 128) = uone4(); *(LAS u32x4*)(VP + tid * 152 + 136) = uzero4(); }
                    for (int i = tid; i < 1152; i += NTHR) { const int dv = i >> 3, c8 = i & 7; *(LAS u32x4*)(CST + dv * 72 + c8 * 8) = *(const u32x4*)(CS + (size_t)ua * 9216 + dv * 64 + c8 * 8); }
                    if (tid < 192) { const int arr = tid >> 6, s = tid & 63; const float* src = (arr == 0) ? GBc : (arr == 1) ? GGc : GMT; float v = src[(m0 + s) * 4 + h];
                        if (arr == 2) v = GBc[(m0 + s) * 4 + h] + fmaxf(mcar, v);
                        GS[arr * 64 + s] = v; }
                    __syncthreads();
#pragma unroll
                    for (int q2 = 0; q2 < 2; ++q2) { const int ti = 2 * wave + q2, tt = ti >> 2, st = ti & 3;
                        f32x4 acc = zero4();
                        if (st <= tt) {
#pragma unroll
                            for (int ks = 0; ks < 2; ++ks) acc = MFMA16(frag_kc(Qs, 72, 16 * tt, 32 * ks, lane), frag_kc(Ks, 72, 16 * st, 32 * ks, lane), acc);
                            const int s = 16 * st + r; const float gs = GS[64 + s];
#pragma unroll
                            for (int i = 0; i < 4; ++i) { const int t = 16 * tt + 4 * g4 + i; const float e = GS[t] - GS[128 + t] + gs;
                                acc[i] = (s <= t) ? acc[i] * 0.125f * __expf(e) : 0.f; }
                        }
                        *(LAS u32x2*)(SMT + (16 * st + r) * 72 + 16 * tt + 4 * g4) = (u32x2){pk2(acc[0], acc[1]), pk2(acc[2], acc[3])}; }
                    __syncthreads();
                    const int tt = wave & 3, half = wave >> 2;
                    f32x4 a1[5], a2[5];
#pragma unroll
                    for (int j = 0; j < 5; ++j) { a1[j] = zero4(); a2[j] = zero4(); }
#pragma unroll
                    for (int ks = 0; ks < 2; ++ks) { const bf16x8 fa1 = frag_ks(SMT, 72, 16 * tt, 32 * ks, lane), fa2 = frag_kc(Qs, 72, 16 * tt, 32 * ks, lane);
#pragma unroll
                        for (int j = 0; j < 5; ++j) { const int dvt = (j < 4) ? half * 4 + j : 8;
                            a1[j] = MFMA16(fa1, frag_ks(VP, 152, 16 * dvt, 32 * ks, lane), a1[j]);
                            a2[j] = MFMA16(fa2, frag_kc(CST, 72, 16 * dvt, 32 * ks, lane), a2[j]); } }
                    float hv[4][4], ssq[4];
#pragma unroll
                    for (int i = 0; i < 4; ++i) { const int t = 16 * tt + 4 * g4 + i; const float b = GS[t], mt = GS[128 + t];
                        const float is = 0.125f * __expf(b + mcar - mt);
                        float den = a1[4][i] + is * a2[4][i]; den = __shfl(den, lane & 48);
                        const float dn = __builtin_amdgcn_rcpf(fmaxf(fabsf(den), __expf(-mt))); float q = 0.f;
#pragma unroll
                        for (int j = 0; j < 4; ++j) { const float v = (a1[j][i] + is * a2[j][i]) * dn; hv[j][i] = v; q += v * v; }
                        q += __shfl_xor(q, 1); q += __shfl_xor(q, 2); q += __shfl_xor(q, 4); q += __shfl_xor(q, 8); ssq[i] = q; }
                    if (r == 0) {
#pragma unroll
                        for (int i = 0; i < 4; ++i) SSQ[half * 64 + 16 * tt + 4 * g4 + i] = ssq[i]; }
                    __syncthreads();
                    const float* ng = ka->in[I_ANG] + (size_t)l * 512 + h * 128;
#pragma unroll
                    for (int i = 0; i < 4; ++i) { const int t = 16 * tt + 4 * g4 + i; const float rstd = rsqrtf((SSQ[t] + SSQ[64 + t]) * (1.f / 128.f) + EPS);
#pragma unroll
                        for (int j = 0; j < 4; ++j) { const int dv = 16 * (half * 4 + j) + r; LAS bf16* op = AOT + t * 136 + dv;
                            *op = (bf16)f2bf(sigmoidf_(bf2f(*op)) * hv[j][i] * rstd * ng[dv]); } }
                    __syncthreads();
                    for (int i = tid; i < 1024; i += NTHR) { const int s = i >> 4, c8 = i & 15; *(u32x4*)(YCAT + (m0 + s) * YW + h * 128 + c8 * 8) = *(const LAS u32x4*)(AOT + s * 136 + c8 * 8); }
                    __syncthreads();
                } else {
                    const int uc2 = u - NUA, bl = uc2 >> 6, c = (uc2 >> 1) & 31, gi = uc2 & 1, hl = wave & 3, th = wave >> 2, hd = gi * 4 + hl; const size_t m0 = (size_t)bl * SEQ + c * 64;
                    LAS bf16* XHs = (LAS bf16*)lds;
                    LAS bf16* HTs = (LAS bf16*)(lds + 36864);
                    LAS bf16* BMg = (LAS bf16*)(lds + 36864 + 69632);
                    LAS bf16* MTt = (LAS bf16*)(lds + 36864 + 69632 + 17408 + wave * 3072);
                    LAS float* ADs = (LAS float*)(lds + 36864 + 69632 + 17408 + 24576);
                    const bf16* Xb = XBC + m0 * 1024;
                    for (int i = tid; i < 2048; i += NTHR) { const int h4 = i >> 9, rem = i & 511, s = rem >> 3, c8 = rem & 7;
                        *(LAS u32x4*)(XHs + h4 * (64 * 72) + s * 72 + c8 * 8) = *(const u32x4*)((Xb + gi * 256) + (unsigned)(s * 1024 + h4 * 64 + c8 * 8)); }
                    { const bf16* Hb = HS + (size_t)((bl * NCH + c) * 8 + gi * 4) * 8192;
                      for (int i = tid; i < 4096; i += NTHR) { const int h4 = i >> 10, rem = i & 1023, p = rem >> 4, c8 = rem & 15;
                        *(LAS u32x4*)(HTs + h4 * (64 * 136) + p * 136 + c8 * 8) = *(const u32x4*)(Hb + (unsigned)(h4 * 8192 + p * 128 + c8 * 8)); } }
                    for (int i = tid; i < 1024; i += NTHR) { const int s = i >> 4, c8 = i & 15; *(LAS u32x4*)(BMg + s * 136 + c8 * 8) = *(const u32x4*)((Xb + 512 + gi * 128) + (unsigned)(s * 1024 + c8 * 8)); }
                    { const int h4 = tid >> 7, arr = (tid >> 6) & 1, s = tid & 63; const float* src = arr ? DTB : ACB; ADs[tid] = (src + m0 * 8 + gi * 4)[(unsigned)(s * 8 + h4)]; }
                    const LAS bf16* XH = XHs + hl * (64 * 72); const LAS bf16* HT = HTs + hl * (64 * 136); const LAS float* AD = ADs + hl * 128;
                    const bf16* Cm = Xb + 768 + gi * 128; const bf16* Zp = P + m0 * PWS + P_CZ + hd * 64; const unsigned zlane = (unsigned)(4 * g4 * PWS + r), ylane = (unsigned)(4 * g4 * YW + r);
                    bf16* Yp = YCAT + m0 * YW + 1024 + hd * 64; float* Sp = SSQC + m0 * 8 + hd;
                    bf16x8 fcn[4];
#pragma unroll
                    for (int ks = 0; ks < 4; ++ks) fcn[ks] = gfrag_kc(Cm, 1024, 16 * th, 32 * ks, lane);
                    const float dsk = ka->in[I_CDSKIP][l * 8 + hd];
                    __syncthreads();
#pragma unroll 1
                    for (int k2 = 0; k2 < 2; ++k2) { const int tt = k2 ? 3 - th : th;
                        bf16x8 fcm[4]; unsigned short zc[4][4];
#pragma unroll
                        for (int ks = 0; ks < 4; ++ks) fcm[ks] = fcn[ks];
#pragma unroll
                        for (int p = 0; p < 4; ++p)
#pragma unroll
                            for (int i = 0; i < 4; ++i) zc[p][i] = (Zp + (size_t)(16 * tt + i) * PWS + 16 * p)[zlane];
#pragma unroll
                        for (int ks = 0; ks < 4; ++ks) fcn[ks] = gfrag_kc(Cm, 1024, 16 * (3 - th), 32 * ks, lane);
                        float at[4];
#pragma unroll
                        for (int i = 0; i < 4; ++i) at[i] = AD[16 * tt + 4 * g4 + i];
#pragma unroll 1
                        for (int st = 0; st <= tt; ++st) { f32x4 acc = zero4();
#pragma unroll
                            for (int ks = 0; ks < 4; ++ks) acc = MFMA16(fcm[ks], frag_kc(BMg, 136, 16 * st, 32 * ks, lane), acc);
                            const int s = 16 * st + r; const float as = AD[s], dts = AD[64 + s];
#pragma unroll
                            for (int i = 0; i < 4; ++i) { const int t = 16 * tt + 4 * g4 + i; acc[i] = (s <= t) ? acc[i] * __expf(at[i] - as) * dts : 0.f; if (s == t) acc[i] += dsk; }
                            *(LAS u32x2*)(MTt + (16 * st + r) * 24 + 4 * g4) = (u32x2){pk2(acc[0], acc[1]), pk2(acc[2], acc[3])}; }
                        if ((tt & 1) == 0) *(LAS u32x2*)(MTt + (16 * (tt + 1) + r) * 24 + 4 * g4) = (u32x2){uzero4().x, uzero4().y};
                        LDS_WAIT(); asm volatile("" ::: "memory");
                        f32x4 ad[4], ao[4];
#pragma unroll
                        for (int p = 0; p < 4; ++p) { ad[p] = zero4(); ao[p] = zero4(); }
#pragma unroll 1
                        for (int ks = 0; ks <= (tt >> 1); ++ks) { const bf16x8 fa = frag_ks(MTt, 24, 0, 32 * ks, lane);
#pragma unroll
                            for (int p = 0; p < 4; ++p) ad[p] = MFMA16(fa, frag_ks(XH, 72, 16 * p, 32 * ks, lane), ad[p]); }
#pragma unroll
                        for (int ks = 0; ks < 4; ++ks)
#pragma unroll
                            for (int p = 0; p < 4; ++p) ao[p] = MFMA16(fcm[ks], frag_kc(HT, 136, 16 * p, 32 * ks, lane), ao[p]);
#pragma unroll
                        for (int i = 0; i < 4; ++i) { const float ea = __expf(at[i]); float q = 0.f;
#pragma unroll
                            for (int p = 0; p < 4; ++p) { const float y = (ad[p][i] + ea * ao[p][i]) * siluf_(bf2f(zc[p][i])); q += y * y;
                                (Yp + (size_t)(16 * tt + i) * YW + 16 * p)[ylane] = (bf16)f2bf(y); }
                            q += __shfl_xor(q, 1); q += __shfl_xor(q, 2); q += __shfl_xor(q, 4); q += __shfl_xor(q, 8);
                            if (r == 0) (Sp + (16 * tt + i) * 8)[(unsigned)(32 * g4)] = q; }
                        LDS_WAIT(); asm volatile("" ::: "memory");
                    }
                    __syncthreads();
                }
            }
            GRID_BAR();
        }

        REPS(PH_LIFT) if (IN(PH_LIFT)) {
            PHASE_BEGIN();
            pg8::Gemm g{YCAT, WliftT, 512, YW, 512, (size_t)512 * 2, (size_t)DM * 512 * 2}; pg8::Order S; S.init(T, DM, NBLK, blk, 4);
            pg8::EpiLift E{FAC, MB + (size_t)(grp % FG) * T * DM, DM, SSQC};
            pg8::gemm_phase<pg8::EpiLift, GEMM_ALIGN>(lds, g, S, E);
            GRID_BAR();
        }
        REPS(PH_OUT) if (IN(PH_OUT) && (grp % FG) == FG - 1) {
            PHASE_BEGIN();
            const size_t prow0 = grow0 - (size_t)(FG - 1) * T;
            pg8::Gemm g{MB, WoutT, DM, DM, DM, 0, 0}; pg8::Order S; S.init(FG * T, DM, NBLK, blk, 1);
            pg8::EpiResid E{XG + prow0 * DM, DM, SSQ2};
            pg8::gemm_phase<pg8::EpiResid, GEMM_ALIGN>(lds, g, S, E);
            GRID_BAR();
        }
        REPS(PH_UP) if (IN(PH_UP) && (grp % FG) == FG - 1) {
            PHASE_BEGIN();
            const size_t prow0 = grow0 - (size_t)(FG - 1) * T;
            pg8::Gemm g{XG + prow0 * DM, WupT, DM, DM, DM, 0, 0}; pg8::Order S; S.init(FG * T, DFF2, NBLK, blk, 1, 8);
            if (tid == 0) *(volatile LAS int*)(lds + 131072 + 12288 + 1024) = -1;
            pg8::EpiConvAct E{ACT, SSQ2, ka->in[I_FCW] + (size_t)l * 3 * DFF2, ka->in[I_FCB] + (size_t)l * DFF2, RAWH, lds + 131072, DFF2 / 256};
            pg8::gemm_phase<pg8::EpiConvAct, GEMM_ALIGN>(lds, g, S, E);
            GRID_BAR();
        }
        REPS(PH_DOWN) if (IN(PH_DOWN) && (grp % FG) == FG - 1) {
            PHASE_BEGIN();
            const size_t prow0 = grow0 - (size_t)(FG - 1) * T;
            pg8::Gemm g{ACT, WdownT, DFF, 128, DFF, 0, 0, 65536, (size_t)22 * 65536}; pg8::Order S; S.init(FG * T, DM, NBLK, blk, 1);
            {
                const float* fw = ka->in[I_FCW] + (size_t)l * 3 * DFF2; const float* fb = ka->in[I_FCB] + (size_t)l * DFF2;
                pg8::Unit uu;
                for (int i = 0; S.next(i, uu); ++i) { const int pm = uu.pm; if ((pm & 7) == 0) continue;
                    for (int ch = tid; ch < DFF; ch += NTHR) { const int tp = ch >> 7, j = ch & 127;
                        const float* own = RAWH + (size_t)(pm * 22 + tp) * 1024; const float* prv = RAWH + (size_t)((pm - 1) * 22 + tp) * 1024;
                        const float g254 = prv[2 * 256 + j], g255 = prv[3 * 256 + j], g0 = own[j], g1 = own[256 + j];
                        const float u254 = prv[2 * 256 + 128 + j], u255 = prv[3 * 256 + 128 + j], u0 = own[128 + j], u1 = own[256 + 128 + j];
                        const float wg0 = fw[ch], wg1 = fw[DFF2 + ch], wg2 = fw[2 * DFF2 + ch], wu0 = fw[DFF + ch], wu1 = fw[DFF2 + DFF + ch], wu2 = fw[2 * DFF2 + DFF + ch], bg = fb[ch], bu = fb[DFF + ch];
                        ACT[((size_t)(pm * 22 + tp) * 256) * 128 + j] = (bf16)f2bf(siluf_(bg + wg0 * g254 + wg1 * g255 + wg2 * g0) * (bu + wu0 * u254 + wu1 * u255 + wu2 * u0));
                        ACT[((size_t)(pm * 22 + tp) * 256 + 1) * 128 + j] = (bf16)f2bf(siluf_(bg + wg0 * g255 + wg1 * g0 + wg2 * g1) * (bu + wu0 * u255 + wu1 * u0 + wu2 * u1)); } }
                asm volatile("s_waitcnt vmcnt(0)" ::: "memory"); __syncthreads();
            }
            pg8::EpiResid E{XG + prow0 * DM, DM, SSQ1 + prow0 * 16};
            pg8::gemm_phase<pg8::EpiResid, GEMM_ALIGN>(lds, g, S, E);
            GRID_BAR();
        }
        REPS(PH_FINAL) if (IN(PH_FINAL) && l == DEPTH - 1 && (grp % FG) == FG - 1) {
            PHASE_BEGIN();
            const size_t prow0 = grow0 - (size_t)(FG - 1) * T;
            const float* gain = ka->in[I_FING];
            f32x4 gv[4];
#pragma unroll
            for (int j = 0; j < 4; ++j) gv[j] = ((const f32x4*)gain)[lane + 64 * j];
            for (int m = gw; m < FG * T; m += NGW) {
                const u32x2* xr = (const u32x2*)(XG + (prow0 + m) * DM) + lane;
                f32x4 v[4]; float sq = 0.f;
#pragma unroll
                for (int j = 0; j < 4; ++j) { const u32x2 w = xr[64 * j]; v[j] = (f32x4){bf2f(w.x & 0xffffu), bf2f(w.x >> 16), bf2f(w.y & 0xffffu), bf2f(w.y >> 16)};
                    sq += (v[j].x * v[j].x + v[j].y * v[j].y) + (v[j].z * v[j].z + v[j].w * v[j].w); }
                const float rstd = rsqrtf(wave_sum(sq) * (1.f / DM) + EPS);
                f32x4* orow = (f32x4*)(ka->out + (prow0 + m) * DM) + lane;
#pragma unroll
                for (int j = 0; j < 4; ++j) orow[64 * j] = v[j] * rstd * gv[j];
            }
            GRID_BAR();
        }
    }
#undef IN
#undef GRID_BAR
#undef PHASE_BEGIN
}

#ifndef ONE_LAUNCH
#define ONE_LAUNCH 1
#endif
extern "C" void kernel_launch(void* const* d_in, const int* in_sizes, int n_in, void* d_out, int out_size, void* d_ws, size_t ws_size, hipStream_t stream) {
    static int grid = 0;
    if (grid == 0) {
        if (n_in != N_IN || in_sizes[0] != BATCH * SEQ * DM || out_size != BATCH * SEQ * DM || ws_size < WS_END) {
            fprintf(stderr, "kernel_launch: unexpected shapes / workspace (n_in %d, ws %zu, need %zu); nothing launched\n", n_in, ws_size, (size_t)WS_END); grid = -1; return; }
        int dev = 0, cus = 0, per_cu = 0;
        if (hipGetDevice(&dev) != hipSuccess || hipDeviceGetAttribute(&cus, hipDeviceAttributeMultiprocessorCount, dev) != hipSuccess) { grid = -1; return; }
        if (hipFuncSetAttribute((const void*)fwd, hipFuncAttributeMaxDynamicSharedMemorySize, LDS_BYTES) != hipSuccess) { fprintf(stderr, "kernel_launch: hipFuncSetAttribute failed\n"); grid = -1; return; }
        if (hipOccupancyMaxActiveBlocksPerMultiprocessor(&per_cu, (const void*)fwd, NTHR, LDS_BYTES) != hipSuccess || per_cu < 1) { fprintf(stderr, "kernel_launch: occupancy query says %d\n", per_cu); (void)hipGetLastError(); }
        grid = cus;
    }
    if (grid < 0) return;
    (void)hipMemsetAsync((char*)d_ws + WS_CTL, 0, (size_t)(4096 + XCD_BAR_WORDS) * 4, stream);
    Args a{};
    for (int i = 0; i < N_IN; ++i) a.in[i] = (const float*)d_in[i];
    a.out = (float*)d_out; a.ws = (unsigned char*)d_ws; a.pad = 0;
#if ONE_LAUNCH
    a.l_lo = 0; a.l_hi = DEPTH; a.g_lo = 0; a.g_hi = NG; a.ph_lo = 0; a.ph_hi = PH_COUNT; a.use_bar = 1;
    hipLaunchKernelGGL(fwd, dim3(grid), dim3(NTHR), LDS_BYTES, stream, a);
#else
    a.use_bar = 0;
    for (int l = 0; l < DEPTH; ++l)
        for (int g = 0; g < NG; ++g)
            for (int ph = 0; ph < PH_COUNT; ++ph) {
                if (ph == PH_W && g != 0) continue;
                if (ph == PH_FINAL && l != DEPTH - 1) continue;
                if ((ph == PH_OUT || ph == PH_UP || ph == PH_DOWN || ph == PH_FINAL) && (g % FG) != FG - 1) continue;
                a.l_lo = l; a.l_hi = l + 1; a.g_lo = g; a.g_hi = g + 1; a.ph_lo = ph; a.ph_hi = ph + 1;
                hipLaunchKernelGGL(fwd, dim3(grid), dim3(NTHR), LDS_BYTES, stream, a);
            }
#endif
}
```
